# Optimizing an MI355X kernel written in HIP

```python
import jax
import jax.numpy as jnp
from jax import lax
import numpy as np

D_MODEL = 1024
BATCH = 8
SEQ = 2048
DEPTH = 1

N_MEM = 256
D_MIX = D_MODEL
HEAD_DIM = 64
NSA_HEADS = 8
NSA_KV_HEADS = 2
NSA_WIDTH = NSA_HEADS * HEAD_DIM
NSA_KV_WIDTH = NSA_KV_HEADS * HEAD_DIM
CONV_WIDTH = D_MIX - NSA_WIDTH
CONV_K = 3
CMP_LEN = 32
CMP_STRIDE = 16
CMP_HIDDEN = 256
SEL_LEN = 64
N_SEL = 16
WINDOW = 512
Q_BLK = 128
ROPE_THETA = 10000.0
XATTN_HEADS = 4
XATTN_HEAD_DIM = D_MODEL // XATTN_HEADS
N_EXPERTS = 32
TOP_K = 4
D_FF = D_MODEL
SWIGLU_LIMIT = 7.0
SWIGLU_ALPHA = 1.702
MOE_BLK = 128
RMS_EPS = 1e-5
NEG_INF = -1e30
FORCED = 1e30
IN_SIZES = (NSA_WIDTH, NSA_KV_WIDTH, NSA_KV_WIDTH, NSA_KV_WIDTH, NSA_KV_WIDTH, NSA_KV_WIDTH, NSA_KV_WIDTH, 3 * NSA_HEADS, CONV_WIDTH, CONV_WIDTH, CONV_WIDTH)
IN_COLS = NSA_WIDTH + 6 * NSA_KV_WIDTH + 3 * NSA_HEADS + 3 * CONV_WIDTH

kernel_name = 'hymba_nsa_shortconv_moe_block'


def rmsnorm(t, g):
    tf = t.astype(jnp.float32)
    y = tf * lax.rsqrt(jnp.mean(tf * tf, axis=-1, keepdims=True) + RMS_EPS)
    return (y * g.astype(jnp.float32)).astype(t.dtype)


def rope(t, pos):
    half = HEAD_DIM // 2
    inv_freq = ROPE_THETA ** (-jnp.arange(half, dtype=jnp.float32) / half)
    ang = pos.astype(jnp.float32)[:, :, None] * inv_freq
    cos = jnp.cos(ang)[:, :, None, :]
    sin = jnp.sin(ang)[:, :, None, :]
    tf = t.astype(jnp.float32)
    t1, t2 = tf[..., :half], tf[..., half:]
    return jnp.concatenate([t1 * cos - t2 * sin, t2 * cos + t1 * sin], axis=-1).astype(t.dtype)


def masked_softmax(s, mask):
    return jax.nn.softmax(jnp.where(mask, s, NEG_INF), axis=-1)


def compress_blocks(t, pos_emb, w1, b1, w2):
    B, S, G, dh = t.shape
    nc = (S - CMP_LEN) // CMP_STRIDE + 1
    idx = jnp.arange(nc)[:, None] * CMP_STRIDE + jnp.arange(CMP_LEN)[None, :]
    blk = t[:, idx] + pos_emb[:, None, :]
    blk = jnp.moveaxis(blk, 3, 2).reshape(B, nc, G, CMP_LEN * dh)
    hid = jax.nn.gelu(blk @ w1 + b1)
    return hid @ w2


def nsa_attention(q, k_cmp, v_cmp, k_slc, v_slc, k_win, v_win, gate_logits,
                  cmp_pos_k, cmp_pos_v, cmp_w1_k, cmp_b1_k, cmp_w2_k, cmp_w1_v, cmp_b1_v, cmp_w2_v):
    B, S = q.shape[0], q.shape[1]
    G = NSA_KV_HEADS
    HPG = NSA_HEADS // NSA_KV_HEADS
    scale = HEAD_DIM ** -0.5
    f32 = jnp.float32
    qg = q.reshape(B, S, G, HPG, HEAD_DIM)
    s_idx = jnp.arange(S)

    kc = compress_blocks(k_cmp, cmp_pos_k, cmp_w1_k, cmp_b1_k, cmp_w2_k)
    vc = compress_blocks(v_cmp, cmp_pos_v, cmp_w1_v, cmp_b1_v, cmp_w2_v)
    nc = kc.shape[1]
    c_end = jnp.arange(nc) * CMP_STRIDE + CMP_LEN - 1
    cmask = c_end[None, :] <= s_idx[:, None]
    sc = jnp.einsum('bsghd,bcgd->bghsc', qg, kc, preferred_element_type=f32) * scale
    p_cmp = jnp.where(cmask, masked_softmax(sc, cmask), 0.0)
    o_cmp = jnp.einsum('bghsc,bcgd->bsghd', p_cmp.astype(vc.dtype), vc).reshape(B, S, NSA_HEADS, HEAD_DIM)

    ns = S // SEL_LEN
    cs = jnp.arange(nc) * CMP_STRIDE
    js = jnp.arange(ns) * SEL_LEN
    overlap = jnp.clip(jnp.minimum(cs[:, None] + CMP_LEN, js[None, :] + SEL_LEN)
                       - jnp.maximum(cs[:, None], js[None, :]), 0, None).astype(f32) / CMP_LEN
    imp = jnp.einsum('bghsc,cj->bgsj', p_cmp, overlap)
    cur = (s_idx // SEL_LEN)[:, None]
    jj = jnp.arange(ns)[None, :]
    forced = (jj == 0) | (jj == cur) | (jj == cur - 1)
    imp = jnp.where(forced, FORCED, jnp.where(jj > cur, NEG_INF, imp))
    n_top = min(N_SEL, ns)
    _, sel_idx = lax.top_k(imp, n_top)

    ks_blk = jnp.moveaxis(k_slc, 2, 1).reshape(B, G, ns, SEL_LEN, HEAD_DIM)
    vs_blk = jnp.moveaxis(v_slc, 2, 1).reshape(B, G, ns, SEL_LEN, HEAD_DIM)
    kw_pad = jnp.pad(k_win, ((0, 0), (WINDOW, 0), (0, 0), (0, 0)))
    vw_pad = jnp.pad(v_win, ((0, 0), (WINDOW, 0), (0, 0), (0, 0)))
    gather = jax.vmap(jax.vmap(lambda blk, ix: blk[ix]))
    offs = jnp.arange(SEL_LEN)
    kpos_rel = jnp.arange(WINDOW + Q_BLK) - WINDOW

    def query_block(ci):
        s0 = ci * Q_BLK
        qpos = s0 + jnp.arange(Q_BLK)
        qc = lax.dynamic_slice_in_dim(qg, s0, Q_BLK, axis=1)
        ix = lax.dynamic_slice_in_dim(sel_idx, s0, Q_BLK, axis=2)
        ksel = gather(ks_blk, ix).reshape(B, G, Q_BLK, n_top * SEL_LEN, HEAD_DIM)
        vsel = gather(vs_blk, ix).reshape(B, G, Q_BLK, n_top * SEL_LEN, HEAD_DIM)
        tpos = (ix[..., None] * SEL_LEN + offs).reshape(B, G, Q_BLK, n_top * SEL_LEN)
        smask = (tpos <= qpos[:, None])[:, :, None]
        ss = jnp.einsum('bqghd,bgqnd->bghqn', qc, ksel, preferred_element_type=f32) * scale
        ps = masked_softmax(ss, smask)
        o_s = jnp.einsum('bghqn,bgqnd->bqghd', ps.astype(vsel.dtype), vsel)
        kw = lax.dynamic_slice_in_dim(kw_pad, s0, WINDOW + Q_BLK, axis=1)
        vw = lax.dynamic_slice_in_dim(vw_pad, s0, WINDOW + Q_BLK, axis=1)
        kpos = s0 + kpos_rel
        wmask = ((kpos[None, :] <= qpos[:, None]) & (qpos[:, None] - kpos[None, :] < WINDOW)
                 & (kpos[None, :] >= 0))
        sw = jnp.einsum('bqghd,bkgd->bghqk', qc, kw, preferred_element_type=f32) * scale
        pw = masked_softmax(sw, wmask)
        o_w = jnp.einsum('bghqk,bkgd->bqghd', pw.astype(vw.dtype), vw)
        return o_s, o_w

    o_slc, o_win = lax.map(query_block, jnp.arange(S // Q_BLK))
    o_slc = jnp.moveaxis(o_slc, 0, 1).reshape(B, S, NSA_HEADS, HEAD_DIM)
    o_win = jnp.moveaxis(o_win, 0, 1).reshape(B, S, NSA_HEADS, HEAD_DIM)

    g = jax.nn.sigmoid(gate_logits.astype(f32)).astype(q.dtype)
    o = g[..., 0:1] * o_cmp + g[..., 1:2] * o_slc + g[..., 2:3] * o_win
    return o.reshape(B, S, NSA_WIDTH)


def short_gated_conv(h, b_gate, c_gate, conv_w):
    u = c_gate * h
    y = lax.conv_general_dilated(u, conv_w[:, None, :].astype(u.dtype), window_strides=(1,),
                                 padding=[(CONV_K - 1, 0)], dimension_numbers=('NWC', 'WIO', 'NWC'),
                                 feature_group_count=u.shape[-1])
    return b_gate * y


def hybrid_mixer(xn, positions, w_mix_in, cmp_pos_k, cmp_pos_v, cmp_w1_k, cmp_b1_k, cmp_w2_k,
                 cmp_w1_v, cmp_b1_v, cmp_w2_v, conv_w, g_nsa_out, g_conv_out, w_mix_out):
    B, S, _ = xn.shape
    proj = xn @ w_mix_in
    splits = np.cumsum(IN_SIZES)[:-1].tolist()
    q, kc, vc, ks, vs, kw, vw, gl, ch, cb, cc = jnp.split(proj, splits, axis=-1)
    kvshape = (B, S, NSA_KV_HEADS, HEAD_DIM)
    q = rope(q.reshape(B, S, NSA_HEADS, HEAD_DIM), positions)
    kc = rope(kc.reshape(kvshape), positions)
    ks = rope(ks.reshape(kvshape), positions)
    kw = rope(kw.reshape(kvshape), positions)
    o_nsa = nsa_attention(q, kc, vc.reshape(kvshape), ks, vs.reshape(kvshape), kw, vw.reshape(kvshape),
                          gl.reshape(B, S, NSA_HEADS, 3), cmp_pos_k, cmp_pos_v,
                          cmp_w1_k, cmp_b1_k, cmp_w2_k, cmp_w1_v, cmp_b1_v, cmp_w2_v)
    o_conv = short_gated_conv(ch, cb, cc, conv_w)
    o = jnp.concatenate([rmsnorm(o_nsa, g_nsa_out), rmsnorm(o_conv, g_conv_out)], axis=-1)
    return o @ w_mix_out


def memory_cross_attention(hn, memn, w_xq, w_xkv, w_xo):
    B, S, D = hn.shape
    M = memn.shape[1]
    q = (hn @ w_xq).reshape(B, S, XATTN_HEADS, XATTN_HEAD_DIM)
    k, v = jnp.split(memn @ w_xkv, 2, axis=-1)
    k = k.reshape(B, M, XATTN_HEADS, XATTN_HEAD_DIM)
    v = v.reshape(B, M, XATTN_HEADS, XATTN_HEAD_DIM)
    s = jnp.einsum('bshd,bmhd->bhsm', q, k, preferred_element_type=jnp.float32) * XATTN_HEAD_DIM ** -0.5
    p = jax.nn.softmax(s, axis=-1)
    o = jnp.einsum('bhsm,bmhd->bshd', p.astype(v.dtype), v).reshape(B, S, D)
    return o @ w_xo


def moe_ffn(xn, w_router, b_router, w_gate_up, b_gate_up, w_down, b_down):
    B, S, D = xn.shape
    T = B * S
    A = T * TOP_K
    xt = xn.reshape(T, D)
    logits = (xt @ w_router + b_router).astype(jnp.float32)
    top_v, top_e = lax.top_k(logits, TOP_K)
    gate = jax.nn.softmax(top_v, axis=-1)
    e_flat = top_e.reshape(A).astype(jnp.int32)
    tok_flat = jnp.repeat(jnp.arange(T, dtype=jnp.int32), TOP_K)
    w_flat = gate.reshape(A)
    order = jnp.argsort(e_flat)
    e_sorted = e_flat[order]
    counts = jnp.bincount(e_flat, length=N_EXPERTS).astype(jnp.int32)
    padded = (counts + MOE_BLK - 1) // MOE_BLK * MOE_BLK
    start = jnp.cumsum(counts) - counts
    pend = jnp.cumsum(padded)
    pstart = pend - padded
    dest = pstart[e_sorted] + (jnp.arange(A, dtype=jnp.int32) - start[e_sorted])
    P = A + N_EXPERTS * MOE_BLK
    nblk = P // MOE_BLK
    tok_buf = jnp.zeros((P,), jnp.int32).at[dest].set(tok_flat[order])
    w_buf = jnp.zeros((P,), jnp.float32).at[dest].set(w_flat[order])
    blk_e = jnp.minimum(jnp.searchsorted(pend, jnp.arange(nblk, dtype=jnp.int32) * MOE_BLK, side='right'),
                        N_EXPERTS - 1).astype(jnp.int32)

    def expert_block(args):
        tok, e = args
        xb = xt[tok]
        gu = xb @ w_gate_up[e] + b_gate_up[e]
        g, u = gu[:, :D_FF], gu[:, D_FF:]
        g = jnp.minimum(g, SWIGLU_LIMIT)
        u = jnp.clip(u, -SWIGLU_LIMIT, SWIGLU_LIMIT)
        hmid = (u + 1.0) * (g * jax.nn.sigmoid(SWIGLU_ALPHA * g))
        return hmid @ w_down[e] + b_down[e]

    out = lax.map(expert_block, (tok_buf.reshape(nblk, MOE_BLK), blk_e))
    y = jnp.zeros((T, D), jnp.float32).at[tok_buf].add(out.reshape(P, D).astype(jnp.float32) * w_buf[:, None])
    return y.astype(xn.dtype).reshape(B, S, D)


def setup_inputs(seed: int = 0) -> dict:
    key = jax.random.key(seed)
    ks = jax.random.split(key, 32)
    L, D = DEPTH, D_MODEL

    def nrm(k, shape, scale):
        return jax.random.normal(k, shape, jnp.float32) * scale

    def gain(k, shape):
        return 1.0 + 0.02 * jax.random.normal(k, shape, jnp.float32)

    positions = (jax.random.randint(ks[2], (BATCH, 1), 0, 4096, dtype=jnp.int32)
                 + jnp.arange(SEQ, dtype=jnp.int32)[None, :])
    return {
        'x': nrm(ks[0], (BATCH, SEQ, D), 1.0),
        'mem': nrm(ks[1], (BATCH, N_MEM, D), 1.0),
        'positions': positions,
        'g_mix_norm': gain(ks[3], (L, D)),
        'w_mix_in': nrm(ks[4], (L, D, IN_COLS), D ** -0.5),
        'cmp_pos_k': nrm(ks[5], (L, CMP_LEN, HEAD_DIM), 0.1),
        'cmp_pos_v': nrm(ks[6], (L, CMP_LEN, HEAD_DIM), 0.1),
        'cmp_w1_k': nrm(ks[7], (L, CMP_LEN * HEAD_DIM, CMP_HIDDEN), (CMP_LEN * HEAD_DIM) ** -0.5),
        'cmp_b1_k': nrm(ks[8], (L, CMP_HIDDEN), 0.01),
        'cmp_w2_k': nrm(ks[9], (L, CMP_HIDDEN, HEAD_DIM), CMP_HIDDEN ** -0.5),
        'cmp_w1_v': nrm(ks[10], (L, CMP_LEN * HEAD_DIM, CMP_HIDDEN), (CMP_LEN * HEAD_DIM) ** -0.5),
        'cmp_b1_v': nrm(ks[11], (L, CMP_HIDDEN), 0.01),
        'cmp_w2_v': nrm(ks[12], (L, CMP_HIDDEN, HEAD_DIM), CMP_HIDDEN ** -0.5),
        'conv_w': nrm(ks[13], (L, CONV_K, CONV_WIDTH), CONV_K ** -0.5),
        'g_nsa_out': gain(ks[14], (L, NSA_WIDTH)),
        'g_conv_out': gain(ks[15], (L, CONV_WIDTH)),
        'w_mix_out': nrm(ks[16], (L, D_MIX, D), D_MIX ** -0.5),
        'g_xattn_norm': gain(ks[17], (L, D)),
        'g_mem_norm': gain(ks[18], (L, D)),
        'w_xq': nrm(ks[19], (L, D, D), D ** -0.5),
        'w_xkv': nrm(ks[20], (L, D, 2 * D), D ** -0.5),
        'w_xo': nrm(ks[21], (L, D, D), D ** -0.5),
        'g_moe_norm': gain(ks[22], (L, D)),
        'w_router': nrm(ks[23], (L, D, N_EXPERTS), D ** -0.5),
        'b_router': nrm(ks[24], (L, N_EXPERTS), 0.01),
        'w_gate_up': nrm(ks[25], (L, N_EXPERTS, D, 2 * D_FF), D ** -0.5),
        'b_gate_up': nrm(ks[26], (L, N_EXPERTS, 2 * D_FF), 0.01),
        'w_down': nrm(ks[27], (L, N_EXPERTS, D_FF, D), D_FF ** -0.5),
        'b_down': nrm(ks[28], (L, N_EXPERTS, D), 0.01),
        'g_final': gain(ks[29], (D,)),
    }


def reference(x, mem, positions, g_mix_norm, w_mix_in, cmp_pos_k, cmp_pos_v, cmp_w1_k, cmp_b1_k, cmp_w2_k,
              cmp_w1_v, cmp_b1_v, cmp_w2_v, conv_w, g_nsa_out, g_conv_out, w_mix_out, g_xattn_norm,
              g_mem_norm, w_xq, w_xkv, w_xo, g_moe_norm, w_router, b_router, w_gate_up, b_gate_up,
              w_down, b_down, g_final):
    h = x
    for l in range(DEPTH):
        h = h + hybrid_mixer(rmsnorm(h, g_mix_norm[l]), positions, w_mix_in[l], cmp_pos_k[l], cmp_pos_v[l],
                             cmp_w1_k[l], cmp_b1_k[l], cmp_w2_k[l], cmp_w1_v[l], cmp_b1_v[l], cmp_w2_v[l],
                             conv_w[l], g_nsa_out[l], g_conv_out[l], w_mix_out[l])
        h = h + memory_cross_attention(rmsnorm(h, g_xattn_norm[l]), rmsnorm(mem, g_mem_norm[l]),
                                       w_xq[l], w_xkv[l], w_xo[l])
        h = h + moe_ffn(rmsnorm(h, g_moe_norm[l]), w_router[l], b_router[l], w_gate_up[l], b_gate_up[l],
                        w_down[l], b_down[l])
    return rmsnorm(h, g_final)
```

```cpp
#include <hip/hip_runtime.h>
#include <hip/hip_bf16.h>
#include <stdint.h>

namespace {
constexpr int D = 1024, NB = 8, S = 2048, T = NB * S, NMEM = 256;
constexpr int INC = 2840;
constexpr int C_Q = 0, C_KC = 512, C_VC = 640, C_KS = 768, C_VS = 896, C_KW = 1024, C_VW = 1152, C_GL = 1280, C_CH = 1304, C_CB = 1816, C_CC = 2328;
constexpr int NC = 127, NCR = NB * NC * 2;
constexpr int NE = 32, TOPK = 4, DFF = 1024, NA = T * TOPK;
constexpr int MT = 64;
constexpr int PMAX = NA + NE * MT, NTILE = PMAX / MT;

__device__ __forceinline__ float wave_sum(float v) { for (int o = 32; o > 0; o >>= 1) v += __shfl_xor(v, o); return v; }
__device__ __forceinline__ float wave_max(float v) { for (int o = 32; o > 0; o >>= 1) v = fmaxf(v, __shfl_xor(v, o)); return v; }

__global__ void __launch_bounds__(256) k_rmsnorm(const float* __restrict__ in, int ldi, const float* __restrict__ g, float* __restrict__ out, int ldo, int W) {
    __shared__ float red[4];
    const float* r = in + (size_t)blockIdx.x * ldi;
    float ss = 0.f;
    for (int i = threadIdx.x; i < W; i += 256) { float v = r[i]; ss += v * v; }
    ss = wave_sum(ss);
    if ((threadIdx.x & 63) == 0) red[threadIdx.x >> 6] = ss;
    __syncthreads();
    ss = red[0] + red[1] + red[2] + red[3];
    const float rs = rsqrtf(ss / (float)W + 1e-5f);
    float* o = out + (size_t)blockIdx.x * ldo;
    for (int i = threadIdx.x; i < W; i += 256) o[i] = r[i] * rs * g[i];
}

template <int NACC, class AL, class BL>
__device__ __forceinline__ void gemm_tile_f32(float (&acc)[NACC][4][4], int K, AL al, BL bl, float (*As)[68], float (*Bs)[NACC * 64 + 4]) {
    const int tid = threadIdx.x, tx = tid & 15, ty = tid >> 4;
    const int ar = tid >> 2, ak = (tid & 3) * 4;
    const int bk = tid >> 4, bc = (tid & 15) * 4;
#pragma unroll
    for (int w = 0; w < NACC; ++w)
#pragma unroll
        for (int i = 0; i < 4; ++i)
#pragma unroll
            for (int j = 0; j < 4; ++j) acc[w][i][j] = 0.f;
    for (int k0 = 0; k0 < K; k0 += 16) {
        const float4 a = al(ar, k0 + ak);
        float4 b[NACC];
#pragma unroll
        for (int w = 0; w < NACC; ++w) b[w] = bl(w, k0 + bk, bc);
        __syncthreads();
        As[ak + 0][ar] = a.x; As[ak + 1][ar] = a.y; As[ak + 2][ar] = a.z; As[ak + 3][ar] = a.w;
#pragma unroll
        for (int w = 0; w < NACC; ++w) *(float4*)&Bs[bk][w * 64 + bc] = b[w];
        __syncthreads();
#pragma unroll
        for (int kk = 0; kk < 16; ++kk) {
            const float4 av = *(const float4*)&As[kk][ty * 4];
            const float aa[4] = {av.x, av.y, av.z, av.w};
#pragma unroll
            for (int w = 0; w < NACC; ++w) {
                const float4 bv = *(const float4*)&Bs[kk][w * 64 + tx * 4];
                const float bb[4] = {bv.x, bv.y, bv.z, bv.w};
#pragma unroll
                for (int i = 0; i < 4; ++i)
#pragma unroll
                    for (int j = 0; j < 4; ++j) acc[w][i][j] += aa[i] * bb[j];
            }
        }
    }
}

__global__ void __launch_bounds__(256) k_gemm(const float* __restrict__ A, int lda, const float* __restrict__ Bm, int ldb, float* C, int ldc,
                                              const float* res, int M, int N, int K) {
    __shared__ float As[16][68];
    __shared__ float Bs[16][68];
    const int row0 = blockIdx.y * 64, col0 = blockIdx.x * 64;
    float acc[1][4][4];
    auto al = [&](int r, int k) -> float4 { const int row = row0 + r; return row < M ? *(const float4*)(A + (size_t)row * lda + k) : make_float4(0.f, 0.f, 0.f, 0.f); };
    auto bl = [&](int, int k, int c) -> float4 { const int col = col0 + c; return col < N ? *(const float4*)(Bm + (size_t)k * ldb + col) : make_float4(0.f, 0.f, 0.f, 0.f); };
    gemm_tile_f32<1>(acc, K, al, bl, As, Bs);
    const int tx = threadIdx.x & 15, ty = threadIdx.x >> 4;
#pragma unroll
    for (int i = 0; i < 4; ++i) {
        const int row = row0 + ty * 4 + i;
        if (row >= M) continue;
#pragma unroll
        for (int j = 0; j < 4; ++j) {
            const int col = col0 + tx * 4 + j;
            if (col >= N) continue;
            float v = acc[0][i][j];
            if (res) v += res[(size_t)row * ldc + col];
            C[(size_t)row * ldc + col] = v;
        }
    }
}

__global__ void __launch_bounds__(256) k_rope(float* __restrict__ proj, const int* __restrict__ pos) {
    const int t = blockIdx.x;
    const float p = (float)pos[t];
    float* r = proj + (size_t)t * INC;
    for (int i = threadIdx.x; i < 448; i += 256) {
        const int hd = i >> 5, f = i & 31;
        int col;
        if (hd < 8) col = C_Q + hd * 64; else if (hd < 10) col = C_KC + (hd - 8) * 64; else if (hd < 12) col = C_KS + (hd - 10) * 64; else col = C_KW + (hd - 12) * 64;
        const float inv = powf(10000.f, -(float)f / 32.f);
        const float ang = p * inv;
        const float c = cosf(ang), s = sinf(ang);
        const float t1 = r[col + f], t2 = r[col + 32 + f];
        r[col + f] = t1 * c - t2 * s;
        r[col + 32 + f] = t2 * c + t1 * s;
    }
}

__device__ __forceinline__ float gelu_tanh(float x) { const float u = 0.7978845608028654f * (x + 0.044715f * x * x * x); return 0.5f * x * (1.f + tanhf(u)); }
__global__ void __launch_bounds__(256) k_cmp1(const float* __restrict__ proj, int colbase, const float* __restrict__ pos, const float* __restrict__ w1, const float* __restrict__ b1, float* __restrict__ hid) {
    __shared__ float As[16][68];
    __shared__ float Bs[16][68];
    const int row0 = blockIdx.y * 64, col0 = blockIdx.x * 64;
    float acc[1][4][4];
    auto al = [&](int r, int k) -> float4 {
        const int row = row0 + r; if (row >= NCR) return make_float4(0.f, 0.f, 0.f, 0.f);
        const int g = row & 1, bc = row >> 1, c = bc % NC, b = bc / NC, l = k >> 6, d = k & 63;
        const float4 v = *(const float4*)(proj + (size_t)(b * S + 16 * c + l) * INC + colbase + g * 64 + d);
        const float4 pe = *(const float4*)(pos + k);
        return make_float4(v.x + pe.x, v.y + pe.y, v.z + pe.z, v.w + pe.w);
    };
    auto bl = [&](int, int k, int c) -> float4 { return *(const float4*)(w1 + (size_t)k * 256 + col0 + c); };
    gemm_tile_f32<1>(acc, 2048, al, bl, As, Bs);
    const int tx = threadIdx.x & 15, ty = threadIdx.x >> 4;
#pragma unroll
    for (int i = 0; i < 4; ++i) {
        const int row = row0 + ty * 4 + i;
        if (row >= NCR) continue;
#pragma unroll
        for (int j = 0; j < 4; ++j) { const int col = col0 + tx * 4 + j; hid[(size_t)row * 256 + col] = gelu_tanh(acc[0][i][j] + b1[col]); }
    }
}

template <int DH, class KeyF>
__device__ __forceinline__ void wave_attend(const float* q, int ncand, KeyF keyf, float* sc, float* out, int lane) {
    float m = -3.0e38f;
    for (int idx = lane; idx < ncand; idx += 64) {
        const float *kp, *vp;
        float s = -3.0e38f;
        if (keyf(idx, kp, vp)) {
            s = 0.f;
#pragma unroll 4
            for (int d = 0; d < DH; d += 4) { const float4 kv = *(const float4*)(kp + d); s += q[d] * kv.x + q[d + 1] * kv.y + q[d + 2] * kv.z + q[d + 3] * kv.w; }
        }
        sc[idx] = s;
        m = fmaxf(m, s);
    }
    m = wave_max(m);
    float sum = 0.f;
    for (int idx = lane; idx < ncand; idx += 64) { const float s = sc[idx]; const float p = (s > -1.0e38f) ? __expf(s - m) : 0.f; sc[idx] = p; sum += p; }
    sum = wave_sum(sum);
    const float inv = (m > -1.0e38f) ? 1.f / sum : 0.f;
    for (int idx = lane; idx < ncand; idx += 64) sc[idx] *= inv;
    __builtin_amdgcn_s_waitcnt(0);
    float o[DH / 64];
#pragma unroll
    for (int i = 0; i < DH / 64; ++i) o[i] = 0.f;
    for (int idx = 0; idx < ncand; ++idx) {
        const float p = sc[idx];
        if (p == 0.f) continue;
        const float *kp, *vp;
        keyf(idx, kp, vp);
#pragma unroll
        for (int i = 0; i < DH / 64; ++i) o[i] += p * vp[lane + 64 * i];
    }
#pragma unroll
    for (int i = 0; i < DH / 64; ++i) out[lane + 64 * i] = o[i];
}

__global__ void __launch_bounds__(256) k_cmp_attn(const float* __restrict__ proj, const float* __restrict__ kc, const float* __restrict__ vc,
                                                  float* __restrict__ o_cmp, unsigned* __restrict__ selmask) {
    __shared__ float qs[4][64];
    __shared__ float ps[4][128];
    __shared__ float imps[32];
    const int g = blockIdx.x & 1, t = blockIdx.x >> 1, b = t / S, s = t % S;
    const int w = threadIdx.x >> 6, lane = threadIdx.x & 63, h = g * 4 + w;
    qs[w][lane] = proj[(size_t)t * INC + C_Q + h * 64 + lane] * 0.125f;
    ps[w][lane] = 0.f; ps[w][lane + 64] = 0.f;
    __syncthreads();
    auto keyf = [&](int c, const float*& kp, const float*& vp) -> bool {
        kp = kc + (size_t)((b * NC + c) * 2 + g) * 64; vp = vc + (size_t)((b * NC + c) * 2 + g) * 64;
        return 16 * c + 31 <= s;
    };
    wave_attend<64>(qs[w], NC, keyf, ps[w], o_cmp + (size_t)t * 512 + h * 64, lane);
    __syncthreads();
    if (threadIdx.x < 32) {
        const int j = threadIdx.x;
        float imp = 0.f;
        for (int hh = 0; hh < 4; ++hh)
            for (int c = 4 * j - 1; c <= 4 * j + 3; ++c) {
                if (c < 0 || c >= NC) continue;
                const float ov = (c == 4 * j - 1 || c == 4 * j + 3) ? 0.5f : 1.0f;
                imp += ps[hh][c] * ov;
            }
        const int cur = s >> 6;
        if (j == 0 || j == cur || j == cur - 1) imp = 1e30f; else if (j > cur) imp = -1e30f;
        imps[j] = imp;
    }
    __syncthreads();
    if (threadIdx.x < 64) {
        const int j = threadIdx.x & 31;
        const float mine = imps[j];
        int rank = 0;
        for (int i = 0; i < 32; ++i) { const float v = imps[i]; rank += (v > mine || (v == mine && i < j)) ? 1 : 0; }
        const unsigned long long bal = __ballot(rank < 16 && threadIdx.x < 32);
        if (threadIdx.x == 0) selmask[(size_t)(b * 2 + g) * S + s] = (unsigned)(bal & 0xffffffffull);
    }
}

template <int MODE>
__global__ void __launch_bounds__(256) k_nsa_attn(const float* __restrict__ proj, const unsigned* __restrict__ selmask, float* __restrict__ outp) {
    __shared__ float qs[4][64];
    __shared__ float scs[4][2048];
    const int g = blockIdx.x & 1, t = blockIdx.x >> 1, b = t / S, s = t % S;
    const int w = threadIdx.x >> 6, lane = threadIdx.x & 63, h = g * 4 + w;
    qs[w][lane] = proj[(size_t)t * INC + C_Q + h * 64 + lane] * 0.125f;
    __syncthreads();
    if (MODE == 0) {
        const unsigned mask = selmask[(size_t)(b * 2 + g) * S + s];
        const int ncand = ((s >> 6) + 1) * 64;
        auto keyf = [&](int idx, const float*& kp, const float*& vp) -> bool {
            const float* r = proj + (size_t)(b * S + idx) * INC + g * 64;
            kp = r + C_KS; vp = r + C_VS;
            return idx <= s && ((mask >> (idx >> 6)) & 1u);
        };
        wave_attend<64>(qs[w], ncand, keyf, scs[w], outp + (size_t)t * 512 + h * 64, lane);
    } else {
        const int lo = s - 511 > 0 ? s - 511 : 0;
        const int ncand = s - lo + 1;
        auto keyf = [&](int idx, const float*& kp, const float*& vp) -> bool {
            const float* r = proj + (size_t)(b * S + lo + idx) * INC + g * 64;
            kp = r + C_KW; vp = r + C_VW;
            return true;
        };
        wave_attend<64>(qs[w], ncand, keyf, scs[w], outp + (size_t)t * 512 + h * 64, lane);
    }
}

__global__ void __launch_bounds__(256) k_xattn(const float* __restrict__ xq, const float* __restrict__ xkv, float* __restrict__ xo) {
    __shared__ float qs[4][256];
    __shared__ float scs[4][256];
    const int t = blockIdx.x, b = t / S, w = threadIdx.x >> 6, lane = threadIdx.x & 63;
    for (int i = lane; i < 256; i += 64) qs[w][i] = xq[(size_t)t * D + w * 256 + i] * 0.0625f;
    __syncthreads();
    auto keyf = [&](int m, const float*& kp, const float*& vp) -> bool {
        const float* r = xkv + (size_t)(b * NMEM + m) * 2048 + w * 256;
        kp = r; vp = r + 1024;
        return true;
    };
    wave_attend<256>(qs[w], NMEM, keyf, scs[w], xo + (size_t)t * D + w * 256, lane);
}

__global__ void __launch_bounds__(256) k_mix_post(const float* __restrict__ proj, const float* __restrict__ o_cmp, const float* __restrict__ o_slc, const float* __restrict__ o_win,
                                                  const float* __restrict__ conv_w, const float* __restrict__ g_nsa, const float* __restrict__ g_conv, float* __restrict__ omix) {
    __shared__ float red[2][4];
    const int t = blockIdx.x, s = t % S, tid = threadIdx.x;
    const float* r = proj + (size_t)t * INC;
    float on[2], oc[2], ssn = 0.f, ssc = 0.f;
#pragma unroll
    for (int e = 0; e < 2; ++e) {
        const int c = tid + 256 * e, h = c >> 6;
        const float g0 = 1.f / (1.f + __expf(-r[C_GL + h * 3 + 0])), g1 = 1.f / (1.f + __expf(-r[C_GL + h * 3 + 1])), g2 = 1.f / (1.f + __expf(-r[C_GL + h * 3 + 2]));
        on[e] = g0 * o_cmp[(size_t)t * 512 + c] + g1 * o_slc[(size_t)t * 512 + c] + g2 * o_win[(size_t)t * 512 + c];
        ssn += on[e] * on[e];
        float y = 0.f;
#pragma unroll
        for (int k = 0; k < 3; ++k) {
            const int sp = s - 2 + k;
            if (sp < 0) continue;
            const float* rp = proj + (size_t)(t - 2 + k) * INC;
            y += conv_w[k * 512 + c] * (rp[C_CC + c] * rp[C_CH + c]);
        }
        oc[e] = r[C_CB + c] * y;
        ssc += oc[e] * oc[e];
    }
    ssn = wave_sum(ssn); ssc = wave_sum(ssc);
    if ((tid & 63) == 0) { red[0][tid >> 6] = ssn; red[1][tid >> 6] = ssc; }
    __syncthreads();
    ssn = red[0][0] + red[0][1] + red[0][2] + red[0][3];
    ssc = red[1][0] + red[1][1] + red[1][2] + red[1][3];
    const float rn = rsqrtf(ssn / 512.f + 1e-5f), rc = rsqrtf(ssc / 512.f + 1e-5f);
#pragma unroll
    for (int e = 0; e < 2; ++e) {
        const int c = tid + 256 * e;
        omix[(size_t)t * D + c] = on[e] * rn * g_nsa[c];
        omix[(size_t)t * D + 512 + c] = oc[e] * rc * g_conv[c];
    }
}

__global__ void __launch_bounds__(256) k_router(const float* __restrict__ xn, const float* __restrict__ wr, const float* __restrict__ br,
                                                int* __restrict__ a_e, float* __restrict__ a_w, int* __restrict__ a_slot, int* __restrict__ counts) {
    const int t = blockIdx.x * 4 + (threadIdx.x >> 6), lane = threadIdx.x & 63, e = lane & 31, half = lane >> 5;
    const float* x = xn + (size_t)t * D + half * 512;
    const float* w = wr + (size_t)half * 512 * NE + e;
    float acc = 0.f;
    for (int k = 0; k < 512; ++k) acc += x[k] * w[(size_t)k * NE];
    acc += __shfl_xor(acc, 32);
    const float logit = acc + br[e];
    int rank = 0;
    for (int i = 0; i < 32; ++i) { const float v = __shfl(logit, i); rank += (v > logit || (v == logit && i < e)) ? 1 : 0; }
    const float vmax = wave_max(logit);
    const bool sel = (rank < TOPK) && (lane < 32);
    const float ex = sel ? __expf(logit - vmax) : 0.f;
    const float sum = wave_sum(ex);
    if (sel) {
        const int a = t * TOPK + rank;
        a_e[a] = e; a_w[a] = ex / sum; a_slot[a] = atomicAdd(&counts[e], 1);
    }
}
__global__ void k_moe_offsets(const int* __restrict__ counts, int* __restrict__ pstart, int* __restrict__ tile_e) {
    __shared__ int ps[NE + 1];
    if (threadIdx.x == 0) { int acc = 0; for (int e = 0; e < NE; ++e) { ps[e] = acc; pstart[e] = acc; acc += (counts[e] + MT - 1) / MT * MT; } ps[NE] = acc; }
    __syncthreads();
    for (int tl = threadIdx.x; tl < NTILE; tl += blockDim.x) {
        const int r = tl * MT; int e = -1;
        for (int i = 0; i < NE; ++i) if (r >= ps[i] && r < ps[i + 1]) e = i;
        tile_e[tl] = e;
    }
}
__global__ void k_moe_fill(int* __restrict__ tok_buf, float* __restrict__ w_buf) { const int i = blockIdx.x * 256 + threadIdx.x; if (i < PMAX) { tok_buf[i] = 0; w_buf[i] = 0.f; } }
__global__ void k_moe_scatter(const int* __restrict__ a_e, const float* __restrict__ a_w, const int* __restrict__ a_slot, const int* __restrict__ pstart,
                              int* __restrict__ tok_buf, float* __restrict__ w_buf, int* __restrict__ dest_of) {
    const int a = blockIdx.x * 256 + threadIdx.x; if (a >= NA) return;
    const int dest = pstart[a_e[a]] + a_slot[a];
    tok_buf[dest] = a / TOPK; w_buf[dest] = a_w[a]; dest_of[a] = dest;
}
__global__ void __launch_bounds__(256) k_moe1(const float* __restrict__ xn, const int* __restrict__ tok_buf, const int* __restrict__ tile_e,
                                              const float* __restrict__ wgu, const float* __restrict__ bgu, __hip_bfloat16* __restrict__ hmid) {
    __shared__ float As[16][68];
    __shared__ float Bs[16][132];
    __shared__ int toks[MT];
    const int e = tile_e[blockIdx.y]; if (e < 0) return;
    const int row0 = blockIdx.y * MT, col0 = blockIdx.x * 64;
    if (threadIdx.x < MT) toks[threadIdx.x] = tok_buf[row0 + threadIdx.x];
    __syncthreads();
    const float* W = wgu + (size_t)e * D * 2048;
    float acc[2][4][4];
    auto al = [&](int r, int k) -> float4 { return *(const float4*)(xn + (size_t)toks[r] * D + k); };
    auto bl = [&](int w, int k, int c) -> float4 { return *(const float4*)(W + (size_t)k * 2048 + w * 1024 + col0 + c); };
    gemm_tile_f32<2>(acc, D, al, bl, As, Bs);
    const int tx = threadIdx.x & 15, ty = threadIdx.x >> 4;
#pragma unroll
    for (int i = 0; i < 4; ++i)
#pragma unroll
        for (int j = 0; j < 4; ++j) {
            const int row = row0 + ty * 4 + i, col = col0 + tx * 4 + j;
            float g = acc[0][i][j] + bgu[(size_t)e * 2048 + col], u = acc[1][i][j] + bgu[(size_t)e * 2048 + 1024 + col];
            g = fminf(g, 7.f); u = fminf(fmaxf(u, -7.f), 7.f);
            const float hm = (u + 1.f) * (g / (1.f + __expf(-1.702f * g)));
            hmid[(size_t)row * DFF + col] = __float2bfloat16(hm);
        }
}
__global__ void __launch_bounds__(256) k_moe2(const __hip_bfloat16* __restrict__ hmid, const int* __restrict__ tile_e, const float* __restrict__ w_buf,
                                              const float* __restrict__ wd, const float* __restrict__ bd, __hip_bfloat16* __restrict__ out_a) {
    __shared__ float As[16][68];
    __shared__ float Bs[16][68];
    const int e = tile_e[blockIdx.y]; if (e < 0) return;
    const int row0 = blockIdx.y * MT, col0 = blockIdx.x * 64;
    const float* W = wd + (size_t)e * DFF * D;
    float acc[1][4][4];
    auto al = [&](int r, int k) -> float4 {
        const __hip_bfloat16* p = hmid + (size_t)(row0 + r) * DFF + k;
        return make_float4(__bfloat162float(p[0]), __bfloat162float(p[1]), __bfloat162float(p[2]), __bfloat162float(p[3]));
    };
    auto bl = [&](int, int k, int c) -> float4 { return *(const float4*)(W + (size_t)k * D + col0 + c); };
    gemm_tile_f32<1>(acc, DFF, al, bl, As, Bs);
    const int tx = threadIdx.x & 15, ty = threadIdx.x >> 4;
#pragma unroll
    for (int i = 0; i < 4; ++i)
#pragma unroll
        for (int j = 0; j < 4; ++j) {
            const int row = row0 + ty * 4 + i, col = col0 + tx * 4 + j;
            out_a[(size_t)row * D + col] = __float2bfloat16((acc[0][i][j] + bd[(size_t)e * D + col]) * w_buf[row]);
        }
}
__global__ void __launch_bounds__(256) k_final(const float* __restrict__ h2, const __hip_bfloat16* __restrict__ out_a, const int* __restrict__ dest_of,
                                               const float* __restrict__ g, float* __restrict__ out) {
    __shared__ float red[4];
    const int t = blockIdx.x, tid = threadIdx.x;
    int d[4];
#pragma unroll
    for (int k = 0; k < 4; ++k) d[k] = dest_of[t * 4 + k];
    float v[4], ss = 0.f;
#pragma unroll
    for (int e = 0; e < 4; ++e) {
        const int c = tid + 256 * e;
        float x = h2[(size_t)t * D + c];
#pragma unroll
        for (int k = 0; k < 4; ++k) x += __bfloat162float(out_a[(size_t)d[k] * D + c]);
        v[e] = x; ss += x * x;
    }
    ss = wave_sum(ss);
    if ((tid & 63) == 0) red[tid >> 6] = ss;
    __syncthreads();
    ss = red[0] + red[1] + red[2] + red[3];
    const float rs = rsqrtf(ss / (float)D + 1e-5f);
#pragma unroll
    for (int e = 0; e < 4; ++e) { const int c = tid + 256 * e; out[(size_t)t * D + c] = v[e] * rs * g[c]; }
}
__global__ void k_fail(float* out, int n) { const int i = blockIdx.x * 256 + threadIdx.x; if (i < n) out[i] = __builtin_nanf(""); }
}

extern "C" void kernel_launch(void* const* d_in, const int* in_sizes, int n_in, void* d_out, int out_size, void* d_ws, size_t ws_size, hipStream_t stream) {
    const float* x = (const float*)d_in[0];
    const float* mem = (const float*)d_in[1];
    const int* positions = (const int*)d_in[2];
    const float* g_mix_norm = (const float*)d_in[3];
    const float* w_mix_in = (const float*)d_in[4];
    const float* cmp_pos_k = (const float*)d_in[5];
    const float* cmp_pos_v = (const float*)d_in[6];
    const float* cmp_w1_k = (const float*)d_in[7];
    const float* cmp_b1_k = (const float*)d_in[8];
    const float* cmp_w2_k = (const float*)d_in[9];
    const float* cmp_w1_v = (const float*)d_in[10];
    const float* cmp_b1_v = (const float*)d_in[11];
    const float* cmp_w2_v = (const float*)d_in[12];
    const float* conv_w = (const float*)d_in[13];
    const float* g_nsa_out = (const float*)d_in[14];
    const float* g_conv_out = (const float*)d_in[15];
    const float* w_mix_out = (const float*)d_in[16];
    const float* g_xattn_norm = (const float*)d_in[17];
    const float* g_mem_norm = (const float*)d_in[18];
    const float* w_xq = (const float*)d_in[19];
    const float* w_xkv = (const float*)d_in[20];
    const float* w_xo = (const float*)d_in[21];
    const float* g_moe_norm = (const float*)d_in[22];
    const float* w_router = (const float*)d_in[23];
    const float* b_router = (const float*)d_in[24];
    const float* w_gate_up = (const float*)d_in[25];
    const float* b_gate_up = (const float*)d_in[26];
    const float* w_down = (const float*)d_in[27];
    const float* b_down = (const float*)d_in[28];
    const float* g_final = (const float*)d_in[29];
    float* out = (float*)d_out;

    char* ws = (char*)d_ws;
    size_t off = 0;
    auto take = [&](size_t bytes) { char* p = ws + off; off += (bytes + 255) & ~(size_t)255; return p; };
    int* counts = (int*)take(NE * 4);
    int* pstart = (int*)take(NE * 4);
    int* tile_e = (int*)take(NTILE * 4);
    int* a_e = (int*)take(NA * 4);
    float* a_w = (float*)take(NA * 4);
    int* a_slot = (int*)take(NA * 4);
    int* dest_of = (int*)take(NA * 4);
    int* tok_buf = (int*)take(PMAX * 4);
    float* w_buf = (float*)take(PMAX * 4);
    unsigned* selmask = (unsigned*)take((size_t)NB * 2 * S * 4);
    float* hid_k = (float*)take((size_t)NCR * 256 * 4);
    float* hid_v = (float*)take((size_t)NCR * 256 * 4);
    float* kc = (float*)take((size_t)NCR * 64 * 4);
    float* vc = (float*)take((size_t)NCR * 64 * 4);
    float* memn = (float*)take((size_t)NB * NMEM * D * 4);
    float* xkv = (float*)take((size_t)NB * NMEM * 2048 * 4);
    float* hbuf = (float*)take((size_t)T * D * 4);
    float* h2 = hbuf;
    char* r14 = take((size_t)T * D * 4 + (size_t)3 * T * 512 * 4);
    float* xn = (float*)r14;
    float* o_cmp = (float*)(r14 + (size_t)T * D * 4);
    float* o_slc = o_cmp + (size_t)T * 512;
    float* o_win = o_slc + (size_t)T * 512;
    float* xq = o_cmp;
    float* proj = (float*)take((size_t)T * INC * 4);
    float* xo = proj;
    __hip_bfloat16* hmid = (__hip_bfloat16*)proj;
    __hip_bfloat16* out_a = (__hip_bfloat16*)r14;
    if (off > ws_size || (size_t)PMAX * D * 2 > (size_t)T * INC * 4 || (size_t)PMAX * D * 2 > (size_t)T * D * 4 + (size_t)3 * T * 512 * 4) {
        k_fail<<<(out_size + 255) / 256, 256, 0, stream>>>(out, out_size);
        return;
    }

    k_rmsnorm<<<T, 256, 0, stream>>>(x, D, g_mix_norm, xn, D, D);
    k_gemm<<<dim3((INC + 63) / 64, T / 64), 256, 0, stream>>>(xn, D, w_mix_in, INC, proj, INC, nullptr, T, INC, D);
    k_rope<<<T, 256, 0, stream>>>(proj, positions);
    k_cmp1<<<dim3(4, (NCR + 63) / 64), 256, 0, stream>>>(proj, C_KC, cmp_pos_k, cmp_w1_k, cmp_b1_k, hid_k);
    k_cmp1<<<dim3(4, (NCR + 63) / 64), 256, 0, stream>>>(proj, C_VC, cmp_pos_v, cmp_w1_v, cmp_b1_v, hid_v);
    k_gemm<<<dim3(1, (NCR + 63) / 64), 256, 0, stream>>>(hid_k, 256, cmp_w2_k, 64, kc, 64, nullptr, NCR, 64, 256);
    k_gemm<<<dim3(1, (NCR + 63) / 64), 256, 0, stream>>>(hid_v, 256, cmp_w2_v, 64, vc, 64, nullptr, NCR, 64, 256);
    k_cmp_attn<<<T * 2, 256, 0, stream>>>(proj, kc, vc, o_cmp, selmask);
    k_nsa_attn<0><<<T * 2, 256, 0, stream>>>(proj, selmask, o_slc);
    k_nsa_attn<1><<<T * 2, 256, 0, stream>>>(proj, selmask, o_win);
    k_mix_post<<<T, 256, 0, stream>>>(proj, o_cmp, o_slc, o_win, conv_w, g_nsa_out, g_conv_out, xn  );
    k_gemm<<<dim3(D / 64, T / 64), 256, 0, stream>>>(xn, D, w_mix_out, D, hbuf, D, x, T, D, D);
    k_rmsnorm<<<T, 256, 0, stream>>>(hbuf, D, g_xattn_norm, xn, D, D);
    k_rmsnorm<<<NB * NMEM, 256, 0, stream>>>(mem, D, g_mem_norm, memn, D, D);
    k_gemm<<<dim3(D / 64, T / 64), 256, 0, stream>>>(xn, D, w_xq, D, xq, D, nullptr, T, D, D);
    k_gemm<<<dim3(2048 / 64, NB * NMEM / 64), 256, 0, stream>>>(memn, D, w_xkv, 2048, xkv, 2048, nullptr, NB * NMEM, 2048, D);
    k_xattn<<<T, 256, 0, stream>>>(xq, xkv, xo);
    k_gemm<<<dim3(D / 64, T / 64), 256, 0, stream>>>(xo, D, w_xo, D, h2, D, hbuf, T, D, D);
    k_rmsnorm<<<T, 256, 0, stream>>>(h2, D, g_moe_norm, xn, D, D);
    hipMemsetAsync(counts, 0, NE * 4, stream);
    k_router<<<T / 4, 256, 0, stream>>>(xn, w_router, b_router, a_e, a_w, a_slot, counts);
    k_moe_offsets<<<1, 256, 0, stream>>>(counts, pstart, tile_e);
    k_moe_fill<<<(PMAX + 255) / 256, 256, 0, stream>>>(tok_buf, w_buf);
    k_moe_scatter<<<(NA + 255) / 256, 256, 0, stream>>>(a_e, a_w, a_slot, pstart, tok_buf, w_buf, dest_of);
    k_moe1<<<dim3(DFF / 64, NTILE), 256, 0, stream>>>(xn, tok_buf, tile_e, w_gate_up, b_gate_up, hmid);
    k_moe2<<<dim3(D / 64, NTILE), 256, 0, stream>>>(hmid, tile_e, w_buf, w_down, b_down, out_a);
    k_final<<<T, 256, 0, stream>>>(h2, out_a, dest_of, g_final, out);
}
```

```cpp
#include <hip/hip_runtime.h>
#include <hip/hip_bf16.h>
#include <stdint.h>
#include <cstdio>

#define XB_TMO      128
#define XB_XCNT(j)  (256  + 64 * (j))
#define XB_XSUB(j)  (1280 + 64 * (j))
#define XB_XGEN(j)  (2304 + 64 * (j))
#define XB_TOP      3328
#define XB_TOPGEN   3392
#define XCD_BAR_WORDS 3456
#define XB_SPIN_CAP (1u << 18)
#define LAS __attribute__((address_space(3)))

__device__ __forceinline__ unsigned xb_ld(unsigned* p)              { return __hip_atomic_load(p, __ATOMIC_RELAXED, __HIP_MEMORY_SCOPE_AGENT); }
__device__ __forceinline__ unsigned xb_add(unsigned* p, unsigned v) { return __hip_atomic_fetch_add(p, v, __ATOMIC_RELAXED, __HIP_MEMORY_SCOPE_AGENT); }
__device__ __forceinline__ unsigned xb_xcc_id() { return (unsigned)__builtin_amdgcn_s_getreg((3 << 11) | 20) & 0xFu; }
#define XB_SPIN(cond, bar) do { unsigned _sp = 0; while (cond) { __builtin_amdgcn_s_sleep(1); \
    if ((++_sp & 255u) == 0u) { if (xb_ld(&(bar)[XB_TMO])) break; if (_sp > XB_SPIN_CAP) { atomicAdd(&(bar)[XB_TMO], 1u); break; } } } } while (0)

struct XcdBarrier {
    unsigned* bar; unsigned x;
    volatile LAS unsigned* st;
};

__device__ __forceinline__ XcdBarrier xcd_barrier_post(unsigned* bar, volatile LAS unsigned* st) {
    XcdBarrier b; b.bar = bar; b.x = xb_xcc_id(); b.st = st;
    if (threadIdx.x == 0) (void)xb_add(&bar[XB_XCNT(b.x)], 1u);
    return b;
}
__device__ __forceinline__ void xcd_barrier_complete(unsigned* bar, unsigned x, unsigned& nloc, unsigned& nx) {
    const unsigned G = gridDim.x * gridDim.y * gridDim.z;
    unsigned sum, cnt, mine, sp = 0u;
    for (;;) {
        sum = 0u; cnt = 0u; mine = 0u;
#pragma unroll
        for (unsigned j = 0; j < 16; ++j) { const unsigned c = xb_ld(&bar[XB_XCNT(j)]); sum += c; cnt += (c > 0u) ? 1u : 0u; mine = (j == x) ? c : mine; }
        if (sum == G) break;
        __builtin_amdgcn_s_sleep(1);
        if ((++sp & 255u) == 0u) { if (xb_ld(&bar[XB_TMO])) break; if (sp > XB_SPIN_CAP) { atomicAdd(&bar[XB_TMO], 1u); break; } }
    }
    nloc = mine > 0u ? mine : 1u; nx = cnt > 0u ? cnt : 1u;
}

__device__ __forceinline__ void xcd_barrier(const XcdBarrier& b) {
    asm volatile("s_waitcnt vmcnt(0)" ::: "memory");
    __syncthreads();
    if (threadIdx.x == 0) {
        unsigned* bar = b.bar;
        __builtin_amdgcn_s_waitcnt(0);
        unsigned nloc = b.st[0], nx = b.st[1];
        if (nloc == 0u) { xcd_barrier_complete(bar, b.x, nloc, nx); b.st[0] = nloc; b.st[1] = nx; }
        const unsigned old = xb_add(&bar[XB_XSUB(b.x)], 1u);
        const unsigned gen = old / nloc;
        if (old + 1u == (gen + 1u) * nloc) {
            __builtin_amdgcn_fence(__ATOMIC_RELEASE, "agent");
            asm volatile("s_waitcnt vmcnt(0)" ::: "memory");
            const unsigned og = xb_add(&bar[XB_TOP], 1u);
            const unsigned tg = og / nx;
            if (og + 1u == (tg + 1u) * nx) xb_add(&bar[XB_TOPGEN], 1u);
            else XB_SPIN(xb_ld(&bar[XB_TOPGEN]) == tg, bar);
            __builtin_amdgcn_fence(__ATOMIC_ACQUIRE, "agent");
            xb_add(&bar[XB_XGEN(b.x)], 1u);
            asm volatile("s_waitcnt vmcnt(0)" ::: "memory");
        } else {
            XB_SPIN(xb_ld(&bar[XB_XGEN(b.x)]) == gen, bar);
            __builtin_amdgcn_fence(__ATOMIC_ACQUIRE, "agent");
            asm volatile("s_waitcnt vmcnt(0)" ::: "memory");
        }
    }
    __syncthreads();
}


namespace {
constexpr int D = 1024, NB = 8, S = 2048, T = NB * S, NMEM = 256;
constexpr int INC = 2840;
constexpr int C_Q = 0, C_KC = 512, C_VC = 640, C_KS = 768, C_VS = 896, C_KW = 1024, C_VW = 1152, C_GL = 1280, C_CH = 1304, C_CB = 1816, C_CC = 2328;
constexpr int NC = 127, NCR = NB * NC * 2;
constexpr int NE = 32, TOPK = 4, DFF = 1024, NA = T * TOPK;
constexpr int MT = 64;
constexpr int PMAX = NA + NE * MT, NTILE = PMAX / MT;
constexpr int LDS_BYTES = 144 * 1024, VB_LDS = 40960;

__device__ __forceinline__ float wave_sum(float v) { for (int o = 32; o > 0; o >>= 1) v += __shfl_xor(v, o); return v; }
__device__ __forceinline__ float wave_max(float v) { for (int o = 32; o > 0; o >>= 1) v = fmaxf(v, __shfl_xor(v, o)); return v; }

struct VB { int vb, nvb, tid; char* lds; };
#define VB_ITEMS(n) for (int _it = 0, item = v.vb; _it < ((n) + v.nvb - 1) / v.nvb; ++_it, item += v.nvb)

__device__ __forceinline__ void p_rmsnorm(const VB& v, int rows, const float* __restrict__ in, int ldi, const float* __restrict__ g, float* __restrict__ out, int ldo, int W) {
    float* red = (float*)v.lds;
    VB_ITEMS(rows) {
        const bool act = item < rows;
        const float* r = in + (size_t)(act ? item : 0) * ldi;
        float ss = 0.f;
        for (int i = v.tid; i < W; i += 256) { float x = r[i]; ss += x * x; }
        ss = wave_sum(ss);
        __syncthreads();
        if ((v.tid & 63) == 0) red[v.tid >> 6] = ss;
        __syncthreads();
        ss = red[0] + red[1] + red[2] + red[3];
        const float rs = rsqrtf(ss / (float)W + 1e-5f);
        if (act) { float* o = out + (size_t)item * ldo; for (int i = v.tid; i < W; i += 256) o[i] = r[i] * rs * g[i]; }
    }
}

template <int NACC, class AL, class BL>
__device__ __forceinline__ void gemm_tile_f32(int tid, float (&acc)[NACC][4][4], int K, AL al, BL bl, float (*As)[68], float (*Bs)[NACC * 64 + 4]) {
    const int tx = tid & 15, ty = tid >> 4;
    const int ar = tid >> 2, ak = (tid & 3) * 4;
    const int bk = tid >> 4, bc = (tid & 15) * 4;
#pragma unroll
    for (int w = 0; w < NACC; ++w)
#pragma unroll
        for (int i = 0; i < 4; ++i)
#pragma unroll
            for (int j = 0; j < 4; ++j) acc[w][i][j] = 0.f;
    for (int k0 = 0; k0 < K; k0 += 16) {
        const float4 a = al(ar, k0 + ak);
        float4 b[NACC];
#pragma unroll
        for (int w = 0; w < NACC; ++w) b[w] = bl(w, k0 + bk, bc);
        __syncthreads();
        As[ak + 0][ar] = a.x; As[ak + 1][ar] = a.y; As[ak + 2][ar] = a.z; As[ak + 3][ar] = a.w;
#pragma unroll
        for (int w = 0; w < NACC; ++w) *(float4*)&Bs[bk][w * 64 + bc] = b[w];
        __syncthreads();
#pragma unroll
        for (int kk = 0; kk < 16; ++kk) {
            const float4 av = *(const float4*)&As[kk][ty * 4];
            const float aa[4] = {av.x, av.y, av.z, av.w};
#pragma unroll
            for (int w = 0; w < NACC; ++w) {
                const float4 bv = *(const float4*)&Bs[kk][w * 64 + tx * 4];
                const float bb[4] = {bv.x, bv.y, bv.z, bv.w};
#pragma unroll
                for (int i = 0; i < 4; ++i)
#pragma unroll
                    for (int j = 0; j < 4; ++j) acc[w][i][j] += aa[i] * bb[j];
            }
        }
    }
}

__device__ __forceinline__ void p_gemm(const VB& v, const float* __restrict__ A, int lda, const float* __restrict__ Bm, int ldb, float* C, int ldc, const float* res, int M, int N, int K) {
    float (*As)[68] = (float (*)[68])v.lds;
    float (*Bs)[68] = (float (*)[68])(v.lds + 16 * 68 * 4);
    const int nx = (N + 63) / 64, ny = (M + 63) / 64, nt = nx * ny;
    VB_ITEMS(nt) {
        const bool act = item < nt;
        const int row0 = act ? (item / nx) * 64 : M, col0 = act ? (item % nx) * 64 : N;
        float acc[1][4][4];
        auto al = [&](int r, int k) -> float4 { const int row = row0 + r; return row < M ? *(const float4*)(A + (size_t)row * lda + k) : make_float4(0.f, 0.f, 0.f, 0.f); };
        auto bl = [&](int, int k, int c) -> float4 { const int col = col0 + c; return col < N ? *(const float4*)(Bm + (size_t)k * ldb + col) : make_float4(0.f, 0.f, 0.f, 0.f); };
        gemm_tile_f32<1>(v.tid, acc, K, al, bl, As, Bs);
        const int tx = v.tid & 15, ty = v.tid >> 4;
#pragma unroll
        for (int i = 0; i < 4; ++i) {
            const int row = row0 + ty * 4 + i;
            if (row >= M) continue;
#pragma unroll
            for (int j = 0; j < 4; ++j) {
                const int col = col0 + tx * 4 + j;
                if (col >= N) continue;
                float x = acc[0][i][j];
                if (res) x += res[(size_t)row * ldc + col];
                C[(size_t)row * ldc + col] = x;
            }
        }
    }
}

__device__ __forceinline__ void p_rope(const VB& v, float* __restrict__ proj, const int* __restrict__ pos) {
    VB_ITEMS(T) {
        if (item >= T) continue;
        const int t = item;
        const float p = (float)pos[t];
        float* r = proj + (size_t)t * INC;
        for (int i = v.tid; i < 448; i += 256) {
            const int hd = i >> 5, f = i & 31;
            int col;
            if (hd < 8) col = C_Q + hd * 64; else if (hd < 10) col = C_KC + (hd - 8) * 64; else if (hd < 12) col = C_KS + (hd - 10) * 64; else col = C_KW + (hd - 12) * 64;
            const float inv = powf(10000.f, -(float)f / 32.f);
            const float ang = p * inv;
            const float c = cosf(ang), s = sinf(ang);
            const float t1 = r[col + f], t2 = r[col + 32 + f];
            r[col + f] = t1 * c - t2 * s;
            r[col + 32 + f] = t2 * c + t1 * s;
        }
    }
}

__device__ __forceinline__ float gelu_tanh(float x) { const float u = 0.7978845608028654f * (x + 0.044715f * x * x * x); return 0.5f * x * (1.f + tanhf(u)); }
__device__ __forceinline__ void p_cmp1(const VB& v, const float* __restrict__ proj, int colbase, const float* __restrict__ pos, const float* __restrict__ w1, const float* __restrict__ b1, float* __restrict__ hid) {
    float (*As)[68] = (float (*)[68])v.lds;
    float (*Bs)[68] = (float (*)[68])(v.lds + 16 * 68 * 4);
    const int nx = 4, ny = (NCR + 63) / 64, nt = nx * ny;
    VB_ITEMS(nt) {
        const bool act = item < nt;
        const int row0 = act ? (item / nx) * 64 : NCR, col0 = act ? (item % nx) * 64 : 0;
        float acc[1][4][4];
        auto al = [&](int r, int k) -> float4 {
            const int row = row0 + r; if (row >= NCR) return make_float4(0.f, 0.f, 0.f, 0.f);
            const int g = row & 1, bc = row >> 1, c = bc % NC, b = bc / NC, l = k >> 6, d = k & 63;
            const float4 x = *(const float4*)(proj + (size_t)(b * S + 16 * c + l) * INC + colbase + g * 64 + d);
            const float4 pe = *(const float4*)(pos + k);
            return make_float4(x.x + pe.x, x.y + pe.y, x.z + pe.z, x.w + pe.w);
        };
        auto bl = [&](int, int k, int c) -> float4 { return *(const float4*)(w1 + (size_t)k * 256 + col0 + c); };
        gemm_tile_f32<1>(v.tid, acc, 2048, al, bl, As, Bs);
        const int tx = v.tid & 15, ty = v.tid >> 4;
#pragma unroll
        for (int i = 0; i < 4; ++i) {
            const int row = row0 + ty * 4 + i;
            if (row >= NCR) continue;
#pragma unroll
            for (int j = 0; j < 4; ++j) { const int col = col0 + tx * 4 + j; hid[(size_t)row * 256 + col] = gelu_tanh(acc[0][i][j] + b1[col]); }
        }
    }
}

template <int DH, class KeyF>
__device__ __forceinline__ void wave_attend(const float* q, int ncand, KeyF keyf, float* sc, float* out, int lane) {
    float m = -3.0e38f;
    for (int idx = lane; idx < ncand; idx += 64) {
        const float *kp, *vp;
        float s = -3.0e38f;
        if (keyf(idx, kp, vp)) {
            s = 0.f;
#pragma unroll 4
            for (int d = 0; d < DH; d += 4) { const float4 kv = *(const float4*)(kp + d); s += q[d] * kv.x + q[d + 1] * kv.y + q[d + 2] * kv.z + q[d + 3] * kv.w; }
        }
        sc[idx] = s;
        m = fmaxf(m, s);
    }
    m = wave_max(m);
    float sum = 0.f;
    for (int idx = lane; idx < ncand; idx += 64) { const float s = sc[idx]; const float p = (s > -1.0e38f) ? __expf(s - m) : 0.f; sc[idx] = p; sum += p; }
    sum = wave_sum(sum);
    const float inv = (m > -1.0e38f) ? 1.f / sum : 0.f;
    for (int idx = lane; idx < ncand; idx += 64) sc[idx] *= inv;
    __builtin_amdgcn_s_waitcnt(0);
    float o[DH / 64];
#pragma unroll
    for (int i = 0; i < DH / 64; ++i) o[i] = 0.f;
    for (int idx = 0; idx < ncand; ++idx) {
        const float p = sc[idx];
        if (p == 0.f) continue;
        const float *kp, *vp;
        keyf(idx, kp, vp);
#pragma unroll
        for (int i = 0; i < DH / 64; ++i) o[i] += p * vp[lane + 64 * i];
    }
#pragma unroll
    for (int i = 0; i < DH / 64; ++i) out[lane + 64 * i] = o[i];
}

__device__ __forceinline__ void p_cmp_attn(const VB& v, const float* __restrict__ proj, const float* __restrict__ kc, const float* __restrict__ vc,
                                           float* __restrict__ o_cmp, unsigned* __restrict__ selmask) {
    float (*qs)[64] = (float (*)[64])v.lds;
    float (*ps)[128] = (float (*)[128])(v.lds + 1024);
    float* imps = (float*)(v.lds + 1024 + 2048);
    VB_ITEMS(T * 2) {
        const int g = item & 1, t = item >> 1, b = t / S, s = t % S;
        const int w = v.tid >> 6, lane = v.tid & 63, h = g * 4 + w;
        __syncthreads();
        qs[w][lane] = proj[(size_t)t * INC + C_Q + h * 64 + lane] * 0.125f;
        ps[w][lane] = 0.f; ps[w][lane + 64] = 0.f;
        __syncthreads();
        auto keyf = [&](int c, const float*& kp, const float*& vp) -> bool {
            kp = kc + (size_t)((b * NC + c) * 2 + g) * 64; vp = vc + (size_t)((b * NC + c) * 2 + g) * 64;
            return 16 * c + 31 <= s;
        };
        wave_attend<64>(qs[w], NC, keyf, ps[w], o_cmp + (size_t)t * 512 + h * 64, lane);
        __syncthreads();
        if (v.tid < 32) {
            const int j = v.tid;
            float imp = 0.f;
            for (int hh = 0; hh < 4; ++hh)
                for (int c = 4 * j - 1; c <= 4 * j + 3; ++c) {
                    if (c < 0 || c >= NC) continue;
                    const float ov = (c == 4 * j - 1 || c == 4 * j + 3) ? 0.5f : 1.0f;
                    imp += ps[hh][c] * ov;
                }
            const int cur = s >> 6;
            if (j == 0 || j == cur || j == cur - 1) imp = 1e30f; else if (j > cur) imp = -1e30f;
            imps[j] = imp;
        }
        __syncthreads();
        if (v.tid < 64) {
            const int j = v.tid & 31;
            const float mine = imps[j];
            int rank = 0;
            for (int i = 0; i < 32; ++i) { const float x = imps[i]; rank += (x > mine || (x == mine && i < j)) ? 1 : 0; }
            const unsigned long long bal = __ballot(rank < 16 && v.tid < 32);
            if (v.tid == 0) selmask[(size_t)(b * 2 + g) * S + s] = (unsigned)(bal & 0xffffffffull);
        }
    }
}

template <int MODE>
__device__ __forceinline__ void p_nsa_attn(const VB& v, const float* __restrict__ proj, const unsigned* __restrict__ selmask, float* __restrict__ outp) {
    float (*qs)[64] = (float (*)[64])v.lds;
    float (*scs)[2048] = (float (*)[2048])(v.lds + 1024);
    VB_ITEMS(T * 2) {
        const int g = item & 1, t = item >> 1, b = t / S, s = t % S;
        const int w = v.tid >> 6, lane = v.tid & 63, h = g * 4 + w;
        qs[w][lane] = proj[(size_t)t * INC + C_Q + h * 64 + lane] * 0.125f;
        __builtin_amdgcn_s_waitcnt(0);
        if (MODE == 0) {
            const unsigned mask = selmask[(size_t)(b * 2 + g) * S + s];
            const int ncand = ((s >> 6) + 1) * 64;
            auto keyf = [&](int idx, const float*& kp, const float*& vp) -> bool {
                const float* r = proj + (size_t)(b * S + idx) * INC + g * 64;
                kp = r + C_KS; vp = r + C_VS;
                return idx <= s && ((mask >> (idx >> 6)) & 1u);
            };
            wave_attend<64>(qs[w], ncand, keyf, scs[w], outp + (size_t)t * 512 + h * 64, lane);
        } else {
            const int lo = s - 511 > 0 ? s - 511 : 0;
            const int ncand = s - lo + 1;
            auto keyf = [&](int idx, const float*& kp, const float*& vp) -> bool {
                const float* r = proj + (size_t)(b * S + lo + idx) * INC + g * 64;
                kp = r + C_KW; vp = r + C_VW;
                return true;
            };
            wave_attend<64>(qs[w], ncand, keyf, scs[w], outp + (size_t)t * 512 + h * 64, lane);
        }
    }
}

__device__ __forceinline__ void p_xattn(const VB& v, const float* __restrict__ xq, const float* __restrict__ xkv, float* __restrict__ xo) {
    float (*qs)[256] = (float (*)[256])v.lds;
    float (*scs)[256] = (float (*)[256])(v.lds + 4096);
    VB_ITEMS(T) {
        const int t = item, b = t / S, w = v.tid >> 6, lane = v.tid & 63;
        for (int i = lane; i < 256; i += 64) qs[w][i] = xq[(size_t)t * D + w * 256 + i] * 0.0625f;
        __builtin_amdgcn_s_waitcnt(0);
        auto keyf = [&](int m, const float*& kp, const float*& vp) -> bool {
            const float* r = xkv + (size_t)(b * NMEM + m) * 2048 + w * 256;
            kp = r; vp = r + 1024;
            return true;
        };
        wave_attend<256>(qs[w], NMEM, keyf, scs[w], xo + (size_t)t * D + w * 256, lane);
    }
}

__device__ __forceinline__ void p_mix_post(const VB& v, const float* __restrict__ proj, const float* __restrict__ o_cmp, const float* __restrict__ o_slc, const float* __restrict__ o_win,
                                           const float* __restrict__ conv_w, const float* __restrict__ g_nsa, const float* __restrict__ g_conv, float* __restrict__ omix) {
    float (*red)[4] = (float (*)[4])v.lds;
    VB_ITEMS(T) {
        const int t = item, s = t % S, tid = v.tid;
        const float* r = proj + (size_t)t * INC;
        float on[2], oc[2], ssn = 0.f, ssc = 0.f;
#pragma unroll
        for (int e = 0; e < 2; ++e) {
            const int c = tid + 256 * e, h = c >> 6;
            const float g0 = 1.f / (1.f + __expf(-r[C_GL + h * 3 + 0])), g1 = 1.f / (1.f + __expf(-r[C_GL + h * 3 + 1])), g2 = 1.f / (1.f + __expf(-r[C_GL + h * 3 + 2]));
            on[e] = g0 * o_cmp[(size_t)t * 512 + c] + g1 * o_slc[(size_t)t * 512 + c] + g2 * o_win[(size_t)t * 512 + c];
            ssn += on[e] * on[e];
            float y = 0.f;
#pragma unroll
            for (int k = 0; k < 3; ++k) {
                const int sp = s - 2 + k;
                if (sp < 0) continue;
                const float* rp = proj + (size_t)(t - 2 + k) * INC;
                y += conv_w[k * 512 + c] * (rp[C_CC + c] * rp[C_CH + c]);
            }
            oc[e] = r[C_CB + c] * y;
            ssc += oc[e] * oc[e];
        }
        ssn = wave_sum(ssn); ssc = wave_sum(ssc);
        __syncthreads();
        if ((tid & 63) == 0) { red[0][tid >> 6] = ssn; red[1][tid >> 6] = ssc; }
        __syncthreads();
        ssn = red[0][0] + red[0][1] + red[0][2] + red[0][3];
        ssc = red[1][0] + red[1][1] + red[1][2] + red[1][3];
        const float rn = rsqrtf(ssn / 512.f + 1e-5f), rc = rsqrtf(ssc / 512.f + 1e-5f);
#pragma unroll
        for (int e = 0; e < 2; ++e) {
            const int c = tid + 256 * e;
            omix[(size_t)t * D + c] = on[e] * rn * g_nsa[c];
            omix[(size_t)t * D + 512 + c] = oc[e] * rc * g_conv[c];
        }
    }
}

__device__ __forceinline__ void p_router(const VB& v, const float* __restrict__ xn, const float* __restrict__ wr, const float* __restrict__ br,
                                         int* __restrict__ a_e, float* __restrict__ a_w, int* __restrict__ a_slot, int* __restrict__ counts) {
    VB_ITEMS(T / 4) {
        const int t = item * 4 + (v.tid >> 6), lane = v.tid & 63, e = lane & 31, half = lane >> 5;
        const float* x = xn + (size_t)t * D + half * 512;
        const float* w = wr + (size_t)half * 512 * NE + e;
        float acc = 0.f;
        for (int k = 0; k < 512; ++k) acc += x[k] * w[(size_t)k * NE];
        acc += __shfl_xor(acc, 32);
        const float logit = acc + br[e];
        int rank = 0;
        for (int i = 0; i < 32; ++i) { const float x2 = __shfl(logit, i); rank += (x2 > logit || (x2 == logit && i < e)) ? 1 : 0; }
        const float vmax = wave_max(logit);
        const bool sel = (rank < TOPK) && (lane < 32);
        const float ex = sel ? __expf(logit - vmax) : 0.f;
        const float sum = wave_sum(ex);
        if (sel) {
            const int a = t * TOPK + rank;
            a_e[a] = e; a_w[a] = ex / sum; a_slot[a] = atomicAdd(&counts[e], 1);
        }
    }
}
__device__ __forceinline__ void p_moe_offsets(const VB& v, const int* __restrict__ counts, int* __restrict__ pstart, int* __restrict__ tile_e, int* __restrict__ tok_buf, float* __restrict__ w_buf) {
    int* ps = (int*)v.lds;
    __syncthreads();
    if (v.tid == 0) { int acc = 0; for (int e = 0; e < NE; ++e) { ps[e] = acc; if (v.vb == 0) pstart[e] = acc; acc += (counts[e] + MT - 1) / MT * MT; } ps[NE] = acc; }
    __syncthreads();
    for (int tl = v.vb * 256 + v.tid; tl < NTILE; tl += v.nvb * 256) {
        const int r = tl * MT; int e = -1;
        for (int i = 0; i < NE; ++i) if (r >= ps[i] && r < ps[i + 1]) e = i;
        tile_e[tl] = e;
    }
    for (int i = v.vb * 256 + v.tid; i < PMAX; i += v.nvb * 256) { tok_buf[i] = 0; w_buf[i] = 0.f; }
}
__device__ __forceinline__ void p_moe_scatter(const VB& v, const int* __restrict__ a_e, const float* __restrict__ a_w, const int* __restrict__ a_slot, const int* __restrict__ pstart,
                                              int* __restrict__ tok_buf, float* __restrict__ w_buf, int* __restrict__ dest_of) {
    for (int a = v.vb * 256 + v.tid; a < NA; a += v.nvb * 256) {
        const int dest = pstart[a_e[a]] + a_slot[a];
        tok_buf[dest] = a / TOPK; w_buf[dest] = a_w[a]; dest_of[a] = dest;
    }
}
__device__ __forceinline__ void p_moe1(const VB& v, const float* __restrict__ xn, const int* __restrict__ tok_buf, const int* __restrict__ tile_e,
                                       const float* __restrict__ wgu, const float* __restrict__ bgu, __hip_bfloat16* __restrict__ hmid) {
    float (*As)[68] = (float (*)[68])v.lds;
    float (*Bs)[132] = (float (*)[132])(v.lds + 16 * 68 * 4);
    int* toks = (int*)(v.lds + 16 * 68 * 4 + 16 * 132 * 4);
    const int nt = 16 * NTILE;
    VB_ITEMS(nt) {
        const int tl = item < nt ? item / 16 : 0, cx = item % 16;
        const int e0 = item < nt ? tile_e[tl] : -1;
        const bool act = e0 >= 0;
        const int e = act ? e0 : 0;
        const int row0 = tl * MT, col0 = cx * 64;
        __syncthreads();
        if (v.tid < MT) toks[v.tid] = act ? tok_buf[row0 + v.tid] : 0;
        __syncthreads();
        const float* W = wgu + (size_t)e * D * 2048;
        float acc[2][4][4];
        auto al = [&](int r, int k) -> float4 { return *(const float4*)(xn + (size_t)toks[r] * D + k); };
        auto bl = [&](int w, int k, int c) -> float4 { return *(const float4*)(W + (size_t)k * 2048 + w * 1024 + col0 + c); };
        gemm_tile_f32<2>(v.tid, acc, D, al, bl, As, Bs);
        if (!act) continue;
        const int tx = v.tid & 15, ty = v.tid >> 4;
#pragma unroll
        for (int i = 0; i < 4; ++i)
#pragma unroll
            for (int j = 0; j < 4; ++j) {
                const int row = row0 + ty * 4 + i, col = col0 + tx * 4 + j;
                float g = acc[0][i][j] + bgu[(size_t)e * 2048 + col], u = acc[1][i][j] + bgu[(size_t)e * 2048 + 1024 + col];
                g = fminf(g, 7.f); u = fminf(fmaxf(u, -7.f), 7.f);
                const float hm = (u + 1.f) * (g / (1.f + __expf(-1.702f * g)));
                hmid[(size_t)row * DFF + col] = __float2bfloat16(hm);
            }
    }
}
__device__ __forceinline__ void p_moe2(const VB& v, const __hip_bfloat16* __restrict__ hmid, const int* __restrict__ tile_e, const float* __restrict__ w_buf,
                                       const float* __restrict__ wd, const float* __restrict__ bd, __hip_bfloat16* __restrict__ out_a) {
    float (*As)[68] = (float (*)[68])v.lds;
    float (*Bs)[68] = (float (*)[68])(v.lds + 16 * 68 * 4);
    const int nt = 16 * NTILE;
    VB_ITEMS(nt) {
        const int tl = item < nt ? item / 16 : 0, cx = item % 16;
        const int e0 = item < nt ? tile_e[tl] : -1;
        const bool act = e0 >= 0;
        const int e = act ? e0 : 0;
        const int row0 = tl * MT, col0 = cx * 64;
        const float* W = wd + (size_t)e * DFF * D;
        float acc[1][4][4];
        auto al = [&](int r, int k) -> float4 {
            if (!act) return make_float4(0.f, 0.f, 0.f, 0.f);
            const __hip_bfloat16* p = hmid + (size_t)(row0 + r) * DFF + k;
            return make_float4(__bfloat162float(p[0]), __bfloat162float(p[1]), __bfloat162float(p[2]), __bfloat162float(p[3]));
        };
        auto bl = [&](int, int k, int c) -> float4 { return *(const float4*)(W + (size_t)k * D + col0 + c); };
        gemm_tile_f32<1>(v.tid, acc, DFF, al, bl, As, Bs);
        if (!act) continue;
        const int tx = v.tid & 15, ty = v.tid >> 4;
#pragma unroll
        for (int i = 0; i < 4; ++i)
#pragma unroll
            for (int j = 0; j < 4; ++j) {
                const int row = row0 + ty * 4 + i, col = col0 + tx * 4 + j;
                out_a[(size_t)row * D + col] = __float2bfloat16((acc[0][i][j] + bd[(size_t)e * D + col]) * w_buf[row]);
            }
    }
}
__device__ __forceinline__ void p_final(const VB& v, const float* __restrict__ h2, const __hip_bfloat16* __restrict__ out_a, const int* __restrict__ dest_of,
                                        const float* __restrict__ g, float* __restrict__ out) {
    float* red = (float*)v.lds;
    VB_ITEMS(T) {
        const int t = item, tid = v.tid;
        int d[4];
#pragma unroll
        for (int k = 0; k < 4; ++k) d[k] = dest_of[t * 4 + k];
        float x4[4], ss = 0.f;
#pragma unroll
        for (int e = 0; e < 4; ++e) {
            const int c = tid + 256 * e;
            float x = h2[(size_t)t * D + c];
#pragma unroll
            for (int k = 0; k < 4; ++k) x += __bfloat162float(out_a[(size_t)d[k] * D + c]);
            x4[e] = x; ss += x * x;
        }
        ss = wave_sum(ss);
        __syncthreads();
        if ((tid & 63) == 0) red[tid >> 6] = ss;
        __syncthreads();
        ss = red[0] + red[1] + red[2] + red[3];
        const float rs = rsqrtf(ss / (float)D + 1e-5f);
#pragma unroll
        for (int e = 0; e < 4; ++e) { const int c = tid + 256 * e; out[(size_t)t * D + c] = x4[e] * rs * g[c]; }
    }
}

struct Params {
    const float *x, *mem; const int* positions;
    const float *g_mix_norm, *w_mix_in, *cmp_pos_k, *cmp_pos_v, *cmp_w1_k, *cmp_b1_k, *cmp_w2_k, *cmp_w1_v, *cmp_b1_v, *cmp_w2_v, *conv_w, *g_nsa_out, *g_conv_out, *w_mix_out,
        *g_xattn_norm, *g_mem_norm, *w_xq, *w_xkv, *w_xo, *g_moe_norm, *w_router, *b_router, *w_gate_up, *b_gate_up, *w_down, *b_down, *g_final;
    float* out;
    unsigned* bar;
    int *counts, *pstart, *tile_e, *a_e, *a_slot, *dest_of, *tok_buf;
    float *a_w, *w_buf;
    unsigned* selmask;
    float *hid_k, *hid_v, *kc, *vc, *memn, *xkv, *hbuf, *xn, *o_cmp, *o_slc, *o_win, *xq, *proj, *xo;
    __hip_bfloat16 *hmid, *out_a;
};

__global__ void __launch_bounds__(512, 2) mega_fwd(Params p) {
    extern __shared__ __attribute__((aligned(16))) char lds[];
    if (threadIdx.x < 4) ((unsigned*)lds)[threadIdx.x] = 0u;
    __syncthreads();
    XcdBarrier bar = xcd_barrier_post(p.bar, (volatile LAS unsigned*)lds);
    VB v; v.vb = blockIdx.x * 2 + (threadIdx.x >> 8); v.nvb = gridDim.x * 2; v.tid = threadIdx.x & 255; v.lds = lds + 64 + (threadIdx.x >> 8) * VB_LDS;

    p_rmsnorm(v, T, p.x, D, p.g_mix_norm, p.xn, D, D);
    p_rmsnorm(v, NB * NMEM, p.mem, D, p.g_mem_norm, p.memn, D, D);
    xcd_barrier(bar);
    p_gemm(v, p.xn, D, p.w_mix_in, INC, p.proj, INC, nullptr, T, INC, D);
    p_gemm(v, p.memn, D, p.w_xkv, 2048, p.xkv, 2048, nullptr, NB * NMEM, 2048, D);
    xcd_barrier(bar);
    p_rope(v, p.proj, p.positions);
    xcd_barrier(bar);
    p_cmp1(v, p.proj, C_KC, p.cmp_pos_k, p.cmp_w1_k, p.cmp_b1_k, p.hid_k);
    p_cmp1(v, p.proj, C_VC, p.cmp_pos_v, p.cmp_w1_v, p.cmp_b1_v, p.hid_v);
    p_nsa_attn<1>(v, p.proj, p.selmask, p.o_win);
    xcd_barrier(bar);
    p_gemm(v, p.hid_k, 256, p.cmp_w2_k, 64, p.kc, 64, nullptr, NCR, 64, 256);
    p_gemm(v, p.hid_v, 256, p.cmp_w2_v, 64, p.vc, 64, nullptr, NCR, 64, 256);
    xcd_barrier(bar);
    p_cmp_attn(v, p.proj, p.kc, p.vc, p.o_cmp, p.selmask);
    xcd_barrier(bar);
    p_nsa_attn<0>(v, p.proj, p.selmask, p.o_slc);
    xcd_barrier(bar);
    p_mix_post(v, p.proj, p.o_cmp, p.o_slc, p.o_win, p.conv_w, p.g_nsa_out, p.g_conv_out, p.xn  );
    xcd_barrier(bar);
    p_gemm(v, p.xn, D, p.w_mix_out, D, p.hbuf, D, p.x, T, D, D);
    xcd_barrier(bar);
    p_rmsnorm(v, T, p.hbuf, D, p.g_xattn_norm, p.xn, D, D);
    xcd_barrier(bar);
    p_gemm(v, p.xn, D, p.w_xq, D, p.xq, D, nullptr, T, D, D);
    xcd_barrier(bar);
    p_xattn(v, p.xq, p.xkv, p.xo);
    xcd_barrier(bar);
    p_gemm(v, p.xo, D, p.w_xo, D, p.hbuf, D, p.hbuf, T, D, D);
    xcd_barrier(bar);
    p_rmsnorm(v, T, p.hbuf, D, p.g_moe_norm, p.xn, D, D);
    xcd_barrier(bar);
    p_router(v, p.xn, p.w_router, p.b_router, p.a_e, p.a_w, p.a_slot, p.counts);
    xcd_barrier(bar);
    p_moe_offsets(v, p.counts, p.pstart, p.tile_e, p.tok_buf, p.w_buf);
    xcd_barrier(bar);
    p_moe_scatter(v, p.a_e, p.a_w, p.a_slot, p.pstart, p.tok_buf, p.w_buf, p.dest_of);
    xcd_barrier(bar);
    p_moe1(v, p.xn, p.tok_buf, p.tile_e, p.w_gate_up, p.b_gate_up, p.hmid);
    xcd_barrier(bar);
    p_moe2(v, p.hmid, p.tile_e, p.w_buf, p.w_down, p.b_down, p.out_a);
    xcd_barrier(bar);
    p_final(v, p.hbuf, p.out_a, p.dest_of, p.g_final, p.out);
}
__global__ void k_fail(float* out, int n) { const int i = blockIdx.x * 256 + threadIdx.x; if (i < n) out[i] = __builtin_nanf(""); }
}

extern "C" void kernel_launch(void* const* d_in, const int* in_sizes, int n_in, void* d_out, int out_size, void* d_ws, size_t ws_size, hipStream_t stream) {
    Params p{};
    p.x = (const float*)d_in[0]; p.mem = (const float*)d_in[1]; p.positions = (const int*)d_in[2];
    const float** fp = &p.g_mix_norm;
    for (int i = 0; i < 27; ++i) fp[i] = (const float*)d_in[3 + i];
    p.out = (float*)d_out;

    char* ws = (char*)d_ws;
    size_t off = 0;
    auto take = [&](size_t bytes) { char* q = ws + off; off += (bytes + 255) & ~(size_t)255; return q; };
    p.bar = (unsigned*)take(XCD_BAR_WORDS * 4);
    p.counts = (int*)take(NE * 4);
    const size_t zero_bytes = off;
    p.pstart = (int*)take(NE * 4);
    p.tile_e = (int*)take(NTILE * 4);
    p.a_e = (int*)take(NA * 4);
    p.a_w = (float*)take(NA * 4);
    p.a_slot = (int*)take(NA * 4);
    p.dest_of = (int*)take(NA * 4);
    p.tok_buf = (int*)take(PMAX * 4);
    p.w_buf = (float*)take(PMAX * 4);
    p.selmask = (unsigned*)take((size_t)NB * 2 * S * 4);
    p.hid_k = (float*)take((size_t)NCR * 256 * 4);
    p.hid_v = (float*)take((size_t)NCR * 256 * 4);
    p.kc = (float*)take((size_t)NCR * 64 * 4);
    p.vc = (float*)take((size_t)NCR * 64 * 4);
    p.memn = (float*)take((size_t)NB * NMEM * D * 4);
    p.xkv = (float*)take((size_t)NB * NMEM * 2048 * 4);
    p.hbuf = (float*)take((size_t)T * D * 4);
    char* r14 = take((size_t)T * D * 4 + (size_t)3 * T * 512 * 4);
    p.xn = (float*)r14;
    p.o_cmp = (float*)(r14 + (size_t)T * D * 4);
    p.o_slc = p.o_cmp + (size_t)T * 512;
    p.o_win = p.o_slc + (size_t)T * 512;
    p.xq = p.o_cmp;
    p.proj = (float*)take((size_t)T * INC * 4);
    p.xo = p.proj;
    p.hmid = (__hip_bfloat16*)p.proj;
    p.out_a = (__hip_bfloat16*)r14;

    static int grid = 0;
    if (grid == 0) {
        int dev = 0, cus = 0;
        if (hipGetDevice(&dev) != hipSuccess || hipDeviceGetAttribute(&cus, hipDeviceAttributeMultiprocessorCount, dev) != hipSuccess) cus = -1;
        if (hipFuncSetAttribute((const void*)mega_fwd, hipFuncAttributeMaxDynamicSharedMemorySize, LDS_BYTES) != hipSuccess) cus = -1;
        int per_cu = 0;
        if (cus > 0 && (hipOccupancyMaxActiveBlocksPerMultiprocessor(&per_cu, (const void*)mega_fwd, 512, LDS_BYTES) != hipSuccess || per_cu < 1)) cus = -1;
        (void)hipGetLastError();
        grid = cus > 0 ? cus : -1;
    }
    if (grid < 0 || off > ws_size) { k_fail<<<(out_size + 255) / 256, 256, 0, stream>>>((float*)d_out, out_size); return; }
    (void)hipMemsetAsync(d_ws, 0, zero_bytes, stream);
    hipLaunchKernelGGL(mega_fwd, dim3(grid), dim3(512), LDS_BYTES, stream, p);
}
```

```cpp
#include <hip/hip_runtime.h>
#include <hip/hip_bf16.h>
#include <stdint.h>
#include <cstdio>

#define XB_TMO      128
#define XB_XCNT(j)  (256  + 64 * (j))
#define XB_XSUB(j)  (1280 + 64 * (j))
#define XB_XGEN(j)  (2304 + 64 * (j))
#define XB_TOP      3328
#define XB_TOPGEN   3392
#define XCD_BAR_WORDS 3456
#define XB_SPIN_CAP (1u << 18)
#define LAS __attribute__((address_space(3)))

__device__ __forceinline__ unsigned xb_ld(unsigned* p)              { return __hip_atomic_load(p, __ATOMIC_RELAXED, __HIP_MEMORY_SCOPE_AGENT); }
__device__ __forceinline__ unsigned xb_add(unsigned* p, unsigned v) { return __hip_atomic_fetch_add(p, v, __ATOMIC_RELAXED, __HIP_MEMORY_SCOPE_AGENT); }
__device__ __forceinline__ unsigned xb_xcc_id() { return (unsigned)__builtin_amdgcn_s_getreg((3 << 11) | 20) & 0xFu; }
#define XB_SPIN(cond, bar) do { unsigned _sp = 0; while (cond) { __builtin_amdgcn_s_sleep(1); \
    if ((++_sp & 255u) == 0u) { if (xb_ld(&(bar)[XB_TMO])) break; if (_sp > XB_SPIN_CAP) { atomicAdd(&(bar)[XB_TMO], 1u); break; } } } } while (0)

struct XcdBarrier {
    unsigned* bar; unsigned x;
    volatile LAS unsigned* st;
};

__device__ __forceinline__ XcdBarrier xcd_barrier_post(unsigned* bar, volatile LAS unsigned* st) {
    XcdBarrier b; b.bar = bar; b.x = xb_xcc_id(); b.st = st;
    if (threadIdx.x == 0) (void)xb_add(&bar[XB_XCNT(b.x)], 1u);
    return b;
}
__device__ __forceinline__ void xcd_barrier_complete(unsigned* bar, unsigned x, unsigned& nloc, unsigned& nx) {
    const unsigned G = gridDim.x * gridDim.y * gridDim.z;
    unsigned sum, cnt, mine, sp = 0u;
    for (;;) {
        sum = 0u; cnt = 0u; mine = 0u;
#pragma unroll
        for (unsigned j = 0; j < 16; ++j) { const unsigned c = xb_ld(&bar[XB_XCNT(j)]); sum += c; cnt += (c > 0u) ? 1u : 0u; mine = (j == x) ? c : mine; }
        if (sum == G) break;
        __builtin_amdgcn_s_sleep(1);
        if ((++sp & 255u) == 0u) { if (xb_ld(&bar[XB_TMO])) break; if (sp > XB_SPIN_CAP) { atomicAdd(&bar[XB_TMO], 1u); break; } }
    }
    nloc = mine > 0u ? mine : 1u; nx = cnt > 0u ? cnt : 1u;
}

__device__ __forceinline__ void xcd_barrier(const XcdBarrier& b) {
    asm volatile("s_waitcnt vmcnt(0)" ::: "memory");
    __syncthreads();
    if (threadIdx.x == 0) {
        unsigned* bar = b.bar;
        __builtin_amdgcn_s_waitcnt(0);
        unsigned nloc = b.st[0], nx = b.st[1];
        if (nloc == 0u) { xcd_barrier_complete(bar, b.x, nloc, nx); b.st[0] = nloc; b.st[1] = nx; }
        const unsigned old = xb_add(&bar[XB_XSUB(b.x)], 1u);
        const unsigned gen = old / nloc;
        if (old + 1u == (gen + 1u) * nloc) {
            __builtin_amdgcn_fence(__ATOMIC_RELEASE, "agent");
            asm volatile("s_waitcnt vmcnt(0)" ::: "memory");
            const unsigned og = xb_add(&bar[XB_TOP], 1u);
            const unsigned tg = og / nx;
            if (og + 1u == (tg + 1u) * nx) xb_add(&bar[XB_TOPGEN], 1u);
            else XB_SPIN(xb_ld(&bar[XB_TOPGEN]) == tg, bar);
            __builtin_amdgcn_fence(__ATOMIC_ACQUIRE, "agent");
            xb_add(&bar[XB_XGEN(b.x)], 1u);
            asm volatile("s_waitcnt vmcnt(0)" ::: "memory");
        } else {
            XB_SPIN(xb_ld(&bar[XB_XGEN(b.x)]) == gen, bar);
            __builtin_amdgcn_fence(__ATOMIC_ACQUIRE, "agent");
            asm volatile("s_waitcnt vmcnt(0)" ::: "memory");
        }
    }
    __syncthreads();
}


namespace {
constexpr int D = 1024, NB = 8, S = 2048, T = NB * S, NMEM = 256;
constexpr int INC = 2840;
constexpr int C_Q = 0, C_KC = 512, C_VC = 640, C_KS = 768, C_VS = 896, C_KW = 1024, C_VW = 1152, C_GL = 1280, C_CH = 1304, C_CB = 1816, C_CC = 2328;
constexpr int NC = 127, NCR = NB * NC * 2;
constexpr int NE = 32, TOPK = 4, DFF = 1024, NA = T * TOPK;
constexpr int MT = 256;
constexpr int PMAX = NA + NE * MT, NTILE = PMAX / MT;
constexpr int LDS_BYTES = 144 * 1024, VB_LDS = 40960;
constexpr float QS = 0.125f * 1.4426950408889634f;

__device__ __forceinline__ float wave_sum(float v) { for (int o = 32; o > 0; o >>= 1) v += __shfl_xor(v, o); return v; }
__device__ __forceinline__ float wave_max(float v) { for (int o = 32; o > 0; o >>= 1) v = fmaxf(v, __shfl_xor(v, o)); return v; }

namespace pg { __device__ __forceinline__ unsigned cvt_pk_bf16(float lo, float hi); }
struct VB { int vb, nvb, tid; char* lds; };
#define VB_ITEMS(n) for (int _it = 0, item = v.vb; _it < ((n) + v.nvb - 1) / v.nvb; ++_it, item += v.nvb)

__device__ __forceinline__ void p_rmsnorm(const VB& v, int rows, const float* __restrict__ in, int ldi, const float* __restrict__ g, float* __restrict__ out, int ldo, int W) {
    float* red = (float*)v.lds;
    VB_ITEMS(rows) {
        const bool act = item < rows;
        const float* r = in + (size_t)(act ? item : 0) * ldi;
        float ss = 0.f;
        for (int i = v.tid; i < W; i += 256) { float x = r[i]; ss += x * x; }
        ss = wave_sum(ss);
        __syncthreads();
        if ((v.tid & 63) == 0) red[v.tid >> 6] = ss;
        __syncthreads();
        ss = red[0] + red[1] + red[2] + red[3];
        const float rs = rsqrtf(ss / (float)W + 1e-5f);
        if (act) { float* o = out + (size_t)item * ldo; for (int i = v.tid; i < W; i += 256) o[i] = r[i] * rs * g[i]; }
    }
}

__device__ __forceinline__ unsigned short f2bf_rne(float f) { unsigned u = __float_as_uint(f); u += 0x7FFFu + ((u >> 16) & 1u); return (unsigned short)(u >> 16); }
__device__ __forceinline__ void p_rmsnorm_bf(const VB& v, int rows, const float* __restrict__ in, int ldi, const float* __restrict__ g, unsigned short* __restrict__ out, int ldo, int W) {
    float* red = (float*)v.lds;
    VB_ITEMS(rows) {
        const bool act = item < rows;
        const float* r = in + (size_t)(act ? item : 0) * ldi;
        float ss = 0.f;
        for (int i = v.tid; i < W; i += 256) { float x = r[i]; ss += x * x; }
        ss = wave_sum(ss);
        __syncthreads();
        if ((v.tid & 63) == 0) red[v.tid >> 6] = ss;
        __syncthreads();
        ss = red[0] + red[1] + red[2] + red[3];
        const float rs = rsqrtf(ss / (float)W + 1e-5f);
        if (act) { unsigned short* o = out + (size_t)item * ldo; for (int i = v.tid; i < W; i += 256) o[i] = f2bf_rne(r[i] * rs * g[i]); }
    }
}

template <int NACC, class AL, class BL>
__device__ __forceinline__ void gemm_tile_f32(int tid, float (&acc)[NACC][4][4], int K, AL al, BL bl, float (*As)[68], float (*Bs)[NACC * 64 + 4]) {
    const int tx = tid & 15, ty = tid >> 4;
    const int ar = tid >> 2, ak = (tid & 3) * 4;
    const int bk = tid >> 4, bc = (tid & 15) * 4;
#pragma unroll
    for (int w = 0; w < NACC; ++w)
#pragma unroll
        for (int i = 0; i < 4; ++i)
#pragma unroll
            for (int j = 0; j < 4; ++j) acc[w][i][j] = 0.f;
    for (int k0 = 0; k0 < K; k0 += 16) {
        const float4 a = al(ar, k0 + ak);
        float4 b[NACC];
#pragma unroll
        for (int w = 0; w < NACC; ++w) b[w] = bl(w, k0 + bk, bc);
        __syncthreads();
        As[ak + 0][ar] = a.x; As[ak + 1][ar] = a.y; As[ak + 2][ar] = a.z; As[ak + 3][ar] = a.w;
#pragma unroll
        for (int w = 0; w < NACC; ++w) *(float4*)&Bs[bk][w * 64 + bc] = b[w];
        __syncthreads();
#pragma unroll
        for (int kk = 0; kk < 16; ++kk) {
            const float4 av = *(const float4*)&As[kk][ty * 4];
            const float aa[4] = {av.x, av.y, av.z, av.w};
#pragma unroll
            for (int w = 0; w < NACC; ++w) {
                const float4 bv = *(const float4*)&Bs[kk][w * 64 + tx * 4];
                const float bb[4] = {bv.x, bv.y, bv.z, bv.w};
#pragma unroll
                for (int i = 0; i < 4; ++i)
#pragma unroll
                    for (int j = 0; j < 4; ++j) acc[w][i][j] += aa[i] * bb[j];
            }
        }
    }
}

__device__ __forceinline__ void p_gemm(const VB& v, const float* __restrict__ A, int lda, const float* __restrict__ Bm, int ldb, float* C, int ldc, const float* res, int M, int N, int K) {
    float (*As)[68] = (float (*)[68])v.lds;
    float (*Bs)[68] = (float (*)[68])(v.lds + 16 * 68 * 4);
    const int nx = (N + 63) / 64, ny = (M + 63) / 64, nt = nx * ny;
    VB_ITEMS(nt) {
        const bool act = item < nt;
        const int row0 = act ? (item / nx) * 64 : M, col0 = act ? (item % nx) * 64 : N;
        float acc[1][4][4];
        auto al = [&](int r, int k) -> float4 { const int row = row0 + r; return row < M ? *(const float4*)(A + (size_t)row * lda + k) : make_float4(0.f, 0.f, 0.f, 0.f); };
        auto bl = [&](int, int k, int c) -> float4 { const int col = col0 + c; return col < N ? *(const float4*)(Bm + (size_t)k * ldb + col) : make_float4(0.f, 0.f, 0.f, 0.f); };
        gemm_tile_f32<1>(v.tid, acc, K, al, bl, As, Bs);
        const int tx = v.tid & 15, ty = v.tid >> 4;
#pragma unroll
        for (int i = 0; i < 4; ++i) {
            const int row = row0 + ty * 4 + i;
            if (row >= M) continue;
#pragma unroll
            for (int j = 0; j < 4; ++j) {
                const int col = col0 + tx * 4 + j;
                if (col >= N) continue;
                float x = acc[0][i][j];
                if (res) x += res[(size_t)row * ldc + col];
                C[(size_t)row * ldc + col] = x;
            }
        }
    }
}

__device__ __forceinline__ void p_rope(const VB& v, float* __restrict__ proj, const int* __restrict__ pos) {
    VB_ITEMS(T) {
        if (item >= T) continue;
        const int t = item;
        const float p = (float)pos[t];
        float* r = proj + (size_t)t * INC;
        for (int i = v.tid; i < 448; i += 256) {
            const int hd = i >> 5, f = i & 31;
            int col;
            if (hd < 8) col = C_Q + hd * 64; else if (hd < 10) col = C_KC + (hd - 8) * 64; else if (hd < 12) col = C_KS + (hd - 10) * 64; else col = C_KW + (hd - 12) * 64;
            const float inv = powf(10000.f, -(float)f / 32.f);
            const float ang = p * inv;
            const float c = cosf(ang), s = sinf(ang);
            const float t1 = r[col + f], t2 = r[col + 32 + f];
            r[col + f] = t1 * c - t2 * s;
            r[col + 32 + f] = t2 * c + t1 * s;
        }
    }
}

__device__ __forceinline__ float gelu_tanh(float x) { const float u = 0.7978845608028654f * (x + 0.044715f * x * x * x); return 0.5f * x * (1.f + tanhf(u)); }
__device__ __forceinline__ void p_cmp1(const VB& v, const float* __restrict__ proj, int colbase, const float* __restrict__ pos, const float* __restrict__ w1, const float* __restrict__ b1, float* __restrict__ hid) {
    float (*As)[68] = (float (*)[68])v.lds;
    float (*Bs)[68] = (float (*)[68])(v.lds + 16 * 68 * 4);
    const int nx = 4, ny = (NCR + 63) / 64, nt = nx * ny;
    VB_ITEMS(nt) {
        const bool act = item < nt;
        const int row0 = act ? (item / nx) * 64 : NCR, col0 = act ? (item % nx) * 64 : 0;
        float acc[1][4][4];
        auto al = [&](int r, int k) -> float4 {
            const int row = row0 + r; if (row >= NCR) return make_float4(0.f, 0.f, 0.f, 0.f);
            const int g = row & 1, bc = row >> 1, c = bc % NC, b = bc / NC, l = k >> 6, d = k & 63;
            const float4 x = *(const float4*)(proj + (size_t)(b * S + 16 * c + l) * INC + colbase + g * 64 + d);
            const float4 pe = *(const float4*)(pos + k);
            return make_float4(x.x + pe.x, x.y + pe.y, x.z + pe.z, x.w + pe.w);
        };
        auto bl = [&](int, int k, int c) -> float4 { return *(const float4*)(w1 + (size_t)k * 256 + col0 + c); };
        gemm_tile_f32<1>(v.tid, acc, 2048, al, bl, As, Bs);
        const int tx = v.tid & 15, ty = v.tid >> 4;
#pragma unroll
        for (int i = 0; i < 4; ++i) {
            const int row = row0 + ty * 4 + i;
            if (row >= NCR) continue;
#pragma unroll
            for (int j = 0; j < 4; ++j) { const int col = col0 + tx * 4 + j; hid[(size_t)row * 256 + col] = gelu_tanh(acc[0][i][j] + b1[col]); }
        }
    }
}

__device__ __forceinline__ void st_out(float* p, float x) { *p = x; }
__device__ __forceinline__ void st_out(unsigned short* p, float x) { *p = f2bf_rne(x); }
template <int DH, class KeyF, class OutT>
__device__ __forceinline__ void wave_attend(const float* q, int ncand, KeyF keyf, float* sc, OutT* out, int lane) {
    float m = -3.0e38f;
    for (int idx = lane; idx < ncand; idx += 64) {
        const float *kp, *vp;
        float s = -3.0e38f;
        if (keyf(idx, kp, vp)) {
            s = 0.f;
#pragma unroll 4
            for (int d = 0; d < DH; d += 4) { const float4 kv = *(const float4*)(kp + d); s += q[d] * kv.x + q[d + 1] * kv.y + q[d + 2] * kv.z + q[d + 3] * kv.w; }
        }
        sc[idx] = s;
        m = fmaxf(m, s);
    }
    m = wave_max(m);
    float sum = 0.f;
    for (int idx = lane; idx < ncand; idx += 64) { const float s = sc[idx]; const float p = (s > -1.0e38f) ? __expf(s - m) : 0.f; sc[idx] = p; sum += p; }
    sum = wave_sum(sum);
    const float inv = (m > -1.0e38f) ? 1.f / sum : 0.f;
    for (int idx = lane; idx < ncand; idx += 64) sc[idx] *= inv;
    __builtin_amdgcn_s_waitcnt(0);
    float o[DH / 64];
#pragma unroll
    for (int i = 0; i < DH / 64; ++i) o[i] = 0.f;
    for (int idx = 0; idx < ncand; ++idx) {
        const float p = sc[idx];
        if (p == 0.f) continue;
        const float *kp, *vp;
        keyf(idx, kp, vp);
#pragma unroll
        for (int i = 0; i < DH / 64; ++i) o[i] += p * vp[lane + 64 * i];
    }
#pragma unroll
    for (int i = 0; i < DH / 64; ++i) st_out(out + lane + 64 * i, o[i]);
}

__device__ __forceinline__ void p_cmp_attn(const VB& v, const float* __restrict__ proj, const float* __restrict__ kc, const float* __restrict__ vc,
                                           float* __restrict__ o_cmp, unsigned* __restrict__ selmask) {
    float (*qs)[64] = (float (*)[64])v.lds;
    float (*ps)[128] = (float (*)[128])(v.lds + 1024);
    float* imps = (float*)(v.lds + 1024 + 2048);
    VB_ITEMS(T * 2) {
        const int g = item & 1, t = item >> 1, b = t / S, s = t % S;
        const int w = v.tid >> 6, lane = v.tid & 63, h = g * 4 + w;
        __syncthreads();
        qs[w][lane] = proj[(size_t)t * INC + C_Q + h * 64 + lane] * 0.125f;
        ps[w][lane] = 0.f; ps[w][lane + 64] = 0.f;
        __syncthreads();
        auto keyf = [&](int c, const float*& kp, const float*& vp) -> bool {
            kp = kc + (size_t)((b * NC + c) * 2 + g) * 64; vp = vc + (size_t)((b * NC + c) * 2 + g) * 64;
            return 16 * c + 31 <= s;
        };
        wave_attend<64>(qs[w], NC, keyf, ps[w], o_cmp + (size_t)t * 512 + h * 64, lane);
        __syncthreads();
        if (v.tid < 32) {
            const int j = v.tid;
            float imp = 0.f;
            for (int hh = 0; hh < 4; ++hh)
                for (int c = 4 * j - 1; c <= 4 * j + 3; ++c) {
                    if (c < 0 || c >= NC) continue;
                    const float ov = (c == 4 * j - 1 || c == 4 * j + 3) ? 0.5f : 1.0f;
                    imp += ps[hh][c] * ov;
                }
            const int cur = s >> 6;
            if (j == 0 || j == cur || j == cur - 1) imp = 1e30f; else if (j > cur) imp = -1e30f;
            imps[j] = imp;
        }
        __syncthreads();
        if (v.tid < 64) {
            const int j = v.tid & 31;
            const float mine = imps[j];
            int rank = 0;
            for (int i = 0; i < 32; ++i) { const float x = imps[i]; rank += (x > mine || (x == mine && i < j)) ? 1 : 0; }
            const unsigned long long bal = __ballot(rank < 16 && v.tid < 32);
            if (v.tid == 0) selmask[(size_t)(b * 2 + g) * S + s] = (unsigned)(bal & 0xffffffffull);
        }
    }
}

template <int MODE>
__device__ __forceinline__ void p_nsa_attn(const VB& v, const float* __restrict__ proj, const unsigned* __restrict__ selmask, float* __restrict__ outp) {
    float (*qs)[64] = (float (*)[64])v.lds;
    float (*scs)[2048] = (float (*)[2048])(v.lds + 1024);
    VB_ITEMS(T * 2) {
        const int g = item & 1, t = item >> 1, b = t / S, s = t % S;
        const int w = v.tid >> 6, lane = v.tid & 63, h = g * 4 + w;
        qs[w][lane] = proj[(size_t)t * INC + C_Q + h * 64 + lane] * 0.125f;
        __builtin_amdgcn_s_waitcnt(0);
        if (MODE == 0) {
            const unsigned mask = selmask[(size_t)(b * 2 + g) * S + s];
            const int ncand = ((s >> 6) + 1) * 64;
            auto keyf = [&](int idx, const float*& kp, const float*& vp) -> bool {
                const float* r = proj + (size_t)(b * S + idx) * INC + g * 64;
                kp = r + C_KS; vp = r + C_VS;
                return idx <= s && ((mask >> (idx >> 6)) & 1u);
            };
            wave_attend<64>(qs[w], ncand, keyf, scs[w], outp + (size_t)t * 512 + h * 64, lane);
        } else {
            const int lo = s - 511 > 0 ? s - 511 : 0;
            const int ncand = s - lo + 1;
            auto keyf = [&](int idx, const float*& kp, const float*& vp) -> bool {
                const float* r = proj + (size_t)(b * S + lo + idx) * INC + g * 64;
                kp = r + C_KW; vp = r + C_VW;
                return true;
            };
            wave_attend<64>(qs[w], ncand, keyf, scs[w], outp + (size_t)t * 512 + h * 64, lane);
        }
    }
}

__device__ __forceinline__ void p_xattn(const VB& v, const float* __restrict__ xq, const float* __restrict__ xkv, unsigned short* __restrict__ xo) {
    float (*qs)[256] = (float (*)[256])v.lds;
    float (*scs)[256] = (float (*)[256])(v.lds + 4096);
    VB_ITEMS(T) {
        const int t = item, b = t / S, w = v.tid >> 6, lane = v.tid & 63;
        for (int i = lane; i < 256; i += 64) qs[w][i] = xq[(size_t)t * D + w * 256 + i] * 0.0625f;
        __builtin_amdgcn_s_waitcnt(0);
        auto keyf = [&](int m, const float*& kp, const float*& vp) -> bool {
            const float* r = xkv + (size_t)(b * NMEM + m) * 2048 + w * 256;
            kp = r; vp = r + 1024;
            return true;
        };
        wave_attend<256>(qs[w], NMEM, keyf, scs[w], xo + (size_t)t * D + w * 256, lane);
    }
}

__device__ __forceinline__ void p_mix_post(const VB& v, const float* __restrict__ proj, const float* __restrict__ o_cmp, const float* __restrict__ o_slc, const float* __restrict__ o_win,
                                           const float* __restrict__ conv_w, const float* __restrict__ g_nsa, const float* __restrict__ g_conv, unsigned short* __restrict__ omix) {
    float (*red)[4] = (float (*)[4])v.lds;
    VB_ITEMS(T) {
        const int t = item, s = t % S, tid = v.tid;
        const float* r = proj + (size_t)t * INC;
        float on[2], oc[2], ssn = 0.f, ssc = 0.f;
#pragma unroll
        for (int e = 0; e < 2; ++e) {
            const int c = tid + 256 * e, h = c >> 6;
            const float g0 = 1.f / (1.f + __expf(-r[C_GL + h * 3 + 0])), g1 = 1.f / (1.f + __expf(-r[C_GL + h * 3 + 1])), g2 = 1.f / (1.f + __expf(-r[C_GL + h * 3 + 2]));
            on[e] = g0 * o_cmp[(size_t)t * 512 + c] + g1 * o_slc[(size_t)t * 512 + c] + g2 * o_win[(size_t)t * 512 + c];
            ssn += on[e] * on[e];
            float y = 0.f;
#pragma unroll
            for (int k = 0; k < 3; ++k) {
                const int sp = s - 2 + k;
                if (sp < 0) continue;
                const float* rp = proj + (size_t)(t - 2 + k) * INC;
                y += conv_w[k * 512 + c] * (rp[C_CC + c] * rp[C_CH + c]);
            }
            oc[e] = r[C_CB + c] * y;
            ssc += oc[e] * oc[e];
        }
        ssn = wave_sum(ssn); ssc = wave_sum(ssc);
        __syncthreads();
        if ((tid & 63) == 0) { red[0][tid >> 6] = ssn; red[1][tid >> 6] = ssc; }
        __syncthreads();
        ssn = red[0][0] + red[0][1] + red[0][2] + red[0][3];
        ssc = red[1][0] + red[1][1] + red[1][2] + red[1][3];
        const float rn = rsqrtf(ssn / 512.f + 1e-5f), rc = rsqrtf(ssc / 512.f + 1e-5f);
#pragma unroll
        for (int e = 0; e < 2; ++e) {
            const int c = tid + 256 * e;
            omix[(size_t)t * D + c] = f2bf_rne(on[e] * rn * g_nsa[c]);
            omix[(size_t)t * D + 512 + c] = f2bf_rne(oc[e] * rc * g_conv[c]);
        }
    }
}


__device__ __forceinline__ float bfu(unsigned short b) { return __uint_as_float(((unsigned)b) << 16); }
__device__ __forceinline__ void p_rope_table(int gtid, int gn, const int* __restrict__ pos, float* __restrict__ cosT, float* __restrict__ sinT) {
    for (int i = gtid; i < T * 32; i += gn) {
        const int t = i >> 5, f = i & 31;
        const float inv = powf(10000.f, -(float)f / 32.f);
        const float ang = (float)pos[t] * inv;
        cosT[i] = cosf(ang); sinT[i] = sinf(ang);
    }
}
template <int DH, class ValidF, class KRow, class VGet, class OutT>
__device__ __forceinline__ void wave_attend_bf(const float* q, int ncand, ValidF valid, KRow krow, VGet vget, float* sc, OutT* out, int lane) {
    float m = -3.0e38f;
    for (int idx = lane; idx < ncand; idx += 64) {
        float s = -3.0e38f;
        if (valid(idx)) {
            const unsigned short* kp = krow(idx);
            s = 0.f;
#pragma unroll 2
            for (int d = 0; d < DH; d += 8) {
                const uint4 kv = *(const uint4*)(kp + d);
                s += q[d] * __uint_as_float(kv.x << 16) + q[d + 1] * __uint_as_float(kv.x & 0xffff0000u) + q[d + 2] * __uint_as_float(kv.y << 16) + q[d + 3] * __uint_as_float(kv.y & 0xffff0000u)
                   + q[d + 4] * __uint_as_float(kv.z << 16) + q[d + 5] * __uint_as_float(kv.z & 0xffff0000u) + q[d + 6] * __uint_as_float(kv.w << 16) + q[d + 7] * __uint_as_float(kv.w & 0xffff0000u);
            }
        }
        sc[idx] = s;
        m = fmaxf(m, s);
    }
    m = wave_max(m);
    float sum = 0.f;
    for (int idx = lane; idx < ncand; idx += 64) { const float s = sc[idx]; const float p = (s > -1.0e38f) ? exp2f(s - m) : 0.f; sc[idx] = p; sum += p; }
    sum = wave_sum(sum);
    const float inv = (m > -1.0e38f) ? 1.f / sum : 0.f;
    for (int idx = lane; idx < ncand; idx += 64) sc[idx] *= inv;
    __builtin_amdgcn_s_waitcnt(0);
    float o[DH / 64];
#pragma unroll
    for (int i = 0; i < DH / 64; ++i) o[i] = 0.f;
    for (int idx = 0; idx < ncand; ++idx) {
        const float p = sc[idx];
        if (p == 0.f) continue;
#pragma unroll
        for (int i = 0; i < DH / 64; ++i) o[i] += p * vget(idx, lane + 64 * i);
    }
#pragma unroll
    for (int i = 0; i < DH / 64; ++i) st_out(out + lane + 64 * i, o[i]);
}

__device__ __forceinline__ void p_cmp1_bf(const VB& v, const unsigned short* __restrict__ src, const float* __restrict__ pos, const float* __restrict__ w1, const float* __restrict__ b1, float* __restrict__ hid) {
    float (*As)[68] = (float (*)[68])v.lds;
    float (*Bs)[68] = (float (*)[68])(v.lds + 16 * 68 * 4);
    const int nx = 4, ny = (NCR + 63) / 64, nt = nx * ny;
    VB_ITEMS(nt) {
        const bool act = item < nt;
        const int row0 = act ? (item / nx) * 64 : NCR, col0 = act ? (item % nx) * 64 : 0;
        float acc[1][4][4];
        auto al = [&](int r, int k) -> float4 {
            const int row = row0 + r; if (row >= NCR) return make_float4(0.f, 0.f, 0.f, 0.f);
            const int g = row & 1, bc = row >> 1, c = bc % NC, b = bc / NC, l = k >> 6, d = k & 63;
            const uint2 x = *(const uint2*)(src + ((size_t)(b * 2 + g) * S + 16 * c + l) * 64 + d);
            const float4 pe = *(const float4*)(pos + k);
            return make_float4(__uint_as_float(x.x << 16) + pe.x, __uint_as_float(x.x & 0xffff0000u) + pe.y, __uint_as_float(x.y << 16) + pe.z, __uint_as_float(x.y & 0xffff0000u) + pe.w);
        };
        auto bl = [&](int, int k, int c) -> float4 { return *(const float4*)(w1 + (size_t)k * 256 + col0 + c); };
        gemm_tile_f32<1>(v.tid, acc, 2048, al, bl, As, Bs);
        const int tx = v.tid & 15, ty = v.tid >> 4;
#pragma unroll
        for (int i = 0; i < 4; ++i) {
            const int row = row0 + ty * 4 + i;
            if (row >= NCR) continue;
#pragma unroll
            for (int j = 0; j < 4; ++j) { const int col = col0 + tx * 4 + j; hid[(size_t)row * 256 + col] = gelu_tanh(acc[0][i][j] + b1[col]); }
        }
    }
}
__device__ __forceinline__ void p_cmp_attn_bf(const VB& v, const unsigned short* __restrict__ qb, const float* __restrict__ kc, const float* __restrict__ vc,
                                              float* __restrict__ o_cmp, unsigned* __restrict__ selmask) {
    float (*qs)[64] = (float (*)[64])v.lds;
    float (*ps)[128] = (float (*)[128])(v.lds + 1024);
    float* imps = (float*)(v.lds + 1024 + 2048);
    VB_ITEMS(T * 2) {
        const int g = item & 1, t = item >> 1, b = t / S, s = t % S;
        const int w = v.tid >> 6, lane = v.tid & 63, h = g * 4 + w;
        __syncthreads();
        qs[w][lane] = bfu(qb[(size_t)t * 512 + h * 64 + lane]);
        ps[w][lane] = 0.f; ps[w][lane + 64] = 0.f;
        __syncthreads();
        {
            float m = -3.0e38f;
            float* sc = ps[w];
            for (int c = lane; c < NC; c += 64) {
                float sv = -3.0e38f;
                if (16 * c + 31 <= s) { const float* kp = kc + (size_t)((b * NC + c) * 2 + g) * 64; sv = 0.f; for (int d = 0; d < 64; ++d) sv += qs[w][d] * kp[d]; }
                sc[c] = sv; m = fmaxf(m, sv);
            }
            m = wave_max(m);
            float sum = 0.f;
            for (int c = lane; c < NC; c += 64) { const float sv = sc[c]; const float pp = (sv > -1.0e38f) ? exp2f(sv - m) : 0.f; sc[c] = pp; sum += pp; }
            sum = wave_sum(sum);
            const float inv = (m > -1.0e38f) ? 1.f / sum : 0.f;
            for (int c = lane; c < NC; c += 64) sc[c] *= inv;
            __builtin_amdgcn_s_waitcnt(0);
            float o = 0.f;
            for (int c = 0; c < NC; ++c) { const float pp = sc[c]; if (pp != 0.f) o += pp * vc[(size_t)((b * NC + c) * 2 + g) * 64 + lane]; }
            o_cmp[(size_t)t * 512 + h * 64 + lane] = o;
        }
        __syncthreads();
        if (v.tid < 32) {
            const int j = v.tid;
            float imp = 0.f;
            for (int hh = 0; hh < 4; ++hh)
                for (int c = 4 * j - 1; c <= 4 * j + 3; ++c) {
                    if (c < 0 || c >= NC) continue;
                    const float ov = (c == 4 * j - 1 || c == 4 * j + 3) ? 0.5f : 1.0f;
                    imp += ps[hh][c] * ov;
                }
            const int cur = s >> 6;
            if (j == 0 || j == cur || j == cur - 1) imp = 1e30f; else if (j > cur) imp = -1e30f;
            imps[j] = imp;
        }
        __syncthreads();
        if (v.tid < 64) {
            const int j = v.tid & 31;
            const float mine = imps[j];
            int rank = 0;
            for (int i = 0; i < 32; ++i) { const float x = imps[i]; rank += (x > mine || (x == mine && i < j)) ? 1 : 0; }
            const unsigned long long bal = __ballot(rank < 16 && v.tid < 32);
            if (v.tid == 0) selmask[(size_t)(b * 2 + g) * S + s] = (unsigned)(bal & 0xffffffffull);
        }
    }
}
template <int MODE>
__device__ __forceinline__ void p_nsa_attn_bf(const VB& v, const unsigned short* __restrict__ qb, const unsigned short* __restrict__ Kh, const unsigned short* __restrict__ VT,
                                              const unsigned* __restrict__ selmask, float* __restrict__ outp) {
    float (*qs)[64] = (float (*)[64])v.lds;
    float (*scs)[2048] = (float (*)[2048])(v.lds + 1024);
    VB_ITEMS(T * 2) {
        const int g = item & 1, t = item >> 1, b = t / S, s = t % S;
        const int w = v.tid >> 6, lane = v.tid & 63, h = g * 4 + w;
        qs[w][lane] = bfu(qb[(size_t)t * 512 + h * 64 + lane]);
        __builtin_amdgcn_s_waitcnt(0);
        const unsigned short* Kb = Kh + (size_t)(b * 2 + g) * S * 64;
        const unsigned short* Vb = VT + (size_t)(b * 2 + g) * 64 * S;
        if (MODE == 0) {
            const unsigned mask = selmask[(size_t)(b * 2 + g) * S + s];
            const int ncand = ((s >> 6) + 1) * 64;
            auto valid = [&](int idx) -> bool { return idx <= s && ((mask >> (idx >> 6)) & 1u); };
            auto krow = [&](int idx) -> const unsigned short* { return Kb + (size_t)idx * 64; };
            auto vget = [&](int idx, int d) -> float { return bfu(Vb[(size_t)d * S + idx]); };
            wave_attend_bf<64>(qs[w], ncand, valid, krow, vget, scs[w], outp + (size_t)t * 512 + h * 64, lane);
        } else {
            const int lo = s - 511 > 0 ? s - 511 : 0;
            const int ncand = s - lo + 1;
            auto valid = [&](int) -> bool { return true; };
            auto krow = [&](int idx) -> const unsigned short* { return Kb + (size_t)(lo + idx) * 64; };
            auto vget = [&](int idx, int d) -> float { return bfu(Vb[(size_t)d * S + lo + idx]); };
            wave_attend_bf<64>(qs[w], ncand, valid, krow, vget, scs[w], outp + (size_t)t * 512 + h * 64, lane);
        }
    }
}
__device__ __forceinline__ void p_mix_post_bf(const VB& v, const float* __restrict__ gates, const unsigned short* __restrict__ ub, const unsigned short* __restrict__ cbb,
                                              const float* __restrict__ o_cmp, const float* __restrict__ o_slc, const float* __restrict__ o_win,
                                              const float* __restrict__ conv_w, const float* __restrict__ g_nsa, const float* __restrict__ g_conv, unsigned short* __restrict__ omix) {
    float (*red)[4] = (float (*)[4])v.lds;
    VB_ITEMS(T) {
        const int t = item, s = t % S, tid = v.tid;
        float on[2], oc[2], ssn = 0.f, ssc = 0.f;
#pragma unroll
        for (int e = 0; e < 2; ++e) {
            const int c = tid + 256 * e, h = c >> 6;
            const float g0 = gates[(size_t)t * 24 + h * 3 + 0], g1 = gates[(size_t)t * 24 + h * 3 + 1], g2 = gates[(size_t)t * 24 + h * 3 + 2];
            on[e] = g0 * o_cmp[(size_t)t * 512 + c] + g1 * o_slc[(size_t)t * 512 + c] + g2 * o_win[(size_t)t * 512 + c];
            ssn += on[e] * on[e];
            float y = 0.f;
#pragma unroll
            for (int k = 0; k < 3; ++k) {
                const int sp = s - 2 + k;
                if (sp < 0) continue;
                y += conv_w[k * 512 + c] * bfu(ub[(size_t)(t - 2 + k) * 512 + c]);
            }
            oc[e] = bfu(cbb[(size_t)t * 512 + c]) * y;
            ssc += oc[e] * oc[e];
        }
        ssn = wave_sum(ssn); ssc = wave_sum(ssc);
        __syncthreads();
        if ((tid & 63) == 0) { red[0][tid >> 6] = ssn; red[1][tid >> 6] = ssc; }
        __syncthreads();
        ssn = red[0][0] + red[0][1] + red[0][2] + red[0][3];
        ssc = red[1][0] + red[1][1] + red[1][2] + red[1][3];
        const float rn = rsqrtf(ssn / 512.f + 1e-5f), rc = rsqrtf(ssc / 512.f + 1e-5f);
#pragma unroll
        for (int e = 0; e < 2; ++e) {
            const int c = tid + 256 * e;
            omix[(size_t)t * D + c] = f2bf_rne(on[e] * rn * g_nsa[c]);
            omix[(size_t)t * D + 512 + c] = f2bf_rne(oc[e] * rc * g_conv[c]);
        }
    }
}

__device__ __forceinline__ void p_router(const VB& v, const float* __restrict__ xn, const float* __restrict__ wr, const float* __restrict__ br,
                                         int* __restrict__ a_e, float* __restrict__ a_w, int* __restrict__ a_slot, int* __restrict__ counts) {
    VB_ITEMS(T / 4) {
        const int t = item * 4 + (v.tid >> 6), lane = v.tid & 63, e = lane & 31, half = lane >> 5;
        const float* x = xn + (size_t)t * D + half * 512;
        const float* w = wr + (size_t)half * 512 * NE + e;
        float acc = 0.f;
        for (int k = 0; k < 512; ++k) acc += x[k] * w[(size_t)k * NE];
        acc += __shfl_xor(acc, 32);
        const float logit = acc + br[e];
        int rank = 0;
        for (int i = 0; i < 32; ++i) { const float x2 = __shfl(logit, i); rank += (x2 > logit || (x2 == logit && i < e)) ? 1 : 0; }
        const float vmax = wave_max(logit);
        const bool sel = (rank < TOPK) && (lane < 32);
        const float ex = sel ? __expf(logit - vmax) : 0.f;
        const float sum = wave_sum(ex);
        if (sel) {
            const int a = t * TOPK + rank;
            a_e[a] = e; a_w[a] = ex / sum; a_slot[a] = atomicAdd(&counts[e], 1);
        }
    }
}
__device__ __forceinline__ void p_moe_offsets(const VB& v, const int* __restrict__ counts, int* __restrict__ pstart, int* __restrict__ tile_e, int* __restrict__ tok_buf, float* __restrict__ w_buf) {
    int* ps = (int*)v.lds;
    __syncthreads();
    if (v.tid == 0) { int acc = 0; for (int e = 0; e < NE; ++e) { ps[e] = acc; if (v.vb == 0) pstart[e] = acc; acc += (counts[e] + MT - 1) / MT * MT; } ps[NE] = acc; if (v.vb == 0) pstart[NE] = acc / MT; }
    __syncthreads();
    for (int tl = v.vb * 256 + v.tid; tl < NTILE; tl += v.nvb * 256) {
        const int r = tl * MT; int e = -1;
        for (int i = 0; i < NE; ++i) if (r >= ps[i] && r < ps[i + 1]) e = i;
        tile_e[tl] = e;
    }
    for (int i = v.vb * 256 + v.tid; i < PMAX; i += v.nvb * 256) { tok_buf[i] = 0; w_buf[i] = 0.f; }
}
__device__ __forceinline__ void p_moe_scatter(const VB& v, const int* __restrict__ a_e, const float* __restrict__ a_w, const int* __restrict__ a_slot, const int* __restrict__ pstart,
                                              int* __restrict__ tok_buf, float* __restrict__ w_buf, int* __restrict__ dest_of, const float* __restrict__ xn, unsigned short* __restrict__ xg) {
    const int lane = v.tid & 63, gw = v.vb * 4 + (v.tid >> 6), ngw = v.nvb * 4;
    for (int a = gw; a < NA; a += ngw) {
        const int dest = pstart[a_e[a]] + a_slot[a], t = a / TOPK;
        if (lane == 0) { tok_buf[dest] = t; w_buf[dest] = a_w[a]; dest_of[a] = dest; }
        const float* src = xn + (size_t)t * D + lane * 16;
        unsigned o[8];
#pragma unroll
        for (int i = 0; i < 4; ++i) { const float4 x = *(const float4*)(src + 4 * i); o[2 * i] = pg::cvt_pk_bf16(x.x, x.y); o[2 * i + 1] = pg::cvt_pk_bf16(x.z, x.w); }
        uint4* dst = (uint4*)(xg + (size_t)dest * D + lane * 16);
        dst[0] = make_uint4(o[0], o[1], o[2], o[3]); dst[1] = make_uint4(o[4], o[5], o[6], o[7]);
    }
}
__device__ __forceinline__ void p_moe1(const VB& v, const float* __restrict__ xn, const int* __restrict__ tok_buf, const int* __restrict__ tile_e,
                                       const float* __restrict__ wgu, const float* __restrict__ bgu, __hip_bfloat16* __restrict__ hmid) {
    float (*As)[68] = (float (*)[68])v.lds;
    float (*Bs)[132] = (float (*)[132])(v.lds + 16 * 68 * 4);
    int* toks = (int*)(v.lds + 16 * 68 * 4 + 16 * 132 * 4);
    const int nt = 16 * NTILE;
    VB_ITEMS(nt) {
        const int tl = item < nt ? item / 16 : 0, cx = item % 16;
        const int e0 = item < nt ? tile_e[tl] : -1;
        const bool act = e0 >= 0;
        const int e = act ? e0 : 0;
        const int row0 = tl * MT, col0 = cx * 64;
        __syncthreads();
        if (v.tid < MT) toks[v.tid] = act ? tok_buf[row0 + v.tid] : 0;
        __syncthreads();
        const float* W = wgu + (size_t)e * D * 2048;
        float acc[2][4][4];
        auto al = [&](int r, int k) -> float4 { return *(const float4*)(xn + (size_t)toks[r] * D + k); };
        auto bl = [&](int w, int k, int c) -> float4 { return *(const float4*)(W + (size_t)k * 2048 + w * 1024 + col0 + c); };
        gemm_tile_f32<2>(v.tid, acc, D, al, bl, As, Bs);
        if (!act) continue;
        const int tx = v.tid & 15, ty = v.tid >> 4;
#pragma unroll
        for (int i = 0; i < 4; ++i)
#pragma unroll
            for (int j = 0; j < 4; ++j) {
                const int row = row0 + ty * 4 + i, col = col0 + tx * 4 + j;
                float g = acc[0][i][j] + bgu[(size_t)e * 2048 + col], u = acc[1][i][j] + bgu[(size_t)e * 2048 + 1024 + col];
                g = fminf(g, 7.f); u = fminf(fmaxf(u, -7.f), 7.f);
                const float hm = (u + 1.f) * (g / (1.f + __expf(-1.702f * g)));
                hmid[(size_t)row * DFF + col] = __float2bfloat16(hm);
            }
    }
}
__device__ __forceinline__ void p_moe2(const VB& v, const __hip_bfloat16* __restrict__ hmid, const int* __restrict__ tile_e, const float* __restrict__ w_buf,
                                       const float* __restrict__ wd, const float* __restrict__ bd, __hip_bfloat16* __restrict__ out_a) {
    float (*As)[68] = (float (*)[68])v.lds;
    float (*Bs)[68] = (float (*)[68])(v.lds + 16 * 68 * 4);
    const int nt = 16 * NTILE;
    VB_ITEMS(nt) {
        const int tl = item < nt ? item / 16 : 0, cx = item % 16;
        const int e0 = item < nt ? tile_e[tl] : -1;
        const bool act = e0 >= 0;
        const int e = act ? e0 : 0;
        const int row0 = tl * MT, col0 = cx * 64;
        const float* W = wd + (size_t)e * DFF * D;
        float acc[1][4][4];
        auto al = [&](int r, int k) -> float4 {
            if (!act) return make_float4(0.f, 0.f, 0.f, 0.f);
            const __hip_bfloat16* p = hmid + (size_t)(row0 + r) * DFF + k;
            return make_float4(__bfloat162float(p[0]), __bfloat162float(p[1]), __bfloat162float(p[2]), __bfloat162float(p[3]));
        };
        auto bl = [&](int, int k, int c) -> float4 { return *(const float4*)(W + (size_t)k * D + col0 + c); };
        gemm_tile_f32<1>(v.tid, acc, DFF, al, bl, As, Bs);
        if (!act) continue;
        const int tx = v.tid & 15, ty = v.tid >> 4;
#pragma unroll
        for (int i = 0; i < 4; ++i)
#pragma unroll
            for (int j = 0; j < 4; ++j) {
                const int row = row0 + ty * 4 + i, col = col0 + tx * 4 + j;
                out_a[(size_t)row * D + col] = __float2bfloat16((acc[0][i][j] + bd[(size_t)e * D + col]) * w_buf[row]);
            }
    }
}
__device__ __forceinline__ void p_final(const VB& v, const float* __restrict__ h2, const unsigned short* __restrict__ out_a, const int* __restrict__ dest_of,
                                        const float* __restrict__ g, float* __restrict__ out) {
    float* red = (float*)v.lds;
    VB_ITEMS(T) {
        const int t = item, tid = v.tid;
        int d[4];
#pragma unroll
        for (int k = 0; k < 4; ++k) d[k] = dest_of[t * 4 + k];
        float x4[4], ss = 0.f;
#pragma unroll
        for (int e = 0; e < 4; ++e) {
            const int c = tid + 256 * e;
            float x = h2[(size_t)t * D + c];
#pragma unroll
            for (int k = 0; k < 4; ++k) x += __uint_as_float(((unsigned)out_a[(size_t)d[k] * D + c]) << 16);
            x4[e] = x; ss += x * x;
        }
        ss = wave_sum(ss);
        __syncthreads();
        if ((tid & 63) == 0) red[tid >> 6] = ss;
        __syncthreads();
        ss = red[0] + red[1] + red[2] + red[3];
        const float rs = rsqrtf(ss / (float)D + 1e-5f);
#pragma unroll
        for (int e = 0; e < 4; ++e) { const int c = tid + 256 * e; out[(size_t)t * D + c] = x4[e] * rs * g[c]; }
    }
}


namespace pg {
typedef unsigned short bf16_t;
typedef short bf16x8 __attribute__((ext_vector_type(8)));
typedef float f32x4 __attribute__((ext_vector_type(4)));
constexpr int BM = 256, BK = 64, HALF = 128, HTB = HALF * BK * 2, STAGE_BYTES = 8 * HTB;
__device__ __forceinline__ int lds_byte(int r, int c) { const int st = (r >> 4) * 2 + (c >> 5), rr = r & 15, cc = c & 31, ob = rr * 64 + cc * 2; return st * 1024 + (ob ^ (((ob >> 9) & 1) << 5)); }
__device__ __forceinline__ void stage_rc(int b, int& R, int& C) { const int st = b / 1024, sb = b % 1024, swz = sb ^ (((sb >> 9) & 1) << 5); R = (st >> 1) * 16 + swz / 64; C = (st & 1) * 32 + (swz % 64) / 2; }
__device__ __forceinline__ unsigned cvt_pk_bf16(float lo, float hi) { unsigned r; asm volatile("v_cvt_pk_bf16_f32 %0, %1, %2" : "=v"(r) : "v"(lo), "v"(hi)); return r; }
__device__ __forceinline__ bf16_t f2bf(float f) { unsigned u = __float_as_uint(f); u += 0x7FFFu + ((u >> 16) & 1u); return (bf16_t)(u >> 16); }
__device__ __forceinline__ float bf2f(bf16_t b) { return __uint_as_float(((unsigned)b) << 16); }

struct GUnit { const char* A; const char* B; int row0, col0, aux; };

template <class Epi, class Sched>
__device__ __forceinline__ void gemm_phase(LAS unsigned char* lds, const int K, const unsigned lda_b, const unsigned ldb_b, const Sched& S, const Epi& E) {
    const int tid = threadIdx.x, wid = __builtin_amdgcn_readfirstlane(tid >> 6), lane = tid & 63, wr = wid >> 2, wc = wid & 3, fr = lane & 15, fq = lane >> 4;
    const int nt = K / BK;
    unsigned voffA[2], voffB[2];
#pragma unroll
    for (int i = 0; i < 2; ++i) { int R, C; stage_rc(tid * 16 + i * 8192, R, C); voffA[i] = (unsigned)R * lda_b + (unsigned)C * 2u; voffB[i] = (unsigned)R * ldb_b + (unsigned)C * 2u; }
    const size_t kstep = (size_t)(BK * 2);
    const size_t hstepA = (size_t)HALF * lda_b, hstepB = (size_t)HALF * ldb_b;
    const unsigned ldsw = (unsigned)wid * 1024u;
    const int aoff = lds_byte(wr * 64 + fr, fq * 8), boff = lds_byte(wc * 32 + fr, fq * 8);
#define PG8_SA(b, h) (((b) * 2 + (h)) * HTB)
#define PG8_SB(b, h) ((4 + (b) * 2 + (h)) * HTB)
#define PG8_STAGE(bufoff, gbase, voff) do { _Pragma("unroll") for (int _i = 0; _i < 2; ++_i) \
        __builtin_amdgcn_global_load_lds((const unsigned*)((const char*)(gbase) + (voff)[_i]), (LAS unsigned*)(lds + (bufoff) + ldsw + _i * 8192), 16, 0, 0); } while (0)
#define PG8_LDA(dst, b, h) do { _Pragma("unroll") for (int m = 0; m < 4; ++m) _Pragma("unroll") for (int k = 0; k < 2; ++k) dst[m][k] = *(const LAS bf16x8*)(lds + PG8_SA(b, h) + aoff + m * 2048 + k * 1024); } while (0)
#define PG8_LDB(dst, b, h) do { _Pragma("unroll") for (int n = 0; n < 2; ++n) _Pragma("unroll") for (int k = 0; k < 2; ++k) dst[n][k] = *(const LAS bf16x8*)(lds + PG8_SB(b, h) + boff + n * 2048 + k * 1024); } while (0)
#define PG8_MMA(ai, bj, At, Bt) do { __builtin_amdgcn_s_setprio(1); _Pragma("unroll") for (int m = 0; m < 4; ++m) _Pragma("unroll") for (int n = 0; n < 2; ++n) _Pragma("unroll") for (int k = 0; k < 2; ++k) \
        acc[ai][bj][m][n] = __builtin_amdgcn_mfma_f32_16x16x32_bf16(Bt[n][k], At[m][k], acc[ai][bj][m][n], 0, 0, 0); __builtin_amdgcn_s_setprio(0); } while (0)
#define PG8_WAIT_V(n) asm volatile("s_waitcnt vmcnt(" #n ")" ::: "memory")
#define PG8_WAIT_L(n) asm volatile("s_waitcnt lgkmcnt(" #n ")" ::: "memory")
#define PG8_BAR __builtin_amdgcn_s_barrier()
#define PG8_SCHED __builtin_amdgcn_sched_barrier(0)
    GUnit cur, nxt; int ui = 0;
    if (!S.next(0, cur)) return;
    f32x4 acc[2][2][4][2];
#pragma unroll
    for (int a = 0; a < 2; ++a)
#pragma unroll
        for (int b = 0; b < 2; ++b)
#pragma unroll
            for (int m = 0; m < 4; ++m)
#pragma unroll
                for (int n = 0; n < 2; ++n) acc[a][b][m][n] = (f32x4){0.f, 0.f, 0.f, 0.f};
    bf16x8 At[4][2], B0[2][2], B1[2][2];
    const char* cA = cur.A; const char* cB = cur.B;
    PG8_STAGE(PG8_SB(0, 0), cB, voffB); PG8_STAGE(PG8_SA(0, 0), cA, voffA); PG8_STAGE(PG8_SB(0, 1), cB + hstepB, voffB); PG8_STAGE(PG8_SA(0, 1), cA + hstepA, voffA);
    if (wr == 1) PG8_BAR;
    PG8_WAIT_V(4); PG8_BAR;
    PG8_STAGE(PG8_SB(1, 0), cB + kstep, voffB); PG8_STAGE(PG8_SA(1, 0), cA + kstep, voffA); PG8_STAGE(PG8_SB(1, 1), cB + hstepB + kstep, voffB);
    PG8_WAIT_V(6); PG8_BAR;
    for (;;) {
        const bool has_next = S.next(ui + 1, nxt);
        const char* nA = has_next ? nxt.A : cA; const char* nB = has_next ? nxt.B : cB;
        for (int t = 0; t < nt; t += 2) {
            const bool last = (t == nt - 2);
            const char* a1 = cA + (size_t)(t + 1) * kstep;
            const char* a2 = last ? nA : cA + (size_t)(t + 2) * kstep; const char* b2 = last ? nB : cB + (size_t)(t + 2) * kstep;
            const char* a3 = a2 + kstep; const char* b3 = b2 + kstep;
            PG8_LDB(B0, 0, 0); PG8_SCHED; PG8_LDA(At, 0, 0); PG8_STAGE(PG8_SA(1, 1), a1 + hstepA, voffA);
            PG8_WAIT_L(8); PG8_BAR; PG8_WAIT_L(0); PG8_MMA(0, 0, At, B0); PG8_BAR; PG8_SCHED;
            PG8_LDB(B1, 0, 1); PG8_STAGE(PG8_SB(0, 0), b2, voffB);
            PG8_BAR; PG8_WAIT_L(0); PG8_MMA(0, 1, At, B1); PG8_BAR;
            PG8_LDA(At, 0, 1); PG8_STAGE(PG8_SA(0, 0), a2, voffA);
            PG8_BAR; PG8_WAIT_L(0); PG8_MMA(1, 0, At, B0); PG8_BAR; PG8_SCHED;
            PG8_STAGE(PG8_SB(0, 1), b2 + hstepB, voffB);
            PG8_WAIT_V(6); PG8_BAR; PG8_MMA(1, 1, At, B1); PG8_BAR;
            PG8_LDB(B0, 1, 0); PG8_SCHED; PG8_LDA(At, 1, 0); PG8_STAGE(PG8_SA(0, 1), a2 + hstepA, voffA);
            PG8_WAIT_L(8); PG8_BAR; PG8_WAIT_L(0); PG8_MMA(0, 0, At, B0); PG8_BAR; PG8_SCHED;
            PG8_LDB(B1, 1, 1); PG8_STAGE(PG8_SB(1, 0), b3, voffB);
            PG8_BAR; PG8_WAIT_L(0); PG8_MMA(0, 1, At, B1); PG8_BAR;
            PG8_LDA(At, 1, 1); PG8_STAGE(PG8_SA(1, 0), a3, voffA);
            PG8_BAR; PG8_WAIT_L(0); PG8_MMA(1, 0, At, B0); PG8_BAR; PG8_SCHED;
            PG8_STAGE(PG8_SB(1, 1), b3 + hstepB, voffB);
            PG8_WAIT_V(6); PG8_BAR; PG8_MMA(1, 1, At, B1); PG8_BAR;
        }
        E(acc, cur, wr, wc, fr, fq);
        if (!has_next) break;
#pragma unroll
        for (int a = 0; a < 2; ++a)
#pragma unroll
            for (int b = 0; b < 2; ++b)
#pragma unroll
                for (int m = 0; m < 4; ++m)
#pragma unroll
                    for (int n = 0; n < 2; ++n) acc[a][b][m][n] = (f32x4){0.f, 0.f, 0.f, 0.f};
        cur = nxt; cA = nA; cB = nB; ++ui;
    }
    PG8_WAIT_V(0);
    if (wr == 0) PG8_BAR;
    PG8_BAR;
#undef PG8_SA
#undef PG8_SB
#undef PG8_STAGE
#undef PG8_LDA
#undef PG8_LDB
#undef PG8_MMA
#undef PG8_WAIT_V
#undef PG8_WAIT_L
#undef PG8_BAR
#undef PG8_SCHED
}

struct DenseOrder {
    const char* A; const char* Bt; unsigned lda_b, ldb_b; int nM, nN, nwg, G, c;
    __device__ void init(const void* A_, const void* Bt_, int M, int N, unsigned lda_b_, unsigned ldb_b_, int G_, int c_) { A = (const char*)A_; Bt = (const char*)Bt_; lda_b = lda_b_; ldb_b = ldb_b_; nM = M / BM; nN = N / BM; nwg = nM * nN; G = G_; c = c_; }
    __device__ bool next(int i, GUnit& u) const {
        const long L = (long)i * G + c; if (L >= nwg) return false;
        int wgid = (int)L; { const int q = nwg / 8, r = nwg % 8, xcd = wgid % 8, off = wgid / 8; wgid = (xcd < r ? xcd * (q + 1) : r * (q + 1) + (xcd - r) * q) + off; }
        const int nig = 8 * nN, gid = wgid / nig, fm = gid * 8, gsz = (nM - fm) < 8 ? (nM - fm) : 8;
        const int pm = fm + ((wgid % nig) % gsz), pn = (wgid % nig) / gsz;
        u.A = A + (size_t)pm * BM * lda_b; u.B = Bt + (size_t)pn * BM * ldb_b; u.row0 = pm * BM; u.col0 = pn * BM; u.aux = 0; return true;
    }
};

struct EpiF32R {
    float* C; int ldc; const float* res; int ncols;
    __device__ __forceinline__ void operator()(const f32x4 (&acc)[2][2][4][2], const GUnit& u, int wr, int wc, int fr, int fq) const {
        const int row0 = u.row0 + wr * 64 + fr, col0 = u.col0 + wc * 32 + 4 * fq;
#pragma unroll
        for (int ai = 0; ai < 2; ++ai)
#pragma unroll
            for (int m = 0; m < 4; ++m) {
                const size_t ro = (size_t)(row0 + ai * HALF + m * 16) * ldc;
#pragma unroll
                for (int bj = 0; bj < 2; ++bj)
#pragma unroll
                    for (int n = 0; n < 2; ++n) {
                        const int col = col0 + bj * HALF + n * 16;
                        if (col < ncols) { f32x4 x = acc[ai][bj][m][n]; if (res) x += *(const f32x4*)(res + ro + col); *(f32x4*)(C + ro + col) = x; }
                    }
            }
    }
};


struct EpiMixIn {
    bf16_t *q, *kk  , *vt  , *u, *cb; float* gates; const float* cosT; const float* sinT;
    __device__ __forceinline__ void operator()(const f32x4 (&acc)[2][2][4][2], const GUnit& un, int wr, int wc, int fr, int fq) const {
        const int pn = un.col0 >> 8, w1 = wc & 1, w2 = wc >> 1, dlo = 16 * w1 + 4 * fq;
#pragma unroll
        for (int ai = 0; ai < 2; ++ai)
#pragma unroll
            for (int m = 0; m < 4; ++m) {
                const int t = un.row0 + ai * HALF + wr * 64 + m * 16 + fr, b = t >> 11, sq = t & 2047;
                if (pn <= 4) {
                    const f32x4 cv = *(const f32x4*)(cosT + (size_t)t * 32 + dlo), sv = *(const f32x4*)(sinT + (size_t)t * 32 + dlo);
#pragma unroll
                    for (int bj = 0; bj < 2; ++bj) {
                        const int blk = 2 * bj + w2;
                        f32x4 x0 = acc[ai][bj][m][0], x1 = acc[ai][bj][m][1];
                        const bool rope = (pn < 2) || (bj == 0);
                        if (rope) { const f32x4 r0 = x0 * cv - x1 * sv, r1 = x1 * cv + x0 * sv; x0 = r0; x1 = r1; }
                        if (pn < 2) { x0 *= QS; x1 *= QS; }
                        uint2 o0, o1; o0.x = cvt_pk_bf16(x0[0], x0[1]); o0.y = cvt_pk_bf16(x0[2], x0[3]); o1.x = cvt_pk_bf16(x1[0], x1[1]); o1.y = cvt_pk_bf16(x1[2], x1[3]);
                        if (pn < 2) {
                            bf16_t* dst = q + (size_t)t * 512 + (pn * 4 + blk) * 64 + dlo;
                            *(uint2*)dst = o0; *(uint2*)(dst + 32) = o1;
                        } else {
                            const int g = blk & 1;
                            const size_t rowi = (size_t)(b * 2 + g) * S + sq;
                            if (bj == 0 || pn == 2) {
                                const int ki = (pn == 2) ? bj : pn - 1;
                                bf16_t* dst = kk + (size_t)ki * ((size_t)T * 128) + rowi * 64 + dlo;
                                *(uint2*)dst = o0; *(uint2*)(dst + 32) = o1;
                            } else {
                                bf16_t* base = vt + (size_t)(pn - 3) * ((size_t)T * 128) + ((size_t)(b * 2 + g) * 64 + dlo) * S + sq;
                                base[0 * S] = (bf16_t)(o0.x & 0xffff); base[1 * S] = (bf16_t)(o0.x >> 16); base[2 * S] = (bf16_t)(o0.y & 0xffff); base[3 * S] = (bf16_t)(o0.y >> 16);
                                base[32 * S] = (bf16_t)(o1.x & 0xffff); base[33 * S] = (bf16_t)(o1.x >> 16); base[34 * S] = (bf16_t)(o1.y & 0xffff); base[35 * S] = (bf16_t)(o1.y >> 16);
                            }
                        }
                    }
                } else if (pn < 9) {
#pragma unroll
                    for (int n = 0; n < 2; ++n) {
                        const f32x4 x = acc[ai][0][m][n] * acc[ai][1][m][n];
                        uint2 o; o.x = cvt_pk_bf16(x[0], x[1]); o.y = cvt_pk_bf16(x[2], x[3]);
                        *(uint2*)(u + (size_t)t * 512 + (pn - 5) * 128 + w2 * 64 + n * 32 + dlo) = o;
                    }
                } else if (pn < 11) {
#pragma unroll
                    for (int bj = 0; bj < 2; ++bj)
#pragma unroll
                        for (int n = 0; n < 2; ++n) {
                            const f32x4 x = acc[ai][bj][m][n];
                            uint2 o; o.x = cvt_pk_bf16(x[0], x[1]); o.y = cvt_pk_bf16(x[2], x[3]);
                            *(uint2*)(cb + (size_t)t * 512 + (pn - 9) * 256 + bj * 128 + w2 * 64 + n * 32 + dlo) = o;
                        }
                } else {
                    if (w2 == 0 && dlo < 24) {
                        const f32x4 x = acc[ai][0][m][0];
                        f32x4 sg;
#pragma unroll
                        for (int j = 0; j < 4; ++j) sg[j] = 1.f / (1.f + __expf(-x[j]));
                        *(f32x4*)(gates + (size_t)t * 24 + dlo) = sg;
                    }
                }
            }
    }
};

template <int NPN>
struct MoeOrder {
    const char* A; const char* Bt; const int* tile_e; int nunits, G, c; size_t bt_expert_bytes;
    __device__ void init(const void* A_, const void* Bt_, const int* tile_e_, int ntiles, size_t bt_expert_bytes_, int G_, int c_) { A = (const char*)A_; Bt = (const char*)Bt_; tile_e = tile_e_; nunits = ntiles * NPN; bt_expert_bytes = bt_expert_bytes_; G = G_; c = c_; }
    __device__ bool next(int i, GUnit& u) const {
        const int L = i * G + c; if (L >= nunits) return false;
        const int tl = L / NPN, pn = L % NPN, e = tile_e[tl];
        u.A = A + (size_t)tl * BM * 2048; u.B = Bt + (size_t)e * bt_expert_bytes + (size_t)pn * BM * 2048; u.row0 = tl * BM; u.col0 = pn * BM; u.aux = e; return true;
    }
};
struct EpiSwiglu {
    bf16_t* H; const float* bias;
    __device__ __forceinline__ void operator()(const f32x4 (&acc)[2][2][4][2], const GUnit& u, int wr, int wc, int fr, int fq) const {
        const int row0 = u.row0 + wr * 64 + fr, pn = u.col0 >> 8, cl0 = wc * 32 + 4 * fq;
        const float* bg = bias + (size_t)u.aux * 2048 + pn * 128 + cl0;
        f32x4 bgv[2], buv[2];
#pragma unroll
        for (int n = 0; n < 2; ++n) { bgv[n] = *(const f32x4*)(bg + n * 16); buv[n] = *(const f32x4*)(bg + 1024 + n * 16); }
#pragma unroll
        for (int ai = 0; ai < 2; ++ai)
#pragma unroll
            for (int m = 0; m < 4; ++m) {
                bf16_t* rowp = H + (size_t)(row0 + ai * HALF + m * 16) * 1024 + pn * 128 + cl0;
#pragma unroll
                for (int n = 0; n < 2; ++n) {
                    const f32x4 g4 = acc[ai][0][m][n] + bgv[n], u4 = acc[ai][1][m][n] + buv[n];
                    float h[4];
#pragma unroll
                    for (int j = 0; j < 4; ++j) {
                        const float g = fminf(g4[j], 7.f), uu = fminf(fmaxf(u4[j], -7.f), 7.f);
                        h[j] = (uu + 1.f) * (g / (1.f + __expf(-1.702f * g)));
                    }
                    uint2 o; o.x = cvt_pk_bf16(h[0], h[1]); o.y = cvt_pk_bf16(h[2], h[3]);
                    *(uint2*)(rowp + n * 16) = o;
                }
            }
    }
};
struct EpiDownScale {
    bf16_t* O; const float* bias; const float* w_buf;
    __device__ __forceinline__ void operator()(const f32x4 (&acc)[2][2][4][2], const GUnit& u, int wr, int wc, int fr, int fq) const {
        const int row0 = u.row0 + wr * 64 + fr, col0 = u.col0 + wc * 32 + 4 * fq;
        f32x4 bv[2][2];
#pragma unroll
        for (int bj = 0; bj < 2; ++bj)
#pragma unroll
            for (int n = 0; n < 2; ++n) bv[bj][n] = *(const f32x4*)(bias + (size_t)u.aux * 1024 + col0 + bj * HALF + n * 16);
#pragma unroll
        for (int ai = 0; ai < 2; ++ai)
#pragma unroll
            for (int m = 0; m < 4; ++m) {
                const int row = row0 + ai * HALF + m * 16;
                const float w = w_buf[row];
                bf16_t* rowp = O + (size_t)row * 1024 + col0;
#pragma unroll
                for (int bj = 0; bj < 2; ++bj)
#pragma unroll
                    for (int n = 0; n < 2; ++n) {
                        const f32x4 x = (acc[ai][bj][m][n] + bv[bj][n]) * w;
                        uint2 o; o.x = cvt_pk_bf16(x[0], x[1]); o.y = cvt_pk_bf16(x[2], x[3]);
                        *(uint2*)(rowp + bj * HALF + n * 16) = o;
                    }
            }
    }
};
}


namespace at {
using pg::bf16_t;
typedef short bf16x8 __attribute__((ext_vector_type(8)));
typedef float f32x16 __attribute__((ext_vector_type(16)));
typedef float f32x4 __attribute__((ext_vector_type(4)));
constexpr int TROW = 144, TILE_B = 64 * TROW;
#define AT_MFMA(a, b, c) __builtin_amdgcn_mfma_f32_32x32x16_bf16(a, b, c, 0, 0, 0)
__device__ __forceinline__ bf16x8 pack8(const f32x16& p, int s8) {
    union { unsigned u[4]; bf16x8 v; } x;
#pragma unroll
    for (int i = 0; i < 4; ++i) x.u[i] = pg::cvt_pk_bf16(p[s8 + 2 * i], p[s8 + 2 * i + 1]);
    return x.v;
}
template <int MODE>
__device__ __forceinline__ void attn64_unit(char* lds, int b, int g, int tq, const bf16_t* __restrict__ Q, const bf16_t* __restrict__ Kh, const bf16_t* __restrict__ VT,
                                            const unsigned* __restrict__ selmask, float* __restrict__ out) {
    const int tid = threadIdx.x, lane = tid & 63, r32 = lane & 31, hi = lane >> 5;
    const int wid = __builtin_amdgcn_readfirstlane(tid >> 6), hl = wid >> 1, qs = wid & 1;
    const int ql = 32 * qs + r32, qpos = tq * 64 + ql, h = g * 4 + hl;
    const size_t trow = (size_t)b * S + qpos;
    const bf16_t* Kb = Kh + (size_t)(b * 2 + g) * S * 64;
    const bf16_t* Vb = VT + (size_t)(b * 2 + g) * 64 * S;
    const int srow = tid >> 3, sch = tid & 7;
    const int kst = srow * TROW + sch * 16;
    const int vst = TILE_B + srow * TROW + ((sch >> 1) * 16 + (sch & 1) * 4) * 2;
    bf16x8 qf[4];
#pragma unroll
    for (int d0 = 0; d0 < 4; ++d0) qf[d0] = *(const bf16x8*)(Q + trow * 512 + h * 64 + 16 * d0 + 8 * hi);
    unsigned msk = 0xffffffffu;
    if (MODE == 0) msk = selmask[(size_t)(b * 2 + g) * S + qpos];
    const int nt = (MODE == 0) ? tq + 1 : (tq < 8 ? tq + 1 : 9);
    f32x16 o0, o1;
#pragma unroll
    for (int r = 0; r < 16; ++r) { o0[r] = 0.f; o1[r] = 0.f; }
    float m = -INFINITY, l = 0.f;
    uint4 kreg, vreg;
    kreg = *(const uint4*)(Kb + (size_t)(tq * 64 + srow) * 64 + sch * 8); vreg = *(const uint4*)(Vb + (size_t)srow * S + tq * 64 + sch * 8);
    __syncthreads();
    *(uint4*)(lds + kst) = kreg; *(uint2*)(lds + vst) = make_uint2(vreg.x, vreg.y); *(uint2*)(lds + vst + 16) = make_uint2(vreg.z, vreg.w);
    __syncthreads();
    for (int i = 0; i < nt; ++i) {
        if (i + 1 < nt) { const int tile = tq - i - 1; kreg = *(const uint4*)(Kb + (size_t)(tile * 64 + srow) * 64 + sch * 8); vreg = *(const uint4*)(Vb + (size_t)srow * S + tile * 64 + sch * 8); }
        const char* kb_ = lds + (i & 1) * 2 * TILE_B; const char* vb_ = kb_ + TILE_B;
        f32x16 p0, p1;
#pragma unroll
        for (int r = 0; r < 16; ++r) { p0[r] = 0.f; p1[r] = 0.f; }
#pragma unroll
        for (int d0 = 0; d0 < 4; ++d0) {
            const bf16x8 kf0 = *(const bf16x8*)(kb_ + r32 * TROW + d0 * 32 + hi * 16), kf1 = *(const bf16x8*)(kb_ + (32 + r32) * TROW + d0 * 32 + hi * 16);
            p0 = AT_MFMA(kf0, qf[d0], p0); p1 = AT_MFMA(kf1, qf[d0], p1);
        }
        if (i == 0) {
#pragma unroll
            for (int r = 0; r < 16; ++r) { const int kl = (r & 3) + 8 * (r >> 2) + 4 * hi; if (kl > ql) p0[r] = -INFINITY; if (kl + 32 > ql) p1[r] = -INFINITY; }
        } else if (MODE == 1) {
            if (i == 8) {
#pragma unroll
                for (int r = 0; r < 16; ++r) { const int kl = (r & 3) + 8 * (r >> 2) + 4 * hi; if (kl <= ql) p0[r] = -INFINITY; if (kl + 32 <= ql) p1[r] = -INFINITY; }
            }
        } else {
            if (!((msk >> (tq - i)) & 1u)) {
#pragma unroll
                for (int r = 0; r < 16; ++r) { p0[r] = -INFINITY; p1[r] = -INFINITY; }
            }
        }
        float mx = fmaxf(p0[0], p1[0]);
#pragma unroll
        for (int r = 1; r < 16; ++r) mx = fmaxf(mx, fmaxf(p0[r], p1[r]));
        mx = fmaxf(mx, __shfl_xor(mx, 32));
        const float mn = fmaxf(m, mx);
        const float alpha = __builtin_amdgcn_exp2f(m - mn);
        m = mn;
        float ls = 0.f;
#pragma unroll
        for (int r = 0; r < 16; ++r) { p0[r] = __builtin_amdgcn_exp2f(p0[r] - mn); p1[r] = __builtin_amdgcn_exp2f(p1[r] - mn); ls += p0[r] + p1[r]; }
        l = l * alpha + ls;
#pragma unroll
        for (int r = 0; r < 16; ++r) { o0[r] *= alpha; o1[r] *= alpha; }
        bf16x8 pb[4];
        pb[0] = pack8(p0, 0); pb[1] = pack8(p0, 8); pb[2] = pack8(p1, 0); pb[3] = pack8(p1, 8);
#pragma unroll
        for (int ks = 0; ks < 4; ++ks) {
            const bf16x8 vf0 = *(const bf16x8*)(vb_ + r32 * TROW + ks * 32 + hi * 16), vf1 = *(const bf16x8*)(vb_ + (32 + r32) * TROW + ks * 32 + hi * 16);
            o0 = AT_MFMA(vf0, pb[ks], o0); o1 = AT_MFMA(vf1, pb[ks], o1);
        }
        if (i + 1 < nt) {
            char* nb = lds + ((i + 1) & 1) * 2 * TILE_B;
            *(uint4*)(nb + kst) = kreg; *(uint2*)(nb + vst) = make_uint2(vreg.x, vreg.y); *(uint2*)(nb + vst + 16) = make_uint2(vreg.z, vreg.w);
        }
        __syncthreads();
    }
    const float lt = l + __shfl_xor(l, 32), inv = 1.f / lt;
    float* orow = out + trow * 512 + h * 64 + 4 * hi;
#pragma unroll
    for (int rr = 0; rr < 4; ++rr) {
        *(f32x4*)(orow + 8 * rr) = (f32x4){o0[4 * rr] * inv, o0[4 * rr + 1] * inv, o0[4 * rr + 2] * inv, o0[4 * rr + 3] * inv};
        *(f32x4*)(orow + 32 + 8 * rr) = (f32x4){o1[4 * rr] * inv, o1[4 * rr + 1] * inv, o1[4 * rr + 2] * inv, o1[4 * rr + 3] * inv};
    }
}
template <int MODE>
__device__ __forceinline__ void p_attn64(char* lds, const bf16_t* Q, const bf16_t* Kh, const bf16_t* VT, const unsigned* selmask, float* out, int wg, int nwg) {
    for (int item = wg; item < 256; item += nwg) {
        const int bg = item >> 4, j = item & 15;
        attn64_unit<MODE>(lds, bg >> 1, bg & 1, 31 - j, Q, Kh, VT, selmask, out);
        attn64_unit<MODE>(lds, bg >> 1, bg & 1, j, Q, Kh, VT, selmask, out);
    }
}
}

template <bool PERM64, class RowMap>
__device__ __forceinline__ void p_convT(char* lds, const float* __restrict__ W, int K, int N, int nmat, pg::bf16_t* __restrict__ Bt, int nrows_out, RowMap rowmap, int wg, int nwg) {
    pg::bf16_t* Ls = (pg::bf16_t*)lds;
    const int tid = threadIdx.x;
    const int tk = K / 128, tn = nrows_out / 64, per = tk * tn, total = per * nmat;
    for (int tile = wg; tile < total; tile += nwg) {
        const int mat = tile / per, r = tile % per, jn = r / tk, jk = r % tk;
        const int k0 = jk * 128, j0 = jn * 64, n0 = rowmap(j0);
        const float* Wm = W + (size_t)mat * K * N;
        __syncthreads();
#pragma unroll
        for (int i = 0; i < 4; ++i) {
            const int idx = tid + 512 * i, kk = idx >> 4, n4 = (idx & 15) * 4;
            float4 x = make_float4(0.f, 0.f, 0.f, 0.f);
            if (n0 >= 0 && n0 + n4 < N) x = *(const float4*)(Wm + (size_t)(k0 + kk) * N + n0 + n4);
            Ls[(n4 + 0) * 136 + kk] = pg::f2bf(x.x); Ls[(n4 + 1) * 136 + kk] = pg::f2bf(x.y); Ls[(n4 + 2) * 136 + kk] = pg::f2bf(x.z); Ls[(n4 + 3) * 136 + kk] = pg::f2bf(x.w);
        }
        __syncthreads();
#pragma unroll
        for (int i = 0; i < 2; ++i) {
            const int c = tid + 512 * i, n = c >> 4, kc = (c & 15) * 8;
            const int ns = PERM64 ? ((n & 15) | ((n & 16) << 1) | ((n & 32) >> 1)) : n;
            const uint4 x = *(const uint4*)(Ls + ns * 136 + kc);
            *(uint4*)(Bt + ((size_t)mat * nrows_out + j0 + n) * K + k0 + kc) = x;
        }
    }
}

struct Params {
    const float *x, *mem; const int* positions;
    const float *g_mix_norm, *w_mix_in, *cmp_pos_k, *cmp_pos_v, *cmp_w1_k, *cmp_b1_k, *cmp_w2_k, *cmp_w1_v, *cmp_b1_v, *cmp_w2_v, *conv_w, *g_nsa_out, *g_conv_out, *w_mix_out,
        *g_xattn_norm, *g_mem_norm, *w_xq, *w_xkv, *w_xo, *g_moe_norm, *w_router, *b_router, *w_gate_up, *b_gate_up, *w_down, *b_down, *g_final;
    float* out;
    unsigned* bar;
    int *counts, *pstart, *tile_e, *a_e, *a_slot, *dest_of, *tok_buf;
    float *a_w, *w_buf;
    unsigned* selmask;
    float *hid_k, *hid_v, *kc, *vc, *memn, *xkv, *hbuf, *xn, *o_cmp, *o_slc, *o_win, *xq, *proj, *xo;
    unsigned short *hmid, *out_a, *xg, *wt_gu, *wt_dn;
    unsigned short *q_bf, *kcmp, *vcmp, *kslc, *vslcT, *kwin, *vwinT, *u_bf, *cb_bf; float *gates, *cosT, *sinT;
    unsigned short *xn_bf, *memn_bf, *xo_bf, *wt_mix_in, *wt_xkv, *wt_mix_out, *wt_xq, *wt_xo;
};

__global__ void __launch_bounds__(512, 2) mega_fwd(Params p) {
    extern __shared__ __attribute__((aligned(16))) char lds[];
    if (threadIdx.x < 4) ((unsigned*)lds)[threadIdx.x] = 0u;
    __syncthreads();
    XcdBarrier bar = xcd_barrier_post(p.bar, (volatile LAS unsigned*)lds);
    LAS unsigned char* glds = (LAS unsigned char*)(lds + 1024);
    VB v; v.vb = blockIdx.x * 2 + (threadIdx.x >> 8); v.nvb = gridDim.x * 2; v.tid = threadIdx.x & 255; v.lds = lds + 64 + (threadIdx.x >> 8) * VB_LDS;

    {
        const int wg = blockIdx.x, nwg = gridDim.x;
        auto ident = [](int j) { return j; };
        auto mixmap = [](int j) {
            const int unit = j >> 8, blk = (j & 255) >> 6;
            if (unit < 2) return C_Q + unit * 256 + blk * 64;
            if (unit == 2) return blk < 2 ? C_KC + blk * 64 : C_VC + (blk - 2) * 64;
            if (unit == 3) return blk < 2 ? C_KS + blk * 64 : C_VS + (blk - 2) * 64;
            if (unit == 4) return blk < 2 ? C_KW + blk * 64 : C_VW + (blk - 2) * 64;
            if (unit < 9) return blk < 2 ? C_CH + (unit - 5) * 128 + blk * 64 : C_CC + (unit - 5) * 128 + (blk - 2) * 64;
            if (unit < 11) return C_CB + (unit - 9) * 256 + blk * 64;
            return blk == 0 ? C_GL : -1;
        };
        p_convT<true>(lds + 1024, p.w_mix_in, D, INC, 1, p.wt_mix_in, 3072, mixmap, wg, nwg);
        p_convT<false>(lds + 1024, p.w_xkv, D, 2048, 1, p.wt_xkv, 2048, ident, wg, nwg);
        p_convT<false>(lds + 1024, p.w_mix_out, D, D, 1, p.wt_mix_out, D, ident, wg, nwg);
        p_convT<false>(lds + 1024, p.w_xq, D, D, 1, p.wt_xq, D, ident, wg, nwg);
        p_convT<false>(lds + 1024, p.w_xo, D, D, 1, p.wt_xo, D, ident, wg, nwg);
        auto gumap = [](int j) { const int blk = j >> 8, w = j & 255; return w < 128 ? 128 * blk + w : 1024 + 128 * blk + (w - 128); };
        p_convT<false>(lds + 1024, p.w_gate_up, D, 2048, NE, p.wt_gu, 2048, gumap, wg, nwg);
        p_convT<false>(lds + 1024, p.w_down, DFF, D, NE, p.wt_dn, D, ident, wg, nwg);
        __syncthreads();
    }
    p_rope_table(blockIdx.x * 512 + threadIdx.x, gridDim.x * 512, p.positions, p.cosT, p.sinT);
    p_rmsnorm_bf(v, T, p.x, D, p.g_mix_norm, p.xn_bf, D, D);
    p_rmsnorm_bf(v, NB * NMEM, p.mem, D, p.g_mem_norm, p.memn_bf, D, D);
    xcd_barrier(bar);
    {
        pg::DenseOrder So; So.init(p.xn_bf, p.wt_mix_in, T, 3072, 2048u, 2048u, (int)gridDim.x, (int)blockIdx.x);
        pg::EpiMixIn E{p.q_bf, p.kcmp, p.vslcT, p.u_bf, p.cb_bf, p.gates, p.cosT, p.sinT};
        pg::gemm_phase(glds, D, 2048u, 2048u, So, E);
    }
    {
        pg::DenseOrder So; So.init(p.memn_bf, p.wt_xkv, NB * NMEM, 2048, 2048u, 2048u, (int)gridDim.x, (int)blockIdx.x);
        pg::EpiF32R E{p.xkv, 2048, nullptr, 2048};
        pg::gemm_phase(glds, D, 2048u, 2048u, So, E);
    }
    xcd_barrier(bar);
    p_cmp1_bf(v, p.kcmp, p.cmp_pos_k, p.cmp_w1_k, p.cmp_b1_k, p.hid_k);
    p_cmp1_bf(v, p.vcmp, p.cmp_pos_v, p.cmp_w1_v, p.cmp_b1_v, p.hid_v);
    at::p_attn64<1>(lds + 1024, p.q_bf, p.kwin, p.vwinT, p.selmask, p.o_win, blockIdx.x, gridDim.x);
    xcd_barrier(bar);
    p_gemm(v, p.hid_k, 256, p.cmp_w2_k, 64, p.kc, 64, nullptr, NCR, 64, 256);
    p_gemm(v, p.hid_v, 256, p.cmp_w2_v, 64, p.vc, 64, nullptr, NCR, 64, 256);
    xcd_barrier(bar);
    p_cmp_attn_bf(v, p.q_bf, p.kc, p.vc, p.o_cmp, p.selmask);
    xcd_barrier(bar);
    at::p_attn64<0>(lds + 1024, p.q_bf, p.kslc, p.vslcT, p.selmask, p.o_slc, blockIdx.x, gridDim.x);
    xcd_barrier(bar);
    p_mix_post_bf(v, p.gates, p.u_bf, p.cb_bf, p.o_cmp, p.o_slc, p.o_win, p.conv_w, p.g_nsa_out, p.g_conv_out, p.xn_bf  );
    xcd_barrier(bar);
    {
        pg::DenseOrder So; So.init(p.xn_bf, p.wt_mix_out, T, D, 2048u, 2048u, (int)gridDim.x, (int)blockIdx.x);
        pg::EpiF32R E{p.hbuf, D, p.x, D};
        pg::gemm_phase(glds, D, 2048u, 2048u, So, E);
    }
    xcd_barrier(bar);
    p_rmsnorm_bf(v, T, p.hbuf, D, p.g_xattn_norm, p.xn_bf, D, D);
    xcd_barrier(bar);
    {
        pg::DenseOrder So; So.init(p.xn_bf, p.wt_xq, T, D, 2048u, 2048u, (int)gridDim.x, (int)blockIdx.x);
        pg::EpiF32R E{p.xq, D, nullptr, D};
        pg::gemm_phase(glds, D, 2048u, 2048u, So, E);
    }
    xcd_barrier(bar);
    p_xattn(v, p.xq, p.xkv, p.xo_bf);
    xcd_barrier(bar);
    {
        pg::DenseOrder So; So.init(p.xo_bf, p.wt_xo, T, D, 2048u, 2048u, (int)gridDim.x, (int)blockIdx.x);
        pg::EpiF32R E{p.hbuf, D, p.hbuf, D};
        pg::gemm_phase(glds, D, 2048u, 2048u, So, E);
    }
    xcd_barrier(bar);
    p_rmsnorm(v, T, p.hbuf, D, p.g_moe_norm, p.xn, D, D);
    xcd_barrier(bar);
    p_router(v, p.xn, p.w_router, p.b_router, p.a_e, p.a_w, p.a_slot, p.counts);
    xcd_barrier(bar);
    p_moe_offsets(v, p.counts, p.pstart, p.tile_e, p.tok_buf, p.w_buf);
    xcd_barrier(bar);
    p_moe_scatter(v, p.a_e, p.a_w, p.a_slot, p.pstart, p.tok_buf, p.w_buf, p.dest_of, p.xn, p.xg);
    xcd_barrier(bar);
    {
        pg::MoeOrder<8> So; So.init(p.xg, p.wt_gu, p.tile_e, p.pstart[NE], (size_t)2048 * 2048, (int)gridDim.x, (int)blockIdx.x);
        pg::EpiSwiglu E{p.hmid, p.b_gate_up};
        pg::gemm_phase(glds, D, 2048u, 2048u, So, E);
    }
    xcd_barrier(bar);
    {
        pg::MoeOrder<4> So; So.init(p.hmid, p.wt_dn, p.tile_e, p.pstart[NE], (size_t)1024 * 2048, (int)gridDim.x, (int)blockIdx.x);
        pg::EpiDownScale E{p.out_a, p.b_down, p.w_buf};
        pg::gemm_phase(glds, DFF, 2048u, 2048u, So, E);
    }
    xcd_barrier(bar);
    p_final(v, p.hbuf, p.out_a, p.dest_of, p.g_final, p.out);
}
__global__ void k_fail(float* out, int n) { const int i = blockIdx.x * 256 + threadIdx.x; if (i < n) out[i] = __builtin_nanf(""); }
}

extern "C" void kernel_launch(void* const* d_in, const int* in_sizes, int n_in, void* d_out, int out_size, void* d_ws, size_t ws_size, hipStream_t stream) {
    Params p{};
    p.x = (const float*)d_in[0]; p.mem = (const float*)d_in[1]; p.positions = (const int*)d_in[2];
    const float** fp = &p.g_mix_norm;
    for (int i = 0; i < 27; ++i) fp[i] = (const float*)d_in[3 + i];
    p.out = (float*)d_out;

    char* ws = (char*)d_ws;
    size_t off = 0;
    auto take = [&](size_t bytes) { char* q = ws + off; off += (bytes + 255) & ~(size_t)255; return q; };
    p.bar = (unsigned*)take(XCD_BAR_WORDS * 4);
    p.counts = (int*)take(NE * 4);
    const size_t zero_bytes = off;
    p.pstart = (int*)take((NE + 1) * 4);
    p.tile_e = (int*)take(NTILE * 4);
    p.a_e = (int*)take(NA * 4);
    p.a_w = (float*)take(NA * 4);
    p.a_slot = (int*)take(NA * 4);
    p.dest_of = (int*)take(NA * 4);
    p.tok_buf = (int*)take(PMAX * 4);
    p.w_buf = (float*)take(PMAX * 4);
    p.selmask = (unsigned*)take((size_t)NB * 2 * S * 4);
    p.hid_k = (float*)take((size_t)NCR * 256 * 4);
    p.hid_v = (float*)take((size_t)NCR * 256 * 4);
    p.kc = (float*)take((size_t)NCR * 64 * 4);
    p.vc = (float*)take((size_t)NCR * 64 * 4);
    p.memn = (float*)take((size_t)NB * NMEM * D * 4);
    p.xkv = (float*)take((size_t)NB * NMEM * 2048 * 4);
    p.hbuf = (float*)take((size_t)T * D * 4);
    char* r14 = take((size_t)T * D * 4 + (size_t)3 * T * 512 * 4);
    p.xn = (float*)r14;
    p.o_cmp = (float*)(r14 + (size_t)T * D * 4);
    p.o_slc = p.o_cmp + (size_t)T * 512;
    p.o_win = p.o_slc + (size_t)T * 512;
    p.xq = p.o_cmp;
    p.proj = (float*)take((size_t)T * INC * 4);
    p.xo = p.proj;
    p.xg = (unsigned short*)p.proj;
    p.out_a = (unsigned short*)p.proj;
    p.hmid = (unsigned short*)take((size_t)PMAX * DFF * 2);
    p.wt_gu = (unsigned short*)take((size_t)NE * 2048 * D * 2);
    p.wt_dn = (unsigned short*)take((size_t)NE * D * DFF * 2);
    p.q_bf = (unsigned short*)take((size_t)T * 512 * 2);
    p.kcmp = (unsigned short*)take((size_t)T * 128 * 2 * 4); p.vcmp = p.kcmp + (size_t)T * 128; p.kslc = p.vcmp + (size_t)T * 128; p.kwin = p.kslc + (size_t)T * 128;
    p.vslcT = (unsigned short*)take((size_t)T * 128 * 2 * 2); p.vwinT = p.vslcT + (size_t)T * 128;
    p.u_bf = (unsigned short*)take((size_t)T * 512 * 2); p.cb_bf = (unsigned short*)take((size_t)T * 512 * 2);
    p.gates = (float*)take((size_t)T * 24 * 4); p.cosT = (float*)take((size_t)T * 32 * 4); p.sinT = (float*)take((size_t)T * 32 * 4);
    p.xn_bf = (unsigned short*)take((size_t)T * D * 2);
    p.memn_bf = (unsigned short*)take((size_t)NB * NMEM * D * 2);
    p.xo_bf = (unsigned short*)take((size_t)T * D * 2);
    p.wt_mix_in = (unsigned short*)take((size_t)3072 * D * 2);
    p.wt_xkv = (unsigned short*)take((size_t)2048 * D * 2);
    p.wt_mix_out = (unsigned short*)take((size_t)D * D * 2);
    p.wt_xq = (unsigned short*)take((size_t)D * D * 2);
    p.wt_xo = (unsigned short*)take((size_t)D * D * 2);

    static int grid = 0;
    if (grid == 0) {
        int dev = 0, cus = 0;
        if (hipGetDevice(&dev) != hipSuccess || hipDeviceGetAttribute(&cus, hipDeviceAttributeMultiprocessorCount, dev) != hipSuccess) cus = -1;
        if (hipFuncSetAttribute((const void*)mega_fwd, hipFuncAttributeMaxDynamicSharedMemorySize, LDS_BYTES) != hipSuccess) cus = -1;
        int per_cu = 0;
        if (cus > 0 && (hipOccupancyMaxActiveBlocksPerMultiprocessor(&per_cu, (const void*)mega_fwd, 512, LDS_BYTES) != hipSuccess || per_cu < 1)) cus = -1;
        (void)hipGetLastError();
        grid = cus > 0 ? cus : -1;
    }
    if (grid < 0 || off > ws_size) { k_fail<<<(out_size + 255) / 256, 256, 0, stream>>>((float*)d_out, out_size); return; }
    (void)hipMemsetAsync(d_ws, 0, zero_bytes, stream);
    hipLaunchKernelGGL(mega_fwd, dim3(grid), dim3(512), LDS_BYTES, stream, p);
}
```

```cpp
#include <hip/hip_runtime.h>
#include <hip/hip_bf16.h>
#include <stdint.h>
#include <cstdio>

#define XB_TMO      128
#define XB_XCNT(j)  (256  + 64 * (j))
#define XB_XSUB(j)  (1280 + 64 * (j))
#define XB_XGEN(j)  (2304 + 64 * (j))
#define XB_TOP      3328
#define XB_TOPGEN   3392
#define XCD_BAR_WORDS 3456
#define XB_SPIN_CAP (1u << 18)
#define LAS __attribute__((address_space(3)))

__device__ __forceinline__ unsigned xb_ld(unsigned* p)              { return __hip_atomic_load(p, __ATOMIC_RELAXED, __HIP_MEMORY_SCOPE_AGENT); }
__device__ __forceinline__ unsigned xb_add(unsigned* p, unsigned v) { return __hip_atomic_fetch_add(p, v, __ATOMIC_RELAXED, __HIP_MEMORY_SCOPE_AGENT); }
__device__ __forceinline__ unsigned xb_xcc_id() { return (unsigned)__builtin_amdgcn_s_getreg((3 << 11) | 20) & 0xFu; }
#define XB_SPIN(cond, bar) do { unsigned _sp = 0; while (cond) { __builtin_amdgcn_s_sleep(1); \
    if ((++_sp & 255u) == 0u) { if (xb_ld(&(bar)[XB_TMO])) break; if (_sp > XB_SPIN_CAP) { atomicAdd(&(bar)[XB_TMO], 1u); break; } } } } while (0)

struct XcdBarrier {
    unsigned* bar; unsigned x;
    volatile LAS unsigned* st;
};

__device__ __forceinline__ XcdBarrier xcd_barrier_post(unsigned* bar, volatile LAS unsigned* st) {
    XcdBarrier b; b.bar = bar; b.x = xb_xcc_id(); b.st = st;
    if (threadIdx.x == 0) (void)xb_add(&bar[XB_XCNT(b.x)], 1u);
    return b;
}
__device__ __forceinline__ void xcd_barrier_complete(unsigned* bar, unsigned x, unsigned& nloc, unsigned& nx) {
    const unsigned G = gridDim.x * gridDim.y * gridDim.z;
    unsigned sum, cnt, mine, sp = 0u;
    for (;;) {
        sum = 0u; cnt = 0u; mine = 0u;
#pragma unroll
        for (unsigned j = 0; j < 16; ++j) { const unsigned c = xb_ld(&bar[XB_XCNT(j)]); sum += c; cnt += (c > 0u) ? 1u : 0u; mine = (j == x) ? c : mine; }
        if (sum == G) break;
        __builtin_amdgcn_s_sleep(1);
        if ((++sp & 255u) == 0u) { if (xb_ld(&bar[XB_TMO])) break; if (sp > XB_SPIN_CAP) { atomicAdd(&bar[XB_TMO], 1u); break; } }
    }
    nloc = mine > 0u ? mine : 1u; nx = cnt > 0u ? cnt : 1u;
}

__device__ __forceinline__ void xcd_barrier(const XcdBarrier& b) {
    asm volatile("s_waitcnt vmcnt(0)" ::: "memory");
    __syncthreads();
    if (threadIdx.x == 0) {
        unsigned* bar = b.bar;
        __builtin_amdgcn_s_waitcnt(0);
        unsigned nloc = b.st[0], nx = b.st[1];
        if (nloc == 0u) { xcd_barrier_complete(bar, b.x, nloc, nx); b.st[0] = nloc; b.st[1] = nx; }
        const unsigned old = xb_add(&bar[XB_XSUB(b.x)], 1u);
        const unsigned gen = old / nloc;
        if (old + 1u == (gen + 1u) * nloc) {
            __builtin_amdgcn_fence(__ATOMIC_RELEASE, "agent");
            asm volatile("s_waitcnt vmcnt(0)" ::: "memory");
            const unsigned og = xb_add(&bar[XB_TOP], 1u);
            const unsigned tg = og / nx;
            if (og + 1u == (tg + 1u) * nx) xb_add(&bar[XB_TOPGEN], 1u);
            else XB_SPIN(xb_ld(&bar[XB_TOPGEN]) == tg, bar);
            __builtin_amdgcn_fence(__ATOMIC_ACQUIRE, "agent");
            xb_add(&bar[XB_XGEN(b.x)], 1u);
            asm volatile("s_waitcnt vmcnt(0)" ::: "memory");
        } else {
            XB_SPIN(xb_ld(&bar[XB_XGEN(b.x)]) == gen, bar);
            __builtin_amdgcn_fence(__ATOMIC_ACQUIRE, "agent");
            asm volatile("s_waitcnt vmcnt(0)" ::: "memory");
        }
    }
    __syncthreads();
}


namespace {
constexpr int D = 1024, NB = 8, S = 2048, T = NB * S, NMEM = 256;
constexpr int INC = 2840;
constexpr int C_Q = 0, C_KC = 512, C_VC = 640, C_KS = 768, C_VS = 896, C_KW = 1024, C_VW = 1152, C_GL = 1280, C_CH = 1304, C_CB = 1816, C_CC = 2328;
constexpr int NC = 127, NCR = NB * NC * 2;
constexpr int NE = 32, TOPK = 4, DFF = 1024, NA = T * TOPK;
constexpr int MT = 256;
constexpr int PMAX = NA + NE * MT, NTILE = PMAX / MT;
constexpr int LDS_BYTES = 144 * 1024, VB_LDS = 40960;
constexpr float QS = 0.125f * 1.4426950408889634f;

__device__ __forceinline__ int opaque_tid() { int t = threadIdx.x; asm volatile("" : "+v"(t)); return t; }
__device__ __forceinline__ float wave_sum(float v) { for (int o = 32; o > 0; o >>= 1) v += __shfl_xor(v, o); return v; }
__device__ __forceinline__ float wave_max(float v) { for (int o = 32; o > 0; o >>= 1) v = fmaxf(v, __shfl_xor(v, o)); return v; }

namespace pg { __device__ __forceinline__ unsigned cvt_pk_bf16(float lo, float hi); __device__ __forceinline__ unsigned cvt_pk_bf16_acc(float lo, float hi); }
struct VB { int vb, nvb, tid; char* lds; };
#define VB_ITEMS(n) for (int _it = 0, item = v.vb; _it < ((n) + v.nvb - 1) / v.nvb; ++_it, item += v.nvb)

__device__ __forceinline__ void p_rmsnorm(const VB& v, int rows, const float* __restrict__ in, int ldi, const float* __restrict__ g, float* __restrict__ out, int ldo, int W) {
    float* red = (float*)v.lds;
    VB_ITEMS(rows) {
        const bool act = item < rows;
        const float* r = in + (size_t)(act ? item : 0) * ldi;
        float ss = 0.f;
        for (int i = v.tid; i < W; i += 256) { float x = r[i]; ss += x * x; }
        ss = wave_sum(ss);
        __syncthreads();
        if ((v.tid & 63) == 0) red[v.tid >> 6] = ss;
        __syncthreads();
        ss = red[0] + red[1] + red[2] + red[3];
        const float rs = rsqrtf(ss / (float)W + 1e-5f);
        if (act) { float* o = out + (size_t)item * ldo; for (int i = v.tid; i < W; i += 256) o[i] = r[i] * rs * g[i]; }
    }
}

__device__ __forceinline__ unsigned short f2bf_rne(float f) { unsigned u = __float_as_uint(f); u += 0x7FFFu + ((u >> 16) & 1u); return (unsigned short)(u >> 16); }
__device__ __forceinline__ void p_rmsnorm_bf(const VB& v, int rows, const float* __restrict__ in, int ldi, const float* __restrict__ g, unsigned short* __restrict__ out, int ldo, int W) {
    float* red = (float*)v.lds;
    VB_ITEMS(rows) {
        const bool act = item < rows;
        const float* r = in + (size_t)(act ? item : 0) * ldi;
        float ss = 0.f;
        for (int i = v.tid; i < W; i += 256) { float x = r[i]; ss += x * x; }
        ss = wave_sum(ss);
        __syncthreads();
        if ((v.tid & 63) == 0) red[v.tid >> 6] = ss;
        __syncthreads();
        ss = red[0] + red[1] + red[2] + red[3];
        const float rs = rsqrtf(ss / (float)W + 1e-5f);
        if (act) { unsigned short* o = out + (size_t)item * ldo; for (int i = v.tid; i < W; i += 256) o[i] = f2bf_rne(r[i] * rs * g[i]); }
    }
}

template <int NACC, class AL, class BL>
__device__ __forceinline__ void gemm_tile_f32(int tid, float (&acc)[NACC][4][4], int K, AL al, BL bl, float (*As)[68], float (*Bs)[NACC * 64 + 4]) {
    const int tx = tid & 15, ty = tid >> 4;
    const int ar = tid >> 2, ak = (tid & 3) * 4;
    const int bk = tid >> 4, bc = (tid & 15) * 4;
#pragma unroll
    for (int w = 0; w < NACC; ++w)
#pragma unroll
        for (int i = 0; i < 4; ++i)
#pragma unroll
            for (int j = 0; j < 4; ++j) acc[w][i][j] = 0.f;
    for (int k0 = 0; k0 < K; k0 += 16) {
        const float4 a = al(ar, k0 + ak);
        float4 b[NACC];
#pragma unroll
        for (int w = 0; w < NACC; ++w) b[w] = bl(w, k0 + bk, bc);
        __syncthreads();
        As[ak + 0][ar] = a.x; As[ak + 1][ar] = a.y; As[ak + 2][ar] = a.z; As[ak + 3][ar] = a.w;
#pragma unroll
        for (int w = 0; w < NACC; ++w) *(float4*)&Bs[bk][w * 64 + bc] = b[w];
        __syncthreads();
#pragma unroll
        for (int kk = 0; kk < 16; ++kk) {
            const float4 av = *(const float4*)&As[kk][ty * 4];
            const float aa[4] = {av.x, av.y, av.z, av.w};
#pragma unroll
            for (int w = 0; w < NACC; ++w) {
                const float4 bv = *(const float4*)&Bs[kk][w * 64 + tx * 4];
                const float bb[4] = {bv.x, bv.y, bv.z, bv.w};
#pragma unroll
                for (int i = 0; i < 4; ++i)
#pragma unroll
                    for (int j = 0; j < 4; ++j) acc[w][i][j] += aa[i] * bb[j];
            }
        }
    }
}

__device__ __forceinline__ void p_gemm(const VB& v, const float* __restrict__ A, int lda, const float* __restrict__ Bm, int ldb, float* C, int ldc, const float* res, int M, int N, int K) {
    float (*As)[68] = (float (*)[68])v.lds;
    float (*Bs)[68] = (float (*)[68])(v.lds + 16 * 68 * 4);
    const int nx = (N + 63) / 64, ny = (M + 63) / 64, nt = nx * ny;
    VB_ITEMS(nt) {
        const bool act = item < nt;
        const int row0 = act ? (item / nx) * 64 : M, col0 = act ? (item % nx) * 64 : N;
        float acc[1][4][4];
        auto al = [&](int r, int k) -> float4 { const int row = row0 + r; return row < M ? *(const float4*)(A + (size_t)row * lda + k) : make_float4(0.f, 0.f, 0.f, 0.f); };
        auto bl = [&](int, int k, int c) -> float4 { const int col = col0 + c; return col < N ? *(const float4*)(Bm + (size_t)k * ldb + col) : make_float4(0.f, 0.f, 0.f, 0.f); };
        gemm_tile_f32<1>(v.tid, acc, K, al, bl, As, Bs);
        const int tx = v.tid & 15, ty = v.tid >> 4;
#pragma unroll
        for (int i = 0; i < 4; ++i) {
            const int row = row0 + ty * 4 + i;
            if (row >= M) continue;
#pragma unroll
            for (int j = 0; j < 4; ++j) {
                const int col = col0 + tx * 4 + j;
                if (col >= N) continue;
                float x = acc[0][i][j];
                if (res) x += res[(size_t)row * ldc + col];
                C[(size_t)row * ldc + col] = x;
            }
        }
    }
}

__device__ __forceinline__ void p_rope(const VB& v, float* __restrict__ proj, const int* __restrict__ pos) {
    VB_ITEMS(T) {
        if (item >= T) continue;
        const int t = item;
        const float p = (float)pos[t];
        float* r = proj + (size_t)t * INC;
        for (int i = v.tid; i < 448; i += 256) {
            const int hd = i >> 5, f = i & 31;
            int col;
            if (hd < 8) col = C_Q + hd * 64; else if (hd < 10) col = C_KC + (hd - 8) * 64; else if (hd < 12) col = C_KS + (hd - 10) * 64; else col = C_KW + (hd - 12) * 64;
            const float inv = powf(10000.f, -(float)f / 32.f);
            const float ang = p * inv;
            const float c = cosf(ang), s = sinf(ang);
            const float t1 = r[col + f], t2 = r[col + 32 + f];
            r[col + f] = t1 * c - t2 * s;
            r[col + 32 + f] = t2 * c + t1 * s;
        }
    }
}

__device__ __forceinline__ float gelu_tanh(float x) { const float u = 0.7978845608028654f * (x + 0.044715f * x * x * x); return 0.5f * x * (1.f + tanhf(u)); }
__device__ __forceinline__ void p_cmp1(const VB& v, const float* __restrict__ proj, int colbase, const float* __restrict__ pos, const float* __restrict__ w1, const float* __restrict__ b1, float* __restrict__ hid) {
    float (*As)[68] = (float (*)[68])v.lds;
    float (*Bs)[68] = (float (*)[68])(v.lds + 16 * 68 * 4);
    const int nx = 4, ny = (NCR + 63) / 64, nt = nx * ny;
    VB_ITEMS(nt) {
        const bool act = item < nt;
        const int row0 = act ? (item / nx) * 64 : NCR, col0 = act ? (item % nx) * 64 : 0;
        float acc[1][4][4];
        auto al = [&](int r, int k) -> float4 {
            const int row = row0 + r; if (row >= NCR) return make_float4(0.f, 0.f, 0.f, 0.f);
            const int g = row & 1, bc = row >> 1, c = bc % NC, b = bc / NC, l = k >> 6, d = k & 63;
            const float4 x = *(const float4*)(proj + (size_t)(b * S + 16 * c + l) * INC + colbase + g * 64 + d);
            const float4 pe = *(const float4*)(pos + k);
            return make_float4(x.x + pe.x, x.y + pe.y, x.z + pe.z, x.w + pe.w);
        };
        auto bl = [&](int, int k, int c) -> float4 { return *(const float4*)(w1 + (size_t)k * 256 + col0 + c); };
        gemm_tile_f32<1>(v.tid, acc, 2048, al, bl, As, Bs);
        const int tx = v.tid & 15, ty = v.tid >> 4;
#pragma unroll
        for (int i = 0; i < 4; ++i) {
            const int row = row0 + ty * 4 + i;
            if (row >= NCR) continue;
#pragma unroll
            for (int j = 0; j < 4; ++j) { const int col = col0 + tx * 4 + j; hid[(size_t)row * 256 + col] = gelu_tanh(acc[0][i][j] + b1[col]); }
        }
    }
}

__device__ __forceinline__ void st_out(float* p, float x) { *p = x; }
__device__ __forceinline__ void st_out(unsigned short* p, float x) { *p = f2bf_rne(x); }
template <int DH, class KeyF, class OutT>
__device__ __forceinline__ void wave_attend(const float* q, int ncand, KeyF keyf, float* sc, OutT* out, int lane) {
    float m = -3.0e38f;
    for (int idx = lane; idx < ncand; idx += 64) {
        const float *kp, *vp;
        float s = -3.0e38f;
        if (keyf(idx, kp, vp)) {
            s = 0.f;
#pragma unroll 4
            for (int d = 0; d < DH; d += 4) { const float4 kv = *(const float4*)(kp + d); s += q[d] * kv.x + q[d + 1] * kv.y + q[d + 2] * kv.z + q[d + 3] * kv.w; }
        }
        sc[idx] = s;
        m = fmaxf(m, s);
    }
    m = wave_max(m);
    float sum = 0.f;
    for (int idx = lane; idx < ncand; idx += 64) { const float s = sc[idx]; const float p = (s > -1.0e38f) ? __expf(s - m) : 0.f; sc[idx] = p; sum += p; }
    sum = wave_sum(sum);
    const float inv = (m > -1.0e38f) ? 1.f / sum : 0.f;
    for (int idx = lane; idx < ncand; idx += 64) sc[idx] *= inv;
    __builtin_amdgcn_s_waitcnt(0);
    float o[DH / 64];
#pragma unroll
    for (int i = 0; i < DH / 64; ++i) o[i] = 0.f;
    for (int idx = 0; idx < ncand; ++idx) {
        const float p = sc[idx];
        if (p == 0.f) continue;
        const float *kp, *vp;
        keyf(idx, kp, vp);
#pragma unroll
        for (int i = 0; i < DH / 64; ++i) o[i] += p * vp[lane + 64 * i];
    }
#pragma unroll
    for (int i = 0; i < DH / 64; ++i) st_out(out + lane + 64 * i, o[i]);
}

__device__ __forceinline__ void p_cmp_attn(const VB& v, const float* __restrict__ proj, const float* __restrict__ kc, const float* __restrict__ vc,
                                           float* __restrict__ o_cmp, unsigned* __restrict__ selmask) {
    float (*qs)[64] = (float (*)[64])v.lds;
    float (*ps)[128] = (float (*)[128])(v.lds + 1024);
    float* imps = (float*)(v.lds + 1024 + 2048);
    VB_ITEMS(T * 2) {
        const int g = item & 1, t = item >> 1, b = t / S, s = t % S;
        const int w = v.tid >> 6, lane = v.tid & 63, h = g * 4 + w;
        __syncthreads();
        qs[w][lane] = proj[(size_t)t * INC + C_Q + h * 64 + lane] * 0.125f;
        ps[w][lane] = 0.f; ps[w][lane + 64] = 0.f;
        __syncthreads();
        auto keyf = [&](int c, const float*& kp, const float*& vp) -> bool {
            kp = kc + (size_t)((b * NC + c) * 2 + g) * 64; vp = vc + (size_t)((b * NC + c) * 2 + g) * 64;
            return 16 * c + 31 <= s;
        };
        wave_attend<64>(qs[w], NC, keyf, ps[w], o_cmp + (size_t)t * 512 + h * 64, lane);
        __syncthreads();
        if (v.tid < 32) {
            const int j = v.tid;
            float imp = 0.f;
            for (int hh = 0; hh < 4; ++hh)
                for (int c = 4 * j - 1; c <= 4 * j + 3; ++c) {
                    if (c < 0 || c >= NC) continue;
                    const float ov = (c == 4 * j - 1 || c == 4 * j + 3) ? 0.5f : 1.0f;
                    imp += ps[hh][c] * ov;
                }
            const int cur = s >> 6;
            if (j == 0 || j == cur || j == cur - 1) imp = 1e30f; else if (j > cur) imp = -1e30f;
            imps[j] = imp;
        }
        __syncthreads();
        if (v.tid < 64) {
            const int j = v.tid & 31;
            const float mine = imps[j];
            int rank = 0;
            for (int i = 0; i < 32; ++i) { const float x = imps[i]; rank += (x > mine || (x == mine && i < j)) ? 1 : 0; }
            const unsigned long long bal = __ballot(rank < 16 && v.tid < 32);
            if (v.tid == 0) selmask[(size_t)(b * 2 + g) * S + s] = (unsigned)(bal & 0xffffffffull);
        }
    }
}

template <int MODE>
__device__ __forceinline__ void p_nsa_attn(const VB& v, const float* __restrict__ proj, const unsigned* __restrict__ selmask, float* __restrict__ outp) {
    float (*qs)[64] = (float (*)[64])v.lds;
    float (*scs)[2048] = (float (*)[2048])(v.lds + 1024);
    VB_ITEMS(T * 2) {
        const int g = item & 1, t = item >> 1, b = t / S, s = t % S;
        const int w = v.tid >> 6, lane = v.tid & 63, h = g * 4 + w;
        qs[w][lane] = proj[(size_t)t * INC + C_Q + h * 64 + lane] * 0.125f;
        __builtin_amdgcn_s_waitcnt(0);
        if (MODE == 0) {
            const unsigned mask = selmask[(size_t)(b * 2 + g) * S + s];
            const int ncand = ((s >> 6) + 1) * 64;
            auto keyf = [&](int idx, const float*& kp, const float*& vp) -> bool {
                const float* r = proj + (size_t)(b * S + idx) * INC + g * 64;
                kp = r + C_KS; vp = r + C_VS;
                return idx <= s && ((mask >> (idx >> 6)) & 1u);
            };
            wave_attend<64>(qs[w], ncand, keyf, scs[w], outp + (size_t)t * 512 + h * 64, lane);
        } else {
            const int lo = s - 511 > 0 ? s - 511 : 0;
            const int ncand = s - lo + 1;
            auto keyf = [&](int idx, const float*& kp, const float*& vp) -> bool {
                const float* r = proj + (size_t)(b * S + lo + idx) * INC + g * 64;
                kp = r + C_KW; vp = r + C_VW;
                return true;
            };
            wave_attend<64>(qs[w], ncand, keyf, scs[w], outp + (size_t)t * 512 + h * 64, lane);
        }
    }
}

__device__ __forceinline__ void p_xattn(const VB& v, const float* __restrict__ xq, const float* __restrict__ xkv, unsigned short* __restrict__ xo) {
    float (*qs)[256] = (float (*)[256])v.lds;
    float (*scs)[256] = (float (*)[256])(v.lds + 4096);
    VB_ITEMS(T) {
        const int t = item, b = t / S, w = v.tid >> 6, lane = v.tid & 63;
        for (int i = lane; i < 256; i += 64) qs[w][i] = xq[(size_t)t * D + w * 256 + i] * 0.0625f;
        __builtin_amdgcn_s_waitcnt(0);
        auto keyf = [&](int m, const float*& kp, const float*& vp) -> bool {
            const float* r = xkv + (size_t)(b * NMEM + m) * 2048 + w * 256;
            kp = r; vp = r + 1024;
            return true;
        };
        wave_attend<256>(qs[w], NMEM, keyf, scs[w], xo + (size_t)t * D + w * 256, lane);
    }
}

__device__ __forceinline__ void p_mix_post(const VB& v, const float* __restrict__ proj, const float* __restrict__ o_cmp, const float* __restrict__ o_slc, const float* __restrict__ o_win,
                                           const float* __restrict__ conv_w, const float* __restrict__ g_nsa, const float* __restrict__ g_conv, unsigned short* __restrict__ omix) {
    float (*red)[4] = (float (*)[4])v.lds;
    VB_ITEMS(T) {
        const int t = item, s = t % S, tid = v.tid;
        const float* r = proj + (size_t)t * INC;
        float on[2], oc[2], ssn = 0.f, ssc = 0.f;
#pragma unroll
        for (int e = 0; e < 2; ++e) {
            const int c = tid + 256 * e, h = c >> 6;
            const float g0 = 1.f / (1.f + __expf(-r[C_GL + h * 3 + 0])), g1 = 1.f / (1.f + __expf(-r[C_GL + h * 3 + 1])), g2 = 1.f / (1.f + __expf(-r[C_GL + h * 3 + 2]));
            on[e] = g0 * o_cmp[(size_t)t * 512 + c] + g1 * o_slc[(size_t)t * 512 + c] + g2 * o_win[(size_t)t * 512 + c];
            ssn += on[e] * on[e];
            float y = 0.f;
#pragma unroll
            for (int k = 0; k < 3; ++k) {
                const int sp = s - 2 + k;
                if (sp < 0) continue;
                const float* rp = proj + (size_t)(t - 2 + k) * INC;
                y += conv_w[k * 512 + c] * (rp[C_CC + c] * rp[C_CH + c]);
            }
            oc[e] = r[C_CB + c] * y;
            ssc += oc[e] * oc[e];
        }
        ssn = wave_sum(ssn); ssc = wave_sum(ssc);
        __syncthreads();
        if ((tid & 63) == 0) { red[0][tid >> 6] = ssn; red[1][tid >> 6] = ssc; }
        __syncthreads();
        ssn = red[0][0] + red[0][1] + red[0][2] + red[0][3];
        ssc = red[1][0] + red[1][1] + red[1][2] + red[1][3];
        const float rn = rsqrtf(ssn / 512.f + 1e-5f), rc = rsqrtf(ssc / 512.f + 1e-5f);
#pragma unroll
        for (int e = 0; e < 2; ++e) {
            const int c = tid + 256 * e;
            omix[(size_t)t * D + c] = f2bf_rne(on[e] * rn * g_nsa[c]);
            omix[(size_t)t * D + 512 + c] = f2bf_rne(oc[e] * rc * g_conv[c]);
        }
    }
}


__device__ __forceinline__ float bfu(unsigned short b) { return __uint_as_float(((unsigned)b) << 16); }
__device__ __forceinline__ void p_rope_table(int gtid, int gn, const int* __restrict__ pos, float* __restrict__ cosT, float* __restrict__ sinT) {
    for (int i = gtid; i < T * 32; i += gn) {
        const int t = i >> 5, f = i & 31;
        const float inv = powf(10000.f, -(float)f / 32.f);
        const float ang = (float)pos[t] * inv;
        cosT[i] = cosf(ang); sinT[i] = sinf(ang);
    }
}
template <int DH, class ValidF, class KRow, class VGet, class OutT>
__device__ __forceinline__ void wave_attend_bf(const float* q, int ncand, ValidF valid, KRow krow, VGet vget, float* sc, OutT* out, int lane) {
    float m = -3.0e38f;
    for (int idx = lane; idx < ncand; idx += 64) {
        float s = -3.0e38f;
        if (valid(idx)) {
            const unsigned short* kp = krow(idx);
            s = 0.f;
#pragma unroll 2
            for (int d = 0; d < DH; d += 8) {
                const uint4 kv = *(const uint4*)(kp + d);
                s += q[d] * __uint_as_float(kv.x << 16) + q[d + 1] * __uint_as_float(kv.x & 0xffff0000u) + q[d + 2] * __uint_as_float(kv.y << 16) + q[d + 3] * __uint_as_float(kv.y & 0xffff0000u)
                   + q[d + 4] * __uint_as_float(kv.z << 16) + q[d + 5] * __uint_as_float(kv.z & 0xffff0000u) + q[d + 6] * __uint_as_float(kv.w << 16) + q[d + 7] * __uint_as_float(kv.w & 0xffff0000u);
            }
        }
        sc[idx] = s;
        m = fmaxf(m, s);
    }
    m = wave_max(m);
    float sum = 0.f;
    for (int idx = lane; idx < ncand; idx += 64) { const float s = sc[idx]; const float p = (s > -1.0e38f) ? exp2f(s - m) : 0.f; sc[idx] = p; sum += p; }
    sum = wave_sum(sum);
    const float inv = (m > -1.0e38f) ? 1.f / sum : 0.f;
    for (int idx = lane; idx < ncand; idx += 64) sc[idx] *= inv;
    __builtin_amdgcn_s_waitcnt(0);
    float o[DH / 64];
#pragma unroll
    for (int i = 0; i < DH / 64; ++i) o[i] = 0.f;
    for (int idx = 0; idx < ncand; ++idx) {
        const float p = sc[idx];
        if (p == 0.f) continue;
#pragma unroll
        for (int i = 0; i < DH / 64; ++i) o[i] += p * vget(idx, lane + 64 * i);
    }
#pragma unroll
    for (int i = 0; i < DH / 64; ++i) st_out(out + lane + 64 * i, o[i]);
}

__device__ __forceinline__ void p_cmp1_bf(const VB& v, const unsigned short* __restrict__ src, const float* __restrict__ pos, const float* __restrict__ w1, const float* __restrict__ b1, float* __restrict__ hid) {
    float (*As)[68] = (float (*)[68])v.lds;
    float (*Bs)[68] = (float (*)[68])(v.lds + 16 * 68 * 4);
    const int nx = 4, ny = (NCR + 63) / 64, nt = nx * ny;
    VB_ITEMS(nt) {
        const bool act = item < nt;
        const int row0 = act ? (item / nx) * 64 : NCR, col0 = act ? (item % nx) * 64 : 0;
        float acc[1][4][4];
        auto al = [&](int r, int k) -> float4 {
            const int row = row0 + r; if (row >= NCR) return make_float4(0.f, 0.f, 0.f, 0.f);
            const int g = row & 1, bc = row >> 1, c = bc % NC, b = bc / NC, l = k >> 6, d = k & 63;
            const uint2 x = *(const uint2*)(src + ((size_t)(b * 2 + g) * S + 16 * c + l) * 64 + d);
            const float4 pe = *(const float4*)(pos + k);
            return make_float4(__uint_as_float(x.x << 16) + pe.x, __uint_as_float(x.x & 0xffff0000u) + pe.y, __uint_as_float(x.y << 16) + pe.z, __uint_as_float(x.y & 0xffff0000u) + pe.w);
        };
        auto bl = [&](int, int k, int c) -> float4 { return *(const float4*)(w1 + (size_t)k * 256 + col0 + c); };
        gemm_tile_f32<1>(v.tid, acc, 2048, al, bl, As, Bs);
        const int tx = v.tid & 15, ty = v.tid >> 4;
#pragma unroll
        for (int i = 0; i < 4; ++i) {
            const int row = row0 + ty * 4 + i;
            if (row >= NCR) continue;
#pragma unroll
            for (int j = 0; j < 4; ++j) { const int col = col0 + tx * 4 + j; hid[(size_t)row * 256 + col] = gelu_tanh(acc[0][i][j] + b1[col]); }
        }
    }
}
__device__ __forceinline__ void p_cmp_attn_bf(const VB& v, const unsigned short* __restrict__ qb, const float* __restrict__ kc, const float* __restrict__ vc,
                                              float* __restrict__ o_cmp, unsigned* __restrict__ selmask) {
    float (*qs)[64] = (float (*)[64])v.lds;
    float (*ps)[128] = (float (*)[128])(v.lds + 1024);
    float* imps = (float*)(v.lds + 1024 + 2048);
    VB_ITEMS(T * 2) {
        const int g = item & 1, t = item >> 1, b = t / S, s = t % S;
        const int w = v.tid >> 6, lane = v.tid & 63, h = g * 4 + w;
        __syncthreads();
        qs[w][lane] = bfu(qb[(size_t)t * 512 + h * 64 + lane]);
        ps[w][lane] = 0.f; ps[w][lane + 64] = 0.f;
        __syncthreads();
        {
            float m = -3.0e38f;
            float* sc = ps[w];
            for (int c = lane; c < NC; c += 64) {
                float sv = -3.0e38f;
                if (16 * c + 31 <= s) { const float* kp = kc + (size_t)((b * NC + c) * 2 + g) * 64; sv = 0.f; for (int d = 0; d < 64; ++d) sv += qs[w][d] * kp[d]; }
                sc[c] = sv; m = fmaxf(m, sv);
            }
            m = wave_max(m);
            float sum = 0.f;
            for (int c = lane; c < NC; c += 64) { const float sv = sc[c]; const float pp = (sv > -1.0e38f) ? exp2f(sv - m) : 0.f; sc[c] = pp; sum += pp; }
            sum = wave_sum(sum);
            const float inv = (m > -1.0e38f) ? 1.f / sum : 0.f;
            for (int c = lane; c < NC; c += 64) sc[c] *= inv;
            __builtin_amdgcn_s_waitcnt(0);
            float o = 0.f;
            for (int c = 0; c < NC; ++c) { const float pp = sc[c]; if (pp != 0.f) o += pp * vc[(size_t)((b * NC + c) * 2 + g) * 64 + lane]; }
            o_cmp[(size_t)t * 512 + h * 64 + lane] = o;
        }
        __syncthreads();
        if (v.tid < 32) {
            const int j = v.tid;
            float imp = 0.f;
            for (int hh = 0; hh < 4; ++hh)
                for (int c = 4 * j - 1; c <= 4 * j + 3; ++c) {
                    if (c < 0 || c >= NC) continue;
                    const float ov = (c == 4 * j - 1 || c == 4 * j + 3) ? 0.5f : 1.0f;
                    imp += ps[hh][c] * ov;
                }
            const int cur = s >> 6;
            if (j == 0 || j == cur || j == cur - 1) imp = 1e30f; else if (j > cur) imp = -1e30f;
            imps[j] = imp;
        }
        __syncthreads();
        if (v.tid < 64) {
            const int j = v.tid & 31;
            const float mine = imps[j];
            int rank = 0;
            for (int i = 0; i < 32; ++i) { const float x = imps[i]; rank += (x > mine || (x == mine && i < j)) ? 1 : 0; }
            const unsigned long long bal = __ballot(rank < 16 && v.tid < 32);
            if (v.tid == 0) selmask[(size_t)(b * 2 + g) * S + s] = (unsigned)(bal & 0xffffffffull);
        }
    }
}
template <int MODE>
__device__ __forceinline__ void p_nsa_attn_bf(const VB& v, const unsigned short* __restrict__ qb, const unsigned short* __restrict__ Kh, const unsigned short* __restrict__ VT,
                                              const unsigned* __restrict__ selmask, float* __restrict__ outp) {
    float (*qs)[64] = (float (*)[64])v.lds;
    float (*scs)[2048] = (float (*)[2048])(v.lds + 1024);
    VB_ITEMS(T * 2) {
        const int g = item & 1, t = item >> 1, b = t / S, s = t % S;
        const int w = v.tid >> 6, lane = v.tid & 63, h = g * 4 + w;
        qs[w][lane] = bfu(qb[(size_t)t * 512 + h * 64 + lane]);
        __builtin_amdgcn_s_waitcnt(0);
        const unsigned short* Kb = Kh + (size_t)(b * 2 + g) * S * 64;
        const unsigned short* Vb = VT + (size_t)(b * 2 + g) * 64 * S;
        if (MODE == 0) {
            const unsigned mask = selmask[(size_t)(b * 2 + g) * S + s];
            const int ncand = ((s >> 6) + 1) * 64;
            auto valid = [&](int idx) -> bool { return idx <= s && ((mask >> (idx >> 6)) & 1u); };
            auto krow = [&](int idx) -> const unsigned short* { return Kb + (size_t)idx * 64; };
            auto vget = [&](int idx, int d) -> float { return bfu(Vb[(size_t)d * S + idx]); };
            wave_attend_bf<64>(qs[w], ncand, valid, krow, vget, scs[w], outp + (size_t)t * 512 + h * 64, lane);
        } else {
            const int lo = s - 511 > 0 ? s - 511 : 0;
            const int ncand = s - lo + 1;
            auto valid = [&](int) -> bool { return true; };
            auto krow = [&](int idx) -> const unsigned short* { return Kb + (size_t)(lo + idx) * 64; };
            auto vget = [&](int idx, int d) -> float { return bfu(Vb[(size_t)d * S + lo + idx]); };
            wave_attend_bf<64>(qs[w], ncand, valid, krow, vget, scs[w], outp + (size_t)t * 512 + h * 64, lane);
        }
    }
}
__device__ __forceinline__ void p_mix_post_bf(const VB& v, const float* __restrict__ gates, const unsigned short* __restrict__ ub, const unsigned short* __restrict__ cbb,
                                              const float* __restrict__ o_cmp, const float* __restrict__ o_slc, const float* __restrict__ o_win,
                                              const float* __restrict__ conv_w, const float* __restrict__ g_nsa, const float* __restrict__ g_conv, unsigned short* __restrict__ omix) {
    float (*red)[4] = (float (*)[4])v.lds;
    VB_ITEMS(T) {
        const int t = item, s = t % S, tid = v.tid;
        float on[2], oc[2], ssn = 0.f, ssc = 0.f;
#pragma unroll
        for (int e = 0; e < 2; ++e) {
            const int c = tid + 256 * e, h = c >> 6;
            const float g0 = gates[(size_t)t * 24 + h * 3 + 0], g1 = gates[(size_t)t * 24 + h * 3 + 1], g2 = gates[(size_t)t * 24 + h * 3 + 2];
            on[e] = g0 * o_cmp[(size_t)t * 512 + c] + g1 * o_slc[(size_t)t * 512 + c] + g2 * o_win[(size_t)t * 512 + c];
            ssn += on[e] * on[e];
            float y = 0.f;
#pragma unroll
            for (int k = 0; k < 3; ++k) {
                const int sp = s - 2 + k;
                if (sp < 0) continue;
                y += conv_w[k * 512 + c] * bfu(ub[(size_t)(t - 2 + k) * 512 + c]);
            }
            oc[e] = bfu(cbb[(size_t)t * 512 + c]) * y;
            ssc += oc[e] * oc[e];
        }
        ssn = wave_sum(ssn); ssc = wave_sum(ssc);
        __syncthreads();
        if ((tid & 63) == 0) { red[0][tid >> 6] = ssn; red[1][tid >> 6] = ssc; }
        __syncthreads();
        ssn = red[0][0] + red[0][1] + red[0][2] + red[0][3];
        ssc = red[1][0] + red[1][1] + red[1][2] + red[1][3];
        const float rn = rsqrtf(ssn / 512.f + 1e-5f), rc = rsqrtf(ssc / 512.f + 1e-5f);
#pragma unroll
        for (int e = 0; e < 2; ++e) {
            const int c = tid + 256 * e;
            omix[(size_t)t * D + c] = f2bf_rne(on[e] * rn * g_nsa[c]);
            omix[(size_t)t * D + 512 + c] = f2bf_rne(oc[e] * rc * g_conv[c]);
        }
    }
}

__device__ __forceinline__ void p_router(const VB& v, const float* __restrict__ xn, const float* __restrict__ wr, const float* __restrict__ br,
                                         int* __restrict__ a_e, float* __restrict__ a_w, int* __restrict__ a_slot, int* __restrict__ counts) {
    VB_ITEMS(T / 4) {
        const int t = item * 4 + (v.tid >> 6), lane = v.tid & 63, e = lane & 31, half = lane >> 5;
        const float* x = xn + (size_t)t * D + half * 512;
        const float* w = wr + (size_t)half * 512 * NE + e;
        float acc = 0.f;
        for (int k = 0; k < 512; ++k) acc += x[k] * w[(size_t)k * NE];
        acc += __shfl_xor(acc, 32);
        const float logit = acc + br[e];
        int rank = 0;
        for (int i = 0; i < 32; ++i) { const float x2 = __shfl(logit, i); rank += (x2 > logit || (x2 == logit && i < e)) ? 1 : 0; }
        const float vmax = wave_max(logit);
        const bool sel = (rank < TOPK) && (lane < 32);
        const float ex = sel ? __expf(logit - vmax) : 0.f;
        const float sum = wave_sum(ex);
        if (sel) {
            const int a = t * TOPK + rank;
            a_e[a] = e; a_w[a] = ex / sum; a_slot[a] = atomicAdd(&counts[e], 1);
        }
    }
}
__device__ __forceinline__ void p_moe_offsets(const VB& v, const int* __restrict__ counts, int* __restrict__ pstart, int* __restrict__ tile_e, int* __restrict__ tok_buf, float* __restrict__ w_buf) {
    int* ps = (int*)v.lds;
    __syncthreads();
    if (v.tid == 0) { int acc = 0; for (int e = 0; e < NE; ++e) { ps[e] = acc; if (v.vb == 0) pstart[e] = acc; acc += (counts[e] + MT - 1) / MT * MT; } ps[NE] = acc; if (v.vb == 0) pstart[NE] = acc / MT; }
    __syncthreads();
    for (int tl = v.vb * 256 + v.tid; tl < NTILE; tl += v.nvb * 256) {
        const int r = tl * MT; int e = -1;
        for (int i = 0; i < NE; ++i) if (r >= ps[i] && r < ps[i + 1]) e = i;
        tile_e[tl] = e;
    }
    for (int i = v.vb * 256 + v.tid; i < PMAX; i += v.nvb * 256) { tok_buf[i] = 0; w_buf[i] = 0.f; }
}
__device__ __forceinline__ void p_moe_scatter(const VB& v, const int* __restrict__ a_e, const float* __restrict__ a_w, const int* __restrict__ a_slot, const int* __restrict__ pstart,
                                              int* __restrict__ tok_buf, float* __restrict__ w_buf, int* __restrict__ dest_of, const float* __restrict__ xn, unsigned short* __restrict__ xg) {
    const int lane = v.tid & 63, gw = v.vb * 4 + (v.tid >> 6), ngw = v.nvb * 4;
    for (int a = gw; a < NA; a += ngw) {
        const int dest = pstart[a_e[a]] + a_slot[a], t = a / TOPK;
        if (lane == 0) { tok_buf[dest] = t; w_buf[dest] = a_w[a]; dest_of[a] = dest; }
        const float* src = xn + (size_t)t * D + lane * 16;
        unsigned o[8];
#pragma unroll
        for (int i = 0; i < 4; ++i) { const float4 x = *(const float4*)(src + 4 * i); o[2 * i] = pg::cvt_pk_bf16(x.x, x.y); o[2 * i + 1] = pg::cvt_pk_bf16(x.z, x.w); }
        uint4* dst = (uint4*)(xg + (size_t)dest * D + lane * 16);
        dst[0] = make_uint4(o[0], o[1], o[2], o[3]); dst[1] = make_uint4(o[4], o[5], o[6], o[7]);
    }
}
__device__ __forceinline__ void p_moe1(const VB& v, const float* __restrict__ xn, const int* __restrict__ tok_buf, const int* __restrict__ tile_e,
                                       const float* __restrict__ wgu, const float* __restrict__ bgu, __hip_bfloat16* __restrict__ hmid) {
    float (*As)[68] = (float (*)[68])v.lds;
    float (*Bs)[132] = (float (*)[132])(v.lds + 16 * 68 * 4);
    int* toks = (int*)(v.lds + 16 * 68 * 4 + 16 * 132 * 4);
    const int nt = 16 * NTILE;
    VB_ITEMS(nt) {
        const int tl = item < nt ? item / 16 : 0, cx = item % 16;
        const int e0 = item < nt ? tile_e[tl] : -1;
        const bool act = e0 >= 0;
        const int e = act ? e0 : 0;
        const int row0 = tl * MT, col0 = cx * 64;
        __syncthreads();
        if (v.tid < MT) toks[v.tid] = act ? tok_buf[row0 + v.tid] : 0;
        __syncthreads();
        const float* W = wgu + (size_t)e * D * 2048;
        float acc[2][4][4];
        auto al = [&](int r, int k) -> float4 { return *(const float4*)(xn + (size_t)toks[r] * D + k); };
        auto bl = [&](int w, int k, int c) -> float4 { return *(const float4*)(W + (size_t)k * 2048 + w * 1024 + col0 + c); };
        gemm_tile_f32<2>(v.tid, acc, D, al, bl, As, Bs);
        if (!act) continue;
        const int tx = v.tid & 15, ty = v.tid >> 4;
#pragma unroll
        for (int i = 0; i < 4; ++i)
#pragma unroll
            for (int j = 0; j < 4; ++j) {
                const int row = row0 + ty * 4 + i, col = col0 + tx * 4 + j;
                float g = acc[0][i][j] + bgu[(size_t)e * 2048 + col], u = acc[1][i][j] + bgu[(size_t)e * 2048 + 1024 + col];
                g = fminf(g, 7.f); u = fminf(fmaxf(u, -7.f), 7.f);
                const float hm = (u + 1.f) * (g / (1.f + __expf(-1.702f * g)));
                hmid[(size_t)row * DFF + col] = __float2bfloat16(hm);
            }
    }
}
__device__ __forceinline__ void p_moe2(const VB& v, const __hip_bfloat16* __restrict__ hmid, const int* __restrict__ tile_e, const float* __restrict__ w_buf,
                                       const float* __restrict__ wd, const float* __restrict__ bd, __hip_bfloat16* __restrict__ out_a) {
    float (*As)[68] = (float (*)[68])v.lds;
    float (*Bs)[68] = (float (*)[68])(v.lds + 16 * 68 * 4);
    const int nt = 16 * NTILE;
    VB_ITEMS(nt) {
        const int tl = item < nt ? item / 16 : 0, cx = item % 16;
        const int e0 = item < nt ? tile_e[tl] : -1;
        const bool act = e0 >= 0;
        const int e = act ? e0 : 0;
        const int row0 = tl * MT, col0 = cx * 64;
        const float* W = wd + (size_t)e * DFF * D;
        float acc[1][4][4];
        auto al = [&](int r, int k) -> float4 {
            if (!act) return make_float4(0.f, 0.f, 0.f, 0.f);
            const __hip_bfloat16* p = hmid + (size_t)(row0 + r) * DFF + k;
            return make_float4(__bfloat162float(p[0]), __bfloat162float(p[1]), __bfloat162float(p[2]), __bfloat162float(p[3]));
        };
        auto bl = [&](int, int k, int c) -> float4 { return *(const float4*)(W + (size_t)k * D + col0 + c); };
        gemm_tile_f32<1>(v.tid, acc, DFF, al, bl, As, Bs);
        if (!act) continue;
        const int tx = v.tid & 15, ty = v.tid >> 4;
#pragma unroll
        for (int i = 0; i < 4; ++i)
#pragma unroll
            for (int j = 0; j < 4; ++j) {
                const int row = row0 + ty * 4 + i, col = col0 + tx * 4 + j;
                out_a[(size_t)row * D + col] = __float2bfloat16((acc[0][i][j] + bd[(size_t)e * D + col]) * w_buf[row]);
            }
    }
}
__device__ __forceinline__ void p_final(const VB& v, const float* __restrict__ h2, const unsigned short* __restrict__ out_a, const int* __restrict__ dest_of,
                                        const float* __restrict__ g, float* __restrict__ out) {
    float* red = (float*)v.lds;
    VB_ITEMS(T) {
        const int t = item, tid = v.tid;
        int d[4];
#pragma unroll
        for (int k = 0; k < 4; ++k) d[k] = dest_of[t * 4 + k];
        float x4[4], ss = 0.f;
#pragma unroll
        for (int e = 0; e < 4; ++e) {
            const int c = tid + 256 * e;
            float x = h2[(size_t)t * D + c];
#pragma unroll
            for (int k = 0; k < 4; ++k) x += __uint_as_float(((unsigned)out_a[(size_t)d[k] * D + c]) << 16);
            x4[e] = x; ss += x * x;
        }
        ss = wave_sum(ss);
        __syncthreads();
        if ((tid & 63) == 0) red[tid >> 6] = ss;
        __syncthreads();
        ss = red[0] + red[1] + red[2] + red[3];
        const float rs = rsqrtf(ss / (float)D + 1e-5f);
#pragma unroll
        for (int e = 0; e < 4; ++e) { const int c = tid + 256 * e; out[(size_t)t * D + c] = x4[e] * rs * g[c]; }
    }
}


namespace pg {
typedef unsigned short bf16_t;
typedef short bf16x8 __attribute__((ext_vector_type(8)));
typedef float f32x4 __attribute__((ext_vector_type(4)));
constexpr int BM = 256, BK = 64, HALF = 128, HTB = HALF * BK * 2, STAGE_BYTES = 8 * HTB;
__device__ __forceinline__ int lds_byte(int r, int c) { const int st = (r >> 4) * 2 + (c >> 5), rr = r & 15, cc = c & 31, ob = rr * 64 + cc * 2; return st * 1024 + (ob ^ (((ob >> 9) & 1) << 5)); }
__device__ __forceinline__ void stage_rc(int b, int& R, int& C) { const int st = b / 1024, sb = b % 1024, swz = sb ^ (((sb >> 9) & 1) << 5); R = (st >> 1) * 16 + swz / 64; C = (st & 1) * 32 + (swz % 64) / 2; }
typedef float f32x2_t __attribute__((ext_vector_type(2)));
typedef __bf16 bf16x2_t __attribute__((ext_vector_type(2)));
__device__ __forceinline__ unsigned cvt_pk_bf16_acc(float lo, float hi) { const f32x2_t v = {lo, hi}; const bf16x2_t b = __builtin_convertvector(v, bf16x2_t); return __builtin_bit_cast(unsigned, b); }
__device__ __forceinline__ unsigned cvt_pk_bf16(float lo, float hi) { unsigned r; asm volatile("v_cvt_pk_bf16_f32 %0, %1, %2" : "=v"(r) : "v"(lo), "v"(hi)); return r; }
__device__ __forceinline__ bf16_t f2bf(float f) { unsigned u = __float_as_uint(f); u += 0x7FFFu + ((u >> 16) & 1u); return (bf16_t)(u >> 16); }
__device__ __forceinline__ float bf2f(bf16_t b) { return __uint_as_float(((unsigned)b) << 16); }

struct GUnit { const char* A; const char* B; int row0, col0, aux; };

template <class Epi, class Sched>
__device__ __forceinline__ void gemm_phase(LAS unsigned char* lds, const int K, const unsigned lda_b, const unsigned ldb_b, const Sched& S, const Epi& E) {
    const int tid = opaque_tid(), wid = __builtin_amdgcn_readfirstlane(tid >> 6), lane = tid & 63, wr = wid >> 2, wc = wid & 3, fr = lane & 15, fq = lane >> 4;
    const int nt = K / BK;
    unsigned voffA[2], voffB[2];
#pragma unroll
    for (int i = 0; i < 2; ++i) { int R, C; stage_rc(tid * 16 + i * 8192, R, C); voffA[i] = (unsigned)R * lda_b + (unsigned)C * 2u; voffB[i] = (unsigned)R * ldb_b + (unsigned)C * 2u; }
    const size_t kstep = (size_t)(BK * 2);
    const size_t hstepA = (size_t)HALF * lda_b, hstepB = (size_t)HALF * ldb_b;
    const unsigned ldsw = (unsigned)wid * 1024u;
    const int aoff = lds_byte(wr * 64 + fr, fq * 8), boff = lds_byte(wc * 32 + fr, fq * 8);
#define PG8_SA(b, h) (((b) * 2 + (h)) * HTB)
#define PG8_SB(b, h) ((4 + (b) * 2 + (h)) * HTB)
#define PG8_STAGE(bufoff, gbase, voff) do { _Pragma("unroll") for (int _i = 0; _i < 2; ++_i) \
        __builtin_amdgcn_global_load_lds((const unsigned*)((const char*)(gbase) + (voff)[_i]), (LAS unsigned*)(lds + (bufoff) + ldsw + _i * 8192), 16, 0, 0); } while (0)
#define PG8_LDA(dst, b, h) do { _Pragma("unroll") for (int m = 0; m < 4; ++m) _Pragma("unroll") for (int k = 0; k < 2; ++k) dst[m][k] = *(const LAS bf16x8*)(lds + PG8_SA(b, h) + aoff + m * 2048 + k * 1024); } while (0)
#define PG8_LDB(dst, b, h) do { _Pragma("unroll") for (int n = 0; n < 2; ++n) _Pragma("unroll") for (int k = 0; k < 2; ++k) dst[n][k] = *(const LAS bf16x8*)(lds + PG8_SB(b, h) + boff + n * 2048 + k * 1024); } while (0)
#define PG8_MMA(ai, bj, At, Bt) do { __builtin_amdgcn_s_setprio(1); _Pragma("unroll") for (int m = 0; m < 4; ++m) _Pragma("unroll") for (int n = 0; n < 2; ++n) _Pragma("unroll") for (int k = 0; k < 2; ++k) \
        acc[ai][bj][m][n] = __builtin_amdgcn_mfma_f32_16x16x32_bf16(Bt[n][k], At[m][k], acc[ai][bj][m][n], 0, 0, 0); __builtin_amdgcn_s_setprio(0); } while (0)
#define PG8_WAIT_V(n) asm volatile("s_waitcnt vmcnt(" #n ")" ::: "memory")
#define PG8_WAIT_L(n) asm volatile("s_waitcnt lgkmcnt(" #n ")" ::: "memory")
#define PG8_BAR __builtin_amdgcn_s_barrier()
#define PG8_SCHED __builtin_amdgcn_sched_barrier(0)
    GUnit cur, nxt; int ui = 0;
    if (!S.next(0, cur)) return;
    f32x4 acc[2][2][4][2];
#pragma unroll
    for (int a = 0; a < 2; ++a)
#pragma unroll
        for (int b = 0; b < 2; ++b)
#pragma unroll
            for (int m = 0; m < 4; ++m)
#pragma unroll
                for (int n = 0; n < 2; ++n) acc[a][b][m][n] = (f32x4){0.f, 0.f, 0.f, 0.f};
    bf16x8 At[4][2], B0[2][2], B1[2][2];
    const char* cA = cur.A; const char* cB = cur.B;
    PG8_STAGE(PG8_SB(0, 0), cB, voffB); PG8_STAGE(PG8_SA(0, 0), cA, voffA); PG8_STAGE(PG8_SB(0, 1), cB + hstepB, voffB); PG8_STAGE(PG8_SA(0, 1), cA + hstepA, voffA);
    if (wr == 1) PG8_BAR;
    PG8_WAIT_V(4); PG8_BAR;
    PG8_STAGE(PG8_SB(1, 0), cB + kstep, voffB); PG8_STAGE(PG8_SA(1, 0), cA + kstep, voffA); PG8_STAGE(PG8_SB(1, 1), cB + hstepB + kstep, voffB);
    PG8_WAIT_V(6); PG8_BAR;
    for (;;) {
        const bool has_next = S.next(ui + 1, nxt);
        const char* nA = has_next ? nxt.A : cA; const char* nB = has_next ? nxt.B : cB;
        for (int t = 0; t < nt; t += 2) {
            const bool last = (t == nt - 2);
            const char* a1 = cA + (size_t)(t + 1) * kstep;
            const char* a2 = last ? nA : cA + (size_t)(t + 2) * kstep; const char* b2 = last ? nB : cB + (size_t)(t + 2) * kstep;
            const char* a3 = a2 + kstep; const char* b3 = b2 + kstep;
            PG8_LDB(B0, 0, 0); PG8_SCHED; PG8_LDA(At, 0, 0); PG8_STAGE(PG8_SA(1, 1), a1 + hstepA, voffA);
            PG8_WAIT_L(8); PG8_BAR; PG8_WAIT_L(0); PG8_MMA(0, 0, At, B0); PG8_BAR; PG8_SCHED;
            PG8_LDB(B1, 0, 1); PG8_STAGE(PG8_SB(0, 0), b2, voffB);
            PG8_BAR; PG8_WAIT_L(0); PG8_MMA(0, 1, At, B1); PG8_BAR;
            PG8_LDA(At, 0, 1); PG8_STAGE(PG8_SA(0, 0), a2, voffA);
            PG8_BAR; PG8_WAIT_L(0); PG8_MMA(1, 0, At, B0); PG8_BAR; PG8_SCHED;
            PG8_STAGE(PG8_SB(0, 1), b2 + hstepB, voffB);
            PG8_WAIT_V(6); PG8_BAR; PG8_MMA(1, 1, At, B1); PG8_BAR;
            PG8_LDB(B0, 1, 0); PG8_SCHED; PG8_LDA(At, 1, 0); PG8_STAGE(PG8_SA(0, 1), a2 + hstepA, voffA);
            PG8_WAIT_L(8); PG8_BAR; PG8_WAIT_L(0); PG8_MMA(0, 0, At, B0); PG8_BAR; PG8_SCHED;
            PG8_LDB(B1, 1, 1); PG8_STAGE(PG8_SB(1, 0), b3, voffB);
            PG8_BAR; PG8_WAIT_L(0); PG8_MMA(0, 1, At, B1); PG8_BAR;
            PG8_LDA(At, 1, 1); PG8_STAGE(PG8_SA(1, 0), a3, voffA);
            PG8_BAR; PG8_WAIT_L(0); PG8_MMA(1, 0, At, B0); PG8_BAR; PG8_SCHED;
            PG8_STAGE(PG8_SB(1, 1), b3 + hstepB, voffB);
            PG8_WAIT_V(6); PG8_BAR; PG8_MMA(1, 1, At, B1); PG8_BAR;
        }
        E(acc, cur, wr, wc, fr, fq);
        if (!has_next) break;
#pragma unroll
        for (int a = 0; a < 2; ++a)
#pragma unroll
            for (int b = 0; b < 2; ++b)
#pragma unroll
                for (int m = 0; m < 4; ++m)
#pragma unroll
                    for (int n = 0; n < 2; ++n) acc[a][b][m][n] = (f32x4){0.f, 0.f, 0.f, 0.f};
        cur = nxt; cA = nA; cB = nB; ++ui;
    }
    PG8_WAIT_V(0);
    if (wr == 0) PG8_BAR;
    PG8_BAR;
#undef PG8_SA
#undef PG8_SB
#undef PG8_STAGE
#undef PG8_LDA
#undef PG8_LDB
#undef PG8_MMA
#undef PG8_WAIT_V
#undef PG8_WAIT_L
#undef PG8_BAR
#undef PG8_SCHED
}

struct DenseOrder {
    const char* A; const char* Bt; unsigned lda_b, ldb_b; int nM, nN, nwg, G, c;
    __device__ void init(const void* A_, const void* Bt_, int M, int N, unsigned lda_b_, unsigned ldb_b_, int G_, int c_) { A = (const char*)A_; Bt = (const char*)Bt_; lda_b = lda_b_; ldb_b = ldb_b_; nM = M / BM; nN = N / BM; nwg = nM * nN; G = G_; c = c_; }
    __device__ bool next(int i, GUnit& u) const {
        const long L = (long)i * G + c; if (L >= nwg) return false;
        int wgid = (int)L; { const int q = nwg / 8, r = nwg % 8, xcd = wgid % 8, off = wgid / 8; wgid = (xcd < r ? xcd * (q + 1) : r * (q + 1) + (xcd - r) * q) + off; }
        const int nig = 8 * nN, gid = wgid / nig, fm = gid * 8, gsz = (nM - fm) < 8 ? (nM - fm) : 8;
        const int pm = fm + ((wgid % nig) % gsz), pn = (wgid % nig) / gsz;
        u.A = A + (size_t)pm * BM * lda_b; u.B = Bt + (size_t)pn * BM * ldb_b; u.row0 = pm * BM; u.col0 = pn * BM; u.aux = 0; return true;
    }
};

struct EpiF32R {
    float* C; int ldc; const float* res; int ncols;
    __device__ __forceinline__ void operator()(const f32x4 (&acc)[2][2][4][2], const GUnit& u, int wr, int wc, int fr, int fq) const {
        const int row0 = u.row0 + wr * 64 + fr, col0 = u.col0 + wc * 32 + 4 * fq;
#pragma unroll
        for (int ai = 0; ai < 2; ++ai)
#pragma unroll
            for (int m = 0; m < 4; ++m) {
                const size_t ro = (size_t)(row0 + ai * HALF + m * 16) * ldc;
#pragma unroll
                for (int bj = 0; bj < 2; ++bj)
#pragma unroll
                    for (int n = 0; n < 2; ++n) {
                        const int col = col0 + bj * HALF + n * 16;
                        if (col < ncols) { f32x4 x = acc[ai][bj][m][n]; if (res) x += *(const f32x4*)(res + ro + col); *(f32x4*)(C + ro + col) = x; }
                    }
            }
    }
};


struct EpiBf16S {
    bf16_t* O; int ldc; float scale;
    __device__ __forceinline__ void operator()(const f32x4 (&acc)[2][2][4][2], const GUnit& u, int wr, int wc, int fr, int fq) const {
        const int row0 = u.row0 + wr * 64 + fr, col0 = u.col0 + wc * 32 + 4 * fq;
#pragma unroll
        for (int ai = 0; ai < 2; ++ai)
#pragma unroll
            for (int m = 0; m < 4; ++m) {
                bf16_t* rowp = O + (size_t)(row0 + ai * HALF + m * 16) * ldc + col0;
#pragma unroll
                for (int bj = 0; bj < 2; ++bj)
#pragma unroll
                    for (int n = 0; n < 2; ++n) { const f32x4 x = acc[ai][bj][m][n] * scale; uint2 o; o.x = cvt_pk_bf16(x[0], x[1]); o.y = cvt_pk_bf16(x[2], x[3]); *(uint2*)(rowp + bj * HALF + n * 16) = o; }
            }
    }
};
struct EpiXkv {
    bf16_t *xk, *xvT;
    __device__ __forceinline__ void operator()(const f32x4 (&acc)[2][2][4][2], const GUnit& u, int wr, int wc, int fr, int fq) const {
        const int row0 = u.row0 + wr * 64 + fr, col0 = u.col0 + wc * 32 + 4 * fq;
        const bool isv = u.col0 >= 1024;
#pragma unroll
        for (int ai = 0; ai < 2; ++ai)
#pragma unroll
            for (int m = 0; m < 4; ++m) {
                const int row = row0 + ai * HALF + m * 16, b = row >> 8, key = row & 255;
#pragma unroll
                for (int bj = 0; bj < 2; ++bj)
#pragma unroll
                    for (int n = 0; n < 2; ++n) {
                        const int col = (col0 + bj * HALF + n * 16) & 1023, h = col >> 8, d = col & 255;
                        const f32x4 x = acc[ai][bj][m][n];
                        uint2 o; o.x = cvt_pk_bf16_acc(x[0], x[1]); o.y = cvt_pk_bf16_acc(x[2], x[3]);
                        if (!isv) *(uint2*)(xk + ((size_t)(b * 4 + h) * 256 + key) * 256 + d) = o;
                        else { bf16_t* base = xvT + ((size_t)(b * 4 + h) * 256 + d) * 256 + key;
                               base[0] = (bf16_t)(o.x & 0xffff); base[256] = (bf16_t)(o.x >> 16); base[512] = (bf16_t)(o.y & 0xffff); base[768] = (bf16_t)(o.y >> 16); }
                    }
            }
    }
};

struct EpiMixIn {
    bf16_t *q, *kk  , *vt  , *u, *cb; float* gates; const float* cosT; const float* sinT;
    __device__ __forceinline__ void operator()(const f32x4 (&acc)[2][2][4][2], const GUnit& un, int wr, int wc, int fr, int fq) const {
        const int pn = un.col0 >> 8, w1 = wc & 1, w2 = wc >> 1, dlo = 16 * w1 + 4 * fq;
#pragma unroll
        for (int ai = 0; ai < 2; ++ai)
#pragma unroll
            for (int m = 0; m < 4; ++m) {
                const int t = un.row0 + ai * HALF + wr * 64 + m * 16 + fr, b = t >> 11, sq = t & 2047;
                if (pn <= 4) {
                    const f32x4 cv = *(const f32x4*)(cosT + (size_t)t * 32 + dlo), sv = *(const f32x4*)(sinT + (size_t)t * 32 + dlo);
#pragma unroll
                    for (int bj = 0; bj < 2; ++bj) {
                        const int blk = 2 * bj + w2;
                        f32x4 x0 = acc[ai][bj][m][0], x1 = acc[ai][bj][m][1];
                        const bool rope = (pn < 2) || (bj == 0);
                        if (rope) { const f32x4 r0 = x0 * cv - x1 * sv, r1 = x1 * cv + x0 * sv; x0 = r0; x1 = r1; }
                        if (pn < 2) { x0 *= QS; x1 *= QS; }
                        uint2 o0, o1; o0.x = cvt_pk_bf16_acc(x0[0], x0[1]); o0.y = cvt_pk_bf16_acc(x0[2], x0[3]); o1.x = cvt_pk_bf16_acc(x1[0], x1[1]); o1.y = cvt_pk_bf16_acc(x1[2], x1[3]);
                        if (pn < 2) {
                            bf16_t* dst = q + (size_t)t * 512 + (pn * 4 + blk) * 64 + dlo;
                            *(uint2*)dst = o0; *(uint2*)(dst + 32) = o1;
                        } else {
                            const int g = blk & 1;
                            const size_t rowi = (size_t)(b * 2 + g) * S + sq;
                            if (bj == 0 || pn == 2) {
                                const int ki = (pn == 2) ? bj : pn - 1;
                                bf16_t* dst = kk + (size_t)ki * ((size_t)T * 128) + rowi * 64 + dlo;
                                *(uint2*)dst = o0; *(uint2*)(dst + 32) = o1;
                            } else {
                                bf16_t* base = vt + (size_t)(pn - 3) * ((size_t)T * 128) + ((size_t)(b * 2 + g) * 64 + dlo) * S + sq;
                                base[0 * S] = (bf16_t)(o0.x & 0xffff); base[1 * S] = (bf16_t)(o0.x >> 16); base[2 * S] = (bf16_t)(o0.y & 0xffff); base[3 * S] = (bf16_t)(o0.y >> 16);
                                base[32 * S] = (bf16_t)(o1.x & 0xffff); base[33 * S] = (bf16_t)(o1.x >> 16); base[34 * S] = (bf16_t)(o1.y & 0xffff); base[35 * S] = (bf16_t)(o1.y >> 16);
                            }
                        }
                    }
                } else if (pn < 9) {
#pragma unroll
                    for (int n = 0; n < 2; ++n) {
                        const f32x4 x = acc[ai][0][m][n] * acc[ai][1][m][n];
                        uint2 o; o.x = cvt_pk_bf16(x[0], x[1]); o.y = cvt_pk_bf16(x[2], x[3]);
                        *(uint2*)(u + (size_t)t * 512 + (pn - 5) * 128 + w2 * 64 + n * 32 + dlo) = o;
                    }
                } else if (pn < 11) {
#pragma unroll
                    for (int bj = 0; bj < 2; ++bj)
#pragma unroll
                        for (int n = 0; n < 2; ++n) {
                            const f32x4 x = acc[ai][bj][m][n];
                            uint2 o; o.x = cvt_pk_bf16_acc(x[0], x[1]); o.y = cvt_pk_bf16_acc(x[2], x[3]);
                            *(uint2*)(cb + (size_t)t * 512 + (pn - 9) * 256 + bj * 128 + w2 * 64 + n * 32 + dlo) = o;
                        }
                } else {
                    if (w2 == 0 && dlo < 24) {
                        const f32x4 x = acc[ai][0][m][0];
                        f32x4 sg;
#pragma unroll
                        for (int j = 0; j < 4; ++j) sg[j] = 1.f / (1.f + __expf(-x[j]));
                        *(f32x4*)(gates + (size_t)t * 24 + dlo) = sg;
                    }
                }
            }
    }
};

template <int NPN>
struct MoeOrder {
    const char* A; const char* Bt; const int* tile_e; int nunits, G, c; size_t bt_expert_bytes;
    __device__ void init(const void* A_, const void* Bt_, const int* tile_e_, int ntiles, size_t bt_expert_bytes_, int G_, int c_) { A = (const char*)A_; Bt = (const char*)Bt_; tile_e = tile_e_; nunits = ntiles * NPN; bt_expert_bytes = bt_expert_bytes_; G = G_; c = c_; }
    __device__ bool next(int i, GUnit& u) const {
        const int L = i * G + c; if (L >= nunits) return false;
        const int tl = L / NPN, pn = L % NPN, e = tile_e[tl];
        u.A = A + (size_t)tl * BM * 2048; u.B = Bt + (size_t)e * bt_expert_bytes + (size_t)pn * BM * 2048; u.row0 = tl * BM; u.col0 = pn * BM; u.aux = e; return true;
    }
};
struct EpiSwiglu {
    bf16_t* H; const float* bias;
    __device__ __forceinline__ void operator()(const f32x4 (&acc)[2][2][4][2], const GUnit& u, int wr, int wc, int fr, int fq) const {
        const int row0 = u.row0 + wr * 64 + fr, pn = u.col0 >> 8, cl0 = wc * 32 + 4 * fq;
        const float* bg = bias + (size_t)u.aux * 2048 + pn * 128 + cl0;
        f32x4 bgv[2], buv[2];
#pragma unroll
        for (int n = 0; n < 2; ++n) { bgv[n] = *(const f32x4*)(bg + n * 16); buv[n] = *(const f32x4*)(bg + 1024 + n * 16); }
#pragma unroll
        for (int ai = 0; ai < 2; ++ai)
#pragma unroll
            for (int m = 0; m < 4; ++m) {
                bf16_t* rowp = H + (size_t)(row0 + ai * HALF + m * 16) * 1024 + pn * 128 + cl0;
#pragma unroll
                for (int n = 0; n < 2; ++n) {
                    const f32x4 g4 = acc[ai][0][m][n] + bgv[n], u4 = acc[ai][1][m][n] + buv[n];
                    float h[4];
#pragma unroll
                    for (int j = 0; j < 4; ++j) {
                        const float g = fminf(g4[j], 7.f), uu = fminf(fmaxf(u4[j], -7.f), 7.f);
                        h[j] = (uu + 1.f) * (g / (1.f + __expf(-1.702f * g)));
                    }
                    uint2 o; o.x = cvt_pk_bf16(h[0], h[1]); o.y = cvt_pk_bf16(h[2], h[3]);
                    *(uint2*)(rowp + n * 16) = o;
                }
            }
    }
};
struct EpiDownScale {
    bf16_t* O; const float* bias; const float* w_buf;
    __device__ __forceinline__ void operator()(const f32x4 (&acc)[2][2][4][2], const GUnit& u, int wr, int wc, int fr, int fq) const {
        const int row0 = u.row0 + wr * 64 + fr, col0 = u.col0 + wc * 32 + 4 * fq;
        f32x4 bv[2][2];
#pragma unroll
        for (int bj = 0; bj < 2; ++bj)
#pragma unroll
            for (int n = 0; n < 2; ++n) bv[bj][n] = *(const f32x4*)(bias + (size_t)u.aux * 1024 + col0 + bj * HALF + n * 16);
#pragma unroll
        for (int ai = 0; ai < 2; ++ai)
#pragma unroll
            for (int m = 0; m < 4; ++m) {
                const int row = row0 + ai * HALF + m * 16;
                const float w = w_buf[row];
                bf16_t* rowp = O + (size_t)row * 1024 + col0;
#pragma unroll
                for (int bj = 0; bj < 2; ++bj)
#pragma unroll
                    for (int n = 0; n < 2; ++n) {
                        const f32x4 x = (acc[ai][bj][m][n] + bv[bj][n]) * w;
                        uint2 o; o.x = cvt_pk_bf16(x[0], x[1]); o.y = cvt_pk_bf16(x[2], x[3]);
                        *(uint2*)(rowp + bj * HALF + n * 16) = o;
                    }
            }
    }
};
}


__device__ __forceinline__ void posbias(int tid256, const float* __restrict__ pos, const float* __restrict__ w1, const float* __restrict__ b1, float* __restrict__ b1p) {
    float acc = b1[tid256];
    for (int k = 0; k < 2048; ++k) acc += pos[k] * w1[(size_t)k * 256 + tid256];
    b1p[tid256] = acc;
}
__device__ __forceinline__ void p_cmp_finalize(char* lds, const float* __restrict__ Pab_k, const float* __restrict__ Pab_v, const float* __restrict__ b1p_k, const float* __restrict__ b1p_v,
                                               const float* __restrict__ w2k, const float* __restrict__ w2v, pg::bf16_t* __restrict__ kc, pg::bf16_t* __restrict__ vcT, int wg, int nwg) {
    const int lane = threadIdx.x & 63, wv = threadIdx.x >> 6;
    float* hs = (float*)lds + wv * 256;
    for (int it = wg * 8 + wv; it < 2 * 16 * 128; it += nwg * 8) {
        const int which = it >> 11, row = it & 2047, bg = row >> 7, c = row & 127;
        const float* P = which ? Pab_v : Pab_k; const float* bp = which ? b1p_v : b1p_k; const float* w2 = which ? w2v : w2k;
        float o = 0.f;
        if (c < 127) {
#pragma unroll
            for (int i = 0; i < 4; ++i) { const int n = lane + 64 * i; hs[n] = gelu_tanh(P[(size_t)row * 512 + n] + P[(size_t)(row + 1) * 512 + 256 + n] + bp[n]); }
            __builtin_amdgcn_s_waitcnt(0);
            for (int n = 0; n < 256; ++n) o += hs[n] * w2[n * 64 + lane];
        }
        if (which == 0) kc[(size_t)row * 64 + lane] = pg::f2bf(o); else vcT[((size_t)bg * 64 + lane) * 128 + c] = pg::f2bf(o);
    }
}

namespace at {
using pg::bf16_t;
typedef short bf16x8 __attribute__((ext_vector_type(8)));
typedef float f32x16 __attribute__((ext_vector_type(16)));
typedef float f32x4 __attribute__((ext_vector_type(4)));
constexpr int TROW = 144, TILE_B = 64 * TROW;
#define AT_MFMA(a, b, c) __builtin_amdgcn_mfma_f32_32x32x16_bf16(a, b, c, 0, 0, 0)
__device__ __forceinline__ bf16x8 pack8(const f32x16& p, int s8) {
    union { unsigned u[4]; bf16x8 v; } x;
#pragma unroll
    for (int i = 0; i < 4; ++i) x.u[i] = pg::cvt_pk_bf16(p[s8 + 2 * i], p[s8 + 2 * i + 1]);
    return x.v;
}
template <int MODE>
__device__ __forceinline__ void attn64_unit(char* lds, int b, int g, int tq, const bf16_t* __restrict__ Q, const bf16_t* __restrict__ Kh, const bf16_t* __restrict__ VT,
                                            const unsigned* __restrict__ selmask, bf16_t* __restrict__ out, const bf16_t* __restrict__ o_cmp, const bf16_t* __restrict__ o_win, const float* __restrict__ gates) {
    const int tid = opaque_tid(), lane = tid & 63, r32 = lane & 31, hi = lane >> 5;
    const int wid = __builtin_amdgcn_readfirstlane(tid >> 6), hl = wid >> 1, qs = wid & 1;
    const int ql = 32 * qs + r32, qpos = tq * 64 + ql, h = g * 4 + hl;
    const size_t trow = (size_t)b * S + qpos;
    const bf16_t* Kb = Kh + (size_t)(b * 2 + g) * S * 64;
    const bf16_t* Vb = VT + (size_t)(b * 2 + g) * 64 * S;
    const int srow = tid >> 3, sch = tid & 7;
    const int kst = srow * TROW + sch * 16;
    const int vst = TILE_B + srow * TROW + ((sch >> 1) * 16 + (sch & 1) * 4) * 2;
    bf16x8 qf[4];
#pragma unroll
    for (int d0 = 0; d0 < 4; ++d0) qf[d0] = *(const bf16x8*)(Q + trow * 512 + h * 64 + 16 * d0 + 8 * hi);
    unsigned msk = 0xffffffffu;
    if (MODE == 0) msk = selmask[(size_t)(b * 2 + g) * S + qpos];
    const int nt = (MODE == 0) ? tq + 1 : (tq < 8 ? tq + 1 : 9);
    f32x16 o0, o1;
#pragma unroll
    for (int r = 0; r < 16; ++r) { o0[r] = 0.f; o1[r] = 0.f; }
    float m = -INFINITY, l = 0.f;
    uint4 kreg, vreg;
    kreg = *(const uint4*)(Kb + (size_t)(tq * 64 + srow) * 64 + sch * 8); vreg = *(const uint4*)(Vb + (size_t)srow * S + tq * 64 + sch * 8);
    __syncthreads();
    *(uint4*)(lds + kst) = kreg; *(uint2*)(lds + vst) = make_uint2(vreg.x, vreg.y); *(uint2*)(lds + vst + 16) = make_uint2(vreg.z, vreg.w);
    __syncthreads();
    for (int i = 0; i < nt; ++i) {
        if (i + 1 < nt) { const int tile = tq - i - 1; kreg = *(const uint4*)(Kb + (size_t)(tile * 64 + srow) * 64 + sch * 8); vreg = *(const uint4*)(Vb + (size_t)srow * S + tile * 64 + sch * 8); }
        const char* kb_ = lds + (i & 1) * 2 * TILE_B; const char* vb_ = kb_ + TILE_B;
        f32x16 p0, p1;
#pragma unroll
        for (int r = 0; r < 16; ++r) { p0[r] = 0.f; p1[r] = 0.f; }
#pragma unroll
        for (int d0 = 0; d0 < 4; ++d0) {
            const bf16x8 kf0 = *(const bf16x8*)(kb_ + r32 * TROW + d0 * 32 + hi * 16), kf1 = *(const bf16x8*)(kb_ + (32 + r32) * TROW + d0 * 32 + hi * 16);
            p0 = AT_MFMA(kf0, qf[d0], p0); p1 = AT_MFMA(kf1, qf[d0], p1);
        }
        if (i == 0) {
#pragma unroll
            for (int r = 0; r < 16; ++r) { const int kl = (r & 3) + 8 * (r >> 2) + 4 * hi; if (kl > ql) p0[r] = -INFINITY; if (kl + 32 > ql) p1[r] = -INFINITY; }
        } else if (MODE == 1) {
            if (i == 8) {
#pragma unroll
                for (int r = 0; r < 16; ++r) { const int kl = (r & 3) + 8 * (r >> 2) + 4 * hi; if (kl <= ql) p0[r] = -INFINITY; if (kl + 32 <= ql) p1[r] = -INFINITY; }
            }
        } else {
            if (!((msk >> (tq - i)) & 1u)) {
#pragma unroll
                for (int r = 0; r < 16; ++r) { p0[r] = -INFINITY; p1[r] = -INFINITY; }
            }
        }
        float mx = fmaxf(p0[0], p1[0]);
#pragma unroll
        for (int r = 1; r < 16; ++r) mx = fmaxf(mx, fmaxf(p0[r], p1[r]));
        mx = fmaxf(mx, __shfl_xor(mx, 32));
        const float mn = fmaxf(m, mx);
        const float alpha = __builtin_amdgcn_exp2f(m - mn);
        m = mn;
        float ls = 0.f;
#pragma unroll
        for (int r = 0; r < 16; ++r) { p0[r] = __builtin_amdgcn_exp2f(p0[r] - mn); p1[r] = __builtin_amdgcn_exp2f(p1[r] - mn); ls += p0[r] + p1[r]; }
        l = l * alpha + ls;
#pragma unroll
        for (int r = 0; r < 16; ++r) { o0[r] *= alpha; o1[r] *= alpha; }
        bf16x8 pb[4];
        pb[0] = pack8(p0, 0); pb[1] = pack8(p0, 8); pb[2] = pack8(p1, 0); pb[3] = pack8(p1, 8);
#pragma unroll
        for (int ks = 0; ks < 4; ++ks) {
            const bf16x8 vf0 = *(const bf16x8*)(vb_ + r32 * TROW + ks * 32 + hi * 16), vf1 = *(const bf16x8*)(vb_ + (32 + r32) * TROW + ks * 32 + hi * 16);
            o0 = AT_MFMA(vf0, pb[ks], o0); o1 = AT_MFMA(vf1, pb[ks], o1);
        }
        if (i + 1 < nt) {
            char* nb = lds + ((i + 1) & 1) * 2 * TILE_B;
            *(uint4*)(nb + kst) = kreg; *(uint2*)(nb + vst) = make_uint2(vreg.x, vreg.y); *(uint2*)(nb + vst + 16) = make_uint2(vreg.z, vreg.w);
        }
        __syncthreads();
    }
    const float lt = l + __shfl_xor(l, 32), inv = 1.f / lt;
    const size_t obase = trow * 512 + h * 64 + 4 * hi;
    float g0 = 0.f, g1 = inv, g2 = 0.f;
    if (MODE == 0) { g0 = gates[trow * 24 + h * 3 + 0]; g1 = gates[trow * 24 + h * 3 + 1] * inv; g2 = gates[trow * 24 + h * 3 + 2]; }
#pragma unroll
    for (int rr = 0; rr < 4; ++rr)
#pragma unroll
        for (int dh = 0; dh < 2; ++dh) {
            const f32x16& oo = dh ? o1 : o0;
            float x0 = oo[4 * rr] * g1, x1 = oo[4 * rr + 1] * g1, x2 = oo[4 * rr + 2] * g1, x3 = oo[4 * rr + 3] * g1;
            const size_t idx = obase + 32 * dh + 8 * rr;
            if (MODE == 0) {
                const uint2 c = *(const uint2*)(o_cmp + idx), w = *(const uint2*)(o_win + idx);
                x0 += g0 * __uint_as_float(c.x << 16) + g2 * __uint_as_float(w.x << 16); x1 += g0 * __uint_as_float(c.x & 0xffff0000u) + g2 * __uint_as_float(w.x & 0xffff0000u);
                x2 += g0 * __uint_as_float(c.y << 16) + g2 * __uint_as_float(w.y << 16); x3 += g0 * __uint_as_float(c.y & 0xffff0000u) + g2 * __uint_as_float(w.y & 0xffff0000u);
            }
            uint2 o; o.x = pg::cvt_pk_bf16(x0, x1); o.y = pg::cvt_pk_bf16(x2, x3);
            *(uint2*)(out + idx) = o;
        }
}
template <int MODE>
__device__ __forceinline__ void p_attn64(char* lds, const bf16_t* Q, const bf16_t* Kh, const bf16_t* VT, const unsigned* selmask, bf16_t* out, const bf16_t* o_cmp, const bf16_t* o_win, const float* gates, int wg, int nwg) {
    for (int item = wg; item < 256; item += nwg) {
        const int bg = item >> 4, j = item & 15;
        attn64_unit<MODE>(lds, bg >> 1, bg & 1, 31 - j, Q, Kh, VT, selmask, out, o_cmp, o_win, gates);
        attn64_unit<MODE>(lds, bg >> 1, bg & 1, j, Q, Kh, VT, selmask, out, o_cmp, o_win, gates);
    }
}

constexpr int CK_ROW = 144, CV_ROW = 272, CK_B = 128 * CK_ROW, CV_B = 64 * CV_ROW, CP_OFF = CK_B + CV_B, CI_OFF = CP_OFF + 4 * 64 * 32 * 4, CMP_LDS = CI_OFF + 64 * 32 * 4;
__device__ __forceinline__ void cmp_unit(char* lds, int b, int g, int tq, const bf16_t* __restrict__ Q, const bf16_t* __restrict__ kc, const bf16_t* __restrict__ vcT,
                                         bf16_t* __restrict__ out, unsigned* __restrict__ selmask) {
    const int tid = opaque_tid(), lane = tid & 63, r32 = lane & 31, hi = lane >> 5;
    const int wid = __builtin_amdgcn_readfirstlane(tid >> 6), hl = wid >> 1, qs = wid & 1;
    const int ql = 32 * qs + r32, qpos = tq * 64 + ql, h = g * 4 + hl, bg = b * 2 + g;
    const size_t trow = (size_t)b * S + qpos;
    __syncthreads();
#pragma unroll
    for (int i = 0; i < 2; ++i) {
        const int ch = tid + 512 * i;
        { const int row = ch >> 3, c8 = ch & 7; *(uint4*)(lds + row * CK_ROW + c8 * 16) = *(const uint4*)(kc + ((size_t)bg * 128 + row) * 64 + c8 * 8); }
        { const int row = ch >> 4, c16 = ch & 15; const uint4 x = *(const uint4*)(vcT + ((size_t)bg * 64 + row) * 128 + c16 * 8);
          char* dst = lds + CK_B + row * CV_ROW + ((c16 >> 1) * 16 + (c16 & 1) * 4) * 2; *(uint2*)dst = make_uint2(x.x, x.y); *(uint2*)(dst + 16) = make_uint2(x.z, x.w); }
    }
    bf16x8 qf[4];
#pragma unroll
    for (int d0 = 0; d0 < 4; ++d0) qf[d0] = *(const bf16x8*)(Q + trow * 512 + h * 64 + 16 * d0 + 8 * hi);
    __syncthreads();
    f32x16 p[4];
#pragma unroll
    for (int kh = 0; kh < 4; ++kh) {
#pragma unroll
        for (int r = 0; r < 16; ++r) p[kh][r] = 0.f;
#pragma unroll
        for (int d0 = 0; d0 < 4; ++d0) { const bf16x8 kf = *(const bf16x8*)(lds + (32 * kh + r32) * CK_ROW + d0 * 32 + hi * 16); p[kh] = AT_MFMA(kf, qf[d0], p[kh]); }
    }
    float mx = -1e30f;
#pragma unroll
    for (int kh = 0; kh < 4; ++kh)
#pragma unroll
        for (int r = 0; r < 16; ++r) { const int c = 32 * kh + (r & 3) + 8 * (r >> 2) + 4 * hi; if (16 * c + 31 > qpos) p[kh][r] = -1e30f; mx = fmaxf(mx, p[kh][r]); }
    mx = fmaxf(mx, __shfl_xor(mx, 32));
    float ls = 0.f;
#pragma unroll
    for (int kh = 0; kh < 4; ++kh)
#pragma unroll
        for (int r = 0; r < 16; ++r) { p[kh][r] = __builtin_amdgcn_exp2f(p[kh][r] - mx); ls += p[kh][r]; }
    ls += __shfl_xor(ls, 32);
    const float inv = (mx > -1e29f) ? 1.f / ls : 0.f;
#pragma unroll
    for (int kh = 0; kh < 4; ++kh)
#pragma unroll
        for (int r = 0; r < 16; ++r) p[kh][r] *= inv;
    f32x16 o0, o1;
#pragma unroll
    for (int r = 0; r < 16; ++r) { o0[r] = 0.f; o1[r] = 0.f; }
#pragma unroll
    for (int ks = 0; ks < 8; ++ks) {
        const bf16x8 pb = pack8(p[ks >> 1], (ks & 1) * 8);
        const bf16x8 vf0 = *(const bf16x8*)(lds + CK_B + r32 * CV_ROW + ks * 32 + hi * 16), vf1 = *(const bf16x8*)(lds + CK_B + (32 + r32) * CV_ROW + ks * 32 + hi * 16);
        o0 = AT_MFMA(vf0, pb, o0); o1 = AT_MFMA(vf1, pb, o1);
    }
    bf16_t* orow = out + trow * 512 + h * 64 + 4 * hi;
#pragma unroll
    for (int rr = 0; rr < 4; ++rr) {
        uint2 a, c; a.x = pg::cvt_pk_bf16_acc(o0[4 * rr], o0[4 * rr + 1]); a.y = pg::cvt_pk_bf16_acc(o0[4 * rr + 2], o0[4 * rr + 3]); c.x = pg::cvt_pk_bf16_acc(o1[4 * rr], o1[4 * rr + 1]); c.y = pg::cvt_pk_bf16_acc(o1[4 * rr + 2], o1[4 * rr + 3]);
        *(uint2*)(orow + 8 * rr) = a; *(uint2*)(orow + 32 + 8 * rr) = c;
    }
    float inn[16], car[16];
#pragma unroll
    for (int t = 0; t < 16; ++t) { const f32x16& pk = p[t >> 2]; const int r0 = 4 * (t & 3); car[t] = 0.5f * pk[r0 + 3]; inn[t] = pk[r0] + pk[r0 + 1] + pk[r0 + 2] + car[t]; }
    float* part = (float*)(lds + CP_OFF) + (hl * 64 + ql) * 32;
#pragma unroll
    for (int t = 0; t < 16; ++t) {
        const float co = __shfl_xor(car[t], 32);
        const float cprev = __shfl_xor(t > 0 ? car[t - 1] : 0.f, 32);
        part[2 * t + hi] = inn[t] + (hi ? co : cprev);
    }
    __syncthreads();
    float* impf = (float*)(lds + CI_OFF);
    const float* pall = (const float*)(lds + CP_OFF);
#pragma unroll
    for (int k = 0; k < 4; ++k) {
        const int idx = tid + 512 * k, q = idx >> 5, j = idx & 31, cur = tq;
        float imp = ((pall[(0 * 64 + q) * 32 + j] + pall[(1 * 64 + q) * 32 + j]) + pall[(2 * 64 + q) * 32 + j]) + pall[(3 * 64 + q) * 32 + j];
        if (j == 0 || j == cur || j == cur - 1) imp = 1e30f; else if (j > cur) imp = -1e30f;
        impf[idx] = imp;
    }
    __syncthreads();
#pragma unroll
    for (int k = 0; k < 4; ++k) {
        const int idx = tid + 512 * k, q = idx >> 5, j = idx & 31;
        const float mine = impf[idx];
        int rank = 0;
        for (int i = 0; i < 32; ++i) { const float x = impf[q * 32 + i]; rank += (x > mine || (x == mine && i < j)) ? 1 : 0; }
        const unsigned long long bal = __ballot(rank < 16);
        if ((lane & 31) == 0) selmask[(size_t)bg * S + tq * 64 + q] = (unsigned)(hi ? (bal >> 32) : (bal & 0xffffffffull));
    }
}
__device__ __forceinline__ void p_cmp_attn_fast(char* lds, const bf16_t* Q, const bf16_t* kc, const bf16_t* vcT, bf16_t* out, unsigned* selmask, int wg, int nwg) {
    for (int item = wg; item < 512; item += nwg) cmp_unit(lds, item >> 6, (item >> 5) & 1, item & 31, Q, kc, vcT, out, selmask);
}

constexpr int XK_ROW = 528, XV_ROW = 144, XK_B = 64 * XK_ROW, XV_B = 256 * XV_ROW;
typedef float f32x4v __attribute__((ext_vector_type(4)));
#define XT_MFMA(a, b, c) __builtin_amdgcn_mfma_f32_16x16x32_bf16(a, b, c, 0, 0, 0)
__device__ __forceinline__ void xattn_unit(char* lds, int b, int h, int qt, const bf16_t* __restrict__ Q, const bf16_t* __restrict__ xk, const bf16_t* __restrict__ xvT, bf16_t* __restrict__ out) {
    const int tid = opaque_tid(), lane = tid & 63, l15 = lane & 15, quad = lane >> 4;
    const int wid = __builtin_amdgcn_readfirstlane(tid >> 6);
    const size_t trow = (size_t)b * S + qt * 128 + wid * 16 + l15;
    const bf16_t* Kb = xk + (size_t)(b * 4 + h) * 256 * 256;
    const bf16_t* Vb = xvT + (size_t)(b * 4 + h) * 256 * 256;
    bf16x8 qf[8];
#pragma unroll
    for (int ds = 0; ds < 8; ++ds) qf[ds] = *(const bf16x8*)(Q + trow * 1024 + h * 256 + 32 * ds + 8 * quad);
    f32x4v o[16];
#pragma unroll
    for (int db = 0; db < 16; ++db) o[db] = (f32x4v){0.f, 0.f, 0.f, 0.f};
    float m = -INFINITY, l = 0.f;
    for (int kt = 0; kt < 4; ++kt) {
        __syncthreads();
#pragma unroll
        for (int i = 0; i < 4; ++i) {
            const int ch = tid + 512 * i;
            { const int row = ch >> 5, c = ch & 31; *(uint4*)(lds + row * XK_ROW + c * 16) = *(const uint4*)(Kb + (size_t)(kt * 64 + row) * 256 + c * 8); }
            { const int row = ch >> 3, c = ch & 7, cp = c & 3; const uint4 x = *(const uint4*)(Vb + (size_t)row * 256 + kt * 64 + c * 8);
              char* dst = lds + XK_B + row * XV_ROW + ((c >> 2) * 32 + 16 * (cp & 1) + 4 * (cp >> 1)) * 2; *(uint2*)dst = make_uint2(x.x, x.y); *(uint2*)(dst + 16) = make_uint2(x.z, x.w); }
        }
        __syncthreads();
        f32x4v sc[4];
#pragma unroll
        for (int kb = 0; kb < 4; ++kb) {
            sc[kb] = (f32x4v){0.f, 0.f, 0.f, 0.f};
#pragma unroll
            for (int ds = 0; ds < 8; ++ds) { const bf16x8 kf = *(const bf16x8*)(lds + (16 * kb + l15) * XK_ROW + ds * 64 + quad * 16); sc[kb] = XT_MFMA(kf, qf[ds], sc[kb]); }
        }
        float mx = -INFINITY;
#pragma unroll
        for (int kb = 0; kb < 4; ++kb)
#pragma unroll
            for (int r = 0; r < 4; ++r) mx = fmaxf(mx, sc[kb][r]);
        mx = fmaxf(mx, __shfl_xor(mx, 16)); mx = fmaxf(mx, __shfl_xor(mx, 32));
        const float mn = fmaxf(m, mx), alpha = __builtin_amdgcn_exp2f(m - mn);
        m = mn;
        float ls = 0.f;
#pragma unroll
        for (int kb = 0; kb < 4; ++kb)
#pragma unroll
            for (int r = 0; r < 4; ++r) { sc[kb][r] = __builtin_amdgcn_exp2f(sc[kb][r] - mn); ls += sc[kb][r]; }
        l = l * alpha + ls;
#pragma unroll
        for (int db = 0; db < 16; ++db) o[db] *= alpha;
#pragma unroll
        for (int k2 = 0; k2 < 2; ++k2) {
            union { unsigned u[4]; bf16x8 v; } pb;
            pb.u[0] = pg::cvt_pk_bf16(sc[2 * k2][0], sc[2 * k2][1]); pb.u[1] = pg::cvt_pk_bf16(sc[2 * k2][2], sc[2 * k2][3]);
            pb.u[2] = pg::cvt_pk_bf16(sc[2 * k2 + 1][0], sc[2 * k2 + 1][1]); pb.u[3] = pg::cvt_pk_bf16(sc[2 * k2 + 1][2], sc[2 * k2 + 1][3]);
#pragma unroll
            for (int db = 0; db < 16; ++db) { const bf16x8 vf = *(const bf16x8*)(lds + XK_B + (16 * db + l15) * XV_ROW + k2 * 64 + quad * 16); o[db] = XT_MFMA(vf, pb.v, o[db]); }
        }
    }
    l += __shfl_xor(l, 16); l += __shfl_xor(l, 32);
    const float inv = 1.f / l;
    bf16_t* orow = out + trow * 1024 + h * 256 + 4 * quad;
#pragma unroll
    for (int db = 0; db < 16; ++db) { uint2 x; x.x = pg::cvt_pk_bf16(o[db][0] * inv, o[db][1] * inv); x.y = pg::cvt_pk_bf16(o[db][2] * inv, o[db][3] * inv); *(uint2*)(orow + 16 * db) = x; }
}
__device__ __forceinline__ void p_xattn_fast(char* lds, const bf16_t* Q, const bf16_t* xk, const bf16_t* xvT, bf16_t* out, int wg, int nwg) {
    for (int item = wg; item < 512; item += nwg) xattn_unit(lds, item >> 6, (item >> 4) & 3, item & 15, Q, xk, xvT, out);
}
}


namespace tl {
using pg::bf16_t; using pg::cvt_pk_bf16;
__device__ __forceinline__ float blo(unsigned u) { return __uint_as_float(u << 16); }
__device__ __forceinline__ float bhi(unsigned u) { return __uint_as_float(u & 0xffff0000u); }
__device__ __forceinline__ float ssq4(const float4& a) { return a.x * a.x + a.y * a.y + a.z * a.z + a.w * a.w; }

__device__ __forceinline__ void rmsnorm_rows(const float* __restrict__ in, const float* __restrict__ g, bf16_t* __restrict__ out, int rows, int gw, int nw, int lane) {
    float4 gv[4];
#pragma unroll
    for (int i = 0; i < 4; ++i) gv[i] = *(const float4*)(g + 256 * i + 4 * lane);
    for (int r0 = gw; r0 < rows; r0 += 2 * nw) {
        const int r1 = r0 + nw; const bool two = r1 < rows;
        float4 a[4], b[4];
#pragma unroll
        for (int i = 0; i < 4; ++i) { a[i] = *(const float4*)(in + (size_t)r0 * 1024 + 256 * i + 4 * lane); b[i] = two ? *(const float4*)(in + (size_t)r1 * 1024 + 256 * i + 4 * lane) : make_float4(0.f, 0.f, 0.f, 0.f); }
        float sa = ssq4(a[0]) + ssq4(a[1]) + ssq4(a[2]) + ssq4(a[3]), sb = ssq4(b[0]) + ssq4(b[1]) + ssq4(b[2]) + ssq4(b[3]);
        sa = wave_sum(sa); sb = wave_sum(sb);
        const float ra = rsqrtf(sa * (1.f / 1024.f) + 1e-5f), rb = rsqrtf(sb * (1.f / 1024.f) + 1e-5f);
#pragma unroll
        for (int i = 0; i < 4; ++i) {
            uint2 o; o.x = cvt_pk_bf16(a[i].x * ra * gv[i].x, a[i].y * ra * gv[i].y); o.y = cvt_pk_bf16(a[i].z * ra * gv[i].z, a[i].w * ra * gv[i].w);
            *(uint2*)(out + (size_t)r0 * 1024 + 256 * i + 4 * lane) = o;
            if (two) { uint2 q; q.x = cvt_pk_bf16(b[i].x * rb * gv[i].x, b[i].y * rb * gv[i].y); q.y = cvt_pk_bf16(b[i].z * rb * gv[i].z, b[i].w * rb * gv[i].w); *(uint2*)(out + (size_t)r1 * 1024 + 256 * i + 4 * lane) = q; }
        }
    }
}

__device__ __forceinline__ void mix_post(const bf16_t* __restrict__ o_nsa, const bf16_t* __restrict__ ub, const bf16_t* __restrict__ cbb, const float* __restrict__ conv_w,
                                         const float* __restrict__ g_nsa, const float* __restrict__ g_conv, bf16_t* __restrict__ omix, int gw, int nw, int lane) {
    float cw[3][8], gn[8], gc[8];
#pragma unroll
    for (int j = 0; j < 8; ++j) { gn[j] = g_nsa[8 * lane + j]; gc[j] = g_conv[8 * lane + j]; cw[0][j] = conv_w[8 * lane + j]; cw[1][j] = conv_w[512 + 8 * lane + j]; cw[2][j] = conv_w[1024 + 8 * lane + j]; }
    for (int t = gw; t < T; t += nw) {
        const int sq = t & (S - 1);
        const uint4 zero = make_uint4(0u, 0u, 0u, 0u);
        const uint4 on4 = *(const uint4*)(o_nsa + (size_t)t * 512 + 8 * lane), c4 = *(const uint4*)(cbb + (size_t)t * 512 + 8 * lane), u2 = *(const uint4*)(ub + (size_t)t * 512 + 8 * lane);
        const uint4 u1 = sq >= 1 ? *(const uint4*)(ub + (size_t)(t - 1) * 512 + 8 * lane) : zero, u0 = sq >= 2 ? *(const uint4*)(ub + (size_t)(t - 2) * 512 + 8 * lane) : zero;
        const unsigned onw[4] = {on4.x, on4.y, on4.z, on4.w}, cbw[4] = {c4.x, c4.y, c4.z, c4.w}, u0w[4] = {u0.x, u0.y, u0.z, u0.w}, u1w[4] = {u1.x, u1.y, u1.z, u1.w}, u2w[4] = {u2.x, u2.y, u2.z, u2.w};
        float on[8], oc[8], ssn = 0.f, ssc = 0.f;
#pragma unroll
        for (int q = 0; q < 4; ++q) {
            on[2 * q] = blo(onw[q]); on[2 * q + 1] = bhi(onw[q]);
            const float y0 = cw[0][2 * q] * blo(u0w[q]) + cw[1][2 * q] * blo(u1w[q]) + cw[2][2 * q] * blo(u2w[q]);
            const float y1 = cw[0][2 * q + 1] * bhi(u0w[q]) + cw[1][2 * q + 1] * bhi(u1w[q]) + cw[2][2 * q + 1] * bhi(u2w[q]);
            oc[2 * q] = blo(cbw[q]) * y0; oc[2 * q + 1] = bhi(cbw[q]) * y1;
        }
#pragma unroll
        for (int j = 0; j < 8; ++j) { ssn += on[j] * on[j]; ssc += oc[j] * oc[j]; }
        ssn = wave_sum(ssn); ssc = wave_sum(ssc);
        const float rn = rsqrtf(ssn * (1.f / 512.f) + 1e-5f), rc = rsqrtf(ssc * (1.f / 512.f) + 1e-5f);
        uint4 o1, o2;
        o1.x = cvt_pk_bf16(on[0] * rn * gn[0], on[1] * rn * gn[1]); o1.y = cvt_pk_bf16(on[2] * rn * gn[2], on[3] * rn * gn[3]); o1.z = cvt_pk_bf16(on[4] * rn * gn[4], on[5] * rn * gn[5]); o1.w = cvt_pk_bf16(on[6] * rn * gn[6], on[7] * rn * gn[7]);
        o2.x = cvt_pk_bf16(oc[0] * rc * gc[0], oc[1] * rc * gc[1]); o2.y = cvt_pk_bf16(oc[2] * rc * gc[2], oc[3] * rc * gc[3]); o2.z = cvt_pk_bf16(oc[4] * rc * gc[4], oc[5] * rc * gc[5]); o2.w = cvt_pk_bf16(oc[6] * rc * gc[6], oc[7] * rc * gc[7]);
        *(uint4*)(omix + (size_t)t * 1024 + 8 * lane) = o1; *(uint4*)(omix + (size_t)t * 1024 + 512 + 8 * lane) = o2;
    }
}

__device__ __forceinline__ void xreduce32(float (&acc)[32], int lane) {
    const bool b5 = lane & 32, b4 = lane & 16, b3 = lane & 8, b2 = lane & 4, b1 = lane & 2;
#pragma unroll
    for (int e = 0; e < 16; ++e) { const float snd = b5 ? acc[e] : acc[e + 16], kp = b5 ? acc[e + 16] : acc[e]; acc[e] = kp + __shfl_xor(snd, 32); }
#pragma unroll
    for (int e = 0; e < 8; ++e) { const float snd = b4 ? acc[e] : acc[e + 8], kp = b4 ? acc[e + 8] : acc[e]; acc[e] = kp + __shfl_xor(snd, 16); }
#pragma unroll
    for (int e = 0; e < 4; ++e) { const float snd = b3 ? acc[e] : acc[e + 4], kp = b3 ? acc[e + 4] : acc[e]; acc[e] = kp + __shfl_xor(snd, 8); }
#pragma unroll
    for (int e = 0; e < 2; ++e) { const float snd = b2 ? acc[e] : acc[e + 2], kp = b2 ? acc[e + 2] : acc[e]; acc[e] = kp + __shfl_xor(snd, 4); }
    { const float snd = b1 ? acc[0] : acc[1], kp = b1 ? acc[1] : acc[0]; acc[0] = kp + __shfl_xor(snd, 2); }
    acc[0] += __shfl_xor(acc[0], 1);
}
__device__ __forceinline__ void route_token(float logit, int t, int lane, int* __restrict__ a_e, float* __restrict__ a_w, int* __restrict__ a_slot, int* __restrict__ counts) {
    const int e = lane >> 1;
    int rank = 0;
#pragma unroll
    for (int i = 0; i < 32; ++i) { const float x = __shfl(logit, 2 * i); rank += (x > logit || (x == logit && i < e)) ? 1 : 0; }
    const float vmax = wave_max(logit);
    const bool sel = (rank < TOPK) && !(lane & 1);
    const float ex = sel ? __expf(logit - vmax) : 0.f;
    const float sum = wave_sum(ex);
    if (sel) { const int a = t * TOPK + rank; a_e[a] = e; a_w[a] = ex / sum; a_slot[a] = atomicAdd(&counts[e], 1); }
}
constexpr int WR_STRIDE = 1028;
__device__ __forceinline__ void norm_router(char* lds, const float* __restrict__ h2, const float* __restrict__ g, const float* __restrict__ wr, const float* __restrict__ br, bf16_t* __restrict__ xn_bf,
                                            int* __restrict__ a_e, float* __restrict__ a_w, int* __restrict__ a_slot, int* __restrict__ counts, int gw, int nw, int lane) {
    float* Ws = (float*)lds;
    __syncthreads();
    for (int idx = threadIdx.x; idx < 1024 * NE; idx += 512) Ws[(idx & 31) * WR_STRIDE + (idx >> 5)] = wr[idx];
    __syncthreads();
    float4 gv[4];
#pragma unroll
    for (int i = 0; i < 4; ++i) gv[i] = *(const float4*)(g + 256 * i + 4 * lane);
    const float bias = br[lane >> 1];
    for (int t0 = gw; t0 < T; t0 += 2 * nw) {
        const int t1 = t0 + nw; const bool two = t1 < T;
        float4 a[4], b[4];
#pragma unroll
        for (int i = 0; i < 4; ++i) { a[i] = *(const float4*)(h2 + (size_t)t0 * 1024 + 256 * i + 4 * lane); b[i] = two ? *(const float4*)(h2 + (size_t)t1 * 1024 + 256 * i + 4 * lane) : make_float4(0.f, 0.f, 0.f, 0.f); }
        float sa = ssq4(a[0]) + ssq4(a[1]) + ssq4(a[2]) + ssq4(a[3]), sb = ssq4(b[0]) + ssq4(b[1]) + ssq4(b[2]) + ssq4(b[3]);
        sa = wave_sum(sa); sb = wave_sum(sb);
        const float ra = rsqrtf(sa * (1.f / 1024.f) + 1e-5f), rb = rsqrtf(sb * (1.f / 1024.f) + 1e-5f);
#pragma unroll
        for (int i = 0; i < 4; ++i) {
            a[i].x *= ra * gv[i].x; a[i].y *= ra * gv[i].y; a[i].z *= ra * gv[i].z; a[i].w *= ra * gv[i].w;
            b[i].x *= rb * gv[i].x; b[i].y *= rb * gv[i].y; b[i].z *= rb * gv[i].z; b[i].w *= rb * gv[i].w;
            uint2 o; o.x = cvt_pk_bf16(a[i].x, a[i].y); o.y = cvt_pk_bf16(a[i].z, a[i].w); *(uint2*)(xn_bf + (size_t)t0 * 1024 + 256 * i + 4 * lane) = o;
            if (two) { uint2 q; q.x = cvt_pk_bf16(b[i].x, b[i].y); q.y = cvt_pk_bf16(b[i].z, b[i].w); *(uint2*)(xn_bf + (size_t)t1 * 1024 + 256 * i + 4 * lane) = q; }
        }
        float accA[32], accB[32];
#pragma unroll
        for (int e = 0; e < 32; ++e) {
            float sA = 0.f, sB = 0.f;
#pragma unroll
            for (int i = 0; i < 4; ++i) {
                const float4 w = *(const float4*)(Ws + e * WR_STRIDE + 256 * i + 4 * lane);
                sA += a[i].x * w.x + a[i].y * w.y + a[i].z * w.z + a[i].w * w.w;
                sB += b[i].x * w.x + b[i].y * w.y + b[i].z * w.z + b[i].w * w.w;
            }
            accA[e] = sA; accB[e] = sB;
        }
        xreduce32(accA, lane); xreduce32(accB, lane);
        route_token(accA[0] + bias, t0, lane, a_e, a_w, a_slot, counts);
        if (two) route_token(accB[0] + bias, t1, lane, a_e, a_w, a_slot, counts);
    }
}
__device__ __forceinline__ void moe_scatter(char* lds, const int* __restrict__ counts, int* __restrict__ pstart, int* __restrict__ tile_e, const int* __restrict__ a_e, const float* __restrict__ a_w,
                                            const int* __restrict__ a_slot, const bf16_t* __restrict__ xn_bf, bf16_t* __restrict__ xg, float* __restrict__ w_buf, int* __restrict__ dest_of, int wg, int gw, int nw, int lane) {
    int* ps = (int*)lds;
    __syncthreads();
    if (threadIdx.x == 0) { int acc = 0; for (int e = 0; e < NE; ++e) { ps[e] = acc; acc += (counts[e] + MT - 1) / MT * MT; } ps[NE] = acc; }
    __syncthreads();
    if (wg == 0) {
        if (threadIdx.x == 0) pstart[NE] = ps[NE] / MT;
        for (int tl_ = threadIdx.x; tl_ < NTILE; tl_ += 512) { const int r = tl_ * MT; int e = -1; for (int i = 0; i < NE; ++i) if (r >= ps[i] && r < ps[i + 1]) e = i; tile_e[tl_] = e; }
    }
    for (int t = gw; t < T; t += nw) {
        uint2 row[4];
#pragma unroll
        for (int i = 0; i < 4; ++i) row[i] = *(const uint2*)(xn_bf + (size_t)t * 1024 + 256 * i + 4 * lane);
        const int4 e4 = *(const int4*)(a_e + 4 * t), s4 = *(const int4*)(a_slot + 4 * t); const float4 w4 = *(const float4*)(a_w + 4 * t);
        const int ee[4] = {e4.x, e4.y, e4.z, e4.w}, sl[4] = {s4.x, s4.y, s4.z, s4.w}; const float ww[4] = {w4.x, w4.y, w4.z, w4.w};
#pragma unroll
        for (int k = 0; k < 4; ++k) {
            const int dest = ps[ee[k]] + sl[k];
#pragma unroll
            for (int i = 0; i < 4; ++i) *(uint2*)(xg + (size_t)dest * 1024 + 256 * i + 4 * lane) = row[i];
            if (lane == 0) { w_buf[dest] = ww[k]; dest_of[4 * t + k] = dest; }
        }
    }
}
__device__ __forceinline__ void final_rows(const float* __restrict__ h2, const bf16_t* __restrict__ out_a, const int* __restrict__ dest_of, const float* __restrict__ g, float* __restrict__ out, int gw, int nw, int lane) {
    float4 gv[4];
#pragma unroll
    for (int i = 0; i < 4; ++i) gv[i] = *(const float4*)(g + 256 * i + 4 * lane);
    for (int t = gw; t < T; t += nw) {
        const int4 d4 = *(const int4*)(dest_of + 4 * t);
        const int dd[4] = {d4.x, d4.y, d4.z, d4.w};
        float4 a[4]; uint2 oa[4][4];
#pragma unroll
        for (int i = 0; i < 4; ++i) a[i] = *(const float4*)(h2 + (size_t)t * 1024 + 256 * i + 4 * lane);
#pragma unroll
        for (int k = 0; k < 4; ++k)
#pragma unroll
            for (int i = 0; i < 4; ++i) oa[k][i] = *(const uint2*)(out_a + (size_t)dd[k] * 1024 + 256 * i + 4 * lane);
        float ss = 0.f;
#pragma unroll
        for (int i = 0; i < 4; ++i) {
#pragma unroll
            for (int k = 0; k < 4; ++k) { a[i].x += blo(oa[k][i].x); a[i].y += bhi(oa[k][i].x); a[i].z += blo(oa[k][i].y); a[i].w += bhi(oa[k][i].y); }
            ss += ssq4(a[i]);
        }
        ss = wave_sum(ss);
        const float rs = rsqrtf(ss * (1.f / 1024.f) + 1e-5f);
#pragma unroll
        for (int i = 0; i < 4; ++i) *(float4*)(out + (size_t)t * 1024 + 256 * i + 4 * lane) = make_float4(a[i].x * rs * gv[i].x, a[i].y * rs * gv[i].y, a[i].z * rs * gv[i].z, a[i].w * rs * gv[i].w);
    }
}
}

template <bool PERM64, class RowMap>
__device__ __forceinline__ void p_convT(char* lds, const float* __restrict__ W, int K, int N, int nmat, pg::bf16_t* __restrict__ Bt, int nrows_out, RowMap rowmap, int wg, int nwg) {
    pg::bf16_t* Ls = (pg::bf16_t*)lds;
    const int tid = opaque_tid();
    const int tk = K / 128, tn = nrows_out / 128, per = tk * tn, total = per * nmat;
    const int kk0 = tid >> 5, n4 = (tid & 31) * 4, sub = n4 >> 6, nl = n4 & 63;
    float4 x[8];
    auto issue = [&](int tile) {
        const int mat = tile / per, r = tile % per, jn = r / tk, jk = r % tk;
        const int n0 = rowmap(jn * 128 + 64 * sub);
        const float* src = W + (size_t)mat * K * N + (size_t)(jk * 128 + kk0) * N + n0 + nl;
        const bool ok = n0 >= 0 && n0 + nl < N;
#pragma unroll
        for (int i = 0; i < 8; ++i) x[i] = ok ? *(const float4*)(src + (size_t)(16 * i) * N) : make_float4(0.f, 0.f, 0.f, 0.f);
    };
    int tile = wg;
    if (tile < total) issue(tile);
    while (tile < total) {
        const int mat = tile / per, r = tile % per, jn = r / tk, jk = r % tk;
        __syncthreads();
#pragma unroll
        for (int i = 0; i < 8; ++i) {
            const int kk = kk0 + 16 * i;
            Ls[(n4 + 0) * 136 + kk] = pg::f2bf(x[i].x); Ls[(n4 + 1) * 136 + kk] = pg::f2bf(x[i].y); Ls[(n4 + 2) * 136 + kk] = pg::f2bf(x[i].z); Ls[(n4 + 3) * 136 + kk] = pg::f2bf(x[i].w);
        }
        const int nxt = tile + nwg;
        if (nxt < total) issue(nxt);
        __syncthreads();
#pragma unroll
        for (int i = 0; i < 4; ++i) {
            const int c = tid + 512 * i, n = c >> 4, kc = (c & 15) * 8;
            const int ns = PERM64 ? ((n & 64) | (n & 15) | ((n & 16) << 1) | ((n & 32) >> 1)) : n;
            const uint4 y = *(const uint4*)(Ls + ns * 136 + kc);
            *(uint4*)(Bt + ((size_t)mat * nrows_out + jn * 128 + n) * K + jk * 128 + kc) = y;
        }
        tile = nxt;
    }
}

struct Params {
    const float *x, *mem; const int* positions;
    const float *g_mix_norm, *w_mix_in, *cmp_pos_k, *cmp_pos_v, *cmp_w1_k, *cmp_b1_k, *cmp_w2_k, *cmp_w1_v, *cmp_b1_v, *cmp_w2_v, *conv_w, *g_nsa_out, *g_conv_out, *w_mix_out,
        *g_xattn_norm, *g_mem_norm, *w_xq, *w_xkv, *w_xo, *g_moe_norm, *w_router, *b_router, *w_gate_up, *b_gate_up, *w_down, *b_down, *g_final;
    float* out;
    unsigned* bar;
    int *counts, *pstart, *tile_e, *a_e, *a_slot, *dest_of, *tok_buf;
    float *a_w, *w_buf;
    unsigned* selmask;
    float *hid_k, *hid_v, *kc, *vc, *memn, *xkv, *hbuf, *xn, *o_cmp, *o_slc, *o_win, *xq, *proj, *xo;
    unsigned short *hmid, *out_a, *xg, *wt_gu, *wt_dn;
    unsigned short *q_bf, *kcmp, *vcmp, *kslc, *vslcT, *kwin, *vwinT, *u_bf, *cb_bf; float *gates, *cosT, *sinT;
    unsigned short *xq_bf, *xk_bf, *xvT_bf, *ocmp_bf, *owin_bf, *onsa_bf;
    unsigned short *wt_c1k, *wt_c1v, *kc_bf, *vcT_bf; float *Pab_k, *Pab_v, *b1p_k, *b1p_v;
    unsigned short *xn_bf, *memn_bf, *xo_bf, *wt_mix_in, *wt_xkv, *wt_mix_out, *wt_xq, *wt_xo;
};

__global__ void __launch_bounds__(512, 2) mega_fwd(Params p) {
    extern __shared__ __attribute__((aligned(16))) char lds[];
    if (threadIdx.x < 4) ((unsigned*)lds)[threadIdx.x] = 0u;
    __syncthreads();
    XcdBarrier bar = xcd_barrier_post(p.bar, (volatile LAS unsigned*)lds);
    LAS unsigned char* glds = (LAS unsigned char*)(lds + 1024);
    const int lane = threadIdx.x & 63, gw = blockIdx.x * 8 + (threadIdx.x >> 6), nw = gridDim.x * 8;
    VB v; v.vb = blockIdx.x * 2 + (threadIdx.x >> 8); v.nvb = gridDim.x * 2; v.tid = threadIdx.x & 255; v.lds = lds + 64 + (threadIdx.x >> 8) * VB_LDS;

    {
        const int wg = blockIdx.x, nwg = gridDim.x;
        auto ident = [](int j) { return j; };
        auto mixmap = [](int j) {
            const int unit = j >> 8, blk = (j & 255) >> 6;
            if (unit < 2) return C_Q + unit * 256 + blk * 64;
            if (unit == 2) return blk < 2 ? C_KC + blk * 64 : C_VC + (blk - 2) * 64;
            if (unit == 3) return blk < 2 ? C_KS + blk * 64 : C_VS + (blk - 2) * 64;
            if (unit == 4) return blk < 2 ? C_KW + blk * 64 : C_VW + (blk - 2) * 64;
            if (unit < 9) return blk < 2 ? C_CH + (unit - 5) * 128 + blk * 64 : C_CC + (unit - 5) * 128 + (blk - 2) * 64;
            if (unit < 11) return C_CB + (unit - 9) * 256 + blk * 64;
            return blk == 0 ? C_GL : -1;
        };
        p_convT<true>(lds + 1024, p.w_mix_in, D, INC, 1, p.wt_mix_in, 3072, mixmap, wg, nwg);
        p_convT<false>(lds + 1024, p.w_xkv, D, 2048, 1, p.wt_xkv, 2048, ident, wg, nwg);
        p_convT<false>(lds + 1024, p.w_mix_out, D, D, 1, p.wt_mix_out, D, ident, wg, nwg);
        p_convT<false>(lds + 1024, p.w_xq, D, D, 1, p.wt_xq, D, ident, wg, nwg);
        p_convT<false>(lds + 1024, p.w_xo, D, D, 1, p.wt_xo, D, ident, wg, nwg);
        auto gumap = [](int j) { const int blk = j >> 8, w = j & 255; return w < 128 ? 128 * blk + w : 1024 + 128 * blk + (w - 128); };
        p_convT<false>(lds + 1024, p.w_gate_up, D, 2048, NE, p.wt_gu, 2048, gumap, wg, nwg);
        p_convT<false>(lds + 1024, p.w_down, DFF, D, NE, p.wt_dn, D, ident, wg, nwg);
        p_convT<false>(lds + 1024, p.cmp_w1_k, 1024, 256, 2, p.wt_c1k, 256, ident, wg, nwg);
        p_convT<false>(lds + 1024, p.cmp_w1_v, 1024, 256, 2, p.wt_c1v, 256, ident, wg, nwg);
        if (wg == nwg - 1) { if (threadIdx.x < 256) posbias(threadIdx.x, p.cmp_pos_k, p.cmp_w1_k, p.cmp_b1_k, p.b1p_k); else posbias(threadIdx.x - 256, p.cmp_pos_v, p.cmp_w1_v, p.cmp_b1_v, p.b1p_v); }
        __syncthreads();
    }
    p_rope_table(blockIdx.x * 512 + threadIdx.x, gridDim.x * 512, p.positions, p.cosT, p.sinT);
    tl::rmsnorm_rows(p.x, p.g_mix_norm, p.xn_bf, T, gw, nw, lane);
    tl::rmsnorm_rows(p.mem, p.g_mem_norm, p.memn_bf, NB * NMEM, gw, nw, lane);
    xcd_barrier(bar);
    {
        pg::DenseOrder So; So.init(p.xn_bf, p.wt_mix_in, T, 3072, 2048u, 2048u, (int)gridDim.x, (int)blockIdx.x);
        pg::EpiMixIn E{p.q_bf, p.kcmp, p.vslcT, p.u_bf, p.cb_bf, p.gates, p.cosT, p.sinT};
        pg::gemm_phase(glds, D, 2048u, 2048u, So, E);
    }
    {
        pg::DenseOrder So; So.init(p.memn_bf, p.wt_xkv, NB * NMEM, 2048, 2048u, 2048u, (int)gridDim.x, (int)blockIdx.x);
        pg::EpiXkv E{p.xk_bf, p.xvT_bf};
        pg::gemm_phase(glds, D, 2048u, 2048u, So, E);
    }
    xcd_barrier(bar);
    {
        pg::DenseOrder So; So.init(p.kcmp, p.wt_c1k, 2048, 512, 2048u, 2048u, (int)gridDim.x, (int)blockIdx.x);
        pg::EpiF32R E{p.Pab_k, 512, nullptr, 512};
        pg::gemm_phase(glds, 1024, 2048u, 2048u, So, E);
    }
    {
        pg::DenseOrder So; So.init(p.vcmp, p.wt_c1v, 2048, 512, 2048u, 2048u, (int)gridDim.x, (int)((blockIdx.x + gridDim.x - 16) % gridDim.x));
        pg::EpiF32R E{p.Pab_v, 512, nullptr, 512};
        pg::gemm_phase(glds, 1024, 2048u, 2048u, So, E);
    }
    at::p_attn64<1>(lds + 1024, p.q_bf, p.kwin, p.vwinT, p.selmask, p.owin_bf, nullptr, nullptr, nullptr, blockIdx.x, gridDim.x);
    xcd_barrier(bar);
    p_cmp_finalize(lds + 1024, p.Pab_k, p.Pab_v, p.b1p_k, p.b1p_v, p.cmp_w2_k, p.cmp_w2_v, p.kc_bf, p.vcT_bf, blockIdx.x, gridDim.x);
    xcd_barrier(bar);
    at::p_cmp_attn_fast(lds + 1024, p.q_bf, p.kc_bf, p.vcT_bf, p.ocmp_bf, p.selmask, blockIdx.x, gridDim.x);
    xcd_barrier(bar);
    at::p_attn64<0>(lds + 1024, p.q_bf, p.kslc, p.vslcT, p.selmask, p.onsa_bf, p.ocmp_bf, p.owin_bf, p.gates, blockIdx.x, gridDim.x);
    xcd_barrier(bar);
    tl::mix_post(p.onsa_bf, p.u_bf, p.cb_bf, p.conv_w, p.g_nsa_out, p.g_conv_out, p.xn_bf  , gw, nw, lane);
    xcd_barrier(bar);
    {
        pg::DenseOrder So; So.init(p.xn_bf, p.wt_mix_out, T, D, 2048u, 2048u, (int)gridDim.x, (int)blockIdx.x);
        pg::EpiF32R E{p.hbuf, D, p.x, D};
        pg::gemm_phase(glds, D, 2048u, 2048u, So, E);
    }
    xcd_barrier(bar);
    tl::rmsnorm_rows(p.hbuf, p.g_xattn_norm, p.xn_bf, T, gw, nw, lane);
    xcd_barrier(bar);
    {
        pg::DenseOrder So; So.init(p.xn_bf, p.wt_xq, T, D, 2048u, 2048u, (int)gridDim.x, (int)blockIdx.x);
        pg::EpiBf16S E{p.xq_bf, D, 0.0625f * 1.4426950408889634f};
        pg::gemm_phase(glds, D, 2048u, 2048u, So, E);
    }
    xcd_barrier(bar);
    at::p_xattn_fast(lds + 1024, p.xq_bf, p.xk_bf, p.xvT_bf, p.xo_bf, blockIdx.x, gridDim.x);
    xcd_barrier(bar);
    {
        pg::DenseOrder So; So.init(p.xo_bf, p.wt_xo, T, D, 2048u, 2048u, (int)gridDim.x, (int)blockIdx.x);
        pg::EpiF32R E{p.hbuf, D, p.hbuf, D};
        pg::gemm_phase(glds, D, 2048u, 2048u, So, E);
    }
    xcd_barrier(bar);
    tl::norm_router(lds + 1024, p.hbuf, p.g_moe_norm, p.w_router, p.b_router, p.xn_bf, p.a_e, p.a_w, p.a_slot, p.counts, gw, nw, lane);
    xcd_barrier(bar);
    tl::moe_scatter(lds + 1024, p.counts, p.pstart, p.tile_e, p.a_e, p.a_w, p.a_slot, p.xn_bf, p.xg, p.w_buf, p.dest_of, blockIdx.x, gw, nw, lane);
    xcd_barrier(bar);
    {
        pg::MoeOrder<8> So; So.init(p.xg, p.wt_gu, p.tile_e, p.pstart[NE], (size_t)2048 * 2048, (int)gridDim.x, (int)blockIdx.x);
        pg::EpiSwiglu E{p.hmid, p.b_gate_up};
        pg::gemm_phase(glds, D, 2048u, 2048u, So, E);
    }
    xcd_barrier(bar);
    {
        pg::MoeOrder<4> So; So.init(p.hmid, p.wt_dn, p.tile_e, p.pstart[NE], (size_t)1024 * 2048, (int)gridDim.x, (int)blockIdx.x);
        pg::EpiDownScale E{p.out_a, p.b_down, p.w_buf};
        pg::gemm_phase(glds, DFF, 2048u, 2048u, So, E);
    }
    xcd_barrier(bar);
    tl::final_rows(p.hbuf, p.out_a, p.dest_of, p.g_final, p.out, gw, nw, lane);
}
__global__ void k_fail(float* out, int n) { const int i = blockIdx.x * 256 + threadIdx.x; if (i < n) out[i] = __builtin_nanf(""); }
}

extern "C" void kernel_launch(void* const* d_in, const int* in_sizes, int n_in, void* d_out, int out_size, void* d_ws, size_t ws_size, hipStream_t stream) {
    Params p{};
    p.x = (const float*)d_in[0]; p.mem = (const float*)d_in[1]; p.positions = (const int*)d_in[2];
    const float** fp = &p.g_mix_norm;
    for (int i = 0; i < 27; ++i) fp[i] = (const float*)d_in[3 + i];
    p.out = (float*)d_out;

    char* ws = (char*)d_ws;
    size_t off = 0;
    auto take = [&](size_t bytes) { char* q = ws + off; off += (bytes + 255) & ~(size_t)255; return q; };
    p.bar = (unsigned*)take(XCD_BAR_WORDS * 4);
    p.counts = (int*)take(NE * 4);
    const size_t zero_bytes = off;
    p.pstart = (int*)take((NE + 1) * 4);
    p.tile_e = (int*)take(NTILE * 4);
    p.a_e = (int*)take(NA * 4);
    p.a_w = (float*)take(NA * 4);
    p.a_slot = (int*)take(NA * 4);
    p.dest_of = (int*)take(NA * 4);
    p.w_buf = (float*)take(PMAX * 4);
    p.selmask = (unsigned*)take((size_t)NB * 2 * S * 4);
    p.hbuf = (float*)take((size_t)T * D * 4);
    p.xg = (unsigned short*)take((size_t)PMAX * D * 2);
    p.out_a = p.xg;
    p.hmid = (unsigned short*)take((size_t)PMAX * DFF * 2);
    p.wt_gu = (unsigned short*)take((size_t)NE * 2048 * D * 2);
    p.wt_dn = (unsigned short*)take((size_t)NE * D * DFF * 2);
    p.q_bf = (unsigned short*)take((size_t)T * 512 * 2);
    p.kcmp = (unsigned short*)take((size_t)T * 128 * 2 * 4); p.vcmp = p.kcmp + (size_t)T * 128; p.kslc = p.vcmp + (size_t)T * 128; p.kwin = p.kslc + (size_t)T * 128;
    p.vslcT = (unsigned short*)take((size_t)T * 128 * 2 * 2); p.vwinT = p.vslcT + (size_t)T * 128;
    p.u_bf = (unsigned short*)take((size_t)T * 512 * 2); p.cb_bf = (unsigned short*)take((size_t)T * 512 * 2);
    p.gates = (float*)take((size_t)T * 24 * 4); p.cosT = (float*)take((size_t)T * 32 * 4); p.sinT = (float*)take((size_t)T * 32 * 4);
    p.wt_c1k = (unsigned short*)take((size_t)512 * 1024 * 2); p.wt_c1v = (unsigned short*)take((size_t)512 * 1024 * 2);
    p.kc_bf = (unsigned short*)take((size_t)16 * 128 * 64 * 2); p.vcT_bf = (unsigned short*)take((size_t)16 * 64 * 128 * 2);
    p.Pab_k = (float*)take((size_t)(2048 + 1) * 512 * 4); p.Pab_v = (float*)take((size_t)(2048 + 1) * 512 * 4);
    p.b1p_k = (float*)take(256 * 4); p.b1p_v = (float*)take(256 * 4);
    p.ocmp_bf = (unsigned short*)take((size_t)T * 512 * 2); p.owin_bf = (unsigned short*)take((size_t)T * 512 * 2); p.onsa_bf = (unsigned short*)take((size_t)T * 512 * 2);
    p.xq_bf = (unsigned short*)take((size_t)T * D * 2); p.xk_bf = (unsigned short*)take((size_t)NB * NMEM * D * 2); p.xvT_bf = (unsigned short*)take((size_t)NB * NMEM * D * 2);
    p.xn_bf = (unsigned short*)take((size_t)T * D * 2);
    p.memn_bf = (unsigned short*)take((size_t)NB * NMEM * D * 2);
    p.xo_bf = (unsigned short*)take((size_t)T * D * 2);
    p.wt_mix_in = (unsigned short*)take((size_t)3072 * D * 2);
    p.wt_xkv = (unsigned short*)take((size_t)2048 * D * 2);
    p.wt_mix_out = (unsigned short*)take((size_t)D * D * 2);
    p.wt_xq = (unsigned short*)take((size_t)D * D * 2);
    p.wt_xo = (unsigned short*)take((size_t)D * D * 2);

    static int grid = 0;
    if (grid == 0) {
        int dev = 0, cus = 0;
        if (hipGetDevice(&dev) != hipSuccess || hipDeviceGetAttribute(&cus, hipDeviceAttributeMultiprocessorCount, dev) != hipSuccess) cus = -1;
        if (hipFuncSetAttribute((const void*)mega_fwd, hipFuncAttributeMaxDynamicSharedMemorySize, LDS_BYTES) != hipSuccess) cus = -1;
        int per_cu = 0;
        if (cus > 0 && (hipOccupancyMaxActiveBlocksPerMultiprocessor(&per_cu, (const void*)mega_fwd, 512, LDS_BYTES) != hipSuccess || per_cu < 1)) cus = -1;
        (void)hipGetLastError();
        grid = cus > 0 ? cus : -1;
    }
    if (grid < 0 || off > ws_size) { k_fail<<<(out_size + 255) / 256, 256, 0, stream>>>((float*)d_out, out_size); return; }
    (void)hipMemsetAsync(d_ws, 0, zero_bytes, stream);
    hipLaunchKernelGGL(mega_fwd, dim3(grid), dim3(512), LDS_BYTES, stream, p);
}
```

```cpp
#include <hip/hip_runtime.h>
#include <hip/hip_bf16.h>
#include <stdint.h>
#include <cstdio>

#define XB_TMO      128
#define XB_XCNT(j)  (256  + 64 * (j))
#define XB_XSUB(j)  (1280 + 64 * (j))
#define XB_XGEN(j)  (2304 + 64 * (j))
#define XB_TOP      3328
#define XB_TOPGEN   3392
#define XCD_BAR_WORDS 3456
#define XB_SPIN_CAP (1u << 18)
#define LAS __attribute__((address_space(3)))

__device__ __forceinline__ unsigned xb_ld(unsigned* p)              { return __hip_atomic_load(p, __ATOMIC_RELAXED, __HIP_MEMORY_SCOPE_AGENT); }
__device__ __forceinline__ unsigned xb_add(unsigned* p, unsigned v) { return __hip_atomic_fetch_add(p, v, __ATOMIC_RELAXED, __HIP_MEMORY_SCOPE_AGENT); }
__device__ __forceinline__ unsigned xb_xcc_id() { return (unsigned)__builtin_amdgcn_s_getreg((3 << 11) | 20) & 0xFu; }
#define XB_SPIN(cond, bar) do { unsigned _sp = 0; while (cond) { __builtin_amdgcn_s_sleep(1); \
    if ((++_sp & 255u) == 0u) { if (xb_ld(&(bar)[XB_TMO])) break; if (_sp > XB_SPIN_CAP) { atomicAdd(&(bar)[XB_TMO], 1u); break; } } } } while (0)

struct XcdBarrier {
    unsigned* bar; unsigned x;
    volatile LAS unsigned* st;
};

__device__ __forceinline__ XcdBarrier xcd_barrier_post(unsigned* bar, volatile LAS unsigned* st) {
    XcdBarrier b; b.bar = bar; b.x = xb_xcc_id(); b.st = st;
    if (threadIdx.x == 0) (void)xb_add(&bar[XB_XCNT(b.x)], 1u);
    return b;
}
__device__ __forceinline__ void xcd_barrier_complete(unsigned* bar, unsigned x, unsigned& nloc, unsigned& nx) {
    const unsigned G = gridDim.x * gridDim.y * gridDim.z;
    unsigned sum, cnt, mine, sp = 0u;
    for (;;) {
        sum = 0u; cnt = 0u; mine = 0u;
#pragma unroll
        for (unsigned j = 0; j < 16; ++j) { const unsigned c = xb_ld(&bar[XB_XCNT(j)]); sum += c; cnt += (c > 0u) ? 1u : 0u; mine = (j == x) ? c : mine; }
        if (sum == G) break;
        __builtin_amdgcn_s_sleep(1);
        if ((++sp & 255u) == 0u) { if (xb_ld(&bar[XB_TMO])) break; if (sp > XB_SPIN_CAP) { atomicAdd(&bar[XB_TMO], 1u); break; } }
    }
    nloc = mine > 0u ? mine : 1u; nx = cnt > 0u ? cnt : 1u;
}

__device__ __forceinline__ void xcd_barrier(const XcdBarrier& b) {
    asm volatile("s_waitcnt vmcnt(0)" ::: "memory");
    __syncthreads();
    if (threadIdx.x == 0) {
        unsigned* bar = b.bar;
        __builtin_amdgcn_s_waitcnt(0);
        unsigned nloc = b.st[0], nx = b.st[1];
        if (nloc == 0u) { xcd_barrier_complete(bar, b.x, nloc, nx); b.st[0] = nloc; b.st[1] = nx; }
        const unsigned old = xb_add(&bar[XB_XSUB(b.x)], 1u);
        const unsigned gen = old / nloc;
        if (old + 1u == (gen + 1u) * nloc) {
            __builtin_amdgcn_fence(__ATOMIC_RELEASE, "agent");
            asm volatile("s_waitcnt vmcnt(0)" ::: "memory");
            const unsigned og = xb_add(&bar[XB_TOP], 1u);
            const unsigned tg = og / nx;
            if (og + 1u == (tg + 1u) * nx) xb_add(&bar[XB_TOPGEN], 1u);
            else XB_SPIN(xb_ld(&bar[XB_TOPGEN]) == tg, bar);
            __builtin_amdgcn_fence(__ATOMIC_ACQUIRE, "agent");
            xb_add(&bar[XB_XGEN(b.x)], 1u);
            asm volatile("s_waitcnt vmcnt(0)" ::: "memory");
        } else {
            XB_SPIN(xb_ld(&bar[XB_XGEN(b.x)]) == gen, bar);
            __builtin_amdgcn_fence(__ATOMIC_ACQUIRE, "agent");
            asm volatile("s_waitcnt vmcnt(0)" ::: "memory");
        }
    }
    __syncthreads();
}


namespace {
constexpr int D = 1024, NB = 8, S = 2048, T = NB * S, NMEM = 256;
constexpr int INC = 2840;
constexpr int C_Q = 0, C_KC = 512, C_VC = 640, C_KS = 768, C_VS = 896, C_KW = 1024, C_VW = 1152, C_GL = 1280, C_CH = 1304, C_CB = 1816, C_CC = 2328;
constexpr int NC = 127, NCR = NB * NC * 2;
constexpr int NE = 32, TOPK = 4, DFF = 1024, NA = T * TOPK;
constexpr int MT = 256;
constexpr int PMAX = NA + NE * MT, NTILE = PMAX / MT;
constexpr int LDS_BYTES = 144 * 1024, VB_LDS = 40960;
constexpr float QS = 0.125f * 1.4426950408889634f;

__device__ __forceinline__ int opaque_tid() { int t = threadIdx.x; asm volatile("" : "+v"(t)); return t; }
__device__ __forceinline__ float wave_sum(float v) { for (int o = 32; o > 0; o >>= 1) v += __shfl_xor(v, o); return v; }
__device__ __forceinline__ float wave_max(float v) { for (int o = 32; o > 0; o >>= 1) v = fmaxf(v, __shfl_xor(v, o)); return v; }

namespace pg { __device__ __forceinline__ unsigned cvt_pk_bf16(float lo, float hi); __device__ __forceinline__ unsigned cvt_pk_bf16_acc(float lo, float hi); }
struct VB { int vb, nvb, tid; char* lds; };
#define VB_ITEMS(n) for (int _it = 0, item = v.vb; _it < ((n) + v.nvb - 1) / v.nvb; ++_it, item += v.nvb)

__device__ __forceinline__ void p_rmsnorm(const VB& v, int rows, const float* __restrict__ in, int ldi, const float* __restrict__ g, float* __restrict__ out, int ldo, int W) {
    float* red = (float*)v.lds;
    VB_ITEMS(rows) {
        const bool act = item < rows;
        const float* r = in + (size_t)(act ? item : 0) * ldi;
        float ss = 0.f;
        for (int i = v.tid; i < W; i += 256) { float x = r[i]; ss += x * x; }
        ss = wave_sum(ss);
        __syncthreads();
        if ((v.tid & 63) == 0) red[v.tid >> 6] = ss;
        __syncthreads();
        ss = red[0] + red[1] + red[2] + red[3];
        const float rs = rsqrtf(ss / (float)W + 1e-5f);
        if (act) { float* o = out + (size_t)item * ldo; for (int i = v.tid; i < W; i += 256) o[i] = r[i] * rs * g[i]; }
    }
}

__device__ __forceinline__ unsigned short f2bf_rne(float f) { unsigned u = __float_as_uint(f); u += 0x7FFFu + ((u >> 16) & 1u); return (unsigned short)(u >> 16); }
__device__ __forceinline__ void p_rmsnorm_bf(const VB& v, int rows, const float* __restrict__ in, int ldi, const float* __restrict__ g, unsigned short* __restrict__ out, int ldo, int W) {
    float* red = (float*)v.lds;
    VB_ITEMS(rows) {
        const bool act = item < rows;
        const float* r = in + (size_t)(act ? item : 0) * ldi;
        float ss = 0.f;
        for (int i = v.tid; i < W; i += 256) { float x = r[i]; ss += x * x; }
        ss = wave_sum(ss);
        __syncthreads();
        if ((v.tid & 63) == 0) red[v.tid >> 6] = ss;
        __syncthreads();
        ss = red[0] + red[1] + red[2] + red[3];
        const float rs = rsqrtf(ss / (float)W + 1e-5f);
        if (act) { unsigned short* o = out + (size_t)item * ldo; for (int i = v.tid; i < W; i += 256) o[i] = f2bf_rne(r[i] * rs * g[i]); }
    }
}

template <int NACC, class AL, class BL>
__device__ __forceinline__ void gemm_tile_f32(int tid, float (&acc)[NACC][4][4], int K, AL al, BL bl, float (*As)[68], float (*Bs)[NACC * 64 + 4]) {
    const int tx = tid & 15, ty = tid >> 4;
    const int ar = tid >> 2, ak = (tid & 3) * 4;
    const int bk = tid >> 4, bc = (tid & 15) * 4;
#pragma unroll
    for (int w = 0; w < NACC; ++w)
#pragma unroll
        for (int i = 0; i < 4; ++i)
#pragma unroll
            for (int j = 0; j < 4; ++j) acc[w][i][j] = 0.f;
    for (int k0 = 0; k0 < K; k0 += 16) {
        const float4 a = al(ar, k0 + ak);
        float4 b[NACC];
#pragma unroll
        for (int w = 0; w < NACC; ++w) b[w] = bl(w, k0 + bk, bc);
        __syncthreads();
        As[ak + 0][ar] = a.x; As[ak + 1][ar] = a.y; As[ak + 2][ar] = a.z; As[ak + 3][ar] = a.w;
#pragma unroll
        for (int w = 0; w < NACC; ++w) *(float4*)&Bs[bk][w * 64 + bc] = b[w];
        __syncthreads();
#pragma unroll
        for (int kk = 0; kk < 16; ++kk) {
            const float4 av = *(const float4*)&As[kk][ty * 4];
            const float aa[4] = {av.x, av.y, av.z, av.w};
#pragma unroll
            for (int w = 0; w < NACC; ++w) {
                const float4 bv = *(const float4*)&Bs[kk][w * 64 + tx * 4];
                const float bb[4] = {bv.x, bv.y, bv.z, bv.w};
#pragma unroll
                for (int i = 0; i < 4; ++i)
#pragma unroll
                    for (int j = 0; j < 4; ++j) acc[w][i][j] += aa[i] * bb[j];
            }
        }
    }
}

__device__ __forceinline__ void p_gemm(const VB& v, const float* __restrict__ A, int lda, const float* __restrict__ Bm, int ldb, float* C, int ldc, const float* res, int M, int N, int K) {
    float (*As)[68] = (float (*)[68])v.lds;
    float (*Bs)[68] = (float (*)[68])(v.lds + 16 * 68 * 4);
    const int nx = (N + 63) / 64, ny = (M + 63) / 64, nt = nx * ny;
    VB_ITEMS(nt) {
        const bool act = item < nt;
        const int row0 = act ? (item / nx) * 64 : M, col0 = act ? (item % nx) * 64 : N;
        float acc[1][4][4];
        auto al = [&](int r, int k) -> float4 { const int row = row0 + r; return row < M ? *(const float4*)(A + (size_t)row * lda + k) : make_float4(0.f, 0.f, 0.f, 0.f); };
        auto bl = [&](int, int k, int c) -> float4 { const int col = col0 + c; return col < N ? *(const float4*)(Bm + (size_t)k * ldb + col) : make_float4(0.f, 0.f, 0.f, 0.f); };
        gemm_tile_f32<1>(v.tid, acc, K, al, bl, As, Bs);
        const int tx = v.tid & 15, ty = v.tid >> 4;
#pragma unroll
        for (int i = 0; i < 4; ++i) {
            const int row = row0 + ty * 4 + i;
            if (row >= M) continue;
#pragma unroll
            for (int j = 0; j < 4; ++j) {
                const int col = col0 + tx * 4 + j;
                if (col >= N) continue;
                float x = acc[0][i][j];
                if (res) x += res[(size_t)row * ldc + col];
                C[(size_t)row * ldc + col] = x;
            }
        }
    }
}

__device__ __forceinline__ void p_rope(const VB& v, float* __restrict__ proj, const int* __restrict__ pos) {
    VB_ITEMS(T) {
        if (item >= T) continue;
        const int t = item;
        const float p = (float)pos[t];
        float* r = proj + (size_t)t * INC;
        for (int i = v.tid; i < 448; i += 256) {
            const int hd = i >> 5, f = i & 31;
            int col;
            if (hd < 8) col = C_Q + hd * 64; else if (hd < 10) col = C_KC + (hd - 8) * 64; else if (hd < 12) col = C_KS + (hd - 10) * 64; else col = C_KW + (hd - 12) * 64;
            const float inv = powf(10000.f, -(float)f / 32.f);
            const float ang = p * inv;
            const float c = cosf(ang), s = sinf(ang);
            const float t1 = r[col + f], t2 = r[col + 32 + f];
            r[col + f] = t1 * c - t2 * s;
            r[col + 32 + f] = t2 * c + t1 * s;
        }
    }
}

__device__ __forceinline__ float gelu_tanh(float x) { const float u = 0.7978845608028654f * (x + 0.044715f * x * x * x); return 0.5f * x * (1.f + tanhf(u)); }
__device__ __forceinline__ void p_cmp1(const VB& v, const float* __restrict__ proj, int colbase, const float* __restrict__ pos, const float* __restrict__ w1, const float* __restrict__ b1, float* __restrict__ hid) {
    float (*As)[68] = (float (*)[68])v.lds;
    float (*Bs)[68] = (float (*)[68])(v.lds + 16 * 68 * 4);
    const int nx = 4, ny = (NCR + 63) / 64, nt = nx * ny;
    VB_ITEMS(nt) {
        const bool act = item < nt;
        const int row0 = act ? (item / nx) * 64 : NCR, col0 = act ? (item % nx) * 64 : 0;
        float acc[1][4][4];
        auto al = [&](int r, int k) -> float4 {
            const int row = row0 + r; if (row >= NCR) return make_float4(0.f, 0.f, 0.f, 0.f);
            const int g = row & 1, bc = row >> 1, c = bc % NC, b = bc / NC, l = k >> 6, d = k & 63;
            const float4 x = *(const float4*)(proj + (size_t)(b * S + 16 * c + l) * INC + colbase + g * 64 + d);
            const float4 pe = *(const float4*)(pos + k);
            return make_float4(x.x + pe.x, x.y + pe.y, x.z + pe.z, x.w + pe.w);
        };
        auto bl = [&](int, int k, int c) -> float4 { return *(const float4*)(w1 + (size_t)k * 256 + col0 + c); };
        gemm_tile_f32<1>(v.tid, acc, 2048, al, bl, As, Bs);
        const int tx = v.tid & 15, ty = v.tid >> 4;
#pragma unroll
        for (int i = 0; i < 4; ++i) {
            const int row = row0 + ty * 4 + i;
            if (row >= NCR) continue;
#pragma unroll
            for (int j = 0; j < 4; ++j) { const int col = col0 + tx * 4 + j; hid[(size_t)row * 256 + col] = gelu_tanh(acc[0][i][j] + b1[col]); }
        }
    }
}

__device__ __forceinline__ void st_out(float* p, float x) { *p = x; }
__device__ __forceinline__ void st_out(unsigned short* p, float x) { *p = f2bf_rne(x); }
template <int DH, class KeyF, class OutT>
__device__ __forceinline__ void wave_attend(const float* q, int ncand, KeyF keyf, float* sc, OutT* out, int lane) {
    float m = -3.0e38f;
    for (int idx = lane; idx < ncand; idx += 64) {
        const float *kp, *vp;
        float s = -3.0e38f;
        if (keyf(idx, kp, vp)) {
            s = 0.f;
#pragma unroll 4
            for (int d = 0; d < DH; d += 4) { const float4 kv = *(const float4*)(kp + d); s += q[d] * kv.x + q[d + 1] * kv.y + q[d + 2] * kv.z + q[d + 3] * kv.w; }
        }
        sc[idx] = s;
        m = fmaxf(m, s);
    }
    m = wave_max(m);
    float sum = 0.f;
    for (int idx = lane; idx < ncand; idx += 64) { const float s = sc[idx]; const float p = (s > -1.0e38f) ? __expf(s - m) : 0.f; sc[idx] = p; sum += p; }
    sum = wave_sum(sum);
    const float inv = (m > -1.0e38f) ? 1.f / sum : 0.f;
    for (int idx = lane; idx < ncand; idx += 64) sc[idx] *= inv;
    __builtin_amdgcn_s_waitcnt(0);
    float o[DH / 64];
#pragma unroll
    for (int i = 0; i < DH / 64; ++i) o[i] = 0.f;
    for (int idx = 0; idx < ncand; ++idx) {
        const float p = sc[idx];
        if (p == 0.f) continue;
        const float *kp, *vp;
        keyf(idx, kp, vp);
#pragma unroll
        for (int i = 0; i < DH / 64; ++i) o[i] += p * vp[lane + 64 * i];
    }
#pragma unroll
    for (int i = 0; i < DH / 64; ++i) st_out(out + lane + 64 * i, o[i]);
}

__device__ __forceinline__ void p_cmp_attn(const VB& v, const float* __restrict__ proj, const float* __restrict__ kc, const float* __restrict__ vc,
                                           float* __restrict__ o_cmp, unsigned* __restrict__ selmask) {
    float (*qs)[64] = (float (*)[64])v.lds;
    float (*ps)[128] = (float (*)[128])(v.lds + 1024);
    float* imps = (float*)(v.lds + 1024 + 2048);
    VB_ITEMS(T * 2) {
        const int g = item & 1, t = item >> 1, b = t / S, s = t % S;
        const int w = v.tid >> 6, lane = v.tid & 63, h = g * 4 + w;
        __syncthreads();
        qs[w][lane] = proj[(size_t)t * INC + C_Q + h * 64 + lane] * 0.125f;
        ps[w][lane] = 0.f; ps[w][lane + 64] = 0.f;
        __syncthreads();
        auto keyf = [&](int c, const float*& kp, const float*& vp) -> bool {
            kp = kc + (size_t)((b * NC + c) * 2 + g) * 64; vp = vc + (size_t)((b * NC + c) * 2 + g) * 64;
            return 16 * c + 31 <= s;
        };
        wave_attend<64>(qs[w], NC, keyf, ps[w], o_cmp + (size_t)t * 512 + h * 64, lane);
        __syncthreads();
        if (v.tid < 32) {
            const int j = v.tid;
            float imp = 0.f;
            for (int hh = 0; hh < 4; ++hh)
                for (int c = 4 * j - 1; c <= 4 * j + 3; ++c) {
                    if (c < 0 || c >= NC) continue;
                    const float ov = (c == 4 * j - 1 || c == 4 * j + 3) ? 0.5f : 1.0f;
                    imp += ps[hh][c] * ov;
                }
            const int cur = s >> 6;
            if (j == 0 || j == cur || j == cur - 1) imp = 1e30f; else if (j > cur) imp = -1e30f;
            imps[j] = imp;
        }
        __syncthreads();
        if (v.tid < 64) {
            const int j = v.tid & 31;
            const float mine = imps[j];
            int rank = 0;
            for (int i = 0; i < 32; ++i) { const float x = imps[i]; rank += (x > mine || (x == mine && i < j)) ? 1 : 0; }
            const unsigned long long bal = __ballot(rank < 16 && v.tid < 32);
            if (v.tid == 0) selmask[(size_t)(b * 2 + g) * S + s] = (unsigned)(bal & 0xffffffffull);
        }
    }
}

template <int MODE>
__device__ __forceinline__ void p_nsa_attn(const VB& v, const float* __restrict__ proj, const unsigned* __restrict__ selmask, float* __restrict__ outp) {
    float (*qs)[64] = (float (*)[64])v.lds;
    float (*scs)[2048] = (float (*)[2048])(v.lds + 1024);
    VB_ITEMS(T * 2) {
        const int g = item & 1, t = item >> 1, b = t / S, s = t % S;
        const int w = v.tid >> 6, lane = v.tid & 63, h = g * 4 + w;
        qs[w][lane] = proj[(size_t)t * INC + C_Q + h * 64 + lane] * 0.125f;
        __builtin_amdgcn_s_waitcnt(0);
        if (MODE == 0) {
            const unsigned mask = selmask[(size_t)(b * 2 + g) * S + s];
            const int ncand = ((s >> 6) + 1) * 64;
            auto keyf = [&](int idx, const float*& kp, const float*& vp) -> bool {
                const float* r = proj + (size_t)(b * S + idx) * INC + g * 64;
                kp = r + C_KS; vp = r + C_VS;
                return idx <= s && ((mask >> (idx >> 6)) & 1u);
            };
            wave_attend<64>(qs[w], ncand, keyf, scs[w], outp + (size_t)t * 512 + h * 64, lane);
        } else {
            const int lo = s - 511 > 0 ? s - 511 : 0;
            const int ncand = s - lo + 1;
            auto keyf = [&](int idx, const float*& kp, const float*& vp) -> bool {
                const float* r = proj + (size_t)(b * S + lo + idx) * INC + g * 64;
                kp = r + C_KW; vp = r + C_VW;
                return true;
            };
            wave_attend<64>(qs[w], ncand, keyf, scs[w], outp + (size_t)t * 512 + h * 64, lane);
        }
    }
}

__device__ __forceinline__ void p_xattn(const VB& v, const float* __restrict__ xq, const float* __restrict__ xkv, unsigned short* __restrict__ xo) {
    float (*qs)[256] = (float (*)[256])v.lds;
    float (*scs)[256] = (float (*)[256])(v.lds + 4096);
    VB_ITEMS(T) {
        const int t = item, b = t / S, w = v.tid >> 6, lane = v.tid & 63;
        for (int i = lane; i < 256; i += 64) qs[w][i] = xq[(size_t)t * D + w * 256 + i] * 0.0625f;
        __builtin_amdgcn_s_waitcnt(0);
        auto keyf = [&](int m, const float*& kp, const float*& vp) -> bool {
            const float* r = xkv + (size_t)(b * NMEM + m) * 2048 + w * 256;
            kp = r; vp = r + 1024;
            return true;
        };
        wave_attend<256>(qs[w], NMEM, keyf, scs[w], xo + (size_t)t * D + w * 256, lane);
    }
}

__device__ __forceinline__ void p_mix_post(const VB& v, const float* __restrict__ proj, const float* __restrict__ o_cmp, const float* __restrict__ o_slc, const float* __restrict__ o_win,
                                           const float* __restrict__ conv_w, const float* __restrict__ g_nsa, const float* __restrict__ g_conv, unsigned short* __restrict__ omix) {
    float (*red)[4] = (float (*)[4])v.lds;
    VB_ITEMS(T) {
        const int t = item, s = t % S, tid = v.tid;
        const float* r = proj + (size_t)t * INC;
        float on[2], oc[2], ssn = 0.f, ssc = 0.f;
#pragma unroll
        for (int e = 0; e < 2; ++e) {
            const int c = tid + 256 * e, h = c >> 6;
            const float g0 = 1.f / (1.f + __expf(-r[C_GL + h * 3 + 0])), g1 = 1.f / (1.f + __expf(-r[C_GL + h * 3 + 1])), g2 = 1.f / (1.f + __expf(-r[C_GL + h * 3 + 2]));
            on[e] = g0 * o_cmp[(size_t)t * 512 + c] + g1 * o_slc[(size_t)t * 512 + c] + g2 * o_win[(size_t)t * 512 + c];
            ssn += on[e] * on[e];
            float y = 0.f;
#pragma unroll
            for (int k = 0; k < 3; ++k) {
                const int sp = s - 2 + k;
                if (sp < 0) continue;
                const float* rp = proj + (size_t)(t - 2 + k) * INC;
                y += conv_w[k * 512 + c] * (rp[C_CC + c] * rp[C_CH + c]);
            }
            oc[e] = r[C_CB + c] * y;
            ssc += oc[e] * oc[e];
        }
        ssn = wave_sum(ssn); ssc = wave_sum(ssc);
        __syncthreads();
        if ((tid & 63) == 0) { red[0][tid >> 6] = ssn; red[1][tid >> 6] = ssc; }
        __syncthreads();
        ssn = red[0][0] + red[0][1] + red[0][2] + red[0][3];
        ssc = red[1][0] + red[1][1] + red[1][2] + red[1][3];
        const float rn = rsqrtf(ssn / 512.f + 1e-5f), rc = rsqrtf(ssc / 512.f + 1e-5f);
#pragma unroll
        for (int e = 0; e < 2; ++e) {
            const int c = tid + 256 * e;
            omix[(size_t)t * D + c] = f2bf_rne(on[e] * rn * g_nsa[c]);
            omix[(size_t)t * D + 512 + c] = f2bf_rne(oc[e] * rc * g_conv[c]);
        }
    }
}


__device__ __forceinline__ float bfu(unsigned short b) { return __uint_as_float(((unsigned)b) << 16); }
__device__ __forceinline__ void p_rope_table(int gtid, int gn, const int* __restrict__ pos, float* __restrict__ cosT, float* __restrict__ sinT) {
    for (int i = gtid; i < T * 32; i += gn) {
        const int t = i >> 5, f = i & 31;
        const float inv = powf(10000.f, -(float)f / 32.f);
        const float ang = (float)pos[t] * inv;
        cosT[i] = cosf(ang); sinT[i] = sinf(ang);
    }
}
template <int DH, class ValidF, class KRow, class VGet, class OutT>
__device__ __forceinline__ void wave_attend_bf(const float* q, int ncand, ValidF valid, KRow krow, VGet vget, float* sc, OutT* out, int lane) {
    float m = -3.0e38f;
    for (int idx = lane; idx < ncand; idx += 64) {
        float s = -3.0e38f;
        if (valid(idx)) {
            const unsigned short* kp = krow(idx);
            s = 0.f;
#pragma unroll 2
            for (int d = 0; d < DH; d += 8) {
                const uint4 kv = *(const uint4*)(kp + d);
                s += q[d] * __uint_as_float(kv.x << 16) + q[d + 1] * __uint_as_float(kv.x & 0xffff0000u) + q[d + 2] * __uint_as_float(kv.y << 16) + q[d + 3] * __uint_as_float(kv.y & 0xffff0000u)
                   + q[d + 4] * __uint_as_float(kv.z << 16) + q[d + 5] * __uint_as_float(kv.z & 0xffff0000u) + q[d + 6] * __uint_as_float(kv.w << 16) + q[d + 7] * __uint_as_float(kv.w & 0xffff0000u);
            }
        }
        sc[idx] = s;
        m = fmaxf(m, s);
    }
    m = wave_max(m);
    float sum = 0.f;
    for (int idx = lane; idx < ncand; idx += 64) { const float s = sc[idx]; const float p = (s > -1.0e38f) ? exp2f(s - m) : 0.f; sc[idx] = p; sum += p; }
    sum = wave_sum(sum);
    const float inv = (m > -1.0e38f) ? 1.f / sum : 0.f;
    for (int idx = lane; idx < ncand; idx += 64) sc[idx] *= inv;
    __builtin_amdgcn_s_waitcnt(0);
    float o[DH / 64];
#pragma unroll
    for (int i = 0; i < DH / 64; ++i) o[i] = 0.f;
    for (int idx = 0; idx < ncand; ++idx) {
        const float p = sc[idx];
        if (p == 0.f) continue;
#pragma unroll
        for (int i = 0; i < DH / 64; ++i) o[i] += p * vget(idx, lane + 64 * i);
    }
#pragma unroll
    for (int i = 0; i < DH / 64; ++i) st_out(out + lane + 64 * i, o[i]);
}

__device__ __forceinline__ void p_cmp1_bf(const VB& v, const unsigned short* __restrict__ src, const float* __restrict__ pos, const float* __restrict__ w1, const float* __restrict__ b1, float* __restrict__ hid) {
    float (*As)[68] = (float (*)[68])v.lds;
    float (*Bs)[68] = (float (*)[68])(v.lds + 16 * 68 * 4);
    const int nx = 4, ny = (NCR + 63) / 64, nt = nx * ny;
    VB_ITEMS(nt) {
        const bool act = item < nt;
        const int row0 = act ? (item / nx) * 64 : NCR, col0 = act ? (item % nx) * 64 : 0;
        float acc[1][4][4];
        auto al = [&](int r, int k) -> float4 {
            const int row = row0 + r; if (row >= NCR) return make_float4(0.f, 0.f, 0.f, 0.f);
            const int g = row & 1, bc = row >> 1, c = bc % NC, b = bc / NC, l = k >> 6, d = k & 63;
            const uint2 x = *(const uint2*)(src + ((size_t)(b * 2 + g) * S + 16 * c + l) * 64 + d);
            const float4 pe = *(const float4*)(pos + k);
            return make_float4(__uint_as_float(x.x << 16) + pe.x, __uint_as_float(x.x & 0xffff0000u) + pe.y, __uint_as_float(x.y << 16) + pe.z, __uint_as_float(x.y & 0xffff0000u) + pe.w);
        };
        auto bl = [&](int, int k, int c) -> float4 { return *(const float4*)(w1 + (size_t)k * 256 + col0 + c); };
        gemm_tile_f32<1>(v.tid, acc, 2048, al, bl, As, Bs);
        const int tx = v.tid & 15, ty = v.tid >> 4;
#pragma unroll
        for (int i = 0; i < 4; ++i) {
            const int row = row0 + ty * 4 + i;
            if (row >= NCR) continue;
#pragma unroll
            for (int j = 0; j < 4; ++j) { const int col = col0 + tx * 4 + j; hid[(size_t)row * 256 + col] = gelu_tanh(acc[0][i][j] + b1[col]); }
        }
    }
}
__device__ __forceinline__ void p_cmp_attn_bf(const VB& v, const unsigned short* __restrict__ qb, const float* __restrict__ kc, const float* __restrict__ vc,
                                              float* __restrict__ o_cmp, unsigned* __restrict__ selmask) {
    float (*qs)[64] = (float (*)[64])v.lds;
    float (*ps)[128] = (float (*)[128])(v.lds + 1024);
    float* imps = (float*)(v.lds + 1024 + 2048);
    VB_ITEMS(T * 2) {
        const int g = item & 1, t = item >> 1, b = t / S, s = t % S;
        const int w = v.tid >> 6, lane = v.tid & 63, h = g * 4 + w;
        __syncthreads();
        qs[w][lane] = bfu(qb[(size_t)t * 512 + h * 64 + lane]);
        ps[w][lane] = 0.f; ps[w][lane + 64] = 0.f;
        __syncthreads();
        {
            float m = -3.0e38f;
            float* sc = ps[w];
            for (int c = lane; c < NC; c += 64) {
                float sv = -3.0e38f;
                if (16 * c + 31 <= s) { const float* kp = kc + (size_t)((b * NC + c) * 2 + g) * 64; sv = 0.f; for (int d = 0; d < 64; ++d) sv += qs[w][d] * kp[d]; }
                sc[c] = sv; m = fmaxf(m, sv);
            }
            m = wave_max(m);
            float sum = 0.f;
            for (int c = lane; c < NC; c += 64) { const float sv = sc[c]; const float pp = (sv > -1.0e38f) ? exp2f(sv - m) : 0.f; sc[c] = pp; sum += pp; }
            sum = wave_sum(sum);
            const float inv = (m > -1.0e38f) ? 1.f / sum : 0.f;
            for (int c = lane; c < NC; c += 64) sc[c] *= inv;
            __builtin_amdgcn_s_waitcnt(0);
            float o = 0.f;
            for (int c = 0; c < NC; ++c) { const float pp = sc[c]; if (pp != 0.f) o += pp * vc[(size_t)((b * NC + c) * 2 + g) * 64 + lane]; }
            o_cmp[(size_t)t * 512 + h * 64 + lane] = o;
        }
        __syncthreads();
        if (v.tid < 32) {
            const int j = v.tid;
            float imp = 0.f;
            for (int hh = 0; hh < 4; ++hh)
                for (int c = 4 * j - 1; c <= 4 * j + 3; ++c) {
                    if (c < 0 || c >= NC) continue;
                    const float ov = (c == 4 * j - 1 || c == 4 * j + 3) ? 0.5f : 1.0f;
                    imp += ps[hh][c] * ov;
                }
            const int cur = s >> 6;
            if (j == 0 || j == cur || j == cur - 1) imp = 1e30f; else if (j > cur) imp = -1e30f;
            imps[j] = imp;
        }
        __syncthreads();
        if (v.tid < 64) {
            const int j = v.tid & 31;
            const float mine = imps[j];
            int rank = 0;
            for (int i = 0; i < 32; ++i) { const float x = imps[i]; rank += (x > mine || (x == mine && i < j)) ? 1 : 0; }
            const unsigned long long bal = __ballot(rank < 16 && v.tid < 32);
            if (v.tid == 0) selmask[(size_t)(b * 2 + g) * S + s] = (unsigned)(bal & 0xffffffffull);
        }
    }
}
template <int MODE>
__device__ __forceinline__ void p_nsa_attn_bf(const VB& v, const unsigned short* __restrict__ qb, const unsigned short* __restrict__ Kh, const unsigned short* __restrict__ VT,
                                              const unsigned* __restrict__ selmask, float* __restrict__ outp) {
    float (*qs)[64] = (float (*)[64])v.lds;
    float (*scs)[2048] = (float (*)[2048])(v.lds + 1024);
    VB_ITEMS(T * 2) {
        const int g = item & 1, t = item >> 1, b = t / S, s = t % S;
        const int w = v.tid >> 6, lane = v.tid & 63, h = g * 4 + w;
        qs[w][lane] = bfu(qb[(size_t)t * 512 + h * 64 + lane]);
        __builtin_amdgcn_s_waitcnt(0);
        const unsigned short* Kb = Kh + (size_t)(b * 2 + g) * S * 64;
        const unsigned short* Vb = VT + (size_t)(b * 2 + g) * 64 * S;
        if (MODE == 0) {
            const unsigned mask = selmask[(size_t)(b * 2 + g) * S + s];
            const int ncand = ((s >> 6) + 1) * 64;
            auto valid = [&](int idx) -> bool { return idx <= s && ((mask >> (idx >> 6)) & 1u); };
            auto krow = [&](int idx) -> const unsigned short* { return Kb + (size_t)idx * 64; };
            auto vget = [&](int idx, int d) -> float { return bfu(Vb[(size_t)d * S + idx]); };
            wave_attend_bf<64>(qs[w], ncand, valid, krow, vget, scs[w], outp + (size_t)t * 512 + h * 64, lane);
        } else {
            const int lo = s - 511 > 0 ? s - 511 : 0;
            const int ncand = s - lo + 1;
            auto valid = [&](int) -> bool { return true; };
            auto krow = [&](int idx) -> const unsigned short* { return Kb + (size_t)(lo + idx) * 64; };
            auto vget = [&](int idx, int d) -> float { return bfu(Vb[(size_t)d * S + lo + idx]); };
            wave_attend_bf<64>(qs[w], ncand, valid, krow, vget, scs[w], outp + (size_t)t * 512 + h * 64, lane);
        }
    }
}
__device__ __forceinline__ void p_mix_post_bf(const VB& v, const float* __restrict__ gates, const unsigned short* __restrict__ ub, const unsigned short* __restrict__ cbb,
                                              const float* __restrict__ o_cmp, const float* __restrict__ o_slc, const float* __restrict__ o_win,
                                              const float* __restrict__ conv_w, const float* __restrict__ g_nsa, const float* __restrict__ g_conv, unsigned short* __restrict__ omix) {
    float (*red)[4] = (float (*)[4])v.lds;
    VB_ITEMS(T) {
        const int t = item, s = t % S, tid = v.tid;
        float on[2], oc[2], ssn = 0.f, ssc = 0.f;
#pragma unroll
        for (int e = 0; e < 2; ++e) {
            const int c = tid + 256 * e, h = c >> 6;
            const float g0 = gates[(size_t)t * 24 + h * 3 + 0], g1 = gates[(size_t)t * 24 + h * 3 + 1], g2 = gates[(size_t)t * 24 + h * 3 + 2];
            on[e] = g0 * o_cmp[(size_t)t * 512 + c] + g1 * o_slc[(size_t)t * 512 + c] + g2 * o_win[(size_t)t * 512 + c];
            ssn += on[e] * on[e];
            float y = 0.f;
#pragma unroll
            for (int k = 0; k < 3; ++k) {
                const int sp = s - 2 + k;
                if (sp < 0) continue;
                y += conv_w[k * 512 + c] * bfu(ub[(size_t)(t - 2 + k) * 512 + c]);
            }
            oc[e] = bfu(cbb[(size_t)t * 512 + c]) * y;
            ssc += oc[e] * oc[e];
        }
        ssn = wave_sum(ssn); ssc = wave_sum(ssc);
        __syncthreads();
        if ((tid & 63) == 0) { red[0][tid >> 6] = ssn; red[1][tid >> 6] = ssc; }
        __syncthreads();
        ssn = red[0][0] + red[0][1] + red[0][2] + red[0][3];
        ssc = red[1][0] + red[1][1] + red[1][2] + red[1][3];
        const float rn = rsqrtf(ssn / 512.f + 1e-5f), rc = rsqrtf(ssc / 512.f + 1e-5f);
#pragma unroll
        for (int e = 0; e < 2; ++e) {
            const int c = tid + 256 * e;
            omix[(size_t)t * D + c] = f2bf_rne(on[e] * rn * g_nsa[c]);
            omix[(size_t)t * D + 512 + c] = f2bf_rne(oc[e] * rc * g_conv[c]);
        }
    }
}

__device__ __forceinline__ void p_router(const VB& v, const float* __restrict__ xn, const float* __restrict__ wr, const float* __restrict__ br,
                                         int* __restrict__ a_e, float* __restrict__ a_w, int* __restrict__ a_slot, int* __restrict__ counts) {
    VB_ITEMS(T / 4) {
        const int t = item * 4 + (v.tid >> 6), lane = v.tid & 63, e = lane & 31, half = lane >> 5;
        const float* x = xn + (size_t)t * D + half * 512;
        const float* w = wr + (size_t)half * 512 * NE + e;
        float acc = 0.f;
        for (int k = 0; k < 512; ++k) acc += x[k] * w[(size_t)k * NE];
        acc += __shfl_xor(acc, 32);
        const float logit = acc + br[e];
        int rank = 0;
        for (int i = 0; i < 32; ++i) { const float x2 = __shfl(logit, i); rank += (x2 > logit || (x2 == logit && i < e)) ? 1 : 0; }
        const float vmax = wave_max(logit);
        const bool sel = (rank < TOPK) && (lane < 32);
        const float ex = sel ? __expf(logit - vmax) : 0.f;
        const float sum = wave_sum(ex);
        if (sel) {
            const int a = t * TOPK + rank;
            a_e[a] = e; a_w[a] = ex / sum; a_slot[a] = atomicAdd(&counts[e], 1);
        }
    }
}
__device__ __forceinline__ void p_moe_offsets(const VB& v, const int* __restrict__ counts, int* __restrict__ pstart, int* __restrict__ tile_e, int* __restrict__ tok_buf, float* __restrict__ w_buf) {
    int* ps = (int*)v.lds;
    __syncthreads();
    if (v.tid == 0) { int acc = 0; for (int e = 0; e < NE; ++e) { ps[e] = acc; if (v.vb == 0) pstart[e] = acc; acc += (counts[e] + MT - 1) / MT * MT; } ps[NE] = acc; if (v.vb == 0) pstart[NE] = acc / MT; }
    __syncthreads();
    for (int tl = v.vb * 256 + v.tid; tl < NTILE; tl += v.nvb * 256) {
        const int r = tl * MT; int e = -1;
        for (int i = 0; i < NE; ++i) if (r >= ps[i] && r < ps[i + 1]) e = i;
        tile_e[tl] = e;
    }
    for (int i = v.vb * 256 + v.tid; i < PMAX; i += v.nvb * 256) { tok_buf[i] = 0; w_buf[i] = 0.f; }
}
__device__ __forceinline__ void p_moe_scatter(const VB& v, const int* __restrict__ a_e, const float* __restrict__ a_w, const int* __restrict__ a_slot, const int* __restrict__ pstart,
                                              int* __restrict__ tok_buf, float* __restrict__ w_buf, int* __restrict__ dest_of, const float* __restrict__ xn, unsigned short* __restrict__ xg) {
    const int lane = v.tid & 63, gw = v.vb * 4 + (v.tid >> 6), ngw = v.nvb * 4;
    for (int a = gw; a < NA; a += ngw) {
        const int dest = pstart[a_e[a]] + a_slot[a], t = a / TOPK;
        if (lane == 0) { tok_buf[dest] = t; w_buf[dest] = a_w[a]; dest_of[a] = dest; }
        const float* src = xn + (size_t)t * D + lane * 16;
        unsigned o[8];
#pragma unroll
        for (int i = 0; i < 4; ++i) { const float4 x = *(const float4*)(src + 4 * i); o[2 * i] = pg::cvt_pk_bf16(x.x, x.y); o[2 * i + 1] = pg::cvt_pk_bf16(x.z, x.w); }
        uint4* dst = (uint4*)(xg + (size_t)dest * D + lane * 16);
        dst[0] = make_uint4(o[0], o[1], o[2], o[3]); dst[1] = make_uint4(o[4], o[5], o[6], o[7]);
    }
}
__device__ __forceinline__ void p_moe1(const VB& v, const float* __restrict__ xn, const int* __restrict__ tok_buf, const int* __restrict__ tile_e,
                                       const float* __restrict__ wgu, const float* __restrict__ bgu, __hip_bfloat16* __restrict__ hmid) {
    float (*As)[68] = (float (*)[68])v.lds;
    float (*Bs)[132] = (float (*)[132])(v.lds + 16 * 68 * 4);
    int* toks = (int*)(v.lds + 16 * 68 * 4 + 16 * 132 * 4);
    const int nt = 16 * NTILE;
    VB_ITEMS(nt) {
        const int tl = item < nt ? item / 16 : 0, cx = item % 16;
        const int e0 = item < nt ? tile_e[tl] : -1;
        const bool act = e0 >= 0;
        const int e = act ? e0 : 0;
        const int row0 = tl * MT, col0 = cx * 64;
        __syncthreads();
        if (v.tid < MT) toks[v.tid] = act ? tok_buf[row0 + v.tid] : 0;
        __syncthreads();
        const float* W = wgu + (size_t)e * D * 2048;
        float acc[2][4][4];
        auto al = [&](int r, int k) -> float4 { return *(const float4*)(xn + (size_t)toks[r] * D + k); };
        auto bl = [&](int w, int k, int c) -> float4 { return *(const float4*)(W + (size_t)k * 2048 + w * 1024 + col0 + c); };
        gemm_tile_f32<2>(v.tid, acc, D, al, bl, As, Bs);
        if (!act) continue;
        const int tx = v.tid & 15, ty = v.tid >> 4;
#pragma unroll
        for (int i = 0; i < 4; ++i)
#pragma unroll
            for (int j = 0; j < 4; ++j) {
                const int row = row0 + ty * 4 + i, col = col0 + tx * 4 + j;
                float g = acc[0][i][j] + bgu[(size_t)e * 2048 + col], u = acc[1][i][j] + bgu[(size_t)e * 2048 + 1024 + col];
                g = fminf(g, 7.f); u = fminf(fmaxf(u, -7.f), 7.f);
                const float hm = (u + 1.f) * (g / (1.f + __expf(-1.702f * g)));
                hmid[(size_t)row * DFF + col] = __float2bfloat16(hm);
            }
    }
}
__device__ __forceinline__ void p_moe2(const VB& v, const __hip_bfloat16* __restrict__ hmid, const int* __restrict__ tile_e, const float* __restrict__ w_buf,
                                       const float* __restrict__ wd, const float* __restrict__ bd, __hip_bfloat16* __restrict__ out_a) {
    float (*As)[68] = (float (*)[68])v.lds;
    float (*Bs)[68] = (float (*)[68])(v.lds + 16 * 68 * 4);
    const int nt = 16 * NTILE;
    VB_ITEMS(nt) {
        const int tl = item < nt ? item / 16 : 0, cx = item % 16;
        const int e0 = item < nt ? tile_e[tl] : -1;
        const bool act = e0 >= 0;
        const int e = act ? e0 : 0;
        const int row0 = tl * MT, col0 = cx * 64;
        const float* W = wd + (size_t)e * DFF * D;
        float acc[1][4][4];
        auto al = [&](int r, int k) -> float4 {
            if (!act) return make_float4(0.f, 0.f, 0.f, 0.f);
            const __hip_bfloat16* p = hmid + (size_t)(row0 + r) * DFF + k;
            return make_float4(__bfloat162float(p[0]), __bfloat162float(p[1]), __bfloat162float(p[2]), __bfloat162float(p[3]));
        };
        auto bl = [&](int, int k, int c) -> float4 { return *(const float4*)(W + (size_t)k * D + col0 + c); };
        gemm_tile_f32<1>(v.tid, acc, DFF, al, bl, As, Bs);
        if (!act) continue;
        const int tx = v.tid & 15, ty = v.tid >> 4;
#pragma unroll
        for (int i = 0; i < 4; ++i)
#pragma unroll
            for (int j = 0; j < 4; ++j) {
                const int row = row0 + ty * 4 + i, col = col0 + tx * 4 + j;
                out_a[(size_t)row * D + col] = __float2bfloat16((acc[0][i][j] + bd[(size_t)e * D + col]) * w_buf[row]);
            }
    }
}
__device__ __forceinline__ void p_final(const VB& v, const float* __restrict__ h2, const unsigned short* __restrict__ out_a, const int* __restrict__ dest_of,
                                        const float* __restrict__ g, float* __restrict__ out) {
    float* red = (float*)v.lds;
    VB_ITEMS(T) {
        const int t = item, tid = v.tid;
        int d[4];
#pragma unroll
        for (int k = 0; k < 4; ++k) d[k] = dest_of[t * 4 + k];
        float x4[4], ss = 0.f;
#pragma unroll
        for (int e = 0; e < 4; ++e) {
            const int c = tid + 256 * e;
            float x = h2[(size_t)t * D + c];
#pragma unroll
            for (int k = 0; k < 4; ++k) x += __uint_as_float(((unsigned)out_a[(size_t)d[k] * D + c]) << 16);
            x4[e] = x; ss += x * x;
        }
        ss = wave_sum(ss);
        __syncthreads();
        if ((tid & 63) == 0) red[tid >> 6] = ss;
        __syncthreads();
        ss = red[0] + red[1] + red[2] + red[3];
        const float rs = rsqrtf(ss / (float)D + 1e-5f);
#pragma unroll
        for (int e = 0; e < 4; ++e) { const int c = tid + 256 * e; out[(size_t)t * D + c] = x4[e] * rs * g[c]; }
    }
}


namespace pg {
typedef unsigned short bf16_t;
typedef short bf16x8 __attribute__((ext_vector_type(8)));
typedef float f32x4 __attribute__((ext_vector_type(4)));
constexpr int BM = 256, BK = 64, HALF = 128, HTB = HALF * BK * 2, STAGE_BYTES = 8 * HTB;
__device__ __forceinline__ int lds_byte(int r, int c) { const int st = (r >> 4) * 2 + (c >> 5), rr = r & 15, cc = c & 31, ob = rr * 64 + cc * 2; return st * 1024 + (ob ^ (((ob >> 9) & 1) << 5)); }
__device__ __forceinline__ void stage_rc(int b, int& R, int& C) { const int st = b / 1024, sb = b % 1024, swz = sb ^ (((sb >> 9) & 1) << 5); R = (st >> 1) * 16 + swz / 64; C = (st & 1) * 32 + (swz % 64) / 2; }
typedef float f32x2_t __attribute__((ext_vector_type(2)));
typedef __bf16 bf16x2_t __attribute__((ext_vector_type(2)));
__device__ __forceinline__ unsigned cvt_pk_bf16_acc(float lo, float hi) { const f32x2_t v = {lo, hi}; const bf16x2_t b = __builtin_convertvector(v, bf16x2_t); return __builtin_bit_cast(unsigned, b); }
__device__ __forceinline__ unsigned cvt_pk_bf16(float lo, float hi) { unsigned r; asm volatile("v_cvt_pk_bf16_f32 %0, %1, %2" : "=v"(r) : "v"(lo), "v"(hi)); return r; }
__device__ __forceinline__ bf16_t f2bf(float f) { unsigned u = __float_as_uint(f); u += 0x7FFFu + ((u >> 16) & 1u); return (bf16_t)(u >> 16); }
__device__ __forceinline__ float bf2f(bf16_t b) { return __uint_as_float(((unsigned)b) << 16); }

struct GUnit { const char* A; const char* B; int row0, col0, aux; };

template <class Epi, class Sched>
__device__ __forceinline__ void gemm_phase(LAS unsigned char* lds, const int K, const unsigned lda_b, const unsigned ldb_b, const Sched& S, const Epi& E) {
    const int tid = opaque_tid(), wid = __builtin_amdgcn_readfirstlane(tid >> 6), lane = tid & 63, wr = wid >> 2, wc = wid & 3, fr = lane & 15, fq = lane >> 4;
    const int nt = K / BK;
    unsigned voffA[2], voffB[2];
#pragma unroll
    for (int i = 0; i < 2; ++i) { int R, C; stage_rc(tid * 16 + i * 8192, R, C); voffA[i] = (unsigned)R * lda_b + (unsigned)C * 2u; voffB[i] = (unsigned)R * ldb_b + (unsigned)C * 2u; }
    const size_t kstep = (size_t)(BK * 2);
    const size_t hstepA = (size_t)HALF * lda_b, hstepB = (size_t)HALF * ldb_b;
    const unsigned ldsw = (unsigned)wid * 1024u;
    const int aoff = lds_byte(wr * 64 + fr, fq * 8), boff = lds_byte(wc * 32 + fr, fq * 8);
#define PG8_SA(b, h) (((b) * 2 + (h)) * HTB)
#define PG8_SB(b, h) ((4 + (b) * 2 + (h)) * HTB)
#define PG8_STAGE(bufoff, gbase, voff) do { _Pragma("unroll") for (int _i = 0; _i < 2; ++_i) \
        __builtin_amdgcn_global_load_lds((const unsigned*)((const char*)(gbase) + (voff)[_i]), (LAS unsigned*)(lds + (bufoff) + ldsw + _i * 8192), 16, 0, 0); } while (0)
#define PG8_LDA(dst, b, h) do { _Pragma("unroll") for (int m = 0; m < 4; ++m) _Pragma("unroll") for (int k = 0; k < 2; ++k) dst[m][k] = *(const LAS bf16x8*)(lds + PG8_SA(b, h) + aoff + m * 2048 + k * 1024); } while (0)
#define PG8_LDB(dst, b, h) do { _Pragma("unroll") for (int n = 0; n < 2; ++n) _Pragma("unroll") for (int k = 0; k < 2; ++k) dst[n][k] = *(const LAS bf16x8*)(lds + PG8_SB(b, h) + boff + n * 2048 + k * 1024); } while (0)
#define PG8_MMA(ai, bj, At, Bt) do { __builtin_amdgcn_s_setprio(1); _Pragma("unroll") for (int m = 0; m < 4; ++m) _Pragma("unroll") for (int n = 0; n < 2; ++n) _Pragma("unroll") for (int k = 0; k < 2; ++k) \
        acc[ai][bj][m][n] = __builtin_amdgcn_mfma_f32_16x16x32_bf16(Bt[n][k], At[m][k], acc[ai][bj][m][n], 0, 0, 0); __builtin_amdgcn_s_setprio(0); } while (0)
#define PG8_WAIT_V(n) asm volatile("s_waitcnt vmcnt(" #n ")" ::: "memory")
#define PG8_WAIT_L(n) asm volatile("s_waitcnt lgkmcnt(" #n ")" ::: "memory")
#define PG8_BAR __builtin_amdgcn_s_barrier()
#define PG8_SCHED __builtin_amdgcn_sched_barrier(0)
    GUnit cur, nxt; int ui = 0;
    if (!S.next(0, cur)) return;
    f32x4 acc[2][2][4][2];
#pragma unroll
    for (int a = 0; a < 2; ++a)
#pragma unroll
        for (int b = 0; b < 2; ++b)
#pragma unroll
            for (int m = 0; m < 4; ++m)
#pragma unroll
                for (int n = 0; n < 2; ++n) acc[a][b][m][n] = (f32x4){0.f, 0.f, 0.f, 0.f};
    bf16x8 At[4][2], B0[2][2], B1[2][2];
    const char* cA = cur.A; const char* cB = cur.B;
    PG8_STAGE(PG8_SB(0, 0), cB, voffB); PG8_STAGE(PG8_SA(0, 0), cA, voffA); PG8_STAGE(PG8_SB(0, 1), cB + hstepB, voffB); PG8_STAGE(PG8_SA(0, 1), cA + hstepA, voffA);
    if (wr == 1) PG8_BAR;
    PG8_WAIT_V(4); PG8_BAR;
    PG8_STAGE(PG8_SB(1, 0), cB + kstep, voffB); PG8_STAGE(PG8_SA(1, 0), cA + kstep, voffA); PG8_STAGE(PG8_SB(1, 1), cB + hstepB + kstep, voffB);
    PG8_WAIT_V(6); PG8_BAR;
    for (;;) {
        const bool has_next = S.next(ui + 1, nxt);
        const char* nA = has_next ? nxt.A : cA; const char* nB = has_next ? nxt.B : cB;
        for (int t = 0; t < nt; t += 2) {
            const bool last = (t == nt - 2);
            const char* a1 = cA + (size_t)(t + 1) * kstep;
            const char* a2 = last ? nA : cA + (size_t)(t + 2) * kstep; const char* b2 = last ? nB : cB + (size_t)(t + 2) * kstep;
            const char* a3 = a2 + kstep; const char* b3 = b2 + kstep;
            PG8_LDB(B0, 0, 0); PG8_SCHED; PG8_LDA(At, 0, 0); PG8_STAGE(PG8_SA(1, 1), a1 + hstepA, voffA);
            PG8_WAIT_L(8); PG8_BAR; PG8_WAIT_L(0); PG8_MMA(0, 0, At, B0); PG8_BAR; PG8_SCHED;
            PG8_LDB(B1, 0, 1); PG8_STAGE(PG8_SB(0, 0), b2, voffB);
            PG8_BAR; PG8_WAIT_L(0); PG8_MMA(0, 1, At, B1); PG8_BAR;
            PG8_LDA(At, 0, 1); PG8_STAGE(PG8_SA(0, 0), a2, voffA);
            PG8_BAR; PG8_WAIT_L(0); PG8_MMA(1, 0, At, B0); PG8_BAR; PG8_SCHED;
            PG8_STAGE(PG8_SB(0, 1), b2 + hstepB, voffB);
            PG8_WAIT_V(6); PG8_BAR; PG8_MMA(1, 1, At, B1); PG8_BAR;
            PG8_LDB(B0, 1, 0); PG8_SCHED; PG8_LDA(At, 1, 0); PG8_STAGE(PG8_SA(0, 1), a2 + hstepA, voffA);
            PG8_WAIT_L(8); PG8_BAR; PG8_WAIT_L(0); PG8_MMA(0, 0, At, B0); PG8_BAR; PG8_SCHED;
            PG8_LDB(B1, 1, 1); PG8_STAGE(PG8_SB(1, 0), b3, voffB);
            PG8_BAR; PG8_WAIT_L(0); PG8_MMA(0, 1, At, B1); PG8_BAR;
            PG8_LDA(At, 1, 1); PG8_STAGE(PG8_SA(1, 0), a3, voffA);
            PG8_BAR; PG8_WAIT_L(0); PG8_MMA(1, 0, At, B0); PG8_BAR; PG8_SCHED;
            PG8_STAGE(PG8_SB(1, 1), b3 + hstepB, voffB);
            PG8_WAIT_V(6); PG8_BAR; PG8_MMA(1, 1, At, B1); PG8_BAR;
        }
        E(acc, cur, wr, wc, fr, fq);
        if (!has_next) break;
#pragma unroll
        for (int a = 0; a < 2; ++a)
#pragma unroll
            for (int b = 0; b < 2; ++b)
#pragma unroll
                for (int m = 0; m < 4; ++m)
#pragma unroll
                    for (int n = 0; n < 2; ++n) acc[a][b][m][n] = (f32x4){0.f, 0.f, 0.f, 0.f};
        cur = nxt; cA = nA; cB = nB; ++ui;
    }
    PG8_WAIT_V(0);
    if (wr == 0) PG8_BAR;
    PG8_BAR;
#undef PG8_SA
#undef PG8_SB
#undef PG8_STAGE
#undef PG8_LDA
#undef PG8_LDB
#undef PG8_MMA
#undef PG8_WAIT_V
#undef PG8_WAIT_L
#undef PG8_BAR
#undef PG8_SCHED
}

typedef int v4i_t __attribute__((ext_vector_type(4)));
typedef int v8i_t __attribute__((ext_vector_type(8)));
template <class Epi, class Sched>
__device__ __forceinline__ void gemm_phase_f8(LAS unsigned char* lds, const int K  , const unsigned lda_b, const unsigned ldb_b, const Sched& S, const Epi& E) {
    const int tid = opaque_tid(), wid = __builtin_amdgcn_readfirstlane(tid >> 6), lane = tid & 63, wr = wid >> 2, wc = wid & 3, fr = lane & 15, fq = lane >> 4;
    const int nt = K / 128;
    unsigned voffA[2], voffB[2];
#pragma unroll
    for (int i = 0; i < 2; ++i) { int R, C; stage_rc(tid * 16 + i * 8192, R, C); voffA[i] = (unsigned)R * lda_b + (unsigned)C * 2u; voffB[i] = (unsigned)R * ldb_b + (unsigned)C * 2u; }
    const size_t kstep = (size_t)(BK * 2);
    const size_t hstepA = (size_t)HALF * lda_b, hstepB = (size_t)HALF * ldb_b;
    const unsigned ldsw = (unsigned)wid * 1024u;
    const int aoff = lds_byte(wr * 64 + fr, fq * 8), boff = lds_byte(wc * 32 + fr, fq * 8);
#define PG8_SA(b, h) (((b) * 2 + (h)) * HTB)
#define PG8_SB(b, h) ((4 + (b) * 2 + (h)) * HTB)
#define PG8_STAGE(bufoff, gbase, voff) do { _Pragma("unroll") for (int _i = 0; _i < 2; ++_i) \
        __builtin_amdgcn_global_load_lds((const unsigned*)((const char*)(gbase) + (voff)[_i]), (LAS unsigned*)(lds + (bufoff) + ldsw + _i * 8192), 16, 0, 0); } while (0)
#define PG8_LDA(dst, b, h) do { _Pragma("unroll") for (int m = 0; m < 4; ++m) { const v4i_t lo_ = *(const LAS v4i_t*)(lds + PG8_SA(b, h) + aoff + m * 2048), hi_ = *(const LAS v4i_t*)(lds + PG8_SA(b, h) + aoff + m * 2048 + 1024); dst[m] = __builtin_shufflevector(lo_, hi_, 0, 1, 2, 3, 4, 5, 6, 7); } } while (0)
#define PG8_LDB(dst, b, h) do { _Pragma("unroll") for (int n = 0; n < 2; ++n) { const v4i_t lo_ = *(const LAS v4i_t*)(lds + PG8_SB(b, h) + boff + n * 2048), hi_ = *(const LAS v4i_t*)(lds + PG8_SB(b, h) + boff + n * 2048 + 1024); dst[n] = __builtin_shufflevector(lo_, hi_, 0, 1, 2, 3, 4, 5, 6, 7); } } while (0)
#define PG8_MMA(ai, bj, At, Bt) do { __builtin_amdgcn_s_setprio(1); _Pragma("unroll") for (int m = 0; m < 4; ++m) _Pragma("unroll") for (int n = 0; n < 2; ++n) \
        asm volatile("v_mfma_scale_f32_16x16x128_f8f6f4 %0, %1, %2, %0, %3, %3 op_sel_hi:[0,0,0]" : "+v"(acc[ai][bj][m][n]) : "v"(Bt[n]), "v"(At[m]), "v"(unit_scale)); __builtin_amdgcn_s_setprio(0); } while (0)
#define PG8_WAIT_V(n) asm volatile("s_waitcnt vmcnt(" #n ")" ::: "memory")
#define PG8_WAIT_L(n) asm volatile("s_waitcnt lgkmcnt(" #n ")" ::: "memory")
#define PG8_BAR __builtin_amdgcn_s_barrier()
#define PG8_SCHED __builtin_amdgcn_sched_barrier(0)
    const int unit_scale = 0x7f7f7f7f;
    GUnit cur, nxt; int ui = 0;
    if (!S.next(0, cur)) return;
    f32x4 acc[2][2][4][2];
#pragma unroll
    for (int a = 0; a < 2; ++a)
#pragma unroll
        for (int b = 0; b < 2; ++b)
#pragma unroll
            for (int m = 0; m < 4; ++m)
#pragma unroll
                for (int n = 0; n < 2; ++n) acc[a][b][m][n] = (f32x4){0.f, 0.f, 0.f, 0.f};
    v8i_t At[4], B0[2], B1[2];
    const char* cA = cur.A; const char* cB = cur.B;
    PG8_STAGE(PG8_SB(0, 0), cB, voffB); PG8_STAGE(PG8_SA(0, 0), cA, voffA); PG8_STAGE(PG8_SB(0, 1), cB + hstepB, voffB); PG8_STAGE(PG8_SA(0, 1), cA + hstepA, voffA);
    if (wr == 1) PG8_BAR;
    PG8_WAIT_V(4); PG8_BAR;
    PG8_STAGE(PG8_SB(1, 0), cB + kstep, voffB); PG8_STAGE(PG8_SA(1, 0), cA + kstep, voffA); PG8_STAGE(PG8_SB(1, 1), cB + hstepB + kstep, voffB);
    PG8_WAIT_V(6); PG8_BAR;
    for (;;) {
        const bool has_next = S.next(ui + 1, nxt);
        const char* nA = has_next ? nxt.A : cA; const char* nB = has_next ? nxt.B : cB;
#pragma nounroll
        for (int t = 0; t < nt; t += 2) {
            const bool last = (t == nt - 2);
            const char* a1 = cA + (size_t)(t + 1) * kstep;
            const char* a2 = last ? nA : cA + (size_t)(t + 2) * kstep; const char* b2 = last ? nB : cB + (size_t)(t + 2) * kstep;
            const char* a3 = a2 + kstep; const char* b3 = b2 + kstep;
            PG8_LDB(B0, 0, 0); PG8_SCHED; PG8_LDA(At, 0, 0); PG8_STAGE(PG8_SA(1, 1), a1 + hstepA, voffA);
            PG8_WAIT_L(8); PG8_BAR; PG8_WAIT_L(0); PG8_MMA(0, 0, At, B0); PG8_BAR; PG8_SCHED;
            PG8_LDB(B1, 0, 1); PG8_STAGE(PG8_SB(0, 0), b2, voffB);
            PG8_BAR; PG8_WAIT_L(0); PG8_MMA(0, 1, At, B1); PG8_BAR;
            PG8_LDA(At, 0, 1); PG8_STAGE(PG8_SA(0, 0), a2, voffA);
            PG8_BAR; PG8_WAIT_L(0); PG8_MMA(1, 0, At, B0); PG8_BAR; PG8_SCHED;
            PG8_STAGE(PG8_SB(0, 1), b2 + hstepB, voffB);
            PG8_WAIT_V(6); PG8_BAR; PG8_MMA(1, 1, At, B1); PG8_BAR;
            PG8_LDB(B0, 1, 0); PG8_SCHED; PG8_LDA(At, 1, 0); PG8_STAGE(PG8_SA(0, 1), a2 + hstepA, voffA);
            PG8_WAIT_L(8); PG8_BAR; PG8_WAIT_L(0); PG8_MMA(0, 0, At, B0); PG8_BAR; PG8_SCHED;
            PG8_LDB(B1, 1, 1); PG8_STAGE(PG8_SB(1, 0), b3, voffB);
            PG8_BAR; PG8_WAIT_L(0); PG8_MMA(0, 1, At, B1); PG8_BAR;
            PG8_LDA(At, 1, 1); PG8_STAGE(PG8_SA(1, 0), a3, voffA);
            PG8_BAR; PG8_WAIT_L(0); PG8_MMA(1, 0, At, B0); PG8_BAR; PG8_SCHED;
            PG8_STAGE(PG8_SB(1, 1), b3 + hstepB, voffB);
            PG8_WAIT_V(6); PG8_BAR; PG8_MMA(1, 1, At, B1); PG8_BAR;
        }
        asm volatile("s_nop 15\n\ts_nop 15" ::: "memory");
        E(acc, cur, wr, wc, fr, fq);
        if (!has_next) break;
#pragma unroll
        for (int a = 0; a < 2; ++a)
#pragma unroll
            for (int b = 0; b < 2; ++b)
#pragma unroll
                for (int m = 0; m < 4; ++m)
#pragma unroll
                    for (int n = 0; n < 2; ++n) acc[a][b][m][n] = (f32x4){0.f, 0.f, 0.f, 0.f};
        cur = nxt; cA = nA; cB = nB; ++ui;
    }
    PG8_WAIT_V(0);
    if (wr == 0) PG8_BAR;
    PG8_BAR;
#undef PG8_SA
#undef PG8_SB
#undef PG8_STAGE
#undef PG8_LDA
#undef PG8_LDB
#undef PG8_MMA
#undef PG8_WAIT_V
#undef PG8_WAIT_L
#undef PG8_BAR
#undef PG8_SCHED
}

struct DenseOrder {
    const char* A; const char* Bt; unsigned lda_b, ldb_b; int nM, nN, nwg, G, c;
    __device__ void init(const void* A_, const void* Bt_, int M, int N, unsigned lda_b_, unsigned ldb_b_, int G_, int c_) { A = (const char*)A_; Bt = (const char*)Bt_; lda_b = lda_b_; ldb_b = ldb_b_; nM = M / BM; nN = N / BM; nwg = nM * nN; G = G_; c = c_; }
    __device__ bool next(int i, GUnit& u) const {
        const long L = (long)i * G + c; if (L >= nwg) return false;
        int wgid = (int)L; { const int q = nwg / 8, r = nwg % 8, xcd = wgid % 8, off = wgid / 8; wgid = (xcd < r ? xcd * (q + 1) : r * (q + 1) + (xcd - r) * q) + off; }
        const int nig = 8 * nN, gid = wgid / nig, fm = gid * 8, gsz = (nM - fm) < 8 ? (nM - fm) : 8;
        const int pm = fm + ((wgid % nig) % gsz), pn = (wgid % nig) / gsz;
        u.A = A + (size_t)pm * BM * lda_b; u.B = Bt + (size_t)pn * BM * ldb_b; u.row0 = pm * BM; u.col0 = pn * BM; u.aux = 0; return true;
    }
};

struct EpiF32R {
    float* C; int ldc; const float* res; int ncols;
    __device__ __forceinline__ void operator()(const f32x4 (&acc)[2][2][4][2], const GUnit& u, int wr, int wc, int fr, int fq) const {
        const int row0 = u.row0 + wr * 64 + fr, col0 = u.col0 + wc * 32 + 4 * fq;
#pragma unroll
        for (int ai = 0; ai < 2; ++ai)
#pragma unroll
            for (int m = 0; m < 4; ++m) {
                const size_t ro = (size_t)(row0 + ai * HALF + m * 16) * ldc;
#pragma unroll
                for (int bj = 0; bj < 2; ++bj)
#pragma unroll
                    for (int n = 0; n < 2; ++n) {
                        const int col = col0 + bj * HALF + n * 16;
                        if (col < ncols) { f32x4 x = acc[ai][bj][m][n]; if (res) x += *(const f32x4*)(res + ro + col); *(f32x4*)(C + ro + col) = x; }
                    }
            }
    }
};


struct EpiBf16S {
    bf16_t* O; int ldc; float scale;
    __device__ __forceinline__ void operator()(const f32x4 (&acc)[2][2][4][2], const GUnit& u, int wr, int wc, int fr, int fq) const {
        const int row0 = u.row0 + wr * 64 + fr, col0 = u.col0 + wc * 32 + 4 * fq;
#pragma unroll
        for (int ai = 0; ai < 2; ++ai)
#pragma unroll
            for (int m = 0; m < 4; ++m) {
                bf16_t* rowp = O + (size_t)(row0 + ai * HALF + m * 16) * ldc + col0;
#pragma unroll
                for (int bj = 0; bj < 2; ++bj)
#pragma unroll
                    for (int n = 0; n < 2; ++n) { const f32x4 x = acc[ai][bj][m][n] * scale; uint2 o; o.x = cvt_pk_bf16(x[0], x[1]); o.y = cvt_pk_bf16(x[2], x[3]); *(uint2*)(rowp + bj * HALF + n * 16) = o; }
            }
    }
};
struct EpiXkv {
    bf16_t *xk, *xvT;
    __device__ __forceinline__ void operator()(const f32x4 (&acc)[2][2][4][2], const GUnit& u, int wr, int wc, int fr, int fq) const {
        const int row0 = u.row0 + wr * 64 + fr, col0 = u.col0 + wc * 32 + 4 * fq;
        const bool isv = u.col0 >= 1024;
#pragma unroll
        for (int ai = 0; ai < 2; ++ai)
#pragma unroll
            for (int m = 0; m < 4; ++m) {
                const int row = row0 + ai * HALF + m * 16, b = row >> 8, key = row & 255;
#pragma unroll
                for (int bj = 0; bj < 2; ++bj)
#pragma unroll
                    for (int n = 0; n < 2; ++n) {
                        const int col = (col0 + bj * HALF + n * 16) & 1023, h = col >> 8, d = col & 255;
                        const f32x4 x = acc[ai][bj][m][n];
                        uint2 o; o.x = cvt_pk_bf16_acc(x[0], x[1]); o.y = cvt_pk_bf16_acc(x[2], x[3]);
                        if (!isv) *(uint2*)(xk + ((size_t)(b * 4 + h) * 256 + key) * 256 + d) = o;
                        else { bf16_t* base = xvT + ((size_t)(b * 4 + h) * 256 + d) * 256 + key;
                               base[0] = (bf16_t)(o.x & 0xffff); base[256] = (bf16_t)(o.x >> 16); base[512] = (bf16_t)(o.y & 0xffff); base[768] = (bf16_t)(o.y >> 16); }
                    }
            }
    }
};

struct EpiMixIn {
    bf16_t *q, *kk  , *vt  , *u, *cb; float* gates; const float* cosT; const float* sinT;
    __device__ __forceinline__ void operator()(const f32x4 (&acc)[2][2][4][2], const GUnit& un, int wr, int wc, int fr, int fq) const {
        const int pn = un.col0 >> 8, w1 = wc & 1, w2 = wc >> 1, dlo = 16 * w1 + 4 * fq;
#pragma unroll
        for (int ai = 0; ai < 2; ++ai)
#pragma unroll
            for (int m = 0; m < 4; ++m) {
                const int t = un.row0 + ai * HALF + wr * 64 + m * 16 + fr, b = t >> 11, sq = t & 2047;
                if (pn <= 4) {
                    const f32x4 cv = *(const f32x4*)(cosT + (size_t)t * 32 + dlo), sv = *(const f32x4*)(sinT + (size_t)t * 32 + dlo);
#pragma unroll
                    for (int bj = 0; bj < 2; ++bj) {
                        const int blk = 2 * bj + w2;
                        f32x4 x0 = acc[ai][bj][m][0], x1 = acc[ai][bj][m][1];
                        const bool rope = (pn < 2) || (bj == 0);
                        if (rope) { const f32x4 r0 = x0 * cv - x1 * sv, r1 = x1 * cv + x0 * sv; x0 = r0; x1 = r1; }
                        if (pn < 2) { x0 *= QS; x1 *= QS; }
                        uint2 o0, o1; o0.x = cvt_pk_bf16_acc(x0[0], x0[1]); o0.y = cvt_pk_bf16_acc(x0[2], x0[3]); o1.x = cvt_pk_bf16_acc(x1[0], x1[1]); o1.y = cvt_pk_bf16_acc(x1[2], x1[3]);
                        if (pn < 2) {
                            bf16_t* dst = q + (size_t)t * 512 + (pn * 4 + blk) * 64 + dlo;
                            *(uint2*)dst = o0; *(uint2*)(dst + 32) = o1;
                        } else {
                            const int g = blk & 1;
                            const size_t rowi = (size_t)(b * 2 + g) * S + sq;
                            if (bj == 0 || pn == 2) {
                                const int ki = (pn == 2) ? bj : pn - 1;
                                bf16_t* dst = kk + (size_t)ki * ((size_t)T * 128) + rowi * 64 + dlo;
                                *(uint2*)dst = o0; *(uint2*)(dst + 32) = o1;
                            } else {
                                bf16_t* base = vt + (size_t)(pn - 3) * ((size_t)T * 128) + ((size_t)(b * 2 + g) * 64 + dlo) * S + sq;
                                base[0 * S] = (bf16_t)(o0.x & 0xffff); base[1 * S] = (bf16_t)(o0.x >> 16); base[2 * S] = (bf16_t)(o0.y & 0xffff); base[3 * S] = (bf16_t)(o0.y >> 16);
                                base[32 * S] = (bf16_t)(o1.x & 0xffff); base[33 * S] = (bf16_t)(o1.x >> 16); base[34 * S] = (bf16_t)(o1.y & 0xffff); base[35 * S] = (bf16_t)(o1.y >> 16);
                            }
                        }
                    }
                } else if (pn < 9) {
#pragma unroll
                    for (int n = 0; n < 2; ++n) {
                        const f32x4 x = acc[ai][0][m][n] * acc[ai][1][m][n];
                        uint2 o; o.x = cvt_pk_bf16(x[0], x[1]); o.y = cvt_pk_bf16(x[2], x[3]);
                        *(uint2*)(u + (size_t)t * 512 + (pn - 5) * 128 + w2 * 64 + n * 32 + dlo) = o;
                    }
                } else if (pn < 11) {
#pragma unroll
                    for (int bj = 0; bj < 2; ++bj)
#pragma unroll
                        for (int n = 0; n < 2; ++n) {
                            const f32x4 x = acc[ai][bj][m][n];
                            uint2 o; o.x = cvt_pk_bf16_acc(x[0], x[1]); o.y = cvt_pk_bf16_acc(x[2], x[3]);
                            *(uint2*)(cb + (size_t)t * 512 + (pn - 9) * 256 + bj * 128 + w2 * 64 + n * 32 + dlo) = o;
                        }
                } else {
                    if (w2 == 0 && dlo < 24) {
                        const f32x4 x = acc[ai][0][m][0];
                        f32x4 sg;
#pragma unroll
                        for (int j = 0; j < 4; ++j) sg[j] = 1.f / (1.f + __expf(-x[j]));
                        *(f32x4*)(gates + (size_t)t * 24 + dlo) = sg;
                    }
                }
            }
    }
};

template <int NPN>
struct MoeOrder {
    const char* A; const char* Bt; const int* tile_e; int nunits, G, c; size_t bt_expert_bytes;
    __device__ void init(const void* A_, const void* Bt_, const int* tile_e_, int ntiles, size_t bt_expert_bytes_, int G_, int c_) { A = (const char*)A_; Bt = (const char*)Bt_; tile_e = tile_e_; nunits = ntiles * NPN; bt_expert_bytes = bt_expert_bytes_; G = G_; c = c_; }
    __device__ bool next(int i, GUnit& u) const {
        const int L = i * G + c; if (L >= nunits) return false;
        const int tl = L / NPN, pn = L % NPN, e = tile_e[tl];
        u.A = A + (size_t)tl * BM * 2048; u.B = Bt + (size_t)e * bt_expert_bytes + (size_t)pn * BM * 2048; u.row0 = tl * BM; u.col0 = pn * BM; u.aux = e; return true;
    }
};
struct EpiSwiglu {
    bf16_t* H; const float* bias;
    __device__ __forceinline__ void operator()(const f32x4 (&acc)[2][2][4][2], const GUnit& u, int wr, int wc, int fr, int fq) const {
        const int row0 = u.row0 + wr * 64 + fr, pn = u.col0 >> 8, cl0 = wc * 32 + 4 * fq;
        const float* bg = bias + (size_t)u.aux * 2048 + pn * 128 + cl0;
        f32x4 bgv[2], buv[2];
#pragma unroll
        for (int n = 0; n < 2; ++n) { bgv[n] = *(const f32x4*)(bg + n * 16); buv[n] = *(const f32x4*)(bg + 1024 + n * 16); }
#pragma unroll
        for (int ai = 0; ai < 2; ++ai)
#pragma unroll
            for (int m = 0; m < 4; ++m) {
                bf16_t* rowp = H + (size_t)(row0 + ai * HALF + m * 16) * 1024 + pn * 128 + cl0;
#pragma unroll
                for (int n = 0; n < 2; ++n) {
                    const f32x4 g4 = acc[ai][0][m][n] + bgv[n], u4 = acc[ai][1][m][n] + buv[n];
                    float h[4];
#pragma unroll
                    for (int j = 0; j < 4; ++j) {
                        const float g = fminf(g4[j], 7.f), uu = fminf(fmaxf(u4[j], -7.f), 7.f);
                        h[j] = (uu + 1.f) * (g / (1.f + __expf(-1.702f * g)));
                    }
                    uint2 o; o.x = cvt_pk_bf16(h[0], h[1]); o.y = cvt_pk_bf16(h[2], h[3]);
                    *(uint2*)(rowp + n * 16) = o;
                }
            }
    }
};
struct EpiDownScale {
    bf16_t* O; const float* bias; const float* w_buf;
    __device__ __forceinline__ void operator()(const f32x4 (&acc)[2][2][4][2], const GUnit& u, int wr, int wc, int fr, int fq) const {
        const int row0 = u.row0 + wr * 64 + fr, col0 = u.col0 + wc * 32 + 4 * fq;
        f32x4 bv[2][2];
#pragma unroll
        for (int bj = 0; bj < 2; ++bj)
#pragma unroll
            for (int n = 0; n < 2; ++n) bv[bj][n] = *(const f32x4*)(bias + (size_t)u.aux * 1024 + col0 + bj * HALF + n * 16);
#pragma unroll
        for (int ai = 0; ai < 2; ++ai)
#pragma unroll
            for (int m = 0; m < 4; ++m) {
                const int row = row0 + ai * HALF + m * 16;
                const float w = w_buf[row];
                bf16_t* rowp = O + (size_t)row * 1024 + col0;
#pragma unroll
                for (int bj = 0; bj < 2; ++bj)
#pragma unroll
                    for (int n = 0; n < 2; ++n) {
                        const f32x4 x = (acc[ai][bj][m][n] + bv[bj][n]) * w;
                        uint2 o; o.x = cvt_pk_bf16(x[0], x[1]); o.y = cvt_pk_bf16(x[2], x[3]);
                        *(uint2*)(rowp + bj * HALF + n * 16) = o;
                    }
            }
    }
};

constexpr float W8_SCALE = 64.f, W8_INV = 1.f / 64.f;
__device__ __forceinline__ unsigned pk4_fp8(float a, float b, float c, float d) { unsigned w = 0; w = __builtin_amdgcn_cvt_pk_fp8_f32(a, b, w, false); w = __builtin_amdgcn_cvt_pk_fp8_f32(c, d, w, true); return w; }
struct EpiSwigluF8out {
    unsigned char* H; const float* bias;
    __device__ __forceinline__ void operator()(const f32x4 (&acc)[2][2][4][2], const GUnit& u, int wr, int wc, int fr, int fq) const {
        const int row0 = u.row0 + wr * 64 + fr, pn = u.col0 >> 8, cl0 = wc * 32 + 4 * fq;
        const float* bg = bias + (size_t)u.aux * 2048 + pn * 128 + cl0;
        f32x4 bgv[2], buv[2];
#pragma unroll
        for (int n = 0; n < 2; ++n) { bgv[n] = *(const f32x4*)(bg + n * 16); buv[n] = *(const f32x4*)(bg + 1024 + n * 16); }
#pragma unroll
        for (int ai = 0; ai < 2; ++ai)
#pragma unroll
            for (int m = 0; m < 4; ++m) {
                unsigned char* rowp = H + (size_t)(row0 + ai * HALF + m * 16) * 1024 + pn * 128 + cl0;
#pragma unroll
                for (int n = 0; n < 2; ++n) {
                    const f32x4 g4 = acc[ai][0][m][n] + bgv[n], u4 = acc[ai][1][m][n] + buv[n];
                    float h[4];
#pragma unroll
                    for (int j = 0; j < 4; ++j) {
                        const float g = fminf(g4[j], 7.f), uu = fminf(fmaxf(u4[j], -7.f), 7.f);
                        h[j] = (uu + 1.f) * (g / (1.f + __expf(-1.702f * g)));
                    }
                    *(unsigned*)(rowp + n * 16) = pk4_fp8(h[0], h[1], h[2], h[3]);
                }
            }
    }
};
struct EpiSwigluF8 {
    unsigned char* H; const float* bias;
    __device__ __forceinline__ void operator()(const f32x4 (&acc)[2][2][4][2], const GUnit& u, int wr, int wc, int fr, int fq) const {
        const int row0 = u.row0 + wr * 64 + fr, pn = u.col0 >> 8, cl0 = wc * 32 + 4 * fq;
        const float* bg = bias + (size_t)u.aux * 2048 + pn * 128 + cl0;
        f32x4 bgv[2], buv[2];
#pragma unroll
        for (int n = 0; n < 2; ++n) { bgv[n] = *(const f32x4*)(bg + n * 16); buv[n] = *(const f32x4*)(bg + 1024 + n * 16); }
#pragma unroll
        for (int ai = 0; ai < 2; ++ai)
#pragma unroll
            for (int m = 0; m < 4; ++m) {
                unsigned char* rowp = H + (size_t)(row0 + ai * HALF + m * 16) * 1024 + pn * 128 + cl0;
#pragma unroll
                for (int n = 0; n < 2; ++n) {
                    const f32x4 g4 = acc[ai][0][m][n] * W8_INV + bgv[n], u4 = acc[ai][1][m][n] * W8_INV + buv[n];
                    float h[4];
#pragma unroll
                    for (int j = 0; j < 4; ++j) {
                        const float g = fminf(g4[j], 7.f), uu = fminf(fmaxf(u4[j], -7.f), 7.f);
                        h[j] = (uu + 1.f) * g * __builtin_amdgcn_rcpf(1.f + __builtin_amdgcn_exp2f(-1.702f * 1.4426950408889634f * g));
                    }
                    *(unsigned*)(rowp + n * 16) = pk4_fp8(h[0], h[1], h[2], h[3]);
                }
            }
    }
};
struct EpiDownScaleF8 {
    bf16_t* O; const float* bias; const float* w_buf;
    __device__ __forceinline__ void operator()(const f32x4 (&acc)[2][2][4][2], const GUnit& u, int wr, int wc, int fr, int fq) const {
        const int row0 = u.row0 + wr * 64 + fr, col0 = u.col0 + wc * 32 + 4 * fq;
        f32x4 bv[2][2];
#pragma unroll
        for (int bj = 0; bj < 2; ++bj)
#pragma unroll
            for (int n = 0; n < 2; ++n) bv[bj][n] = *(const f32x4*)(bias + (size_t)u.aux * 1024 + col0 + bj * HALF + n * 16);
#pragma unroll
        for (int ai = 0; ai < 2; ++ai)
#pragma unroll
            for (int m = 0; m < 4; ++m) {
                const int row = row0 + ai * HALF + m * 16;
                const float w = w_buf[row];
                bf16_t* rowp = O + (size_t)row * 1024 + col0;
#pragma unroll
                for (int bj = 0; bj < 2; ++bj)
#pragma unroll
                    for (int n = 0; n < 2; ++n) {
                        const f32x4 x = (acc[ai][bj][m][n] * W8_INV + bv[bj][n]) * w;
                        uint2 o; o.x = cvt_pk_bf16(x[0], x[1]); o.y = cvt_pk_bf16(x[2], x[3]);
                        *(uint2*)(rowp + bj * HALF + n * 16) = o;
                    }
            }
    }
};
template <int NPN>
struct MoeOrderB {
    const char* A; const char* Bt; const int* tile_e; int nunits, G, c; size_t bt_expert_bytes; unsigned row_b;
    __device__ void init(const void* A_, const void* Bt_, const int* tile_e_, int ntiles, size_t bt_expert_bytes_, unsigned row_b_, int G_, int c_) { A = (const char*)A_; Bt = (const char*)Bt_; tile_e = tile_e_; nunits = ntiles * NPN; bt_expert_bytes = bt_expert_bytes_; row_b = row_b_; G = G_; c = c_; }
    __device__ bool next(int i, GUnit& u) const {
        const int L = i * G + c; if (L >= nunits) return false;
        const int tl = L / NPN, pn = L % NPN, e = tile_e[tl];
        u.A = A + (size_t)tl * BM * row_b; u.B = Bt + (size_t)e * bt_expert_bytes + (size_t)pn * BM * row_b; u.row0 = tl * BM; u.col0 = pn * BM; u.aux = e; return true;
    }
};
}


__device__ __forceinline__ void posbias_wave(int n, int lane, const float* __restrict__ pos, const float* __restrict__ w1, const float* __restrict__ b1, float* __restrict__ b1p) {
    float acc = 0.f;
#pragma unroll 8
    for (int i = 0; i < 32; ++i) { const int k = lane + 64 * i; acc += pos[k] * w1[(size_t)k * 256 + n]; }
    acc = wave_sum(acc);
    if (lane == 0) b1p[n] = acc + b1[n];
}
__device__ __forceinline__ void p_cmp_finalize(char* lds, const float* __restrict__ Pab_k, const float* __restrict__ Pab_v, const float* __restrict__ b1p_k, const float* __restrict__ b1p_v,
                                               const float* __restrict__ w2k, const float* __restrict__ w2v, pg::bf16_t* __restrict__ kc, pg::bf16_t* __restrict__ vcT, int wg, int nwg) {
    const int lane = threadIdx.x & 63, wv = threadIdx.x >> 6;
    float* hs = (float*)lds + wv * 256;
    for (int it = wg * 8 + wv; it < 2 * 16 * 128; it += nwg * 8) {
        const int which = it >> 11, row = it & 2047, bg = row >> 7, c = row & 127;
        const float* P = which ? Pab_v : Pab_k; const float* bp = which ? b1p_v : b1p_k; const float* w2 = which ? w2v : w2k;
        float o = 0.f;
        if (c < 127) {
#pragma unroll
            for (int i = 0; i < 4; ++i) { const int n = lane + 64 * i; hs[n] = gelu_tanh(P[(size_t)row * 512 + n] + P[(size_t)(row + 1) * 512 + 256 + n] + bp[n]); }
            __builtin_amdgcn_s_waitcnt(0);
            for (int n = 0; n < 256; ++n) o += hs[n] * w2[n * 64 + lane];
        }
        if (which == 0) kc[(size_t)row * 64 + lane] = pg::f2bf(o); else vcT[((size_t)bg * 64 + lane) * 128 + c] = pg::f2bf(o);
    }
}

namespace at {
using pg::bf16_t;
typedef short bf16x8 __attribute__((ext_vector_type(8)));
typedef float f32x16 __attribute__((ext_vector_type(16)));
typedef float f32x4 __attribute__((ext_vector_type(4)));
constexpr int TROW = 144, TILE_B = 64 * TROW;
#define AT_MFMA(a, b, c) __builtin_amdgcn_mfma_f32_32x32x16_bf16(a, b, c, 0, 0, 0)
__device__ __forceinline__ bf16x8 pack8(const f32x16& p, int s8) {
    union { unsigned u[4]; bf16x8 v; } x;
#pragma unroll
    for (int i = 0; i < 4; ++i) x.u[i] = pg::cvt_pk_bf16(p[s8 + 2 * i], p[s8 + 2 * i + 1]);
    return x.v;
}
template <int MODE>
__device__ __forceinline__ void attn64_unit(char* lds, int b, int g, int tq, const bf16_t* __restrict__ Q, const bf16_t* __restrict__ Kh, const bf16_t* __restrict__ VT,
                                            const unsigned* __restrict__ selmask, bf16_t* __restrict__ out, const bf16_t* __restrict__ o_cmp, const bf16_t* __restrict__ o_win, const float* __restrict__ gates) {
    const int tid = opaque_tid(), lane = tid & 63, r32 = lane & 31, hi = lane >> 5;
    const int wid = __builtin_amdgcn_readfirstlane(tid >> 6), hl = wid >> 1, qs = wid & 1;
    const int ql = 32 * qs + r32, qpos = tq * 64 + ql, h = g * 4 + hl;
    const size_t trow = (size_t)b * S + qpos;
    const bf16_t* Kb = Kh + (size_t)(b * 2 + g) * S * 64;
    const bf16_t* Vb = VT + (size_t)(b * 2 + g) * 64 * S;
    const int srow = tid >> 3, sch = tid & 7;
    const int kst = srow * TROW + sch * 16;
    const int vst = TILE_B + srow * TROW + ((sch >> 1) * 16 + (sch & 1) * 4) * 2;
    bf16x8 qf[4];
#pragma unroll
    for (int d0 = 0; d0 < 4; ++d0) qf[d0] = *(const bf16x8*)(Q + trow * 512 + h * 64 + 16 * d0 + 8 * hi);
    unsigned msk = 0xffffffffu;
    if (MODE == 0) msk = selmask[(size_t)(b * 2 + g) * S + qpos];
    const int nt = (MODE == 0) ? tq + 1 : (tq < 8 ? tq + 1 : 9);
    f32x16 o0, o1;
#pragma unroll
    for (int r = 0; r < 16; ++r) { o0[r] = 0.f; o1[r] = 0.f; }
    float m = -INFINITY, l = 0.f;
    uint4 kreg, vreg;
    kreg = *(const uint4*)(Kb + (size_t)(tq * 64 + srow) * 64 + sch * 8); vreg = *(const uint4*)(Vb + (size_t)srow * S + tq * 64 + sch * 8);
    __syncthreads();
    *(uint4*)(lds + kst) = kreg; *(uint2*)(lds + vst) = make_uint2(vreg.x, vreg.y); *(uint2*)(lds + vst + 16) = make_uint2(vreg.z, vreg.w);
    __syncthreads();
    for (int i = 0; i < nt; ++i) {
        if (i + 1 < nt) { const int tile = tq - i - 1; kreg = *(const uint4*)(Kb + (size_t)(tile * 64 + srow) * 64 + sch * 8); vreg = *(const uint4*)(Vb + (size_t)srow * S + tile * 64 + sch * 8); }
        const char* kb_ = lds + (i & 1) * 2 * TILE_B; const char* vb_ = kb_ + TILE_B;
        f32x16 p0, p1;
#pragma unroll
        for (int r = 0; r < 16; ++r) { p0[r] = 0.f; p1[r] = 0.f; }
#pragma unroll
        for (int d0 = 0; d0 < 4; ++d0) {
            const bf16x8 kf0 = *(const bf16x8*)(kb_ + r32 * TROW + d0 * 32 + hi * 16), kf1 = *(const bf16x8*)(kb_ + (32 + r32) * TROW + d0 * 32 + hi * 16);
            p0 = AT_MFMA(kf0, qf[d0], p0); p1 = AT_MFMA(kf1, qf[d0], p1);
        }
        if (i == 0) {
#pragma unroll
            for (int r = 0; r < 16; ++r) { const int kl = (r & 3) + 8 * (r >> 2) + 4 * hi; if (kl > ql) p0[r] = -INFINITY; if (kl + 32 > ql) p1[r] = -INFINITY; }
        } else if (MODE == 1) {
            if (i == 8) {
#pragma unroll
                for (int r = 0; r < 16; ++r) { const int kl = (r & 3) + 8 * (r >> 2) + 4 * hi; if (kl <= ql) p0[r] = -INFINITY; if (kl + 32 <= ql) p1[r] = -INFINITY; }
            }
        } else {
            if (!((msk >> (tq - i)) & 1u)) {
#pragma unroll
                for (int r = 0; r < 16; ++r) { p0[r] = -INFINITY; p1[r] = -INFINITY; }
            }
        }
        float mx = fmaxf(p0[0], p1[0]);
#pragma unroll
        for (int r = 1; r < 16; ++r) mx = fmaxf(mx, fmaxf(p0[r], p1[r]));
        mx = fmaxf(mx, __shfl_xor(mx, 32));
        const float mn = fmaxf(m, mx);
        const float alpha = __builtin_amdgcn_exp2f(m - mn);
        m = mn;
        float ls = 0.f;
#pragma unroll
        for (int r = 0; r < 16; ++r) { p0[r] = __builtin_amdgcn_exp2f(p0[r] - mn); p1[r] = __builtin_amdgcn_exp2f(p1[r] - mn); ls += p0[r] + p1[r]; }
        l = l * alpha + ls;
#pragma unroll
        for (int r = 0; r < 16; ++r) { o0[r] *= alpha; o1[r] *= alpha; }
        bf16x8 pb[4];
        pb[0] = pack8(p0, 0); pb[1] = pack8(p0, 8); pb[2] = pack8(p1, 0); pb[3] = pack8(p1, 8);
#pragma unroll
        for (int ks = 0; ks < 4; ++ks) {
            const bf16x8 vf0 = *(const bf16x8*)(vb_ + r32 * TROW + ks * 32 + hi * 16), vf1 = *(const bf16x8*)(vb_ + (32 + r32) * TROW + ks * 32 + hi * 16);
            o0 = AT_MFMA(vf0, pb[ks], o0); o1 = AT_MFMA(vf1, pb[ks], o1);
        }
        if (i + 1 < nt) {
            char* nb = lds + ((i + 1) & 1) * 2 * TILE_B;
            *(uint4*)(nb + kst) = kreg; *(uint2*)(nb + vst) = make_uint2(vreg.x, vreg.y); *(uint2*)(nb + vst + 16) = make_uint2(vreg.z, vreg.w);
        }
        __syncthreads();
    }
    const float lt = l + __shfl_xor(l, 32), inv = 1.f / lt;
    const size_t obase = trow * 512 + h * 64 + 4 * hi;
    float g0 = 0.f, g1 = inv, g2 = 0.f;
    if (MODE == 0) { g0 = gates[trow * 24 + h * 3 + 0]; g1 = gates[trow * 24 + h * 3 + 1] * inv; g2 = gates[trow * 24 + h * 3 + 2]; }
#pragma unroll
    for (int rr = 0; rr < 4; ++rr)
#pragma unroll
        for (int dh = 0; dh < 2; ++dh) {
            const f32x16& oo = dh ? o1 : o0;
            float x0 = oo[4 * rr] * g1, x1 = oo[4 * rr + 1] * g1, x2 = oo[4 * rr + 2] * g1, x3 = oo[4 * rr + 3] * g1;
            const size_t idx = obase + 32 * dh + 8 * rr;
            if (MODE == 0) {
                const uint2 c = *(const uint2*)(o_cmp + idx), w = *(const uint2*)(o_win + idx);
                x0 += g0 * __uint_as_float(c.x << 16) + g2 * __uint_as_float(w.x << 16); x1 += g0 * __uint_as_float(c.x & 0xffff0000u) + g2 * __uint_as_float(w.x & 0xffff0000u);
                x2 += g0 * __uint_as_float(c.y << 16) + g2 * __uint_as_float(w.y << 16); x3 += g0 * __uint_as_float(c.y & 0xffff0000u) + g2 * __uint_as_float(w.y & 0xffff0000u);
            }
            uint2 o; o.x = pg::cvt_pk_bf16(x0, x1); o.y = pg::cvt_pk_bf16(x2, x3);
            *(uint2*)(out + idx) = o;
        }
}
template <int MODE>
__device__ __forceinline__ void p_attn64(char* lds, const bf16_t* Q, const bf16_t* Kh, const bf16_t* VT, const unsigned* selmask, bf16_t* out, const bf16_t* o_cmp, const bf16_t* o_win, const float* gates, int wg, int nwg) {
    for (int item = wg; item < 256; item += nwg) {
        const int bg = item >> 4, j = item & 15;
        attn64_unit<MODE>(lds, bg >> 1, bg & 1, 31 - j, Q, Kh, VT, selmask, out, o_cmp, o_win, gates);
        attn64_unit<MODE>(lds, bg >> 1, bg & 1, j, Q, Kh, VT, selmask, out, o_cmp, o_win, gates);
    }
}

constexpr int CK_ROW = 144, CV_ROW = 272, CK_B = 128 * CK_ROW, CV_B = 64 * CV_ROW, CP_OFF = CK_B + CV_B, CI_OFF = CP_OFF + 4 * 64 * 32 * 4, CMP_LDS = CI_OFF + 64 * 32 * 4;
__device__ __forceinline__ void cmp_unit(char* lds, int b, int g, int tq, const bf16_t* __restrict__ Q, const bf16_t* __restrict__ kc, const bf16_t* __restrict__ vcT,
                                         bf16_t* __restrict__ out, unsigned* __restrict__ selmask) {
    const int tid = opaque_tid(), lane = tid & 63, r32 = lane & 31, hi = lane >> 5;
    const int wid = __builtin_amdgcn_readfirstlane(tid >> 6), hl = wid >> 1, qs = wid & 1;
    const int ql = 32 * qs + r32, qpos = tq * 64 + ql, h = g * 4 + hl, bg = b * 2 + g;
    const size_t trow = (size_t)b * S + qpos;
    __syncthreads();
#pragma unroll
    for (int i = 0; i < 2; ++i) {
        const int ch = tid + 512 * i;
        { const int row = ch >> 3, c8 = ch & 7; *(uint4*)(lds + row * CK_ROW + c8 * 16) = *(const uint4*)(kc + ((size_t)bg * 128 + row) * 64 + c8 * 8); }
        { const int row = ch >> 4, c16 = ch & 15; const uint4 x = *(const uint4*)(vcT + ((size_t)bg * 64 + row) * 128 + c16 * 8);
          char* dst = lds + CK_B + row * CV_ROW + ((c16 >> 1) * 16 + (c16 & 1) * 4) * 2; *(uint2*)dst = make_uint2(x.x, x.y); *(uint2*)(dst + 16) = make_uint2(x.z, x.w); }
    }
    bf16x8 qf[4];
#pragma unroll
    for (int d0 = 0; d0 < 4; ++d0) qf[d0] = *(const bf16x8*)(Q + trow * 512 + h * 64 + 16 * d0 + 8 * hi);
    __syncthreads();
    f32x16 p[4];
#pragma unroll
    for (int kh = 0; kh < 4; ++kh) {
#pragma unroll
        for (int r = 0; r < 16; ++r) p[kh][r] = 0.f;
#pragma unroll
        for (int d0 = 0; d0 < 4; ++d0) { const bf16x8 kf = *(const bf16x8*)(lds + (32 * kh + r32) * CK_ROW + d0 * 32 + hi * 16); p[kh] = AT_MFMA(kf, qf[d0], p[kh]); }
    }
    float mx = -1e30f;
#pragma unroll
    for (int kh = 0; kh < 4; ++kh)
#pragma unroll
        for (int r = 0; r < 16; ++r) { const int c = 32 * kh + (r & 3) + 8 * (r >> 2) + 4 * hi; if (16 * c + 31 > qpos) p[kh][r] = -1e30f; mx = fmaxf(mx, p[kh][r]); }
    mx = fmaxf(mx, __shfl_xor(mx, 32));
    float ls = 0.f;
#pragma unroll
    for (int kh = 0; kh < 4; ++kh)
#pragma unroll
        for (int r = 0; r < 16; ++r) { p[kh][r] = __builtin_amdgcn_exp2f(p[kh][r] - mx); ls += p[kh][r]; }
    ls += __shfl_xor(ls, 32);
    const float inv = (mx > -1e29f) ? 1.f / ls : 0.f;
#pragma unroll
    for (int kh = 0; kh < 4; ++kh)
#pragma unroll
        for (int r = 0; r < 16; ++r) p[kh][r] *= inv;
    f32x16 o0, o1;
#pragma unroll
    for (int r = 0; r < 16; ++r) { o0[r] = 0.f; o1[r] = 0.f; }
#pragma unroll
    for (int ks = 0; ks < 8; ++ks) {
        const bf16x8 pb = pack8(p[ks >> 1], (ks & 1) * 8);
        const bf16x8 vf0 = *(const bf16x8*)(lds + CK_B + r32 * CV_ROW + ks * 32 + hi * 16), vf1 = *(const bf16x8*)(lds + CK_B + (32 + r32) * CV_ROW + ks * 32 + hi * 16);
        o0 = AT_MFMA(vf0, pb, o0); o1 = AT_MFMA(vf1, pb, o1);
    }
    bf16_t* orow = out + trow * 512 + h * 64 + 4 * hi;
#pragma unroll
    for (int rr = 0; rr < 4; ++rr) {
        uint2 a, c; a.x = pg::cvt_pk_bf16_acc(o0[4 * rr], o0[4 * rr + 1]); a.y = pg::cvt_pk_bf16_acc(o0[4 * rr + 2], o0[4 * rr + 3]); c.x = pg::cvt_pk_bf16_acc(o1[4 * rr], o1[4 * rr + 1]); c.y = pg::cvt_pk_bf16_acc(o1[4 * rr + 2], o1[4 * rr + 3]);
        *(uint2*)(orow + 8 * rr) = a; *(uint2*)(orow + 32 + 8 * rr) = c;
    }
    float inn[16], car[16];
#pragma unroll
    for (int t = 0; t < 16; ++t) { const f32x16& pk = p[t >> 2]; const int r0 = 4 * (t & 3); car[t] = 0.5f * pk[r0 + 3]; inn[t] = pk[r0] + pk[r0 + 1] + pk[r0 + 2] + car[t]; }
    float* part = (float*)(lds + CP_OFF) + (hl * 64 + ql) * 32;
#pragma unroll
    for (int t = 0; t < 16; ++t) {
        const float co = __shfl_xor(car[t], 32);
        const float cprev = __shfl_xor(t > 0 ? car[t - 1] : 0.f, 32);
        part[2 * t + hi] = inn[t] + (hi ? co : cprev);
    }
    __syncthreads();
    float* impf = (float*)(lds + CI_OFF);
    const float* pall = (const float*)(lds + CP_OFF);
#pragma unroll
    for (int k = 0; k < 4; ++k) {
        const int idx = tid + 512 * k, q = idx >> 5, j = idx & 31, cur = tq;
        float imp = ((pall[(0 * 64 + q) * 32 + j] + pall[(1 * 64 + q) * 32 + j]) + pall[(2 * 64 + q) * 32 + j]) + pall[(3 * 64 + q) * 32 + j];
        if (j == 0 || j == cur || j == cur - 1) imp = 1e30f; else if (j > cur) imp = -1e30f;
        impf[idx] = imp;
    }
    __syncthreads();
#pragma unroll
    for (int k = 0; k < 4; ++k) {
        const int idx = tid + 512 * k, q = idx >> 5, j = idx & 31;
        const float mine = impf[idx];
        int rank = 0;
        for (int i = 0; i < 32; ++i) { const float x = impf[q * 32 + i]; rank += (x > mine || (x == mine && i < j)) ? 1 : 0; }
        const unsigned long long bal = __ballot(rank < 16);
        if ((lane & 31) == 0) selmask[(size_t)bg * S + tq * 64 + q] = (unsigned)(hi ? (bal >> 32) : (bal & 0xffffffffull));
    }
}
__device__ __forceinline__ void p_cmp_attn_fast(char* lds, const bf16_t* Q, const bf16_t* kc, const bf16_t* vcT, bf16_t* out, unsigned* selmask, int wg, int nwg) {
    for (int item = wg; item < 512; item += nwg) cmp_unit(lds, item >> 6, (item >> 5) & 1, item & 31, Q, kc, vcT, out, selmask);
}

constexpr int XK_ROW = 528, XV_ROW = 144, XK_B = 64 * XK_ROW, XV_B = 256 * XV_ROW;
typedef float f32x4v __attribute__((ext_vector_type(4)));
#define XT_MFMA(a, b, c) __builtin_amdgcn_mfma_f32_16x16x32_bf16(a, b, c, 0, 0, 0)
__device__ __forceinline__ void xattn_unit(char* lds, int b, int h, int qt, const bf16_t* __restrict__ Q, const bf16_t* __restrict__ xk, const bf16_t* __restrict__ xvT, bf16_t* __restrict__ out) {
    const int tid = opaque_tid(), lane = tid & 63, l15 = lane & 15, quad = lane >> 4;
    const int wid = __builtin_amdgcn_readfirstlane(tid >> 6);
    const size_t trow = (size_t)b * S + qt * 128 + wid * 16 + l15;
    const bf16_t* Kb = xk + (size_t)(b * 4 + h) * 256 * 256;
    const bf16_t* Vb = xvT + (size_t)(b * 4 + h) * 256 * 256;
    bf16x8 qf[8];
#pragma unroll
    for (int ds = 0; ds < 8; ++ds) qf[ds] = *(const bf16x8*)(Q + trow * 1024 + h * 256 + 32 * ds + 8 * quad);
    f32x4v o[16];
#pragma unroll
    for (int db = 0; db < 16; ++db) o[db] = (f32x4v){0.f, 0.f, 0.f, 0.f};
    float m = -INFINITY, l = 0.f;
    for (int kt = 0; kt < 4; ++kt) {
        __syncthreads();
#pragma unroll
        for (int i = 0; i < 4; ++i) {
            const int ch = tid + 512 * i;
            { const int row = ch >> 5, c = ch & 31; *(uint4*)(lds + row * XK_ROW + c * 16) = *(const uint4*)(Kb + (size_t)(kt * 64 + row) * 256 + c * 8); }
            { const int row = ch >> 3, c = ch & 7, cp = c & 3; const uint4 x = *(const uint4*)(Vb + (size_t)row * 256 + kt * 64 + c * 8);
              char* dst = lds + XK_B + row * XV_ROW + ((c >> 2) * 32 + 16 * (cp & 1) + 4 * (cp >> 1)) * 2; *(uint2*)dst = make_uint2(x.x, x.y); *(uint2*)(dst + 16) = make_uint2(x.z, x.w); }
        }
        __syncthreads();
        f32x4v sc[4];
#pragma unroll
        for (int kb = 0; kb < 4; ++kb) {
            sc[kb] = (f32x4v){0.f, 0.f, 0.f, 0.f};
#pragma unroll
            for (int ds = 0; ds < 8; ++ds) { const bf16x8 kf = *(const bf16x8*)(lds + (16 * kb + l15) * XK_ROW + ds * 64 + quad * 16); sc[kb] = XT_MFMA(kf, qf[ds], sc[kb]); }
        }
        float mx = -INFINITY;
#pragma unroll
        for (int kb = 0; kb < 4; ++kb)
#pragma unroll
            for (int r = 0; r < 4; ++r) mx = fmaxf(mx, sc[kb][r]);
        mx = fmaxf(mx, __shfl_xor(mx, 16)); mx = fmaxf(mx, __shfl_xor(mx, 32));
        const float mn = fmaxf(m, mx), alpha = __builtin_amdgcn_exp2f(m - mn);
        m = mn;
        float ls = 0.f;
#pragma unroll
        for (int kb = 0; kb < 4; ++kb)
#pragma unroll
            for (int r = 0; r < 4; ++r) { sc[kb][r] = __builtin_amdgcn_exp2f(sc[kb][r] - mn); ls += sc[kb][r]; }
        l = l * alpha + ls;
#pragma unroll
        for (int db = 0; db < 16; ++db) o[db] *= alpha;
#pragma unroll
        for (int k2 = 0; k2 < 2; ++k2) {
            union { unsigned u[4]; bf16x8 v; } pb;
            pb.u[0] = pg::cvt_pk_bf16(sc[2 * k2][0], sc[2 * k2][1]); pb.u[1] = pg::cvt_pk_bf16(sc[2 * k2][2], sc[2 * k2][3]);
            pb.u[2] = pg::cvt_pk_bf16(sc[2 * k2 + 1][0], sc[2 * k2 + 1][1]); pb.u[3] = pg::cvt_pk_bf16(sc[2 * k2 + 1][2], sc[2 * k2 + 1][3]);
#pragma unroll
            for (int db = 0; db < 16; ++db) { const bf16x8 vf = *(const bf16x8*)(lds + XK_B + (16 * db + l15) * XV_ROW + k2 * 64 + quad * 16); o[db] = XT_MFMA(vf, pb.v, o[db]); }
        }
    }
    l += __shfl_xor(l, 16); l += __shfl_xor(l, 32);
    const float inv = 1.f / l;
    bf16_t* orow = out + trow * 1024 + h * 256 + 4 * quad;
#pragma unroll
    for (int db = 0; db < 16; ++db) { uint2 x; x.x = pg::cvt_pk_bf16(o[db][0] * inv, o[db][1] * inv); x.y = pg::cvt_pk_bf16(o[db][2] * inv, o[db][3] * inv); *(uint2*)(orow + 16 * db) = x; }
}
__device__ __forceinline__ void p_xattn_fast(char* lds, const bf16_t* Q, const bf16_t* xk, const bf16_t* xvT, bf16_t* out, int wg, int nwg) {
    for (int item = wg; item < 512; item += nwg) xattn_unit(lds, item >> 6, (item >> 4) & 3, item & 15, Q, xk, xvT, out);
}
}


namespace tl {
using pg::bf16_t; using pg::cvt_pk_bf16;
__device__ __forceinline__ float blo(unsigned u) { return __uint_as_float(u << 16); }
__device__ __forceinline__ float bhi(unsigned u) { return __uint_as_float(u & 0xffff0000u); }
__device__ __forceinline__ float ssq4(const float4& a) { return a.x * a.x + a.y * a.y + a.z * a.z + a.w * a.w; }

__device__ __forceinline__ void rmsnorm_rows(const float* __restrict__ in, const float* __restrict__ g, bf16_t* __restrict__ out, int rows, int gw, int nw, int lane) {
    float4 gv[4];
#pragma unroll
    for (int i = 0; i < 4; ++i) gv[i] = *(const float4*)(g + 256 * i + 4 * lane);
    for (int r0 = gw; r0 < rows; r0 += 2 * nw) {
        const int r1 = r0 + nw; const bool two = r1 < rows;
        float4 a[4], b[4];
#pragma unroll
        for (int i = 0; i < 4; ++i) { a[i] = *(const float4*)(in + (size_t)r0 * 1024 + 256 * i + 4 * lane); b[i] = two ? *(const float4*)(in + (size_t)r1 * 1024 + 256 * i + 4 * lane) : make_float4(0.f, 0.f, 0.f, 0.f); }
        float sa = ssq4(a[0]) + ssq4(a[1]) + ssq4(a[2]) + ssq4(a[3]), sb = ssq4(b[0]) + ssq4(b[1]) + ssq4(b[2]) + ssq4(b[3]);
        sa = wave_sum(sa); sb = wave_sum(sb);
        const float ra = rsqrtf(sa * (1.f / 1024.f) + 1e-5f), rb = rsqrtf(sb * (1.f / 1024.f) + 1e-5f);
#pragma unroll
        for (int i = 0; i < 4; ++i) {
            uint2 o; o.x = cvt_pk_bf16(a[i].x * ra * gv[i].x, a[i].y * ra * gv[i].y); o.y = cvt_pk_bf16(a[i].z * ra * gv[i].z, a[i].w * ra * gv[i].w);
            *(uint2*)(out + (size_t)r0 * 1024 + 256 * i + 4 * lane) = o;
            if (two) { uint2 q; q.x = cvt_pk_bf16(b[i].x * rb * gv[i].x, b[i].y * rb * gv[i].y); q.y = cvt_pk_bf16(b[i].z * rb * gv[i].z, b[i].w * rb * gv[i].w); *(uint2*)(out + (size_t)r1 * 1024 + 256 * i + 4 * lane) = q; }
        }
    }
}

__device__ __forceinline__ void mix_post(const bf16_t* __restrict__ o_nsa, const bf16_t* __restrict__ ub, const bf16_t* __restrict__ cbb, const float* __restrict__ conv_w,
                                         const float* __restrict__ g_nsa, const float* __restrict__ g_conv, bf16_t* __restrict__ omix, int gw, int nw, int lane) {
    float cw[3][8], gn[8], gc[8];
#pragma unroll
    for (int j = 0; j < 8; ++j) { gn[j] = g_nsa[8 * lane + j]; gc[j] = g_conv[8 * lane + j]; cw[0][j] = conv_w[8 * lane + j]; cw[1][j] = conv_w[512 + 8 * lane + j]; cw[2][j] = conv_w[1024 + 8 * lane + j]; }
    for (int t = gw; t < T; t += nw) {
        const int sq = t & (S - 1);
        const uint4 zero = make_uint4(0u, 0u, 0u, 0u);
        const uint4 on4 = *(const uint4*)(o_nsa + (size_t)t * 512 + 8 * lane), c4 = *(const uint4*)(cbb + (size_t)t * 512 + 8 * lane), u2 = *(const uint4*)(ub + (size_t)t * 512 + 8 * lane);
        const uint4 u1 = sq >= 1 ? *(const uint4*)(ub + (size_t)(t - 1) * 512 + 8 * lane) : zero, u0 = sq >= 2 ? *(const uint4*)(ub + (size_t)(t - 2) * 512 + 8 * lane) : zero;
        const unsigned onw[4] = {on4.x, on4.y, on4.z, on4.w}, cbw[4] = {c4.x, c4.y, c4.z, c4.w}, u0w[4] = {u0.x, u0.y, u0.z, u0.w}, u1w[4] = {u1.x, u1.y, u1.z, u1.w}, u2w[4] = {u2.x, u2.y, u2.z, u2.w};
        float on[8], oc[8], ssn = 0.f, ssc = 0.f;
#pragma unroll
        for (int q = 0; q < 4; ++q) {
            on[2 * q] = blo(onw[q]); on[2 * q + 1] = bhi(onw[q]);
            const float y0 = cw[0][2 * q] * blo(u0w[q]) + cw[1][2 * q] * blo(u1w[q]) + cw[2][2 * q] * blo(u2w[q]);
            const float y1 = cw[0][2 * q + 1] * bhi(u0w[q]) + cw[1][2 * q + 1] * bhi(u1w[q]) + cw[2][2 * q + 1] * bhi(u2w[q]);
            oc[2 * q] = blo(cbw[q]) * y0; oc[2 * q + 1] = bhi(cbw[q]) * y1;
        }
#pragma unroll
        for (int j = 0; j < 8; ++j) { ssn += on[j] * on[j]; ssc += oc[j] * oc[j]; }
        ssn = wave_sum(ssn); ssc = wave_sum(ssc);
        const float rn = rsqrtf(ssn * (1.f / 512.f) + 1e-5f), rc = rsqrtf(ssc * (1.f / 512.f) + 1e-5f);
        uint4 o1, o2;
        o1.x = cvt_pk_bf16(on[0] * rn * gn[0], on[1] * rn * gn[1]); o1.y = cvt_pk_bf16(on[2] * rn * gn[2], on[3] * rn * gn[3]); o1.z = cvt_pk_bf16(on[4] * rn * gn[4], on[5] * rn * gn[5]); o1.w = cvt_pk_bf16(on[6] * rn * gn[6], on[7] * rn * gn[7]);
        o2.x = cvt_pk_bf16(oc[0] * rc * gc[0], oc[1] * rc * gc[1]); o2.y = cvt_pk_bf16(oc[2] * rc * gc[2], oc[3] * rc * gc[3]); o2.z = cvt_pk_bf16(oc[4] * rc * gc[4], oc[5] * rc * gc[5]); o2.w = cvt_pk_bf16(oc[6] * rc * gc[6], oc[7] * rc * gc[7]);
        *(uint4*)(omix + (size_t)t * 1024 + 8 * lane) = o1; *(uint4*)(omix + (size_t)t * 1024 + 512 + 8 * lane) = o2;
    }
}

__device__ __forceinline__ void xreduce32(float (&acc)[32], int lane) {
    const bool b5 = lane & 32, b4 = lane & 16, b3 = lane & 8, b2 = lane & 4, b1 = lane & 2;
#pragma unroll
    for (int e = 0; e < 16; ++e) { const float snd = b5 ? acc[e] : acc[e + 16], kp = b5 ? acc[e + 16] : acc[e]; acc[e] = kp + __shfl_xor(snd, 32); }
#pragma unroll
    for (int e = 0; e < 8; ++e) { const float snd = b4 ? acc[e] : acc[e + 8], kp = b4 ? acc[e + 8] : acc[e]; acc[e] = kp + __shfl_xor(snd, 16); }
#pragma unroll
    for (int e = 0; e < 4; ++e) { const float snd = b3 ? acc[e] : acc[e + 4], kp = b3 ? acc[e + 4] : acc[e]; acc[e] = kp + __shfl_xor(snd, 8); }
#pragma unroll
    for (int e = 0; e < 2; ++e) { const float snd = b2 ? acc[e] : acc[e + 2], kp = b2 ? acc[e + 2] : acc[e]; acc[e] = kp + __shfl_xor(snd, 4); }
    { const float snd = b1 ? acc[0] : acc[1], kp = b1 ? acc[1] : acc[0]; acc[0] = kp + __shfl_xor(snd, 2); }
    acc[0] += __shfl_xor(acc[0], 1);
}
__device__ __forceinline__ void route_token(float logit, int t, int lane, int* __restrict__ a_e, float* __restrict__ a_w, int* __restrict__ a_slot, int* lcnt) {
    const int e = lane >> 1;
    int rank = 0;
#pragma unroll
    for (int i = 0; i < 32; ++i) { const float x = __shfl(logit, 2 * i); rank += (x > logit || (x == logit && i < e)) ? 1 : 0; }
    const float vmax = wave_max(logit);
    const bool sel = (rank < TOPK) && !(lane & 1);
    const float ex = sel ? __expf(logit - vmax) : 0.f;
    const float sum = wave_sum(ex);
    if (sel) { const int a = t * TOPK + rank; a_e[a] = e; a_w[a] = ex / sum; a_slot[a] = atomicAdd(&lcnt[e], 1); }
}
constexpr int WR_STRIDE = 1028;
__device__ __forceinline__ void norm_router(char* lds, const float* __restrict__ h2, const float* __restrict__ g, const float* __restrict__ wr, const float* __restrict__ br, unsigned char* __restrict__ xn8,
                                            int* __restrict__ a_e, float* __restrict__ a_w, int* __restrict__ a_slot, int* __restrict__ wgcnt  , int gw, int nw, int lane) {
    float* Ws = (float*)lds;
    int* lcnt = (int*)(lds + NE * WR_STRIDE * 4);
    __syncthreads();
    for (int idx = threadIdx.x; idx < 1024 * NE; idx += 512) Ws[(idx & 31) * WR_STRIDE + (idx >> 5)] = wr[idx];
    if (threadIdx.x < NE) lcnt[threadIdx.x] = 0;
    __syncthreads();
    float4 gv[4];
#pragma unroll
    for (int i = 0; i < 4; ++i) gv[i] = *(const float4*)(g + 256 * i + 4 * lane);
    const float bias = br[lane >> 1];
    for (int t0 = gw; t0 < T; t0 += 2 * nw) {
        const int t1 = t0 + nw; const bool two = t1 < T;
        float4 a[4], b[4];
#pragma unroll
        for (int i = 0; i < 4; ++i) { a[i] = *(const float4*)(h2 + (size_t)t0 * 1024 + 256 * i + 4 * lane); b[i] = two ? *(const float4*)(h2 + (size_t)t1 * 1024 + 256 * i + 4 * lane) : make_float4(0.f, 0.f, 0.f, 0.f); }
        float sa = ssq4(a[0]) + ssq4(a[1]) + ssq4(a[2]) + ssq4(a[3]), sb = ssq4(b[0]) + ssq4(b[1]) + ssq4(b[2]) + ssq4(b[3]);
        sa = wave_sum(sa); sb = wave_sum(sb);
        const float ra = rsqrtf(sa * (1.f / 1024.f) + 1e-5f), rb = rsqrtf(sb * (1.f / 1024.f) + 1e-5f);
#pragma unroll
        for (int i = 0; i < 4; ++i) {
            a[i].x *= ra * gv[i].x; a[i].y *= ra * gv[i].y; a[i].z *= ra * gv[i].z; a[i].w *= ra * gv[i].w;
            b[i].x *= rb * gv[i].x; b[i].y *= rb * gv[i].y; b[i].z *= rb * gv[i].z; b[i].w *= rb * gv[i].w;
            *(unsigned*)(xn8 + (size_t)t0 * 1024 + 256 * i + 4 * lane) = pg::pk4_fp8(a[i].x, a[i].y, a[i].z, a[i].w);
            if (two) *(unsigned*)(xn8 + (size_t)t1 * 1024 + 256 * i + 4 * lane) = pg::pk4_fp8(b[i].x, b[i].y, b[i].z, b[i].w);
        }
        float accA[32], accB[32];
#pragma unroll
        for (int e = 0; e < 32; ++e) {
            float sA = 0.f, sB = 0.f;
#pragma unroll
            for (int i = 0; i < 4; ++i) {
                const float4 w = *(const float4*)(Ws + e * WR_STRIDE + 256 * i + 4 * lane);
                sA += a[i].x * w.x + a[i].y * w.y + a[i].z * w.z + a[i].w * w.w;
                sB += b[i].x * w.x + b[i].y * w.y + b[i].z * w.z + b[i].w * w.w;
            }
            accA[e] = sA; accB[e] = sB;
        }
        xreduce32(accA, lane); xreduce32(accB, lane);
        route_token(accA[0] + bias, t0, lane, a_e, a_w, a_slot, lcnt);
        if (two) route_token(accB[0] + bias, t1, lane, a_e, a_w, a_slot, lcnt);
    }
    __syncthreads();
    if (threadIdx.x < NE) wgcnt[blockIdx.x * NE + threadIdx.x] = lcnt[threadIdx.x];
}
__device__ __forceinline__ void moe_scatter(char* lds, const int* __restrict__ wgcnt, int* __restrict__ pstart, int* __restrict__ tile_e, const int* __restrict__ a_e, const float* __restrict__ a_w,
                                            const int* __restrict__ a_slot, const unsigned char* __restrict__ xn8, unsigned char* __restrict__ xg8, float* __restrict__ w_buf, int* __restrict__ dest_of, int wg, int gw, int nw, int lane) {
    int* ps = (int*)lds;
    int* wb = ps + 64;
    int* part = ps + 128;
    __syncthreads();
    {
        const int e = threadIdx.x & 31, q = threadIdx.x >> 5, nwg_ = gridDim.x;
        int tot = 0, below = 0;
        const int per = (nwg_ + 15) / 16;
        for (int w = q * per; w < (q + 1) * per && w < nwg_; ++w) { const int c = wgcnt[w * NE + e]; tot += c; below += (w < wg) ? c : 0; }
        part[(q * NE + e) * 2] = tot; part[(q * NE + e) * 2 + 1] = below;
    }
    __syncthreads();
    if (threadIdx.x < NE) { int tot = 0, below = 0; for (int q = 0; q < 16; ++q) { tot += part[(q * NE + threadIdx.x) * 2]; below += part[(q * NE + threadIdx.x) * 2 + 1]; } ps[96 + threadIdx.x] = tot; wb[threadIdx.x] = below; }
    __syncthreads();
    if (threadIdx.x == 0) { int acc = 0; for (int e = 0; e < NE; ++e) { ps[e] = acc; acc += (ps[96 + e] + MT - 1) / MT * MT; } ps[NE] = acc; }
    __syncthreads();
    if (wg == 0) {
        if (threadIdx.x == 0) pstart[NE] = ps[NE] / MT;
        for (int tl_ = threadIdx.x; tl_ < NTILE; tl_ += 512) { const int r = tl_ * MT; int e = -1; for (int i = 0; i < NE; ++i) if (r >= ps[i] && r < ps[i + 1]) e = i; tile_e[tl_] = e; }
    }
    for (int t = gw; t < T; t += nw) {
        const uint4 row = *(const uint4*)(xn8 + (size_t)t * 1024 + 16 * lane);
        const int4 e4 = *(const int4*)(a_e + 4 * t), s4 = *(const int4*)(a_slot + 4 * t); const float4 w4 = *(const float4*)(a_w + 4 * t);
        const int ee[4] = {e4.x, e4.y, e4.z, e4.w}, sl[4] = {s4.x, s4.y, s4.z, s4.w}; const float ww[4] = {w4.x, w4.y, w4.z, w4.w};
#pragma unroll
        for (int k = 0; k < 4; ++k) {
            const int dest = ps[ee[k]] + wb[ee[k]] + sl[k];
            *(uint4*)(xg8 + (size_t)dest * 1024 + 16 * lane) = row;
            if (lane == 0) { w_buf[dest] = ww[k]; dest_of[4 * t + k] = dest; }
        }
    }
}
__device__ __forceinline__ void final_rows(const float* __restrict__ h2, const bf16_t* __restrict__ out_a, const int* __restrict__ dest_of, const float* __restrict__ g, float* __restrict__ out, int gw, int nw, int lane) {
    float4 gv[4];
#pragma unroll
    for (int i = 0; i < 4; ++i) gv[i] = *(const float4*)(g + 256 * i + 4 * lane);
    for (int t = gw; t < T; t += nw) {
        const int4 d4 = *(const int4*)(dest_of + 4 * t);
        const int dd[4] = {d4.x, d4.y, d4.z, d4.w};
        float4 a[4]; uint2 oa[4][4];
#pragma unroll
        for (int i = 0; i < 4; ++i) a[i] = *(const float4*)(h2 + (size_t)t * 1024 + 256 * i + 4 * lane);
#pragma unroll
        for (int k = 0; k < 4; ++k)
#pragma unroll
            for (int i = 0; i < 4; ++i) oa[k][i] = *(const uint2*)(out_a + (size_t)dd[k] * 1024 + 256 * i + 4 * lane);
        float ss = 0.f;
#pragma unroll
        for (int i = 0; i < 4; ++i) {
#pragma unroll
            for (int k = 0; k < 4; ++k) { a[i].x += blo(oa[k][i].x); a[i].y += bhi(oa[k][i].x); a[i].z += blo(oa[k][i].y); a[i].w += bhi(oa[k][i].y); }
            ss += ssq4(a[i]);
        }
        ss = wave_sum(ss);
        const float rs = rsqrtf(ss * (1.f / 1024.f) + 1e-5f);
#pragma unroll
        for (int i = 0; i < 4; ++i) *(float4*)(out + (size_t)t * 1024 + 256 * i + 4 * lane) = make_float4(a[i].x * rs * gv[i].x, a[i].y * rs * gv[i].y, a[i].z * rs * gv[i].z, a[i].w * rs * gv[i].w);
    }
}
}

template <bool PERM64, class RowMap>
__device__ __forceinline__ void p_convT(char* lds, const float* __restrict__ W, int K, int N, int nmat, pg::bf16_t* __restrict__ Bt, int nrows_out, RowMap rowmap, int wg, int nwg) {
    pg::bf16_t* Ls = (pg::bf16_t*)lds;
    const int tid = opaque_tid();
    const int tk = K / 128, tn = nrows_out / 128, per = tk * tn, total = per * nmat;
    const int kk0 = tid >> 5, n4 = (tid & 31) * 4, sub = n4 >> 6, nl = n4 & 63;
    float4 x[8];
    auto issue = [&](int tile) {
        const int mat = tile / per, r = tile % per, jn = r / tk, jk = r % tk;
        const int n0 = rowmap(jn * 128 + 64 * sub);
        const float* src = W + (size_t)mat * K * N + (size_t)(jk * 128 + kk0) * N + n0 + nl;
        const bool ok = n0 >= 0 && n0 + nl < N;
#pragma unroll
        for (int i = 0; i < 8; ++i) x[i] = ok ? *(const float4*)(src + (size_t)(16 * i) * N) : make_float4(0.f, 0.f, 0.f, 0.f);
    };
    int tile = wg;
    if (tile < total) issue(tile);
    while (tile < total) {
        const int mat = tile / per, r = tile % per, jn = r / tk, jk = r % tk;
        __syncthreads();
#pragma unroll
        for (int i = 0; i < 8; ++i) {
            const int kk = kk0 + 16 * i;
            Ls[(n4 + 0) * 136 + kk] = pg::f2bf(x[i].x); Ls[(n4 + 1) * 136 + kk] = pg::f2bf(x[i].y); Ls[(n4 + 2) * 136 + kk] = pg::f2bf(x[i].z); Ls[(n4 + 3) * 136 + kk] = pg::f2bf(x[i].w);
        }
        const int nxt = tile + nwg;
        if (nxt < total) issue(nxt);
        __syncthreads();
#pragma unroll
        for (int i = 0; i < 4; ++i) {
            const int c = tid + 512 * i, n = c >> 4, kc = (c & 15) * 8;
            const int ns = PERM64 ? ((n & 64) | (n & 15) | ((n & 16) << 1) | ((n & 32) >> 1)) : n;
            const uint4 y = *(const uint4*)(Ls + ns * 136 + kc);
            *(uint4*)(Bt + ((size_t)mat * nrows_out + jn * 128 + n) * K + jk * 128 + kc) = y;
        }
        tile = nxt;
    }
}


template <class RowMap>
__device__ __forceinline__ void p_convT8(char* lds, const float* __restrict__ W, int K, int N, int nmat, unsigned char* __restrict__ Bt, int nrows_out, RowMap rowmap, int wg, int nwg) {
    unsigned char* Ls = (unsigned char*)lds;
    const int tid = opaque_tid();
    const int tk = K / 128, tn = nrows_out / 128, per = tk * tn, total = per * nmat;
    const int kk0 = tid >> 5, n4 = (tid & 31) * 4, sub = n4 >> 6, nl = n4 & 63;
    float4 x[8];
    auto issue = [&](int tile) {
        const int mat = tile / per, r = tile % per, jn = r / tk, jk = r % tk;
        const int n0 = rowmap(jn * 128 + 64 * sub);
        const float* src = W + (size_t)mat * K * N + (size_t)(jk * 128 + kk0) * N + n0 + nl;
        const bool ok = n0 >= 0 && n0 + nl < N;
#pragma unroll
        for (int i = 0; i < 8; ++i) x[i] = ok ? *(const float4*)(src + (size_t)(16 * i) * N) : make_float4(0.f, 0.f, 0.f, 0.f);
    };
    int tile = wg;
    if (tile < total) issue(tile);
    while (tile < total) {
        const int mat = tile / per, r = tile % per, jn = r / tk, jk = r % tk;
        __syncthreads();
#pragma unroll
        for (int i = 0; i < 8; ++i) {
            const int kk = kk0 + 16 * i;
            const unsigned p01 = __builtin_amdgcn_cvt_pk_fp8_f32(x[i].x * pg::W8_SCALE, x[i].y * pg::W8_SCALE, 0u, false), p23 = __builtin_amdgcn_cvt_pk_fp8_f32(x[i].z * pg::W8_SCALE, x[i].w * pg::W8_SCALE, 0u, false);
            Ls[(n4 + 0) * 144 + kk] = (unsigned char)(p01 & 0xff); Ls[(n4 + 1) * 144 + kk] = (unsigned char)((p01 >> 8) & 0xff);
            Ls[(n4 + 2) * 144 + kk] = (unsigned char)(p23 & 0xff); Ls[(n4 + 3) * 144 + kk] = (unsigned char)((p23 >> 8) & 0xff);
        }
        const int nxt = tile + nwg;
        if (nxt < total) issue(nxt);
        __syncthreads();
#pragma unroll
        for (int i = 0; i < 2; ++i) {
            const int c = tid + 512 * i, n = c >> 3, kc = (c & 7) * 16;
            const uint4 y = *(const uint4*)(Ls + n * 144 + kc);
            *(uint4*)(Bt + ((size_t)mat * nrows_out + jn * 128 + n) * K + jk * 128 + kc) = y;
        }
        tile = nxt;
    }
}

struct Params {
    const float *x, *mem; const int* positions;
    const float *g_mix_norm, *w_mix_in, *cmp_pos_k, *cmp_pos_v, *cmp_w1_k, *cmp_b1_k, *cmp_w2_k, *cmp_w1_v, *cmp_b1_v, *cmp_w2_v, *conv_w, *g_nsa_out, *g_conv_out, *w_mix_out,
        *g_xattn_norm, *g_mem_norm, *w_xq, *w_xkv, *w_xo, *g_moe_norm, *w_router, *b_router, *w_gate_up, *b_gate_up, *w_down, *b_down, *g_final;
    float* out;
    unsigned* bar;
    int *wgcnt, *counts, *pstart, *tile_e, *a_e, *a_slot, *dest_of, *tok_buf;
    float *a_w, *w_buf;
    unsigned* selmask;
    float *hid_k, *hid_v, *kc, *vc, *memn, *xkv, *hbuf, *xn, *o_cmp, *o_slc, *o_win, *xq, *proj, *xo;
    unsigned short *hmid, *out_a, *xg, *wt_gu, *wt_dn; unsigned char *hmid8, *wt_dn8, *wt_gu8, *xg8, *xn8;
    unsigned short *q_bf, *kcmp, *vcmp, *kslc, *vslcT, *kwin, *vwinT, *u_bf, *cb_bf; float *gates, *cosT, *sinT;
    unsigned short *xq_bf, *xk_bf, *xvT_bf, *ocmp_bf, *owin_bf, *onsa_bf;
    unsigned short *wt_c1k, *wt_c1v, *kc_bf, *vcT_bf; float *Pab_k, *Pab_v, *b1p_k, *b1p_v;
    unsigned short *xn_bf, *memn_bf, *xo_bf, *wt_mix_in, *wt_xkv, *wt_mix_out, *wt_xq, *wt_xo;
};

__global__ void __launch_bounds__(512, 2) mega_fwd(Params p) {
    extern __shared__ __attribute__((aligned(16))) char lds[];
    if (threadIdx.x < 4) ((unsigned*)lds)[threadIdx.x] = 0u;
    __syncthreads();
    XcdBarrier bar = xcd_barrier_post(p.bar, (volatile LAS unsigned*)lds);
    LAS unsigned char* glds = (LAS unsigned char*)(lds + 1024);

    {
        const int wg = blockIdx.x, nwg = gridDim.x;
        auto ident = [](int j) { return j; };
        auto mixmap = [](int j) {
            const int unit = j >> 8, blk = (j & 255) >> 6;
            if (unit < 2) return C_Q + unit * 256 + blk * 64;
            if (unit == 2) return blk < 2 ? C_KC + blk * 64 : C_VC + (blk - 2) * 64;
            if (unit == 3) return blk < 2 ? C_KS + blk * 64 : C_VS + (blk - 2) * 64;
            if (unit == 4) return blk < 2 ? C_KW + blk * 64 : C_VW + (blk - 2) * 64;
            if (unit < 9) return blk < 2 ? C_CH + (unit - 5) * 128 + blk * 64 : C_CC + (unit - 5) * 128 + (blk - 2) * 64;
            if (unit < 11) return C_CB + (unit - 9) * 256 + blk * 64;
            return blk == 0 ? C_GL : -1;
        };
        p_convT<true>(lds + 1024, p.w_mix_in, D, INC, 1, p.wt_mix_in, 3072, mixmap, wg, nwg);
        p_convT<false>(lds + 1024, p.w_xkv, D, 2048, 1, p.wt_xkv, 2048, ident, wg, nwg);
        p_convT<false>(lds + 1024, p.w_mix_out, D, D, 1, p.wt_mix_out, D, ident, wg, nwg);
        p_convT<false>(lds + 1024, p.w_xq, D, D, 1, p.wt_xq, D, ident, wg, nwg);
        p_convT<false>(lds + 1024, p.w_xo, D, D, 1, p.wt_xo, D, ident, wg, nwg);
        auto gumap = [](int j) { const int blk = j >> 8, w = j & 255; return w < 128 ? 128 * blk + w : 1024 + 128 * blk + (w - 128); };
        p_convT8(lds + 1024, p.w_gate_up, D, 2048, NE, p.wt_gu8, 2048, gumap, wg, nwg);
        p_convT8(lds + 1024, p.w_down, DFF, D, NE, p.wt_dn8, D, ident, wg, nwg);
        p_convT<false>(lds + 1024, p.cmp_w1_k, 1024, 256, 2, p.wt_c1k, 256, ident, wg, nwg);
        p_convT<false>(lds + 1024, p.cmp_w1_v, 1024, 256, 2, p.wt_c1v, 256, ident, wg, nwg);
        for (int o = wg * 8 + (threadIdx.x >> 6); o < 512; o += nwg * 8) {
            if (o < 256) posbias_wave(o, threadIdx.x & 63, p.cmp_pos_k, p.cmp_w1_k, p.cmp_b1_k, p.b1p_k); else posbias_wave(o - 256, threadIdx.x & 63, p.cmp_pos_v, p.cmp_w1_v, p.cmp_b1_v, p.b1p_v);
        }
        __syncthreads();
    }
    p_rope_table(blockIdx.x * 512 + threadIdx.x, gridDim.x * 512, p.positions, p.cosT, p.sinT);
    tl::rmsnorm_rows(p.x, p.g_mix_norm, p.xn_bf, T, (int)(blockIdx.x * 8 + (opaque_tid() >> 6)), (int)(gridDim.x * 8), opaque_tid() & 63);
    tl::rmsnorm_rows(p.mem, p.g_mem_norm, p.memn_bf, NB * NMEM, (int)(blockIdx.x * 8 + (opaque_tid() >> 6)), (int)(gridDim.x * 8), opaque_tid() & 63);
    xcd_barrier(bar);
    {
        pg::DenseOrder So; So.init(p.xn_bf, p.wt_mix_in, T, 3072, 2048u, 2048u, (int)gridDim.x, (int)blockIdx.x);
        pg::EpiMixIn E{p.q_bf, p.kcmp, p.vslcT, p.u_bf, p.cb_bf, p.gates, p.cosT, p.sinT};
        pg::gemm_phase(glds, D, 2048u, 2048u, So, E);
    }
    {
        pg::DenseOrder So; So.init(p.memn_bf, p.wt_xkv, NB * NMEM, 2048, 2048u, 2048u, (int)gridDim.x, (int)blockIdx.x);
        pg::EpiXkv E{p.xk_bf, p.xvT_bf};
        pg::gemm_phase(glds, D, 2048u, 2048u, So, E);
    }
    xcd_barrier(bar);
    {
        pg::DenseOrder So; So.init(p.kcmp, p.wt_c1k, 2048, 512, 2048u, 2048u, (int)gridDim.x, (int)blockIdx.x);
        pg::EpiF32R E{p.Pab_k, 512, nullptr, 512};
        pg::gemm_phase(glds, 1024, 2048u, 2048u, So, E);
    }
    {
        pg::DenseOrder So; So.init(p.vcmp, p.wt_c1v, 2048, 512, 2048u, 2048u, (int)gridDim.x, (int)((blockIdx.x + gridDim.x - 16) % gridDim.x));
        pg::EpiF32R E{p.Pab_v, 512, nullptr, 512};
        pg::gemm_phase(glds, 1024, 2048u, 2048u, So, E);
    }
    at::p_attn64<1>(lds + 1024, p.q_bf, p.kwin, p.vwinT, p.selmask, p.owin_bf, nullptr, nullptr, nullptr, blockIdx.x, gridDim.x);
    xcd_barrier(bar);
    p_cmp_finalize(lds + 1024, p.Pab_k, p.Pab_v, p.b1p_k, p.b1p_v, p.cmp_w2_k, p.cmp_w2_v, p.kc_bf, p.vcT_bf, blockIdx.x, gridDim.x);
    xcd_barrier(bar);
    at::p_cmp_attn_fast(lds + 1024, p.q_bf, p.kc_bf, p.vcT_bf, p.ocmp_bf, p.selmask, blockIdx.x, gridDim.x);
    xcd_barrier(bar);
    at::p_attn64<0>(lds + 1024, p.q_bf, p.kslc, p.vslcT, p.selmask, p.onsa_bf, p.ocmp_bf, p.owin_bf, p.gates, blockIdx.x, gridDim.x);
    xcd_barrier(bar);
    tl::mix_post(p.onsa_bf, p.u_bf, p.cb_bf, p.conv_w, p.g_nsa_out, p.g_conv_out, p.xn_bf  , (int)(blockIdx.x * 8 + (opaque_tid() >> 6)), (int)(gridDim.x * 8), opaque_tid() & 63);
    xcd_barrier(bar);
    {
        pg::DenseOrder So; So.init(p.xn_bf, p.wt_mix_out, T, D, 2048u, 2048u, (int)gridDim.x, (int)blockIdx.x);
        pg::EpiF32R E{p.hbuf, D, p.x, D};
        pg::gemm_phase(glds, D, 2048u, 2048u, So, E);
    }
    xcd_barrier(bar);
    tl::rmsnorm_rows(p.hbuf, p.g_xattn_norm, p.xn_bf, T, (int)(blockIdx.x * 8 + (opaque_tid() >> 6)), (int)(gridDim.x * 8), opaque_tid() & 63);
    xcd_barrier(bar);
    {
        pg::DenseOrder So; So.init(p.xn_bf, p.wt_xq, T, D, 2048u, 2048u, (int)gridDim.x, (int)blockIdx.x);
        pg::EpiBf16S E{p.xq_bf, D, 0.0625f * 1.4426950408889634f};
        pg::gemm_phase(glds, D, 2048u, 2048u, So, E);
    }
    xcd_barrier(bar);
    at::p_xattn_fast(lds + 1024, p.xq_bf, p.xk_bf, p.xvT_bf, p.xo_bf, blockIdx.x, gridDim.x);
    xcd_barrier(bar);
    {
        pg::DenseOrder So; So.init(p.xo_bf, p.wt_xo, T, D, 2048u, 2048u, (int)gridDim.x, (int)blockIdx.x);
        pg::EpiF32R E{p.hbuf, D, p.hbuf, D};
        pg::gemm_phase(glds, D, 2048u, 2048u, So, E);
    }
    xcd_barrier(bar);
    tl::norm_router(lds + 1024, p.hbuf, p.g_moe_norm, p.w_router, p.b_router, p.xn8, p.a_e, p.a_w, p.a_slot, p.wgcnt, (int)(blockIdx.x * 8 + (opaque_tid() >> 6)), (int)(gridDim.x * 8), opaque_tid() & 63);
    xcd_barrier(bar);
    tl::moe_scatter(lds + 1024, p.wgcnt, p.pstart, p.tile_e, p.a_e, p.a_w, p.a_slot, p.xn8, p.xg8, p.w_buf, p.dest_of, blockIdx.x, (int)(blockIdx.x * 8 + (opaque_tid() >> 6)), (int)(gridDim.x * 8), opaque_tid() & 63);
    xcd_barrier(bar);
    {
        pg::MoeOrderB<8> So; So.init(p.xg8, p.wt_gu8, p.tile_e, p.pstart[NE], (size_t)2048 * 1024, 1024u, (int)gridDim.x, (int)blockIdx.x);
        pg::EpiSwigluF8 E{p.hmid8, p.b_gate_up};
        pg::gemm_phase_f8(glds, D, 1024u, 1024u, So, E);
    }
    xcd_barrier(bar);
    {
        pg::MoeOrderB<4> So; So.init(p.hmid8, p.wt_dn8, p.tile_e, p.pstart[NE], (size_t)1024 * 1024, 1024u, (int)gridDim.x, (int)blockIdx.x);
        pg::EpiDownScaleF8 E{p.out_a, p.b_down, p.w_buf};
        pg::gemm_phase_f8(glds, DFF, 1024u, 1024u, So, E);
    }
    xcd_barrier(bar);
    tl::final_rows(p.hbuf, p.out_a, p.dest_of, p.g_final, p.out, (int)(blockIdx.x * 8 + (opaque_tid() >> 6)), (int)(gridDim.x * 8), opaque_tid() & 63);
}
__global__ void k_fail(float* out, int n) { const int i = blockIdx.x * 256 + threadIdx.x; if (i < n) out[i] = __builtin_nanf(""); }
}

extern "C" void kernel_launch(void* const* d_in, const int* in_sizes, int n_in, void* d_out, int out_size, void* d_ws, size_t ws_size, hipStream_t stream) {
    Params p{};
    p.x = (const float*)d_in[0]; p.mem = (const float*)d_in[1]; p.positions = (const int*)d_in[2];
    const float** fp = &p.g_mix_norm;
    for (int i = 0; i < 27; ++i) fp[i] = (const float*)d_in[3 + i];
    p.out = (float*)d_out;

    char* ws = (char*)d_ws;
    size_t off = 0;
    auto take = [&](size_t bytes) { char* q = ws + off; off += (bytes + 255) & ~(size_t)255; return q; };
    p.bar = (unsigned*)take(XCD_BAR_WORDS * 4);
    p.counts = (int*)take(NE * 4);
    const size_t zero_bytes = off;
    p.pstart = (int*)take((NE + 1) * 4);
    p.wgcnt = (int*)take(1024 * NE * 4);
    p.tile_e = (int*)take(NTILE * 4);
    p.a_e = (int*)take(NA * 4);
    p.a_w = (float*)take(NA * 4);
    p.a_slot = (int*)take(NA * 4);
    p.dest_of = (int*)take(NA * 4);
    p.w_buf = (float*)take(PMAX * 4);
    p.selmask = (unsigned*)take((size_t)NB * 2 * S * 4);
    p.hbuf = (float*)take((size_t)T * D * 4);
    p.out_a = (unsigned short*)take((size_t)PMAX * D * 2);
    p.xg8 = (unsigned char*)take((size_t)PMAX * D);
    p.xn8 = (unsigned char*)take((size_t)T * D);
    p.hmid8 = (unsigned char*)take((size_t)PMAX * DFF);
    p.wt_gu8 = (unsigned char*)take((size_t)NE * 2048 * D);
    p.wt_dn8 = (unsigned char*)take((size_t)NE * D * DFF);
    p.q_bf = (unsigned short*)take((size_t)T * 512 * 2);
    p.kcmp = (unsigned short*)take((size_t)T * 128 * 2 * 4); p.vcmp = p.kcmp + (size_t)T * 128; p.kslc = p.vcmp + (size_t)T * 128; p.kwin = p.kslc + (size_t)T * 128;
    p.vslcT = (unsigned short*)take((size_t)T * 128 * 2 * 2); p.vwinT = p.vslcT + (size_t)T * 128;
    p.u_bf = (unsigned short*)take((size_t)T * 512 * 2); p.cb_bf = (unsigned short*)take((size_t)T * 512 * 2);
    p.gates = (float*)take((size_t)T * 24 * 4); p.cosT = (float*)take((size_t)T * 32 * 4); p.sinT = (float*)take((size_t)T * 32 * 4);
    p.wt_c1k = (unsigned short*)take((size_t)512 * 1024 * 2); p.wt_c1v = (unsigned short*)take((size_t)512 * 1024 * 2);
    p.kc_bf = (unsigned short*)take((size_t)16 * 128 * 64 * 2); p.vcT_bf = (unsigned short*)take((size_t)16 * 64 * 128 * 2);
    p.Pab_k = (float*)take((size_t)(2048 + 1) * 512 * 4); p.Pab_v = (float*)take((size_t)(2048 + 1) * 512 * 4);
    p.b1p_k = (float*)take(256 * 4); p.b1p_v = (float*)take(256 * 4);
    p.ocmp_bf = (unsigned short*)take((size_t)T * 512 * 2); p.owin_bf = (unsigned short*)take((size_t)T * 512 * 2); p.onsa_bf = (unsigned short*)take((size_t)T * 512 * 2);
    p.xq_bf = (unsigned short*)take((size_t)T * D * 2); p.xk_bf = (unsigned short*)take((size_t)NB * NMEM * D * 2); p.xvT_bf = (unsigned short*)take((size_t)NB * NMEM * D * 2);
    p.xn_bf = (unsigned short*)take((size_t)T * D * 2);
    p.memn_bf = (unsigned short*)take((size_t)NB * NMEM * D * 2);
    p.xo_bf = (unsigned short*)take((size_t)T * D * 2);
    p.wt_mix_in = (unsigned short*)take((size_t)3072 * D * 2);
    p.wt_xkv = (unsigned short*)take((size_t)2048 * D * 2);
    p.wt_mix_out = (unsigned short*)take((size_t)D * D * 2);
    p.wt_xq = (unsigned short*)take((size_t)D * D * 2);
    p.wt_xo = (unsigned short*)take((size_t)D * D * 2);

    static int grid = 0;
    if (grid == 0) {
        int dev = 0, cus = 0;
        if (hipGetDevice(&dev) != hipSuccess || hipDeviceGetAttribute(&cus, hipDeviceAttributeMultiprocessorCount, dev) != hipSuccess) cus = -1;
        if (hipFuncSetAttribute((const void*)mega_fwd, hipFuncAttributeMaxDynamicSharedMemorySize, LDS_BYTES) != hipSuccess) cus = -1;
        int per_cu = 0;
        if (cus > 0 && (hipOccupancyMaxActiveBlocksPerMultiprocessor(&per_cu, (const void*)mega_fwd, 512, LDS_BYTES) != hipSuccess || per_cu < 1)) cus = -1;
        (void)hipGetLastError();
        grid = cus > 0 ? cus : -1;
    }
    if (grid < 0 || off > ws_size) { k_fail<<<(out_size + 255) / 256, 256, 0, stream>>>((float*)d_out, out_size); return; }
    (void)hipMemsetAsync(d_ws, 0, zero_bytes, stream);
    hipLaunchKernelGGL(mega_fwd, dim3(grid), dim3(512), LDS_BYTES, stream, p);
}
```

```cpp
#include <hip/hip_runtime.h>
#include <hip/hip_bf16.h>
#include <stdint.h>
#include <cstdio>

#define XB_TMO      128
#define XB_XCNT(j)  (256  + 64 * (j))
#define XB_XSUB(j)  (1280 + 64 * (j))
#define XB_XGEN(j)  (2304 + 64 * (j))
#define XB_TOP      3328
#define XB_TOPGEN   3392
#define XCD_BAR_WORDS 3456
#define XB_SPIN_CAP (1u << 18)
#define LAS __attribute__((address_space(3)))

__device__ __forceinline__ unsigned xb_ld(unsigned* p)              { return __hip_atomic_load(p, __ATOMIC_RELAXED, __HIP_MEMORY_SCOPE_AGENT); }
__device__ __forceinline__ unsigned xb_add(unsigned* p, unsigned v) { return __hip_atomic_fetch_add(p, v, __ATOMIC_RELAXED, __HIP_MEMORY_SCOPE_AGENT); }
__device__ __forceinline__ unsigned xb_xcc_id() { return (unsigned)__builtin_amdgcn_s_getreg((3 << 11) | 20) & 0xFu; }
#define XB_SPIN(cond, bar) do { unsigned _sp = 0; while (cond) { __builtin_amdgcn_s_sleep(1); \
    if ((++_sp & 255u) == 0u) { if (xb_ld(&(bar)[XB_TMO])) break; if (_sp > XB_SPIN_CAP) { atomicAdd(&(bar)[XB_TMO], 1u); break; } } } } while (0)

struct XcdBarrier {
    unsigned* bar; unsigned x;
    volatile LAS unsigned* st;
};

__device__ __forceinline__ XcdBarrier xcd_barrier_post(unsigned* bar, volatile LAS unsigned* st) {
    XcdBarrier b; b.bar = bar; b.x = xb_xcc_id(); b.st = st;
    if (threadIdx.x == 0) (void)xb_add(&bar[XB_XCNT(b.x)], 1u);
    return b;
}
__device__ __forceinline__ void xcd_barrier_complete(unsigned* bar, unsigned x, unsigned& nloc, unsigned& nx) {
    const unsigned G = gridDim.x * gridDim.y * gridDim.z;
    unsigned sum, cnt, mine, sp = 0u;
    for (;;) {
        sum = 0u; cnt = 0u; mine = 0u;
#pragma unroll
        for (unsigned j = 0; j < 16; ++j) { const unsigned c = xb_ld(&bar[XB_XCNT(j)]); sum += c; cnt += (c > 0u) ? 1u : 0u; mine = (j == x) ? c : mine; }
        if (sum == G) break;
        __builtin_amdgcn_s_sleep(1);
        if ((++sp & 255u) == 0u) { if (xb_ld(&bar[XB_TMO])) break; if (sp > XB_SPIN_CAP) { atomicAdd(&bar[XB_TMO], 1u); break; } }
    }
    nloc = mine > 0u ? mine : 1u; nx = cnt > 0u ? cnt : 1u;
}

__device__ __forceinline__ void xcd_barrier(const XcdBarrier& b) {
    asm volatile("s_waitcnt vmcnt(0)" ::: "memory");
    __syncthreads();
    if (threadIdx.x == 0) {
        unsigned* bar = b.bar;
        __builtin_amdgcn_s_waitcnt(0);
        unsigned nloc = b.st[0], nx = b.st[1];
        if (nloc == 0u) { xcd_barrier_complete(bar, b.x, nloc, nx); b.st[0] = nloc; b.st[1] = nx; }
        const unsigned old = xb_add(&bar[XB_XSUB(b.x)], 1u);
        const unsigned gen = old / nloc;
        if (old + 1u == (gen + 1u) * nloc) {
            __builtin_amdgcn_fence(__ATOMIC_RELEASE, "agent");
            asm volatile("s_waitcnt vmcnt(0)" ::: "memory");
            const unsigned og = xb_add(&bar[XB_TOP], 1u);
            const unsigned tg = og / nx;
            if (og + 1u == (tg + 1u) * nx) xb_add(&bar[XB_TOPGEN], 1u);
            else XB_SPIN(xb_ld(&bar[XB_TOPGEN]) == tg, bar);
            __builtin_amdgcn_fence(__ATOMIC_ACQUIRE, "agent");
            xb_add(&bar[XB_XGEN(b.x)], 1u);
            asm volatile("s_waitcnt vmcnt(0)" ::: "memory");
        } else {
            XB_SPIN(xb_ld(&bar[XB_XGEN(b.x)]) == gen, bar);
            __builtin_amdgcn_fence(__ATOMIC_ACQUIRE, "agent");
            asm volatile("s_waitcnt vmcnt(0)" ::: "memory");
        }
    }
    __syncthreads();
}


namespace {
constexpr int D = 1024, NB = 8, S = 2048, T = NB * S, NMEM = 256;
constexpr int INC = 2840;
constexpr int C_Q = 0, C_KC = 512, C_VC = 640, C_KS = 768, C_VS = 896, C_KW = 1024, C_VW = 1152, C_GL = 1280, C_CH = 1304, C_CB = 1816, C_CC = 2328;
constexpr int NC = 127, NCR = NB * NC * 2;
constexpr int NE = 32, TOPK = 4, DFF = 1024, NA = T * TOPK;
constexpr int MT = 256;
constexpr int PMAX = NA + NE * MT, NTILE = PMAX / MT;
constexpr int LDS_BYTES = 144 * 1024, VB_LDS = 40960;
constexpr float QS = 0.125f * 1.4426950408889634f;

__device__ __forceinline__ int opaque_tid() { int t = threadIdx.x; asm volatile("" : "+v"(t)); return t; }
__device__ __forceinline__ float dpp_xor8(float v) { return __uint_as_float(__builtin_amdgcn_update_dpp(0u, __float_as_uint(v), 0x128, 0xf, 0xf, true)); }
__device__ __forceinline__ float dpp_xor4(float v) { unsigned r = __builtin_amdgcn_update_dpp(__float_as_uint(v), __float_as_uint(v), 0x104, 0xf, 0x5, false); r = __builtin_amdgcn_update_dpp(r, __float_as_uint(v), 0x114, 0xf, 0xa, false); return __uint_as_float(r); }
__device__ __forceinline__ float dpp_xor2(float v) { return __uint_as_float(__builtin_amdgcn_update_dpp(0u, __float_as_uint(v), 0x4e, 0xf, 0xf, true)); }
__device__ __forceinline__ float dpp_xor1(float v) { return __uint_as_float(__builtin_amdgcn_update_dpp(0u, __float_as_uint(v), 0xb1, 0xf, 0xf, true)); }

__device__ __forceinline__ float lane_xor32(float v) { const auto r = __builtin_amdgcn_permlane32_swap(__float_as_uint(v), __float_as_uint(v), false, false); return __uint_as_float((threadIdx.x & 32) ? r[0] : r[1]); }
__device__ __forceinline__ float lane_xor16(float v) { const auto r = __builtin_amdgcn_permlane16_swap(__float_as_uint(v), __float_as_uint(v), false, false); return __uint_as_float((threadIdx.x & 16) ? r[0] : r[1]); }
__device__ __forceinline__ float wave_sum(float v) {
    { const auto r = __builtin_amdgcn_permlane32_swap(__float_as_uint(v), __float_as_uint(v), false, false); v = __uint_as_float(r[0]) + __uint_as_float(r[1]); }
    { const auto r = __builtin_amdgcn_permlane16_swap(__float_as_uint(v), __float_as_uint(v), false, false); v = __uint_as_float(r[0]) + __uint_as_float(r[1]); }
    v += dpp_xor8(v); v += dpp_xor4(v); v += dpp_xor2(v); v += dpp_xor1(v); return v;
}
__device__ __forceinline__ float wave_max(float v) {
    { const auto r = __builtin_amdgcn_permlane32_swap(__float_as_uint(v), __float_as_uint(v), false, false); v = fmaxf(__uint_as_float(r[0]), __uint_as_float(r[1])); }
    { const auto r = __builtin_amdgcn_permlane16_swap(__float_as_uint(v), __float_as_uint(v), false, false); v = fmaxf(__uint_as_float(r[0]), __uint_as_float(r[1])); }
    v = fmaxf(v, dpp_xor8(v)); v = fmaxf(v, dpp_xor4(v)); v = fmaxf(v, dpp_xor2(v)); v = fmaxf(v, dpp_xor1(v)); return v;
}

namespace pg { __device__ __forceinline__ unsigned cvt_pk_bf16(float lo, float hi); __device__ __forceinline__ unsigned cvt_pk_bf16_acc(float lo, float hi); }
struct VB { int vb, nvb, tid; char* lds; };
#define VB_ITEMS(n) for (int _it = 0, item = v.vb; _it < ((n) + v.nvb - 1) / v.nvb; ++_it, item += v.nvb)

__device__ __forceinline__ void p_rmsnorm(const VB& v, int rows, const float* __restrict__ in, int ldi, const float* __restrict__ g, float* __restrict__ out, int ldo, int W) {
    float* red = (float*)v.lds;
    VB_ITEMS(rows) {
        const bool act = item < rows;
        const float* r = in + (size_t)(act ? item : 0) * ldi;
        float ss = 0.f;
        for (int i = v.tid; i < W; i += 256) { float x = r[i]; ss += x * x; }
        ss = wave_sum(ss);
        __syncthreads();
        if ((v.tid & 63) == 0) red[v.tid >> 6] = ss;
        __syncthreads();
        ss = red[0] + red[1] + red[2] + red[3];
        const float rs = rsqrtf(ss / (float)W + 1e-5f);
        if (act) { float* o = out + (size_t)item * ldo; for (int i = v.tid; i < W; i += 256) o[i] = r[i] * rs * g[i]; }
    }
}

__device__ __forceinline__ unsigned short f2bf_rne(float f) { unsigned u = __float_as_uint(f); u += 0x7FFFu + ((u >> 16) & 1u); return (unsigned short)(u >> 16); }
__device__ __forceinline__ void p_rmsnorm_bf(const VB& v, int rows, const float* __restrict__ in, int ldi, const float* __restrict__ g, unsigned short* __restrict__ out, int ldo, int W) {
    float* red = (float*)v.lds;
    VB_ITEMS(rows) {
        const bool act = item < rows;
        const float* r = in + (size_t)(act ? item : 0) * ldi;
        float ss = 0.f;
        for (int i = v.tid; i < W; i += 256) { float x = r[i]; ss += x * x; }
        ss = wave_sum(ss);
        __syncthreads();
        if ((v.tid & 63) == 0) red[v.tid >> 6] = ss;
        __syncthreads();
        ss = red[0] + red[1] + red[2] + red[3];
        const float rs = rsqrtf(ss / (float)W + 1e-5f);
        if (act) { unsigned short* o = out + (size_t)item * ldo; for (int i = v.tid; i < W; i += 256) o[i] = f2bf_rne(r[i] * rs * g[i]); }
    }
}

template <int NACC, class AL, class BL>
__device__ __forceinline__ void gemm_tile_f32(int tid, float (&acc)[NACC][4][4], int K, AL al, BL bl, float (*As)[68], float (*Bs)[NACC * 64 + 4]) {
    const int tx = tid & 15, ty = tid >> 4;
    const int ar = tid >> 2, ak = (tid & 3) * 4;
    const int bk = tid >> 4, bc = (tid & 15) * 4;
#pragma unroll
    for (int w = 0; w < NACC; ++w)
#pragma unroll
        for (int i = 0; i < 4; ++i)
#pragma unroll
            for (int j = 0; j < 4; ++j) acc[w][i][j] = 0.f;
    for (int k0 = 0; k0 < K; k0 += 16) {
        const float4 a = al(ar, k0 + ak);
        float4 b[NACC];
#pragma unroll
        for (int w = 0; w < NACC; ++w) b[w] = bl(w, k0 + bk, bc);
        __syncthreads();
        As[ak + 0][ar] = a.x; As[ak + 1][ar] = a.y; As[ak + 2][ar] = a.z; As[ak + 3][ar] = a.w;
#pragma unroll
        for (int w = 0; w < NACC; ++w) *(float4*)&Bs[bk][w * 64 + bc] = b[w];
        __syncthreads();
#pragma unroll
        for (int kk = 0; kk < 16; ++kk) {
            const float4 av = *(const float4*)&As[kk][ty * 4];
            const float aa[4] = {av.x, av.y, av.z, av.w};
#pragma unroll
            for (int w = 0; w < NACC; ++w) {
                const float4 bv = *(const float4*)&Bs[kk][w * 64 + tx * 4];
                const float bb[4] = {bv.x, bv.y, bv.z, bv.w};
#pragma unroll
                for (int i = 0; i < 4; ++i)
#pragma unroll
                    for (int j = 0; j < 4; ++j) acc[w][i][j] += aa[i] * bb[j];
            }
        }
    }
}

__device__ __forceinline__ void p_gemm(const VB& v, const float* __restrict__ A, int lda, const float* __restrict__ Bm, int ldb, float* C, int ldc, const float* res, int M, int N, int K) {
    float (*As)[68] = (float (*)[68])v.lds;
    float (*Bs)[68] = (float (*)[68])(v.lds + 16 * 68 * 4);
    const int nx = (N + 63) / 64, ny = (M + 63) / 64, nt = nx * ny;
    VB_ITEMS(nt) {
        const bool act = item < nt;
        const int row0 = act ? (item / nx) * 64 : M, col0 = act ? (item % nx) * 64 : N;
        float acc[1][4][4];
        auto al = [&](int r, int k) -> float4 { const int row = row0 + r; return row < M ? *(const float4*)(A + (size_t)row * lda + k) : make_float4(0.f, 0.f, 0.f, 0.f); };
        auto bl = [&](int, int k, int c) -> float4 { const int col = col0 + c; return col < N ? *(const float4*)(Bm + (size_t)k * ldb + col) : make_float4(0.f, 0.f, 0.f, 0.f); };
        gemm_tile_f32<1>(v.tid, acc, K, al, bl, As, Bs);
        const int tx = v.tid & 15, ty = v.tid >> 4;
#pragma unroll
        for (int i = 0; i < 4; ++i) {
            const int row = row0 + ty * 4 + i;
            if (row >= M) continue;
#pragma unroll
            for (int j = 0; j < 4; ++j) {
                const int col = col0 + tx * 4 + j;
                if (col >= N) continue;
                float x = acc[0][i][j];
                if (res) x += res[(size_t)row * ldc + col];
                C[(size_t)row * ldc + col] = x;
            }
        }
    }
}

__device__ __forceinline__ void p_rope(const VB& v, float* __restrict__ proj, const int* __restrict__ pos) {
    VB_ITEMS(T) {
        if (item >= T) continue;
        const int t = item;
        const float p = (float)pos[t];
        float* r = proj + (size_t)t * INC;
        for (int i = v.tid; i < 448; i += 256) {
            const int hd = i >> 5, f = i & 31;
            int col;
            if (hd < 8) col = C_Q + hd * 64; else if (hd < 10) col = C_KC + (hd - 8) * 64; else if (hd < 12) col = C_KS + (hd - 10) * 64; else col = C_KW + (hd - 12) * 64;
            const float inv = powf(10000.f, -(float)f / 32.f);
            const float ang = p * inv;
            const float c = cosf(ang), s = sinf(ang);
            const float t1 = r[col + f], t2 = r[col + 32 + f];
            r[col + f] = t1 * c - t2 * s;
            r[col + 32 + f] = t2 * c + t1 * s;
        }
    }
}

__device__ __forceinline__ float gelu_tanh(float x) { const float u = 0.7978845608028654f * (x + 0.044715f * x * x * x); return 0.5f * x * (1.f + tanhf(u)); }
__device__ __forceinline__ void p_cmp1(const VB& v, const float* __restrict__ proj, int colbase, const float* __restrict__ pos, const float* __restrict__ w1, const float* __restrict__ b1, float* __restrict__ hid) {
    float (*As)[68] = (float (*)[68])v.lds;
    float (*Bs)[68] = (float (*)[68])(v.lds + 16 * 68 * 4);
    const int nx = 4, ny = (NCR + 63) / 64, nt = nx * ny;
    VB_ITEMS(nt) {
        const bool act = item < nt;
        const int row0 = act ? (item / nx) * 64 : NCR, col0 = act ? (item % nx) * 64 : 0;
        float acc[1][4][4];
        auto al = [&](int r, int k) -> float4 {
            const int row = row0 + r; if (row >= NCR) return make_float4(0.f, 0.f, 0.f, 0.f);
            const int g = row & 1, bc = row >> 1, c = bc % NC, b = bc / NC, l = k >> 6, d = k & 63;
            const float4 x = *(const float4*)(proj + (size_t)(b * S + 16 * c + l) * INC + colbase + g * 64 + d);
            const float4 pe = *(const float4*)(pos + k);
            return make_float4(x.x + pe.x, x.y + pe.y, x.z + pe.z, x.w + pe.w);
        };
        auto bl = [&](int, int k, int c) -> float4 { return *(const float4*)(w1 + (size_t)k * 256 + col0 + c); };
        gemm_tile_f32<1>(v.tid, acc, 2048, al, bl, As, Bs);
        const int tx = v.tid & 15, ty = v.tid >> 4;
#pragma unroll
        for (int i = 0; i < 4; ++i) {
            const int row = row0 + ty * 4 + i;
            if (row >= NCR) continue;
#pragma unroll
            for (int j = 0; j < 4; ++j) { const int col = col0 + tx * 4 + j; hid[(size_t)row * 256 + col] = gelu_tanh(acc[0][i][j] + b1[col]); }
        }
    }
}

__device__ __forceinline__ void st_out(float* p, float x) { *p = x; }
__device__ __forceinline__ void st_out(unsigned short* p, float x) { *p = f2bf_rne(x); }
template <int DH, class KeyF, class OutT>
__device__ __forceinline__ void wave_attend(const float* q, int ncand, KeyF keyf, float* sc, OutT* out, int lane) {
    float m = -3.0e38f;
    for (int idx = lane; idx < ncand; idx += 64) {
        const float *kp, *vp;
        float s = -3.0e38f;
        if (keyf(idx, kp, vp)) {
            s = 0.f;
#pragma unroll 4
            for (int d = 0; d < DH; d += 4) { const float4 kv = *(const float4*)(kp + d); s += q[d] * kv.x + q[d + 1] * kv.y + q[d + 2] * kv.z + q[d + 3] * kv.w; }
        }
        sc[idx] = s;
        m = fmaxf(m, s);
    }
    m = wave_max(m);
    float sum = 0.f;
    for (int idx = lane; idx < ncand; idx += 64) { const float s = sc[idx]; const float p = (s > -1.0e38f) ? __expf(s - m) : 0.f; sc[idx] = p; sum += p; }
    sum = wave_sum(sum);
    const float inv = (m > -1.0e38f) ? 1.f / sum : 0.f;
    for (int idx = lane; idx < ncand; idx += 64) sc[idx] *= inv;
    __builtin_amdgcn_s_waitcnt(0);
    float o[DH / 64];
#pragma unroll
    for (int i = 0; i < DH / 64; ++i) o[i] = 0.f;
    for (int idx = 0; idx < ncand; ++idx) {
        const float p = sc[idx];
        if (p == 0.f) continue;
        const float *kp, *vp;
        keyf(idx, kp, vp);
#pragma unroll
        for (int i = 0; i < DH / 64; ++i) o[i] += p * vp[lane + 64 * i];
    }
#pragma unroll
    for (int i = 0; i < DH / 64; ++i) st_out(out + lane + 64 * i, o[i]);
}

__device__ __forceinline__ void p_cmp_attn(const VB& v, const float* __restrict__ proj, const float* __restrict__ kc, const float* __restrict__ vc,
                                           float* __restrict__ o_cmp, unsigned* __restrict__ selmask) {
    float (*qs)[64] = (float (*)[64])v.lds;
    float (*ps)[128] = (float (*)[128])(v.lds + 1024);
    float* imps = (float*)(v.lds + 1024 + 2048);
    VB_ITEMS(T * 2) {
        const int g = item & 1, t = item >> 1, b = t / S, s = t % S;
        const int w = v.tid >> 6, lane = v.tid & 63, h = g * 4 + w;
        __syncthreads();
        qs[w][lane] = proj[(size_t)t * INC + C_Q + h * 64 + lane] * 0.125f;
        ps[w][lane] = 0.f; ps[w][lane + 64] = 0.f;
        __syncthreads();
        auto keyf = [&](int c, const float*& kp, const float*& vp) -> bool {
            kp = kc + (size_t)((b * NC + c) * 2 + g) * 64; vp = vc + (size_t)((b * NC + c) * 2 + g) * 64;
            return 16 * c + 31 <= s;
        };
        wave_attend<64>(qs[w], NC, keyf, ps[w], o_cmp + (size_t)t * 512 + h * 64, lane);
        __syncthreads();
        if (v.tid < 32) {
            const int j = v.tid;
            float imp = 0.f;
            for (int hh = 0; hh < 4; ++hh)
                for (int c = 4 * j - 1; c <= 4 * j + 3; ++c) {
                    if (c < 0 || c >= NC) continue;
                    const float ov = (c == 4 * j - 1 || c == 4 * j + 3) ? 0.5f : 1.0f;
                    imp += ps[hh][c] * ov;
                }
            const int cur = s >> 6;
            if (j == 0 || j == cur || j == cur - 1) imp = 1e30f; else if (j > cur) imp = -1e30f;
            imps[j] = imp;
        }
        __syncthreads();
        if (v.tid < 64) {
            const int j = v.tid & 31;
            const float mine = imps[j];
            int rank = 0;
            for (int i = 0; i < 32; ++i) { const float x = imps[i]; rank += (x > mine || (x == mine && i < j)) ? 1 : 0; }
            const unsigned long long bal = __ballot(rank < 16 && v.tid < 32);
            if (v.tid == 0) selmask[(size_t)(b * 2 + g) * S + s] = (unsigned)(bal & 0xffffffffull);
        }
    }
}

template <int MODE>
__device__ __forceinline__ void p_nsa_attn(const VB& v, const float* __restrict__ proj, const unsigned* __restrict__ selmask, float* __restrict__ outp) {
    float (*qs)[64] = (float (*)[64])v.lds;
    float (*scs)[2048] = (float (*)[2048])(v.lds + 1024);
    VB_ITEMS(T * 2) {
        const int g = item & 1, t = item >> 1, b = t / S, s = t % S;
        const int w = v.tid >> 6, lane = v.tid & 63, h = g * 4 + w;
        qs[w][lane] = proj[(size_t)t * INC + C_Q + h * 64 + lane] * 0.125f;
        __builtin_amdgcn_s_waitcnt(0);
        if (MODE == 0) {
            const unsigned mask = selmask[(size_t)(b * 2 + g) * S + s];
            const int ncand = ((s >> 6) + 1) * 64;
            auto keyf = [&](int idx, const float*& kp, const float*& vp) -> bool {
                const float* r = proj + (size_t)(b * S + idx) * INC + g * 64;
                kp = r + C_KS; vp = r + C_VS;
                return idx <= s && ((mask >> (idx >> 6)) & 1u);
            };
            wave_attend<64>(qs[w], ncand, keyf, scs[w], outp + (size_t)t * 512 + h * 64, lane);
        } else {
            const int lo = s - 511 > 0 ? s - 511 : 0;
            const int ncand = s - lo + 1;
            auto keyf = [&](int idx, const float*& kp, const float*& vp) -> bool {
                const float* r = proj + (size_t)(b * S + lo + idx) * INC + g * 64;
                kp = r + C_KW; vp = r + C_VW;
                return true;
            };
            wave_attend<64>(qs[w], ncand, keyf, scs[w], outp + (size_t)t * 512 + h * 64, lane);
        }
    }
}

__device__ __forceinline__ void p_xattn(const VB& v, const float* __restrict__ xq, const float* __restrict__ xkv, unsigned short* __restrict__ xo) {
    float (*qs)[256] = (float (*)[256])v.lds;
    float (*scs)[256] = (float (*)[256])(v.lds + 4096);
    VB_ITEMS(T) {
        const int t = item, b = t / S, w = v.tid >> 6, lane = v.tid & 63;
        for (int i = lane; i < 256; i += 64) qs[w][i] = xq[(size_t)t * D + w * 256 + i] * 0.0625f;
        __builtin_amdgcn_s_waitcnt(0);
        auto keyf = [&](int m, const float*& kp, const float*& vp) -> bool {
            const float* r = xkv + (size_t)(b * NMEM + m) * 2048 + w * 256;
            kp = r; vp = r + 1024;
            return true;
        };
        wave_attend<256>(qs[w], NMEM, keyf, scs[w], xo + (size_t)t * D + w * 256, lane);
    }
}

__device__ __forceinline__ void p_mix_post(const VB& v, const float* __restrict__ proj, const float* __restrict__ o_cmp, const float* __restrict__ o_slc, const float* __restrict__ o_win,
                                           const float* __restrict__ conv_w, const float* __restrict__ g_nsa, const float* __restrict__ g_conv, unsigned short* __restrict__ omix) {
    float (*red)[4] = (float (*)[4])v.lds;
    VB_ITEMS(T) {
        const int t = item, s = t % S, tid = v.tid;
        const float* r = proj + (size_t)t * INC;
        float on[2], oc[2], ssn = 0.f, ssc = 0.f;
#pragma unroll
        for (int e = 0; e < 2; ++e) {
            const int c = tid + 256 * e, h = c >> 6;
            const float g0 = 1.f / (1.f + __expf(-r[C_GL + h * 3 + 0])), g1 = 1.f / (1.f + __expf(-r[C_GL + h * 3 + 1])), g2 = 1.f / (1.f + __expf(-r[C_GL + h * 3 + 2]));
            on[e] = g0 * o_cmp[(size_t)t * 512 + c] + g1 * o_slc[(size_t)t * 512 + c] + g2 * o_win[(size_t)t * 512 + c];
            ssn += on[e] * on[e];
            float y = 0.f;
#pragma unroll
            for (int k = 0; k < 3; ++k) {
                const int sp = s - 2 + k;
                if (sp < 0) continue;
                const float* rp = proj + (size_t)(t - 2 + k) * INC;
                y += conv_w[k * 512 + c] * (rp[C_CC + c] * rp[C_CH + c]);
            }
            oc[e] = r[C_CB + c] * y;
            ssc += oc[e] * oc[e];
        }
        ssn = wave_sum(ssn); ssc = wave_sum(ssc);
        __syncthreads();
        if ((tid & 63) == 0) { red[0][tid >> 6] = ssn; red[1][tid >> 6] = ssc; }
        __syncthreads();
        ssn = red[0][0] + red[0][1] + red[0][2] + red[0][3];
        ssc = red[1][0] + red[1][1] + red[1][2] + red[1][3];
        const float rn = rsqrtf(ssn / 512.f + 1e-5f), rc = rsqrtf(ssc / 512.f + 1e-5f);
#pragma unroll
        for (int e = 0; e < 2; ++e) {
            const int c = tid + 256 * e;
            omix[(size_t)t * D + c] = f2bf_rne(on[e] * rn * g_nsa[c]);
            omix[(size_t)t * D + 512 + c] = f2bf_rne(oc[e] * rc * g_conv[c]);
        }
    }
}


__device__ __forceinline__ float bfu(unsigned short b) { return __uint_as_float(((unsigned)b) << 16); }
__device__ __forceinline__ void p_rope_table(int gtid, int gn, const int* __restrict__ pos, float* __restrict__ cosT, float* __restrict__ sinT) {
    for (int i = gtid; i < T * 32; i += gn) {
        const int t = i >> 5, f = i & 31;
        const float inv = powf(10000.f, -(float)f / 32.f);
        const float ang = (float)pos[t] * inv;
        cosT[i] = cosf(ang); sinT[i] = sinf(ang);
    }
}
template <int DH, class ValidF, class KRow, class VGet, class OutT>
__device__ __forceinline__ void wave_attend_bf(const float* q, int ncand, ValidF valid, KRow krow, VGet vget, float* sc, OutT* out, int lane) {
    float m = -3.0e38f;
    for (int idx = lane; idx < ncand; idx += 64) {
        float s = -3.0e38f;
        if (valid(idx)) {
            const unsigned short* kp = krow(idx);
            s = 0.f;
#pragma unroll 2
            for (int d = 0; d < DH; d += 8) {
                const uint4 kv = *(const uint4*)(kp + d);
                s += q[d] * __uint_as_float(kv.x << 16) + q[d + 1] * __uint_as_float(kv.x & 0xffff0000u) + q[d + 2] * __uint_as_float(kv.y << 16) + q[d + 3] * __uint_as_float(kv.y & 0xffff0000u)
                   + q[d + 4] * __uint_as_float(kv.z << 16) + q[d + 5] * __uint_as_float(kv.z & 0xffff0000u) + q[d + 6] * __uint_as_float(kv.w << 16) + q[d + 7] * __uint_as_float(kv.w & 0xffff0000u);
            }
        }
        sc[idx] = s;
        m = fmaxf(m, s);
    }
    m = wave_max(m);
    float sum = 0.f;
    for (int idx = lane; idx < ncand; idx += 64) { const float s = sc[idx]; const float p = (s > -1.0e38f) ? exp2f(s - m) : 0.f; sc[idx] = p; sum += p; }
    sum = wave_sum(sum);
    const float inv = (m > -1.0e38f) ? 1.f / sum : 0.f;
    for (int idx = lane; idx < ncand; idx += 64) sc[idx] *= inv;
    __builtin_amdgcn_s_waitcnt(0);
    float o[DH / 64];
#pragma unroll
    for (int i = 0; i < DH / 64; ++i) o[i] = 0.f;
    for (int idx = 0; idx < ncand; ++idx) {
        const float p = sc[idx];
        if (p == 0.f) continue;
#pragma unroll
        for (int i = 0; i < DH / 64; ++i) o[i] += p * vget(idx, lane + 64 * i);
    }
#pragma unroll
    for (int i = 0; i < DH / 64; ++i) st_out(out + lane + 64 * i, o[i]);
}

__device__ __forceinline__ void p_cmp1_bf(const VB& v, const unsigned short* __restrict__ src, const float* __restrict__ pos, const float* __restrict__ w1, const float* __restrict__ b1, float* __restrict__ hid) {
    float (*As)[68] = (float (*)[68])v.lds;
    float (*Bs)[68] = (float (*)[68])(v.lds + 16 * 68 * 4);
    const int nx = 4, ny = (NCR + 63) / 64, nt = nx * ny;
    VB_ITEMS(nt) {
        const bool act = item < nt;
        const int row0 = act ? (item / nx) * 64 : NCR, col0 = act ? (item % nx) * 64 : 0;
        float acc[1][4][4];
        auto al = [&](int r, int k) -> float4 {
            const int row = row0 + r; if (row >= NCR) return make_float4(0.f, 0.f, 0.f, 0.f);
            const int g = row & 1, bc = row >> 1, c = bc % NC, b = bc / NC, l = k >> 6, d = k & 63;
            const uint2 x = *(const uint2*)(src + ((size_t)(b * 2 + g) * S + 16 * c + l) * 64 + d);
            const float4 pe = *(const float4*)(pos + k);
            return make_float4(__uint_as_float(x.x << 16) + pe.x, __uint_as_float(x.x & 0xffff0000u) + pe.y, __uint_as_float(x.y << 16) + pe.z, __uint_as_float(x.y & 0xffff0000u) + pe.w);
        };
        auto bl = [&](int, int k, int c) -> float4 { return *(const float4*)(w1 + (size_t)k * 256 + col0 + c); };
        gemm_tile_f32<1>(v.tid, acc, 2048, al, bl, As, Bs);
        const int tx = v.tid & 15, ty = v.tid >> 4;
#pragma unroll
        for (int i = 0; i < 4; ++i) {
            const int row = row0 + ty * 4 + i;
            if (row >= NCR) continue;
#pragma unroll
            for (int j = 0; j < 4; ++j) { const int col = col0 + tx * 4 + j; hid[(size_t)row * 256 + col] = gelu_tanh(acc[0][i][j] + b1[col]); }
        }
    }
}
__device__ __forceinline__ void p_cmp_attn_bf(const VB& v, const unsigned short* __restrict__ qb, const float* __restrict__ kc, const float* __restrict__ vc,
                                              float* __restrict__ o_cmp, unsigned* __restrict__ selmask) {
    float (*qs)[64] = (float (*)[64])v.lds;
    float (*ps)[128] = (float (*)[128])(v.lds + 1024);
    float* imps = (float*)(v.lds + 1024 + 2048);
    VB_ITEMS(T * 2) {
        const int g = item & 1, t = item >> 1, b = t / S, s = t % S;
        const int w = v.tid >> 6, lane = v.tid & 63, h = g * 4 + w;
        __syncthreads();
        qs[w][lane] = bfu(qb[(size_t)t * 512 + h * 64 + lane]);
        ps[w][lane] = 0.f; ps[w][lane + 64] = 0.f;
        __syncthreads();
        {
            float m = -3.0e38f;
            float* sc = ps[w];
            for (int c = lane; c < NC; c += 64) {
                float sv = -3.0e38f;
                if (16 * c + 31 <= s) { const float* kp = kc + (size_t)((b * NC + c) * 2 + g) * 64; sv = 0.f; for (int d = 0; d < 64; ++d) sv += qs[w][d] * kp[d]; }
                sc[c] = sv; m = fmaxf(m, sv);
            }
            m = wave_max(m);
            float sum = 0.f;
            for (int c = lane; c < NC; c += 64) { const float sv = sc[c]; const float pp = (sv > -1.0e38f) ? exp2f(sv - m) : 0.f; sc[c] = pp; sum += pp; }
            sum = wave_sum(sum);
            const float inv = (m > -1.0e38f) ? 1.f / sum : 0.f;
            for (int c = lane; c < NC; c += 64) sc[c] *= inv;
            __builtin_amdgcn_s_waitcnt(0);
            float o = 0.f;
            for (int c = 0; c < NC; ++c) { const float pp = sc[c]; if (pp != 0.f) o += pp * vc[(size_t)((b * NC + c) * 2 + g) * 64 + lane]; }
            o_cmp[(size_t)t * 512 + h * 64 + lane] = o;
        }
        __syncthreads();
        if (v.tid < 32) {
            const int j = v.tid;
            float imp = 0.f;
            for (int hh = 0; hh < 4; ++hh)
                for (int c = 4 * j - 1; c <= 4 * j + 3; ++c) {
                    if (c < 0 || c >= NC) continue;
                    const float ov = (c == 4 * j - 1 || c == 4 * j + 3) ? 0.5f : 1.0f;
                    imp += ps[hh][c] * ov;
                }
            const int cur = s >> 6;
            if (j == 0 || j == cur || j == cur - 1) imp = 1e30f; else if (j > cur) imp = -1e30f;
            imps[j] = imp;
        }
        __syncthreads();
        if (v.tid < 64) {
            const int j = v.tid & 31;
            const float mine = imps[j];
            int rank = 0;
            for (int i = 0; i < 32; ++i) { const float x = imps[i]; rank += (x > mine || (x == mine && i < j)) ? 1 : 0; }
            const unsigned long long bal = __ballot(rank < 16 && v.tid < 32);
            if (v.tid == 0) selmask[(size_t)(b * 2 + g) * S + s] = (unsigned)(bal & 0xffffffffull);
        }
    }
}
template <int MODE>
__device__ __forceinline__ void p_nsa_attn_bf(const VB& v, const unsigned short* __restrict__ qb, const unsigned short* __restrict__ Kh, const unsigned short* __restrict__ VT,
                                              const unsigned* __restrict__ selmask, float* __restrict__ outp) {
    float (*qs)[64] = (float (*)[64])v.lds;
    float (*scs)[2048] = (float (*)[2048])(v.lds + 1024);
    VB_ITEMS(T * 2) {
        const int g = item & 1, t = item >> 1, b = t / S, s = t % S;
        const int w = v.tid >> 6, lane = v.tid & 63, h = g * 4 + w;
        qs[w][lane] = bfu(qb[(size_t)t * 512 + h * 64 + lane]);
        __builtin_amdgcn_s_waitcnt(0);
        const unsigned short* Kb = Kh + (size_t)(b * 2 + g) * S * 64;
        const unsigned short* Vb = VT + (size_t)(b * 2 + g) * 64 * S;
        if (MODE == 0) {
            const unsigned mask = selmask[(size_t)(b * 2 + g) * S + s];
            const int ncand = ((s >> 6) + 1) * 64;
            auto valid = [&](int idx) -> bool { return idx <= s && ((mask >> (idx >> 6)) & 1u); };
            auto krow = [&](int idx) -> const unsigned short* { return Kb + (size_t)idx * 64; };
            auto vget = [&](int idx, int d) -> float { return bfu(Vb[(size_t)d * S + idx]); };
            wave_attend_bf<64>(qs[w], ncand, valid, krow, vget, scs[w], outp + (size_t)t * 512 + h * 64, lane);
        } else {
            const int lo = s - 511 > 0 ? s - 511 : 0;
            const int ncand = s - lo + 1;
            auto valid = [&](int) -> bool { return true; };
            auto krow = [&](int idx) -> const unsigned short* { return Kb + (size_t)(lo + idx) * 64; };
            auto vget = [&](int idx, int d) -> float { return bfu(Vb[(size_t)d * S + lo + idx]); };
            wave_attend_bf<64>(qs[w], ncand, valid, krow, vget, scs[w], outp + (size_t)t * 512 + h * 64, lane);
        }
    }
}
__device__ __forceinline__ void p_mix_post_bf(const VB& v, const float* __restrict__ gates, const unsigned short* __restrict__ ub, const unsigned short* __restrict__ cbb,
                                              const float* __restrict__ o_cmp, const float* __restrict__ o_slc, const float* __restrict__ o_win,
                                              const float* __restrict__ conv_w, const float* __restrict__ g_nsa, const float* __restrict__ g_conv, unsigned short* __restrict__ omix) {
    float (*red)[4] = (float (*)[4])v.lds;
    VB_ITEMS(T) {
        const int t = item, s = t % S, tid = v.tid;
        float on[2], oc[2], ssn = 0.f, ssc = 0.f;
#pragma unroll
        for (int e = 0; e < 2; ++e) {
            const int c = tid + 256 * e, h = c >> 6;
            const float g0 = gates[(size_t)t * 24 + h * 3 + 0], g1 = gates[(size_t)t * 24 + h * 3 + 1], g2 = gates[(size_t)t * 24 + h * 3 + 2];
            on[e] = g0 * o_cmp[(size_t)t * 512 + c] + g1 * o_slc[(size_t)t * 512 + c] + g2 * o_win[(size_t)t * 512 + c];
            ssn += on[e] * on[e];
            float y = 0.f;
#pragma unroll
            for (int k = 0; k < 3; ++k) {
                const int sp = s - 2 + k;
                if (sp < 0) continue;
                y += conv_w[k * 512 + c] * bfu(ub[(size_t)(t - 2 + k) * 512 + c]);
            }
            oc[e] = bfu(cbb[(size_t)t * 512 + c]) * y;
            ssc += oc[e] * oc[e];
        }
        ssn = wave_sum(ssn); ssc = wave_sum(ssc);
        __syncthreads();
        if ((tid & 63) == 0) { red[0][tid >> 6] = ssn; red[1][tid >> 6] = ssc; }
        __syncthreads();
        ssn = red[0][0] + red[0][1] + red[0][2] + red[0][3];
        ssc = red[1][0] + red[1][1] + red[1][2] + red[1][3];
        const float rn = rsqrtf(ssn / 512.f + 1e-5f), rc = rsqrtf(ssc / 512.f + 1e-5f);
#pragma unroll
        for (int e = 0; e < 2; ++e) {
            const int c = tid + 256 * e;
            omix[(size_t)t * D + c] = f2bf_rne(on[e] * rn * g_nsa[c]);
            omix[(size_t)t * D + 512 + c] = f2bf_rne(oc[e] * rc * g_conv[c]);
        }
    }
}

__device__ __forceinline__ void p_router(const VB& v, const float* __restrict__ xn, const float* __restrict__ wr, const float* __restrict__ br,
                                         int* __restrict__ a_e, float* __restrict__ a_w, int* __restrict__ a_slot, int* __restrict__ counts) {
    VB_ITEMS(T / 4) {
        const int t = item * 4 + (v.tid >> 6), lane = v.tid & 63, e = lane & 31, half = lane >> 5;
        const float* x = xn + (size_t)t * D + half * 512;
        const float* w = wr + (size_t)half * 512 * NE + e;
        float acc = 0.f;
        for (int k = 0; k < 512; ++k) acc += x[k] * w[(size_t)k * NE];
        acc += __shfl_xor(acc, 32);
        const float logit = acc + br[e];
        int rank = 0;
        for (int i = 0; i < 32; ++i) { const float x2 = __shfl(logit, i); rank += (x2 > logit || (x2 == logit && i < e)) ? 1 : 0; }
        const float vmax = wave_max(logit);
        const bool sel = (rank < TOPK) && (lane < 32);
        const float ex = sel ? __expf(logit - vmax) : 0.f;
        const float sum = wave_sum(ex);
        if (sel) {
            const int a = t * TOPK + rank;
            a_e[a] = e; a_w[a] = ex / sum; a_slot[a] = atomicAdd(&counts[e], 1);
        }
    }
}
__device__ __forceinline__ void p_moe_offsets(const VB& v, const int* __restrict__ counts, int* __restrict__ pstart, int* __restrict__ tile_e, int* __restrict__ tok_buf, float* __restrict__ w_buf) {
    int* ps = (int*)v.lds;
    __syncthreads();
    if (v.tid == 0) { int acc = 0; for (int e = 0; e < NE; ++e) { ps[e] = acc; if (v.vb == 0) pstart[e] = acc; acc += (counts[e] + MT - 1) / MT * MT; } ps[NE] = acc; if (v.vb == 0) pstart[NE] = acc / MT; }
    __syncthreads();
    for (int tl = v.vb * 256 + v.tid; tl < NTILE; tl += v.nvb * 256) {
        const int r = tl * MT; int e = -1;
        for (int i = 0; i < NE; ++i) if (r >= ps[i] && r < ps[i + 1]) e = i;
        tile_e[tl] = e;
    }
    for (int i = v.vb * 256 + v.tid; i < PMAX; i += v.nvb * 256) { tok_buf[i] = 0; w_buf[i] = 0.f; }
}
__device__ __forceinline__ void p_moe_scatter(const VB& v, const int* __restrict__ a_e, const float* __restrict__ a_w, const int* __restrict__ a_slot, const int* __restrict__ pstart,
                                              int* __restrict__ tok_buf, float* __restrict__ w_buf, int* __restrict__ dest_of, const float* __restrict__ xn, unsigned short* __restrict__ xg) {
    const int lane = v.tid & 63, gw = v.vb * 4 + (v.tid >> 6), ngw = v.nvb * 4;
    for (int a = gw; a < NA; a += ngw) {
        const int dest = pstart[a_e[a]] + a_slot[a], t = a / TOPK;
        if (lane == 0) { tok_buf[dest] = t; w_buf[dest] = a_w[a]; dest_of[a] = dest; }
        const float* src = xn + (size_t)t * D + lane * 16;
        unsigned o[8];
#pragma unroll
        for (int i = 0; i < 4; ++i) { const float4 x = *(const float4*)(src + 4 * i); o[2 * i] = pg::cvt_pk_bf16(x.x, x.y); o[2 * i + 1] = pg::cvt_pk_bf16(x.z, x.w); }
        uint4* dst = (uint4*)(xg + (size_t)dest * D + lane * 16);
        dst[0] = make_uint4(o[0], o[1], o[2], o[3]); dst[1] = make_uint4(o[4], o[5], o[6], o[7]);
    }
}
__device__ __forceinline__ void p_moe1(const VB& v, const float* __restrict__ xn, const int* __restrict__ tok_buf, const int* __restrict__ tile_e,
                                       const float* __restrict__ wgu, const float* __restrict__ bgu, __hip_bfloat16* __restrict__ hmid) {
    float (*As)[68] = (float (*)[68])v.lds;
    float (*Bs)[132] = (float (*)[132])(v.lds + 16 * 68 * 4);
    int* toks = (int*)(v.lds + 16 * 68 * 4 + 16 * 132 * 4);
    const int nt = 16 * NTILE;
    VB_ITEMS(nt) {
        const int tl = item < nt ? item / 16 : 0, cx = item % 16;
        const int e0 = item < nt ? tile_e[tl] : -1;
        const bool act = e0 >= 0;
        const int e = act ? e0 : 0;
        const int row0 = tl * MT, col0 = cx * 64;
        __syncthreads();
        if (v.tid < MT) toks[v.tid] = act ? tok_buf[row0 + v.tid] : 0;
        __syncthreads();
        const float* W = wgu + (size_t)e * D * 2048;
        float acc[2][4][4];
        auto al = [&](int r, int k) -> float4 { return *(const float4*)(xn + (size_t)toks[r] * D + k); };
        auto bl = [&](int w, int k, int c) -> float4 { return *(const float4*)(W + (size_t)k * 2048 + w * 1024 + col0 + c); };
        gemm_tile_f32<2>(v.tid, acc, D, al, bl, As, Bs);
        if (!act) continue;
        const int tx = v.tid & 15, ty = v.tid >> 4;
#pragma unroll
        for (int i = 0; i < 4; ++i)
#pragma unroll
            for (int j = 0; j < 4; ++j) {
                const int row = row0 + ty * 4 + i, col = col0 + tx * 4 + j;
                float g = acc[0][i][j] + bgu[(size_t)e * 2048 + col], u = acc[1][i][j] + bgu[(size_t)e * 2048 + 1024 + col];
                g = fminf(g, 7.f); u = fminf(fmaxf(u, -7.f), 7.f);
                const float hm = (u + 1.f) * (g / (1.f + __expf(-1.702f * g)));
                hmid[(size_t)row * DFF + col] = __float2bfloat16(hm);
            }
    }
}
__device__ __forceinline__ void p_moe2(const VB& v, const __hip_bfloat16* __restrict__ hmid, const int* __restrict__ tile_e, const float* __restrict__ w_buf,
                                       const float* __restrict__ wd, const float* __restrict__ bd, __hip_bfloat16* __restrict__ out_a) {
    float (*As)[68] = (float (*)[68])v.lds;
    float (*Bs)[68] = (float (*)[68])(v.lds + 16 * 68 * 4);
    const int nt = 16 * NTILE;
    VB_ITEMS(nt) {
        const int tl = item < nt ? item / 16 : 0, cx = item % 16;
        const int e0 = item < nt ? tile_e[tl] : -1;
        const bool act = e0 >= 0;
        const int e = act ? e0 : 0;
        const int row0 = tl * MT, col0 = cx * 64;
        const float* W = wd + (size_t)e * DFF * D;
        float acc[1][4][4];
        auto al = [&](int r, int k) -> float4 {
            if (!act) return make_float4(0.f, 0.f, 0.f, 0.f);
            const __hip_bfloat16* p = hmid + (size_t)(row0 + r) * DFF + k;
            return make_float4(__bfloat162float(p[0]), __bfloat162float(p[1]), __bfloat162float(p[2]), __bfloat162float(p[3]));
        };
        auto bl = [&](int, int k, int c) -> float4 { return *(const float4*)(W + (size_t)k * D + col0 + c); };
        gemm_tile_f32<1>(v.tid, acc, DFF, al, bl, As, Bs);
        if (!act) continue;
        const int tx = v.tid & 15, ty = v.tid >> 4;
#pragma unroll
        for (int i = 0; i < 4; ++i)
#pragma unroll
            for (int j = 0; j < 4; ++j) {
                const int row = row0 + ty * 4 + i, col = col0 + tx * 4 + j;
                out_a[(size_t)row * D + col] = __float2bfloat16((acc[0][i][j] + bd[(size_t)e * D + col]) * w_buf[row]);
            }
    }
}
__device__ __forceinline__ void p_final(const VB& v, const float* __restrict__ h2, const unsigned short* __restrict__ out_a, const int* __restrict__ dest_of,
                                        const float* __restrict__ g, float* __restrict__ out) {
    float* red = (float*)v.lds;
    VB_ITEMS(T) {
        const int t = item, tid = v.tid;
        int d[4];
#pragma unroll
        for (int k = 0; k < 4; ++k) d[k] = dest_of[t * 4 + k];
        float x4[4], ss = 0.f;
#pragma unroll
        for (int e = 0; e < 4; ++e) {
            const int c = tid + 256 * e;
            float x = h2[(size_t)t * D + c];
#pragma unroll
            for (int k = 0; k < 4; ++k) x += __uint_as_float(((unsigned)out_a[(size_t)d[k] * D + c]) << 16);
            x4[e] = x; ss += x * x;
        }
        ss = wave_sum(ss);
        __syncthreads();
        if ((tid & 63) == 0) red[tid >> 6] = ss;
        __syncthreads();
        ss = red[0] + red[1] + red[2] + red[3];
        const float rs = rsqrtf(ss / (float)D + 1e-5f);
#pragma unroll
        for (int e = 0; e < 4; ++e) { const int c = tid + 256 * e; out[(size_t)t * D + c] = x4[e] * rs * g[c]; }
    }
}


namespace pg {
typedef unsigned short bf16_t;
typedef short bf16x8 __attribute__((ext_vector_type(8)));
typedef float f32x4 __attribute__((ext_vector_type(4)));
constexpr int BM = 256, BK = 64, HALF = 128, HTB = HALF * BK * 2, STAGE_BYTES = 8 * HTB;
__device__ __forceinline__ int lds_byte(int r, int c) { const int st = (r >> 4) * 2 + (c >> 5), rr = r & 15, cc = c & 31, ob = rr * 64 + cc * 2; return st * 1024 + (ob ^ (((ob >> 9) & 1) << 5)); }
__device__ __forceinline__ void stage_rc(int b, int& R, int& C) { const int st = b / 1024, sb = b % 1024, swz = sb ^ (((sb >> 9) & 1) << 5); R = (st >> 1) * 16 + swz / 64; C = (st & 1) * 32 + (swz % 64) / 2; }
typedef float f32x2_t __attribute__((ext_vector_type(2)));
typedef __bf16 bf16x2_t __attribute__((ext_vector_type(2)));
__device__ __forceinline__ unsigned cvt_pk_bf16_acc(float lo, float hi) { const f32x2_t v = {lo, hi}; const bf16x2_t b = __builtin_convertvector(v, bf16x2_t); return __builtin_bit_cast(unsigned, b); }
__device__ __forceinline__ unsigned cvt_pk_bf16(float lo, float hi) { unsigned r; asm volatile("v_cvt_pk_bf16_f32 %0, %1, %2" : "=v"(r) : "v"(lo), "v"(hi)); return r; }
__device__ __forceinline__ bf16_t f2bf(float f) { unsigned u = __float_as_uint(f); u += 0x7FFFu + ((u >> 16) & 1u); return (bf16_t)(u >> 16); }
__device__ __forceinline__ float bf2f(bf16_t b) { return __uint_as_float(((unsigned)b) << 16); }

__device__ __forceinline__ unsigned pk4_fp8(float a, float b, float c, float d);
struct GUnit { const char* A; const char* B; int row0, col0, aux; };

template <class Epi, class Sched>
__device__ __forceinline__ void gemm_phase(LAS unsigned char* lds, const int K, const unsigned lda_b, const unsigned ldb_b, const Sched& S, const Epi& E) {
    const int tid = opaque_tid(), wid = __builtin_amdgcn_readfirstlane(tid >> 6), lane = tid & 63, wr = wid >> 2, wc = wid & 3, fr = lane & 15, fq = lane >> 4;
    const int nt = K / BK;
    unsigned voffA[2], voffB[2];
#pragma unroll
    for (int i = 0; i < 2; ++i) { int R, C; stage_rc(tid * 16 + i * 8192, R, C); voffA[i] = (unsigned)R * lda_b + (unsigned)C * 2u; voffB[i] = (unsigned)R * ldb_b + (unsigned)C * 2u; }
    const size_t kstep = (size_t)(BK * 2);
    const size_t hstepA = (size_t)HALF * lda_b, hstepB = (size_t)HALF * ldb_b;
    const unsigned ldsw = (unsigned)wid * 1024u;
    const int aoff = lds_byte(wr * 64 + fr, fq * 8), boff = lds_byte(wc * 32 + fr, fq * 8);
#define PG8_SA(b, h) (((b) * 2 + (h)) * HTB)
#define PG8_SB(b, h) ((4 + (b) * 2 + (h)) * HTB)
#define PG8_STAGE(bufoff, gbase, voff) do { _Pragma("unroll") for (int _i = 0; _i < 2; ++_i) \
        __builtin_amdgcn_global_load_lds((const unsigned*)((const char*)(gbase) + (voff)[_i]), (LAS unsigned*)(lds + (bufoff) + ldsw + _i * 8192), 16, 0, 0); } while (0)
#define PG8_LDA(dst, b, h) do { _Pragma("unroll") for (int m = 0; m < 4; ++m) _Pragma("unroll") for (int k = 0; k < 2; ++k) dst[m][k] = *(const LAS bf16x8*)(lds + PG8_SA(b, h) + aoff + m * 2048 + k * 1024); } while (0)
#define PG8_LDB(dst, b, h) do { _Pragma("unroll") for (int n = 0; n < 2; ++n) _Pragma("unroll") for (int k = 0; k < 2; ++k) dst[n][k] = *(const LAS bf16x8*)(lds + PG8_SB(b, h) + boff + n * 2048 + k * 1024); } while (0)
#define PG8_MMA(ai, bj, At, Bt) do { __builtin_amdgcn_s_setprio(1); _Pragma("unroll") for (int m = 0; m < 4; ++m) _Pragma("unroll") for (int n = 0; n < 2; ++n) _Pragma("unroll") for (int k = 0; k < 2; ++k) \
        acc[ai][bj][m][n] = __builtin_amdgcn_mfma_f32_16x16x32_bf16(Bt[n][k], At[m][k], acc[ai][bj][m][n], 0, 0, 0); __builtin_amdgcn_s_setprio(0); } while (0)
#define PG8_WAIT_V(n) asm volatile("s_waitcnt vmcnt(" #n ")" ::: "memory")
#define PG8_WAIT_L(n) asm volatile("s_waitcnt lgkmcnt(" #n ")" ::: "memory")
#define PG8_BAR __builtin_amdgcn_s_barrier()
#define PG8_SCHED __builtin_amdgcn_sched_barrier(0)
    GUnit cur, nxt; int ui = 0;
    if (!S.next(0, cur)) return;
    f32x4 acc[2][2][4][2];
#pragma unroll
    for (int a = 0; a < 2; ++a)
#pragma unroll
        for (int b = 0; b < 2; ++b)
#pragma unroll
            for (int m = 0; m < 4; ++m)
#pragma unroll
                for (int n = 0; n < 2; ++n) acc[a][b][m][n] = (f32x4){0.f, 0.f, 0.f, 0.f};
    bf16x8 At[4][2], B0[2][2], B1[2][2];
    const char* cA = cur.A; const char* cB = cur.B;
    PG8_STAGE(PG8_SB(0, 0), cB, voffB); PG8_STAGE(PG8_SA(0, 0), cA, voffA); PG8_STAGE(PG8_SB(0, 1), cB + hstepB, voffB); PG8_STAGE(PG8_SA(0, 1), cA + hstepA, voffA);
    if (wr == 1) PG8_BAR;
    PG8_WAIT_V(4); PG8_BAR;
    PG8_STAGE(PG8_SB(1, 0), cB + kstep, voffB); PG8_STAGE(PG8_SA(1, 0), cA + kstep, voffA); PG8_STAGE(PG8_SB(1, 1), cB + hstepB + kstep, voffB);
    PG8_WAIT_V(6); PG8_BAR;
    for (;;) {
        const bool has_next = S.next(ui + 1, nxt);
        const char* nA = has_next ? nxt.A : cA; const char* nB = has_next ? nxt.B : cB;
        for (int t = 0; t < nt; t += 2) {
            const bool last = (t == nt - 2);
            const char* a1 = cA + (size_t)(t + 1) * kstep;
            const char* a2 = last ? nA : cA + (size_t)(t + 2) * kstep; const char* b2 = last ? nB : cB + (size_t)(t + 2) * kstep;
            const char* a3 = a2 + kstep; const char* b3 = b2 + kstep;
            PG8_LDB(B0, 0, 0); PG8_SCHED; PG8_LDA(At, 0, 0); PG8_STAGE(PG8_SA(1, 1), a1 + hstepA, voffA);
            PG8_WAIT_L(8); PG8_BAR; PG8_WAIT_L(0); PG8_MMA(0, 0, At, B0); PG8_BAR; PG8_SCHED;
            PG8_LDB(B1, 0, 1); PG8_STAGE(PG8_SB(0, 0), b2, voffB);
            PG8_BAR; PG8_WAIT_L(0); PG8_MMA(0, 1, At, B1); PG8_BAR;
            PG8_LDA(At, 0, 1); PG8_STAGE(PG8_SA(0, 0), a2, voffA);
            PG8_BAR; PG8_WAIT_L(0); PG8_MMA(1, 0, At, B0); PG8_BAR; PG8_SCHED;
            PG8_STAGE(PG8_SB(0, 1), b2 + hstepB, voffB);
            PG8_WAIT_V(6); PG8_BAR; PG8_MMA(1, 1, At, B1); PG8_BAR;
            PG8_LDB(B0, 1, 0); PG8_SCHED; PG8_LDA(At, 1, 0); PG8_STAGE(PG8_SA(0, 1), a2 + hstepA, voffA);
            PG8_WAIT_L(8); PG8_BAR; PG8_WAIT_L(0); PG8_MMA(0, 0, At, B0); PG8_BAR; PG8_SCHED;
            PG8_LDB(B1, 1, 1); PG8_STAGE(PG8_SB(1, 0), b3, voffB);
            PG8_BAR; PG8_WAIT_L(0); PG8_MMA(0, 1, At, B1); PG8_BAR;
            PG8_LDA(At, 1, 1); PG8_STAGE(PG8_SA(1, 0), a3, voffA);
            PG8_BAR; PG8_WAIT_L(0); PG8_MMA(1, 0, At, B0); PG8_BAR; PG8_SCHED;
            PG8_STAGE(PG8_SB(1, 1), b3 + hstepB, voffB);
            PG8_WAIT_V(6); PG8_BAR; PG8_MMA(1, 1, At, B1); PG8_BAR;
        }
        E(acc, cur, wr, wc, fr, fq);
        if (!has_next) break;
#pragma unroll
        for (int a = 0; a < 2; ++a)
#pragma unroll
            for (int b = 0; b < 2; ++b)
#pragma unroll
                for (int m = 0; m < 4; ++m)
#pragma unroll
                    for (int n = 0; n < 2; ++n) acc[a][b][m][n] = (f32x4){0.f, 0.f, 0.f, 0.f};
        cur = nxt; cA = nA; cB = nB; ++ui;
    }
    PG8_WAIT_V(0);
    if (wr == 0) PG8_BAR;
    PG8_BAR;
#undef PG8_SA
#undef PG8_SB
#undef PG8_STAGE
#undef PG8_LDA
#undef PG8_LDB
#undef PG8_MMA
#undef PG8_WAIT_V
#undef PG8_WAIT_L
#undef PG8_BAR
#undef PG8_SCHED
}

typedef int v4i_t __attribute__((ext_vector_type(4)));
typedef int v8i_t __attribute__((ext_vector_type(8)));
template <class Epi, class Sched>
__device__ __forceinline__ void gemm_phase_f8(LAS unsigned char* lds, const int K  , const unsigned lda_b, const unsigned ldb_b, const Sched& S, const Epi& E) {
    const int tid = opaque_tid(), wid = __builtin_amdgcn_readfirstlane(tid >> 6), lane = tid & 63, wr = wid >> 2, wc = wid & 3, fr = lane & 15, fq = lane >> 4;
    const int nt = K / 128;
    unsigned voffA[2], voffB[2];
#pragma unroll
    for (int i = 0; i < 2; ++i) { int R, C; stage_rc(tid * 16 + i * 8192, R, C); voffA[i] = (unsigned)R * lda_b + (unsigned)C * 2u; voffB[i] = (unsigned)R * ldb_b + (unsigned)C * 2u; }
    const size_t kstep = (size_t)(BK * 2);
    const size_t hstepA = (size_t)HALF * lda_b, hstepB = (size_t)HALF * ldb_b;
    const unsigned ldsw = (unsigned)wid * 1024u;
    const int aoff = lds_byte(wr * 64 + fr, fq * 8), boff = lds_byte(wc * 32 + fr, fq * 8);
#define PG8_SA(b, h) (((b) * 2 + (h)) * HTB)
#define PG8_SB(b, h) ((4 + (b) * 2 + (h)) * HTB)
#define PG8_STAGE(bufoff, gbase, voff) do { _Pragma("unroll") for (int _i = 0; _i < 2; ++_i) \
        __builtin_amdgcn_global_load_lds((const unsigned*)((const char*)(gbase) + (voff)[_i]), (LAS unsigned*)(lds + (bufoff) + ldsw + _i * 8192), 16, 0, 0); } while (0)
#define PG8_LDA(dst, b, h) do { _Pragma("unroll") for (int m = 0; m < 4; ++m) { const v4i_t lo_ = *(const LAS v4i_t*)(lds + PG8_SA(b, h) + aoff + m * 2048), hi_ = *(const LAS v4i_t*)(lds + PG8_SA(b, h) + aoff + m * 2048 + 1024); dst[m] = __builtin_shufflevector(lo_, hi_, 0, 1, 2, 3, 4, 5, 6, 7); } } while (0)
#define PG8_LDB(dst, b, h) do { _Pragma("unroll") for (int n = 0; n < 2; ++n) { const v4i_t lo_ = *(const LAS v4i_t*)(lds + PG8_SB(b, h) + boff + n * 2048), hi_ = *(const LAS v4i_t*)(lds + PG8_SB(b, h) + boff + n * 2048 + 1024); dst[n] = __builtin_shufflevector(lo_, hi_, 0, 1, 2, 3, 4, 5, 6, 7); } } while (0)
#define PG8_MMA(ai, bj, At, Bt) do { __builtin_amdgcn_s_setprio(1); _Pragma("unroll") for (int m = 0; m < 4; ++m) _Pragma("unroll") for (int n = 0; n < 2; ++n) \
        asm volatile("v_mfma_scale_f32_16x16x128_f8f6f4 %0, %1, %2, %0, %3, %3 op_sel_hi:[0,0,0]" : "+v"(acc[ai][bj][m][n]) : "v"(Bt[n]), "v"(At[m]), "v"(unit_scale)); __builtin_amdgcn_s_setprio(0); } while (0)
#define PG8_WAIT_V(n) asm volatile("s_waitcnt vmcnt(" #n ")" ::: "memory")
#define PG8_WAIT_L(n) asm volatile("s_waitcnt lgkmcnt(" #n ")" ::: "memory")
#define PG8_BAR __builtin_amdgcn_s_barrier()
#define PG8_SCHED __builtin_amdgcn_sched_barrier(0)
    const int unit_scale = 0x7f7f7f7f;
    GUnit cur, nxt; int ui = 0;
    if (!S.next(0, cur)) return;
    f32x4 acc[2][2][4][2];
#pragma unroll
    for (int a = 0; a < 2; ++a)
#pragma unroll
        for (int b = 0; b < 2; ++b)
#pragma unroll
            for (int m = 0; m < 4; ++m)
#pragma unroll
                for (int n = 0; n < 2; ++n) acc[a][b][m][n] = (f32x4){0.f, 0.f, 0.f, 0.f};
    v8i_t At[4], B0[2], B1[2];
    const char* cA = cur.A; const char* cB = cur.B;
    PG8_STAGE(PG8_SB(0, 0), cB, voffB); PG8_STAGE(PG8_SA(0, 0), cA, voffA); PG8_STAGE(PG8_SB(0, 1), cB + hstepB, voffB); PG8_STAGE(PG8_SA(0, 1), cA + hstepA, voffA);
    if (wr == 1) PG8_BAR;
    PG8_WAIT_V(4); PG8_BAR;
    PG8_STAGE(PG8_SB(1, 0), cB + kstep, voffB); PG8_STAGE(PG8_SA(1, 0), cA + kstep, voffA); PG8_STAGE(PG8_SB(1, 1), cB + hstepB + kstep, voffB);
    PG8_WAIT_V(6); PG8_BAR;
    for (;;) {
        const bool has_next = S.next(ui + 1, nxt);
        const char* nA = has_next ? nxt.A : cA; const char* nB = has_next ? nxt.B : cB;
#pragma nounroll
        for (int t = 0; t < nt; t += 2) {
            const bool last = (t == nt - 2);
            const char* a1 = cA + (size_t)(t + 1) * kstep;
            const char* a2 = last ? nA : cA + (size_t)(t + 2) * kstep; const char* b2 = last ? nB : cB + (size_t)(t + 2) * kstep;
            const char* a3 = a2 + kstep; const char* b3 = b2 + kstep;
            PG8_LDB(B0, 0, 0); PG8_SCHED; PG8_LDA(At, 0, 0); PG8_STAGE(PG8_SA(1, 1), a1 + hstepA, voffA);
            PG8_WAIT_L(8); PG8_BAR; PG8_WAIT_L(0); PG8_MMA(0, 0, At, B0); PG8_BAR; PG8_SCHED;
            PG8_LDB(B1, 0, 1); PG8_STAGE(PG8_SB(0, 0), b2, voffB);
            PG8_BAR; PG8_WAIT_L(0); PG8_MMA(0, 1, At, B1); PG8_BAR;
            PG8_LDA(At, 0, 1); PG8_STAGE(PG8_SA(0, 0), a2, voffA);
            PG8_BAR; PG8_WAIT_L(0); PG8_MMA(1, 0, At, B0); PG8_BAR; PG8_SCHED;
            PG8_STAGE(PG8_SB(0, 1), b2 + hstepB, voffB);
            PG8_WAIT_V(6); PG8_BAR; PG8_MMA(1, 1, At, B1); PG8_BAR;
            PG8_LDB(B0, 1, 0); PG8_SCHED; PG8_LDA(At, 1, 0); PG8_STAGE(PG8_SA(0, 1), a2 + hstepA, voffA);
            PG8_WAIT_L(8); PG8_BAR; PG8_WAIT_L(0); PG8_MMA(0, 0, At, B0); PG8_BAR; PG8_SCHED;
            PG8_LDB(B1, 1, 1); PG8_STAGE(PG8_SB(1, 0), b3, voffB);
            PG8_BAR; PG8_WAIT_L(0); PG8_MMA(0, 1, At, B1); PG8_BAR;
            PG8_LDA(At, 1, 1); PG8_STAGE(PG8_SA(1, 0), a3, voffA);
            PG8_BAR; PG8_WAIT_L(0); PG8_MMA(1, 0, At, B0); PG8_BAR; PG8_SCHED;
            PG8_STAGE(PG8_SB(1, 1), b3 + hstepB, voffB);
            PG8_WAIT_V(6); PG8_BAR; PG8_MMA(1, 1, At, B1); PG8_BAR;
        }
        asm volatile("s_nop 15\n\ts_nop 15" ::: "memory");
        E(acc, cur, wr, wc, fr, fq);
        if (!has_next) break;
#pragma unroll
        for (int a = 0; a < 2; ++a)
#pragma unroll
            for (int b = 0; b < 2; ++b)
#pragma unroll
                for (int m = 0; m < 4; ++m)
#pragma unroll
                    for (int n = 0; n < 2; ++n) acc[a][b][m][n] = (f32x4){0.f, 0.f, 0.f, 0.f};
        cur = nxt; cA = nA; cB = nB; ++ui;
    }
    PG8_WAIT_V(0);
    if (wr == 0) PG8_BAR;
    PG8_BAR;
#undef PG8_SA
#undef PG8_SB
#undef PG8_STAGE
#undef PG8_LDA
#undef PG8_LDB
#undef PG8_MMA
#undef PG8_WAIT_V
#undef PG8_WAIT_L
#undef PG8_BAR
#undef PG8_SCHED
}

__device__ __forceinline__ void dense_map(int L, int nM, int nN, int& pm, int& pn) {
    const int nwg = nM * nN;
    int wgid = L; { const int q = nwg / 8, r = nwg % 8, xcd = wgid % 8, off = wgid / 8; wgid = (xcd < r ? xcd * (q + 1) : r * (q + 1) + (xcd - r) * q) + off; }
    const int nig = 8 * nN, gid = wgid / nig, fm = gid * 8, gsz = (nM - fm) < 8 ? (nM - fm) : 8;
    pm = fm + ((wgid % nig) % gsz); pn = (wgid % nig) / gsz;
}
struct DenseOrder {
    const char* A; const char* Bt; unsigned lda_b, ldb_b; int nM, nN, nwg, G, c;
    __device__ void init(const void* A_, const void* Bt_, int M, int N, unsigned lda_b_, unsigned ldb_b_, int G_, int c_) { A = (const char*)A_; Bt = (const char*)Bt_; lda_b = lda_b_; ldb_b = ldb_b_; nM = M / BM; nN = N / BM; nwg = nM * nN; G = G_; c = c_; }
    __device__ bool next(int i, GUnit& u) const {
        const long L = (long)i * G + c; if (L >= nwg) return false;
        int pm, pn; dense_map((int)L, nM, nN, pm, pn);
        u.A = A + (size_t)pm * BM * lda_b; u.B = Bt + (size_t)pn * BM * ldb_b; u.row0 = pm * BM; u.col0 = pn * BM; u.aux = 0; return true;
    }
};


struct OneUnit {
    GUnit u;
    __device__ bool next(int i, GUnit& o) const { if (i != 0) return false; o = u; return true; }
};
struct EpiF32R {
    float* C; int ldc; const float* res; int ncols;
    __device__ __forceinline__ void operator()(const f32x4 (&acc)[2][2][4][2], const GUnit& u, int wr, int wc, int fr, int fq) const {
        const int row0 = u.row0 + wr * 64 + fr, col0 = u.col0 + wc * 32 + 4 * fq;
#pragma unroll
        for (int ai = 0; ai < 2; ++ai)
#pragma unroll
            for (int m = 0; m < 4; ++m) {
                const size_t ro = (size_t)(row0 + ai * HALF + m * 16) * ldc;
#pragma unroll
                for (int bj = 0; bj < 2; ++bj)
#pragma unroll
                    for (int n = 0; n < 2; ++n) {
                        const int col = col0 + bj * HALF + n * 16;
                        if (col < ncols) { f32x4 x = acc[ai][bj][m][n]; if (res) x += *(const f32x4*)(res + ro + col); *(f32x4*)(C + ro + col) = x; }
                    }
            }
    }
};


struct EpiResNormStats {
    const float* res; bf16_t* Hb; float* ss; unsigned char* H8;
    __device__ __forceinline__ void operator()(const f32x4 (&acc)[2][2][4][2], const GUnit& u, int wr, int wc, int fr, int fq) const {
        const int row0 = u.row0 + wr * 64 + fr, col0 = u.col0 + wc * 32 + 4 * fq;
#pragma unroll
        for (int ai = 0; ai < 2; ++ai)
#pragma unroll
            for (int m = 0; m < 4; ++m) {
                const int row = row0 + ai * HALF + m * 16;
                const size_t ro = (size_t)row * 1024;
                float sq = 0.f;
#pragma unroll
                for (int bj = 0; bj < 2; ++bj)
#pragma unroll
                    for (int n = 0; n < 2; ++n) {
                        const int col = col0 + bj * HALF + n * 16;
                        const f32x4 x = acc[ai][bj][m][n] + *(const f32x4*)(res + ro + col);
                        uint2 o; o.x = cvt_pk_bf16(x[0], x[1]); o.y = cvt_pk_bf16(x[2], x[3]);
                        *(uint2*)(Hb + ro + col) = o;
                        *(unsigned*)(H8 + ro + col) = pk4_fp8(x[0], x[1], x[2], x[3]);
                        sq += x[0] * x[0] + x[1] * x[1] + x[2] * x[2] + x[3] * x[3];
                    }
                sq += __shfl_xor(sq, 16); sq += __shfl_xor(sq, 32);
                if (fq == 0) ss[(size_t)row * 16 + (u.col0 >> 8) * 4 + wc] = sq;
            }
    }
};
struct EpiBf16RowScale {
    bf16_t* O; const float* ss; float scale;
    __device__ __forceinline__ void operator()(const f32x4 (&acc)[2][2][4][2], const GUnit& u, int wr, int wc, int fr, int fq) const {
        const int row0 = u.row0 + wr * 64 + fr, col0 = u.col0 + wc * 32 + 4 * fq;
#pragma unroll
        for (int ai = 0; ai < 2; ++ai)
#pragma unroll
            for (int m = 0; m < 4; ++m) {
                const int row = row0 + ai * HALF + m * 16;
                const f32x4* sp = (const f32x4*)(ss + (size_t)row * 16);
                const f32x4 s0 = sp[0], s1 = sp[1], s2 = sp[2], s3 = sp[3];
                const float tot = (((s0[0] + s0[1]) + (s0[2] + s0[3])) + ((s1[0] + s1[1]) + (s1[2] + s1[3]))) + (((s2[0] + s2[1]) + (s2[2] + s2[3])) + ((s3[0] + s3[1]) + (s3[2] + s3[3])));
                const float rs = rsqrtf(tot * (1.f / 1024.f) + 1e-5f) * scale;
                bf16_t* rowp = O + (size_t)row * 1024 + col0;
#pragma unroll
                for (int bj = 0; bj < 2; ++bj)
#pragma unroll
                    for (int n = 0; n < 2; ++n) { const f32x4 x = acc[ai][bj][m][n] * rs; uint2 o; o.x = cvt_pk_bf16(x[0], x[1]); o.y = cvt_pk_bf16(x[2], x[3]); *(uint2*)(rowp + bj * HALF + n * 16) = o; }
            }
    }
};

struct EpiBf16Res {
    bf16_t* H; float scale;
    __device__ __forceinline__ void operator()(const f32x4 (&acc)[2][2][4][2], const GUnit& u, int wr, int wc, int fr, int fq) const {
        const int row0 = u.row0 + wr * 64 + fr, col0 = u.col0 + wc * 32 + 4 * fq;
#pragma unroll
        for (int ai = 0; ai < 2; ++ai)
#pragma unroll
            for (int m = 0; m < 4; ++m) {
                bf16_t* rowp = H + (size_t)(row0 + ai * HALF + m * 16) * 1024 + col0;
#pragma unroll
                for (int bj = 0; bj < 2; ++bj)
#pragma unroll
                    for (int n = 0; n < 2; ++n) {
                        const uint2 r = *(const uint2*)(rowp + bj * HALF + n * 16);
                        const f32x4 a = acc[ai][bj][m][n] * scale;
                        uint2 o; o.x = cvt_pk_bf16(a[0] + __uint_as_float(r.x << 16), a[1] + __uint_as_float(r.x & 0xffff0000u)); o.y = cvt_pk_bf16(a[2] + __uint_as_float(r.y << 16), a[3] + __uint_as_float(r.y & 0xffff0000u));
                        *(uint2*)(rowp + bj * HALF + n * 16) = o;
                    }
            }
    }
};
struct EpiBf16S {
    bf16_t* O; int ldc; float scale;
    __device__ __forceinline__ void operator()(const f32x4 (&acc)[2][2][4][2], const GUnit& u, int wr, int wc, int fr, int fq) const {
        const int row0 = u.row0 + wr * 64 + fr, col0 = u.col0 + wc * 32 + 4 * fq;
#pragma unroll
        for (int ai = 0; ai < 2; ++ai)
#pragma unroll
            for (int m = 0; m < 4; ++m) {
                bf16_t* rowp = O + (size_t)(row0 + ai * HALF + m * 16) * ldc + col0;
#pragma unroll
                for (int bj = 0; bj < 2; ++bj)
#pragma unroll
                    for (int n = 0; n < 2; ++n) { const f32x4 x = acc[ai][bj][m][n] * scale; uint2 o; o.x = cvt_pk_bf16(x[0], x[1]); o.y = cvt_pk_bf16(x[2], x[3]); *(uint2*)(rowp + bj * HALF + n * 16) = o; }
            }
    }
};
struct EpiXkv {
    bf16_t *xk, *xvT;
    __device__ __forceinline__ void operator()(const f32x4 (&acc)[2][2][4][2], const GUnit& u, int wr, int wc, int fr, int fq) const {
        const int row0 = u.row0 + wr * 64 + fr, col0 = u.col0 + wc * 32 + 4 * fq;
        const bool isv = u.col0 >= 1024;
#pragma unroll
        for (int ai = 0; ai < 2; ++ai)
#pragma unroll
            for (int m = 0; m < 4; ++m) {
                const int row = row0 + ai * HALF + m * 16, b = row >> 8, key = row & 255;
#pragma unroll
                for (int bj = 0; bj < 2; ++bj)
#pragma unroll
                    for (int n = 0; n < 2; ++n) {
                        const int col = (col0 + bj * HALF + n * 16) & 1023, h = col >> 8, d = col & 255;
                        const f32x4 x = acc[ai][bj][m][n];
                        uint2 o; o.x = cvt_pk_bf16_acc(x[0], x[1]); o.y = cvt_pk_bf16_acc(x[2], x[3]);
                        if (!isv) *(uint2*)(xk + ((size_t)(b * 4 + h) * 256 + key) * 256 + d) = o;
                        else { bf16_t* base = xvT + ((size_t)(b * 4 + h) * 256 + d) * 256 + key;
                               base[0] = (bf16_t)(o.x & 0xffff); base[256] = (bf16_t)(o.x >> 16); base[512] = (bf16_t)(o.y & 0xffff); base[768] = (bf16_t)(o.y >> 16); }
                    }
            }
    }
};

struct EpiMixIn {
    bf16_t *q, *kk  , *vt  , *u, *cb; float* gates; const float* cosT; const float* sinT;
    __device__ __forceinline__ void operator()(const f32x4 (&acc)[2][2][4][2], const GUnit& un, int wr, int wc, int fr, int fq) const {
        const int pn = un.col0 >> 8, w1 = wc & 1, w2 = wc >> 1, dlo = 16 * w1 + 4 * fq;
#pragma unroll
        for (int ai = 0; ai < 2; ++ai)
#pragma unroll
            for (int m = 0; m < 4; ++m) {
                const int t = un.row0 + ai * HALF + wr * 64 + m * 16 + fr, b = t >> 11, sq = t & 2047;
                if (pn <= 4) {
                    const f32x4 cv = *(const f32x4*)(cosT + (size_t)t * 32 + dlo), sv = *(const f32x4*)(sinT + (size_t)t * 32 + dlo);
#pragma unroll
                    for (int bj = 0; bj < 2; ++bj) {
                        const int blk = 2 * bj + w2;
                        f32x4 x0 = acc[ai][bj][m][0], x1 = acc[ai][bj][m][1];
                        const bool rope = (pn < 2) || (bj == 0);
                        if (rope) { const f32x4 r0 = x0 * cv - x1 * sv, r1 = x1 * cv + x0 * sv; x0 = r0; x1 = r1; }
                        if (pn < 2) { x0 *= QS; x1 *= QS; }
                        uint2 o0, o1; o0.x = cvt_pk_bf16_acc(x0[0], x0[1]); o0.y = cvt_pk_bf16_acc(x0[2], x0[3]); o1.x = cvt_pk_bf16_acc(x1[0], x1[1]); o1.y = cvt_pk_bf16_acc(x1[2], x1[3]);
                        if (pn < 2) {
                            bf16_t* dst = q + (size_t)t * 512 + (pn * 4 + blk) * 64 + dlo;
                            *(uint2*)dst = o0; *(uint2*)(dst + 32) = o1;
                        } else {
                            const int g = blk & 1;
                            const size_t rowi = (size_t)(b * 2 + g) * S + sq;
                            if (bj == 0 || pn == 2) {
                                const int ki = (pn == 2) ? bj : pn - 1;
                                bf16_t* dst = kk + (size_t)ki * ((size_t)T * 128) + rowi * 64 + dlo;
                                *(uint2*)dst = o0; *(uint2*)(dst + 32) = o1;
                            } else {
                                bf16_t* base = vt + (size_t)(pn - 3) * ((size_t)T * 128) + ((size_t)(b * 2 + g) * 64 + dlo) * S + sq;
                                base[0 * S] = (bf16_t)(o0.x & 0xffff); base[1 * S] = (bf16_t)(o0.x >> 16); base[2 * S] = (bf16_t)(o0.y & 0xffff); base[3 * S] = (bf16_t)(o0.y >> 16);
                                base[32 * S] = (bf16_t)(o1.x & 0xffff); base[33 * S] = (bf16_t)(o1.x >> 16); base[34 * S] = (bf16_t)(o1.y & 0xffff); base[35 * S] = (bf16_t)(o1.y >> 16);
                            }
                        }
                    }
                } else if (pn < 9) {
#pragma unroll
                    for (int n = 0; n < 2; ++n) {
                        const f32x4 x = acc[ai][0][m][n] * acc[ai][1][m][n];
                        uint2 o; o.x = cvt_pk_bf16(x[0], x[1]); o.y = cvt_pk_bf16(x[2], x[3]);
                        *(uint2*)(u + (size_t)t * 512 + (pn - 5) * 128 + w2 * 64 + n * 32 + dlo) = o;
                    }
                } else if (pn < 11) {
#pragma unroll
                    for (int bj = 0; bj < 2; ++bj)
#pragma unroll
                        for (int n = 0; n < 2; ++n) {
                            const f32x4 x = acc[ai][bj][m][n];
                            uint2 o; o.x = cvt_pk_bf16_acc(x[0], x[1]); o.y = cvt_pk_bf16_acc(x[2], x[3]);
                            *(uint2*)(cb + (size_t)t * 512 + (pn - 9) * 256 + bj * 128 + w2 * 64 + n * 32 + dlo) = o;
                        }
                } else {
                    if (w2 == 0 && dlo < 24) {
                        const f32x4 x = acc[ai][0][m][0];
                        f32x4 sg;
#pragma unroll
                        for (int j = 0; j < 4; ++j) sg[j] = 1.f / (1.f + __expf(-x[j]));
                        *(f32x4*)(gates + (size_t)t * 24 + dlo) = sg;
                    }
                }
            }
    }
};

template <int NPN>
struct MoeOrder {
    const char* A; const char* Bt; const int* tile_e; int nunits, G, c; size_t bt_expert_bytes;
    __device__ void init(const void* A_, const void* Bt_, const int* tile_e_, int ntiles, size_t bt_expert_bytes_, int G_, int c_) { A = (const char*)A_; Bt = (const char*)Bt_; tile_e = tile_e_; nunits = ntiles * NPN; bt_expert_bytes = bt_expert_bytes_; G = G_; c = c_; }
    __device__ bool next(int i, GUnit& u) const {
        const int L = i * G + c; if (L >= nunits) return false;
        const int tl = L / NPN, pn = L % NPN, e = tile_e[tl];
        u.A = A + (size_t)tl * BM * 2048; u.B = Bt + (size_t)e * bt_expert_bytes + (size_t)pn * BM * 2048; u.row0 = tl * BM; u.col0 = pn * BM; u.aux = e; return true;
    }
};
struct EpiSwiglu {
    bf16_t* H; const float* bias;
    __device__ __forceinline__ void operator()(const f32x4 (&acc)[2][2][4][2], const GUnit& u, int wr, int wc, int fr, int fq) const {
        const int row0 = u.row0 + wr * 64 + fr, pn = u.col0 >> 8, cl0 = wc * 32 + 4 * fq;
        const float* bg = bias + (size_t)u.aux * 2048 + pn * 128 + cl0;
        f32x4 bgv[2], buv[2];
#pragma unroll
        for (int n = 0; n < 2; ++n) { bgv[n] = *(const f32x4*)(bg + n * 16); buv[n] = *(const f32x4*)(bg + 1024 + n * 16); }
#pragma unroll
        for (int ai = 0; ai < 2; ++ai)
#pragma unroll
            for (int m = 0; m < 4; ++m) {
                bf16_t* rowp = H + (size_t)(row0 + ai * HALF + m * 16) * 1024 + pn * 128 + cl0;
#pragma unroll
                for (int n = 0; n < 2; ++n) {
                    const f32x4 g4 = acc[ai][0][m][n] + bgv[n], u4 = acc[ai][1][m][n] + buv[n];
                    float h[4];
#pragma unroll
                    for (int j = 0; j < 4; ++j) {
                        const float g = fminf(g4[j], 7.f), uu = fminf(fmaxf(u4[j], -7.f), 7.f);
                        h[j] = (uu + 1.f) * (g / (1.f + __expf(-1.702f * g)));
                    }
                    uint2 o; o.x = cvt_pk_bf16(h[0], h[1]); o.y = cvt_pk_bf16(h[2], h[3]);
                    *(uint2*)(rowp + n * 16) = o;
                }
            }
    }
};
struct EpiDownScale {
    bf16_t* O; const float* bias; const float* w_buf;
    __device__ __forceinline__ void operator()(const f32x4 (&acc)[2][2][4][2], const GUnit& u, int wr, int wc, int fr, int fq) const {
        const int row0 = u.row0 + wr * 64 + fr, col0 = u.col0 + wc * 32 + 4 * fq;
        f32x4 bv[2][2];
#pragma unroll
        for (int bj = 0; bj < 2; ++bj)
#pragma unroll
            for (int n = 0; n < 2; ++n) bv[bj][n] = *(const f32x4*)(bias + (size_t)u.aux * 1024 + col0 + bj * HALF + n * 16);
#pragma unroll
        for (int ai = 0; ai < 2; ++ai)
#pragma unroll
            for (int m = 0; m < 4; ++m) {
                const int row = row0 + ai * HALF + m * 16;
                const float w = w_buf[row];
                bf16_t* rowp = O + (size_t)row * 1024 + col0;
#pragma unroll
                for (int bj = 0; bj < 2; ++bj)
#pragma unroll
                    for (int n = 0; n < 2; ++n) {
                        const f32x4 x = (acc[ai][bj][m][n] + bv[bj][n]) * w;
                        uint2 o; o.x = cvt_pk_bf16(x[0], x[1]); o.y = cvt_pk_bf16(x[2], x[3]);
                        *(uint2*)(rowp + bj * HALF + n * 16) = o;
                    }
            }
    }
};

constexpr float W8_SCALE = 64.f, W8_INV = 1.f / 64.f;
__device__ __forceinline__ unsigned pk4_fp8(float a, float b, float c, float d) { unsigned w = 0; w = __builtin_amdgcn_cvt_pk_fp8_f32(a, b, w, false); w = __builtin_amdgcn_cvt_pk_fp8_f32(c, d, w, true); return w; }
struct EpiSwigluF8out {
    unsigned char* H; const float* bias;
    __device__ __forceinline__ void operator()(const f32x4 (&acc)[2][2][4][2], const GUnit& u, int wr, int wc, int fr, int fq) const {
        const int row0 = u.row0 + wr * 64 + fr, pn = u.col0 >> 8, cl0 = wc * 32 + 4 * fq;
        const float* bg = bias + (size_t)u.aux * 2048 + pn * 128 + cl0;
        f32x4 bgv[2], buv[2];
#pragma unroll
        for (int n = 0; n < 2; ++n) { bgv[n] = *(const f32x4*)(bg + n * 16); buv[n] = *(const f32x4*)(bg + 1024 + n * 16); }
#pragma unroll
        for (int ai = 0; ai < 2; ++ai)
#pragma unroll
            for (int m = 0; m < 4; ++m) {
                unsigned char* rowp = H + (size_t)(row0 + ai * HALF + m * 16) * 1024 + pn * 128 + cl0;
#pragma unroll
                for (int n = 0; n < 2; ++n) {
                    const f32x4 g4 = acc[ai][0][m][n] + bgv[n], u4 = acc[ai][1][m][n] + buv[n];
                    float h[4];
#pragma unroll
                    for (int j = 0; j < 4; ++j) {
                        const float g = fminf(g4[j], 7.f), uu = fminf(fmaxf(u4[j], -7.f), 7.f);
                        h[j] = (uu + 1.f) * (g / (1.f + __expf(-1.702f * g)));
                    }
                    *(unsigned*)(rowp + n * 16) = pk4_fp8(h[0], h[1], h[2], h[3]);
                }
            }
    }
};
struct EpiSwigluF8 {
    unsigned char* H; const float* bias;
    __device__ __forceinline__ void operator()(const f32x4 (&acc)[2][2][4][2], const GUnit& u, int wr, int wc, int fr, int fq) const {
        const int row0 = u.row0 + wr * 64 + fr, pn = u.col0 >> 8, cl0 = wc * 32 + 4 * fq;
        const float* bg = bias + (size_t)u.aux * 2048 + pn * 128 + cl0;
        f32x4 bgv[2], buv[2];
#pragma unroll
        for (int n = 0; n < 2; ++n) { bgv[n] = *(const f32x4*)(bg + n * 16); buv[n] = *(const f32x4*)(bg + 1024 + n * 16); }
#pragma unroll
        for (int ai = 0; ai < 2; ++ai)
#pragma unroll
            for (int m = 0; m < 4; ++m) {
                unsigned char* rowp = H + (size_t)(row0 + ai * HALF + m * 16) * 1024 + pn * 128 + cl0;
#pragma unroll
                for (int n = 0; n < 2; ++n) {
                    const f32x4 g4 = acc[ai][0][m][n] * W8_INV + bgv[n], u4 = acc[ai][1][m][n] * W8_INV + buv[n];
                    float h[4];
#pragma unroll
                    for (int j = 0; j < 4; ++j) {
                        const float g = fminf(g4[j], 7.f), uu = fminf(fmaxf(u4[j], -7.f), 7.f);
                        h[j] = (uu + 1.f) * g * __builtin_amdgcn_rcpf(1.f + __builtin_amdgcn_exp2f(-1.702f * 1.4426950408889634f * g));
                    }
                    *(unsigned*)(rowp + n * 16) = pk4_fp8(h[0], h[1], h[2], h[3]);
                }
            }
    }
};
struct EpiDownScaleF8 {
    unsigned char* O; const float* bias; const float* w_buf;
    __device__ __forceinline__ void operator()(const f32x4 (&acc)[2][2][4][2], const GUnit& u, int wr, int wc, int fr, int fq) const {
        const int row0 = u.row0 + wr * 64 + fr, col0 = u.col0 + wc * 32 + 4 * fq;
        f32x4 bv[2][2];
#pragma unroll
        for (int bj = 0; bj < 2; ++bj)
#pragma unroll
            for (int n = 0; n < 2; ++n) bv[bj][n] = *(const f32x4*)(bias + (size_t)u.aux * 1024 + col0 + bj * HALF + n * 16);
#pragma unroll
        for (int ai = 0; ai < 2; ++ai)
#pragma unroll
            for (int m = 0; m < 4; ++m) {
                const int row = row0 + ai * HALF + m * 16;
                const float w = w_buf[row] * 8.f;
                unsigned char* rowp = O + (size_t)row * 1024 + col0;
#pragma unroll
                for (int bj = 0; bj < 2; ++bj)
#pragma unroll
                    for (int n = 0; n < 2; ++n) {
                        const f32x4 x = (acc[ai][bj][m][n] * W8_INV + bv[bj][n]) * w;
                        *(unsigned*)(rowp + bj * HALF + n * 16) = pk4_fp8(x[0], x[1], x[2], x[3]);
                    }
            }
    }
};
template <int NPN>
struct MoeOrderB {
    const char* A; const char* Bt; const int* tile_e; int nunits, G, c; size_t bt_expert_bytes; unsigned row_b;
    __device__ void init(const void* A_, const void* Bt_, const int* tile_e_, int ntiles, size_t bt_expert_bytes_, unsigned row_b_, int G_, int c_) { A = (const char*)A_; Bt = (const char*)Bt_; tile_e = tile_e_; nunits = ntiles * NPN; bt_expert_bytes = bt_expert_bytes_; row_b = row_b_; G = G_; c = c_; }
    __device__ bool next(int i, GUnit& u) const {
        const int L = i * G + c; if (L >= nunits) return false;
        const int tl = L / NPN, pn = L % NPN, e = tile_e[tl];
        u.A = A + (size_t)tl * BM * row_b; u.B = Bt + (size_t)e * bt_expert_bytes + (size_t)pn * BM * row_b; u.row0 = tl * BM; u.col0 = pn * BM; u.aux = e; return true;
    }
};
}


__device__ __forceinline__ void posbias_wave(int n, int lane, const float* __restrict__ pos, const float* __restrict__ w1, const float* __restrict__ b1, float* __restrict__ b1p) {
    float acc = 0.f;
#pragma unroll 8
    for (int i = 0; i < 32; ++i) { const int k = lane + 64 * i; acc += pos[k] * w1[(size_t)k * 256 + n]; }
    acc = wave_sum(acc);
    if (lane == 0) b1p[n] = acc + b1[n];
}
__device__ __forceinline__ void p_cmp_finalize(char* lds, const float* __restrict__ Pab_k, const float* __restrict__ Pab_v, const float* __restrict__ b1p_k, const float* __restrict__ b1p_v,
                                               const float* __restrict__ w2k, const float* __restrict__ w2v, pg::bf16_t* __restrict__ kc, pg::bf16_t* __restrict__ vcT, int wg, int nwg) {
    const int lane = threadIdx.x & 63, wv = threadIdx.x >> 6;
    float* hs = (float*)lds + wv * 256;
    for (int it = wg * 8 + wv; it < 2 * 16 * 128; it += nwg * 8) {
        const int which = it >> 11, row = it & 2047, bg = row >> 7, c = row & 127;
        const float* P = which ? Pab_v : Pab_k; const float* bp = which ? b1p_v : b1p_k; const float* w2 = which ? w2v : w2k;
        float o = 0.f;
        if (c < 127) {
#pragma unroll
            for (int i = 0; i < 4; ++i) { const int n = lane + 64 * i; hs[n] = gelu_tanh(P[(size_t)row * 512 + n] + P[(size_t)(row + 1) * 512 + 256 + n] + bp[n]); }
            __builtin_amdgcn_s_waitcnt(0);
            for (int n = 0; n < 256; ++n) o += hs[n] * w2[n * 64 + lane];
        }
        if (which == 0) kc[(size_t)row * 64 + lane] = pg::f2bf(o); else vcT[((size_t)bg * 64 + lane) * 128 + c] = pg::f2bf(o);
    }
}

namespace at {
using pg::bf16_t;
typedef short bf16x8 __attribute__((ext_vector_type(8)));
typedef float f32x16 __attribute__((ext_vector_type(16)));
typedef float f32x4 __attribute__((ext_vector_type(4)));
constexpr int TROW = 144, TILE_B = 64 * TROW;
#define AT_MFMA(a, b, c) __builtin_amdgcn_mfma_f32_32x32x16_bf16(a, b, c, 0, 0, 0)
__device__ __forceinline__ bf16x8 pack8(const f32x16& p, int s8) {
    union { unsigned u[4]; bf16x8 v; } x;
#pragma unroll
    for (int i = 0; i < 4; ++i) x.u[i] = pg::cvt_pk_bf16(p[s8 + 2 * i], p[s8 + 2 * i + 1]);
    return x.v;
}
template <int MODE>
__device__ __forceinline__ void attn64_unit(char* lds, int b, int g, int tq, const bf16_t* __restrict__ Q, const bf16_t* __restrict__ Kh, const bf16_t* __restrict__ VT,
                                            const unsigned* __restrict__ selmask, bf16_t* __restrict__ out, const bf16_t* __restrict__ o_cmp, const bf16_t* __restrict__ o_win, const float* __restrict__ gates) {
    const int tid = opaque_tid(), lane = tid & 63, r32 = lane & 31, hi = lane >> 5;
    const int wid = __builtin_amdgcn_readfirstlane(tid >> 6), hl = wid >> 1, qs = wid & 1;
    const int ql = 32 * qs + r32, qpos = tq * 64 + ql, h = g * 4 + hl;
    const size_t trow = (size_t)b * S + qpos;
    const bf16_t* Kb = Kh + (size_t)(b * 2 + g) * S * 64;
    const bf16_t* Vb = VT + (size_t)(b * 2 + g) * 64 * S;
    const int srow = tid >> 3, sch = tid & 7;
    const int kst = srow * TROW + sch * 16;
    const int vst = TILE_B + srow * TROW + ((sch >> 1) * 16 + (sch & 1) * 4) * 2;
    bf16x8 qf[4];
#pragma unroll
    for (int d0 = 0; d0 < 4; ++d0) qf[d0] = *(const bf16x8*)(Q + trow * 512 + h * 64 + 16 * d0 + 8 * hi);
    unsigned msk = 0xffffffffu;
    if (MODE == 0) msk = selmask[(size_t)(b * 2 + g) * S + qpos];
    const int nt = (MODE == 0) ? tq + 1 : (tq < 8 ? tq + 1 : 9);
    f32x16 o0, o1;
#pragma unroll
    for (int r = 0; r < 16; ++r) { o0[r] = 0.f; o1[r] = 0.f; }
    float m = -INFINITY, l = 0.f;
    uint4 kreg, vreg;
    kreg = *(const uint4*)(Kb + (size_t)(tq * 64 + srow) * 64 + sch * 8); vreg = *(const uint4*)(Vb + (size_t)srow * S + tq * 64 + sch * 8);
    __syncthreads();
    *(uint4*)(lds + kst) = kreg; *(uint2*)(lds + vst) = make_uint2(vreg.x, vreg.y); *(uint2*)(lds + vst + 16) = make_uint2(vreg.z, vreg.w);
    __syncthreads();
    for (int i = 0; i < nt; ++i) {
        if (i + 1 < nt) { const int tile = tq - i - 1; kreg = *(const uint4*)(Kb + (size_t)(tile * 64 + srow) * 64 + sch * 8); vreg = *(const uint4*)(Vb + (size_t)srow * S + tile * 64 + sch * 8); }
        const char* kb_ = lds + (i & 1) * 2 * TILE_B; const char* vb_ = kb_ + TILE_B;
        f32x16 p0, p1;
#pragma unroll
        for (int r = 0; r < 16; ++r) { p0[r] = 0.f; p1[r] = 0.f; }
#pragma unroll
        for (int d0 = 0; d0 < 4; ++d0) {
            const bf16x8 kf0 = *(const bf16x8*)(kb_ + r32 * TROW + d0 * 32 + hi * 16), kf1 = *(const bf16x8*)(kb_ + (32 + r32) * TROW + d0 * 32 + hi * 16);
            p0 = AT_MFMA(kf0, qf[d0], p0); p1 = AT_MFMA(kf1, qf[d0], p1);
        }
        if (i == 0) {
#pragma unroll
            for (int r = 0; r < 16; ++r) { const int kl = (r & 3) + 8 * (r >> 2) + 4 * hi; if (kl > ql) p0[r] = -INFINITY; if (kl + 32 > ql) p1[r] = -INFINITY; }
        } else if (MODE == 1) {
            if (i == 8) {
#pragma unroll
                for (int r = 0; r < 16; ++r) { const int kl = (r & 3) + 8 * (r >> 2) + 4 * hi; if (kl <= ql) p0[r] = -INFINITY; if (kl + 32 <= ql) p1[r] = -INFINITY; }
            }
        } else {
            if (!((msk >> (tq - i)) & 1u)) {
#pragma unroll
                for (int r = 0; r < 16; ++r) { p0[r] = -INFINITY; p1[r] = -INFINITY; }
            }
        }
        float mx = fmaxf(p0[0], p1[0]);
#pragma unroll
        for (int r = 1; r < 16; ++r) mx = fmaxf(mx, fmaxf(p0[r], p1[r]));
        mx = fmaxf(mx, lane_xor32(mx));
        if (i == 0) m = mx;
        else if (__builtin_amdgcn_ballot_w64(mx > m + 8.f) != 0ull) {
            const float mn = fmaxf(m, mx), alpha = __builtin_amdgcn_exp2f(m - mn);
            m = mn; l *= alpha;
#pragma unroll
            for (int r = 0; r < 16; ++r) { o0[r] *= alpha; o1[r] *= alpha; }
        }
        float ls = 0.f;
#pragma unroll
        for (int r = 0; r < 16; ++r) { p0[r] = __builtin_amdgcn_exp2f(p0[r] - m); p1[r] = __builtin_amdgcn_exp2f(p1[r] - m); ls += p0[r] + p1[r]; }
        l += ls;
        bf16x8 pb[4];
        pb[0] = pack8(p0, 0); pb[1] = pack8(p0, 8); pb[2] = pack8(p1, 0); pb[3] = pack8(p1, 8);
#pragma unroll
        for (int ks = 0; ks < 4; ++ks) {
            const bf16x8 vf0 = *(const bf16x8*)(vb_ + r32 * TROW + ks * 32 + hi * 16), vf1 = *(const bf16x8*)(vb_ + (32 + r32) * TROW + ks * 32 + hi * 16);
            o0 = AT_MFMA(vf0, pb[ks], o0); o1 = AT_MFMA(vf1, pb[ks], o1);
        }
        if (i + 1 < nt) {
            char* nb = lds + ((i + 1) & 1) * 2 * TILE_B;
            *(uint4*)(nb + kst) = kreg; *(uint2*)(nb + vst) = make_uint2(vreg.x, vreg.y); *(uint2*)(nb + vst + 16) = make_uint2(vreg.z, vreg.w);
        }
        __syncthreads();
    }
    const float lt = l + lane_xor32(l), inv = 1.f / lt;
    const size_t obase = trow * 512 + h * 64 + 4 * hi;
    float g0 = 0.f, g1 = inv, g2 = 0.f;
    if (MODE == 0) { g0 = gates[trow * 24 + h * 3 + 0]; g1 = gates[trow * 24 + h * 3 + 1] * inv; g2 = gates[trow * 24 + h * 3 + 2]; }
#pragma unroll
    for (int rr = 0; rr < 4; ++rr)
#pragma unroll
        for (int dh = 0; dh < 2; ++dh) {
            const f32x16& oo = dh ? o1 : o0;
            float x0 = oo[4 * rr] * g1, x1 = oo[4 * rr + 1] * g1, x2 = oo[4 * rr + 2] * g1, x3 = oo[4 * rr + 3] * g1;
            const size_t idx = obase + 32 * dh + 8 * rr;
            if (MODE == 0) {
                const uint2 c = *(const uint2*)(o_cmp + idx), w = *(const uint2*)(o_win + idx);
                x0 += g0 * __uint_as_float(c.x << 16) + g2 * __uint_as_float(w.x << 16); x1 += g0 * __uint_as_float(c.x & 0xffff0000u) + g2 * __uint_as_float(w.x & 0xffff0000u);
                x2 += g0 * __uint_as_float(c.y << 16) + g2 * __uint_as_float(w.y << 16); x3 += g0 * __uint_as_float(c.y & 0xffff0000u) + g2 * __uint_as_float(w.y & 0xffff0000u);
            }
            uint2 o; o.x = pg::cvt_pk_bf16(x0, x1); o.y = pg::cvt_pk_bf16(x2, x3);
            *(uint2*)(out + idx) = o;
        }
}
template <int MODE>
__device__ __forceinline__ void p_attn64(char* lds, const bf16_t* Q, const bf16_t* Kh, const bf16_t* VT, const unsigned* selmask, bf16_t* out, const bf16_t* o_cmp, const bf16_t* o_win, const float* gates, int wg, int nwg) {
    for (int item = wg; item < 256; item += nwg) {
        const int bg = item >> 4, j = item & 15;
        attn64_unit<MODE>(lds, bg >> 1, bg & 1, 31 - j, Q, Kh, VT, selmask, out, o_cmp, o_win, gates);
        attn64_unit<MODE>(lds, bg >> 1, bg & 1, j, Q, Kh, VT, selmask, out, o_cmp, o_win, gates);
    }
}

constexpr int CK_ROW = 144, CV_ROW = 272, CK_B = 128 * CK_ROW, CV_B = 64 * CV_ROW, CP_OFF = CK_B + CV_B, CI_OFF = CP_OFF + 4 * 64 * 32 * 4, CMP_LDS = CI_OFF + 64 * 32 * 4;
__device__ __forceinline__ void cmp_unit(char* lds, int b, int g, int tq, const bf16_t* __restrict__ Q, const bf16_t* __restrict__ kc, const bf16_t* __restrict__ vcT,
                                         bf16_t* __restrict__ out, unsigned* __restrict__ selmask) {
    const int tid = opaque_tid(), lane = tid & 63, r32 = lane & 31, hi = lane >> 5;
    const int wid = __builtin_amdgcn_readfirstlane(tid >> 6), hl = wid >> 1, qs = wid & 1;
    const int ql = 32 * qs + r32, qpos = tq * 64 + ql, h = g * 4 + hl, bg = b * 2 + g;
    const size_t trow = (size_t)b * S + qpos;
    __syncthreads();
#pragma unroll
    for (int i = 0; i < 2; ++i) {
        const int ch = tid + 512 * i;
        { const int row = ch >> 3, c8 = ch & 7; *(uint4*)(lds + row * CK_ROW + c8 * 16) = *(const uint4*)(kc + ((size_t)bg * 128 + row) * 64 + c8 * 8); }
        { const int row = ch >> 4, c16 = ch & 15; const uint4 x = *(const uint4*)(vcT + ((size_t)bg * 64 + row) * 128 + c16 * 8);
          char* dst = lds + CK_B + row * CV_ROW + ((c16 >> 1) * 16 + (c16 & 1) * 4) * 2; *(uint2*)dst = make_uint2(x.x, x.y); *(uint2*)(dst + 16) = make_uint2(x.z, x.w); }
    }
    bf16x8 qf[4];
#pragma unroll
    for (int d0 = 0; d0 < 4; ++d0) qf[d0] = *(const bf16x8*)(Q + trow * 512 + h * 64 + 16 * d0 + 8 * hi);
    __syncthreads();
    f32x16 p[4];
#pragma unroll
    for (int kh = 0; kh < 4; ++kh) {
#pragma unroll
        for (int r = 0; r < 16; ++r) p[kh][r] = 0.f;
#pragma unroll
        for (int d0 = 0; d0 < 4; ++d0) { const bf16x8 kf = *(const bf16x8*)(lds + (32 * kh + r32) * CK_ROW + d0 * 32 + hi * 16); p[kh] = AT_MFMA(kf, qf[d0], p[kh]); }
    }
    float mx = -1e30f;
#pragma unroll
    for (int kh = 0; kh < 4; ++kh)
#pragma unroll
        for (int r = 0; r < 16; ++r) { const int c = 32 * kh + (r & 3) + 8 * (r >> 2) + 4 * hi; if (16 * c + 31 > qpos) p[kh][r] = -1e30f; mx = fmaxf(mx, p[kh][r]); }
    mx = fmaxf(mx, lane_xor32(mx));
    float ls = 0.f;
#pragma unroll
    for (int kh = 0; kh < 4; ++kh)
#pragma unroll
        for (int r = 0; r < 16; ++r) { p[kh][r] = __builtin_amdgcn_exp2f(p[kh][r] - mx); ls += p[kh][r]; }
    ls += lane_xor32(ls);
    const float inv = (mx > -1e29f) ? 1.f / ls : 0.f;
#pragma unroll
    for (int kh = 0; kh < 4; ++kh)
#pragma unroll
        for (int r = 0; r < 16; ++r) p[kh][r] *= inv;
    f32x16 o0, o1;
#pragma unroll
    for (int r = 0; r < 16; ++r) { o0[r] = 0.f; o1[r] = 0.f; }
#pragma unroll
    for (int ks = 0; ks < 8; ++ks) {
        const bf16x8 pb = pack8(p[ks >> 1], (ks & 1) * 8);
        const bf16x8 vf0 = *(const bf16x8*)(lds + CK_B + r32 * CV_ROW + ks * 32 + hi * 16), vf1 = *(const bf16x8*)(lds + CK_B + (32 + r32) * CV_ROW + ks * 32 + hi * 16);
        o0 = AT_MFMA(vf0, pb, o0); o1 = AT_MFMA(vf1, pb, o1);
    }
    bf16_t* orow = out + trow * 512 + h * 64 + 4 * hi;
#pragma unroll
    for (int rr = 0; rr < 4; ++rr) {
        uint2 a, c; a.x = pg::cvt_pk_bf16_acc(o0[4 * rr], o0[4 * rr + 1]); a.y = pg::cvt_pk_bf16_acc(o0[4 * rr + 2], o0[4 * rr + 3]); c.x = pg::cvt_pk_bf16_acc(o1[4 * rr], o1[4 * rr + 1]); c.y = pg::cvt_pk_bf16_acc(o1[4 * rr + 2], o1[4 * rr + 3]);
        *(uint2*)(orow + 8 * rr) = a; *(uint2*)(orow + 32 + 8 * rr) = c;
    }
    float inn[16], car[16];
#pragma unroll
    for (int t = 0; t < 16; ++t) { const f32x16& pk = p[t >> 2]; const int r0 = 4 * (t & 3); car[t] = 0.5f * pk[r0 + 3]; inn[t] = pk[r0] + pk[r0 + 1] + pk[r0 + 2] + car[t]; }
    float* part = (float*)(lds + CP_OFF) + (hl * 64 + ql) * 32;
#pragma unroll
    for (int t = 0; t < 16; ++t) {
        const float co = lane_xor32(car[t]);
        const float cprev = t > 0 ? lane_xor32(car[t - 1]) : 0.f;
        part[2 * t + hi] = inn[t] + (hi ? co : cprev);
    }
    __syncthreads();
    float* impf = (float*)(lds + CI_OFF);
    const float* pall = (const float*)(lds + CP_OFF);
#pragma unroll
    for (int k = 0; k < 4; ++k) {
        const int idx = tid + 512 * k, q = idx >> 5, j = idx & 31, cur = tq;
        float imp = ((pall[(0 * 64 + q) * 32 + j] + pall[(1 * 64 + q) * 32 + j]) + pall[(2 * 64 + q) * 32 + j]) + pall[(3 * 64 + q) * 32 + j];
        if (j == 0 || j == cur || j == cur - 1) imp = 1e30f; else if (j > cur) imp = -1e30f;
        impf[idx] = imp;
    }
    __syncthreads();
#pragma unroll
    for (int k = 0; k < 4; ++k) {
        const int idx = tid + 512 * k, q = idx >> 5, j = idx & 31;
        const float mine = impf[idx];
        int rank = 0;
        for (int i = 0; i < 32; ++i) { const float x = impf[q * 32 + i]; rank += (x > mine || (x == mine && i < j)) ? 1 : 0; }
        const unsigned long long bal = __ballot(rank < 16);
        if ((lane & 31) == 0) selmask[(size_t)bg * S + tq * 64 + q] = (unsigned)(hi ? (bal >> 32) : (bal & 0xffffffffull));
    }
}
__device__ __forceinline__ void p_cmp_attn_fast(char* lds, const bf16_t* Q, const bf16_t* kc, const bf16_t* vcT, bf16_t* out, unsigned* selmask, int wg, int nwg) {
    for (int item = wg; item < 512; item += nwg) cmp_unit(lds, item >> 6, (item >> 5) & 1, item & 31, Q, kc, vcT, out, selmask);
}

constexpr int XK_ROW = 528, XV_ROW = 144, XK_B = 64 * XK_ROW, XV_B = 256 * XV_ROW;
typedef float f32x4v __attribute__((ext_vector_type(4)));
#define XT_MFMA(a, b, c) __builtin_amdgcn_mfma_f32_16x16x32_bf16(a, b, c, 0, 0, 0)
__device__ __forceinline__ void xattn_unit(char* lds, int b, int h, int qt, const bf16_t* __restrict__ Q, const bf16_t* __restrict__ xk, const bf16_t* __restrict__ xvT, unsigned char* __restrict__ out) {
    const int tid = opaque_tid(), lane = tid & 63, l15 = lane & 15, quad = lane >> 4;
    const int wid = __builtin_amdgcn_readfirstlane(tid >> 6);
    const size_t trow = (size_t)b * S + qt * 128 + wid * 16 + l15;
    const bf16_t* Kb = xk + (size_t)(b * 4 + h) * 256 * 256;
    const bf16_t* Vb = xvT + (size_t)(b * 4 + h) * 256 * 256;
    bf16x8 qf[8];
#pragma unroll
    for (int ds = 0; ds < 8; ++ds) qf[ds] = *(const bf16x8*)(Q + trow * 1024 + h * 256 + 32 * ds + 8 * quad);
    f32x4v o[16];
#pragma unroll
    for (int db = 0; db < 16; ++db) o[db] = (f32x4v){0.f, 0.f, 0.f, 0.f};
    float m = -INFINITY, l = 0.f;
    for (int kt = 0; kt < 4; ++kt) {
        __syncthreads();
#pragma unroll
        for (int i = 0; i < 4; ++i) {
            const int ch = tid + 512 * i;
            { const int row = ch >> 5, c = ch & 31; *(uint4*)(lds + row * XK_ROW + c * 16) = *(const uint4*)(Kb + (size_t)(kt * 64 + row) * 256 + c * 8); }
            { const int row = ch >> 3, c = ch & 7, cp = c & 3; const uint4 x = *(const uint4*)(Vb + (size_t)row * 256 + kt * 64 + c * 8);
              char* dst = lds + XK_B + row * XV_ROW + ((c >> 2) * 32 + 16 * (cp & 1) + 4 * (cp >> 1)) * 2; *(uint2*)dst = make_uint2(x.x, x.y); *(uint2*)(dst + 16) = make_uint2(x.z, x.w); }
        }
        __syncthreads();
        f32x4v sc[4];
#pragma unroll
        for (int kb = 0; kb < 4; ++kb) {
            sc[kb] = (f32x4v){0.f, 0.f, 0.f, 0.f};
#pragma unroll
            for (int ds = 0; ds < 8; ++ds) { const bf16x8 kf = *(const bf16x8*)(lds + (16 * kb + l15) * XK_ROW + ds * 64 + quad * 16); sc[kb] = XT_MFMA(kf, qf[ds], sc[kb]); }
        }
        float mx = -INFINITY;
#pragma unroll
        for (int kb = 0; kb < 4; ++kb)
#pragma unroll
            for (int r = 0; r < 4; ++r) mx = fmaxf(mx, sc[kb][r]);
        mx = fmaxf(mx, lane_xor16(mx)); mx = fmaxf(mx, lane_xor32(mx));
        const float mn = fmaxf(m, mx), alpha = __builtin_amdgcn_exp2f(m - mn);
        m = mn;
        float ls = 0.f;
#pragma unroll
        for (int kb = 0; kb < 4; ++kb)
#pragma unroll
            for (int r = 0; r < 4; ++r) { sc[kb][r] = __builtin_amdgcn_exp2f(sc[kb][r] - mn); ls += sc[kb][r]; }
        l = l * alpha + ls;
#pragma unroll
        for (int db = 0; db < 16; ++db) o[db] *= alpha;
#pragma unroll
        for (int k2 = 0; k2 < 2; ++k2) {
            union { unsigned u[4]; bf16x8 v; } pb;
            pb.u[0] = pg::cvt_pk_bf16(sc[2 * k2][0], sc[2 * k2][1]); pb.u[1] = pg::cvt_pk_bf16(sc[2 * k2][2], sc[2 * k2][3]);
            pb.u[2] = pg::cvt_pk_bf16(sc[2 * k2 + 1][0], sc[2 * k2 + 1][1]); pb.u[3] = pg::cvt_pk_bf16(sc[2 * k2 + 1][2], sc[2 * k2 + 1][3]);
#pragma unroll
            for (int db = 0; db < 16; ++db) { const bf16x8 vf = *(const bf16x8*)(lds + XK_B + (16 * db + l15) * XV_ROW + k2 * 64 + quad * 16); o[db] = XT_MFMA(vf, pb.v, o[db]); }
        }
    }
    l += lane_xor16(l); l += lane_xor32(l);
    const float inv = 1.f / l;
    unsigned char* orow = out + trow * 1024 + h * 256 + 4 * quad;
    const float inv16 = inv * 16.f;
#pragma unroll
    for (int db = 0; db < 16; ++db) *(unsigned*)(orow + 16 * db) = pg::pk4_fp8(o[db][0] * inv16, o[db][1] * inv16, o[db][2] * inv16, o[db][3] * inv16);
}
__device__ __forceinline__ void p_xattn_fast(char* lds, const bf16_t* Q, const bf16_t* xk, const bf16_t* xvT, unsigned char* out, int wg, int nwg) {
    for (int item = wg; item < 512; item += nwg) xattn_unit(lds, item >> 6, (item >> 4) & 3, item & 15, Q, xk, xvT, out);
}
}


namespace tl {
using pg::bf16_t; using pg::cvt_pk_bf16;
__device__ __forceinline__ float blo(unsigned u) { return __uint_as_float(u << 16); }
__device__ __forceinline__ float bhi(unsigned u) { return __uint_as_float(u & 0xffff0000u); }
__device__ __forceinline__ float ssq4(const float4& a) { return a.x * a.x + a.y * a.y + a.z * a.z + a.w * a.w; }

__device__ __forceinline__ void rmsnorm_rows(const float* __restrict__ in, const float* __restrict__ g, bf16_t* __restrict__ out, int rows, int gw, int nw, int lane) {
    float4 gv[4];
#pragma unroll
    for (int i = 0; i < 4; ++i) gv[i] = *(const float4*)(g + 256 * i + 4 * lane);
    for (int r0 = gw; r0 < rows; r0 += 2 * nw) {
        const int r1 = r0 + nw; const bool two = r1 < rows;
        float4 a[4], b[4];
#pragma unroll
        for (int i = 0; i < 4; ++i) { a[i] = *(const float4*)(in + (size_t)r0 * 1024 + 256 * i + 4 * lane); b[i] = two ? *(const float4*)(in + (size_t)r1 * 1024 + 256 * i + 4 * lane) : make_float4(0.f, 0.f, 0.f, 0.f); }
        float sa = ssq4(a[0]) + ssq4(a[1]) + ssq4(a[2]) + ssq4(a[3]), sb = ssq4(b[0]) + ssq4(b[1]) + ssq4(b[2]) + ssq4(b[3]);
        sa = wave_sum(sa); sb = wave_sum(sb);
        const float ra = rsqrtf(sa * (1.f / 1024.f) + 1e-5f), rb = rsqrtf(sb * (1.f / 1024.f) + 1e-5f);
#pragma unroll
        for (int i = 0; i < 4; ++i) {
            uint2 o; o.x = cvt_pk_bf16(a[i].x * ra * gv[i].x, a[i].y * ra * gv[i].y); o.y = cvt_pk_bf16(a[i].z * ra * gv[i].z, a[i].w * ra * gv[i].w);
            *(uint2*)(out + (size_t)r0 * 1024 + 256 * i + 4 * lane) = o;
            if (two) { uint2 q; q.x = cvt_pk_bf16(b[i].x * rb * gv[i].x, b[i].y * rb * gv[i].y); q.y = cvt_pk_bf16(b[i].z * rb * gv[i].z, b[i].w * rb * gv[i].w); *(uint2*)(out + (size_t)r1 * 1024 + 256 * i + 4 * lane) = q; }
        }
    }
}

__device__ __forceinline__ void mix_post(const bf16_t* __restrict__ o_nsa, const bf16_t* __restrict__ ub, const bf16_t* __restrict__ cbb, const float* __restrict__ conv_w,
                                         const float* __restrict__ g_nsa, const float* __restrict__ g_conv, bf16_t* __restrict__ omix, int gw, int nw, int lane) {
    float cw[3][8], gn[8], gc[8];
#pragma unroll
    for (int j = 0; j < 8; ++j) { gn[j] = g_nsa[8 * lane + j]; gc[j] = g_conv[8 * lane + j]; cw[0][j] = conv_w[8 * lane + j]; cw[1][j] = conv_w[512 + 8 * lane + j]; cw[2][j] = conv_w[1024 + 8 * lane + j]; }
    for (int t = gw; t < T; t += nw) {
        const int sq = t & (S - 1);
        const uint4 zero = make_uint4(0u, 0u, 0u, 0u);
        const uint4 on4 = *(const uint4*)(o_nsa + (size_t)t * 512 + 8 * lane), c4 = *(const uint4*)(cbb + (size_t)t * 512 + 8 * lane), u2 = *(const uint4*)(ub + (size_t)t * 512 + 8 * lane);
        const uint4 u1 = sq >= 1 ? *(const uint4*)(ub + (size_t)(t - 1) * 512 + 8 * lane) : zero, u0 = sq >= 2 ? *(const uint4*)(ub + (size_t)(t - 2) * 512 + 8 * lane) : zero;
        const unsigned onw[4] = {on4.x, on4.y, on4.z, on4.w}, cbw[4] = {c4.x, c4.y, c4.z, c4.w}, u0w[4] = {u0.x, u0.y, u0.z, u0.w}, u1w[4] = {u1.x, u1.y, u1.z, u1.w}, u2w[4] = {u2.x, u2.y, u2.z, u2.w};
        float on[8], oc[8], ssn = 0.f, ssc = 0.f;
#pragma unroll
        for (int q = 0; q < 4; ++q) {
            on[2 * q] = blo(onw[q]); on[2 * q + 1] = bhi(onw[q]);
            const float y0 = cw[0][2 * q] * blo(u0w[q]) + cw[1][2 * q] * blo(u1w[q]) + cw[2][2 * q] * blo(u2w[q]);
            const float y1 = cw[0][2 * q + 1] * bhi(u0w[q]) + cw[1][2 * q + 1] * bhi(u1w[q]) + cw[2][2 * q + 1] * bhi(u2w[q]);
            oc[2 * q] = blo(cbw[q]) * y0; oc[2 * q + 1] = bhi(cbw[q]) * y1;
        }
#pragma unroll
        for (int j = 0; j < 8; ++j) { ssn += on[j] * on[j]; ssc += oc[j] * oc[j]; }
        ssn = wave_sum(ssn); ssc = wave_sum(ssc);
        const float rn = rsqrtf(ssn * (1.f / 512.f) + 1e-5f), rc = rsqrtf(ssc * (1.f / 512.f) + 1e-5f);
        uint4 o1, o2;
        o1.x = cvt_pk_bf16(on[0] * rn * gn[0], on[1] * rn * gn[1]); o1.y = cvt_pk_bf16(on[2] * rn * gn[2], on[3] * rn * gn[3]); o1.z = cvt_pk_bf16(on[4] * rn * gn[4], on[5] * rn * gn[5]); o1.w = cvt_pk_bf16(on[6] * rn * gn[6], on[7] * rn * gn[7]);
        o2.x = cvt_pk_bf16(oc[0] * rc * gc[0], oc[1] * rc * gc[1]); o2.y = cvt_pk_bf16(oc[2] * rc * gc[2], oc[3] * rc * gc[3]); o2.z = cvt_pk_bf16(oc[4] * rc * gc[4], oc[5] * rc * gc[5]); o2.w = cvt_pk_bf16(oc[6] * rc * gc[6], oc[7] * rc * gc[7]);
        *(uint4*)(omix + (size_t)t * 1024 + 8 * lane) = o1; *(uint4*)(omix + (size_t)t * 1024 + 512 + 8 * lane) = o2;
    }
}

__device__ __forceinline__ void xreduce32(float (&acc)[32], int lane) {
    const bool b3 = lane & 8, b2 = lane & 4, b1 = lane & 2;
#pragma unroll
    for (int e = 0; e < 16; ++e) { const auto r = __builtin_amdgcn_permlane32_swap(__float_as_uint(acc[e]), __float_as_uint(acc[e + 16]), false, false); acc[e] = __uint_as_float(r[0]) + __uint_as_float(r[1]); }
#pragma unroll
    for (int e = 0; e < 8; ++e) { const auto r = __builtin_amdgcn_permlane16_swap(__float_as_uint(acc[e]), __float_as_uint(acc[e + 8]), false, false); acc[e] = __uint_as_float(r[0]) + __uint_as_float(r[1]); }
#pragma unroll
    for (int e = 0; e < 4; ++e) { const float snd = b3 ? acc[e] : acc[e + 4], kp = b3 ? acc[e + 4] : acc[e]; acc[e] = kp + dpp_xor8(snd); }
#pragma unroll
    for (int e = 0; e < 2; ++e) { const float snd = b2 ? acc[e] : acc[e + 2], kp = b2 ? acc[e + 2] : acc[e]; acc[e] = kp + dpp_xor4(snd); }
    { const float snd = b1 ? acc[0] : acc[1], kp = b1 ? acc[1] : acc[0]; acc[0] = kp + dpp_xor2(snd); }
    acc[0] += dpp_xor1(acc[0]);
}
__device__ __forceinline__ void route_token(float logit, int t, int lane, int* __restrict__ a_e, float* __restrict__ a_w, int* __restrict__ a_slot, int* lcnt) {
    const int e = lane >> 1;
    int rank = 0;
#pragma unroll
    for (int i = 0; i < 32; ++i) { const float x = __int_as_float(__builtin_amdgcn_readlane(__float_as_int(logit), 2 * i)); rank += (x > logit || (x == logit && i < e)) ? 1 : 0; }
    const float vmax = wave_max(logit);
    const bool sel = (rank < TOPK) && !(lane & 1);
    const float ex = sel ? __expf(logit - vmax) : 0.f;
    const float sum = wave_sum(ex);
    if (sel) { const int a = t * TOPK + rank; a_e[a] = e; a_w[a] = ex / sum; a_slot[a] = atomicAdd(&lcnt[e], 1); }
}
constexpr int WR_STRIDE = 1028;
__device__ __forceinline__ void norm_router(char* lds, const bf16_t* __restrict__ h2, const float* __restrict__ g, const float* __restrict__ wr, const float* __restrict__ br, unsigned char* __restrict__ xn8,
                                            int* __restrict__ a_e, float* __restrict__ a_w, int* __restrict__ a_slot, int* __restrict__ wgcnt  , int gw, int nw, int lane) {
    float* Ws = (float*)lds;
    int* lcnt = (int*)(lds + NE * WR_STRIDE * 4);
    __syncthreads();
    for (int idx = threadIdx.x; idx < NE * WR_STRIDE / 4; idx += 512) ((uint4*)Ws)[idx] = ((const uint4*)wr)[idx];
    if (threadIdx.x < NE) lcnt[threadIdx.x] = 0;
    __syncthreads();
    float4 gv[4];
#pragma unroll
    for (int i = 0; i < 4; ++i) gv[i] = *(const float4*)(g + 256 * i + 4 * lane);
    const float bias = br[lane >> 1];
    for (int t0 = gw; t0 < T; t0 += 2 * nw) {
        const int t1 = t0 + nw; const bool two = t1 < T;
        float4 a[4], b[4];
#pragma unroll
        for (int i = 0; i < 4; ++i) {
            const uint2 ua = *(const uint2*)(h2 + (size_t)t0 * 1024 + 256 * i + 4 * lane), ub = two ? *(const uint2*)(h2 + (size_t)t1 * 1024 + 256 * i + 4 * lane) : make_uint2(0u, 0u);
            a[i] = make_float4(blo(ua.x), bhi(ua.x), blo(ua.y), bhi(ua.y)); b[i] = make_float4(blo(ub.x), bhi(ub.x), blo(ub.y), bhi(ub.y));
        }
        float sa = ssq4(a[0]) + ssq4(a[1]) + ssq4(a[2]) + ssq4(a[3]), sb = ssq4(b[0]) + ssq4(b[1]) + ssq4(b[2]) + ssq4(b[3]);
        sa = wave_sum(sa); sb = wave_sum(sb);
        const float ra = rsqrtf(sa * (1.f / 1024.f) + 1e-5f), rb = rsqrtf(sb * (1.f / 1024.f) + 1e-5f);
#pragma unroll
        for (int i = 0; i < 4; ++i) {
            a[i].x *= ra; a[i].y *= ra; a[i].z *= ra; a[i].w *= ra;
            b[i].x *= rb; b[i].y *= rb; b[i].z *= rb; b[i].w *= rb;
            *(unsigned*)(xn8 + (size_t)t0 * 1024 + 256 * i + 4 * lane) = pg::pk4_fp8(a[i].x * gv[i].x, a[i].y * gv[i].y, a[i].z * gv[i].z, a[i].w * gv[i].w);
            if (two) *(unsigned*)(xn8 + (size_t)t1 * 1024 + 256 * i + 4 * lane) = pg::pk4_fp8(b[i].x * gv[i].x, b[i].y * gv[i].y, b[i].z * gv[i].z, b[i].w * gv[i].w);
        }
        float accA[32], accB[32];
#pragma unroll
        for (int e = 0; e < 32; ++e) {
            float sA = 0.f, sB = 0.f;
#pragma unroll
            for (int i = 0; i < 4; ++i) {
                const float4 w = *(const float4*)(Ws + e * WR_STRIDE + 256 * i + 4 * lane);
                sA += a[i].x * w.x + a[i].y * w.y + a[i].z * w.z + a[i].w * w.w;
                sB += b[i].x * w.x + b[i].y * w.y + b[i].z * w.z + b[i].w * w.w;
            }
            accA[e] = sA; accB[e] = sB;
        }
        xreduce32(accA, lane); xreduce32(accB, lane);
        route_token(accA[0] + bias, t0, lane, a_e, a_w, a_slot, lcnt);
        if (two) route_token(accB[0] + bias, t1, lane, a_e, a_w, a_slot, lcnt);
    }
    __syncthreads();
    if (threadIdx.x < NE) wgcnt[blockIdx.x * NE + threadIdx.x] = lcnt[threadIdx.x];
}
__device__ __forceinline__ void moe_scatter(char* lds, const int* __restrict__ wgcnt, int* __restrict__ pstart, int* __restrict__ tile_e, const int* __restrict__ a_e, const float* __restrict__ a_w,
                                            const int* __restrict__ a_slot, const unsigned char* __restrict__ xn8, unsigned char* __restrict__ xg8, float* __restrict__ w_buf, int* __restrict__ dest_of, int wg, int gw, int nw, int lane) {
    int* ps = (int*)lds;
    int* wb = ps + 64;
    int* part = ps + 128;
    __syncthreads();
    {
        const int e = threadIdx.x & 31, q = threadIdx.x >> 5, nwg_ = gridDim.x;
        int tot = 0, below = 0;
        const int per = (nwg_ + 15) / 16;
        for (int w = q * per; w < (q + 1) * per && w < nwg_; ++w) { const int c = wgcnt[w * NE + e]; tot += c; below += (w < wg) ? c : 0; }
        part[(q * NE + e) * 2] = tot; part[(q * NE + e) * 2 + 1] = below;
    }
    __syncthreads();
    if (threadIdx.x < NE) { int tot = 0, below = 0; for (int q = 0; q < 16; ++q) { tot += part[(q * NE + threadIdx.x) * 2]; below += part[(q * NE + threadIdx.x) * 2 + 1]; } ps[96 + threadIdx.x] = tot; wb[threadIdx.x] = below; }
    __syncthreads();
    if (threadIdx.x == 0) { int acc = 0; for (int e = 0; e < NE; ++e) { ps[e] = acc; acc += (ps[96 + e] + MT - 1) / MT * MT; } ps[NE] = acc; }
    __syncthreads();
    if (wg == 0) {
        if (threadIdx.x == 0) pstart[NE] = ps[NE] / MT;
        for (int tl_ = threadIdx.x; tl_ < NTILE; tl_ += 512) { const int r = tl_ * MT; int e = -1; for (int i = 0; i < NE; ++i) if (r >= ps[i] && r < ps[i + 1]) e = i; tile_e[tl_] = e; }
    }
    for (int t = gw; t < T; t += nw) {
        const uint4 row = *(const uint4*)(xn8 + (size_t)t * 1024 + 16 * lane);
        const int4 e4 = *(const int4*)(a_e + 4 * t), s4 = *(const int4*)(a_slot + 4 * t); const float4 w4 = *(const float4*)(a_w + 4 * t);
        const int ee[4] = {e4.x, e4.y, e4.z, e4.w}, sl[4] = {s4.x, s4.y, s4.z, s4.w}; const float ww[4] = {w4.x, w4.y, w4.z, w4.w};
#pragma unroll
        for (int k = 0; k < 4; ++k) {
            const int dest = ps[ee[k]] + wb[ee[k]] + sl[k];
            *(uint4*)(xg8 + (size_t)dest * 1024 + 16 * lane) = row;
            if (lane == 0) { w_buf[dest] = ww[k]; dest_of[4 * t + k] = dest; }
        }
    }
}
__device__ __forceinline__ void final_rows(const bf16_t* __restrict__ h2, const unsigned char* __restrict__ out_a, const int* __restrict__ dest_of, const float* __restrict__ g, float* __restrict__ out, int gw, int nw, int lane) {
    float4 gv[4];
#pragma unroll
    for (int i = 0; i < 4; ++i) gv[i] = *(const float4*)(g + 256 * i + 4 * lane);
    for (int t = gw; t < T; t += nw) {
        const int4 d4 = *(const int4*)(dest_of + 4 * t);
        const int dd[4] = {d4.x, d4.y, d4.z, d4.w};
        uint2 hh[4]; unsigned oa[4][4];
#pragma unroll
        for (int i = 0; i < 4; ++i) hh[i] = *(const uint2*)(h2 + (size_t)t * 1024 + 256 * i + 4 * lane);
#pragma unroll
        for (int k = 0; k < 4; ++k)
#pragma unroll
            for (int i = 0; i < 4; ++i) oa[k][i] = *(const unsigned*)(out_a + (size_t)dd[k] * 1024 + 256 * i + 4 * lane);
        float4 a[4];
        float ss = 0.f;
#pragma unroll
        for (int i = 0; i < 4; ++i) {
            float s0 = 0.f, s1 = 0.f, s2 = 0.f, s3 = 0.f;
#pragma unroll
            for (int k = 0; k < 4; ++k) {
                const auto lo = __builtin_amdgcn_cvt_pk_f32_fp8(oa[k][i], false), hi = __builtin_amdgcn_cvt_pk_f32_fp8(oa[k][i], true);
                s0 += lo[0]; s1 += lo[1]; s2 += hi[0]; s3 += hi[1];
            }
            a[i] = make_float4(blo(hh[i].x) + 0.125f * s0, bhi(hh[i].x) + 0.125f * s1, blo(hh[i].y) + 0.125f * s2, bhi(hh[i].y) + 0.125f * s3);
            ss += ssq4(a[i]);
        }
        ss = wave_sum(ss);
        const float rs = rsqrtf(ss * (1.f / 1024.f) + 1e-5f);
#pragma unroll
        for (int i = 0; i < 4; ++i) *(float4*)(out + (size_t)t * 1024 + 256 * i + 4 * lane) = make_float4(a[i].x * rs * gv[i].x, a[i].y * rs * gv[i].y, a[i].z * rs * gv[i].z, a[i].w * rs * gv[i].w);
    }
}
}

template <bool PERM64, class RowMap>
__device__ __forceinline__ void p_convT(char* lds, const float* __restrict__ W, int K, int N, int nmat, pg::bf16_t* __restrict__ Bt, int nrows_out, RowMap rowmap, int wg, int nwg, const float* __restrict__ kscale = nullptr) {
    pg::bf16_t* Ls = (pg::bf16_t*)lds;
    const int tid = opaque_tid();
    const int tk = K / 128, tn = nrows_out / 128, per = tk * tn, total = per * nmat;
    const int kk0 = tid >> 5, n4 = (tid & 31) * 4, sub = n4 >> 6, nl = n4 & 63;
    float4 x[8];
    auto issue = [&](int tile) {
        const int mat = tile / per, r = tile % per, jn = r / tk, jk = r % tk;
        const int n0 = rowmap(jn * 128 + 64 * sub);
        const float* src = W + (size_t)mat * K * N + (size_t)(jk * 128 + kk0) * N + n0 + nl;
        const bool ok = n0 >= 0 && n0 + nl < N;
#pragma unroll
        for (int i = 0; i < 8; ++i) x[i] = ok ? *(const float4*)(src + (size_t)(16 * i) * N) : make_float4(0.f, 0.f, 0.f, 0.f);
    };
    int tile = wg;
    if (tile < total) issue(tile);
    while (tile < total) {
        const int mat = tile / per, r = tile % per, jn = r / tk, jk = r % tk;
        __syncthreads();
#pragma unroll
        for (int i = 0; i < 8; ++i) {
            const int kk = kk0 + 16 * i;
            const float ks = kscale ? kscale[jk * 128 + kk] : 1.f;
            Ls[(n4 + 0) * 136 + kk] = pg::f2bf(x[i].x * ks); Ls[(n4 + 1) * 136 + kk] = pg::f2bf(x[i].y * ks); Ls[(n4 + 2) * 136 + kk] = pg::f2bf(x[i].z * ks); Ls[(n4 + 3) * 136 + kk] = pg::f2bf(x[i].w * ks);
        }
        const int nxt = tile + nwg;
        if (nxt < total) issue(nxt);
        __syncthreads();
#pragma unroll
        for (int i = 0; i < 4; ++i) {
            const int c = tid + 512 * i, n = c >> 4, kc = (c & 15) * 8;
            const int ns = PERM64 ? ((n & 64) | (n & 15) | ((n & 16) << 1) | ((n & 32) >> 1)) : n;
            const uint4 y = *(const uint4*)(Ls + ns * 136 + kc);
            *(uint4*)(Bt + ((size_t)mat * nrows_out + jn * 128 + n) * K + jk * 128 + kc) = y;
        }
        tile = nxt;
    }
}


template <class RowMap>
__device__ __forceinline__ void p_convT8(char* lds, const float* __restrict__ W, int K, int N, int nmat, unsigned char* __restrict__ Bt, int nrows_out, RowMap rowmap, int wg, int nwg, const float* __restrict__ kscale = nullptr) {
    unsigned char* Ls = (unsigned char*)lds;
    const int tid = opaque_tid();
    const int tk = K / 128, tn = nrows_out / 128, per = tk * tn, total = per * nmat;
    const int kk0 = tid >> 5, n4 = (tid & 31) * 4, sub = n4 >> 6, nl = n4 & 63;
    float4 x[8];
    auto issue = [&](int tile) {
        const int mat = tile / per, r = tile % per, jn = r / tk, jk = r % tk;
        const int n0 = rowmap(jn * 128 + 64 * sub);
        const float* src = W + (size_t)mat * K * N + (size_t)(jk * 128 + kk0) * N + n0 + nl;
        const bool ok = n0 >= 0 && n0 + nl < N;
#pragma unroll
        for (int i = 0; i < 8; ++i) x[i] = ok ? *(const float4*)(src + (size_t)(16 * i) * N) : make_float4(0.f, 0.f, 0.f, 0.f);
    };
    int tile = wg;
    if (tile < total) issue(tile);
    while (tile < total) {
        const int mat = tile / per, r = tile % per, jn = r / tk, jk = r % tk;
        __syncthreads();
#pragma unroll
        for (int i = 0; i < 8; ++i) {
            const int kk = kk0 + 16 * i;
            const float ks = pg::W8_SCALE * (kscale ? kscale[jk * 128 + kk] : 1.f);
            const unsigned p01 = __builtin_amdgcn_cvt_pk_fp8_f32(x[i].x * ks, x[i].y * ks, 0u, false), p23 = __builtin_amdgcn_cvt_pk_fp8_f32(x[i].z * ks, x[i].w * ks, 0u, false);
            Ls[(n4 + 0) * 144 + kk] = (unsigned char)(p01 & 0xff); Ls[(n4 + 1) * 144 + kk] = (unsigned char)((p01 >> 8) & 0xff);
            Ls[(n4 + 2) * 144 + kk] = (unsigned char)(p23 & 0xff); Ls[(n4 + 3) * 144 + kk] = (unsigned char)((p23 >> 8) & 0xff);
        }
        const int nxt = tile + nwg;
        if (nxt < total) issue(nxt);
        __syncthreads();
#pragma unroll
        for (int i = 0; i < 2; ++i) {
            const int c = tid + 512 * i, n = c >> 3, kc = (c & 7) * 16;
            const uint4 y = *(const uint4*)(Ls + n * 144 + kc);
            *(uint4*)(Bt + ((size_t)mat * nrows_out + jn * 128 + n) * K + jk * 128 + kc) = y;
        }
        tile = nxt;
    }
}

struct Params {
    const float *x, *mem; const int* positions;
    const float *g_mix_norm, *w_mix_in, *cmp_pos_k, *cmp_pos_v, *cmp_w1_k, *cmp_b1_k, *cmp_w2_k, *cmp_w1_v, *cmp_b1_v, *cmp_w2_v, *conv_w, *g_nsa_out, *g_conv_out, *w_mix_out,
        *g_xattn_norm, *g_mem_norm, *w_xq, *w_xkv, *w_xo, *g_moe_norm, *w_router, *b_router, *w_gate_up, *b_gate_up, *w_down, *b_down, *g_final;
    float* out;
    unsigned* bar; unsigned* queue;
    int *wgcnt, *counts, *pstart, *tile_e, *a_e, *a_slot, *dest_of, *tok_buf;
    float *a_w, *w_buf;
    unsigned* selmask;
    float *hid_k, *hid_v, *kc, *vc, *memn, *xkv, *hbuf, *xn, *o_cmp, *o_slc, *o_win, *xq, *proj, *xo;
    unsigned short *hmid, *out_a, *xg, *wt_gu, *wt_dn; unsigned char *hmid8, *wt_dn8, *wt_gu8, *xg8, *xn8, *out_a8, *h1_8, *xo8, *wt_xq8, *wt_xo8; unsigned short* h1_bf; float* ssq; float* wrt;
    unsigned short *q_bf, *kcmp, *vcmp, *kslc, *vslcT, *kwin, *vwinT, *u_bf, *cb_bf; float *gates, *cosT, *sinT;
    unsigned short *xq_bf, *xk_bf, *xvT_bf, *ocmp_bf, *owin_bf, *onsa_bf;
    unsigned short *wt_c1k, *wt_c1v, *kc_bf, *vcT_bf; float *Pab_k, *Pab_v, *b1p_k, *b1p_v;
    unsigned short *xn_bf, *memn_bf, *xo_bf, *wt_mix_in, *wt_xkv, *wt_mix_out, *wt_xq, *wt_xo;
};

__global__ void __launch_bounds__(512, 2) mega_fwd(Params p) {
    extern __shared__ __attribute__((aligned(16))) char lds[];
    if (threadIdx.x < 4) ((unsigned*)lds)[threadIdx.x] = 0u;
    __syncthreads();
    XcdBarrier bar = xcd_barrier_post(p.bar, (volatile LAS unsigned*)lds);
    LAS unsigned char* glds = (LAS unsigned char*)(lds + 1024);

    {
        const int wg = blockIdx.x, nwg = gridDim.x;
        auto ident = [](int j) { return j; };
        auto mixmap = [](int j) {
            const int unit = j >> 8, blk = (j & 255) >> 6;
            if (unit < 2) return C_Q + unit * 256 + blk * 64;
            if (unit == 2) return blk < 2 ? C_KC + blk * 64 : C_VC + (blk - 2) * 64;
            if (unit == 3) return blk < 2 ? C_KS + blk * 64 : C_VS + (blk - 2) * 64;
            if (unit == 4) return blk < 2 ? C_KW + blk * 64 : C_VW + (blk - 2) * 64;
            if (unit < 9) return blk < 2 ? C_CH + (unit - 5) * 128 + blk * 64 : C_CC + (unit - 5) * 128 + (blk - 2) * 64;
            if (unit < 11) return C_CB + (unit - 9) * 256 + blk * 64;
            return blk == 0 ? C_GL : -1;
        };
        p_convT<true>(lds + 1024, p.w_mix_in, D, INC, 1, p.wt_mix_in, 3072, mixmap, wg, nwg);
        p_convT<false>(lds + 1024, p.w_xkv, D, 2048, 1, p.wt_xkv, 2048, ident, wg, nwg);
        p_convT<false>(lds + 1024, p.w_mix_out, D, D, 1, p.wt_mix_out, D, ident, wg, nwg);
        p_convT8(lds + 1024, p.w_xq, D, D, 1, p.wt_xq8, D, ident, wg, nwg, p.g_xattn_norm);
        p_convT8(lds + 1024, p.w_xo, D, D, 1, p.wt_xo8, D, ident, wg, nwg);
        auto gumap = [](int j) { const int blk = j >> 8, w = j & 255; return w < 128 ? 128 * blk + w : 1024 + 128 * blk + (w - 128); };
        p_convT8(lds + 1024, p.w_gate_up, D, 2048, NE, p.wt_gu8, 2048, gumap, wg, nwg);
        p_convT8(lds + 1024, p.w_down, DFF, D, NE, p.wt_dn8, D, ident, wg, nwg);
        p_convT<false>(lds + 1024, p.cmp_w1_k, 1024, 256, 2, p.wt_c1k, 256, ident, wg, nwg);
        p_convT<false>(lds + 1024, p.cmp_w1_v, 1024, 256, 2, p.wt_c1v, 256, ident, wg, nwg);
        for (int o = wg * 8 + (threadIdx.x >> 6); o < 512; o += nwg * 8) {
            if (o < 256) posbias_wave(o, threadIdx.x & 63, p.cmp_pos_k, p.cmp_w1_k, p.cmp_b1_k, p.b1p_k); else posbias_wave(o - 256, threadIdx.x & 63, p.cmp_pos_v, p.cmp_w1_v, p.cmp_b1_v, p.b1p_v);
        }
        __syncthreads();
    }
    p_rope_table(blockIdx.x * 512 + threadIdx.x, gridDim.x * 512, p.positions, p.cosT, p.sinT);
    for (int idx = blockIdx.x * 512 + threadIdx.x; idx < 1024 * NE; idx += gridDim.x * 512) p.wrt[(idx & 31) * tl::WR_STRIDE + (idx >> 5)] = p.g_moe_norm[idx >> 5] * p.w_router[idx];
    tl::rmsnorm_rows(p.x, p.g_mix_norm, p.xn_bf, T, (int)(blockIdx.x * 8 + (opaque_tid() >> 6)), (int)(gridDim.x * 8), opaque_tid() & 63);
    tl::rmsnorm_rows(p.mem, p.g_mem_norm, p.memn_bf, NB * NMEM, (int)(blockIdx.x * 8 + (opaque_tid() >> 6)), (int)(gridDim.x * 8), opaque_tid() & 63);
    xcd_barrier(bar);
    {
        pg::DenseOrder So; So.init(p.xn_bf, p.wt_mix_in, T, 3072, 2048u, 2048u, (int)gridDim.x, (int)blockIdx.x);
        pg::EpiMixIn E{p.q_bf, p.kcmp, p.vslcT, p.u_bf, p.cb_bf, p.gates, p.cosT, p.sinT};
        pg::gemm_phase(glds, D, 2048u, 2048u, So, E);
    }
    xcd_barrier(bar);
    {
        volatile int* item_s = (volatile int*)(lds + 64);
        for (;;) {
            __syncthreads();
            if (threadIdx.x == 0) *item_s = (int)atomicAdd(p.queue, 1u);
            __syncthreads();
            const int item = __builtin_amdgcn_readfirstlane(*item_s);
            if (item >= 96 + 512) break;
            if (item < 64) {
                const int pm = item >> 3, pn = item & 7;
                pg::OneUnit So; So.u.A = (const char*)p.memn_bf + (size_t)pm * 256 * 2048; So.u.B = (const char*)p.wt_xkv + (size_t)pn * 256 * 2048; So.u.row0 = pm * 256; So.u.col0 = pn * 256; So.u.aux = 0;
                pg::EpiXkv E{p.xk_bf, p.xvT_bf};
                pg::gemm_phase(glds, D, 2048u, 2048u, So, E);
            } else if (item < 96) {
                const int which = (item - 64) >> 4, r = (item - 64) & 15, pm = r >> 1, pn = r & 1;
                pg::OneUnit So; So.u.A = (const char*)(which ? p.vcmp : p.kcmp) + (size_t)pm * 256 * 2048; So.u.B = (const char*)(which ? p.wt_c1v : p.wt_c1k) + (size_t)pn * 256 * 2048; So.u.row0 = pm * 256; So.u.col0 = pn * 256; So.u.aux = 0;
                pg::EpiF32R E{which ? p.Pab_v : p.Pab_k, 512, nullptr, 512};
                pg::gemm_phase(glds, 1024, 2048u, 2048u, So, E);
            } else {
                const int idx = item - 96, tq = 31 - (idx >> 4), bg = idx & 15;
                at::attn64_unit<1>(lds + 1024, bg >> 1, bg & 1, tq, p.q_bf, p.kwin, p.vwinT, p.selmask, p.owin_bf, nullptr, nullptr, nullptr);
            }
        }
    }
    xcd_barrier(bar);
    p_cmp_finalize(lds + 1024, p.Pab_k, p.Pab_v, p.b1p_k, p.b1p_v, p.cmp_w2_k, p.cmp_w2_v, p.kc_bf, p.vcT_bf, blockIdx.x, gridDim.x);
    xcd_barrier(bar);
    for (int item = blockIdx.x; item < 256; item += gridDim.x) {
        const int bg = item >> 4, j = item & 15;
        at::cmp_unit(lds + 1024, bg >> 1, bg & 1, 31 - j, p.q_bf, p.kc_bf, p.vcT_bf, p.ocmp_bf, p.selmask);
        at::cmp_unit(lds + 1024, bg >> 1, bg & 1, j, p.q_bf, p.kc_bf, p.vcT_bf, p.ocmp_bf, p.selmask);
        asm volatile("s_waitcnt vmcnt(0)" ::: "memory");
        __syncthreads();
        at::attn64_unit<0>(lds + 1024, bg >> 1, bg & 1, 31 - j, p.q_bf, p.kslc, p.vslcT, p.selmask, p.onsa_bf, p.ocmp_bf, p.owin_bf, p.gates);
        at::attn64_unit<0>(lds + 1024, bg >> 1, bg & 1, j, p.q_bf, p.kslc, p.vslcT, p.selmask, p.onsa_bf, p.ocmp_bf, p.owin_bf, p.gates);
    }
    xcd_barrier(bar);
    tl::mix_post(p.onsa_bf, p.u_bf, p.cb_bf, p.conv_w, p.g_nsa_out, p.g_conv_out, p.xn_bf  , (int)(blockIdx.x * 8 + (opaque_tid() >> 6)), (int)(gridDim.x * 8), opaque_tid() & 63);
    xcd_barrier(bar);
    {
        pg::DenseOrder So; So.init(p.xn_bf, p.wt_mix_out, T, D, 2048u, 2048u, (int)gridDim.x, (int)blockIdx.x);
        pg::EpiResNormStats E{p.x, p.h1_bf, p.ssq, p.h1_8};
        pg::gemm_phase(glds, D, 2048u, 2048u, So, E);
    }
    xcd_barrier(bar);
    {
        pg::DenseOrder So; So.init(p.h1_8, p.wt_xq8, T, D, 1024u, 1024u, (int)gridDim.x, (int)blockIdx.x);
        pg::EpiBf16RowScale E{p.xq_bf, p.ssq, 0.0625f * 1.4426950408889634f * pg::W8_INV};
        pg::gemm_phase_f8(glds, D, 1024u, 1024u, So, E);
        for (int L = blockIdx.x; L < (T / 256) * (D / 256); L += gridDim.x) {
            int pm, h; pg::dense_map(L, T / 256, D / 256, pm, h);
            const int b = pm >> 3, qt = (pm & 7) * 2;
            at::xattn_unit(lds + 1024, b, h, qt, p.xq_bf, p.xk_bf, p.xvT_bf, p.xo8);
            at::xattn_unit(lds + 1024, b, h, qt + 1, p.xq_bf, p.xk_bf, p.xvT_bf, p.xo8);
        }
    }
    xcd_barrier(bar);
    {
        pg::DenseOrder So; So.init(p.xo8, p.wt_xo8, T, D, 1024u, 1024u, (int)gridDim.x, (int)blockIdx.x);
        pg::EpiBf16Res E{p.h1_bf, pg::W8_INV * (1.f / 16.f)};
        pg::gemm_phase_f8(glds, D, 1024u, 1024u, So, E);
    }
    xcd_barrier(bar);
    tl::norm_router(lds + 1024, p.h1_bf, p.g_moe_norm, p.wrt, p.b_router, p.xn8, p.a_e, p.a_w, p.a_slot, p.wgcnt, (int)(blockIdx.x * 8 + (opaque_tid() >> 6)), (int)(gridDim.x * 8), opaque_tid() & 63);
    xcd_barrier(bar);
    tl::moe_scatter(lds + 1024, p.wgcnt, p.pstart, p.tile_e, p.a_e, p.a_w, p.a_slot, p.xn8, p.xg8, p.w_buf, p.dest_of, blockIdx.x, (int)(blockIdx.x * 8 + (opaque_tid() >> 6)), (int)(gridDim.x * 8), opaque_tid() & 63);
    xcd_barrier(bar);
    {
        pg::MoeOrderB<8> So; So.init(p.xg8, p.wt_gu8, p.tile_e, p.pstart[NE], (size_t)2048 * 1024, 1024u, (int)gridDim.x, (int)blockIdx.x);
        pg::EpiSwigluF8 E{p.hmid8, p.b_gate_up};
        pg::gemm_phase_f8(glds, D, 1024u, 1024u, So, E);
    }
    xcd_barrier(bar);
    {
        pg::MoeOrderB<4> So; So.init(p.hmid8, p.wt_dn8, p.tile_e, p.pstart[NE], (size_t)1024 * 1024, 1024u, (int)gridDim.x, (int)blockIdx.x);
        pg::EpiDownScaleF8 E{p.out_a8, p.b_down, p.w_buf};
        pg::gemm_phase_f8(glds, DFF, 1024u, 1024u, So, E);
    }
    xcd_barrier(bar);
    tl::final_rows(p.h1_bf, p.out_a8, p.dest_of, p.g_final, p.out, (int)(blockIdx.x * 8 + (opaque_tid() >> 6)), (int)(gridDim.x * 8), opaque_tid() & 63);
}
__global__ void k_fail(float* out, int n) { const int i = blockIdx.x * 256 + threadIdx.x; if (i < n) out[i] = __builtin_nanf(""); }
}

extern "C" void kernel_launch(void* const* d_in, const int* in_sizes, int n_in, void* d_out, int out_size, void* d_ws, size_t ws_size, hipStream_t stream) {
    Params p{};
    p.x = (const float*)d_in[0]; p.mem = (const float*)d_in[1]; p.positions = (const int*)d_in[2];
    const float** fp = &p.g_mix_norm;
    for (int i = 0; i < 27; ++i) fp[i] = (const float*)d_in[3 + i];
    p.out = (float*)d_out;

    char* ws = (char*)d_ws;
    size_t off = 0;
    auto take = [&](size_t bytes) { char* q = ws + off; off += (bytes + 255) & ~(size_t)255; return q; };
    p.bar = (unsigned*)take(XCD_BAR_WORDS * 4);
    p.counts = (int*)take(NE * 4);
    p.queue = (unsigned*)take(256);
    const size_t zero_bytes = off;
    p.pstart = (int*)take((NE + 1) * 4);
    p.wgcnt = (int*)take(1024 * NE * 4);
    p.tile_e = (int*)take(NTILE * 4);
    p.a_e = (int*)take(NA * 4);
    p.a_w = (float*)take(NA * 4);
    p.a_slot = (int*)take(NA * 4);
    p.dest_of = (int*)take(NA * 4);
    p.w_buf = (float*)take(PMAX * 4);
    p.selmask = (unsigned*)take((size_t)NB * 2 * S * 4);
    p.out_a8 = (unsigned char*)take((size_t)PMAX * D);
    p.xg8 = (unsigned char*)take((size_t)PMAX * D);
    p.xn8 = (unsigned char*)take((size_t)T * D);
    p.h1_bf = (unsigned short*)take((size_t)T * D * 2);
    p.ssq = (float*)take((size_t)T * 16 * 4);
    p.wrt = (float*)take((size_t)NE * 1028 * 4);
    p.hmid8 = (unsigned char*)take((size_t)PMAX * DFF);
    p.wt_gu8 = (unsigned char*)take((size_t)NE * 2048 * D);
    p.wt_dn8 = (unsigned char*)take((size_t)NE * D * DFF);
    p.q_bf = (unsigned short*)take((size_t)T * 512 * 2);
    p.kcmp = (unsigned short*)take((size_t)T * 128 * 2 * 4); p.vcmp = p.kcmp + (size_t)T * 128; p.kslc = p.vcmp + (size_t)T * 128; p.kwin = p.kslc + (size_t)T * 128;
    p.vslcT = (unsigned short*)take((size_t)T * 128 * 2 * 2); p.vwinT = p.vslcT + (size_t)T * 128;
    p.u_bf = (unsigned short*)take((size_t)T * 512 * 2); p.cb_bf = (unsigned short*)take((size_t)T * 512 * 2);
    p.gates = (float*)take((size_t)T * 24 * 4); p.cosT = (float*)take((size_t)T * 32 * 4); p.sinT = (float*)take((size_t)T * 32 * 4);
    p.wt_c1k = (unsigned short*)take((size_t)512 * 1024 * 2); p.wt_c1v = (unsigned short*)take((size_t)512 * 1024 * 2);
    p.kc_bf = (unsigned short*)take((size_t)16 * 128 * 64 * 2); p.vcT_bf = (unsigned short*)take((size_t)16 * 64 * 128 * 2);
    p.Pab_k = (float*)take((size_t)(2048 + 1) * 512 * 4); p.Pab_v = (float*)take((size_t)(2048 + 1) * 512 * 4);
    p.b1p_k = (float*)take(256 * 4); p.b1p_v = (float*)take(256 * 4);
    p.ocmp_bf = (unsigned short*)take((size_t)T * 512 * 2); p.owin_bf = (unsigned short*)take((size_t)T * 512 * 2); p.onsa_bf = (unsigned short*)take((size_t)T * 512 * 2);
    p.xq_bf = (unsigned short*)take((size_t)T * D * 2); p.xk_bf = (unsigned short*)take((size_t)NB * NMEM * D * 2); p.xvT_bf = (unsigned short*)take((size_t)NB * NMEM * D * 2);
    p.xn_bf = (unsigned short*)take((size_t)T * D * 2);
    p.memn_bf = (unsigned short*)take((size_t)NB * NMEM * D * 2);
    p.xo8 = (unsigned char*)take((size_t)T * D);
    p.h1_8 = (unsigned char*)take((size_t)T * D);
    p.wt_mix_in = (unsigned short*)take((size_t)3072 * D * 2);
    p.wt_xkv = (unsigned short*)take((size_t)2048 * D * 2);
    p.wt_mix_out = (unsigned short*)take((size_t)D * D * 2);
    p.wt_xq8 = (unsigned char*)take((size_t)D * D);
    p.wt_xo8 = (unsigned char*)take((size_t)D * D);

    static int grid = 0;
    if (grid == 0) {
        int dev = 0, cus = 0;
        if (hipGetDevice(&dev) != hipSuccess || hipDeviceGetAttribute(&cus, hipDeviceAttributeMultiprocessorCount, dev) != hipSuccess) cus = -1;
        if (hipFuncSetAttribute((const void*)mega_fwd, hipFuncAttributeMaxDynamicSharedMemorySize, LDS_BYTES) != hipSuccess) cus = -1;
        int per_cu = 0;
        if (cus > 0 && (hipOccupancyMaxActiveBlocksPerMultiprocessor(&per_cu, (const void*)mega_fwd, 512, LDS_BYTES) != hipSuccess || per_cu < 1)) cus = -1;
        (void)hipGetLastError();
        grid = cus > 0 ? cus : -1;
    }
    if (grid < 0 || off > ws_size) { k_fail<<<(out_size + 255) / 256, 256, 0, stream>>>((float*)d_out, out_size); return; }
    (void)hipMemsetAsync(d_ws, 0, zero_bytes, stream);
    hipLaunchKernelGGL(mega_fwd, dim3(grid), dim3(512), LDS_BYTES, stream, p);
}
```

```cpp
#include <hip/hip_runtime.h>
#include <hip/hip_bf16.h>
#include <stdint.h>
#include <cstdio>

#define XB_TMO      128
#define XB_XCNT(j)  (256  + 64 * (j))
#define XB_XSUB(j)  (1280 + 64 * (j))
#define XB_XGEN(j)  (2304 + 64 * (j))
#define XB_TOP      3328
#define XB_TOPGEN   3392
#define XCD_BAR_WORDS 3456
#define XB_SPIN_CAP (1u << 18)
#define LAS __attribute__((address_space(3)))

__device__ __forceinline__ unsigned xb_ld(unsigned* p)              { return __hip_atomic_load(p, __ATOMIC_RELAXED, __HIP_MEMORY_SCOPE_AGENT); }
__device__ __forceinline__ unsigned xb_add(unsigned* p, unsigned v) { return __hip_atomic_fetch_add(p, v, __ATOMIC_RELAXED, __HIP_MEMORY_SCOPE_AGENT); }
__device__ __forceinline__ unsigned xb_xcc_id() { return (unsigned)__builtin_amdgcn_s_getreg((3 << 11) | 20) & 0xFu; }
#define XB_SPIN(cond, bar) do { unsigned _sp = 0; while (cond) { __builtin_amdgcn_s_sleep(1); \
    if ((++_sp & 255u) == 0u) { if (xb_ld(&(bar)[XB_TMO])) break; if (_sp > XB_SPIN_CAP) { atomicAdd(&(bar)[XB_TMO], 1u); break; } } } } while (0)

struct XcdBarrier {
    unsigned* bar; unsigned x;
    volatile LAS unsigned* st;
};

__device__ __forceinline__ XcdBarrier xcd_barrier_post(unsigned* bar, volatile LAS unsigned* st) {
    XcdBarrier b; b.bar = bar; b.x = xb_xcc_id(); b.st = st;
    if (threadIdx.x == 0) (void)xb_add(&bar[XB_XCNT(b.x)], 1u);
    return b;
}
__device__ __forceinline__ void xcd_barrier_complete(unsigned* bar, unsigned x, unsigned& nloc, unsigned& nx) {
    const unsigned G = gridDim.x * gridDim.y * gridDim.z;
    unsigned sum, cnt, mine, sp = 0u;
    for (;;) {
        sum = 0u; cnt = 0u; mine = 0u;
#pragma unroll
        for (unsigned j = 0; j < 16; ++j) { const unsigned c = xb_ld(&bar[XB_XCNT(j)]); sum += c; cnt += (c > 0u) ? 1u : 0u; mine = (j == x) ? c : mine; }
        if (sum == G) break;
        __builtin_amdgcn_s_sleep(1);
        if ((++sp & 255u) == 0u) { if (xb_ld(&bar[XB_TMO])) break; if (sp > XB_SPIN_CAP) { atomicAdd(&bar[XB_TMO], 1u); break; } }
    }
    nloc = mine > 0u ? mine : 1u; nx = cnt > 0u ? cnt : 1u;
}

__device__ __forceinline__ void xcd_barrier(const XcdBarrier& b) {
    asm volatile("s_waitcnt vmcnt(0)" ::: "memory");
    __syncthreads();
    if (threadIdx.x == 0) {
        unsigned* bar = b.bar;
        __builtin_amdgcn_s_waitcnt(0);
        unsigned nloc = b.st[0], nx = b.st[1];
        if (nloc == 0u) { xcd_barrier_complete(bar, b.x, nloc, nx); b.st[0] = nloc; b.st[1] = nx; }
        const unsigned old = xb_add(&bar[XB_XSUB(b.x)], 1u);
        const unsigned gen = old / nloc;
        if (old + 1u == (gen + 1u) * nloc) {
            __builtin_amdgcn_fence(__ATOMIC_RELEASE, "agent");
            asm volatile("s_waitcnt vmcnt(0)" ::: "memory");
            const unsigned og = xb_add(&bar[XB_TOP], 1u);
            const unsigned tg = og / nx;
            if (og + 1u == (tg + 1u) * nx) xb_add(&bar[XB_TOPGEN], 1u);
            else XB_SPIN(xb_ld(&bar[XB_TOPGEN]) == tg, bar);
            __builtin_amdgcn_fence(__ATOMIC_ACQUIRE, "agent");
            xb_add(&bar[XB_XGEN(b.x)], 1u);
            asm volatile("s_waitcnt vmcnt(0)" ::: "memory");
        } else {
            XB_SPIN(xb_ld(&bar[XB_XGEN(b.x)]) == gen, bar);
            __builtin_amdgcn_fence(__ATOMIC_ACQUIRE, "agent");
            asm volatile("s_waitcnt vmcnt(0)" ::: "memory");
        }
    }
    __syncthreads();
}


namespace {
constexpr int D = 1024, NB = 8, S = 2048, T = NB * S, NMEM = 256;
constexpr int INC = 2840;
constexpr int C_Q = 0, C_KC = 512, C_VC = 640, C_KS = 768, C_VS = 896, C_KW = 1024, C_VW = 1152, C_GL = 1280, C_CH = 1304, C_CB = 1816, C_CC = 2328;
constexpr int NC = 127, NCR = NB * NC * 2;
constexpr int NE = 32, TOPK = 4, DFF = 1024, NA = T * TOPK;
constexpr int MT = 256;
constexpr int PMAX = NA + NE * MT, NTILE = PMAX / MT;
constexpr int LDS_BYTES = 144 * 1024, VB_LDS = 40960;
constexpr float QS = 0.125f * 1.4426950408889634f;

__device__ __forceinline__ int opaque_tid() { int t = threadIdx.x; asm volatile("" : "+v"(t)); return t; }
__device__ __forceinline__ float dpp_xor8(float v) { return __uint_as_float(__builtin_amdgcn_update_dpp(0u, __float_as_uint(v), 0x128, 0xf, 0xf, true)); }
__device__ __forceinline__ float dpp_xor4(float v) { unsigned r = __builtin_amdgcn_update_dpp(__float_as_uint(v), __float_as_uint(v), 0x104, 0xf, 0x5, false); r = __builtin_amdgcn_update_dpp(r, __float_as_uint(v), 0x114, 0xf, 0xa, false); return __uint_as_float(r); }
__device__ __forceinline__ float dpp_xor2(float v) { return __uint_as_float(__builtin_amdgcn_update_dpp(0u, __float_as_uint(v), 0x4e, 0xf, 0xf, true)); }
__device__ __forceinline__ float dpp_xor1(float v) { return __uint_as_float(__builtin_amdgcn_update_dpp(0u, __float_as_uint(v), 0xb1, 0xf, 0xf, true)); }

__device__ __forceinline__ float lane_xor32(float v) { const auto r = __builtin_amdgcn_permlane32_swap(__float_as_uint(v), __float_as_uint(v), false, false); return __uint_as_float((threadIdx.x & 32) ? r[0] : r[1]); }
__device__ __forceinline__ float lane_xor16(float v) { const auto r = __builtin_amdgcn_permlane16_swap(__float_as_uint(v), __float_as_uint(v), false, false); return __uint_as_float((threadIdx.x & 16) ? r[0] : r[1]); }
__device__ __forceinline__ float wave_sum(float v) {
    { const auto r = __builtin_amdgcn_permlane32_swap(__float_as_uint(v), __float_as_uint(v), false, false); v = __uint_as_float(r[0]) + __uint_as_float(r[1]); }
    { const auto r = __builtin_amdgcn_permlane16_swap(__float_as_uint(v), __float_as_uint(v), false, false); v = __uint_as_float(r[0]) + __uint_as_float(r[1]); }
    v += dpp_xor8(v); v += dpp_xor4(v); v += dpp_xor2(v); v += dpp_xor1(v); return v;
}
__device__ __forceinline__ float wave_max(float v) {
    { const auto r = __builtin_amdgcn_permlane32_swap(__float_as_uint(v), __float_as_uint(v), false, false); v = fmaxf(__uint_as_float(r[0]), __uint_as_float(r[1])); }
    { const auto r = __builtin_amdgcn_permlane16_swap(__float_as_uint(v), __float_as_uint(v), false, false); v = fmaxf(__uint_as_float(r[0]), __uint_as_float(r[1])); }
    v = fmaxf(v, dpp_xor8(v)); v = fmaxf(v, dpp_xor4(v)); v = fmaxf(v, dpp_xor2(v)); v = fmaxf(v, dpp_xor1(v)); return v;
}

namespace pg { __device__ __forceinline__ unsigned cvt_pk_bf16(float lo, float hi); __device__ __forceinline__ unsigned cvt_pk_bf16_acc(float lo, float hi); }
struct VB { int vb, nvb, tid; char* lds; };
#define VB_ITEMS(n) for (int _it = 0, item = v.vb; _it < ((n) + v.nvb - 1) / v.nvb; ++_it, item += v.nvb)

__device__ __forceinline__ void p_rmsnorm(const VB& v, int rows, const float* __restrict__ in, int ldi, const float* __restrict__ g, float* __restrict__ out, int ldo, int W) {
    float* red = (float*)v.lds;
    VB_ITEMS(rows) {
        const bool act = item < rows;
        const float* r = in + (size_t)(act ? item : 0) * ldi;
        float ss = 0.f;
        for (int i = v.tid; i < W; i += 256) { float x = r[i]; ss += x * x; }
        ss = wave_sum(ss);
        __syncthreads();
        if ((v.tid & 63) == 0) red[v.tid >> 6] = ss;
        __syncthreads();
        ss = red[0] + red[1] + red[2] + red[3];
        const float rs = rsqrtf(ss / (float)W + 1e-5f);
        if (act) { float* o = out + (size_t)item * ldo; for (int i = v.tid; i < W; i += 256) o[i] = r[i] * rs * g[i]; }
    }
}

__device__ __forceinline__ unsigned short f2bf_rne(float f) { unsigned u = __float_as_uint(f); u += 0x7FFFu + ((u >> 16) & 1u); return (unsigned short)(u >> 16); }
__device__ __forceinline__ void p_rmsnorm_bf(const VB& v, int rows, const float* __restrict__ in, int ldi, const float* __restrict__ g, unsigned short* __restrict__ out, int ldo, int W) {
    float* red = (float*)v.lds;
    VB_ITEMS(rows) {
        const bool act = item < rows;
        const float* r = in + (size_t)(act ? item : 0) * ldi;
        float ss = 0.f;
        for (int i = v.tid; i < W; i += 256) { float x = r[i]; ss += x * x; }
        ss = wave_sum(ss);
        __syncthreads();
        if ((v.tid & 63) == 0) red[v.tid >> 6] = ss;
        __syncthreads();
        ss = red[0] + red[1] + red[2] + red[3];
        const float rs = rsqrtf(ss / (float)W + 1e-5f);
        if (act) { unsigned short* o = out + (size_t)item * ldo; for (int i = v.tid; i < W; i += 256) o[i] = f2bf_rne(r[i] * rs * g[i]); }
    }
}

template <int NACC, class AL, class BL>
__device__ __forceinline__ void gemm_tile_f32(int tid, float (&acc)[NACC][4][4], int K, AL al, BL bl, float (*As)[68], float (*Bs)[NACC * 64 + 4]) {
    const int tx = tid & 15, ty = tid >> 4;
    const int ar = tid >> 2, ak = (tid & 3) * 4;
    const int bk = tid >> 4, bc = (tid & 15) * 4;
#pragma unroll
    for (int w = 0; w < NACC; ++w)
#pragma unroll
        for (int i = 0; i < 4; ++i)
#pragma unroll
            for (int j = 0; j < 4; ++j) acc[w][i][j] = 0.f;
    for (int k0 = 0; k0 < K; k0 += 16) {
        const float4 a = al(ar, k0 + ak);
        float4 b[NACC];
#pragma unroll
        for (int w = 0; w < NACC; ++w) b[w] = bl(w, k0 + bk, bc);
        __syncthreads();
        As[ak + 0][ar] = a.x; As[ak + 1][ar] = a.y; As[ak + 2][ar] = a.z; As[ak + 3][ar] = a.w;
#pragma unroll
        for (int w = 0; w < NACC; ++w) *(float4*)&Bs[bk][w * 64 + bc] = b[w];
        __syncthreads();
#pragma unroll
        for (int kk = 0; kk < 16; ++kk) {
            const float4 av = *(const float4*)&As[kk][ty * 4];
            const float aa[4] = {av.x, av.y, av.z, av.w};
#pragma unroll
            for (int w = 0; w < NACC; ++w) {
                const float4 bv = *(const float4*)&Bs[kk][w * 64 + tx * 4];
                const float bb[4] = {bv.x, bv.y, bv.z, bv.w};
#pragma unroll
                for (int i = 0; i < 4; ++i)
#pragma unroll
                    for (int j = 0; j < 4; ++j) acc[w][i][j] += aa[i] * bb[j];
            }
        }
    }
}

__device__ __forceinline__ void p_gemm(const VB& v, const float* __restrict__ A, int lda, const float* __restrict__ Bm, int ldb, float* C, int ldc, const float* res, int M, int N, int K) {
    float (*As)[68] = (float (*)[68])v.lds;
    float (*Bs)[68] = (float (*)[68])(v.lds + 16 * 68 * 4);
    const int nx = (N + 63) / 64, ny = (M + 63) / 64, nt = nx * ny;
    VB_ITEMS(nt) {
        const bool act = item < nt;
        const int row0 = act ? (item / nx) * 64 : M, col0 = act ? (item % nx) * 64 : N;
        float acc[1][4][4];
        auto al = [&](int r, int k) -> float4 { const int row = row0 + r; return row < M ? *(const float4*)(A + (size_t)row * lda + k) : make_float4(0.f, 0.f, 0.f, 0.f); };
        auto bl = [&](int, int k, int c) -> float4 { const int col = col0 + c; return col < N ? *(const float4*)(Bm + (size_t)k * ldb + col) : make_float4(0.f, 0.f, 0.f, 0.f); };
        gemm_tile_f32<1>(v.tid, acc, K, al, bl, As, Bs);
        const int tx = v.tid & 15, ty = v.tid >> 4;
#pragma unroll
        for (int i = 0; i < 4; ++i) {
            const int row = row0 + ty * 4 + i;
            if (row >= M) continue;
#pragma unroll
            for (int j = 0; j < 4; ++j) {
                const int col = col0 + tx * 4 + j;
                if (col >= N) continue;
                float x = acc[0][i][j];
                if (res) x += res[(size_t)row * ldc + col];
                C[(size_t)row * ldc + col] = x;
            }
        }
    }
}

__device__ __forceinline__ void p_rope(const VB& v, float* __restrict__ proj, const int* __restrict__ pos) {
    VB_ITEMS(T) {
        if (item >= T) continue;
        const int t = item;
        const float p = (float)pos[t];
        float* r = proj + (size_t)t * INC;
        for (int i = v.tid; i < 448; i += 256) {
            const int hd = i >> 5, f = i & 31;
            int col;
            if (hd < 8) col = C_Q + hd * 64; else if (hd < 10) col = C_KC + (hd - 8) * 64; else if (hd < 12) col = C_KS + (hd - 10) * 64; else col = C_KW + (hd - 12) * 64;
            const float inv = powf(10000.f, -(float)f / 32.f);
            const float ang = p * inv;
            const float c = cosf(ang), s = sinf(ang);
            const float t1 = r[col + f], t2 = r[col + 32 + f];
            r[col + f] = t1 * c - t2 * s;
            r[col + 32 + f] = t2 * c + t1 * s;
        }
    }
}

__device__ __forceinline__ float gelu_tanh(float x) { const float u = 0.7978845608028654f * (x + 0.044715f * x * x * x); return 0.5f * x * (1.f + tanhf(u)); }
__device__ __forceinline__ void p_cmp1(const VB& v, const float* __restrict__ proj, int colbase, const float* __restrict__ pos, const float* __restrict__ w1, const float* __restrict__ b1, float* __restrict__ hid) {
    float (*As)[68] = (float (*)[68])v.lds;
    float (*Bs)[68] = (float (*)[68])(v.lds + 16 * 68 * 4);
    const int nx = 4, ny = (NCR + 63) / 64, nt = nx * ny;
    VB_ITEMS(nt) {
        const bool act = item < nt;
        const int row0 = act ? (item / nx) * 64 : NCR, col0 = act ? (item % nx) * 64 : 0;
        float acc[1][4][4];
        auto al = [&](int r, int k) -> float4 {
            const int row = row0 + r; if (row >= NCR) return make_float4(0.f, 0.f, 0.f, 0.f);
            const int g = row & 1, bc = row >> 1, c = bc % NC, b = bc / NC, l = k >> 6, d = k & 63;
            const float4 x = *(const float4*)(proj + (size_t)(b * S + 16 * c + l) * INC + colbase + g * 64 + d);
            const float4 pe = *(const float4*)(pos + k);
            return make_float4(x.x + pe.x, x.y + pe.y, x.z + pe.z, x.w + pe.w);
        };
        auto bl = [&](int, int k, int c) -> float4 { return *(const float4*)(w1 + (size_t)k * 256 + col0 + c); };
        gemm_tile_f32<1>(v.tid, acc, 2048, al, bl, As, Bs);
        const int tx = v.tid & 15, ty = v.tid >> 4;
#pragma unroll
        for (int i = 0; i < 4; ++i) {
            const int row = row0 + ty * 4 + i;
            if (row >= NCR) continue;
#pragma unroll
            for (int j = 0; j < 4; ++j) { const int col = col0 + tx * 4 + j; hid[(size_t)row * 256 + col] = gelu_tanh(acc[0][i][j] + b1[col]); }
        }
    }
}

__device__ __forceinline__ void st_out(float* p, float x) { *p = x; }
__device__ __forceinline__ void st_out(unsigned short* p, float x) { *p = f2bf_rne(x); }
template <int DH, class KeyF, class OutT>
__device__ __forceinline__ void wave_attend(const float* q, int ncand, KeyF keyf, float* sc, OutT* out, int lane) {
    float m = -3.0e38f;
    for (int idx = lane; idx < ncand; idx += 64) {
        const float *kp, *vp;
        float s = -3.0e38f;
        if (keyf(idx, kp, vp)) {
            s = 0.f;
#pragma unroll 4
            for (int d = 0; d < DH; d += 4) { const float4 kv = *(const float4*)(kp + d); s += q[d] * kv.x + q[d + 1] * kv.y + q[d + 2] * kv.z + q[d + 3] * kv.w; }
        }
        sc[idx] = s;
        m = fmaxf(m, s);
    }
    m = wave_max(m);
    float sum = 0.f;
    for (int idx = lane; idx < ncand; idx += 64) { const float s = sc[idx]; const float p = (s > -1.0e38f) ? __expf(s - m) : 0.f; sc[idx] = p; sum += p; }
    sum = wave_sum(sum);
    const float inv = (m > -1.0e38f) ? 1.f / sum : 0.f;
    for (int idx = lane; idx < ncand; idx += 64) sc[idx] *= inv;
    __builtin_amdgcn_s_waitcnt(0);
    float o[DH / 64];
#pragma unroll
    for (int i = 0; i < DH / 64; ++i) o[i] = 0.f;
    for (int idx = 0; idx < ncand; ++idx) {
        const float p = sc[idx];
        if (p == 0.f) continue;
        const float *kp, *vp;
        keyf(idx, kp, vp);
#pragma unroll
        for (int i = 0; i < DH / 64; ++i) o[i] += p * vp[lane + 64 * i];
    }
#pragma unroll
    for (int i = 0; i < DH / 64; ++i) st_out(out + lane + 64 * i, o[i]);
}

__device__ __forceinline__ void p_cmp_attn(const VB& v, const float* __restrict__ proj, const float* __restrict__ kc, const float* __restrict__ vc,
                                           float* __restrict__ o_cmp, unsigned* __restrict__ selmask) {
    float (*qs)[64] = (float (*)[64])v.lds;
    float (*ps)[128] = (float (*)[128])(v.lds + 1024);
    float* imps = (float*)(v.lds + 1024 + 2048);
    VB_ITEMS(T * 2) {
        const int g = item & 1, t = item >> 1, b = t / S, s = t % S;
        const int w = v.tid >> 6, lane = v.tid & 63, h = g * 4 + w;
        __syncthreads();
        qs[w][lane] = proj[(size_t)t * INC + C_Q + h * 64 + lane] * 0.125f;
        ps[w][lane] = 0.f; ps[w][lane + 64] = 0.f;
        __syncthreads();
        auto keyf = [&](int c, const float*& kp, const float*& vp) -> bool {
            kp = kc + (size_t)((b * NC + c) * 2 + g) * 64; vp = vc + (size_t)((b * NC + c) * 2 + g) * 64;
            return 16 * c + 31 <= s;
        };
        wave_attend<64>(qs[w], NC, keyf, ps[w], o_cmp + (size_t)t * 512 + h * 64, lane);
        __syncthreads();
        if (v.tid < 32) {
            const int j = v.tid;
            float imp = 0.f;
            for (int hh = 0; hh < 4; ++hh)
                for (int c = 4 * j - 1; c <= 4 * j + 3; ++c) {
                    if (c < 0 || c >= NC) continue;
                    const float ov = (c == 4 * j - 1 || c == 4 * j + 3) ? 0.5f : 1.0f;
                    imp += ps[hh][c] * ov;
                }
            const int cur = s >> 6;
            if (j == 0 || j == cur || j == cur - 1) imp = 1e30f; else if (j > cur) imp = -1e30f;
            imps[j] = imp;
        }
        __syncthreads();
        if (v.tid < 64) {
            const int j = v.tid & 31;
            const float mine = imps[j];
            int rank = 0;
            for (int i = 0; i < 32; ++i) { const float x = imps[i]; rank += (x > mine || (x == mine && i < j)) ? 1 : 0; }
            const unsigned long long bal = __ballot(rank < 16 && v.tid < 32);
            if (v.tid == 0) selmask[(size_t)(b * 2 + g) * S + s] = (unsigned)(bal & 0xffffffffull);
        }
    }
}

template <int MODE>
__device__ __forceinline__ void p_nsa_attn(const VB& v, const float* __restrict__ proj, const unsigned* __restrict__ selmask, float* __restrict__ outp) {
    float (*qs)[64] = (float (*)[64])v.lds;
    float (*scs)[2048] = (float (*)[2048])(v.lds + 1024);
    VB_ITEMS(T * 2) {
        const int g = item & 1, t = item >> 1, b = t / S, s = t % S;
        const int w = v.tid >> 6, lane = v.tid & 63, h = g * 4 + w;
        qs[w][lane] = proj[(size_t)t * INC + C_Q + h * 64 + lane] * 0.125f;
        __builtin_amdgcn_s_waitcnt(0);
        if (MODE == 0) {
            const unsigned mask = selmask[(size_t)(b * 2 + g) * S + s];
            const int ncand = ((s >> 6) + 1) * 64;
            auto keyf = [&](int idx, const float*& kp, const float*& vp) -> bool {
                const float* r = proj + (size_t)(b * S + idx) * INC + g * 64;
                kp = r + C_KS; vp = r + C_VS;
                return idx <= s && ((mask >> (idx >> 6)) & 1u);
            };
            wave_attend<64>(qs[w], ncand, keyf, scs[w], outp + (size_t)t * 512 + h * 64, lane);
        } else {
            const int lo = s - 511 > 0 ? s - 511 : 0;
            const int ncand = s - lo + 1;
            auto keyf = [&](int idx, const float*& kp, const float*& vp) -> bool {
                const float* r = proj + (size_t)(b * S + lo + idx) * INC + g * 64;
                kp = r + C_KW; vp = r + C_VW;
                return true;
            };
            wave_attend<64>(qs[w], ncand, keyf, scs[w], outp + (size_t)t * 512 + h * 64, lane);
        }
    }
}

__device__ __forceinline__ void p_xattn(const VB& v, const float* __restrict__ xq, const float* __restrict__ xkv, unsigned short* __restrict__ xo) {
    float (*qs)[256] = (float (*)[256])v.lds;
    float (*scs)[256] = (float (*)[256])(v.lds + 4096);
    VB_ITEMS(T) {
        const int t = item, b = t / S, w = v.tid >> 6, lane = v.tid & 63;
        for (int i = lane; i < 256; i += 64) qs[w][i] = xq[(size_t)t * D + w * 256 + i] * 0.0625f;
        __builtin_amdgcn_s_waitcnt(0);
        auto keyf = [&](int m, const float*& kp, const float*& vp) -> bool {
            const float* r = xkv + (size_t)(b * NMEM + m) * 2048 + w * 256;
            kp = r; vp = r + 1024;
            return true;
        };
        wave_attend<256>(qs[w], NMEM, keyf, scs[w], xo + (size_t)t * D + w * 256, lane);
    }
}

__device__ __forceinline__ void p_mix_post(const VB& v, const float* __restrict__ proj, const float* __restrict__ o_cmp, const float* __restrict__ o_slc, const float* __restrict__ o_win,
                                           const float* __restrict__ conv_w, const float* __restrict__ g_nsa, const float* __restrict__ g_conv, unsigned short* __restrict__ omix) {
    float (*red)[4] = (float (*)[4])v.lds;
    VB_ITEMS(T) {
        const int t = item, s = t % S, tid = v.tid;
        const float* r = proj + (size_t)t * INC;
        float on[2], oc[2], ssn = 0.f, ssc = 0.f;
#pragma unroll
        for (int e = 0; e < 2; ++e) {
            const int c = tid + 256 * e, h = c >> 6;
            const float g0 = 1.f / (1.f + __expf(-r[C_GL + h * 3 + 0])), g1 = 1.f / (1.f + __expf(-r[C_GL + h * 3 + 1])), g2 = 1.f / (1.f + __expf(-r[C_GL + h * 3 + 2]));
            on[e] = g0 * o_cmp[(size_t)t * 512 + c] + g1 * o_slc[(size_t)t * 512 + c] + g2 * o_win[(size_t)t * 512 + c];
            ssn += on[e] * on[e];
            float y = 0.f;
#pragma unroll
            for (int k = 0; k < 3; ++k) {
                const int sp = s - 2 + k;
                if (sp < 0) continue;
                const float* rp = proj + (size_t)(t - 2 + k) * INC;
                y += conv_w[k * 512 + c] * (rp[C_CC + c] * rp[C_CH + c]);
            }
            oc[e] = r[C_CB + c] * y;
            ssc += oc[e] * oc[e];
        }
        ssn = wave_sum(ssn); ssc = wave_sum(ssc);
        __syncthreads();
        if ((tid & 63) == 0) { red[0][tid >> 6] = ssn; red[1][tid >> 6] = ssc; }
        __syncthreads();
        ssn = red[0][0] + red[0][1] + red[0][2] + red[0][3];
        ssc = red[1][0] + red[1][1] + red[1][2] + red[1][3];
        const float rn = rsqrtf(ssn / 512.f + 1e-5f), rc = rsqrtf(ssc / 512.f + 1e-5f);
#pragma unroll
        for (int e = 0; e < 2; ++e) {
            const int c = tid + 256 * e;
            omix[(size_t)t * D + c] = f2bf_rne(on[e] * rn * g_nsa[c]);
            omix[(size_t)t * D + 512 + c] = f2bf_rne(oc[e] * rc * g_conv[c]);
        }
    }
}


__device__ __forceinline__ float bfu(unsigned short b) { return __uint_as_float(((unsigned)b) << 16); }
__device__ __forceinline__ void p_rope_table(int gtid, int gn, const int* __restrict__ pos, float* __restrict__ cosT, float* __restrict__ sinT) {
    for (int i = gtid; i < T * 32; i += gn) {
        const int t = i >> 5, f = i & 31;
        const float inv = powf(10000.f, -(float)f / 32.f);
        const float ang = (float)pos[t] * inv;
        cosT[i] = cosf(ang); sinT[i] = sinf(ang);
    }
}
template <int DH, class ValidF, class KRow, class VGet, class OutT>
__device__ __forceinline__ void wave_attend_bf(const float* q, int ncand, ValidF valid, KRow krow, VGet vget, float* sc, OutT* out, int lane) {
    float m = -3.0e38f;
    for (int idx = lane; idx < ncand; idx += 64) {
        float s = -3.0e38f;
        if (valid(idx)) {
            const unsigned short* kp = krow(idx);
            s = 0.f;
#pragma unroll 2
            for (int d = 0; d < DH; d += 8) {
                const uint4 kv = *(const uint4*)(kp + d);
                s += q[d] * __uint_as_float(kv.x << 16) + q[d + 1] * __uint_as_float(kv.x & 0xffff0000u) + q[d + 2] * __uint_as_float(kv.y << 16) + q[d + 3] * __uint_as_float(kv.y & 0xffff0000u)
                   + q[d + 4] * __uint_as_float(kv.z << 16) + q[d + 5] * __uint_as_float(kv.z & 0xffff0000u) + q[d + 6] * __uint_as_float(kv.w << 16) + q[d + 7] * __uint_as_float(kv.w & 0xffff0000u);
            }
        }
        sc[idx] = s;
        m = fmaxf(m, s);
    }
    m = wave_max(m);
    float sum = 0.f;
    for (int idx = lane; idx < ncand; idx += 64) { const float s = sc[idx]; const float p = (s > -1.0e38f) ? exp2f(s - m) : 0.f; sc[idx] = p; sum += p; }
    sum = wave_sum(sum);
    const float inv = (m > -1.0e38f) ? 1.f / sum : 0.f;
    for (int idx = lane; idx < ncand; idx += 64) sc[idx] *= inv;
    __builtin_amdgcn_s_waitcnt(0);
    float o[DH / 64];
#pragma unroll
    for (int i = 0; i < DH / 64; ++i) o[i] = 0.f;
    for (int idx = 0; idx < ncand; ++idx) {
        const float p = sc[idx];
        if (p == 0.f) continue;
#pragma unroll
        for (int i = 0; i < DH / 64; ++i) o[i] += p * vget(idx, lane + 64 * i);
    }
#pragma unroll
    for (int i = 0; i < DH / 64; ++i) st_out(out + lane + 64 * i, o[i]);
}

__device__ __forceinline__ void p_cmp1_bf(const VB& v, const unsigned short* __restrict__ src, const float* __restrict__ pos, const float* __restrict__ w1, const float* __restrict__ b1, float* __restrict__ hid) {
    float (*As)[68] = (float (*)[68])v.lds;
    float (*Bs)[68] = (float (*)[68])(v.lds + 16 * 68 * 4);
    const int nx = 4, ny = (NCR + 63) / 64, nt = nx * ny;
    VB_ITEMS(nt) {
        const bool act = item < nt;
        const int row0 = act ? (item / nx) * 64 : NCR, col0 = act ? (item % nx) * 64 : 0;
        float acc[1][4][4];
        auto al = [&](int r, int k) -> float4 {
            const int row = row0 + r; if (row >= NCR) return make_float4(0.f, 0.f, 0.f, 0.f);
            const int g = row & 1, bc = row >> 1, c = bc % NC, b = bc / NC, l = k >> 6, d = k & 63;
            const uint2 x = *(const uint2*)(src + ((size_t)(b * 2 + g) * S + 16 * c + l) * 64 + d);
            const float4 pe = *(const float4*)(pos + k);
            return make_float4(__uint_as_float(x.x << 16) + pe.x, __uint_as_float(x.x & 0xffff0000u) + pe.y, __uint_as_float(x.y << 16) + pe.z, __uint_as_float(x.y & 0xffff0000u) + pe.w);
        };
        auto bl = [&](int, int k, int c) -> float4 { return *(const float4*)(w1 + (size_t)k * 256 + col0 + c); };
        gemm_tile_f32<1>(v.tid, acc, 2048, al, bl, As, Bs);
        const int tx = v.tid & 15, ty = v.tid >> 4;
#pragma unroll
        for (int i = 0; i < 4; ++i) {
            const int row = row0 + ty * 4 + i;
            if (row >= NCR) continue;
#pragma unroll
            for (int j = 0; j < 4; ++j) { const int col = col0 + tx * 4 + j; hid[(size_t)row * 256 + col] = gelu_tanh(acc[0][i][j] + b1[col]); }
        }
    }
}
__device__ __forceinline__ void p_cmp_attn_bf(const VB& v, const unsigned short* __restrict__ qb, const float* __restrict__ kc, const float* __restrict__ vc,
                                              float* __restrict__ o_cmp, unsigned* __restrict__ selmask) {
    float (*qs)[64] = (float (*)[64])v.lds;
    float (*ps)[128] = (float (*)[128])(v.lds + 1024);
    float* imps = (float*)(v.lds + 1024 + 2048);
    VB_ITEMS(T * 2) {
        const int g = item & 1, t = item >> 1, b = t / S, s = t % S;
        const int w = v.tid >> 6, lane = v.tid & 63, h = g * 4 + w;
        __syncthreads();
        qs[w][lane] = bfu(qb[(size_t)t * 512 + h * 64 + lane]);
        ps[w][lane] = 0.f; ps[w][lane + 64] = 0.f;
        __syncthreads();
        {
            float m = -3.0e38f;
            float* sc = ps[w];
            for (int c = lane; c < NC; c += 64) {
                float sv = -3.0e38f;
                if (16 * c + 31 <= s) { const float* kp = kc + (size_t)((b * NC + c) * 2 + g) * 64; sv = 0.f; for (int d = 0; d < 64; ++d) sv += qs[w][d] * kp[d]; }
                sc[c] = sv; m = fmaxf(m, sv);
            }
            m = wave_max(m);
            float sum = 0.f;
            for (int c = lane; c < NC; c += 64) { const float sv = sc[c]; const float pp = (sv > -1.0e38f) ? exp2f(sv - m) : 0.f; sc[c] = pp; sum += pp; }
            sum = wave_sum(sum);
            const float inv = (m > -1.0e38f) ? 1.f / sum : 0.f;
            for (int c = lane; c < NC; c += 64) sc[c] *= inv;
            __builtin_amdgcn_s_waitcnt(0);
            float o = 0.f;
            for (int c = 0; c < NC; ++c) { const float pp = sc[c]; if (pp != 0.f) o += pp * vc[(size_t)((b * NC + c) * 2 + g) * 64 + lane]; }
            o_cmp[(size_t)t * 512 + h * 64 + lane] = o;
        }
        __syncthreads();
        if (v.tid < 32) {
            const int j = v.tid;
            float imp = 0.f;
            for (int hh = 0; hh < 4; ++hh)
                for (int c = 4 * j - 1; c <= 4 * j + 3; ++c) {
                    if (c < 0 || c >= NC) continue;
                    const float ov = (c == 4 * j - 1 || c == 4 * j + 3) ? 0.5f : 1.0f;
                    imp += ps[hh][c] * ov;
                }
            const int cur = s >> 6;
            if (j == 0 || j == cur || j == cur - 1) imp = 1e30f; else if (j > cur) imp = -1e30f;
            imps[j] = imp;
        }
        __syncthreads();
        if (v.tid < 64) {
            const int j = v.tid & 31;
            const float mine = imps[j];
            int rank = 0;
            for (int i = 0; i < 32; ++i) { const float x = imps[i]; rank += (x > mine || (x == mine && i < j)) ? 1 : 0; }
            const unsigned long long bal = __ballot(rank < 16 && v.tid < 32);
            if (v.tid == 0) selmask[(size_t)(b * 2 + g) * S + s] = (unsigned)(bal & 0xffffffffull);
        }
    }
}
template <int MODE>
__device__ __forceinline__ void p_nsa_attn_bf(const VB& v, const unsigned short* __restrict__ qb, const unsigned short* __restrict__ Kh, const unsigned short* __restrict__ VT,
                                              const unsigned* __restrict__ selmask, float* __restrict__ outp) {
    float (*qs)[64] = (float (*)[64])v.lds;
    float (*scs)[2048] = (float (*)[2048])(v.lds + 1024);
    VB_ITEMS(T * 2) {
        const int g = item & 1, t = item >> 1, b = t / S, s = t % S;
        const int w = v.tid >> 6, lane = v.tid & 63, h = g * 4 + w;
        qs[w][lane] = bfu(qb[(size_t)t * 512 + h * 64 + lane]);
        __builtin_amdgcn_s_waitcnt(0);
        const unsigned short* Kb = Kh + (size_t)(b * 2 + g) * S * 64;
        const unsigned short* Vb = VT + (size_t)(b * 2 + g) * 64 * S;
        if (MODE == 0) {
            const unsigned mask = selmask[(size_t)(b * 2 + g) * S + s];
            const int ncand = ((s >> 6) + 1) * 64;
            auto valid = [&](int idx) -> bool { return idx <= s && ((mask >> (idx >> 6)) & 1u); };
            auto krow = [&](int idx) -> const unsigned short* { return Kb + (size_t)idx * 64; };
            auto vget = [&](int idx, int d) -> float { return bfu(Vb[(size_t)d * S + idx]); };
            wave_attend_bf<64>(qs[w], ncand, valid, krow, vget, scs[w], outp + (size_t)t * 512 + h * 64, lane);
        } else {
            const int lo = s - 511 > 0 ? s - 511 : 0;
            const int ncand = s - lo + 1;
            auto valid = [&](int) -> bool { return true; };
            auto krow = [&](int idx) -> const unsigned short* { return Kb + (size_t)(lo + idx) * 64; };
            auto vget = [&](int idx, int d) -> float { return bfu(Vb[(size_t)d * S + lo + idx]); };
            wave_attend_bf<64>(qs[w], ncand, valid, krow, vget, scs[w], outp + (size_t)t * 512 + h * 64, lane);
        }
    }
}
__device__ __forceinline__ void p_mix_post_bf(const VB& v, const float* __restrict__ gates, const unsigned short* __restrict__ ub, const unsigned short* __restrict__ cbb,
                                              const float* __restrict__ o_cmp, const float* __restrict__ o_slc, const float* __restrict__ o_win,
                                              const float* __restrict__ conv_w, const float* __restrict__ g_nsa, const float* __restrict__ g_conv, unsigned short* __restrict__ omix) {
    float (*red)[4] = (float (*)[4])v.lds;
    VB_ITEMS(T) {
        const int t = item, s = t % S, tid = v.tid;
        float on[2], oc[2], ssn = 0.f, ssc = 0.f;
#pragma unroll
        for (int e = 0; e < 2; ++e) {
            const int c = tid + 256 * e, h = c >> 6;
            const float g0 = gates[(size_t)t * 24 + h * 3 + 0], g1 = gates[(size_t)t * 24 + h * 3 + 1], g2 = gates[(size_t)t * 24 + h * 3 + 2];
            on[e] = g0 * o_cmp[(size_t)t * 512 + c] + g1 * o_slc[(size_t)t * 512 + c] + g2 * o_win[(size_t)t * 512 + c];
            ssn += on[e] * on[e];
            float y = 0.f;
#pragma unroll
            for (int k = 0; k < 3; ++k) {
                const int sp = s - 2 + k;
                if (sp < 0) continue;
                y += conv_w[k * 512 + c] * bfu(ub[(size_t)(t - 2 + k) * 512 + c]);
            }
            oc[e] = bfu(cbb[(size_t)t * 512 + c]) * y;
            ssc += oc[e] * oc[e];
        }
        ssn = wave_sum(ssn); ssc = wave_sum(ssc);
        __syncthreads();
        if ((tid & 63) == 0) { red[0][tid >> 6] = ssn; red[1][tid >> 6] = ssc; }
        __syncthreads();
        ssn = red[0][0] + red[0][1] + red[0][2] + red[0][3];
        ssc = red[1][0] + red[1][1] + red[1][2] + red[1][3];
        const float rn = rsqrtf(ssn / 512.f + 1e-5f), rc = rsqrtf(ssc / 512.f + 1e-5f);
#pragma unroll
        for (int e = 0; e < 2; ++e) {
            const int c = tid + 256 * e;
            omix[(size_t)t * D + c] = f2bf_rne(on[e] * rn * g_nsa[c]);
            omix[(size_t)t * D + 512 + c] = f2bf_rne(oc[e] * rc * g_conv[c]);
        }
    }
}

__device__ __forceinline__ void p_router(const VB& v, const float* __restrict__ xn, const float* __restrict__ wr, const float* __restrict__ br,
                                         int* __restrict__ a_e, float* __restrict__ a_w, int* __restrict__ a_slot, int* __restrict__ counts) {
    VB_ITEMS(T / 4) {
        const int t = item * 4 + (v.tid >> 6), lane = v.tid & 63, e = lane & 31, half = lane >> 5;
        const float* x = xn + (size_t)t * D + half * 512;
        const float* w = wr + (size_t)half * 512 * NE + e;
        float acc = 0.f;
        for (int k = 0; k < 512; ++k) acc += x[k] * w[(size_t)k * NE];
        acc += __shfl_xor(acc, 32);
        const float logit = acc + br[e];
        int rank = 0;
        for (int i = 0; i < 32; ++i) { const float x2 = __shfl(logit, i); rank += (x2 > logit || (x2 == logit && i < e)) ? 1 : 0; }
        const float vmax = wave_max(logit);
        const bool sel = (rank < TOPK) && (lane < 32);
        const float ex = sel ? __expf(logit - vmax) : 0.f;
        const float sum = wave_sum(ex);
        if (sel) {
            const int a = t * TOPK + rank;
            a_e[a] = e; a_w[a] = ex / sum; a_slot[a] = atomicAdd(&counts[e], 1);
        }
    }
}
__device__ __forceinline__ void p_moe_offsets(const VB& v, const int* __restrict__ counts, int* __restrict__ pstart, int* __restrict__ tile_e, int* __restrict__ tok_buf, float* __restrict__ w_buf) {
    int* ps = (int*)v.lds;
    __syncthreads();
    if (v.tid == 0) { int acc = 0; for (int e = 0; e < NE; ++e) { ps[e] = acc; if (v.vb == 0) pstart[e] = acc; acc += (counts[e] + MT - 1) / MT * MT; } ps[NE] = acc; if (v.vb == 0) pstart[NE] = acc / MT; }
    __syncthreads();
    for (int tl = v.vb * 256 + v.tid; tl < NTILE; tl += v.nvb * 256) {
        const int r = tl * MT; int e = -1;
        for (int i = 0; i < NE; ++i) if (r >= ps[i] && r < ps[i + 1]) e = i;
        tile_e[tl] = e;
    }
    for (int i = v.vb * 256 + v.tid; i < PMAX; i += v.nvb * 256) { tok_buf[i] = 0; w_buf[i] = 0.f; }
}
__device__ __forceinline__ void p_moe_scatter(const VB& v, const int* __restrict__ a_e, const float* __restrict__ a_w, const int* __restrict__ a_slot, const int* __restrict__ pstart,
                                              int* __restrict__ tok_buf, float* __restrict__ w_buf, int* __restrict__ dest_of, const float* __restrict__ xn, unsigned short* __restrict__ xg) {
    const int lane = v.tid & 63, gw = v.vb * 4 + (v.tid >> 6), ngw = v.nvb * 4;
    for (int a = gw; a < NA; a += ngw) {
        const int dest = pstart[a_e[a]] + a_slot[a], t = a / TOPK;
        if (lane == 0) { tok_buf[dest] = t; w_buf[dest] = a_w[a]; dest_of[a] = dest; }
        const float* src = xn + (size_t)t * D + lane * 16;
        unsigned o[8];
#pragma unroll
        for (int i = 0; i < 4; ++i) { const float4 x = *(const float4*)(src + 4 * i); o[2 * i] = pg::cvt_pk_bf16(x.x, x.y); o[2 * i + 1] = pg::cvt_pk_bf16(x.z, x.w); }
        uint4* dst = (uint4*)(xg + (size_t)dest * D + lane * 16);
        dst[0] = make_uint4(o[0], o[1], o[2], o[3]); dst[1] = make_uint4(o[4], o[5], o[6], o[7]);
    }
}
__device__ __forceinline__ void p_moe1(const VB& v, const float* __restrict__ xn, const int* __restrict__ tok_buf, const int* __restrict__ tile_e,
                                       const float* __restrict__ wgu, const float* __restrict__ bgu, __hip_bfloat16* __restrict__ hmid) {
    float (*As)[68] = (float (*)[68])v.lds;
    float (*Bs)[132] = (float (*)[132])(v.lds + 16 * 68 * 4);
    int* toks = (int*)(v.lds + 16 * 68 * 4 + 16 * 132 * 4);
    const int nt = 16 * NTILE;
    VB_ITEMS(nt) {
        const int tl = item < nt ? item / 16 : 0, cx = item % 16;
        const int e0 = item < nt ? tile_e[tl] : -1;
        const bool act = e0 >= 0;
        const int e = act ? e0 : 0;
        const int row0 = tl * MT, col0 = cx * 64;
        __syncthreads();
        if (v.tid < MT) toks[v.tid] = act ? tok_buf[row0 + v.tid] : 0;
        __syncthreads();
        const float* W = wgu + (size_t)e * D * 2048;
        float acc[2][4][4];
        auto al = [&](int r, int k) -> float4 { return *(const float4*)(xn + (size_t)toks[r] * D + k); };
        auto bl = [&](int w, int k, int c) -> float4 { return *(const float4*)(W + (size_t)k * 2048 + w * 1024 + col0 + c); };
        gemm_tile_f32<2>(v.tid, acc, D, al, bl, As, Bs);
        if (!act) continue;
        const int tx = v.tid & 15, ty = v.tid >> 4;
#pragma unroll
        for (int i = 0; i < 4; ++i)
#pragma unroll
            for (int j = 0; j < 4; ++j) {
                const int row = row0 + ty * 4 + i, col = col0 + tx * 4 + j;
                float g = acc[0][i][j] + bgu[(size_t)e * 2048 + col], u = acc[1][i][j] + bgu[(size_t)e * 2048 + 1024 + col];
                g = fminf(g, 7.f); u = fminf(fmaxf(u, -7.f), 7.f);
                const float hm = (u + 1.f) * (g / (1.f + __expf(-1.702f * g)));
                hmid[(size_t)row * DFF + col] = __float2bfloat16(hm);
            }
    }
}
__device__ __forceinline__ void p_moe2(const VB& v, const __hip_bfloat16* __restrict__ hmid, const int* __restrict__ tile_e, const float* __restrict__ w_buf,
                                       const float* __restrict__ wd, const float* __restrict__ bd, __hip_bfloat16* __restrict__ out_a) {
    float (*As)[68] = (float (*)[68])v.lds;
    float (*Bs)[68] = (float (*)[68])(v.lds + 16 * 68 * 4);
    const int nt = 16 * NTILE;
    VB_ITEMS(nt) {
        const int tl = item < nt ? item / 16 : 0, cx = item % 16;
        const int e0 = item < nt ? tile_e[tl] : -1;
        const bool act = e0 >= 0;
        const int e = act ? e0 : 0;
        const int row0 = tl * MT, col0 = cx * 64;
        const float* W = wd + (size_t)e * DFF * D;
        float acc[1][4][4];
        auto al = [&](int r, int k) -> float4 {
            if (!act) return make_float4(0.f, 0.f, 0.f, 0.f);
            const __hip_bfloat16* p = hmid + (size_t)(row0 + r) * DFF + k;
            return make_float4(__bfloat162float(p[0]), __bfloat162float(p[1]), __bfloat162float(p[2]), __bfloat162float(p[3]));
        };
        auto bl = [&](int, int k, int c) -> float4 { return *(const float4*)(W + (size_t)k * D + col0 + c); };
        gemm_tile_f32<1>(v.tid, acc, DFF, al, bl, As, Bs);
        if (!act) continue;
        const int tx = v.tid & 15, ty = v.tid >> 4;
#pragma unroll
        for (int i = 0; i < 4; ++i)
#pragma unroll
            for (int j = 0; j < 4; ++j) {
                const int row = row0 + ty * 4 + i, col = col0 + tx * 4 + j;
                out_a[(size_t)row * D + col] = __float2bfloat16((acc[0][i][j] + bd[(size_t)e * D + col]) * w_buf[row]);
            }
    }
}
__device__ __forceinline__ void p_final(const VB& v, const float* __restrict__ h2, const unsigned short* __restrict__ out_a, const int* __restrict__ dest_of,
                                        const float* __restrict__ g, float* __restrict__ out) {
    float* red = (float*)v.lds;
    VB_ITEMS(T) {
        const int t = item, tid = v.tid;
        int d[4];
#pragma unroll
        for (int k = 0; k < 4; ++k) d[k] = dest_of[t * 4 + k];
        float x4[4], ss = 0.f;
#pragma unroll
        for (int e = 0; e < 4; ++e) {
            const int c = tid + 256 * e;
            float x = h2[(size_t)t * D + c];
#pragma unroll
            for (int k = 0; k < 4; ++k) x += __uint_as_float(((unsigned)out_a[(size_t)d[k] * D + c]) << 16);
            x4[e] = x; ss += x * x;
        }
        ss = wave_sum(ss);
        __syncthreads();
        if ((tid & 63) == 0) red[tid >> 6] = ss;
        __syncthreads();
        ss = red[0] + red[1] + red[2] + red[3];
        const float rs = rsqrtf(ss / (float)D + 1e-5f);
#pragma unroll
        for (int e = 0; e < 4; ++e) { const int c = tid + 256 * e; out[(size_t)t * D + c] = x4[e] * rs * g[c]; }
    }
}


namespace pg {
typedef unsigned short bf16_t;
typedef short bf16x8 __attribute__((ext_vector_type(8)));
typedef float f32x4 __attribute__((ext_vector_type(4)));
constexpr int BM = 256, BK = 64, HALF = 128, HTB = HALF * BK * 2, STAGE_BYTES = 8 * HTB;
__device__ __forceinline__ int lds_byte(int r, int c) { const int st = (r >> 4) * 2 + (c >> 5), rr = r & 15, cc = c & 31, ob = rr * 64 + cc * 2; return st * 1024 + (ob ^ (((ob >> 9) & 1) << 5)); }
__device__ __forceinline__ void stage_rc(int b, int& R, int& C) { const int st = b / 1024, sb = b % 1024, swz = sb ^ (((sb >> 9) & 1) << 5); R = (st >> 1) * 16 + swz / 64; C = (st & 1) * 32 + (swz % 64) / 2; }
typedef float f32x2_t __attribute__((ext_vector_type(2)));
typedef __bf16 bf16x2_t __attribute__((ext_vector_type(2)));
__device__ __forceinline__ unsigned cvt_pk_bf16_acc(float lo, float hi) { const f32x2_t v = {lo, hi}; const bf16x2_t b = __builtin_convertvector(v, bf16x2_t); return __builtin_bit_cast(unsigned, b); }
__device__ __forceinline__ unsigned cvt_pk_bf16(float lo, float hi) { unsigned r; asm volatile("v_cvt_pk_bf16_f32 %0, %1, %2" : "=v"(r) : "v"(lo), "v"(hi)); return r; }
__device__ __forceinline__ bf16_t f2bf(float f) { unsigned u = __float_as_uint(f); u += 0x7FFFu + ((u >> 16) & 1u); return (bf16_t)(u >> 16); }
__device__ __forceinline__ float bf2f(bf16_t b) { return __uint_as_float(((unsigned)b) << 16); }

__device__ __forceinline__ unsigned pk4_fp8(float a, float b, float c, float d);
struct GUnit { const char* A; const char* B; int row0, col0, aux; };

template <class Epi, class Sched>
__device__ __forceinline__ void gemm_phase(LAS unsigned char* lds, const int K, const unsigned lda_b, const unsigned ldb_b, const Sched& S, const Epi& E) {
    const int tid = opaque_tid(), wid = __builtin_amdgcn_readfirstlane(tid >> 6), lane = tid & 63, wr = wid >> 2, wc = wid & 3, fr = lane & 15, fq = lane >> 4;
    const int nt = K / BK;
    unsigned voffA[2], voffB[2];
#pragma unroll
    for (int i = 0; i < 2; ++i) { int R, C; stage_rc(tid * 16 + i * 8192, R, C); voffA[i] = (unsigned)R * lda_b + (unsigned)C * 2u; voffB[i] = (unsigned)R * ldb_b + (unsigned)C * 2u; }
    const size_t kstep = (size_t)(BK * 2);
    const size_t hstepA = (size_t)HALF * lda_b, hstepB = (size_t)HALF * ldb_b;
    const unsigned ldsw = (unsigned)wid * 1024u;
    const int aoff = lds_byte(wr * 64 + fr, fq * 8), boff = lds_byte(wc * 32 + fr, fq * 8);
#define PG8_SA(b, h) (((b) * 2 + (h)) * HTB)
#define PG8_SB(b, h) ((4 + (b) * 2 + (h)) * HTB)
#define PG8_STAGE(bufoff, gbase, voff) do { _Pragma("unroll") for (int _i = 0; _i < 2; ++_i) \
        __builtin_amdgcn_global_load_lds((const unsigned*)((const char*)(gbase) + (voff)[_i]), (LAS unsigned*)(lds + (bufoff) + ldsw + _i * 8192), 16, 0, 0); } while (0)
#define PG8_LDA(dst, b, h) do { _Pragma("unroll") for (int m = 0; m < 4; ++m) _Pragma("unroll") for (int k = 0; k < 2; ++k) dst[m][k] = *(const LAS bf16x8*)(lds + PG8_SA(b, h) + aoff + m * 2048 + k * 1024); } while (0)
#define PG8_LDB(dst, b, h) do { _Pragma("unroll") for (int n = 0; n < 2; ++n) _Pragma("unroll") for (int k = 0; k < 2; ++k) dst[n][k] = *(const LAS bf16x8*)(lds + PG8_SB(b, h) + boff + n * 2048 + k * 1024); } while (0)
#define PG8_MMA(ai, bj, At, Bt) do { __builtin_amdgcn_s_setprio(1); _Pragma("unroll") for (int m = 0; m < 4; ++m) _Pragma("unroll") for (int n = 0; n < 2; ++n) _Pragma("unroll") for (int k = 0; k < 2; ++k) \
        acc[ai][bj][m][n] = __builtin_amdgcn_mfma_f32_16x16x32_bf16(Bt[n][k], At[m][k], acc[ai][bj][m][n], 0, 0, 0); __builtin_amdgcn_s_setprio(0); } while (0)
#define PG8_WAIT_V(n) asm volatile("s_waitcnt vmcnt(" #n ")" ::: "memory")
#define PG8_WAIT_L(n) asm volatile("s_waitcnt lgkmcnt(" #n ")" ::: "memory")
#define PG8_BAR __builtin_amdgcn_s_barrier()
#define PG8_SCHED __builtin_amdgcn_sched_barrier(0)
    GUnit cur, nxt; int ui = 0;
    if (!S.next(0, cur)) return;
    f32x4 acc[2][2][4][2];
#pragma unroll
    for (int a = 0; a < 2; ++a)
#pragma unroll
        for (int b = 0; b < 2; ++b)
#pragma unroll
            for (int m = 0; m < 4; ++m)
#pragma unroll
                for (int n = 0; n < 2; ++n) acc[a][b][m][n] = (f32x4){0.f, 0.f, 0.f, 0.f};
    bf16x8 At[4][2], B0[2][2], B1[2][2];
    const char* cA = cur.A; const char* cB = cur.B;
    PG8_STAGE(PG8_SB(0, 0), cB, voffB); PG8_STAGE(PG8_SA(0, 0), cA, voffA); PG8_STAGE(PG8_SB(0, 1), cB + hstepB, voffB); PG8_STAGE(PG8_SA(0, 1), cA + hstepA, voffA);
    if (wr == 1) PG8_BAR;
    PG8_WAIT_V(4); PG8_BAR;
    PG8_STAGE(PG8_SB(1, 0), cB + kstep, voffB); PG8_STAGE(PG8_SA(1, 0), cA + kstep, voffA); PG8_STAGE(PG8_SB(1, 1), cB + hstepB + kstep, voffB);
    PG8_WAIT_V(6); PG8_BAR;
    for (;;) {
        const bool has_next = S.next(ui + 1, nxt);
        const char* nA = has_next ? nxt.A : cA; const char* nB = has_next ? nxt.B : cB;
        for (int t = 0; t < nt; t += 2) {
            const bool last = (t == nt - 2);
            const char* a1 = cA + (size_t)(t + 1) * kstep;
            const char* a2 = last ? nA : cA + (size_t)(t + 2) * kstep; const char* b2 = last ? nB : cB + (size_t)(t + 2) * kstep;
            const char* a3 = a2 + kstep; const char* b3 = b2 + kstep;
            PG8_LDB(B0, 0, 0); PG8_SCHED; PG8_LDA(At, 0, 0); PG8_STAGE(PG8_SA(1, 1), a1 + hstepA, voffA);
            PG8_WAIT_L(8); PG8_BAR; PG8_WAIT_L(0); PG8_MMA(0, 0, At, B0); PG8_BAR; PG8_SCHED;
            PG8_LDB(B1, 0, 1); PG8_STAGE(PG8_SB(0, 0), b2, voffB);
            PG8_BAR; PG8_WAIT_L(0); PG8_MMA(0, 1, At, B1); PG8_BAR;
            PG8_LDA(At, 0, 1); PG8_STAGE(PG8_SA(0, 0), a2, voffA);
            PG8_BAR; PG8_WAIT_L(0); PG8_MMA(1, 0, At, B0); PG8_BAR; PG8_SCHED;
            PG8_STAGE(PG8_SB(0, 1), b2 + hstepB, voffB);
            PG8_WAIT_V(6); PG8_BAR; PG8_MMA(1, 1, At, B1); PG8_BAR;
            PG8_LDB(B0, 1, 0); PG8_SCHED; PG8_LDA(At, 1, 0); PG8_STAGE(PG8_SA(0, 1), a2 + hstepA, voffA);
            PG8_WAIT_L(8); PG8_BAR; PG8_WAIT_L(0); PG8_MMA(0, 0, At, B0); PG8_BAR; PG8_SCHED;
            PG8_LDB(B1, 1, 1); PG8_STAGE(PG8_SB(1, 0), b3, voffB);
            PG8_BAR; PG8_WAIT_L(0); PG8_MMA(0, 1, At, B1); PG8_BAR;
            PG8_LDA(At, 1, 1); PG8_STAGE(PG8_SA(1, 0), a3, voffA);
            PG8_BAR; PG8_WAIT_L(0); PG8_MMA(1, 0, At, B0); PG8_BAR; PG8_SCHED;
            PG8_STAGE(PG8_SB(1, 1), b3 + hstepB, voffB);
            PG8_WAIT_V(6); PG8_BAR; PG8_MMA(1, 1, At, B1); PG8_BAR;
        }
        E(acc, cur, wr, wc, fr, fq);
        if (!has_next) break;
#pragma unroll
        for (int a = 0; a < 2; ++a)
#pragma unroll
            for (int b = 0; b < 2; ++b)
#pragma unroll
                for (int m = 0; m < 4; ++m)
#pragma unroll
                    for (int n = 0; n < 2; ++n) acc[a][b][m][n] = (f32x4){0.f, 0.f, 0.f, 0.f};
        cur = nxt; cA = nA; cB = nB; ++ui;
    }
    PG8_WAIT_V(0);
    if (wr == 0) PG8_BAR;
    PG8_BAR;
#undef PG8_SA
#undef PG8_SB
#undef PG8_STAGE
#undef PG8_LDA
#undef PG8_LDB
#undef PG8_MMA
#undef PG8_WAIT_V
#undef PG8_WAIT_L
#undef PG8_BAR
#undef PG8_SCHED
}

typedef int v4i_t __attribute__((ext_vector_type(4)));
typedef int v8i_t __attribute__((ext_vector_type(8)));
template <class Epi, class Sched>
__device__ __forceinline__ void gemm_phase_f8(LAS unsigned char* lds, const int K  , const unsigned lda_b, const unsigned ldb_b, const Sched& S, const Epi& E) {
    const int tid = opaque_tid(), wid = __builtin_amdgcn_readfirstlane(tid >> 6), lane = tid & 63, wr = wid >> 2, wc = wid & 3, fr = lane & 15, fq = lane >> 4;
    const int nt = K / 128;
    unsigned voffA[2], voffB[2];
#pragma unroll
    for (int i = 0; i < 2; ++i) { int R, C; stage_rc(tid * 16 + i * 8192, R, C); voffA[i] = (unsigned)R * lda_b + (unsigned)C * 2u; voffB[i] = (unsigned)R * ldb_b + (unsigned)C * 2u; }
    const size_t kstep = (size_t)(BK * 2);
    const size_t hstepA = (size_t)HALF * lda_b, hstepB = (size_t)HALF * ldb_b;
    const unsigned ldsw = (unsigned)wid * 1024u;
    const int aoff = lds_byte(wr * 64 + fr, fq * 8), boff = lds_byte(wc * 32 + fr, fq * 8);
#define PG8_SA(b, h) (((b) * 2 + (h)) * HTB)
#define PG8_SB(b, h) ((4 + (b) * 2 + (h)) * HTB)
#define PG8_STAGE(bufoff, gbase, voff) do { _Pragma("unroll") for (int _i = 0; _i < 2; ++_i) \
        __builtin_amdgcn_global_load_lds((const unsigned*)((const char*)(gbase) + (voff)[_i]), (LAS unsigned*)(lds + (bufoff) + ldsw + _i * 8192), 16, 0, 0); } while (0)
#define PG8_LDA(dst, b, h) do { _Pragma("unroll") for (int m = 0; m < 4; ++m) { const v4i_t lo_ = *(const LAS v4i_t*)(lds + PG8_SA(b, h) + aoff + m * 2048), hi_ = *(const LAS v4i_t*)(lds + PG8_SA(b, h) + aoff + m * 2048 + 1024); dst[m] = __builtin_shufflevector(lo_, hi_, 0, 1, 2, 3, 4, 5, 6, 7); } } while (0)
#define PG8_LDB(dst, b, h) do { _Pragma("unroll") for (int n = 0; n < 2; ++n) { const v4i_t lo_ = *(const LAS v4i_t*)(lds + PG8_SB(b, h) + boff + n * 2048), hi_ = *(const LAS v4i_t*)(lds + PG8_SB(b, h) + boff + n * 2048 + 1024); dst[n] = __builtin_shufflevector(lo_, hi_, 0, 1, 2, 3, 4, 5, 6, 7); } } while (0)
#define PG8_MMA(ai, bj, At, Bt) do { __builtin_amdgcn_s_setprio(1); _Pragma("unroll") for (int m = 0; m < 4; ++m) _Pragma("unroll") for (int n = 0; n < 2; ++n) \
        asm volatile("v_mfma_scale_f32_16x16x128_f8f6f4 %0, %1, %2, %0, %3, %3 op_sel_hi:[0,0,0]" : "+v"(acc[ai][bj][m][n]) : "v"(Bt[n]), "v"(At[m]), "v"(unit_scale)); __builtin_amdgcn_s_setprio(0); } while (0)
#define PG8_WAIT_V(n) asm volatile("s_waitcnt vmcnt(" #n ")" ::: "memory")
#define PG8_WAIT_L(n) asm volatile("s_waitcnt lgkmcnt(" #n ")" ::: "memory")
#define PG8_BAR __builtin_amdgcn_s_barrier()
#define PG8_SCHED __builtin_amdgcn_sched_barrier(0)
    const int unit_scale = 0x7f7f7f7f;
    GUnit cur, nxt; int ui = 0;
    if (!S.next(0, cur)) return;
    f32x4 acc[2][2][4][2];
#pragma unroll
    for (int a = 0; a < 2; ++a)
#pragma unroll
        for (int b = 0; b < 2; ++b)
#pragma unroll
            for (int m = 0; m < 4; ++m)
#pragma unroll
                for (int n = 0; n < 2; ++n) acc[a][b][m][n] = (f32x4){0.f, 0.f, 0.f, 0.f};
    v8i_t At[4], B0[2], B1[2];
    const char* cA = cur.A; const char* cB = cur.B;
    PG8_STAGE(PG8_SB(0, 0), cB, voffB); PG8_STAGE(PG8_SA(0, 0), cA, voffA); PG8_STAGE(PG8_SB(0, 1), cB + hstepB, voffB); PG8_STAGE(PG8_SA(0, 1), cA + hstepA, voffA);
    if (wr == 1) PG8_BAR;
    PG8_WAIT_V(4); PG8_BAR;
    PG8_STAGE(PG8_SB(1, 0), cB + kstep, voffB); PG8_STAGE(PG8_SA(1, 0), cA + kstep, voffA); PG8_STAGE(PG8_SB(1, 1), cB + hstepB + kstep, voffB);
    PG8_WAIT_V(6); PG8_BAR;
    for (;;) {
        const bool has_next = S.next(ui + 1, nxt);
        const char* nA = has_next ? nxt.A : cA; const char* nB = has_next ? nxt.B : cB;
#pragma nounroll
        for (int t = 0; t < nt; t += 2) {
            const bool last = (t == nt - 2);
            const char* a1 = cA + (size_t)(t + 1) * kstep;
            const char* a2 = last ? nA : cA + (size_t)(t + 2) * kstep; const char* b2 = last ? nB : cB + (size_t)(t + 2) * kstep;
            const char* a3 = a2 + kstep; const char* b3 = b2 + kstep;
            PG8_LDB(B0, 0, 0); PG8_SCHED; PG8_LDA(At, 0, 0); PG8_STAGE(PG8_SA(1, 1), a1 + hstepA, voffA);
            PG8_WAIT_L(8); PG8_BAR; PG8_WAIT_L(0); PG8_MMA(0, 0, At, B0); PG8_BAR; PG8_SCHED;
            PG8_LDB(B1, 0, 1); PG8_STAGE(PG8_SB(0, 0), b2, voffB);
            PG8_BAR; PG8_WAIT_L(0); PG8_MMA(0, 1, At, B1); PG8_BAR;
            PG8_LDA(At, 0, 1); PG8_STAGE(PG8_SA(0, 0), a2, voffA);
            PG8_BAR; PG8_WAIT_L(0); PG8_MMA(1, 0, At, B0); PG8_BAR; PG8_SCHED;
            PG8_STAGE(PG8_SB(0, 1), b2 + hstepB, voffB);
            PG8_WAIT_V(6); PG8_BAR; PG8_MMA(1, 1, At, B1); PG8_BAR;
            PG8_LDB(B0, 1, 0); PG8_SCHED; PG8_LDA(At, 1, 0); PG8_STAGE(PG8_SA(0, 1), a2 + hstepA, voffA);
            PG8_WAIT_L(8); PG8_BAR; PG8_WAIT_L(0); PG8_MMA(0, 0, At, B0); PG8_BAR; PG8_SCHED;
            PG8_LDB(B1, 1, 1); PG8_STAGE(PG8_SB(1, 0), b3, voffB);
            PG8_BAR; PG8_WAIT_L(0); PG8_MMA(0, 1, At, B1); PG8_BAR;
            PG8_LDA(At, 1, 1); PG8_STAGE(PG8_SA(1, 0), a3, voffA);
            PG8_BAR; PG8_WAIT_L(0); PG8_MMA(1, 0, At, B0); PG8_BAR; PG8_SCHED;
            PG8_STAGE(PG8_SB(1, 1), b3 + hstepB, voffB);
            PG8_WAIT_V(6); PG8_BAR; PG8_MMA(1, 1, At, B1); PG8_BAR;
        }
        asm volatile("s_nop 15\n\ts_nop 15" ::: "memory");
        E(acc, cur, wr, wc, fr, fq);
        if (!has_next) break;
#pragma unroll
        for (int a = 0; a < 2; ++a)
#pragma unroll
            for (int b = 0; b < 2; ++b)
#pragma unroll
                for (int m = 0; m < 4; ++m)
#pragma unroll
                    for (int n = 0; n < 2; ++n) acc[a][b][m][n] = (f32x4){0.f, 0.f, 0.f, 0.f};
        cur = nxt; cA = nA; cB = nB; ++ui;
    }
    PG8_WAIT_V(0);
    if (wr == 0) PG8_BAR;
    PG8_BAR;
#undef PG8_SA
#undef PG8_SB
#undef PG8_STAGE
#undef PG8_LDA
#undef PG8_LDB
#undef PG8_MMA
#undef PG8_WAIT_V
#undef PG8_WAIT_L
#undef PG8_BAR
#undef PG8_SCHED
}

template <class Epi, class Sched>
__device__ __forceinline__ void gemm_phase_f8g(LAS unsigned char* lds, const int K  , const unsigned lda_b, const unsigned ldb_b, const Sched& S, const Epi& E, const char* Abase, const int* __restrict__ tok) {
    const int tid = opaque_tid(), wid = __builtin_amdgcn_readfirstlane(tid >> 6), lane = tid & 63, wr = wid >> 2, wc = wid & 3, fr = lane & 15, fq = lane >> 4;
    const int nt = K / 128;
    unsigned voffA[2], voffB[2];
    int RA[2]; unsigned CA[2];
#pragma unroll
    for (int i = 0; i < 2; ++i) { int R, C; stage_rc(tid * 16 + i * 8192, R, C); RA[i] = R; CA[i] = (unsigned)C * 2u; voffA[i] = 0u; voffB[i] = (unsigned)R * ldb_b + (unsigned)C * 2u; }
    unsigned cv0[2], cv1[2], nv0[2], nv1[2];
#define PG8_TOKV(v0_, v1_, row0_) do { _Pragma("unroll") for (int i_ = 0; i_ < 2; ++i_) { v0_[i_] = (unsigned)tok[(row0_) + RA[i_]] * lda_b + CA[i_]; v1_[i_] = (unsigned)tok[(row0_) + HALF + RA[i_]] * lda_b + CA[i_]; } } while (0)
    const size_t kstep = (size_t)(BK * 2);
    const size_t hstepA = (size_t)HALF * lda_b, hstepB = (size_t)HALF * ldb_b;
    const unsigned ldsw = (unsigned)wid * 1024u;
    const int aoff = lds_byte(wr * 64 + fr, fq * 8), boff = lds_byte(wc * 32 + fr, fq * 8);
#define PG8_SA(b, h) (((b) * 2 + (h)) * HTB)
#define PG8_SB(b, h) ((4 + (b) * 2 + (h)) * HTB)
#define PG8_STAGE(bufoff, gbase, voff) do { _Pragma("unroll") for (int _i = 0; _i < 2; ++_i) \
        __builtin_amdgcn_global_load_lds((const unsigned*)((const char*)(gbase) + (voff)[_i]), (LAS unsigned*)(lds + (bufoff) + ldsw + _i * 8192), 16, 0, 0); } while (0)
#define PG8_LDA(dst, b, h) do { _Pragma("unroll") for (int m = 0; m < 4; ++m) { const v4i_t lo_ = *(const LAS v4i_t*)(lds + PG8_SA(b, h) + aoff + m * 2048), hi_ = *(const LAS v4i_t*)(lds + PG8_SA(b, h) + aoff + m * 2048 + 1024); dst[m] = __builtin_shufflevector(lo_, hi_, 0, 1, 2, 3, 4, 5, 6, 7); } } while (0)
#define PG8_LDB(dst, b, h) do { _Pragma("unroll") for (int n = 0; n < 2; ++n) { const v4i_t lo_ = *(const LAS v4i_t*)(lds + PG8_SB(b, h) + boff + n * 2048), hi_ = *(const LAS v4i_t*)(lds + PG8_SB(b, h) + boff + n * 2048 + 1024); dst[n] = __builtin_shufflevector(lo_, hi_, 0, 1, 2, 3, 4, 5, 6, 7); } } while (0)
#define PG8_MMA(ai, bj, At, Bt) do { __builtin_amdgcn_s_setprio(1); _Pragma("unroll") for (int m = 0; m < 4; ++m) _Pragma("unroll") for (int n = 0; n < 2; ++n) \
        asm volatile("v_mfma_scale_f32_16x16x128_f8f6f4 %0, %1, %2, %0, %3, %3 op_sel_hi:[0,0,0]" : "+v"(acc[ai][bj][m][n]) : "v"(Bt[n]), "v"(At[m]), "v"(unit_scale)); __builtin_amdgcn_s_setprio(0); } while (0)
#define PG8_WAIT_V(n) asm volatile("s_waitcnt vmcnt(" #n ")" ::: "memory")
#define PG8_WAIT_L(n) asm volatile("s_waitcnt lgkmcnt(" #n ")" ::: "memory")
#define PG8_BAR __builtin_amdgcn_s_barrier()
#define PG8_SCHED __builtin_amdgcn_sched_barrier(0)
    const int unit_scale = 0x7f7f7f7f;
    GUnit cur, nxt; int ui = 0;
    if (!S.next(0, cur)) return;
    f32x4 acc[2][2][4][2];
#pragma unroll
    for (int a = 0; a < 2; ++a)
#pragma unroll
        for (int b = 0; b < 2; ++b)
#pragma unroll
            for (int m = 0; m < 4; ++m)
#pragma unroll
                for (int n = 0; n < 2; ++n) acc[a][b][m][n] = (f32x4){0.f, 0.f, 0.f, 0.f};
    v8i_t At[4], B0[2], B1[2];
    const char* cB = cur.B;
    PG8_TOKV(cv0, cv1, cur.row0);
    PG8_STAGE(PG8_SB(0, 0), cB, voffB); PG8_STAGE(PG8_SA(0, 0), Abase, cv0); PG8_STAGE(PG8_SB(0, 1), cB + hstepB, voffB); PG8_STAGE(PG8_SA(0, 1), Abase, cv1);
    if (wr == 1) PG8_BAR;
    PG8_WAIT_V(4); PG8_BAR;
    PG8_STAGE(PG8_SB(1, 0), cB + kstep, voffB); PG8_STAGE(PG8_SA(1, 0), Abase + kstep, cv0); PG8_STAGE(PG8_SB(1, 1), cB + hstepB + kstep, voffB);
    PG8_WAIT_V(6); PG8_BAR;
    for (;;) {
        const bool has_next = S.next(ui + 1, nxt);
        const char* nB = has_next ? nxt.B : cB;
        if (has_next) PG8_TOKV(nv0, nv1, nxt.row0); else { nv0[0] = cv0[0]; nv0[1] = cv0[1]; nv1[0] = cv1[0]; nv1[1] = cv1[1]; }
#pragma nounroll
        for (int t = 0; t < nt; t += 2) {
            const bool last = (t == nt - 2);
            const char* a1 = Abase + (size_t)(t + 1) * kstep;
            const char* a2 = last ? Abase : Abase + (size_t)(t + 2) * kstep; const char* b2 = last ? nB : cB + (size_t)(t + 2) * kstep;
            const char* a3 = a2 + kstep; const char* b3 = b2 + kstep;
            unsigned v20[2], v21[2];
            v20[0] = last ? nv0[0] : cv0[0]; v20[1] = last ? nv0[1] : cv0[1]; v21[0] = last ? nv1[0] : cv1[0]; v21[1] = last ? nv1[1] : cv1[1];
            PG8_LDB(B0, 0, 0); PG8_SCHED; PG8_LDA(At, 0, 0); PG8_STAGE(PG8_SA(1, 1), a1, cv1);
            PG8_WAIT_L(8); PG8_BAR; PG8_WAIT_L(0); PG8_MMA(0, 0, At, B0); PG8_BAR; PG8_SCHED;
            PG8_LDB(B1, 0, 1); PG8_STAGE(PG8_SB(0, 0), b2, voffB);
            PG8_BAR; PG8_WAIT_L(0); PG8_MMA(0, 1, At, B1); PG8_BAR;
            PG8_LDA(At, 0, 1); PG8_STAGE(PG8_SA(0, 0), a2, v20);
            PG8_BAR; PG8_WAIT_L(0); PG8_MMA(1, 0, At, B0); PG8_BAR; PG8_SCHED;
            PG8_STAGE(PG8_SB(0, 1), b2 + hstepB, voffB);
            PG8_WAIT_V(6); PG8_BAR; PG8_MMA(1, 1, At, B1); PG8_BAR;
            PG8_LDB(B0, 1, 0); PG8_SCHED; PG8_LDA(At, 1, 0); PG8_STAGE(PG8_SA(0, 1), a2, v21);
            PG8_WAIT_L(8); PG8_BAR; PG8_WAIT_L(0); PG8_MMA(0, 0, At, B0); PG8_BAR; PG8_SCHED;
            PG8_LDB(B1, 1, 1); PG8_STAGE(PG8_SB(1, 0), b3, voffB);
            PG8_BAR; PG8_WAIT_L(0); PG8_MMA(0, 1, At, B1); PG8_BAR;
            PG8_LDA(At, 1, 1); PG8_STAGE(PG8_SA(1, 0), a3, v20);
            PG8_BAR; PG8_WAIT_L(0); PG8_MMA(1, 0, At, B0); PG8_BAR; PG8_SCHED;
            PG8_STAGE(PG8_SB(1, 1), b3 + hstepB, voffB);
            PG8_WAIT_V(6); PG8_BAR; PG8_MMA(1, 1, At, B1); PG8_BAR;
        }
        asm volatile("s_nop 15\n\ts_nop 15" ::: "memory");
        E(acc, cur, wr, wc, fr, fq);
        if (!has_next) break;
#pragma unroll
        for (int a = 0; a < 2; ++a)
#pragma unroll
            for (int b = 0; b < 2; ++b)
#pragma unroll
                for (int m = 0; m < 4; ++m)
#pragma unroll
                    for (int n = 0; n < 2; ++n) acc[a][b][m][n] = (f32x4){0.f, 0.f, 0.f, 0.f};
        cur = nxt; cB = nB; ++ui; cv0[0] = nv0[0]; cv0[1] = nv0[1]; cv1[0] = nv1[0]; cv1[1] = nv1[1];
    }
    PG8_WAIT_V(0);
    if (wr == 0) PG8_BAR;
    PG8_BAR;
#undef PG8_TOKV
#undef PG8_SA
#undef PG8_SB
#undef PG8_STAGE
#undef PG8_LDA
#undef PG8_LDB
#undef PG8_MMA
#undef PG8_WAIT_V
#undef PG8_WAIT_L
#undef PG8_BAR
#undef PG8_SCHED
}

__device__ __forceinline__ void dense_map(int L, int nM, int nN, int& pm, int& pn) {
    const int nwg = nM * nN;
    int wgid = L; { const int q = nwg / 8, r = nwg % 8, xcd = wgid % 8, off = wgid / 8; wgid = (xcd < r ? xcd * (q + 1) : r * (q + 1) + (xcd - r) * q) + off; }
    const int nig = 8 * nN, gid = wgid / nig, fm = gid * 8, gsz = (nM - fm) < 8 ? (nM - fm) : 8;
    pm = fm + ((wgid % nig) % gsz); pn = (wgid % nig) / gsz;
}
struct DenseOrder {
    const char* A; const char* Bt; unsigned lda_b, ldb_b; int nM, nN, nwg, G, c;
    __device__ void init(const void* A_, const void* Bt_, int M, int N, unsigned lda_b_, unsigned ldb_b_, int G_, int c_) { A = (const char*)A_; Bt = (const char*)Bt_; lda_b = lda_b_; ldb_b = ldb_b_; nM = M / BM; nN = N / BM; nwg = nM * nN; G = G_; c = c_; }
    __device__ bool next(int i, GUnit& u) const {
        const long L = (long)i * G + c; if (L >= nwg) return false;
        int pm, pn; dense_map((int)L, nM, nN, pm, pn);
        u.A = A + (size_t)pm * BM * lda_b; u.B = Bt + (size_t)pn * BM * ldb_b; u.row0 = pm * BM; u.col0 = pn * BM; u.aux = 0; return true;
    }
};


struct OneUnit {
    GUnit u;
    __device__ bool next(int i, GUnit& o) const { if (i != 0) return false; o = u; return true; }
};
struct EpiF32R {
    float* C; int ldc; const float* res; int ncols;
    __device__ __forceinline__ void operator()(const f32x4 (&acc)[2][2][4][2], const GUnit& u, int wr, int wc, int fr, int fq) const {
        const int row0 = u.row0 + wr * 64 + fr, col0 = u.col0 + wc * 32 + 4 * fq;
#pragma unroll
        for (int ai = 0; ai < 2; ++ai)
#pragma unroll
            for (int m = 0; m < 4; ++m) {
                const size_t ro = (size_t)(row0 + ai * HALF + m * 16) * ldc;
#pragma unroll
                for (int bj = 0; bj < 2; ++bj)
#pragma unroll
                    for (int n = 0; n < 2; ++n) {
                        const int col = col0 + bj * HALF + n * 16;
                        if (col < ncols) { f32x4 x = acc[ai][bj][m][n]; if (res) x += *(const f32x4*)(res + ro + col); *(f32x4*)(C + ro + col) = x; }
                    }
            }
    }
};


struct EpiResNormStats {
    const float* res; bf16_t* Hb; float* ss; unsigned char* H8;
    __device__ __forceinline__ void operator()(const f32x4 (&acc)[2][2][4][2], const GUnit& u, int wr, int wc, int fr, int fq) const {
        const int row0 = u.row0 + wr * 64 + fr, col0 = u.col0 + wc * 32 + 4 * fq;
#pragma unroll
        for (int ai = 0; ai < 2; ++ai)
#pragma unroll
            for (int m = 0; m < 4; ++m) {
                const int row = row0 + ai * HALF + m * 16;
                const size_t ro = (size_t)row * 1024;
                float sq = 0.f;
#pragma unroll
                for (int bj = 0; bj < 2; ++bj)
#pragma unroll
                    for (int n = 0; n < 2; ++n) {
                        const int col = col0 + bj * HALF + n * 16;
                        const f32x4 x = acc[ai][bj][m][n] + *(const f32x4*)(res + ro + col);
                        uint2 o; o.x = cvt_pk_bf16(x[0], x[1]); o.y = cvt_pk_bf16(x[2], x[3]);
                        *(uint2*)(Hb + ro + col) = o;
                        *(unsigned*)(H8 + ro + col) = pk4_fp8(x[0], x[1], x[2], x[3]);
                        sq += x[0] * x[0] + x[1] * x[1] + x[2] * x[2] + x[3] * x[3];
                    }
                sq += __shfl_xor(sq, 16); sq += __shfl_xor(sq, 32);
                if (fq == 0) ss[(size_t)row * 16 + (u.col0 >> 8) * 4 + wc] = sq;
            }
    }
};
struct EpiBf16RowScale {
    bf16_t* O; const float* ss; float scale;
    __device__ __forceinline__ void operator()(const f32x4 (&acc)[2][2][4][2], const GUnit& u, int wr, int wc, int fr, int fq) const {
        const int row0 = u.row0 + wr * 64 + fr, col0 = u.col0 + wc * 32 + 4 * fq;
#pragma unroll
        for (int ai = 0; ai < 2; ++ai)
#pragma unroll
            for (int m = 0; m < 4; ++m) {
                const int row = row0 + ai * HALF + m * 16;
                const f32x4* sp = (const f32x4*)(ss + (size_t)row * 16);
                const f32x4 s0 = sp[0], s1 = sp[1], s2 = sp[2], s3 = sp[3];
                const float tot = (((s0[0] + s0[1]) + (s0[2] + s0[3])) + ((s1[0] + s1[1]) + (s1[2] + s1[3]))) + (((s2[0] + s2[1]) + (s2[2] + s2[3])) + ((s3[0] + s3[1]) + (s3[2] + s3[3])));
                const float rs = rsqrtf(tot * (1.f / 1024.f) + 1e-5f) * scale;
                bf16_t* rowp = O + (size_t)row * 1024 + col0;
#pragma unroll
                for (int bj = 0; bj < 2; ++bj)
#pragma unroll
                    for (int n = 0; n < 2; ++n) { const f32x4 x = acc[ai][bj][m][n] * rs; uint2 o; o.x = cvt_pk_bf16(x[0], x[1]); o.y = cvt_pk_bf16(x[2], x[3]); *(uint2*)(rowp + bj * HALF + n * 16) = o; }
            }
    }
};

struct EpiBf16Res {
    bf16_t* H; float scale;
    __device__ __forceinline__ void operator()(const f32x4 (&acc)[2][2][4][2], const GUnit& u, int wr, int wc, int fr, int fq) const {
        const int row0 = u.row0 + wr * 64 + fr, col0 = u.col0 + wc * 32 + 4 * fq;
#pragma unroll
        for (int ai = 0; ai < 2; ++ai)
#pragma unroll
            for (int m = 0; m < 4; ++m) {
                bf16_t* rowp = H + (size_t)(row0 + ai * HALF + m * 16) * 1024 + col0;
#pragma unroll
                for (int bj = 0; bj < 2; ++bj)
#pragma unroll
                    for (int n = 0; n < 2; ++n) {
                        const uint2 r = *(const uint2*)(rowp + bj * HALF + n * 16);
                        const f32x4 a = acc[ai][bj][m][n] * scale;
                        uint2 o; o.x = cvt_pk_bf16(a[0] + __uint_as_float(r.x << 16), a[1] + __uint_as_float(r.x & 0xffff0000u)); o.y = cvt_pk_bf16(a[2] + __uint_as_float(r.y << 16), a[3] + __uint_as_float(r.y & 0xffff0000u));
                        *(uint2*)(rowp + bj * HALF + n * 16) = o;
                    }
            }
    }
};
struct EpiBf16S {
    bf16_t* O; int ldc; float scale;
    __device__ __forceinline__ void operator()(const f32x4 (&acc)[2][2][4][2], const GUnit& u, int wr, int wc, int fr, int fq) const {
        const int row0 = u.row0 + wr * 64 + fr, col0 = u.col0 + wc * 32 + 4 * fq;
#pragma unroll
        for (int ai = 0; ai < 2; ++ai)
#pragma unroll
            for (int m = 0; m < 4; ++m) {
                bf16_t* rowp = O + (size_t)(row0 + ai * HALF + m * 16) * ldc + col0;
#pragma unroll
                for (int bj = 0; bj < 2; ++bj)
#pragma unroll
                    for (int n = 0; n < 2; ++n) { const f32x4 x = acc[ai][bj][m][n] * scale; uint2 o; o.x = cvt_pk_bf16(x[0], x[1]); o.y = cvt_pk_bf16(x[2], x[3]); *(uint2*)(rowp + bj * HALF + n * 16) = o; }
            }
    }
};
struct EpiXkv {
    bf16_t *xk, *xvT;
    __device__ __forceinline__ void operator()(const f32x4 (&acc)[2][2][4][2], const GUnit& u, int wr, int wc, int fr, int fq) const {
        const int row0 = u.row0 + wr * 64 + fr, col0 = u.col0 + wc * 32 + 4 * fq;
        const bool isv = u.col0 >= 1024;
#pragma unroll
        for (int ai = 0; ai < 2; ++ai)
#pragma unroll
            for (int m = 0; m < 4; ++m) {
                const int row = row0 + ai * HALF + m * 16, b = row >> 8, key = row & 255;
#pragma unroll
                for (int bj = 0; bj < 2; ++bj)
#pragma unroll
                    for (int n = 0; n < 2; ++n) {
                        const int col = (col0 + bj * HALF + n * 16) & 1023, h = col >> 8, d = col & 255;
                        const f32x4 x = acc[ai][bj][m][n];
                        uint2 o; o.x = cvt_pk_bf16_acc(x[0], x[1]); o.y = cvt_pk_bf16_acc(x[2], x[3]);
                        if (!isv) *(uint2*)(xk + ((size_t)(b * 4 + h) * 256 + key) * 256 + d) = o;
                        else { bf16_t* base = xvT + ((size_t)(b * 4 + h) * 256 + d) * 256 + key;
                               base[0] = (bf16_t)(o.x & 0xffff); base[256] = (bf16_t)(o.x >> 16); base[512] = (bf16_t)(o.y & 0xffff); base[768] = (bf16_t)(o.y >> 16); }
                    }
            }
    }
};

struct EpiMixIn {
    bf16_t *q, *kk  , *vt  , *u, *cb; float* gates; const float* cosT; const float* sinT;
    __device__ __forceinline__ void operator()(const f32x4 (&acc)[2][2][4][2], const GUnit& un, int wr, int wc, int fr, int fq) const {
        const int pn = un.col0 >> 8, w1 = wc & 1, w2 = wc >> 1, dlo = 16 * w1 + 4 * fq;
#pragma unroll
        for (int ai = 0; ai < 2; ++ai)
#pragma unroll
            for (int m = 0; m < 4; ++m) {
                const int t = un.row0 + ai * HALF + wr * 64 + m * 16 + fr, b = t >> 11, sq = t & 2047;
                if (pn <= 4) {
                    const f32x4 cv = *(const f32x4*)(cosT + (size_t)t * 32 + dlo), sv = *(const f32x4*)(sinT + (size_t)t * 32 + dlo);
#pragma unroll
                    for (int bj = 0; bj < 2; ++bj) {
                        const int blk = 2 * bj + w2;
                        f32x4 x0 = acc[ai][bj][m][0], x1 = acc[ai][bj][m][1];
                        const bool rope = (pn < 2) || (bj == 0);
                        if (rope) { const f32x4 r0 = x0 * cv - x1 * sv, r1 = x1 * cv + x0 * sv; x0 = r0; x1 = r1; }
                        if (pn < 2) { x0 *= QS; x1 *= QS; }
                        uint2 o0, o1; o0.x = cvt_pk_bf16_acc(x0[0], x0[1]); o0.y = cvt_pk_bf16_acc(x0[2], x0[3]); o1.x = cvt_pk_bf16_acc(x1[0], x1[1]); o1.y = cvt_pk_bf16_acc(x1[2], x1[3]);
                        if (pn < 2) {
                            bf16_t* dst = q + (size_t)t * 512 + (pn * 4 + blk) * 64 + dlo;
                            *(uint2*)dst = o0; *(uint2*)(dst + 32) = o1;
                        } else {
                            const int g = blk & 1;
                            const size_t rowi = (size_t)(b * 2 + g) * S + sq;
                            if (bj == 0 || pn == 2) {
                                const int ki = (pn == 2) ? bj : pn - 1;
                                bf16_t* dst = kk + (size_t)ki * ((size_t)T * 128) + rowi * 64 + dlo;
                                *(uint2*)dst = o0; *(uint2*)(dst + 32) = o1;
                            } else {
                                bf16_t* base = vt + (size_t)(pn - 3) * ((size_t)T * 128) + ((size_t)(b * 2 + g) * 64 + dlo) * S + sq;
                                base[0 * S] = (bf16_t)(o0.x & 0xffff); base[1 * S] = (bf16_t)(o0.x >> 16); base[2 * S] = (bf16_t)(o0.y & 0xffff); base[3 * S] = (bf16_t)(o0.y >> 16);
                                base[32 * S] = (bf16_t)(o1.x & 0xffff); base[33 * S] = (bf16_t)(o1.x >> 16); base[34 * S] = (bf16_t)(o1.y & 0xffff); base[35 * S] = (bf16_t)(o1.y >> 16);
                            }
                        }
                    }
                } else if (pn < 9) {
#pragma unroll
                    for (int n = 0; n < 2; ++n) {
                        const f32x4 x = acc[ai][0][m][n] * acc[ai][1][m][n];
                        uint2 o; o.x = cvt_pk_bf16(x[0], x[1]); o.y = cvt_pk_bf16(x[2], x[3]);
                        *(uint2*)(u + (size_t)t * 512 + (pn - 5) * 128 + w2 * 64 + n * 32 + dlo) = o;
                    }
                } else if (pn < 11) {
#pragma unroll
                    for (int bj = 0; bj < 2; ++bj)
#pragma unroll
                        for (int n = 0; n < 2; ++n) {
                            const f32x4 x = acc[ai][bj][m][n];
                            uint2 o; o.x = cvt_pk_bf16_acc(x[0], x[1]); o.y = cvt_pk_bf16_acc(x[2], x[3]);
                            *(uint2*)(cb + (size_t)t * 512 + (pn - 9) * 256 + bj * 128 + w2 * 64 + n * 32 + dlo) = o;
                        }
                } else {
                    if (w2 == 0 && dlo < 24) {
                        const f32x4 x = acc[ai][0][m][0];
                        f32x4 sg;
#pragma unroll
                        for (int j = 0; j < 4; ++j) sg[j] = 1.f / (1.f + __expf(-x[j]));
                        *(f32x4*)(gates + (size_t)t * 24 + dlo) = sg;
                    }
                }
            }
    }
};

template <int NPN>
struct MoeOrder {
    const char* A; const char* Bt; const int* tile_e; int nunits, G, c; size_t bt_expert_bytes;
    __device__ void init(const void* A_, const void* Bt_, const int* tile_e_, int ntiles, size_t bt_expert_bytes_, int G_, int c_) { A = (const char*)A_; Bt = (const char*)Bt_; tile_e = tile_e_; nunits = ntiles * NPN; bt_expert_bytes = bt_expert_bytes_; G = G_; c = c_; }
    __device__ bool next(int i, GUnit& u) const {
        const int L = i * G + c; if (L >= nunits) return false;
        const int tl = L / NPN, pn = L % NPN, e = tile_e[tl];
        u.A = A + (size_t)tl * BM * 2048; u.B = Bt + (size_t)e * bt_expert_bytes + (size_t)pn * BM * 2048; u.row0 = tl * BM; u.col0 = pn * BM; u.aux = e; return true;
    }
};
struct EpiSwiglu {
    bf16_t* H; const float* bias;
    __device__ __forceinline__ void operator()(const f32x4 (&acc)[2][2][4][2], const GUnit& u, int wr, int wc, int fr, int fq) const {
        const int row0 = u.row0 + wr * 64 + fr, pn = u.col0 >> 8, cl0 = wc * 32 + 4 * fq;
        const float* bg = bias + (size_t)u.aux * 2048 + pn * 128 + cl0;
        f32x4 bgv[2], buv[2];
#pragma unroll
        for (int n = 0; n < 2; ++n) { bgv[n] = *(const f32x4*)(bg + n * 16); buv[n] = *(const f32x4*)(bg + 1024 + n * 16); }
#pragma unroll
        for (int ai = 0; ai < 2; ++ai)
#pragma unroll
            for (int m = 0; m < 4; ++m) {
                bf16_t* rowp = H + (size_t)(row0 + ai * HALF + m * 16) * 1024 + pn * 128 + cl0;
#pragma unroll
                for (int n = 0; n < 2; ++n) {
                    const f32x4 g4 = acc[ai][0][m][n] + bgv[n], u4 = acc[ai][1][m][n] + buv[n];
                    float h[4];
#pragma unroll
                    for (int j = 0; j < 4; ++j) {
                        const float g = fminf(g4[j], 7.f), uu = fminf(fmaxf(u4[j], -7.f), 7.f);
                        h[j] = (uu + 1.f) * (g / (1.f + __expf(-1.702f * g)));
                    }
                    uint2 o; o.x = cvt_pk_bf16(h[0], h[1]); o.y = cvt_pk_bf16(h[2], h[3]);
                    *(uint2*)(rowp + n * 16) = o;
                }
            }
    }
};
struct EpiDownScale {
    bf16_t* O; const float* bias; const float* w_buf;
    __device__ __forceinline__ void operator()(const f32x4 (&acc)[2][2][4][2], const GUnit& u, int wr, int wc, int fr, int fq) const {
        const int row0 = u.row0 + wr * 64 + fr, col0 = u.col0 + wc * 32 + 4 * fq;
        f32x4 bv[2][2];
#pragma unroll
        for (int bj = 0; bj < 2; ++bj)
#pragma unroll
            for (int n = 0; n < 2; ++n) bv[bj][n] = *(const f32x4*)(bias + (size_t)u.aux * 1024 + col0 + bj * HALF + n * 16);
#pragma unroll
        for (int ai = 0; ai < 2; ++ai)
#pragma unroll
            for (int m = 0; m < 4; ++m) {
                const int row = row0 + ai * HALF + m * 16;
                const float w = w_buf[row];
                bf16_t* rowp = O + (size_t)row * 1024 + col0;
#pragma unroll
                for (int bj = 0; bj < 2; ++bj)
#pragma unroll
                    for (int n = 0; n < 2; ++n) {
                        const f32x4 x = (acc[ai][bj][m][n] + bv[bj][n]) * w;
                        uint2 o; o.x = cvt_pk_bf16(x[0], x[1]); o.y = cvt_pk_bf16(x[2], x[3]);
                        *(uint2*)(rowp + bj * HALF + n * 16) = o;
                    }
            }
    }
};

constexpr float W8_SCALE = 64.f, W8_INV = 1.f / 64.f;
__device__ __forceinline__ unsigned pk4_fp8(float a, float b, float c, float d) { unsigned w = 0; w = __builtin_amdgcn_cvt_pk_fp8_f32(a, b, w, false); w = __builtin_amdgcn_cvt_pk_fp8_f32(c, d, w, true); return w; }
struct EpiSwigluF8out {
    unsigned char* H; const float* bias;
    __device__ __forceinline__ void operator()(const f32x4 (&acc)[2][2][4][2], const GUnit& u, int wr, int wc, int fr, int fq) const {
        const int row0 = u.row0 + wr * 64 + fr, pn = u.col0 >> 8, cl0 = wc * 32 + 4 * fq;
        const float* bg = bias + (size_t)u.aux * 2048 + pn * 128 + cl0;
        f32x4 bgv[2], buv[2];
#pragma unroll
        for (int n = 0; n < 2; ++n) { bgv[n] = *(const f32x4*)(bg + n * 16); buv[n] = *(const f32x4*)(bg + 1024 + n * 16); }
#pragma unroll
        for (int ai = 0; ai < 2; ++ai)
#pragma unroll
            for (int m = 0; m < 4; ++m) {
                unsigned char* rowp = H + (size_t)(row0 + ai * HALF + m * 16) * 1024 + pn * 128 + cl0;
#pragma unroll
                for (int n = 0; n < 2; ++n) {
                    const f32x4 g4 = acc[ai][0][m][n] + bgv[n], u4 = acc[ai][1][m][n] + buv[n];
                    float h[4];
#pragma unroll
                    for (int j = 0; j < 4; ++j) {
                        const float g = fminf(g4[j], 7.f), uu = fminf(fmaxf(u4[j], -7.f), 7.f);
                        h[j] = (uu + 1.f) * (g / (1.f + __expf(-1.702f * g)));
                    }
                    *(unsigned*)(rowp + n * 16) = pk4_fp8(h[0], h[1], h[2], h[3]);
                }
            }
    }
};
struct EpiSwigluF8 {
    unsigned char* H; const float* bias;
    __device__ __forceinline__ void operator()(const f32x4 (&acc)[2][2][4][2], const GUnit& u, int wr, int wc, int fr, int fq) const {
        const int row0 = u.row0 + wr * 64 + fr, pn = u.col0 >> 8, cl0 = wc * 32 + 4 * fq;
        const float* bg = bias + (size_t)u.aux * 2048 + pn * 128 + cl0;
        f32x4 bgv[2], buv[2];
#pragma unroll
        for (int n = 0; n < 2; ++n) { bgv[n] = *(const f32x4*)(bg + n * 16); buv[n] = *(const f32x4*)(bg + 1024 + n * 16); }
#pragma unroll
        for (int ai = 0; ai < 2; ++ai)
#pragma unroll
            for (int m = 0; m < 4; ++m) {
                unsigned char* rowp = H + (size_t)(row0 + ai * HALF + m * 16) * 1024 + pn * 128 + cl0;
#pragma unroll
                for (int n = 0; n < 2; ++n) {
                    const f32x4 g4 = acc[ai][0][m][n] * W8_INV + bgv[n], u4 = acc[ai][1][m][n] * W8_INV + buv[n];
                    float h[4];
#pragma unroll
                    for (int j = 0; j < 4; ++j) {
                        const float g = fminf(g4[j], 7.f), uu = fminf(fmaxf(u4[j], -7.f), 7.f);
                        h[j] = (uu + 1.f) * g * __builtin_amdgcn_rcpf(1.f + __builtin_amdgcn_exp2f(-1.702f * 1.4426950408889634f * g));
                    }
                    *(unsigned*)(rowp + n * 16) = pk4_fp8(h[0], h[1], h[2], h[3]);
                }
            }
    }
};
struct EpiDownScaleF8 {
    unsigned char* O; const float* bias; const float* w_buf;
    __device__ __forceinline__ void operator()(const f32x4 (&acc)[2][2][4][2], const GUnit& u, int wr, int wc, int fr, int fq) const {
        const int row0 = u.row0 + wr * 64 + fr, col0 = u.col0 + wc * 32 + 4 * fq;
        f32x4 bv[2][2];
#pragma unroll
        for (int bj = 0; bj < 2; ++bj)
#pragma unroll
            for (int n = 0; n < 2; ++n) bv[bj][n] = *(const f32x4*)(bias + (size_t)u.aux * 1024 + col0 + bj * HALF + n * 16);
#pragma unroll
        for (int ai = 0; ai < 2; ++ai)
#pragma unroll
            for (int m = 0; m < 4; ++m) {
                const int row = row0 + ai * HALF + m * 16;
                const float w = w_buf[row] * 8.f;
                unsigned char* rowp = O + (size_t)row * 1024 + col0;
#pragma unroll
                for (int bj = 0; bj < 2; ++bj)
#pragma unroll
                    for (int n = 0; n < 2; ++n) {
                        const f32x4 x = (acc[ai][bj][m][n] * W8_INV + bv[bj][n]) * w;
                        *(unsigned*)(rowp + bj * HALF + n * 16) = pk4_fp8(x[0], x[1], x[2], x[3]);
                    }
            }
    }
};
template <int NPN>
struct MoeOrderB {
    const char* A; const char* Bt; const int* tile_e; int nunits, G, c; size_t bt_expert_bytes; unsigned row_b;
    __device__ void init(const void* A_, const void* Bt_, const int* tile_e_, int ntiles, size_t bt_expert_bytes_, unsigned row_b_, int G_, int c_) { A = (const char*)A_; Bt = (const char*)Bt_; tile_e = tile_e_; nunits = ntiles * NPN; bt_expert_bytes = bt_expert_bytes_; row_b = row_b_; G = G_; c = c_; }
    __device__ bool next(int i, GUnit& u) const {
        const int L = i * G + c; if (L >= nunits) return false;
        const int tl = L / NPN, pn = L % NPN, e = tile_e[tl];
        u.A = A + (size_t)tl * BM * row_b; u.B = Bt + (size_t)e * bt_expert_bytes + (size_t)pn * BM * row_b; u.row0 = tl * BM; u.col0 = pn * BM; u.aux = e; return true;
    }
};
}


__device__ __forceinline__ void posbias_wave(int n, int lane, const float* __restrict__ pos, const float* __restrict__ w1, const float* __restrict__ b1, float* __restrict__ b1p) {
    float acc = 0.f;
#pragma unroll 8
    for (int i = 0; i < 32; ++i) { const int k = lane + 64 * i; acc += pos[k] * w1[(size_t)k * 256 + n]; }
    acc = wave_sum(acc);
    if (lane == 0) b1p[n] = acc + b1[n];
}
__device__ __forceinline__ void p_cmp_finalize(char* lds, const float* __restrict__ Pab_k, const float* __restrict__ Pab_v, const float* __restrict__ b1p_k, const float* __restrict__ b1p_v,
                                               const float* __restrict__ w2k, const float* __restrict__ w2v, pg::bf16_t* __restrict__ kc, pg::bf16_t* __restrict__ vcT, int wg, int nwg) {
    const int lane = threadIdx.x & 63, wv = threadIdx.x >> 6;
    float* hs = (float*)lds + wv * 256;
    for (int it = wg * 8 + wv; it < 2 * 16 * 128; it += nwg * 8) {
        const int which = it >> 11, row = it & 2047, bg = row >> 7, c = row & 127;
        const float* P = which ? Pab_v : Pab_k; const float* bp = which ? b1p_v : b1p_k; const float* w2 = which ? w2v : w2k;
        float o = 0.f;
        if (c < 127) {
#pragma unroll
            for (int i = 0; i < 4; ++i) { const int n = lane + 64 * i; hs[n] = gelu_tanh(P[(size_t)row * 512 + n] + P[(size_t)(row + 1) * 512 + 256 + n] + bp[n]); }
            __builtin_amdgcn_s_waitcnt(0);
            for (int n = 0; n < 256; ++n) o += hs[n] * w2[n * 64 + lane];
        }
        if (which == 0) kc[(size_t)row * 64 + lane] = pg::f2bf(o); else vcT[((size_t)bg * 64 + lane) * 128 + c] = pg::f2bf(o);
    }
}

namespace at {
using pg::bf16_t;
typedef short bf16x8 __attribute__((ext_vector_type(8)));
typedef float f32x16 __attribute__((ext_vector_type(16)));
typedef float f32x4 __attribute__((ext_vector_type(4)));
constexpr int TROW = 144, TILE_B = 64 * TROW;
#define AT_MFMA(a, b, c) __builtin_amdgcn_mfma_f32_32x32x16_bf16(a, b, c, 0, 0, 0)
__device__ __forceinline__ bf16x8 pack8(const f32x16& p, int s8) {
    union { unsigned u[4]; bf16x8 v; } x;
#pragma unroll
    for (int i = 0; i < 4; ++i) x.u[i] = pg::cvt_pk_bf16(p[s8 + 2 * i], p[s8 + 2 * i + 1]);
    return x.v;
}
template <int MODE>
__device__ __forceinline__ void attn64_unit(char* lds, int b, int g, int tq, const bf16_t* __restrict__ Q, const bf16_t* __restrict__ Kh, const bf16_t* __restrict__ VT,
                                            const unsigned* __restrict__ selmask, bf16_t* __restrict__ out, const bf16_t* __restrict__ o_cmp, const bf16_t* __restrict__ o_win, const float* __restrict__ gates) {
    const int tid = opaque_tid(), lane = tid & 63, r32 = lane & 31, hi = lane >> 5;
    const int wid = __builtin_amdgcn_readfirstlane(tid >> 6), hl = wid >> 1, qs = wid & 1;
    const int ql = 32 * qs + r32, qpos = tq * 64 + ql, h = g * 4 + hl;
    const size_t trow = (size_t)b * S + qpos;
    const bf16_t* Kb = Kh + (size_t)(b * 2 + g) * S * 64;
    const bf16_t* Vb = VT + (size_t)(b * 2 + g) * 64 * S;
    const int srow = tid >> 3, sch = tid & 7;
    const int kst = srow * TROW + sch * 16;
    const int vst = TILE_B + srow * TROW + ((sch >> 1) * 16 + (sch & 1) * 4) * 2;
    bf16x8 qf[4];
#pragma unroll
    for (int d0 = 0; d0 < 4; ++d0) qf[d0] = *(const bf16x8*)(Q + trow * 512 + h * 64 + 16 * d0 + 8 * hi);
    unsigned msk = 0xffffffffu;
    if (MODE == 0) msk = selmask[(size_t)(b * 2 + g) * S + qpos];
    const int nt = (MODE == 0) ? tq + 1 : (tq < 8 ? tq + 1 : 9);
    f32x16 o0, o1;
#pragma unroll
    for (int r = 0; r < 16; ++r) { o0[r] = 0.f; o1[r] = 0.f; }
    float m = -INFINITY, l = 0.f;
    uint4 kreg, vreg;
    kreg = *(const uint4*)(Kb + (size_t)(tq * 64 + srow) * 64 + sch * 8); vreg = *(const uint4*)(Vb + (size_t)srow * S + tq * 64 + sch * 8);
    __syncthreads();
    *(uint4*)(lds + kst) = kreg; *(uint2*)(lds + vst) = make_uint2(vreg.x, vreg.y); *(uint2*)(lds + vst + 16) = make_uint2(vreg.z, vreg.w);
    __syncthreads();
    for (int i = 0; i < nt; ++i) {
        if (i + 1 < nt) { const int tile = tq - i - 1; kreg = *(const uint4*)(Kb + (size_t)(tile * 64 + srow) * 64 + sch * 8); vreg = *(const uint4*)(Vb + (size_t)srow * S + tile * 64 + sch * 8); }
        const char* kb_ = lds + (i & 1) * 2 * TILE_B; const char* vb_ = kb_ + TILE_B;
        f32x16 p0, p1;
#pragma unroll
        for (int r = 0; r < 16; ++r) { p0[r] = 0.f; p1[r] = 0.f; }
#pragma unroll
        for (int d0 = 0; d0 < 4; ++d0) {
            const bf16x8 kf0 = *(const bf16x8*)(kb_ + r32 * TROW + d0 * 32 + hi * 16), kf1 = *(const bf16x8*)(kb_ + (32 + r32) * TROW + d0 * 32 + hi * 16);
            p0 = AT_MFMA(kf0, qf[d0], p0); p1 = AT_MFMA(kf1, qf[d0], p1);
        }
        if (i == 0) {
#pragma unroll
            for (int r = 0; r < 16; ++r) { const int kl = (r & 3) + 8 * (r >> 2) + 4 * hi; if (kl > ql) p0[r] = -INFINITY; if (kl + 32 > ql) p1[r] = -INFINITY; }
        } else if (MODE == 1) {
            if (i == 8) {
#pragma unroll
                for (int r = 0; r < 16; ++r) { const int kl = (r & 3) + 8 * (r >> 2) + 4 * hi; if (kl <= ql) p0[r] = -INFINITY; if (kl + 32 <= ql) p1[r] = -INFINITY; }
            }
        } else {
            if (!((msk >> (tq - i)) & 1u)) {
#pragma unroll
                for (int r = 0; r < 16; ++r) { p0[r] = -INFINITY; p1[r] = -INFINITY; }
            }
        }
        float mx = fmaxf(p0[0], p1[0]);
#pragma unroll
        for (int r = 1; r < 16; ++r) mx = fmaxf(mx, fmaxf(p0[r], p1[r]));
        mx = fmaxf(mx, lane_xor32(mx));
        if (i == 0) m = mx;
        else if (__builtin_amdgcn_ballot_w64(mx > m + 8.f) != 0ull) {
            const float mn = fmaxf(m, mx), alpha = __builtin_amdgcn_exp2f(m - mn);
            m = mn; l *= alpha;
#pragma unroll
            for (int r = 0; r < 16; ++r) { o0[r] *= alpha; o1[r] *= alpha; }
        }
        float ls = 0.f;
#pragma unroll
        for (int r = 0; r < 16; ++r) { p0[r] = __builtin_amdgcn_exp2f(p0[r] - m); p1[r] = __builtin_amdgcn_exp2f(p1[r] - m); ls += p0[r] + p1[r]; }
        l += ls;
        bf16x8 pb[4];
        pb[0] = pack8(p0, 0); pb[1] = pack8(p0, 8); pb[2] = pack8(p1, 0); pb[3] = pack8(p1, 8);
#pragma unroll
        for (int ks = 0; ks < 4; ++ks) {
            const bf16x8 vf0 = *(const bf16x8*)(vb_ + r32 * TROW + ks * 32 + hi * 16), vf1 = *(const bf16x8*)(vb_ + (32 + r32) * TROW + ks * 32 + hi * 16);
            o0 = AT_MFMA(vf0, pb[ks], o0); o1 = AT_MFMA(vf1, pb[ks], o1);
        }
        if (i + 1 < nt) {
            char* nb = lds + ((i + 1) & 1) * 2 * TILE_B;
            *(uint4*)(nb + kst) = kreg; *(uint2*)(nb + vst) = make_uint2(vreg.x, vreg.y); *(uint2*)(nb + vst + 16) = make_uint2(vreg.z, vreg.w);
        }
        __syncthreads();
    }
    const float lt = l + lane_xor32(l), inv = 1.f / lt;
    const size_t obase = trow * 512 + h * 64 + 4 * hi;
    float g0 = 0.f, g1 = inv, g2 = 0.f;
    if (MODE == 0) { g0 = gates[trow * 24 + h * 3 + 0]; g1 = gates[trow * 24 + h * 3 + 1] * inv; g2 = gates[trow * 24 + h * 3 + 2]; }
#pragma unroll
    for (int rr = 0; rr < 4; ++rr)
#pragma unroll
        for (int dh = 0; dh < 2; ++dh) {
            const f32x16& oo = dh ? o1 : o0;
            float x0 = oo[4 * rr] * g1, x1 = oo[4 * rr + 1] * g1, x2 = oo[4 * rr + 2] * g1, x3 = oo[4 * rr + 3] * g1;
            const size_t idx = obase + 32 * dh + 8 * rr;
            if (MODE == 0) {
                const uint2 c = *(const uint2*)(o_cmp + idx), w = *(const uint2*)(o_win + idx);
                x0 += g0 * __uint_as_float(c.x << 16) + g2 * __uint_as_float(w.x << 16); x1 += g0 * __uint_as_float(c.x & 0xffff0000u) + g2 * __uint_as_float(w.x & 0xffff0000u);
                x2 += g0 * __uint_as_float(c.y << 16) + g2 * __uint_as_float(w.y << 16); x3 += g0 * __uint_as_float(c.y & 0xffff0000u) + g2 * __uint_as_float(w.y & 0xffff0000u);
            }
            uint2 o; o.x = pg::cvt_pk_bf16(x0, x1); o.y = pg::cvt_pk_bf16(x2, x3);
            *(uint2*)(out + idx) = o;
        }
}
template <int MODE>
__device__ __forceinline__ void p_attn64(char* lds, const bf16_t* Q, const bf16_t* Kh, const bf16_t* VT, const unsigned* selmask, bf16_t* out, const bf16_t* o_cmp, const bf16_t* o_win, const float* gates, int wg, int nwg) {
    for (int item = wg; item < 256; item += nwg) {
        const int bg = item >> 4, j = item & 15;
        attn64_unit<MODE>(lds, bg >> 1, bg & 1, 31 - j, Q, Kh, VT, selmask, out, o_cmp, o_win, gates);
        attn64_unit<MODE>(lds, bg >> 1, bg & 1, j, Q, Kh, VT, selmask, out, o_cmp, o_win, gates);
    }
}

constexpr int CK_ROW = 144, CV_ROW = 272, CK_B = 128 * CK_ROW, CV_B = 64 * CV_ROW, CP_OFF = CK_B + CV_B, CI_OFF = CP_OFF + 4 * 64 * 32 * 4, CMP_LDS = CI_OFF + 64 * 32 * 4;
__device__ __forceinline__ void cmp_unit(char* lds, int b, int g, int tq, const bf16_t* __restrict__ Q, const bf16_t* __restrict__ kc, const bf16_t* __restrict__ vcT,
                                         bf16_t* __restrict__ out, unsigned* __restrict__ selmask) {
    const int tid = opaque_tid(), lane = tid & 63, r32 = lane & 31, hi = lane >> 5;
    const int wid = __builtin_amdgcn_readfirstlane(tid >> 6), hl = wid >> 1, qs = wid & 1;
    const int ql = 32 * qs + r32, qpos = tq * 64 + ql, h = g * 4 + hl, bg = b * 2 + g;
    const size_t trow = (size_t)b * S + qpos;
    __syncthreads();
#pragma unroll
    for (int i = 0; i < 2; ++i) {
        const int ch = tid + 512 * i;
        { const int row = ch >> 3, c8 = ch & 7; *(uint4*)(lds + row * CK_ROW + c8 * 16) = *(const uint4*)(kc + ((size_t)bg * 128 + row) * 64 + c8 * 8); }
        { const int row = ch >> 4, c16 = ch & 15; const uint4 x = *(const uint4*)(vcT + ((size_t)bg * 64 + row) * 128 + c16 * 8);
          char* dst = lds + CK_B + row * CV_ROW + ((c16 >> 1) * 16 + (c16 & 1) * 4) * 2; *(uint2*)dst = make_uint2(x.x, x.y); *(uint2*)(dst + 16) = make_uint2(x.z, x.w); }
    }
    bf16x8 qf[4];
#pragma unroll
    for (int d0 = 0; d0 < 4; ++d0) qf[d0] = *(const bf16x8*)(Q + trow * 512 + h * 64 + 16 * d0 + 8 * hi);
    __syncthreads();
    f32x16 p[4];
#pragma unroll
    for (int kh = 0; kh < 4; ++kh) {
#pragma unroll
        for (int r = 0; r < 16; ++r) p[kh][r] = 0.f;
#pragma unroll
        for (int d0 = 0; d0 < 4; ++d0) { const bf16x8 kf = *(const bf16x8*)(lds + (32 * kh + r32) * CK_ROW + d0 * 32 + hi * 16); p[kh] = AT_MFMA(kf, qf[d0], p[kh]); }
    }
    float mx = -1e30f;
#pragma unroll
    for (int kh = 0; kh < 4; ++kh)
#pragma unroll
        for (int r = 0; r < 16; ++r) { const int c = 32 * kh + (r & 3) + 8 * (r >> 2) + 4 * hi; if (16 * c + 31 > qpos) p[kh][r] = -1e30f; mx = fmaxf(mx, p[kh][r]); }
    mx = fmaxf(mx, lane_xor32(mx));
    float ls = 0.f;
#pragma unroll
    for (int kh = 0; kh < 4; ++kh)
#pragma unroll
        for (int r = 0; r < 16; ++r) { p[kh][r] = __builtin_amdgcn_exp2f(p[kh][r] - mx); ls += p[kh][r]; }
    ls += lane_xor32(ls);
    const float inv = (mx > -1e29f) ? 1.f / ls : 0.f;
#pragma unroll
    for (int kh = 0; kh < 4; ++kh)
#pragma unroll
        for (int r = 0; r < 16; ++r) p[kh][r] *= inv;
    f32x16 o0, o1;
#pragma unroll
    for (int r = 0; r < 16; ++r) { o0[r] = 0.f; o1[r] = 0.f; }
#pragma unroll
    for (int ks = 0; ks < 8; ++ks) {
        const bf16x8 pb = pack8(p[ks >> 1], (ks & 1) * 8);
        const bf16x8 vf0 = *(const bf16x8*)(lds + CK_B + r32 * CV_ROW + ks * 32 + hi * 16), vf1 = *(const bf16x8*)(lds + CK_B + (32 + r32) * CV_ROW + ks * 32 + hi * 16);
        o0 = AT_MFMA(vf0, pb, o0); o1 = AT_MFMA(vf1, pb, o1);
    }
    bf16_t* orow = out + trow * 512 + h * 64 + 4 * hi;
#pragma unroll
    for (int rr = 0; rr < 4; ++rr) {
        uint2 a, c; a.x = pg::cvt_pk_bf16_acc(o0[4 * rr], o0[4 * rr + 1]); a.y = pg::cvt_pk_bf16_acc(o0[4 * rr + 2], o0[4 * rr + 3]); c.x = pg::cvt_pk_bf16_acc(o1[4 * rr], o1[4 * rr + 1]); c.y = pg::cvt_pk_bf16_acc(o1[4 * rr + 2], o1[4 * rr + 3]);
        *(uint2*)(orow + 8 * rr) = a; *(uint2*)(orow + 32 + 8 * rr) = c;
    }
    float inn[16], car[16];
#pragma unroll
    for (int t = 0; t < 16; ++t) { const f32x16& pk = p[t >> 2]; const int r0 = 4 * (t & 3); car[t] = 0.5f * pk[r0 + 3]; inn[t] = pk[r0] + pk[r0 + 1] + pk[r0 + 2] + car[t]; }
    float* part = (float*)(lds + CP_OFF) + (hl * 64 + ql) * 32;
#pragma unroll
    for (int t = 0; t < 16; ++t) {
        const float co = lane_xor32(car[t]);
        const float cprev = t > 0 ? lane_xor32(car[t - 1]) : 0.f;
        part[2 * t + hi] = inn[t] + (hi ? co : cprev);
    }
    __syncthreads();
    float* impf = (float*)(lds + CI_OFF);
    const float* pall = (const float*)(lds + CP_OFF);
#pragma unroll
    for (int k = 0; k < 4; ++k) {
        const int idx = tid + 512 * k, q = idx >> 5, j = idx & 31, cur = tq;
        float imp = ((pall[(0 * 64 + q) * 32 + j] + pall[(1 * 64 + q) * 32 + j]) + pall[(2 * 64 + q) * 32 + j]) + pall[(3 * 64 + q) * 32 + j];
        if (j == 0 || j == cur || j == cur - 1) imp = 1e30f; else if (j > cur) imp = -1e30f;
        impf[idx] = imp;
    }
    __syncthreads();
#pragma unroll
    for (int k = 0; k < 4; ++k) {
        const int idx = tid + 512 * k, q = idx >> 5, j = idx & 31;
        const float mine = impf[idx];
        int rank = 0;
        for (int i = 0; i < 32; ++i) { const float x = impf[q * 32 + i]; rank += (x > mine || (x == mine && i < j)) ? 1 : 0; }
        const unsigned long long bal = __ballot(rank < 16);
        if ((lane & 31) == 0) selmask[(size_t)bg * S + tq * 64 + q] = (unsigned)(hi ? (bal >> 32) : (bal & 0xffffffffull));
    }
}
__device__ __forceinline__ void p_cmp_attn_fast(char* lds, const bf16_t* Q, const bf16_t* kc, const bf16_t* vcT, bf16_t* out, unsigned* selmask, int wg, int nwg) {
    for (int item = wg; item < 512; item += nwg) cmp_unit(lds, item >> 6, (item >> 5) & 1, item & 31, Q, kc, vcT, out, selmask);
}

constexpr int XK_ROW = 528, XV_ROW = 144, XK_B = 64 * XK_ROW, XV_B = 256 * XV_ROW;
typedef float f32x4v __attribute__((ext_vector_type(4)));
#define XT_MFMA(a, b, c) __builtin_amdgcn_mfma_f32_16x16x32_bf16(a, b, c, 0, 0, 0)
__device__ __forceinline__ void xattn_unit(char* lds, int b, int h, int qt, const bf16_t* __restrict__ Q, const bf16_t* __restrict__ xk, const bf16_t* __restrict__ xvT, unsigned char* __restrict__ out) {
    const int tid = opaque_tid(), lane = tid & 63, l15 = lane & 15, quad = lane >> 4;
    const int wid = __builtin_amdgcn_readfirstlane(tid >> 6);
    const size_t trow = (size_t)b * S + qt * 128 + wid * 16 + l15;
    const bf16_t* Kb = xk + (size_t)(b * 4 + h) * 256 * 256;
    const bf16_t* Vb = xvT + (size_t)(b * 4 + h) * 256 * 256;
    bf16x8 qf[8];
#pragma unroll
    for (int ds = 0; ds < 8; ++ds) qf[ds] = *(const bf16x8*)(Q + trow * 1024 + h * 256 + 32 * ds + 8 * quad);
    f32x4v o[16];
#pragma unroll
    for (int db = 0; db < 16; ++db) o[db] = (f32x4v){0.f, 0.f, 0.f, 0.f};
    float m = -INFINITY, l = 0.f;
    for (int kt = 0; kt < 4; ++kt) {
        __syncthreads();
#pragma unroll
        for (int i = 0; i < 4; ++i) {
            const int ch = tid + 512 * i;
            { const int row = ch >> 5, c = ch & 31; *(uint4*)(lds + row * XK_ROW + c * 16) = *(const uint4*)(Kb + (size_t)(kt * 64 + row) * 256 + c * 8); }
            { const int row = ch >> 3, c = ch & 7, cp = c & 3; const uint4 x = *(const uint4*)(Vb + (size_t)row * 256 + kt * 64 + c * 8);
              char* dst = lds + XK_B + row * XV_ROW + ((c >> 2) * 32 + 16 * (cp & 1) + 4 * (cp >> 1)) * 2; *(uint2*)dst = make_uint2(x.x, x.y); *(uint2*)(dst + 16) = make_uint2(x.z, x.w); }
        }
        __syncthreads();
        f32x4v sc[4];
#pragma unroll
        for (int kb = 0; kb < 4; ++kb) {
            sc[kb] = (f32x4v){0.f, 0.f, 0.f, 0.f};
#pragma unroll
            for (int ds = 0; ds < 8; ++ds) { const bf16x8 kf = *(const bf16x8*)(lds + (16 * kb + l15) * XK_ROW + ds * 64 + quad * 16); sc[kb] = XT_MFMA(kf, qf[ds], sc[kb]); }
        }
        float mx = -INFINITY;
#pragma unroll
        for (int kb = 0; kb < 4; ++kb)
#pragma unroll
            for (int r = 0; r < 4; ++r) mx = fmaxf(mx, sc[kb][r]);
        mx = fmaxf(mx, lane_xor16(mx)); mx = fmaxf(mx, lane_xor32(mx));
        const float mn = fmaxf(m, mx), alpha = __builtin_amdgcn_exp2f(m - mn);
        m = mn;
        float ls = 0.f;
#pragma unroll
        for (int kb = 0; kb < 4; ++kb)
#pragma unroll
            for (int r = 0; r < 4; ++r) { sc[kb][r] = __builtin_amdgcn_exp2f(sc[kb][r] - mn); ls += sc[kb][r]; }
        l = l * alpha + ls;
#pragma unroll
        for (int db = 0; db < 16; ++db) o[db] *= alpha;
#pragma unroll
        for (int k2 = 0; k2 < 2; ++k2) {
            union { unsigned u[4]; bf16x8 v; } pb;
            pb.u[0] = pg::cvt_pk_bf16(sc[2 * k2][0], sc[2 * k2][1]); pb.u[1] = pg::cvt_pk_bf16(sc[2 * k2][2], sc[2 * k2][3]);
            pb.u[2] = pg::cvt_pk_bf16(sc[2 * k2 + 1][0], sc[2 * k2 + 1][1]); pb.u[3] = pg::cvt_pk_bf16(sc[2 * k2 + 1][2], sc[2 * k2 + 1][3]);
#pragma unroll
            for (int db = 0; db < 16; ++db) { const bf16x8 vf = *(const bf16x8*)(lds + XK_B + (16 * db + l15) * XV_ROW + k2 * 64 + quad * 16); o[db] = XT_MFMA(vf, pb.v, o[db]); }
        }
    }
    l += lane_xor16(l); l += lane_xor32(l);
    const float inv = 1.f / l;
    unsigned char* orow = out + trow * 1024 + h * 256 + 4 * quad;
    const float inv16 = inv * 16.f;
#pragma unroll
    for (int db = 0; db < 16; ++db) *(unsigned*)(orow + 16 * db) = pg::pk4_fp8(o[db][0] * inv16, o[db][1] * inv16, o[db][2] * inv16, o[db][3] * inv16);
}
__device__ __forceinline__ void p_xattn_fast(char* lds, const bf16_t* Q, const bf16_t* xk, const bf16_t* xvT, unsigned char* out, int wg, int nwg) {
    for (int item = wg; item < 512; item += nwg) xattn_unit(lds, item >> 6, (item >> 4) & 3, item & 15, Q, xk, xvT, out);
}
}


namespace tl {
using pg::bf16_t; using pg::cvt_pk_bf16;
__device__ __forceinline__ float blo(unsigned u) { return __uint_as_float(u << 16); }
__device__ __forceinline__ float bhi(unsigned u) { return __uint_as_float(u & 0xffff0000u); }
__device__ __forceinline__ float ssq4(const float4& a) { return a.x * a.x + a.y * a.y + a.z * a.z + a.w * a.w; }

__device__ __forceinline__ void rmsnorm_rows(const float* __restrict__ in, const float* __restrict__ g, bf16_t* __restrict__ out, int rows, int gw, int nw, int lane) {
    float4 gv[4];
#pragma unroll
    for (int i = 0; i < 4; ++i) gv[i] = *(const float4*)(g + 256 * i + 4 * lane);
    for (int r0 = gw; r0 < rows; r0 += 2 * nw) {
        const int r1 = r0 + nw; const bool two = r1 < rows;
        float4 a[4], b[4];
#pragma unroll
        for (int i = 0; i < 4; ++i) { a[i] = *(const float4*)(in + (size_t)r0 * 1024 + 256 * i + 4 * lane); b[i] = two ? *(const float4*)(in + (size_t)r1 * 1024 + 256 * i + 4 * lane) : make_float4(0.f, 0.f, 0.f, 0.f); }
        float sa = ssq4(a[0]) + ssq4(a[1]) + ssq4(a[2]) + ssq4(a[3]), sb = ssq4(b[0]) + ssq4(b[1]) + ssq4(b[2]) + ssq4(b[3]);
        sa = wave_sum(sa); sb = wave_sum(sb);
        const float ra = rsqrtf(sa * (1.f / 1024.f) + 1e-5f), rb = rsqrtf(sb * (1.f / 1024.f) + 1e-5f);
#pragma unroll
        for (int i = 0; i < 4; ++i) {
            uint2 o; o.x = cvt_pk_bf16(a[i].x * ra * gv[i].x, a[i].y * ra * gv[i].y); o.y = cvt_pk_bf16(a[i].z * ra * gv[i].z, a[i].w * ra * gv[i].w);
            *(uint2*)(out + (size_t)r0 * 1024 + 256 * i + 4 * lane) = o;
            if (two) { uint2 q; q.x = cvt_pk_bf16(b[i].x * rb * gv[i].x, b[i].y * rb * gv[i].y); q.y = cvt_pk_bf16(b[i].z * rb * gv[i].z, b[i].w * rb * gv[i].w); *(uint2*)(out + (size_t)r1 * 1024 + 256 * i + 4 * lane) = q; }
        }
    }
}

__device__ __forceinline__ void mix_post(const bf16_t* __restrict__ o_nsa, const bf16_t* __restrict__ ub, const bf16_t* __restrict__ cbb, const float* __restrict__ conv_w,
                                         const float* __restrict__ g_nsa, const float* __restrict__ g_conv, bf16_t* __restrict__ omix, int gw, int nw, int lane) {
    float cw[3][8], gn[8], gc[8];
#pragma unroll
    for (int j = 0; j < 8; ++j) { gn[j] = g_nsa[8 * lane + j]; gc[j] = g_conv[8 * lane + j]; cw[0][j] = conv_w[8 * lane + j]; cw[1][j] = conv_w[512 + 8 * lane + j]; cw[2][j] = conv_w[1024 + 8 * lane + j]; }
    for (int t = gw; t < T; t += nw) {
        const int sq = t & (S - 1);
        const uint4 zero = make_uint4(0u, 0u, 0u, 0u);
        const uint4 on4 = *(const uint4*)(o_nsa + (size_t)t * 512 + 8 * lane), c4 = *(const uint4*)(cbb + (size_t)t * 512 + 8 * lane), u2 = *(const uint4*)(ub + (size_t)t * 512 + 8 * lane);
        const uint4 u1 = sq >= 1 ? *(const uint4*)(ub + (size_t)(t - 1) * 512 + 8 * lane) : zero, u0 = sq >= 2 ? *(const uint4*)(ub + (size_t)(t - 2) * 512 + 8 * lane) : zero;
        const unsigned onw[4] = {on4.x, on4.y, on4.z, on4.w}, cbw[4] = {c4.x, c4.y, c4.z, c4.w}, u0w[4] = {u0.x, u0.y, u0.z, u0.w}, u1w[4] = {u1.x, u1.y, u1.z, u1.w}, u2w[4] = {u2.x, u2.y, u2.z, u2.w};
        float on[8], oc[8], ssn = 0.f, ssc = 0.f;
#pragma unroll
        for (int q = 0; q < 4; ++q) {
            on[2 * q] = blo(onw[q]); on[2 * q + 1] = bhi(onw[q]);
            const float y0 = cw[0][2 * q] * blo(u0w[q]) + cw[1][2 * q] * blo(u1w[q]) + cw[2][2 * q] * blo(u2w[q]);
            const float y1 = cw[0][2 * q + 1] * bhi(u0w[q]) + cw[1][2 * q + 1] * bhi(u1w[q]) + cw[2][2 * q + 1] * bhi(u2w[q]);
            oc[2 * q] = blo(cbw[q]) * y0; oc[2 * q + 1] = bhi(cbw[q]) * y1;
        }
#pragma unroll
        for (int j = 0; j < 8; ++j) { ssn += on[j] * on[j]; ssc += oc[j] * oc[j]; }
        ssn = wave_sum(ssn); ssc = wave_sum(ssc);
        const float rn = rsqrtf(ssn * (1.f / 512.f) + 1e-5f), rc = rsqrtf(ssc * (1.f / 512.f) + 1e-5f);
        uint4 o1, o2;
        o1.x = cvt_pk_bf16(on[0] * rn * gn[0], on[1] * rn * gn[1]); o1.y = cvt_pk_bf16(on[2] * rn * gn[2], on[3] * rn * gn[3]); o1.z = cvt_pk_bf16(on[4] * rn * gn[4], on[5] * rn * gn[5]); o1.w = cvt_pk_bf16(on[6] * rn * gn[6], on[7] * rn * gn[7]);
        o2.x = cvt_pk_bf16(oc[0] * rc * gc[0], oc[1] * rc * gc[1]); o2.y = cvt_pk_bf16(oc[2] * rc * gc[2], oc[3] * rc * gc[3]); o2.z = cvt_pk_bf16(oc[4] * rc * gc[4], oc[5] * rc * gc[5]); o2.w = cvt_pk_bf16(oc[6] * rc * gc[6], oc[7] * rc * gc[7]);
        *(uint4*)(omix + (size_t)t * 1024 + 8 * lane) = o1; *(uint4*)(omix + (size_t)t * 1024 + 512 + 8 * lane) = o2;
    }
}

__device__ __forceinline__ void xreduce32(float (&acc)[32], int lane) {
    const bool b3 = lane & 8, b2 = lane & 4, b1 = lane & 2;
#pragma unroll
    for (int e = 0; e < 16; ++e) { const auto r = __builtin_amdgcn_permlane32_swap(__float_as_uint(acc[e]), __float_as_uint(acc[e + 16]), false, false); acc[e] = __uint_as_float(r[0]) + __uint_as_float(r[1]); }
#pragma unroll
    for (int e = 0; e < 8; ++e) { const auto r = __builtin_amdgcn_permlane16_swap(__float_as_uint(acc[e]), __float_as_uint(acc[e + 8]), false, false); acc[e] = __uint_as_float(r[0]) + __uint_as_float(r[1]); }
#pragma unroll
    for (int e = 0; e < 4; ++e) { const float snd = b3 ? acc[e] : acc[e + 4], kp = b3 ? acc[e + 4] : acc[e]; acc[e] = kp + dpp_xor8(snd); }
#pragma unroll
    for (int e = 0; e < 2; ++e) { const float snd = b2 ? acc[e] : acc[e + 2], kp = b2 ? acc[e + 2] : acc[e]; acc[e] = kp + dpp_xor4(snd); }
    { const float snd = b1 ? acc[0] : acc[1], kp = b1 ? acc[1] : acc[0]; acc[0] = kp + dpp_xor2(snd); }
    acc[0] += dpp_xor1(acc[0]);
}
__device__ __forceinline__ void route_token(float logit, int t, int lane, int* __restrict__ a_e, float* __restrict__ a_w, int* __restrict__ a_slot, int* lcnt) {
    const int e = lane >> 1;
    int rank = 0;
#pragma unroll
    for (int i = 0; i < 32; ++i) { const float x = __int_as_float(__builtin_amdgcn_readlane(__float_as_int(logit), 2 * i)); rank += (x > logit || (x == logit && i < e)) ? 1 : 0; }
    const float vmax = wave_max(logit);
    const bool sel = (rank < TOPK) && !(lane & 1);
    const float ex = sel ? __expf(logit - vmax) : 0.f;
    const float sum = wave_sum(ex);
    if (sel) { const int a = t * TOPK + rank; a_e[a] = e; a_w[a] = ex / sum; a_slot[a] = atomicAdd(&lcnt[e], 1); }
}
constexpr int WR_STRIDE = 1028;
__device__ __forceinline__ void norm_router(char* lds, const bf16_t* __restrict__ h2, const float* __restrict__ g, const float* __restrict__ wr, const float* __restrict__ br, unsigned char* __restrict__ xn8,
                                            int* __restrict__ a_e, float* __restrict__ a_w, int* __restrict__ a_slot, int* __restrict__ wgcnt  , int gw, int nw, int lane) {
    float* Ws = (float*)lds;
    int* lcnt = (int*)(lds + NE * WR_STRIDE * 4);
    __syncthreads();
    for (int idx = threadIdx.x; idx < NE * WR_STRIDE / 4; idx += 512) ((uint4*)Ws)[idx] = ((const uint4*)wr)[idx];
    if (threadIdx.x < NE) lcnt[threadIdx.x] = 0;
    __syncthreads();
    float4 gv[4];
#pragma unroll
    for (int i = 0; i < 4; ++i) gv[i] = *(const float4*)(g + 256 * i + 4 * lane);
    const float bias = br[lane >> 1];
    for (int t0 = gw; t0 < T; t0 += 2 * nw) {
        const int t1 = t0 + nw; const bool two = t1 < T;
        float4 a[4], b[4];
#pragma unroll
        for (int i = 0; i < 4; ++i) {
            const uint2 ua = *(const uint2*)(h2 + (size_t)t0 * 1024 + 256 * i + 4 * lane), ub = two ? *(const uint2*)(h2 + (size_t)t1 * 1024 + 256 * i + 4 * lane) : make_uint2(0u, 0u);
            a[i] = make_float4(blo(ua.x), bhi(ua.x), blo(ua.y), bhi(ua.y)); b[i] = make_float4(blo(ub.x), bhi(ub.x), blo(ub.y), bhi(ub.y));
        }
        float sa = ssq4(a[0]) + ssq4(a[1]) + ssq4(a[2]) + ssq4(a[3]), sb = ssq4(b[0]) + ssq4(b[1]) + ssq4(b[2]) + ssq4(b[3]);
        sa = wave_sum(sa); sb = wave_sum(sb);
        const float ra = rsqrtf(sa * (1.f / 1024.f) + 1e-5f), rb = rsqrtf(sb * (1.f / 1024.f) + 1e-5f);
#pragma unroll
        for (int i = 0; i < 4; ++i) {
            a[i].x *= ra; a[i].y *= ra; a[i].z *= ra; a[i].w *= ra;
            b[i].x *= rb; b[i].y *= rb; b[i].z *= rb; b[i].w *= rb;
            *(unsigned*)(xn8 + (size_t)t0 * 1024 + 256 * i + 4 * lane) = pg::pk4_fp8(a[i].x * gv[i].x, a[i].y * gv[i].y, a[i].z * gv[i].z, a[i].w * gv[i].w);
            if (two) *(unsigned*)(xn8 + (size_t)t1 * 1024 + 256 * i + 4 * lane) = pg::pk4_fp8(b[i].x * gv[i].x, b[i].y * gv[i].y, b[i].z * gv[i].z, b[i].w * gv[i].w);
        }
        float accA[32], accB[32];
#pragma unroll
        for (int e = 0; e < 32; ++e) {
            float sA = 0.f, sB = 0.f;
#pragma unroll
            for (int i = 0; i < 4; ++i) {
                const float4 w = *(const float4*)(Ws + e * WR_STRIDE + 256 * i + 4 * lane);
                sA += a[i].x * w.x + a[i].y * w.y + a[i].z * w.z + a[i].w * w.w;
                sB += b[i].x * w.x + b[i].y * w.y + b[i].z * w.z + b[i].w * w.w;
            }
            accA[e] = sA; accB[e] = sB;
        }
        xreduce32(accA, lane); xreduce32(accB, lane);
        route_token(accA[0] + bias, t0, lane, a_e, a_w, a_slot, lcnt);
        if (two) route_token(accB[0] + bias, t1, lane, a_e, a_w, a_slot, lcnt);
    }
    __syncthreads();
    if (threadIdx.x < NE) wgcnt[blockIdx.x * NE + threadIdx.x] = lcnt[threadIdx.x];
}
__device__ __forceinline__ void moe_scatter(char* lds, const int* __restrict__ wgcnt, int* __restrict__ pstart, int* __restrict__ tile_e, const int* __restrict__ a_e, const float* __restrict__ a_w,
                                            const int* __restrict__ a_slot, int* __restrict__ tokmap, float* __restrict__ w_buf, int* __restrict__ dest_of, int wg, int gw, int nw, int lane) {
    int* ps = (int*)lds;
    int* wb = ps + 64;
    int* part = ps + 128;
    __syncthreads();
    {
        const int e = threadIdx.x & 31, q = threadIdx.x >> 5, nwg_ = gridDim.x;
        int tot = 0, below = 0;
        const int per = (nwg_ + 15) / 16;
        for (int w = q * per; w < (q + 1) * per && w < nwg_; ++w) { const int c = wgcnt[w * NE + e]; tot += c; below += (w < wg) ? c : 0; }
        part[(q * NE + e) * 2] = tot; part[(q * NE + e) * 2 + 1] = below;
    }
    __syncthreads();
    if (threadIdx.x < NE) { int tot = 0, below = 0; for (int q = 0; q < 16; ++q) { tot += part[(q * NE + threadIdx.x) * 2]; below += part[(q * NE + threadIdx.x) * 2 + 1]; } ps[96 + threadIdx.x] = tot; wb[threadIdx.x] = below; }
    __syncthreads();
    if (threadIdx.x == 0) { int acc = 0; for (int e = 0; e < NE; ++e) { ps[e] = acc; acc += (ps[96 + e] + MT - 1) / MT * MT; } ps[NE] = acc; }
    __syncthreads();
    if (wg == 0) {
        if (threadIdx.x == 0) pstart[NE] = ps[NE] / MT;
        for (int tl_ = threadIdx.x; tl_ < NTILE; tl_ += 512) { const int r = tl_ * MT; int e = -1; for (int i = 0; i < NE; ++i) if (r >= ps[i] && r < ps[i + 1]) e = i; tile_e[tl_] = e; }
    }
    for (int t = gw; t < T; t += nw) {
        const int4 e4 = *(const int4*)(a_e + 4 * t), s4 = *(const int4*)(a_slot + 4 * t); const float4 w4 = *(const float4*)(a_w + 4 * t);
        const int ee[4] = {e4.x, e4.y, e4.z, e4.w}, sl[4] = {s4.x, s4.y, s4.z, s4.w}; const float ww[4] = {w4.x, w4.y, w4.z, w4.w};
#pragma unroll
        for (int k = 0; k < 4; ++k) {
            const int dest = ps[ee[k]] + wb[ee[k]] + sl[k];
            if (lane == 0) { w_buf[dest] = ww[k]; dest_of[4 * t + k] = dest; tokmap[dest] = t; }
        }
    }
}
__device__ __forceinline__ void final_rows(const bf16_t* __restrict__ h2, const unsigned char* __restrict__ out_a, const int* __restrict__ dest_of, const float* __restrict__ g, float* __restrict__ out, int gw, int nw, int lane) {
    float4 gv[4];
#pragma unroll
    for (int i = 0; i < 4; ++i) gv[i] = *(const float4*)(g + 256 * i + 4 * lane);
    for (int t = gw; t < T; t += nw) {
        const int4 d4 = *(const int4*)(dest_of + 4 * t);
        const int dd[4] = {d4.x, d4.y, d4.z, d4.w};
        uint2 hh[4]; unsigned oa[4][4];
#pragma unroll
        for (int i = 0; i < 4; ++i) hh[i] = *(const uint2*)(h2 + (size_t)t * 1024 + 256 * i + 4 * lane);
#pragma unroll
        for (int k = 0; k < 4; ++k)
#pragma unroll
            for (int i = 0; i < 4; ++i) oa[k][i] = *(const unsigned*)(out_a + (size_t)dd[k] * 1024 + 256 * i + 4 * lane);
        float4 a[4];
        float ss = 0.f;
#pragma unroll
        for (int i = 0; i < 4; ++i) {
            float s0 = 0.f, s1 = 0.f, s2 = 0.f, s3 = 0.f;
#pragma unroll
            for (int k = 0; k < 4; ++k) {
                const auto lo = __builtin_amdgcn_cvt_pk_f32_fp8(oa[k][i], false), hi = __builtin_amdgcn_cvt_pk_f32_fp8(oa[k][i], true);
                s0 += lo[0]; s1 += lo[1]; s2 += hi[0]; s3 += hi[1];
            }
            a[i] = make_float4(blo(hh[i].x) + 0.125f * s0, bhi(hh[i].x) + 0.125f * s1, blo(hh[i].y) + 0.125f * s2, bhi(hh[i].y) + 0.125f * s3);
            ss += ssq4(a[i]);
        }
        ss = wave_sum(ss);
        const float rs = rsqrtf(ss * (1.f / 1024.f) + 1e-5f);
#pragma unroll
        for (int i = 0; i < 4; ++i) *(float4*)(out + (size_t)t * 1024 + 256 * i + 4 * lane) = make_float4(a[i].x * rs * gv[i].x, a[i].y * rs * gv[i].y, a[i].z * rs * gv[i].z, a[i].w * rs * gv[i].w);
    }
}
}

template <bool PERM64, class RowMap>
__device__ __forceinline__ void p_convT(char* lds, const float* __restrict__ W, int K, int N, int nmat, pg::bf16_t* __restrict__ Bt, int nrows_out, RowMap rowmap, int wg, int nwg, const float* __restrict__ kscale = nullptr) {
    uint2* Ls = (uint2*)lds;
    const int tid = opaque_tid();
    const int tk = K / 128, tn = nrows_out / 128, per = tk * tn, total = per * nmat;
    float4 x[2][4];
    auto issue = [&](int tile) {
        const int mat = tile / per, r = tile % per, jn = r / tk, jk = r % tk;
#pragma unroll
        for (int j = 0; j < 2; ++j) {
            const int bid = tid + 512 * j, kb = bid >> 5, n4 = (bid & 31) * 4;
            const int n0 = rowmap(jn * 128 + (n4 & 64));
            const float* src = W + (size_t)mat * K * N + (size_t)(jk * 128 + 4 * kb) * N + n0 + (n4 & 63);
            const bool ok = n0 >= 0 && n0 + (n4 & 63) < N;
#pragma unroll
            for (int rr = 0; rr < 4; ++rr) x[j][rr] = ok ? *(const float4*)(src + (size_t)rr * N) : make_float4(0.f, 0.f, 0.f, 0.f);
        }
    };
    int tile = wg;
    if (tile < total) issue(tile);
    while (tile < total) {
        const int mat = tile / per, r = tile % per, jn = r / tk, jk = r % tk;
        __syncthreads();
#pragma unroll
        for (int j = 0; j < 2; ++j) {
            const int bid = tid + 512 * j, kb = bid >> 5, n4 = (bid & 31) * 4;
            float ks[4];
#pragma unroll
            for (int rr = 0; rr < 4; ++rr) ks[rr] = kscale ? kscale[jk * 128 + 4 * kb + rr] : 1.f;
            uint4 d0, d1;
            d0.x = pg::cvt_pk_bf16(x[j][0].x * ks[0], x[j][1].x * ks[1]); d0.y = pg::cvt_pk_bf16(x[j][2].x * ks[2], x[j][3].x * ks[3]);
            d0.z = pg::cvt_pk_bf16(x[j][0].y * ks[0], x[j][1].y * ks[1]); d0.w = pg::cvt_pk_bf16(x[j][2].y * ks[2], x[j][3].y * ks[3]);
            d1.x = pg::cvt_pk_bf16(x[j][0].z * ks[0], x[j][1].z * ks[1]); d1.y = pg::cvt_pk_bf16(x[j][2].z * ks[2], x[j][3].z * ks[3]);
            d1.z = pg::cvt_pk_bf16(x[j][0].w * ks[0], x[j][1].w * ks[1]); d1.w = pg::cvt_pk_bf16(x[j][2].w * ks[2], x[j][3].w * ks[3]);
            *(uint4*)(Ls + kb * 130 + n4) = d0; *(uint4*)(Ls + kb * 130 + n4 + 2) = d1;
        }
        const int nxt = tile + nwg;
        if (nxt < total) issue(nxt);
        __syncthreads();
#pragma unroll
        for (int i = 0; i < 4; ++i) {
            const int c = tid + 512 * i, n = c >> 4, kc = c & 15;
            const int ns = PERM64 ? ((n & 64) | (n & 15) | ((n & 16) << 1) | ((n & 32) >> 1)) : n;
            const uint2 lo = Ls[(2 * kc) * 130 + ns], hi = Ls[(2 * kc + 1) * 130 + ns];
            *(uint4*)(Bt + ((size_t)mat * nrows_out + jn * 128 + n) * K + jk * 128 + 8 * kc) = make_uint4(lo.x, lo.y, hi.x, hi.y);
        }
        tile = nxt;
    }
}

template <class RowMap>
__device__ __forceinline__ void p_convT8(char* lds, const float* __restrict__ W, int K, int N, int nmat, unsigned char* __restrict__ Bt, int nrows_out, RowMap rowmap, int wg, int nwg, const float* __restrict__ kscale = nullptr) {
    unsigned* Ls = (unsigned*)lds;
    const int tid = opaque_tid();
    const int tk = K / 128, tn = nrows_out / 128, per = tk * tn, total = per * nmat;
    float4 x[2][4];
    auto issue = [&](int tile) {
        const int mat = tile / per, r = tile % per, jn = r / tk, jk = r % tk;
#pragma unroll
        for (int j = 0; j < 2; ++j) {
            const int bid = tid + 512 * j, kb = bid >> 5, n4 = (bid & 31) * 4;
            const int n0 = rowmap(jn * 128 + (n4 & 64));
            const float* src = W + (size_t)mat * K * N + (size_t)(jk * 128 + 4 * kb) * N + n0 + (n4 & 63);
            const bool ok = n0 >= 0 && n0 + (n4 & 63) < N;
#pragma unroll
            for (int rr = 0; rr < 4; ++rr) x[j][rr] = ok ? *(const float4*)(src + (size_t)rr * N) : make_float4(0.f, 0.f, 0.f, 0.f);
        }
    };
    int tile = wg;
    if (tile < total) issue(tile);
    while (tile < total) {
        const int mat = tile / per, r = tile % per, jn = r / tk, jk = r % tk;
        __syncthreads();
#pragma unroll
        for (int j = 0; j < 2; ++j) {
            const int bid = tid + 512 * j, kb = bid >> 5, n4 = (bid & 31) * 4;
            float ks[4];
#pragma unroll
            for (int rr = 0; rr < 4; ++rr) ks[rr] = pg::W8_SCALE * (kscale ? kscale[jk * 128 + 4 * kb + rr] : 1.f);
            uint4 d;
            d.x = pg::pk4_fp8(x[j][0].x * ks[0], x[j][1].x * ks[1], x[j][2].x * ks[2], x[j][3].x * ks[3]);
            d.y = pg::pk4_fp8(x[j][0].y * ks[0], x[j][1].y * ks[1], x[j][2].y * ks[2], x[j][3].y * ks[3]);
            d.z = pg::pk4_fp8(x[j][0].z * ks[0], x[j][1].z * ks[1], x[j][2].z * ks[2], x[j][3].z * ks[3]);
            d.w = pg::pk4_fp8(x[j][0].w * ks[0], x[j][1].w * ks[1], x[j][2].w * ks[2], x[j][3].w * ks[3]);
            *(uint4*)(Ls + kb * 132 + n4) = d;
        }
        const int nxt = tile + nwg;
        if (nxt < total) issue(nxt);
        __syncthreads();
#pragma unroll
        for (int i = 0; i < 2; ++i) {
            const int c = tid + 512 * i, n = c >> 3, kc = c & 7;
            uint4 y; y.x = Ls[(4 * kc + 0) * 132 + n]; y.y = Ls[(4 * kc + 1) * 132 + n]; y.z = Ls[(4 * kc + 2) * 132 + n]; y.w = Ls[(4 * kc + 3) * 132 + n];
            *(uint4*)(Bt + ((size_t)mat * nrows_out + jn * 128 + n) * K + jk * 128 + 16 * kc) = y;
        }
        tile = nxt;
    }
}

struct Params {
    const float *x, *mem; const int* positions;
    const float *g_mix_norm, *w_mix_in, *cmp_pos_k, *cmp_pos_v, *cmp_w1_k, *cmp_b1_k, *cmp_w2_k, *cmp_w1_v, *cmp_b1_v, *cmp_w2_v, *conv_w, *g_nsa_out, *g_conv_out, *w_mix_out,
        *g_xattn_norm, *g_mem_norm, *w_xq, *w_xkv, *w_xo, *g_moe_norm, *w_router, *b_router, *w_gate_up, *b_gate_up, *w_down, *b_down, *g_final;
    float* out;
    unsigned* bar; unsigned* queue;
    int *wgcnt, *counts, *pstart, *tile_e, *a_e, *a_slot, *dest_of, *tok_buf;
    float *a_w, *w_buf;
    unsigned* selmask;
    float *hid_k, *hid_v, *kc, *vc, *memn, *xkv, *hbuf, *xn, *o_cmp, *o_slc, *o_win, *xq, *proj, *xo;
    unsigned short *hmid, *out_a, *xg, *wt_gu, *wt_dn; unsigned char *hmid8, *wt_dn8, *wt_gu8, *xg8, *xn8, *out_a8, *h1_8, *xo8, *wt_xq8, *wt_xo8; unsigned short* h1_bf; float* ssq; float* wrt;
    unsigned short *q_bf, *kcmp, *vcmp, *kslc, *vslcT, *kwin, *vwinT, *u_bf, *cb_bf; float *gates, *cosT, *sinT;
    unsigned short *xq_bf, *xk_bf, *xvT_bf, *ocmp_bf, *owin_bf, *onsa_bf;
    unsigned short *wt_c1k, *wt_c1v, *kc_bf, *vcT_bf; float *Pab_k, *Pab_v, *b1p_k, *b1p_v;
    unsigned short *xn_bf, *memn_bf, *xo_bf, *wt_mix_in, *wt_xkv, *wt_mix_out, *wt_xq, *wt_xo;
};

__global__ void __launch_bounds__(512, 2) mega_fwd(Params p) {
    extern __shared__ __attribute__((aligned(16))) char lds[];
    if (threadIdx.x < 4) ((unsigned*)lds)[threadIdx.x] = 0u;
    __syncthreads();
    XcdBarrier bar = xcd_barrier_post(p.bar, (volatile LAS unsigned*)lds);
    LAS unsigned char* glds = (LAS unsigned char*)(lds + 1024);

    {
        const int wg = blockIdx.x, nwg = gridDim.x;
        auto ident = [](int j) { return j; };
        auto mixmap = [](int j) {
            const int unit = j >> 8, blk = (j & 255) >> 6;
            if (unit < 2) return C_Q + unit * 256 + blk * 64;
            if (unit == 2) return blk < 2 ? C_KC + blk * 64 : C_VC + (blk - 2) * 64;
            if (unit == 3) return blk < 2 ? C_KS + blk * 64 : C_VS + (blk - 2) * 64;
            if (unit == 4) return blk < 2 ? C_KW + blk * 64 : C_VW + (blk - 2) * 64;
            if (unit < 9) return blk < 2 ? C_CH + (unit - 5) * 128 + blk * 64 : C_CC + (unit - 5) * 128 + (blk - 2) * 64;
            if (unit < 11) return C_CB + (unit - 9) * 256 + blk * 64;
            return blk == 0 ? C_GL : -1;
        };
        p_convT<true>(lds + 1024, p.w_mix_in, D, INC, 1, p.wt_mix_in, 3072, mixmap, wg, nwg);
        p_convT<false>(lds + 1024, p.w_xkv, D, 2048, 1, p.wt_xkv, 2048, ident, wg, nwg);
        p_convT<false>(lds + 1024, p.w_mix_out, D, D, 1, p.wt_mix_out, D, ident, wg, nwg);
        p_convT8(lds + 1024, p.w_xq, D, D, 1, p.wt_xq8, D, ident, wg, nwg, p.g_xattn_norm);
        p_convT8(lds + 1024, p.w_xo, D, D, 1, p.wt_xo8, D, ident, wg, nwg);
        auto gumap = [](int j) { const int blk = j >> 8, w = j & 255; return w < 128 ? 128 * blk + w : 1024 + 128 * blk + (w - 128); };
        p_convT8(lds + 1024, p.w_gate_up, D, 2048, NE, p.wt_gu8, 2048, gumap, wg, nwg);
        p_convT8(lds + 1024, p.w_down, DFF, D, NE, p.wt_dn8, D, ident, wg, nwg);
        p_convT<false>(lds + 1024, p.cmp_w1_k, 1024, 256, 2, p.wt_c1k, 256, ident, wg, nwg);
        p_convT<false>(lds + 1024, p.cmp_w1_v, 1024, 256, 2, p.wt_c1v, 256, ident, wg, nwg);
        for (int o = wg * 8 + (threadIdx.x >> 6); o < 512; o += nwg * 8) {
            if (o < 256) posbias_wave(o, threadIdx.x & 63, p.cmp_pos_k, p.cmp_w1_k, p.cmp_b1_k, p.b1p_k); else posbias_wave(o - 256, threadIdx.x & 63, p.cmp_pos_v, p.cmp_w1_v, p.cmp_b1_v, p.b1p_v);
        }
        __syncthreads();
    }
    p_rope_table(blockIdx.x * 512 + threadIdx.x, gridDim.x * 512, p.positions, p.cosT, p.sinT);
    for (int i = blockIdx.x * 512 + threadIdx.x; i < PMAX; i += gridDim.x * 512) p.tok_buf[i] = 0;
    for (int idx = blockIdx.x * 512 + threadIdx.x; idx < 1024 * NE; idx += gridDim.x * 512) p.wrt[(idx & 31) * tl::WR_STRIDE + (idx >> 5)] = p.g_moe_norm[idx >> 5] * p.w_router[idx];
    tl::rmsnorm_rows(p.x, p.g_mix_norm, p.xn_bf, T, (int)(blockIdx.x * 8 + (opaque_tid() >> 6)), (int)(gridDim.x * 8), opaque_tid() & 63);
    tl::rmsnorm_rows(p.mem, p.g_mem_norm, p.memn_bf, NB * NMEM, (int)(blockIdx.x * 8 + (opaque_tid() >> 6)), (int)(gridDim.x * 8), opaque_tid() & 63);
    xcd_barrier(bar);
    {
        pg::DenseOrder So; So.init(p.xn_bf, p.wt_mix_in, T, 3072, 2048u, 2048u, (int)gridDim.x, (int)blockIdx.x);
        pg::EpiMixIn E{p.q_bf, p.kcmp, p.vslcT, p.u_bf, p.cb_bf, p.gates, p.cosT, p.sinT};
        pg::gemm_phase(glds, D, 2048u, 2048u, So, E);
    }
    xcd_barrier(bar);
    {
        volatile int* item_s = (volatile int*)(lds + 64);
        for (;;) {
            __syncthreads();
            if (threadIdx.x == 0) *item_s = (int)atomicAdd(p.queue, 1u);
            __syncthreads();
            const int item = __builtin_amdgcn_readfirstlane(*item_s);
            if (item >= 96 + 512) break;
            if (item < 64) {
                const int pm = item >> 3, pn = item & 7;
                pg::OneUnit So; So.u.A = (const char*)p.memn_bf + (size_t)pm * 256 * 2048; So.u.B = (const char*)p.wt_xkv + (size_t)pn * 256 * 2048; So.u.row0 = pm * 256; So.u.col0 = pn * 256; So.u.aux = 0;
                pg::EpiXkv E{p.xk_bf, p.xvT_bf};
                pg::gemm_phase(glds, D, 2048u, 2048u, So, E);
            } else if (item < 96) {
                const int which = (item - 64) >> 4, r = (item - 64) & 15, pm = r >> 1, pn = r & 1;
                pg::OneUnit So; So.u.A = (const char*)(which ? p.vcmp : p.kcmp) + (size_t)pm * 256 * 2048; So.u.B = (const char*)(which ? p.wt_c1v : p.wt_c1k) + (size_t)pn * 256 * 2048; So.u.row0 = pm * 256; So.u.col0 = pn * 256; So.u.aux = 0;
                pg::EpiF32R E{which ? p.Pab_v : p.Pab_k, 512, nullptr, 512};
                pg::gemm_phase(glds, 1024, 2048u, 2048u, So, E);
            } else {
                const int idx = item - 96, tq = 31 - (idx >> 4), bg = idx & 15;
                at::attn64_unit<1>(lds + 1024, bg >> 1, bg & 1, tq, p.q_bf, p.kwin, p.vwinT, p.selmask, p.owin_bf, nullptr, nullptr, nullptr);
            }
        }
    }
    xcd_barrier(bar);
    p_cmp_finalize(lds + 1024, p.Pab_k, p.Pab_v, p.b1p_k, p.b1p_v, p.cmp_w2_k, p.cmp_w2_v, p.kc_bf, p.vcT_bf, blockIdx.x, gridDim.x);
    xcd_barrier(bar);
    for (int item = blockIdx.x; item < 256; item += gridDim.x) {
        const int bg = item >> 4, j = item & 15;
        at::cmp_unit(lds + 1024, bg >> 1, bg & 1, 31 - j, p.q_bf, p.kc_bf, p.vcT_bf, p.ocmp_bf, p.selmask);
        at::cmp_unit(lds + 1024, bg >> 1, bg & 1, j, p.q_bf, p.kc_bf, p.vcT_bf, p.ocmp_bf, p.selmask);
        asm volatile("s_waitcnt vmcnt(0)" ::: "memory");
        __syncthreads();
        at::attn64_unit<0>(lds + 1024, bg >> 1, bg & 1, 31 - j, p.q_bf, p.kslc, p.vslcT, p.selmask, p.onsa_bf, p.ocmp_bf, p.owin_bf, p.gates);
        at::attn64_unit<0>(lds + 1024, bg >> 1, bg & 1, j, p.q_bf, p.kslc, p.vslcT, p.selmask, p.onsa_bf, p.ocmp_bf, p.owin_bf, p.gates);
    }
    xcd_barrier(bar);
    tl::mix_post(p.onsa_bf, p.u_bf, p.cb_bf, p.conv_w, p.g_nsa_out, p.g_conv_out, p.xn_bf  , (int)(blockIdx.x * 8 + (opaque_tid() >> 6)), (int)(gridDim.x * 8), opaque_tid() & 63);
    xcd_barrier(bar);
    {
        pg::DenseOrder So; So.init(p.xn_bf, p.wt_mix_out, T, D, 2048u, 2048u, (int)gridDim.x, (int)blockIdx.x);
        pg::EpiResNormStats E{p.x, p.h1_bf, p.ssq, p.h1_8};
        pg::gemm_phase(glds, D, 2048u, 2048u, So, E);
    }
    xcd_barrier(bar);
    {
        pg::DenseOrder So; So.init(p.h1_8, p.wt_xq8, T, D, 1024u, 1024u, (int)gridDim.x, (int)blockIdx.x);
        pg::EpiBf16RowScale E{p.xq_bf, p.ssq, 0.0625f * 1.4426950408889634f * pg::W8_INV};
        pg::gemm_phase_f8(glds, D, 1024u, 1024u, So, E);
        for (int L = blockIdx.x; L < (T / 256) * (D / 256); L += gridDim.x) {
            int pm, h; pg::dense_map(L, T / 256, D / 256, pm, h);
            const int b = pm >> 3, qt = (pm & 7) * 2;
            at::xattn_unit(lds + 1024, b, h, qt, p.xq_bf, p.xk_bf, p.xvT_bf, p.xo8);
            at::xattn_unit(lds + 1024, b, h, qt + 1, p.xq_bf, p.xk_bf, p.xvT_bf, p.xo8);
        }
    }
    xcd_barrier(bar);
    {
        pg::DenseOrder So; So.init(p.xo8, p.wt_xo8, T, D, 1024u, 1024u, (int)gridDim.x, (int)blockIdx.x);
        pg::EpiBf16Res E{p.h1_bf, pg::W8_INV * (1.f / 16.f)};
        pg::gemm_phase_f8(glds, D, 1024u, 1024u, So, E);
    }
    xcd_barrier(bar);
    tl::norm_router(lds + 1024, p.h1_bf, p.g_moe_norm, p.wrt, p.b_router, p.xn8, p.a_e, p.a_w, p.a_slot, p.wgcnt, (int)(blockIdx.x * 8 + (opaque_tid() >> 6)), (int)(gridDim.x * 8), opaque_tid() & 63);
    xcd_barrier(bar);
    tl::moe_scatter(lds + 1024, p.wgcnt, p.pstart, p.tile_e, p.a_e, p.a_w, p.a_slot, p.tok_buf, p.w_buf, p.dest_of, blockIdx.x, (int)(blockIdx.x * 8 + (opaque_tid() >> 6)), (int)(gridDim.x * 8), opaque_tid() & 63);
    xcd_barrier(bar);
    {
        pg::MoeOrderB<8> So; So.init(p.xn8, p.wt_gu8, p.tile_e, p.pstart[NE], (size_t)2048 * 1024, 1024u, (int)gridDim.x, (int)blockIdx.x);
        pg::EpiSwigluF8 E{p.hmid8, p.b_gate_up};
        pg::gemm_phase_f8g(glds, D, 1024u, 1024u, So, E, (const char*)p.xn8, p.tok_buf);
    }
    xcd_barrier(bar);
    {
        pg::MoeOrderB<4> So; So.init(p.hmid8, p.wt_dn8, p.tile_e, p.pstart[NE], (size_t)1024 * 1024, 1024u, (int)gridDim.x, (int)blockIdx.x);
        pg::EpiDownScaleF8 E{p.out_a8, p.b_down, p.w_buf};
        pg::gemm_phase_f8(glds, DFF, 1024u, 1024u, So, E);
    }
    xcd_barrier(bar);
    tl::final_rows(p.h1_bf, p.out_a8, p.dest_of, p.g_final, p.out, (int)(blockIdx.x * 8 + (opaque_tid() >> 6)), (int)(gridDim.x * 8), opaque_tid() & 63);
}
__global__ void k_fail(float* out, int n) { const int i = blockIdx.x * 256 + threadIdx.x; if (i < n) out[i] = __builtin_nanf(""); }
}

extern "C" void kernel_launch(void* const* d_in, const int* in_sizes, int n_in, void* d_out, int out_size, void* d_ws, size_t ws_size, hipStream_t stream) {
    Params p{};
    p.x = (const float*)d_in[0]; p.mem = (const float*)d_in[1]; p.positions = (const int*)d_in[2];
    const float** fp = &p.g_mix_norm;
    for (int i = 0; i < 27; ++i) fp[i] = (const float*)d_in[3 + i];
    p.out = (float*)d_out;

    char* ws = (char*)d_ws;
    size_t off = 0;
    auto take = [&](size_t bytes) { char* q = ws + off; off += (bytes + 255) & ~(size_t)255; return q; };
    p.bar = (unsigned*)take(XCD_BAR_WORDS * 4);
    p.counts = (int*)take(NE * 4);
    p.queue = (unsigned*)take(256);
    const size_t zero_bytes = off;
    p.pstart = (int*)take((NE + 1) * 4);
    p.wgcnt = (int*)take(1024 * NE * 4);
    p.tile_e = (int*)take(NTILE * 4);
    p.a_e = (int*)take(NA * 4);
    p.a_w = (float*)take(NA * 4);
    p.a_slot = (int*)take(NA * 4);
    p.dest_of = (int*)take(NA * 4);
    p.w_buf = (float*)take(PMAX * 4);
    p.tok_buf = (int*)take(PMAX * 4);
    p.selmask = (unsigned*)take((size_t)NB * 2 * S * 4);
    p.out_a8 = (unsigned char*)take((size_t)PMAX * D);
    p.xn8 = (unsigned char*)take((size_t)T * D);
    p.h1_bf = (unsigned short*)take((size_t)T * D * 2);
    p.ssq = (float*)take((size_t)T * 16 * 4);
    p.wrt = (float*)take((size_t)NE * 1028 * 4);
    p.hmid8 = (unsigned char*)take((size_t)PMAX * DFF);
    p.wt_gu8 = (unsigned char*)take((size_t)NE * 2048 * D);
    p.wt_dn8 = (unsigned char*)take((size_t)NE * D * DFF);
    p.q_bf = (unsigned short*)take((size_t)T * 512 * 2);
    p.kcmp = (unsigned short*)take((size_t)T * 128 * 2 * 4); p.vcmp = p.kcmp + (size_t)T * 128; p.kslc = p.vcmp + (size_t)T * 128; p.kwin = p.kslc + (size_t)T * 128;
    p.vslcT = (unsigned short*)take((size_t)T * 128 * 2 * 2); p.vwinT = p.vslcT + (size_t)T * 128;
    p.u_bf = (unsigned short*)take((size_t)T * 512 * 2); p.cb_bf = (unsigned short*)take((size_t)T * 512 * 2);
    p.gates = (float*)take((size_t)T * 24 * 4); p.cosT = (float*)take((size_t)T * 32 * 4); p.sinT = (float*)take((size_t)T * 32 * 4);
    p.wt_c1k = (unsigned short*)take((size_t)512 * 1024 * 2); p.wt_c1v = (unsigned short*)take((size_t)512 * 1024 * 2);
    p.kc_bf = (unsigned short*)take((size_t)16 * 128 * 64 * 2); p.vcT_bf = (unsigned short*)take((size_t)16 * 64 * 128 * 2);
    p.Pab_k = (float*)take((size_t)(2048 + 1) * 512 * 4); p.Pab_v = (float*)take((size_t)(2048 + 1) * 512 * 4);
    p.b1p_k = (float*)take(256 * 4); p.b1p_v = (float*)take(256 * 4);
    p.ocmp_bf = (unsigned short*)take((size_t)T * 512 * 2); p.owin_bf = (unsigned short*)take((size_t)T * 512 * 2); p.onsa_bf = (unsigned short*)take((size_t)T * 512 * 2);
    p.xq_bf = (unsigned short*)take((size_t)T * D * 2); p.xk_bf = (unsigned short*)take((size_t)NB * NMEM * D * 2); p.xvT_bf = (unsigned short*)take((size_t)NB * NMEM * D * 2);
    p.xn_bf = (unsigned short*)take((size_t)T * D * 2);
    p.memn_bf = (unsigned short*)take((size_t)NB * NMEM * D * 2);
    p.xo8 = (unsigned char*)take((size_t)T * D);
    p.h1_8 = (unsigned char*)take((size_t)T * D);
    p.wt_mix_in = (unsigned short*)take((size_t)3072 * D * 2);
    p.wt_xkv = (unsigned short*)take((size_t)2048 * D * 2);
    p.wt_mix_out = (unsigned short*)take((size_t)D * D * 2);
    p.wt_xq8 = (unsigned char*)take((size_t)D * D);
    p.wt_xo8 = (unsigned char*)take((size_t)D * D);

    static int grid = 0;
    if (grid == 0) {
        int dev = 0, cus = 0;
        if (hipGetDevice(&dev) != hipSuccess || hipDeviceGetAttribute(&cus, hipDeviceAttributeMultiprocessorCount, dev) != hipSuccess) cus = -1;
        if (hipFuncSetAttribute((const void*)mega_fwd, hipFuncAttributeMaxDynamicSharedMemorySize, LDS_BYTES) != hipSuccess) cus = -1;
        int per_cu = 0;
        if (cus > 0 && (hipOccupancyMaxActiveBlocksPerMultiprocessor(&per_cu, (const void*)mega_fwd, 512, LDS_BYTES) != hipSuccess || per_cu < 1)) cus = -1;
        (void)hipGetLastError();
        grid = cus > 0 ? cus : -1;
    }
    if (grid < 0 || off > ws_size) { k_fail<<<(out_size + 255) / 256, 256, 0, stream>>>((float*)d_out, out_size); return; }
    (void)hipMemsetAsync(d_ws, 0, zero_bytes, stream);
    hipLaunchKernelGGL(mega_fwd, dim3(grid), dim3(512), LDS_BYTES, stream, p);
}
```

```cpp
#include <hip/hip_runtime.h>
#include <hip/hip_bf16.h>
#include <stdint.h>
#include <cstdio>

#define XB_TMO      128
#define XB_XCNT(j)  (256  + 64 * (j))
#define XB_XSUB(j)  (1280 + 64 * (j))
#define XB_XGEN(j)  (2304 + 64 * (j))
#define XB_TOP      3328
#define XB_TOPGEN   3392
#define XCD_BAR_WORDS 3456
#define XB_SPIN_CAP (1u << 18)
#define LAS __attribute__((address_space(3)))

__device__ __forceinline__ unsigned xb_ld(unsigned* p)              { return __hip_atomic_load(p, __ATOMIC_RELAXED, __HIP_MEMORY_SCOPE_AGENT); }
__device__ __forceinline__ unsigned xb_add(unsigned* p, unsigned v) { return __hip_atomic_fetch_add(p, v, __ATOMIC_RELAXED, __HIP_MEMORY_SCOPE_AGENT); }
__device__ __forceinline__ unsigned xb_xcc_id() { return (unsigned)__builtin_amdgcn_s_getreg((3 << 11) | 20) & 0xFu; }
#define XB_SPIN(cond, bar) do { unsigned _sp = 0; while (cond) { __builtin_amdgcn_s_sleep(1); \
    if ((++_sp & 255u) == 0u) { if (xb_ld(&(bar)[XB_TMO])) break; if (_sp > XB_SPIN_CAP) { atomicAdd(&(bar)[XB_TMO], 1u); break; } } } } while (0)

struct XcdBarrier {
    unsigned* bar; unsigned x;
    volatile LAS unsigned* st;
};

__device__ __forceinline__ XcdBarrier xcd_barrier_post(unsigned* bar, volatile LAS unsigned* st) {
    XcdBarrier b; b.bar = bar; b.x = xb_xcc_id(); b.st = st;
    if (threadIdx.x == 0) (void)xb_add(&bar[XB_XCNT(b.x)], 1u);
    return b;
}
__device__ __forceinline__ void xcd_barrier_complete(unsigned* bar, unsigned x, unsigned& nloc, unsigned& nx) {
    const unsigned G = gridDim.x * gridDim.y * gridDim.z;
    unsigned sum, cnt, mine, sp = 0u;
    for (;;) {
        sum = 0u; cnt = 0u; mine = 0u;
#pragma unroll
        for (unsigned j = 0; j < 16; ++j) { const unsigned c = xb_ld(&bar[XB_XCNT(j)]); sum += c; cnt += (c > 0u) ? 1u : 0u; mine = (j == x) ? c : mine; }
        if (sum == G) break;
        __builtin_amdgcn_s_sleep(1);
        if ((++sp & 255u) == 0u) { if (xb_ld(&bar[XB_TMO])) break; if (sp > XB_SPIN_CAP) { atomicAdd(&bar[XB_TMO], 1u); break; } }
    }
    nloc = mine > 0u ? mine : 1u; nx = cnt > 0u ? cnt : 1u;
}

__device__ __forceinline__ void xcd_barrier(const XcdBarrier& b) {
    asm volatile("s_waitcnt vmcnt(0)" ::: "memory");
    __syncthreads();
    if (threadIdx.x == 0) {
        unsigned* bar = b.bar;
        __builtin_amdgcn_s_waitcnt(0);
        unsigned nloc = b.st[0], nx = b.st[1];
        if (nloc == 0u) { xcd_barrier_complete(bar, b.x, nloc, nx); b.st[0] = nloc; b.st[1] = nx; }
        const unsigned old = xb_add(&bar[XB_XSUB(b.x)], 1u);
        const unsigned gen = old / nloc;
        if (old + 1u == (gen + 1u) * nloc) {
            __builtin_amdgcn_fence(__ATOMIC_RELEASE, "agent");
            asm volatile("s_waitcnt vmcnt(0)" ::: "memory");
            const unsigned og = xb_add(&bar[XB_TOP], 1u);
            const unsigned tg = og / nx;
            if (og + 1u == (tg + 1u) * nx) xb_add(&bar[XB_TOPGEN], 1u);
            else XB_SPIN(xb_ld(&bar[XB_TOPGEN]) == tg, bar);
            __builtin_amdgcn_fence(__ATOMIC_ACQUIRE, "agent");
            xb_add(&bar[XB_XGEN(b.x)], 1u);
            asm volatile("s_waitcnt vmcnt(0)" ::: "memory");
        } else {
            XB_SPIN(xb_ld(&bar[XB_XGEN(b.x)]) == gen, bar);
            __builtin_amdgcn_fence(__ATOMIC_ACQUIRE, "agent");
            asm volatile("s_waitcnt vmcnt(0)" ::: "memory");
        }
    }
    __syncthreads();
}


namespace {
constexpr int D = 1024, NB = 8, S = 2048, T = NB * S, NMEM = 256;
constexpr int INC = 2840;
constexpr int C_Q = 0, C_KC = 512, C_VC = 640, C_KS = 768, C_VS = 896, C_KW = 1024, C_VW = 1152, C_GL = 1280, C_CH = 1304, C_CB = 1816, C_CC = 2328;
constexpr int NC = 127, NCR = NB * NC * 2;
constexpr int NE = 32, TOPK = 4, DFF = 1024, NA = T * TOPK;
constexpr int MT = 256;
constexpr int PMAX = NA + NE * MT, NTILE = PMAX / MT;
constexpr int LDS_BYTES = 144 * 1024, VB_LDS = 40960;
constexpr float QS = 0.125f * 1.4426950408889634f;

__device__ __forceinline__ int opaque_tid() { int t = threadIdx.x; asm volatile("" : "+v"(t)); return t; }
__device__ __forceinline__ float dpp_xor8(float v) { return __uint_as_float(__builtin_amdgcn_update_dpp(0u, __float_as_uint(v), 0x128, 0xf, 0xf, true)); }
__device__ __forceinline__ float dpp_xor4(float v) { unsigned r = __builtin_amdgcn_update_dpp(__float_as_uint(v), __float_as_uint(v), 0x104, 0xf, 0x5, false); r = __builtin_amdgcn_update_dpp(r, __float_as_uint(v), 0x114, 0xf, 0xa, false); return __uint_as_float(r); }
__device__ __forceinline__ float dpp_xor2(float v) { return __uint_as_float(__builtin_amdgcn_update_dpp(0u, __float_as_uint(v), 0x4e, 0xf, 0xf, true)); }
__device__ __forceinline__ float dpp_xor1(float v) { return __uint_as_float(__builtin_amdgcn_update_dpp(0u, __float_as_uint(v), 0xb1, 0xf, 0xf, true)); }

__device__ __forceinline__ float lane_xor32(float v) { const auto r = __builtin_amdgcn_permlane32_swap(__float_as_uint(v), __float_as_uint(v), false, false); return __uint_as_float((threadIdx.x & 32) ? r[0] : r[1]); }
__device__ __forceinline__ float lane_xor16(float v) { const auto r = __builtin_amdgcn_permlane16_swap(__float_as_uint(v), __float_as_uint(v), false, false); return __uint_as_float((threadIdx.x & 16) ? r[0] : r[1]); }
__device__ __forceinline__ float wave_sum(float v) {
    { const auto r = __builtin_amdgcn_permlane32_swap(__float_as_uint(v), __float_as_uint(v), false, false); v = __uint_as_float(r[0]) + __uint_as_float(r[1]); }
    { const auto r = __builtin_amdgcn_permlane16_swap(__float_as_uint(v), __float_as_uint(v), false, false); v = __uint_as_float(r[0]) + __uint_as_float(r[1]); }
    v += dpp_xor8(v); v += dpp_xor4(v); v += dpp_xor2(v); v += dpp_xor1(v); return v;
}
__device__ __forceinline__ float wave_max(float v) {
    { const auto r = __builtin_amdgcn_permlane32_swap(__float_as_uint(v), __float_as_uint(v), false, false); v = fmaxf(__uint_as_float(r[0]), __uint_as_float(r[1])); }
    { const auto r = __builtin_amdgcn_permlane16_swap(__float_as_uint(v), __float_as_uint(v), false, false); v = fmaxf(__uint_as_float(r[0]), __uint_as_float(r[1])); }
    v = fmaxf(v, dpp_xor8(v)); v = fmaxf(v, dpp_xor4(v)); v = fmaxf(v, dpp_xor2(v)); v = fmaxf(v, dpp_xor1(v)); return v;
}

namespace pg { __device__ __forceinline__ unsigned cvt_pk_bf16(float lo, float hi); __device__ __forceinline__ unsigned cvt_pk_bf16_acc(float lo, float hi); }
struct VB { int vb, nvb, tid; char* lds; };
#define VB_ITEMS(n) for (int _it = 0, item = v.vb; _it < ((n) + v.nvb - 1) / v.nvb; ++_it, item += v.nvb)


__device__ __forceinline__ unsigned short f2bf_rne(float f) { unsigned u = __float_as_uint(f); u += 0x7FFFu + ((u >> 16) & 1u); return (unsigned short)(u >> 16); }


__device__ __forceinline__ float gelu_tanh(float x) { const float u = 0.7978845608028654f * (x + 0.044715f * x * x * x); return 0.5f * x * (1.f + tanhf(u)); }

__device__ __forceinline__ void st_out(float* p, float x) { *p = x; }
__device__ __forceinline__ void st_out(unsigned short* p, float x) { *p = f2bf_rne(x); }


__device__ __forceinline__ void p_rope_table(int gtid, int gn, const int* __restrict__ pos, float* __restrict__ cosT, float* __restrict__ sinT) {
    for (int i = gtid; i < T * 32; i += gn) {
        const int t = i >> 5, f = i & 31;
        const float inv = powf(10000.f, -(float)f / 32.f);
        const float ang = (float)pos[t] * inv;
        cosT[i] = cosf(ang); sinT[i] = sinf(ang);
    }
}


namespace pg {
typedef unsigned short bf16_t;
typedef short bf16x8 __attribute__((ext_vector_type(8)));
typedef float f32x4 __attribute__((ext_vector_type(4)));
constexpr int BM = 256, BK = 64, HALF = 128, HTB = HALF * BK * 2, STAGE_BYTES = 8 * HTB;
__device__ __forceinline__ int lds_byte(int r, int c) { const int st = (r >> 4) * 2 + (c >> 5), rr = r & 15, cc = c & 31, ob = rr * 64 + cc * 2; return st * 1024 + (ob ^ (((ob >> 9) & 1) << 5)); }
__device__ __forceinline__ void stage_rc(int b, int& R, int& C) { const int st = b / 1024, sb = b % 1024, swz = sb ^ (((sb >> 9) & 1) << 5); R = (st >> 1) * 16 + swz / 64; C = (st & 1) * 32 + (swz % 64) / 2; }
typedef float f32x2_t __attribute__((ext_vector_type(2)));
typedef __bf16 bf16x2_t __attribute__((ext_vector_type(2)));
__device__ __forceinline__ unsigned cvt_pk_bf16_acc(float lo, float hi) { const f32x2_t v = {lo, hi}; const bf16x2_t b = __builtin_convertvector(v, bf16x2_t); return __builtin_bit_cast(unsigned, b); }
__device__ __forceinline__ unsigned cvt_pk_bf16(float lo, float hi) { unsigned r; asm volatile("v_cvt_pk_bf16_f32 %0, %1, %2" : "=v"(r) : "v"(lo), "v"(hi)); return r; }
__device__ __forceinline__ bf16_t f2bf(float f) { unsigned u = __float_as_uint(f); u += 0x7FFFu + ((u >> 16) & 1u); return (bf16_t)(u >> 16); }

__device__ __forceinline__ unsigned pk4_fp8(float a, float b, float c, float d);
struct GUnit { const char* A; const char* B; int row0, col0, aux; };

template <class Epi, class Sched>
__device__ __forceinline__ void gemm_phase(LAS unsigned char* lds, const int K, const unsigned lda_b, const unsigned ldb_b, const Sched& S, const Epi& E) {
    const int tid = opaque_tid(), wid = __builtin_amdgcn_readfirstlane(tid >> 6), lane = tid & 63, wr = wid >> 2, wc = wid & 3, fr = lane & 15, fq = lane >> 4;
    const int nt = K / BK;
    unsigned voffA[2], voffB[2];
#pragma unroll
    for (int i = 0; i < 2; ++i) { int R, C; stage_rc(tid * 16 + i * 8192, R, C); voffA[i] = (unsigned)R * lda_b + (unsigned)C * 2u; voffB[i] = (unsigned)R * ldb_b + (unsigned)C * 2u; }
    const size_t kstep = (size_t)(BK * 2);
    const size_t hstepA = (size_t)HALF * lda_b, hstepB = (size_t)HALF * ldb_b;
    const unsigned ldsw = (unsigned)wid * 1024u;
    const int aoff = lds_byte(wr * 64 + fr, fq * 8), boff = lds_byte(wc * 32 + fr, fq * 8);
#define PG8_SA(b, h) (((b) * 2 + (h)) * HTB)
#define PG8_SB(b, h) ((4 + (b) * 2 + (h)) * HTB)
#define PG8_STAGE(bufoff, gbase, voff) do { _Pragma("unroll") for (int _i = 0; _i < 2; ++_i) \
        __builtin_amdgcn_global_load_lds((const unsigned*)((const char*)(gbase) + (voff)[_i]), (LAS unsigned*)(lds + (bufoff) + ldsw + _i * 8192), 16, 0, 0); } while (0)
#define PG8_LDA(dst, b, h) do { _Pragma("unroll") for (int m = 0; m < 4; ++m) _Pragma("unroll") for (int k = 0; k < 2; ++k) dst[m][k] = *(const LAS bf16x8*)(lds + PG8_SA(b, h) + aoff + m * 2048 + k * 1024); } while (0)
#define PG8_LDB(dst, b, h) do { _Pragma("unroll") for (int n = 0; n < 2; ++n) _Pragma("unroll") for (int k = 0; k < 2; ++k) dst[n][k] = *(const LAS bf16x8*)(lds + PG8_SB(b, h) + boff + n * 2048 + k * 1024); } while (0)
#define PG8_MMA(ai, bj, At, Bt) do { __builtin_amdgcn_s_setprio(1); _Pragma("unroll") for (int m = 0; m < 4; ++m) _Pragma("unroll") for (int n = 0; n < 2; ++n) _Pragma("unroll") for (int k = 0; k < 2; ++k) \
        acc[ai][bj][m][n] = __builtin_amdgcn_mfma_f32_16x16x32_bf16(Bt[n][k], At[m][k], acc[ai][bj][m][n], 0, 0, 0); __builtin_amdgcn_s_setprio(0); } while (0)
#define PG8_WAIT_V(n) asm volatile("s_waitcnt vmcnt(" #n ")" ::: "memory")
#define PG8_WAIT_L(n) asm volatile("s_waitcnt lgkmcnt(" #n ")" ::: "memory")
#define PG8_BAR __builtin_amdgcn_s_barrier()
#define PG8_SCHED __builtin_amdgcn_sched_barrier(0)
    GUnit cur, nxt; int ui = 0;
    if (!S.next(0, cur)) return;
    f32x4 acc[2][2][4][2];
#pragma unroll
    for (int a = 0; a < 2; ++a)
#pragma unroll
        for (int b = 0; b < 2; ++b)
#pragma unroll
            for (int m = 0; m < 4; ++m)
#pragma unroll
                for (int n = 0; n < 2; ++n) acc[a][b][m][n] = (f32x4){0.f, 0.f, 0.f, 0.f};
    bf16x8 At[4][2], B0[2][2], B1[2][2];
    const char* cA = cur.A; const char* cB = cur.B;
    PG8_STAGE(PG8_SB(0, 0), cB, voffB); PG8_STAGE(PG8_SA(0, 0), cA, voffA); PG8_STAGE(PG8_SB(0, 1), cB + hstepB, voffB); PG8_STAGE(PG8_SA(0, 1), cA + hstepA, voffA);
    if (wr == 1) PG8_BAR;
    PG8_WAIT_V(4); PG8_BAR;
    PG8_STAGE(PG8_SB(1, 0), cB + kstep, voffB); PG8_STAGE(PG8_SA(1, 0), cA + kstep, voffA); PG8_STAGE(PG8_SB(1, 1), cB + hstepB + kstep, voffB);
    PG8_WAIT_V(6); PG8_BAR;
    for (;;) {
        const bool has_next = S.next(ui + 1, nxt);
        const char* nA = has_next ? nxt.A : cA; const char* nB = has_next ? nxt.B : cB;
        for (int t = 0; t < nt; t += 2) {
            const bool last = (t == nt - 2);
            const char* a1 = cA + (size_t)(t + 1) * kstep;
            const char* a2 = last ? nA : cA + (size_t)(t + 2) * kstep; const char* b2 = last ? nB : cB + (size_t)(t + 2) * kstep;
            const char* a3 = a2 + kstep; const char* b3 = b2 + kstep;
            PG8_LDB(B0, 0, 0); PG8_SCHED; PG8_LDA(At, 0, 0); PG8_STAGE(PG8_SA(1, 1), a1 + hstepA, voffA);
            PG8_WAIT_L(8); PG8_BAR; PG8_WAIT_L(0); PG8_MMA(0, 0, At, B0); PG8_BAR; PG8_SCHED;
            PG8_LDB(B1, 0, 1); PG8_STAGE(PG8_SB(0, 0), b2, voffB);
            PG8_BAR; PG8_WAIT_L(0); PG8_MMA(0, 1, At, B1); PG8_BAR;
            PG8_LDA(At, 0, 1); PG8_STAGE(PG8_SA(0, 0), a2, voffA);
            PG8_BAR; PG8_WAIT_L(0); PG8_MMA(1, 0, At, B0); PG8_BAR; PG8_SCHED;
            PG8_STAGE(PG8_SB(0, 1), b2 + hstepB, voffB);
            PG8_WAIT_V(6); PG8_BAR; PG8_MMA(1, 1, At, B1); PG8_BAR;
            PG8_LDB(B0, 1, 0); PG8_SCHED; PG8_LDA(At, 1, 0); PG8_STAGE(PG8_SA(0, 1), a2 + hstepA, voffA);
            PG8_WAIT_L(8); PG8_BAR; PG8_WAIT_L(0); PG8_MMA(0, 0, At, B0); PG8_BAR; PG8_SCHED;
            PG8_LDB(B1, 1, 1); PG8_STAGE(PG8_SB(1, 0), b3, voffB);
            PG8_BAR; PG8_WAIT_L(0); PG8_MMA(0, 1, At, B1); PG8_BAR;
            PG8_LDA(At, 1, 1); PG8_STAGE(PG8_SA(1, 0), a3, voffA);
            PG8_BAR; PG8_WAIT_L(0); PG8_MMA(1, 0, At, B0); PG8_BAR; PG8_SCHED;
            PG8_STAGE(PG8_SB(1, 1), b3 + hstepB, voffB);
            PG8_WAIT_V(6); PG8_BAR; PG8_MMA(1, 1, At, B1); PG8_BAR;
        }
        E(acc, cur, wr, wc, fr, fq);
        if (!has_next) break;
#pragma unroll
        for (int a = 0; a < 2; ++a)
#pragma unroll
            for (int b = 0; b < 2; ++b)
#pragma unroll
                for (int m = 0; m < 4; ++m)
#pragma unroll
                    for (int n = 0; n < 2; ++n) acc[a][b][m][n] = (f32x4){0.f, 0.f, 0.f, 0.f};
        cur = nxt; cA = nA; cB = nB; ++ui;
    }
    PG8_WAIT_V(0);
    if (wr == 0) PG8_BAR;
    PG8_BAR;
#undef PG8_SA
#undef PG8_SB
#undef PG8_STAGE
#undef PG8_LDA
#undef PG8_LDB
#undef PG8_MMA
#undef PG8_WAIT_V
#undef PG8_WAIT_L
#undef PG8_BAR
#undef PG8_SCHED
}

typedef int v4i_t __attribute__((ext_vector_type(4)));
typedef int v8i_t __attribute__((ext_vector_type(8)));
template <class Epi, class Sched>
__device__ __forceinline__ void gemm_phase_f8(LAS unsigned char* lds, const int K  , const unsigned lda_b, const unsigned ldb_b, const Sched& S, const Epi& E) {
    const int tid = opaque_tid(), wid = __builtin_amdgcn_readfirstlane(tid >> 6), lane = tid & 63, wr = wid >> 2, wc = wid & 3, fr = lane & 15, fq = lane >> 4;
    const int nt = K / 128;
    unsigned voffA[2], voffB[2];
#pragma unroll
    for (int i = 0; i < 2; ++i) { int R, C; stage_rc(tid * 16 + i * 8192, R, C); voffA[i] = (unsigned)R * lda_b + (unsigned)C * 2u; voffB[i] = (unsigned)R * ldb_b + (unsigned)C * 2u; }
    const size_t kstep = (size_t)(BK * 2);
    const size_t hstepA = (size_t)HALF * lda_b, hstepB = (size_t)HALF * ldb_b;
    const unsigned ldsw = (unsigned)wid * 1024u;
    const int aoff = lds_byte(wr * 64 + fr, fq * 8), boff = lds_byte(wc * 32 + fr, fq * 8);
#define PG8_SA(b, h) (((b) * 2 + (h)) * HTB)
#define PG8_SB(b, h) ((4 + (b) * 2 + (h)) * HTB)
#define PG8_STAGE(bufoff, gbase, voff) do { _Pragma("unroll") for (int _i = 0; _i < 2; ++_i) \
        __builtin_amdgcn_global_load_lds((const unsigned*)((const char*)(gbase) + (voff)[_i]), (LAS unsigned*)(lds + (bufoff) + ldsw + _i * 8192), 16, 0, 0); } while (0)
#define PG8_LDA(dst, b, h) do { _Pragma("unroll") for (int m = 0; m < 4; ++m) { const v4i_t lo_ = *(const LAS v4i_t*)(lds + PG8_SA(b, h) + aoff + m * 2048), hi_ = *(const LAS v4i_t*)(lds + PG8_SA(b, h) + aoff + m * 2048 + 1024); dst[m] = __builtin_shufflevector(lo_, hi_, 0, 1, 2, 3, 4, 5, 6, 7); } } while (0)
#define PG8_LDB(dst, b, h) do { _Pragma("unroll") for (int n = 0; n < 2; ++n) { const v4i_t lo_ = *(const LAS v4i_t*)(lds + PG8_SB(b, h) + boff + n * 2048), hi_ = *(const LAS v4i_t*)(lds + PG8_SB(b, h) + boff + n * 2048 + 1024); dst[n] = __builtin_shufflevector(lo_, hi_, 0, 1, 2, 3, 4, 5, 6, 7); } } while (0)
#define PG8_MMA(ai, bj, At, Bt) do { __builtin_amdgcn_s_setprio(1); _Pragma("unroll") for (int m = 0; m < 4; ++m) _Pragma("unroll") for (int n = 0; n < 2; ++n) \
        asm volatile("v_mfma_scale_f32_16x16x128_f8f6f4 %0, %1, %2, %0, %3, %3 op_sel_hi:[0,0,0]" : "+v"(acc[ai][bj][m][n]) : "v"(Bt[n]), "v"(At[m]), "v"(unit_scale)); __builtin_amdgcn_s_setprio(0); } while (0)
#define PG8_WAIT_V(n) asm volatile("s_waitcnt vmcnt(" #n ")" ::: "memory")
#define PG8_WAIT_L(n) asm volatile("s_waitcnt lgkmcnt(" #n ")" ::: "memory")
#define PG8_BAR __builtin_amdgcn_s_barrier()
#define PG8_SCHED __builtin_amdgcn_sched_barrier(0)
    const int unit_scale = 0x7f7f7f7f;
    GUnit cur, nxt; int ui = 0;
    if (!S.next(0, cur)) return;
    f32x4 acc[2][2][4][2];
#pragma unroll
    for (int a = 0; a < 2; ++a)
#pragma unroll
        for (int b = 0; b < 2; ++b)
#pragma unroll
            for (int m = 0; m < 4; ++m)
#pragma unroll
                for (int n = 0; n < 2; ++n) acc[a][b][m][n] = (f32x4){0.f, 0.f, 0.f, 0.f};
    v8i_t At[4], B0[2], B1[2];
    const char* cA = cur.A; const char* cB = cur.B;
    PG8_STAGE(PG8_SB(0, 0), cB, voffB); PG8_STAGE(PG8_SA(0, 0), cA, voffA); PG8_STAGE(PG8_SB(0, 1), cB + hstepB, voffB); PG8_STAGE(PG8_SA(0, 1), cA + hstepA, voffA);
    if (wr == 1) PG8_BAR;
    PG8_WAIT_V(4); PG8_BAR;
    PG8_STAGE(PG8_SB(1, 0), cB + kstep, voffB); PG8_STAGE(PG8_SA(1, 0), cA + kstep, voffA); PG8_STAGE(PG8_SB(1, 1), cB + hstepB + kstep, voffB);
    PG8_WAIT_V(6); PG8_BAR;
    for (;;) {
        const bool has_next = S.next(ui + 1, nxt);
        const char* nA = has_next ? nxt.A : cA; const char* nB = has_next ? nxt.B : cB;
#pragma nounroll
        for (int t = 0; t < nt; t += 2) {
            const bool last = (t == nt - 2);
            const char* a1 = cA + (size_t)(t + 1) * kstep;
            const char* a2 = last ? nA : cA + (size_t)(t + 2) * kstep; const char* b2 = last ? nB : cB + (size_t)(t + 2) * kstep;
            const char* a3 = a2 + kstep; const char* b3 = b2 + kstep;
            PG8_LDB(B0, 0, 0); PG8_SCHED; PG8_LDA(At, 0, 0); PG8_STAGE(PG8_SA(1, 1), a1 + hstepA, voffA);
            PG8_WAIT_L(8); PG8_BAR; PG8_WAIT_L(0); PG8_MMA(0, 0, At, B0); PG8_BAR; PG8_SCHED;
            PG8_LDB(B1, 0, 1); PG8_STAGE(PG8_SB(0, 0), b2, voffB);
            PG8_BAR; PG8_WAIT_L(0); PG8_MMA(0, 1, At, B1); PG8_BAR;
            PG8_LDA(At, 0, 1); PG8_STAGE(PG8_SA(0, 0), a2, voffA);
            PG8_BAR; PG8_WAIT_L(0); PG8_MMA(1, 0, At, B0); PG8_BAR; PG8_SCHED;
            PG8_STAGE(PG8_SB(0, 1), b2 + hstepB, voffB);
            PG8_WAIT_V(6); PG8_BAR; PG8_MMA(1, 1, At, B1); PG8_BAR;
            PG8_LDB(B0, 1, 0); PG8_SCHED; PG8_LDA(At, 1, 0); PG8_STAGE(PG8_SA(0, 1), a2 + hstepA, voffA);
            PG8_WAIT_L(8); PG8_BAR; PG8_WAIT_L(0); PG8_MMA(0, 0, At, B0); PG8_BAR; PG8_SCHED;
            PG8_LDB(B1, 1, 1); PG8_STAGE(PG8_SB(1, 0), b3, voffB);
            PG8_BAR; PG8_WAIT_L(0); PG8_MMA(0, 1, At, B1); PG8_BAR;
            PG8_LDA(At, 1, 1); PG8_STAGE(PG8_SA(1, 0), a3, voffA);
            PG8_BAR; PG8_WAIT_L(0); PG8_MMA(1, 0, At, B0); PG8_BAR; PG8_SCHED;
            PG8_STAGE(PG8_SB(1, 1), b3 + hstepB, voffB);
            PG8_WAIT_V(6); PG8_BAR; PG8_MMA(1, 1, At, B1); PG8_BAR;
        }
        asm volatile("s_nop 15\n\ts_nop 15" ::: "memory");
        E(acc, cur, wr, wc, fr, fq);
        if (!has_next) break;
#pragma unroll
        for (int a = 0; a < 2; ++a)
#pragma unroll
            for (int b = 0; b < 2; ++b)
#pragma unroll
                for (int m = 0; m < 4; ++m)
#pragma unroll
                    for (int n = 0; n < 2; ++n) acc[a][b][m][n] = (f32x4){0.f, 0.f, 0.f, 0.f};
        cur = nxt; cA = nA; cB = nB; ++ui;
    }
    PG8_WAIT_V(0);
    if (wr == 0) PG8_BAR;
    PG8_BAR;
#undef PG8_SA
#undef PG8_SB
#undef PG8_STAGE
#undef PG8_LDA
#undef PG8_LDB
#undef PG8_MMA
#undef PG8_WAIT_V
#undef PG8_WAIT_L
#undef PG8_BAR
#undef PG8_SCHED
}

template <class Epi, class Sched>
__device__ __forceinline__ void gemm_phase_f8g(LAS unsigned char* lds, const int K  , const unsigned lda_b, const unsigned ldb_b, const Sched& S, const Epi& E, const char* Abase, const int* __restrict__ tok) {
    const int tid = opaque_tid(), wid = __builtin_amdgcn_readfirstlane(tid >> 6), lane = tid & 63, wr = wid >> 2, wc = wid & 3, fr = lane & 15, fq = lane >> 4;
    const int nt = K / 128;
    unsigned voffA[2], voffB[2];
    int RA[2]; unsigned CA[2];
#pragma unroll
    for (int i = 0; i < 2; ++i) { int R, C; stage_rc(tid * 16 + i * 8192, R, C); RA[i] = R; CA[i] = (unsigned)C * 2u; voffA[i] = 0u; voffB[i] = (unsigned)R * ldb_b + (unsigned)C * 2u; }
    unsigned cv0[2], cv1[2], nv0[2], nv1[2];
#define PG8_TOKV(v0_, v1_, row0_) do { _Pragma("unroll") for (int i_ = 0; i_ < 2; ++i_) { v0_[i_] = (unsigned)tok[(row0_) + RA[i_]] * lda_b + CA[i_]; v1_[i_] = (unsigned)tok[(row0_) + HALF + RA[i_]] * lda_b + CA[i_]; } } while (0)
    const size_t kstep = (size_t)(BK * 2);
    const size_t hstepA = (size_t)HALF * lda_b, hstepB = (size_t)HALF * ldb_b;
    const unsigned ldsw = (unsigned)wid * 1024u;
    const int aoff = lds_byte(wr * 64 + fr, fq * 8), boff = lds_byte(wc * 32 + fr, fq * 8);
#define PG8_SA(b, h) (((b) * 2 + (h)) * HTB)
#define PG8_SB(b, h) ((4 + (b) * 2 + (h)) * HTB)
#define PG8_STAGE(bufoff, gbase, voff) do { _Pragma("unroll") for (int _i = 0; _i < 2; ++_i) \
        __builtin_amdgcn_global_load_lds((const unsigned*)((const char*)(gbase) + (voff)[_i]), (LAS unsigned*)(lds + (bufoff) + ldsw + _i * 8192), 16, 0, 0); } while (0)
#define PG8_LDA(dst, b, h) do { _Pragma("unroll") for (int m = 0; m < 4; ++m) { const v4i_t lo_ = *(const LAS v4i_t*)(lds + PG8_SA(b, h) + aoff + m * 2048), hi_ = *(const LAS v4i_t*)(lds + PG8_SA(b, h) + aoff + m * 2048 + 1024); dst[m] = __builtin_shufflevector(lo_, hi_, 0, 1, 2, 3, 4, 5, 6, 7); } } while (0)
#define PG8_LDB(dst, b, h) do { _Pragma("unroll") for (int n = 0; n < 2; ++n) { const v4i_t lo_ = *(const LAS v4i_t*)(lds + PG8_SB(b, h) + boff + n * 2048), hi_ = *(const LAS v4i_t*)(lds + PG8_SB(b, h) + boff + n * 2048 + 1024); dst[n] = __builtin_shufflevector(lo_, hi_, 0, 1, 2, 3, 4, 5, 6, 7); } } while (0)
#define PG8_MMA(ai, bj, At, Bt) do { __builtin_amdgcn_s_setprio(1); _Pragma("unroll") for (int m = 0; m < 4; ++m) _Pragma("unroll") for (int n = 0; n < 2; ++n) \
        asm volatile("v_mfma_scale_f32_16x16x128_f8f6f4 %0, %1, %2, %0, %3, %3 op_sel_hi:[0,0,0]" : "+v"(acc[ai][bj][m][n]) : "v"(Bt[n]), "v"(At[m]), "v"(unit_scale)); __builtin_amdgcn_s_setprio(0); } while (0)
#define PG8_WAIT_V(n) asm volatile("s_waitcnt vmcnt(" #n ")" ::: "memory")
#define PG8_WAIT_L(n) asm volatile("s_waitcnt lgkmcnt(" #n ")" ::: "memory")
#define PG8_BAR __builtin_amdgcn_s_barrier()
#define PG8_SCHED __builtin_amdgcn_sched_barrier(0)
    const int unit_scale = 0x7f7f7f7f;
    GUnit cur, nxt; int ui = 0;
    if (!S.next(0, cur)) return;
    f32x4 acc[2][2][4][2];
#pragma unroll
    for (int a = 0; a < 2; ++a)
#pragma unroll
        for (int b = 0; b < 2; ++b)
#pragma unroll
            for (int m = 0; m < 4; ++m)
#pragma unroll
                for (int n = 0; n < 2; ++n) acc[a][b][m][n] = (f32x4){0.f, 0.f, 0.f, 0.f};
    v8i_t At[4], B0[2], B1[2];
    const char* cB = cur.B;
    PG8_TOKV(cv0, cv1, cur.row0);
    PG8_STAGE(PG8_SB(0, 0), cB, voffB); PG8_STAGE(PG8_SA(0, 0), Abase, cv0); PG8_STAGE(PG8_SB(0, 1), cB + hstepB, voffB); PG8_STAGE(PG8_SA(0, 1), Abase, cv1);
    if (wr == 1) PG8_BAR;
    PG8_WAIT_V(4); PG8_BAR;
    PG8_STAGE(PG8_SB(1, 0), cB + kstep, voffB); PG8_STAGE(PG8_SA(1, 0), Abase + kstep, cv0); PG8_STAGE(PG8_SB(1, 1), cB + hstepB + kstep, voffB);
    PG8_WAIT_V(6); PG8_BAR;
    for (;;) {
        const bool has_next = S.next(ui + 1, nxt);
        const char* nB = has_next ? nxt.B : cB;
        if (has_next) PG8_TOKV(nv0, nv1, nxt.row0); else { nv0[0] = cv0[0]; nv0[1] = cv0[1]; nv1[0] = cv1[0]; nv1[1] = cv1[1]; }
#pragma nounroll
        for (int t = 0; t < nt; t += 2) {
            const bool last = (t == nt - 2);
            const char* a1 = Abase + (size_t)(t + 1) * kstep;
            const char* a2 = last ? Abase : Abase + (size_t)(t + 2) * kstep; const char* b2 = last ? nB : cB + (size_t)(t + 2) * kstep;
            const char* a3 = a2 + kstep; const char* b3 = b2 + kstep;
            unsigned v20[2], v21[2];
            v20[0] = last ? nv0[0] : cv0[0]; v20[1] = last ? nv0[1] : cv0[1]; v21[0] = last ? nv1[0] : cv1[0]; v21[1] = last ? nv1[1] : cv1[1];
            PG8_LDB(B0, 0, 0); PG8_SCHED; PG8_LDA(At, 0, 0); PG8_STAGE(PG8_SA(1, 1), a1, cv1);
            PG8_WAIT_L(8); PG8_BAR; PG8_WAIT_L(0); PG8_MMA(0, 0, At, B0); PG8_BAR; PG8_SCHED;
            PG8_LDB(B1, 0, 1); PG8_STAGE(PG8_SB(0, 0), b2, voffB);
            PG8_BAR; PG8_WAIT_L(0); PG8_MMA(0, 1, At, B1); PG8_BAR;
            PG8_LDA(At, 0, 1); PG8_STAGE(PG8_SA(0, 0), a2, v20);
            PG8_BAR; PG8_WAIT_L(0); PG8_MMA(1, 0, At, B0); PG8_BAR; PG8_SCHED;
            PG8_STAGE(PG8_SB(0, 1), b2 + hstepB, voffB);
            PG8_WAIT_V(6); PG8_BAR; PG8_MMA(1, 1, At, B1); PG8_BAR;
            PG8_LDB(B0, 1, 0); PG8_SCHED; PG8_LDA(At, 1, 0); PG8_STAGE(PG8_SA(0, 1), a2, v21);
            PG8_WAIT_L(8); PG8_BAR; PG8_WAIT_L(0); PG8_MMA(0, 0, At, B0); PG8_BAR; PG8_SCHED;
            PG8_LDB(B1, 1, 1); PG8_STAGE(PG8_SB(1, 0), b3, voffB);
            PG8_BAR; PG8_WAIT_L(0); PG8_MMA(0, 1, At, B1); PG8_BAR;
            PG8_LDA(At, 1, 1); PG8_STAGE(PG8_SA(1, 0), a3, v20);
            PG8_BAR; PG8_WAIT_L(0); PG8_MMA(1, 0, At, B0); PG8_BAR; PG8_SCHED;
            PG8_STAGE(PG8_SB(1, 1), b3 + hstepB, voffB);
            PG8_WAIT_V(6); PG8_BAR; PG8_MMA(1, 1, At, B1); PG8_BAR;
        }
        asm volatile("s_nop 15\n\ts_nop 15" ::: "memory");
        E(acc, cur, wr, wc, fr, fq);
        if (!has_next) break;
#pragma unroll
        for (int a = 0; a < 2; ++a)
#pragma unroll
            for (int b = 0; b < 2; ++b)
#pragma unroll
                for (int m = 0; m < 4; ++m)
#pragma unroll
                    for (int n = 0; n < 2; ++n) acc[a][b][m][n] = (f32x4){0.f, 0.f, 0.f, 0.f};
        cur = nxt; cB = nB; ++ui; cv0[0] = nv0[0]; cv0[1] = nv0[1]; cv1[0] = nv1[0]; cv1[1] = nv1[1];
    }
    PG8_WAIT_V(0);
    if (wr == 0) PG8_BAR;
    PG8_BAR;
#undef PG8_TOKV
#undef PG8_SA
#undef PG8_SB
#undef PG8_STAGE
#undef PG8_LDA
#undef PG8_LDB
#undef PG8_MMA
#undef PG8_WAIT_V
#undef PG8_WAIT_L
#undef PG8_BAR
#undef PG8_SCHED
}

__device__ __forceinline__ void dense_map(int L, int nM, int nN, int& pm, int& pn) {
    const int nwg = nM * nN;
    int wgid = L; { const int q = nwg / 8, r = nwg % 8, xcd = wgid % 8, off = wgid / 8; wgid = (xcd < r ? xcd * (q + 1) : r * (q + 1) + (xcd - r) * q) + off; }
    const int nig = 8 * nN, gid = wgid / nig, fm = gid * 8, gsz = (nM - fm) < 8 ? (nM - fm) : 8;
    pm = fm + ((wgid % nig) % gsz); pn = (wgid % nig) / gsz;
}
struct DenseOrder {
    const char* A; const char* Bt; unsigned lda_b, ldb_b; int nM, nN, nwg, G, c;
    __device__ void init(const void* A_, const void* Bt_, int M, int N, unsigned lda_b_, unsigned ldb_b_, int G_, int c_) { A = (const char*)A_; Bt = (const char*)Bt_; lda_b = lda_b_; ldb_b = ldb_b_; nM = M / BM; nN = N / BM; nwg = nM * nN; G = G_; c = c_; }
    __device__ bool next(int i, GUnit& u) const {
        const long L = (long)i * G + c; if (L >= nwg) return false;
        int pm, pn; dense_map((int)L, nM, nN, pm, pn);
        u.A = A + (size_t)pm * BM * lda_b; u.B = Bt + (size_t)pn * BM * ldb_b; u.row0 = pm * BM; u.col0 = pn * BM; u.aux = 0; return true;
    }
};


struct OneUnit {
    GUnit u;
    __device__ bool next(int i, GUnit& o) const { if (i != 0) return false; o = u; return true; }
};
struct EpiF32R {
    float* C; int ldc; const float* res; int ncols;
    __device__ __forceinline__ void operator()(const f32x4 (&acc)[2][2][4][2], const GUnit& u, int wr, int wc, int fr, int fq) const {
        const int row0 = u.row0 + wr * 64 + fr, col0 = u.col0 + wc * 32 + 4 * fq;
#pragma unroll
        for (int ai = 0; ai < 2; ++ai)
#pragma unroll
            for (int m = 0; m < 4; ++m) {
                const size_t ro = (size_t)(row0 + ai * HALF + m * 16) * ldc;
#pragma unroll
                for (int bj = 0; bj < 2; ++bj)
#pragma unroll
                    for (int n = 0; n < 2; ++n) {
                        const int col = col0 + bj * HALF + n * 16;
                        if (col < ncols) { f32x4 x = acc[ai][bj][m][n]; if (res) x += *(const f32x4*)(res + ro + col); *(f32x4*)(C + ro + col) = x; }
                    }
            }
    }
};


struct EpiResNormStats {
    const float* res; bf16_t* Hb; float* ss; unsigned char* H8;
    __device__ __forceinline__ void operator()(const f32x4 (&acc)[2][2][4][2], const GUnit& u, int wr, int wc, int fr, int fq) const {
        const int row0 = u.row0 + wr * 64 + fr, col0 = u.col0 + wc * 32 + 4 * fq;
#pragma unroll
        for (int ai = 0; ai < 2; ++ai)
#pragma unroll
            for (int m = 0; m < 4; ++m) {
                const int row = row0 + ai * HALF + m * 16;
                const size_t ro = (size_t)row * 1024;
                float sq = 0.f;
#pragma unroll
                for (int bj = 0; bj < 2; ++bj)
#pragma unroll
                    for (int n = 0; n < 2; ++n) {
                        const int col = col0 + bj * HALF + n * 16;
                        const f32x4 x = acc[ai][bj][m][n] + *(const f32x4*)(res + ro + col);
                        uint2 o; o.x = cvt_pk_bf16(x[0], x[1]); o.y = cvt_pk_bf16(x[2], x[3]);
                        *(uint2*)(Hb + ro + col) = o;
                        *(unsigned*)(H8 + ro + col) = pk4_fp8(x[0], x[1], x[2], x[3]);
                        sq += x[0] * x[0] + x[1] * x[1] + x[2] * x[2] + x[3] * x[3];
                    }
                sq += __shfl_xor(sq, 16); sq += __shfl_xor(sq, 32);
                if (fq == 0) ss[(size_t)row * 16 + (u.col0 >> 8) * 4 + wc] = sq;
            }
    }
};
struct EpiBf16RowScale {
    bf16_t* O; const float* ss; float scale;
    __device__ __forceinline__ void operator()(const f32x4 (&acc)[2][2][4][2], const GUnit& u, int wr, int wc, int fr, int fq) const {
        const int row0 = u.row0 + wr * 64 + fr, col0 = u.col0 + wc * 32 + 4 * fq;
#pragma unroll
        for (int ai = 0; ai < 2; ++ai)
#pragma unroll
            for (int m = 0; m < 4; ++m) {
                const int row = row0 + ai * HALF + m * 16;
                const f32x4* sp = (const f32x4*)(ss + (size_t)row * 16);
                const f32x4 s0 = sp[0], s1 = sp[1], s2 = sp[2], s3 = sp[3];
                const float tot = (((s0[0] + s0[1]) + (s0[2] + s0[3])) + ((s1[0] + s1[1]) + (s1[2] + s1[3]))) + (((s2[0] + s2[1]) + (s2[2] + s2[3])) + ((s3[0] + s3[1]) + (s3[2] + s3[3])));
                const float rs = rsqrtf(tot * (1.f / 1024.f) + 1e-5f) * scale;
                bf16_t* rowp = O + (size_t)row * 1024 + col0;
#pragma unroll
                for (int bj = 0; bj < 2; ++bj)
#pragma unroll
                    for (int n = 0; n < 2; ++n) { const f32x4 x = acc[ai][bj][m][n] * rs; uint2 o; o.x = cvt_pk_bf16(x[0], x[1]); o.y = cvt_pk_bf16(x[2], x[3]); *(uint2*)(rowp + bj * HALF + n * 16) = o; }
            }
    }
};

struct EpiBf16Res {
    bf16_t* H; float scale;
    __device__ __forceinline__ void operator()(const f32x4 (&acc)[2][2][4][2], const GUnit& u, int wr, int wc, int fr, int fq) const {
        const int row0 = u.row0 + wr * 64 + fr, col0 = u.col0 + wc * 32 + 4 * fq;
#pragma unroll
        for (int ai = 0; ai < 2; ++ai)
#pragma unroll
            for (int m = 0; m < 4; ++m) {
                bf16_t* rowp = H + (size_t)(row0 + ai * HALF + m * 16) * 1024 + col0;
#pragma unroll
                for (int bj = 0; bj < 2; ++bj)
#pragma unroll
                    for (int n = 0; n < 2; ++n) {
                        const uint2 r = *(const uint2*)(rowp + bj * HALF + n * 16);
                        const f32x4 a = acc[ai][bj][m][n] * scale;
                        uint2 o; o.x = cvt_pk_bf16(a[0] + __uint_as_float(r.x << 16), a[1] + __uint_as_float(r.x & 0xffff0000u)); o.y = cvt_pk_bf16(a[2] + __uint_as_float(r.y << 16), a[3] + __uint_as_float(r.y & 0xffff0000u));
                        *(uint2*)(rowp + bj * HALF + n * 16) = o;
                    }
            }
    }
};
struct EpiBf16S {
    bf16_t* O; int ldc; float scale;
    __device__ __forceinline__ void operator()(const f32x4 (&acc)[2][2][4][2], const GUnit& u, int wr, int wc, int fr, int fq) const {
        const int row0 = u.row0 + wr * 64 + fr, col0 = u.col0 + wc * 32 + 4 * fq;
#pragma unroll
        for (int ai = 0; ai < 2; ++ai)
#pragma unroll
            for (int m = 0; m < 4; ++m) {
                bf16_t* rowp = O + (size_t)(row0 + ai * HALF + m * 16) * ldc + col0;
#pragma unroll
                for (int bj = 0; bj < 2; ++bj)
#pragma unroll
                    for (int n = 0; n < 2; ++n) { const f32x4 x = acc[ai][bj][m][n] * scale; uint2 o; o.x = cvt_pk_bf16(x[0], x[1]); o.y = cvt_pk_bf16(x[2], x[3]); *(uint2*)(rowp + bj * HALF + n * 16) = o; }
            }
    }
};
struct EpiXkv {
    bf16_t *xk, *xvT;
    __device__ __forceinline__ void operator()(const f32x4 (&acc)[2][2][4][2], const GUnit& u, int wr, int wc, int fr, int fq) const {
        const int row0 = u.row0 + wr * 64 + fr, col0 = u.col0 + wc * 32 + 4 * fq;
        const bool isv = u.col0 >= 1024;
#pragma unroll
        for (int ai = 0; ai < 2; ++ai)
#pragma unroll
            for (int m = 0; m < 4; ++m) {
                const int row = row0 + ai * HALF + m * 16, b = row >> 8, key = row & 255;
#pragma unroll
                for (int bj = 0; bj < 2; ++bj)
#pragma unroll
                    for (int n = 0; n < 2; ++n) {
                        const int col = (col0 + bj * HALF + n * 16) & 1023, h = col >> 8, d = col & 255;
                        const f32x4 x = acc[ai][bj][m][n];
                        uint2 o; o.x = cvt_pk_bf16_acc(x[0], x[1]); o.y = cvt_pk_bf16_acc(x[2], x[3]);
                        if (!isv) *(uint2*)(xk + ((size_t)(b * 4 + h) * 256 + key) * 256 + d) = o;
                        else { bf16_t* base = xvT + ((size_t)(b * 4 + h) * 256 + d) * 256 + key;
                               base[0] = (bf16_t)(o.x & 0xffff); base[256] = (bf16_t)(o.x >> 16); base[512] = (bf16_t)(o.y & 0xffff); base[768] = (bf16_t)(o.y >> 16); }
                    }
            }
    }
};

struct EpiMixIn {
    bf16_t *q, *kk  , *vt  , *u, *cb; float* gates; const float* cosT; const float* sinT;
    __device__ __forceinline__ void operator()(const f32x4 (&acc)[2][2][4][2], const GUnit& un, int wr, int wc, int fr, int fq) const {
        const int pn = un.col0 >> 8, w1 = wc & 1, w2 = wc >> 1, dlo = 16 * w1 + 4 * fq;
#pragma unroll
        for (int ai = 0; ai < 2; ++ai)
#pragma unroll
            for (int m = 0; m < 4; ++m) {
                const int t = un.row0 + ai * HALF + wr * 64 + m * 16 + fr, b = t >> 11, sq = t & 2047;
                if (pn <= 4) {
                    const f32x4 cv = *(const f32x4*)(cosT + (size_t)t * 32 + dlo), sv = *(const f32x4*)(sinT + (size_t)t * 32 + dlo);
#pragma unroll
                    for (int bj = 0; bj < 2; ++bj) {
                        const int blk = 2 * bj + w2;
                        f32x4 x0 = acc[ai][bj][m][0], x1 = acc[ai][bj][m][1];
                        const bool rope = (pn < 2) || (bj == 0);
                        if (rope) { const f32x4 r0 = x0 * cv - x1 * sv, r1 = x1 * cv + x0 * sv; x0 = r0; x1 = r1; }
                        if (pn < 2) { x0 *= QS; x1 *= QS; }
                        uint2 o0, o1; o0.x = cvt_pk_bf16_acc(x0[0], x0[1]); o0.y = cvt_pk_bf16_acc(x0[2], x0[3]); o1.x = cvt_pk_bf16_acc(x1[0], x1[1]); o1.y = cvt_pk_bf16_acc(x1[2], x1[3]);
                        if (pn < 2) {
                            bf16_t* dst = q + (size_t)t * 512 + (pn * 4 + blk) * 64 + dlo;
                            *(uint2*)dst = o0; *(uint2*)(dst + 32) = o1;
                        } else {
                            const int g = blk & 1;
                            const size_t rowi = (size_t)(b * 2 + g) * S + sq;
                            if (bj == 0 || pn == 2) {
                                const int ki = (pn == 2) ? bj : pn - 1;
                                bf16_t* dst = kk + (size_t)ki * ((size_t)T * 128) + rowi * 64 + dlo;
                                *(uint2*)dst = o0; *(uint2*)(dst + 32) = o1;
                            } else {
                                bf16_t* base = vt + (size_t)(pn - 3) * ((size_t)T * 128) + ((size_t)(b * 2 + g) * 64 + dlo) * S + sq;
                                base[0 * S] = (bf16_t)(o0.x & 0xffff); base[1 * S] = (bf16_t)(o0.x >> 16); base[2 * S] = (bf16_t)(o0.y & 0xffff); base[3 * S] = (bf16_t)(o0.y >> 16);
                                base[32 * S] = (bf16_t)(o1.x & 0xffff); base[33 * S] = (bf16_t)(o1.x >> 16); base[34 * S] = (bf16_t)(o1.y & 0xffff); base[35 * S] = (bf16_t)(o1.y >> 16);
                            }
                        }
                    }
                } else if (pn < 9) {
#pragma unroll
                    for (int n = 0; n < 2; ++n) {
                        const f32x4 x = acc[ai][0][m][n] * acc[ai][1][m][n];
                        uint2 o; o.x = cvt_pk_bf16(x[0], x[1]); o.y = cvt_pk_bf16(x[2], x[3]);
                        *(uint2*)(u + (size_t)t * 512 + (pn - 5) * 128 + w2 * 64 + n * 32 + dlo) = o;
                    }
                } else if (pn < 11) {
#pragma unroll
                    for (int bj = 0; bj < 2; ++bj)
#pragma unroll
                        for (int n = 0; n < 2; ++n) {
                            const f32x4 x = acc[ai][bj][m][n];
                            uint2 o; o.x = cvt_pk_bf16_acc(x[0], x[1]); o.y = cvt_pk_bf16_acc(x[2], x[3]);
                            *(uint2*)(cb + (size_t)t * 512 + (pn - 9) * 256 + bj * 128 + w2 * 64 + n * 32 + dlo) = o;
                        }
                } else {
                    if (w2 == 0 && dlo < 24) {
                        const f32x4 x = acc[ai][0][m][0];
                        f32x4 sg;
#pragma unroll
                        for (int j = 0; j < 4; ++j) sg[j] = 1.f / (1.f + __expf(-x[j]));
                        *(f32x4*)(gates + (size_t)t * 24 + dlo) = sg;
                    }
                }
            }
    }
};

template <int NPN>
struct MoeOrder {
    const char* A; const char* Bt; const int* tile_e; int nunits, G, c; size_t bt_expert_bytes;
    __device__ void init(const void* A_, const void* Bt_, const int* tile_e_, int ntiles, size_t bt_expert_bytes_, int G_, int c_) { A = (const char*)A_; Bt = (const char*)Bt_; tile_e = tile_e_; nunits = ntiles * NPN; bt_expert_bytes = bt_expert_bytes_; G = G_; c = c_; }
    __device__ bool next(int i, GUnit& u) const {
        const int L = i * G + c; if (L >= nunits) return false;
        const int tl = L / NPN, pn = L % NPN, e = tile_e[tl];
        u.A = A + (size_t)tl * BM * 2048; u.B = Bt + (size_t)e * bt_expert_bytes + (size_t)pn * BM * 2048; u.row0 = tl * BM; u.col0 = pn * BM; u.aux = e; return true;
    }
};
struct EpiSwiglu {
    bf16_t* H; const float* bias;
    __device__ __forceinline__ void operator()(const f32x4 (&acc)[2][2][4][2], const GUnit& u, int wr, int wc, int fr, int fq) const {
        const int row0 = u.row0 + wr * 64 + fr, pn = u.col0 >> 8, cl0 = wc * 32 + 4 * fq;
        const float* bg = bias + (size_t)u.aux * 2048 + pn * 128 + cl0;
        f32x4 bgv[2], buv[2];
#pragma unroll
        for (int n = 0; n < 2; ++n) { bgv[n] = *(const f32x4*)(bg + n * 16); buv[n] = *(const f32x4*)(bg + 1024 + n * 16); }
#pragma unroll
        for (int ai = 0; ai < 2; ++ai)
#pragma unroll
            for (int m = 0; m < 4; ++m) {
                bf16_t* rowp = H + (size_t)(row0 + ai * HALF + m * 16) * 1024 + pn * 128 + cl0;
#pragma unroll
                for (int n = 0; n < 2; ++n) {
                    const f32x4 g4 = acc[ai][0][m][n] + bgv[n], u4 = acc[ai][1][m][n] + buv[n];
                    float h[4];
#pragma unroll
                    for (int j = 0; j < 4; ++j) {
                        const float g = fminf(g4[j], 7.f), uu = fminf(fmaxf(u4[j], -7.f), 7.f);
                        h[j] = (uu + 1.f) * (g / (1.f + __expf(-1.702f * g)));
                    }
                    uint2 o; o.x = cvt_pk_bf16(h[0], h[1]); o.y = cvt_pk_bf16(h[2], h[3]);
                    *(uint2*)(rowp + n * 16) = o;
                }
            }
    }
};
struct EpiDownScale {
    bf16_t* O; const float* bias; const float* w_buf;
    __device__ __forceinline__ void operator()(const f32x4 (&acc)[2][2][4][2], const GUnit& u, int wr, int wc, int fr, int fq) const {
        const int row0 = u.row0 + wr * 64 + fr, col0 = u.col0 + wc * 32 + 4 * fq;
        f32x4 bv[2][2];
#pragma unroll
        for (int bj = 0; bj < 2; ++bj)
#pragma unroll
            for (int n = 0; n < 2; ++n) bv[bj][n] = *(const f32x4*)(bias + (size_t)u.aux * 1024 + col0 + bj * HALF + n * 16);
#pragma unroll
        for (int ai = 0; ai < 2; ++ai)
#pragma unroll
            for (int m = 0; m < 4; ++m) {
                const int row = row0 + ai * HALF + m * 16;
                const float w = w_buf[row];
                bf16_t* rowp = O + (size_t)row * 1024 + col0;
#pragma unroll
                for (int bj = 0; bj < 2; ++bj)
#pragma unroll
                    for (int n = 0; n < 2; ++n) {
                        const f32x4 x = (acc[ai][bj][m][n] + bv[bj][n]) * w;
                        uint2 o; o.x = cvt_pk_bf16(x[0], x[1]); o.y = cvt_pk_bf16(x[2], x[3]);
                        *(uint2*)(rowp + bj * HALF + n * 16) = o;
                    }
            }
    }
};

constexpr float W8_SCALE = 64.f, W8_INV = 1.f / 64.f;
__device__ __forceinline__ unsigned pk4_fp8(float a, float b, float c, float d) { unsigned w = 0; w = __builtin_amdgcn_cvt_pk_fp8_f32(a, b, w, false); w = __builtin_amdgcn_cvt_pk_fp8_f32(c, d, w, true); return w; }
struct EpiSwigluF8out {
    unsigned char* H; const float* bias;
    __device__ __forceinline__ void operator()(const f32x4 (&acc)[2][2][4][2], const GUnit& u, int wr, int wc, int fr, int fq) const {
        const int row0 = u.row0 + wr * 64 + fr, pn = u.col0 >> 8, cl0 = wc * 32 + 4 * fq;
        const float* bg = bias + (size_t)u.aux * 2048 + pn * 128 + cl0;
        f32x4 bgv[2], buv[2];
#pragma unroll
        for (int n = 0; n < 2; ++n) { bgv[n] = *(const f32x4*)(bg + n * 16); buv[n] = *(const f32x4*)(bg + 1024 + n * 16); }
#pragma unroll
        for (int ai = 0; ai < 2; ++ai)
#pragma unroll
            for (int m = 0; m < 4; ++m) {
                unsigned char* rowp = H + (size_t)(row0 + ai * HALF + m * 16) * 1024 + pn * 128 + cl0;
#pragma unroll
                for (int n = 0; n < 2; ++n) {
                    const f32x4 g4 = acc[ai][0][m][n] + bgv[n], u4 = acc[ai][1][m][n] + buv[n];
                    float h[4];
#pragma unroll
                    for (int j = 0; j < 4; ++j) {
                        const float g = fminf(g4[j], 7.f), uu = fminf(fmaxf(u4[j], -7.f), 7.f);
                        h[j] = (uu + 1.f) * (g / (1.f + __expf(-1.702f * g)));
                    }
                    *(unsigned*)(rowp + n * 16) = pk4_fp8(h[0], h[1], h[2], h[3]);
                }
            }
    }
};
struct EpiSwigluF8 {
    unsigned char* H; const float* bias;
    __device__ __forceinline__ void operator()(const f32x4 (&acc)[2][2][4][2], const GUnit& u, int wr, int wc, int fr, int fq) const {
        const int row0 = u.row0 + wr * 64 + fr, pn = u.col0 >> 8, cl0 = wc * 32 + 4 * fq;
        const float* bg = bias + (size_t)u.aux * 2048 + pn * 128 + cl0;
        f32x4 bgv[2], buv[2];
#pragma unroll
        for (int n = 0; n < 2; ++n) { bgv[n] = *(const f32x4*)(bg + n * 16); buv[n] = *(const f32x4*)(bg + 1024 + n * 16); }
#pragma unroll
        for (int ai = 0; ai < 2; ++ai)
#pragma unroll
            for (int m = 0; m < 4; ++m) {
                unsigned char* rowp = H + (size_t)(row0 + ai * HALF + m * 16) * 1024 + pn * 128 + cl0;
#pragma unroll
                for (int n = 0; n < 2; ++n) {
                    const f32x4 g4 = acc[ai][0][m][n] * W8_INV + bgv[n], u4 = acc[ai][1][m][n] * W8_INV + buv[n];
                    float h[4];
#pragma unroll
                    for (int j = 0; j < 4; ++j) {
                        const float g = fminf(g4[j], 7.f), uu = fminf(fmaxf(u4[j], -7.f), 7.f);
                        h[j] = (uu + 1.f) * g * __builtin_amdgcn_rcpf(1.f + __builtin_amdgcn_exp2f(-1.702f * 1.4426950408889634f * g));
                    }
                    *(unsigned*)(rowp + n * 16) = pk4_fp8(h[0], h[1], h[2], h[3]);
                }
            }
    }
};
struct EpiDownScaleF8 {
    unsigned char* O; const float* bias; const float* w_buf;
    __device__ __forceinline__ void operator()(const f32x4 (&acc)[2][2][4][2], const GUnit& u, int wr, int wc, int fr, int fq) const {
        const int row0 = u.row0 + wr * 64 + fr, col0 = u.col0 + wc * 32 + 4 * fq;
        f32x4 bv[2][2];
#pragma unroll
        for (int bj = 0; bj < 2; ++bj)
#pragma unroll
            for (int n = 0; n < 2; ++n) bv[bj][n] = *(const f32x4*)(bias + (size_t)u.aux * 1024 + col0 + bj * HALF + n * 16);
#pragma unroll
        for (int ai = 0; ai < 2; ++ai)
#pragma unroll
            for (int m = 0; m < 4; ++m) {
                const int row = row0 + ai * HALF + m * 16;
                const float w = w_buf[row] * 8.f;
                unsigned char* rowp = O + (size_t)row * 1024 + col0;
#pragma unroll
                for (int bj = 0; bj < 2; ++bj)
#pragma unroll
                    for (int n = 0; n < 2; ++n) {
                        const f32x4 x = (acc[ai][bj][m][n] * W8_INV + bv[bj][n]) * w;
                        *(unsigned*)(rowp + bj * HALF + n * 16) = pk4_fp8(x[0], x[1], x[2], x[3]);
                    }
            }
    }
};
template <int NPN>
struct MoeOrderB {
    const char* A; const char* Bt; const int* tile_e; int nunits, G, c; size_t bt_expert_bytes; unsigned row_b;
    __device__ void init(const void* A_, const void* Bt_, const int* tile_e_, int ntiles, size_t bt_expert_bytes_, unsigned row_b_, int G_, int c_) { A = (const char*)A_; Bt = (const char*)Bt_; tile_e = tile_e_; nunits = ntiles * NPN; bt_expert_bytes = bt_expert_bytes_; row_b = row_b_; G = G_; c = c_; }
    __device__ bool next(int i, GUnit& u) const {
        const int L = i * G + c; if (L >= nunits) return false;
        const int tl = L / NPN, pn = L % NPN, e = tile_e[tl];
        u.A = A + (size_t)tl * BM * row_b; u.B = Bt + (size_t)e * bt_expert_bytes + (size_t)pn * BM * row_b; u.row0 = tl * BM; u.col0 = pn * BM; u.aux = e; return true;
    }
};
}


__device__ __forceinline__ void posbias_wave(int n, int lane, const float* __restrict__ pos, const float* __restrict__ w1, const float* __restrict__ b1, float* __restrict__ b1p) {
    float acc = 0.f;
#pragma unroll 8
    for (int i = 0; i < 32; ++i) { const int k = lane + 64 * i; acc += pos[k] * w1[(size_t)k * 256 + n]; }
    acc = wave_sum(acc);
    if (lane == 0) b1p[n] = acc + b1[n];
}
__device__ __forceinline__ void p_cmp_finalize(char* lds, const float* __restrict__ Pab_k, const float* __restrict__ Pab_v, const float* __restrict__ b1p_k, const float* __restrict__ b1p_v,
                                               const float* __restrict__ w2k, const float* __restrict__ w2v, pg::bf16_t* __restrict__ kc, pg::bf16_t* __restrict__ vcT, int wg, int nwg) {
    const int lane = threadIdx.x & 63, wv = threadIdx.x >> 6;
    float* hs = (float*)lds + wv * 256;
    for (int it = wg * 8 + wv; it < 2 * 16 * 128; it += nwg * 8) {
        const int which = it >> 11, row = it & 2047, bg = row >> 7, c = row & 127;
        const float* P = which ? Pab_v : Pab_k; const float* bp = which ? b1p_v : b1p_k; const float* w2 = which ? w2v : w2k;
        float o = 0.f;
        if (c < 127) {
#pragma unroll
            for (int i = 0; i < 4; ++i) { const int n = lane + 64 * i; hs[n] = gelu_tanh(P[(size_t)row * 512 + n] + P[(size_t)(row + 1) * 512 + 256 + n] + bp[n]); }
            __builtin_amdgcn_s_waitcnt(0);
            for (int n = 0; n < 256; ++n) o += hs[n] * w2[n * 64 + lane];
        }
        if (which == 0) kc[(size_t)row * 64 + lane] = pg::f2bf(o); else vcT[((size_t)bg * 64 + lane) * 128 + c] = pg::f2bf(o);
    }
}

namespace at {
using pg::bf16_t;
typedef short bf16x8 __attribute__((ext_vector_type(8)));
typedef float f32x16 __attribute__((ext_vector_type(16)));
typedef float f32x4 __attribute__((ext_vector_type(4)));
constexpr int TROW = 144, TILE_B = 64 * TROW;
#define AT_MFMA(a, b, c) __builtin_amdgcn_mfma_f32_32x32x16_bf16(a, b, c, 0, 0, 0)
__device__ __forceinline__ bf16x8 pack8(const f32x16& p, int s8) {
    union { unsigned u[4]; bf16x8 v; } x;
#pragma unroll
    for (int i = 0; i < 4; ++i) x.u[i] = pg::cvt_pk_bf16(p[s8 + 2 * i], p[s8 + 2 * i + 1]);
    return x.v;
}
template <int MODE>
__device__ __forceinline__ void attn64_unit(char* lds, int b, int g, int tq, const bf16_t* __restrict__ Q, const bf16_t* __restrict__ Kh, const bf16_t* __restrict__ VT,
                                            const unsigned* __restrict__ selmask, bf16_t* __restrict__ out, const bf16_t* __restrict__ o_cmp, const bf16_t* __restrict__ o_win, const float* __restrict__ gates) {
    const int tid = opaque_tid(), lane = tid & 63, r32 = lane & 31, hi = lane >> 5;
    const int wid = __builtin_amdgcn_readfirstlane(tid >> 6), hl = wid >> 1, qs = wid & 1;
    const int ql = 32 * qs + r32, qpos = tq * 64 + ql, h = g * 4 + hl;
    const size_t trow = (size_t)b * S + qpos;
    const bf16_t* Kb = Kh + (size_t)(b * 2 + g) * S * 64;
    const bf16_t* Vb = VT + (size_t)(b * 2 + g) * 64 * S;
    const int srow = tid >> 3, sch = tid & 7;
    const int kst = srow * TROW + sch * 16;
    const int vst = TILE_B + srow * TROW + ((sch >> 1) * 16 + (sch & 1) * 4) * 2;
    bf16x8 qf[4];
#pragma unroll
    for (int d0 = 0; d0 < 4; ++d0) qf[d0] = *(const bf16x8*)(Q + trow * 512 + h * 64 + 16 * d0 + 8 * hi);
    unsigned msk = 0xffffffffu;
    if (MODE == 0) msk = selmask[(size_t)(b * 2 + g) * S + qpos];
    const int nt = (MODE == 0) ? tq + 1 : (tq < 8 ? tq + 1 : 9);
    f32x16 o0, o1;
#pragma unroll
    for (int r = 0; r < 16; ++r) { o0[r] = 0.f; o1[r] = 0.f; }
    float m = -INFINITY, l = 0.f;
    uint4 kreg, vreg;
    kreg = *(const uint4*)(Kb + (size_t)(tq * 64 + srow) * 64 + sch * 8); vreg = *(const uint4*)(Vb + (size_t)srow * S + tq * 64 + sch * 8);
    __syncthreads();
    *(uint4*)(lds + kst) = kreg; *(uint2*)(lds + vst) = make_uint2(vreg.x, vreg.y); *(uint2*)(lds + vst + 16) = make_uint2(vreg.z, vreg.w);
    __syncthreads();
    for (int i = 0; i < nt; ++i) {
        if (i + 1 < nt) { const int tile = tq - i - 1; kreg = *(const uint4*)(Kb + (size_t)(tile * 64 + srow) * 64 + sch * 8); vreg = *(const uint4*)(Vb + (size_t)srow * S + tile * 64 + sch * 8); }
        const char* kb_ = lds + (i & 1) * 2 * TILE_B; const char* vb_ = kb_ + TILE_B;
        f32x16 p0, p1;
#pragma unroll
        for (int r = 0; r < 16; ++r) { p0[r] = 0.f; p1[r] = 0.f; }
#pragma unroll
        for (int d0 = 0; d0 < 4; ++d0) {
            const bf16x8 kf0 = *(const bf16x8*)(kb_ + r32 * TROW + d0 * 32 + hi * 16), kf1 = *(const bf16x8*)(kb_ + (32 + r32) * TROW + d0 * 32 + hi * 16);
            p0 = AT_MFMA(kf0, qf[d0], p0); p1 = AT_MFMA(kf1, qf[d0], p1);
        }
        if (i == 0) {
#pragma unroll
            for (int r = 0; r < 16; ++r) { const int kl = (r & 3) + 8 * (r >> 2) + 4 * hi; if (kl > ql) p0[r] = -INFINITY; if (kl + 32 > ql) p1[r] = -INFINITY; }
        } else if (MODE == 1) {
            if (i == 8) {
#pragma unroll
                for (int r = 0; r < 16; ++r) { const int kl = (r & 3) + 8 * (r >> 2) + 4 * hi; if (kl <= ql) p0[r] = -INFINITY; if (kl + 32 <= ql) p1[r] = -INFINITY; }
            }
        } else {
            if (!((msk >> (tq - i)) & 1u)) {
#pragma unroll
                for (int r = 0; r < 16; ++r) { p0[r] = -INFINITY; p1[r] = -INFINITY; }
            }
        }
        float mx = fmaxf(p0[0], p1[0]);
#pragma unroll
        for (int r = 1; r < 16; ++r) mx = fmaxf(mx, fmaxf(p0[r], p1[r]));
        mx = fmaxf(mx, lane_xor32(mx));
        if (i == 0) m = mx;
        else if (__builtin_amdgcn_ballot_w64(mx > m + 8.f) != 0ull) {
            const float mn = fmaxf(m, mx), alpha = __builtin_amdgcn_exp2f(m - mn);
            m = mn; l *= alpha;
#pragma unroll
            for (int r = 0; r < 16; ++r) { o0[r] *= alpha; o1[r] *= alpha; }
        }
        float ls = 0.f;
#pragma unroll
        for (int r = 0; r < 16; ++r) { p0[r] = __builtin_amdgcn_exp2f(p0[r] - m); p1[r] = __builtin_amdgcn_exp2f(p1[r] - m); ls += p0[r] + p1[r]; }
        l += ls;
        bf16x8 pb[4];
        pb[0] = pack8(p0, 0); pb[1] = pack8(p0, 8); pb[2] = pack8(p1, 0); pb[3] = pack8(p1, 8);
#pragma unroll
        for (int ks = 0; ks < 4; ++ks) {
            const bf16x8 vf0 = *(const bf16x8*)(vb_ + r32 * TROW + ks * 32 + hi * 16), vf1 = *(const bf16x8*)(vb_ + (32 + r32) * TROW + ks * 32 + hi * 16);
            o0 = AT_MFMA(vf0, pb[ks], o0); o1 = AT_MFMA(vf1, pb[ks], o1);
        }
        if (i + 1 < nt) {
            char* nb = lds + ((i + 1) & 1) * 2 * TILE_B;
            *(uint4*)(nb + kst) = kreg; *(uint2*)(nb + vst) = make_uint2(vreg.x, vreg.y); *(uint2*)(nb + vst + 16) = make_uint2(vreg.z, vreg.w);
        }
        __syncthreads();
    }
    const float lt = l + lane_xor32(l), inv = 1.f / lt;
    const size_t obase = trow * 512 + h * 64 + 4 * hi;
    float g0 = 0.f, g1 = inv, g2 = 0.f;
    if (MODE == 0) { g0 = gates[trow * 24 + h * 3 + 0]; g1 = gates[trow * 24 + h * 3 + 1] * inv; g2 = gates[trow * 24 + h * 3 + 2]; }
#pragma unroll
    for (int rr = 0; rr < 4; ++rr)
#pragma unroll
        for (int dh = 0; dh < 2; ++dh) {
            const f32x16& oo = dh ? o1 : o0;
            float x0 = oo[4 * rr] * g1, x1 = oo[4 * rr + 1] * g1, x2 = oo[4 * rr + 2] * g1, x3 = oo[4 * rr + 3] * g1;
            const size_t idx = obase + 32 * dh + 8 * rr;
            if (MODE == 0) {
                const uint2 c = *(const uint2*)(o_cmp + idx), w = *(const uint2*)(o_win + idx);
                x0 += g0 * __uint_as_float(c.x << 16) + g2 * __uint_as_float(w.x << 16); x1 += g0 * __uint_as_float(c.x & 0xffff0000u) + g2 * __uint_as_float(w.x & 0xffff0000u);
                x2 += g0 * __uint_as_float(c.y << 16) + g2 * __uint_as_float(w.y << 16); x3 += g0 * __uint_as_float(c.y & 0xffff0000u) + g2 * __uint_as_float(w.y & 0xffff0000u);
            }
            uint2 o; o.x = pg::cvt_pk_bf16(x0, x1); o.y = pg::cvt_pk_bf16(x2, x3);
            *(uint2*)(out + idx) = o;
        }
}

constexpr int CK_ROW = 144, CV_ROW = 272, CK_B = 128 * CK_ROW, CV_B = 64 * CV_ROW, CP_OFF = CK_B + CV_B, CI_OFF = CP_OFF + 4 * 64 * 32 * 4, CMP_LDS = CI_OFF + 64 * 32 * 4;
__device__ __forceinline__ void cmp_unit(char* lds, int b, int g, int tq, const bf16_t* __restrict__ Q, const bf16_t* __restrict__ kc, const bf16_t* __restrict__ vcT,
                                         bf16_t* __restrict__ out, unsigned* __restrict__ selmask) {
    const int tid = opaque_tid(), lane = tid & 63, r32 = lane & 31, hi = lane >> 5;
    const int wid = __builtin_amdgcn_readfirstlane(tid >> 6), hl = wid >> 1, qs = wid & 1;
    const int ql = 32 * qs + r32, qpos = tq * 64 + ql, h = g * 4 + hl, bg = b * 2 + g;
    const size_t trow = (size_t)b * S + qpos;
    __syncthreads();
#pragma unroll
    for (int i = 0; i < 2; ++i) {
        const int ch = tid + 512 * i;
        { const int row = ch >> 3, c8 = ch & 7; *(uint4*)(lds + row * CK_ROW + c8 * 16) = *(const uint4*)(kc + ((size_t)bg * 128 + row) * 64 + c8 * 8); }
        { const int row = ch >> 4, c16 = ch & 15; const uint4 x = *(const uint4*)(vcT + ((size_t)bg * 64 + row) * 128 + c16 * 8);
          char* dst = lds + CK_B + row * CV_ROW + ((c16 >> 1) * 16 + (c16 & 1) * 4) * 2; *(uint2*)dst = make_uint2(x.x, x.y); *(uint2*)(dst + 16) = make_uint2(x.z, x.w); }
    }
    bf16x8 qf[4];
#pragma unroll
    for (int d0 = 0; d0 < 4; ++d0) qf[d0] = *(const bf16x8*)(Q + trow * 512 + h * 64 + 16 * d0 + 8 * hi);
    __syncthreads();
    f32x16 p[4];
#pragma unroll
    for (int kh = 0; kh < 4; ++kh) {
#pragma unroll
        for (int r = 0; r < 16; ++r) p[kh][r] = 0.f;
#pragma unroll
        for (int d0 = 0; d0 < 4; ++d0) { const bf16x8 kf = *(const bf16x8*)(lds + (32 * kh + r32) * CK_ROW + d0 * 32 + hi * 16); p[kh] = AT_MFMA(kf, qf[d0], p[kh]); }
    }
    float mx = -1e30f;
#pragma unroll
    for (int kh = 0; kh < 4; ++kh)
#pragma unroll
        for (int r = 0; r < 16; ++r) { const int c = 32 * kh + (r & 3) + 8 * (r >> 2) + 4 * hi; if (16 * c + 31 > qpos) p[kh][r] = -1e30f; mx = fmaxf(mx, p[kh][r]); }
    mx = fmaxf(mx, lane_xor32(mx));
    float ls = 0.f;
#pragma unroll
    for (int kh = 0; kh < 4; ++kh)
#pragma unroll
        for (int r = 0; r < 16; ++r) { p[kh][r] = __builtin_amdgcn_exp2f(p[kh][r] - mx); ls += p[kh][r]; }
    ls += lane_xor32(ls);
    const float inv = (mx > -1e29f) ? 1.f / ls : 0.f;
#pragma unroll
    for (int kh = 0; kh < 4; ++kh)
#pragma unroll
        for (int r = 0; r < 16; ++r) p[kh][r] *= inv;
    f32x16 o0, o1;
#pragma unroll
    for (int r = 0; r < 16; ++r) { o0[r] = 0.f; o1[r] = 0.f; }
#pragma unroll
    for (int ks = 0; ks < 8; ++ks) {
        const bf16x8 pb = pack8(p[ks >> 1], (ks & 1) * 8);
        const bf16x8 vf0 = *(const bf16x8*)(lds + CK_B + r32 * CV_ROW + ks * 32 + hi * 16), vf1 = *(const bf16x8*)(lds + CK_B + (32 + r32) * CV_ROW + ks * 32 + hi * 16);
        o0 = AT_MFMA(vf0, pb, o0); o1 = AT_MFMA(vf1, pb, o1);
    }
    bf16_t* orow = out + trow * 512 + h * 64 + 4 * hi;
#pragma unroll
    for (int rr = 0; rr < 4; ++rr) {
        uint2 a, c; a.x = pg::cvt_pk_bf16_acc(o0[4 * rr], o0[4 * rr + 1]); a.y = pg::cvt_pk_bf16_acc(o0[4 * rr + 2], o0[4 * rr + 3]); c.x = pg::cvt_pk_bf16_acc(o1[4 * rr], o1[4 * rr + 1]); c.y = pg::cvt_pk_bf16_acc(o1[4 * rr + 2], o1[4 * rr + 3]);
        *(uint2*)(orow + 8 * rr) = a; *(uint2*)(orow + 32 + 8 * rr) = c;
    }
    float inn[16], car[16];
#pragma unroll
    for (int t = 0; t < 16; ++t) { const f32x16& pk = p[t >> 2]; const int r0 = 4 * (t & 3); car[t] = 0.5f * pk[r0 + 3]; inn[t] = pk[r0] + pk[r0 + 1] + pk[r0 + 2] + car[t]; }
    float* part = (float*)(lds + CP_OFF) + (hl * 64 + ql) * 32;
#pragma unroll
    for (int t = 0; t < 16; ++t) {
        const float co = lane_xor32(car[t]);
        const float cprev = t > 0 ? lane_xor32(car[t - 1]) : 0.f;
        part[2 * t + hi] = inn[t] + (hi ? co : cprev);
    }
    __syncthreads();
    float* impf = (float*)(lds + CI_OFF);
    const float* pall = (const float*)(lds + CP_OFF);
#pragma unroll
    for (int k = 0; k < 4; ++k) {
        const int idx = tid + 512 * k, q = idx >> 5, j = idx & 31, cur = tq;
        float imp = ((pall[(0 * 64 + q) * 32 + j] + pall[(1 * 64 + q) * 32 + j]) + pall[(2 * 64 + q) * 32 + j]) + pall[(3 * 64 + q) * 32 + j];
        if (j == 0 || j == cur || j == cur - 1) imp = 1e30f; else if (j > cur) imp = -1e30f;
        impf[idx] = imp;
    }
    __syncthreads();
#pragma unroll
    for (int k = 0; k < 4; ++k) {
        const int idx = tid + 512 * k, q = idx >> 5, j = idx & 31;
        const float mine = impf[idx];
        int rank = 0;
        for (int i = 0; i < 32; ++i) { const float x = impf[q * 32 + i]; rank += (x > mine || (x == mine && i < j)) ? 1 : 0; }
        const unsigned long long bal = __ballot(rank < 16);
        if ((lane & 31) == 0) selmask[(size_t)bg * S + tq * 64 + q] = (unsigned)(hi ? (bal >> 32) : (bal & 0xffffffffull));
    }
}

constexpr int XK_ROW = 528, XV_ROW = 144, XK_B = 64 * XK_ROW, XV_B = 256 * XV_ROW;
typedef float f32x4v __attribute__((ext_vector_type(4)));
#define XT_MFMA(a, b, c) __builtin_amdgcn_mfma_f32_16x16x32_bf16(a, b, c, 0, 0, 0)
__device__ __forceinline__ void xattn_unit(char* lds, int b, int h, int qt, const bf16_t* __restrict__ Q, const bf16_t* __restrict__ xk, const bf16_t* __restrict__ xvT, unsigned char* __restrict__ out) {
    const int tid = opaque_tid(), lane = tid & 63, l15 = lane & 15, quad = lane >> 4;
    const int wid = __builtin_amdgcn_readfirstlane(tid >> 6);
    const size_t trow = (size_t)b * S + qt * 128 + wid * 16 + l15;
    const bf16_t* Kb = xk + (size_t)(b * 4 + h) * 256 * 256;
    const bf16_t* Vb = xvT + (size_t)(b * 4 + h) * 256 * 256;
    bf16x8 qf[8];
#pragma unroll
    for (int ds = 0; ds < 8; ++ds) qf[ds] = *(const bf16x8*)(Q + trow * 1024 + h * 256 + 32 * ds + 8 * quad);
    f32x4v o[16];
#pragma unroll
    for (int db = 0; db < 16; ++db) o[db] = (f32x4v){0.f, 0.f, 0.f, 0.f};
    float m = -INFINITY, l = 0.f;
    for (int kt = 0; kt < 4; ++kt) {
        __syncthreads();
#pragma unroll
        for (int i = 0; i < 4; ++i) {
            const int ch = tid + 512 * i;
            { const int row = ch >> 5, c = ch & 31; *(uint4*)(lds + row * XK_ROW + c * 16) = *(const uint4*)(Kb + (size_t)(kt * 64 + row) * 256 + c * 8); }
            { const int row = ch >> 3, c = ch & 7, cp = c & 3; const uint4 x = *(const uint4*)(Vb + (size_t)row * 256 + kt * 64 + c * 8);
              char* dst = lds + XK_B + row * XV_ROW + ((c >> 2) * 32 + 16 * (cp & 1) + 4 * (cp >> 1)) * 2; *(uint2*)dst = make_uint2(x.x, x.y); *(uint2*)(dst + 16) = make_uint2(x.z, x.w); }
        }
        __syncthreads();
        f32x4v sc[4];
#pragma unroll
        for (int kb = 0; kb < 4; ++kb) {
            sc[kb] = (f32x4v){0.f, 0.f, 0.f, 0.f};
#pragma unroll
            for (int ds = 0; ds < 8; ++ds) { const bf16x8 kf = *(const bf16x8*)(lds + (16 * kb + l15) * XK_ROW + ds * 64 + quad * 16); sc[kb] = XT_MFMA(kf, qf[ds], sc[kb]); }
        }
        float mx = -INFINITY;
#pragma unroll
        for (int kb = 0; kb < 4; ++kb)
#pragma unroll
            for (int r = 0; r < 4; ++r) mx = fmaxf(mx, sc[kb][r]);
        mx = fmaxf(mx, lane_xor16(mx)); mx = fmaxf(mx, lane_xor32(mx));
        const float mn = fmaxf(m, mx), alpha = __builtin_amdgcn_exp2f(m - mn);
        m = mn;
        float ls = 0.f;
#pragma unroll
        for (int kb = 0; kb < 4; ++kb)
#pragma unroll
            for (int r = 0; r < 4; ++r) { sc[kb][r] = __builtin_amdgcn_exp2f(sc[kb][r] - mn); ls += sc[kb][r]; }
        l = l * alpha + ls;
#pragma unroll
        for (int db = 0; db < 16; ++db) o[db] *= alpha;
#pragma unroll
        for (int k2 = 0; k2 < 2; ++k2) {
            union { unsigned u[4]; bf16x8 v; } pb;
            pb.u[0] = pg::cvt_pk_bf16(sc[2 * k2][0], sc[2 * k2][1]); pb.u[1] = pg::cvt_pk_bf16(sc[2 * k2][2], sc[2 * k2][3]);
            pb.u[2] = pg::cvt_pk_bf16(sc[2 * k2 + 1][0], sc[2 * k2 + 1][1]); pb.u[3] = pg::cvt_pk_bf16(sc[2 * k2 + 1][2], sc[2 * k2 + 1][3]);
#pragma unroll
            for (int db = 0; db < 16; ++db) { const bf16x8 vf = *(const bf16x8*)(lds + XK_B + (16 * db + l15) * XV_ROW + k2 * 64 + quad * 16); o[db] = XT_MFMA(vf, pb.v, o[db]); }
        }
    }
    l += lane_xor16(l); l += lane_xor32(l);
    const float inv = 1.f / l;
    unsigned char* orow = out + trow * 1024 + h * 256 + 4 * quad;
    const float inv16 = inv * 16.f;
#pragma unroll
    for (int db = 0; db < 16; ++db) *(unsigned*)(orow + 16 * db) = pg::pk4_fp8(o[db][0] * inv16, o[db][1] * inv16, o[db][2] * inv16, o[db][3] * inv16);
}
}


namespace tl {
using pg::bf16_t; using pg::cvt_pk_bf16;
__device__ __forceinline__ float blo(unsigned u) { return __uint_as_float(u << 16); }
__device__ __forceinline__ float bhi(unsigned u) { return __uint_as_float(u & 0xffff0000u); }
__device__ __forceinline__ float ssq4(const float4& a) { return a.x * a.x + a.y * a.y + a.z * a.z + a.w * a.w; }

__device__ __forceinline__ void rmsnorm_rows(const float* __restrict__ in, const float* __restrict__ g, bf16_t* __restrict__ out, int rows, int gw, int nw, int lane) {
    float4 gv[4];
#pragma unroll
    for (int i = 0; i < 4; ++i) gv[i] = *(const float4*)(g + 256 * i + 4 * lane);
    for (int r0 = gw; r0 < rows; r0 += 2 * nw) {
        const int r1 = r0 + nw; const bool two = r1 < rows;
        float4 a[4], b[4];
#pragma unroll
        for (int i = 0; i < 4; ++i) { a[i] = *(const float4*)(in + (size_t)r0 * 1024 + 256 * i + 4 * lane); b[i] = two ? *(const float4*)(in + (size_t)r1 * 1024 + 256 * i + 4 * lane) : make_float4(0.f, 0.f, 0.f, 0.f); }
        float sa = ssq4(a[0]) + ssq4(a[1]) + ssq4(a[2]) + ssq4(a[3]), sb = ssq4(b[0]) + ssq4(b[1]) + ssq4(b[2]) + ssq4(b[3]);
        sa = wave_sum(sa); sb = wave_sum(sb);
        const float ra = rsqrtf(sa * (1.f / 1024.f) + 1e-5f), rb = rsqrtf(sb * (1.f / 1024.f) + 1e-5f);
#pragma unroll
        for (int i = 0; i < 4; ++i) {
            uint2 o; o.x = cvt_pk_bf16(a[i].x * ra * gv[i].x, a[i].y * ra * gv[i].y); o.y = cvt_pk_bf16(a[i].z * ra * gv[i].z, a[i].w * ra * gv[i].w);
            *(uint2*)(out + (size_t)r0 * 1024 + 256 * i + 4 * lane) = o;
            if (two) { uint2 q; q.x = cvt_pk_bf16(b[i].x * rb * gv[i].x, b[i].y * rb * gv[i].y); q.y = cvt_pk_bf16(b[i].z * rb * gv[i].z, b[i].w * rb * gv[i].w); *(uint2*)(out + (size_t)r1 * 1024 + 256 * i + 4 * lane) = q; }
        }
    }
}

__device__ __forceinline__ void mix_post(const bf16_t* __restrict__ o_nsa, const bf16_t* __restrict__ ub, const bf16_t* __restrict__ cbb, const float* __restrict__ conv_w,
                                         const float* __restrict__ g_nsa, const float* __restrict__ g_conv, bf16_t* __restrict__ omix, int gw, int nw, int lane) {
    float cw[3][8], gn[8], gc[8];
#pragma unroll
    for (int j = 0; j < 8; ++j) { gn[j] = g_nsa[8 * lane + j]; gc[j] = g_conv[8 * lane + j]; cw[0][j] = conv_w[8 * lane + j]; cw[1][j] = conv_w[512 + 8 * lane + j]; cw[2][j] = conv_w[1024 + 8 * lane + j]; }
    for (int t = gw; t < T; t += nw) {
        const int sq = t & (S - 1);
        const uint4 zero = make_uint4(0u, 0u, 0u, 0u);
        const uint4 on4 = *(const uint4*)(o_nsa + (size_t)t * 512 + 8 * lane), c4 = *(const uint4*)(cbb + (size_t)t * 512 + 8 * lane), u2 = *(const uint4*)(ub + (size_t)t * 512 + 8 * lane);
        const uint4 u1 = sq >= 1 ? *(const uint4*)(ub + (size_t)(t - 1) * 512 + 8 * lane) : zero, u0 = sq >= 2 ? *(const uint4*)(ub + (size_t)(t - 2) * 512 + 8 * lane) : zero;
        const unsigned onw[4] = {on4.x, on4.y, on4.z, on4.w}, cbw[4] = {c4.x, c4.y, c4.z, c4.w}, u0w[4] = {u0.x, u0.y, u0.z, u0.w}, u1w[4] = {u1.x, u1.y, u1.z, u1.w}, u2w[4] = {u2.x, u2.y, u2.z, u2.w};
        float on[8], oc[8], ssn = 0.f, ssc = 0.f;
#pragma unroll
        for (int q = 0; q < 4; ++q) {
            on[2 * q] = blo(onw[q]); on[2 * q + 1] = bhi(onw[q]);
            const float y0 = cw[0][2 * q] * blo(u0w[q]) + cw[1][2 * q] * blo(u1w[q]) + cw[2][2 * q] * blo(u2w[q]);
            const float y1 = cw[0][2 * q + 1] * bhi(u0w[q]) + cw[1][2 * q + 1] * bhi(u1w[q]) + cw[2][2 * q + 1] * bhi(u2w[q]);
            oc[2 * q] = blo(cbw[q]) * y0; oc[2 * q + 1] = bhi(cbw[q]) * y1;
        }
#pragma unroll
        for (int j = 0; j < 8; ++j) { ssn += on[j] * on[j]; ssc += oc[j] * oc[j]; }
        ssn = wave_sum(ssn); ssc = wave_sum(ssc);
        const float rn = rsqrtf(ssn * (1.f / 512.f) + 1e-5f), rc = rsqrtf(ssc * (1.f / 512.f) + 1e-5f);
        uint4 o1, o2;
        o1.x = cvt_pk_bf16(on[0] * rn * gn[0], on[1] * rn * gn[1]); o1.y = cvt_pk_bf16(on[2] * rn * gn[2], on[3] * rn * gn[3]); o1.z = cvt_pk_bf16(on[4] * rn * gn[4], on[5] * rn * gn[5]); o1.w = cvt_pk_bf16(on[6] * rn * gn[6], on[7] * rn * gn[7]);
        o2.x = cvt_pk_bf16(oc[0] * rc * gc[0], oc[1] * rc * gc[1]); o2.y = cvt_pk_bf16(oc[2] * rc * gc[2], oc[3] * rc * gc[3]); o2.z = cvt_pk_bf16(oc[4] * rc * gc[4], oc[5] * rc * gc[5]); o2.w = cvt_pk_bf16(oc[6] * rc * gc[6], oc[7] * rc * gc[7]);
        *(uint4*)(omix + (size_t)t * 1024 + 8 * lane) = o1; *(uint4*)(omix + (size_t)t * 1024 + 512 + 8 * lane) = o2;
    }
}

__device__ __forceinline__ void xreduce32(float (&acc)[32], int lane) {
    const bool b3 = lane & 8, b2 = lane & 4, b1 = lane & 2;
#pragma unroll
    for (int e = 0; e < 16; ++e) { const auto r = __builtin_amdgcn_permlane32_swap(__float_as_uint(acc[e]), __float_as_uint(acc[e + 16]), false, false); acc[e] = __uint_as_float(r[0]) + __uint_as_float(r[1]); }
#pragma unroll
    for (int e = 0; e < 8; ++e) { const auto r = __builtin_amdgcn_permlane16_swap(__float_as_uint(acc[e]), __float_as_uint(acc[e + 8]), false, false); acc[e] = __uint_as_float(r[0]) + __uint_as_float(r[1]); }
#pragma unroll
    for (int e = 0; e < 4; ++e) { const float snd = b3 ? acc[e] : acc[e + 4], kp = b3 ? acc[e + 4] : acc[e]; acc[e] = kp + dpp_xor8(snd); }
#pragma unroll
    for (int e = 0; e < 2; ++e) { const float snd = b2 ? acc[e] : acc[e + 2], kp = b2 ? acc[e + 2] : acc[e]; acc[e] = kp + dpp_xor4(snd); }
    { const float snd = b1 ? acc[0] : acc[1], kp = b1 ? acc[1] : acc[0]; acc[0] = kp + dpp_xor2(snd); }
    acc[0] += dpp_xor1(acc[0]);
}
__device__ __forceinline__ void route_token(float logit, int t, int lane, int* __restrict__ a_e, float* __restrict__ a_w, int* __restrict__ a_slot, int* lcnt) {
    const int e = lane >> 1;
    int rank = 0;
#pragma unroll
    for (int i = 0; i < 32; ++i) { const float x = __int_as_float(__builtin_amdgcn_readlane(__float_as_int(logit), 2 * i)); rank += (x > logit || (x == logit && i < e)) ? 1 : 0; }
    const float vmax = wave_max(logit);
    const bool sel = (rank < TOPK) && !(lane & 1);
    const float ex = sel ? __expf(logit - vmax) : 0.f;
    const float sum = wave_sum(ex);
    if (sel) { const int a = t * TOPK + rank; a_e[a] = e; a_w[a] = ex / sum; a_slot[a] = atomicAdd(&lcnt[e], 1); }
}
constexpr int WR_STRIDE = 1028;
__device__ __forceinline__ void norm_router(char* lds, const bf16_t* __restrict__ h2, const float* __restrict__ g, const float* __restrict__ wr, const float* __restrict__ br, unsigned char* __restrict__ xn8,
                                            int* __restrict__ a_e, float* __restrict__ a_w, int* __restrict__ a_slot, int* __restrict__ wgcnt  , int gw, int nw, int lane) {
    float* Ws = (float*)lds;
    int* lcnt = (int*)(lds + NE * WR_STRIDE * 4);
    __syncthreads();
    for (int idx = threadIdx.x; idx < NE * WR_STRIDE / 4; idx += 512) ((uint4*)Ws)[idx] = ((const uint4*)wr)[idx];
    if (threadIdx.x < NE) lcnt[threadIdx.x] = 0;
    __syncthreads();
    float4 gv[4];
#pragma unroll
    for (int i = 0; i < 4; ++i) gv[i] = *(const float4*)(g + 256 * i + 4 * lane);
    const float bias = br[lane >> 1];
    for (int t0 = gw; t0 < T; t0 += 2 * nw) {
        const int t1 = t0 + nw; const bool two = t1 < T;
        float4 a[4], b[4];
#pragma unroll
        for (int i = 0; i < 4; ++i) {
            const uint2 ua = *(const uint2*)(h2 + (size_t)t0 * 1024 + 256 * i + 4 * lane), ub = two ? *(const uint2*)(h2 + (size_t)t1 * 1024 + 256 * i + 4 * lane) : make_uint2(0u, 0u);
            a[i] = make_float4(blo(ua.x), bhi(ua.x), blo(ua.y), bhi(ua.y)); b[i] = make_float4(blo(ub.x), bhi(ub.x), blo(ub.y), bhi(ub.y));
        }
        float sa = ssq4(a[0]) + ssq4(a[1]) + ssq4(a[2]) + ssq4(a[3]), sb = ssq4(b[0]) + ssq4(b[1]) + ssq4(b[2]) + ssq4(b[3]);
        sa = wave_sum(sa); sb = wave_sum(sb);
        const float ra = rsqrtf(sa * (1.f / 1024.f) + 1e-5f), rb = rsqrtf(sb * (1.f / 1024.f) + 1e-5f);
#pragma unroll
        for (int i = 0; i < 4; ++i) {
            a[i].x *= ra; a[i].y *= ra; a[i].z *= ra; a[i].w *= ra;
            b[i].x *= rb; b[i].y *= rb; b[i].z *= rb; b[i].w *= rb;
            *(unsigned*)(xn8 + (size_t)t0 * 1024 + 256 * i + 4 * lane) = pg::pk4_fp8(a[i].x * gv[i].x, a[i].y * gv[i].y, a[i].z * gv[i].z, a[i].w * gv[i].w);
            if (two) *(unsigned*)(xn8 + (size_t)t1 * 1024 + 256 * i + 4 * lane) = pg::pk4_fp8(b[i].x * gv[i].x, b[i].y * gv[i].y, b[i].z * gv[i].z, b[i].w * gv[i].w);
        }
        float accA[32], accB[32];
#pragma unroll
        for (int e = 0; e < 32; ++e) {
            float sA = 0.f, sB = 0.f;
#pragma unroll
            for (int i = 0; i < 4; ++i) {
                const float4 w = *(const float4*)(Ws + e * WR_STRIDE + 256 * i + 4 * lane);
                sA += a[i].x * w.x + a[i].y * w.y + a[i].z * w.z + a[i].w * w.w;
                sB += b[i].x * w.x + b[i].y * w.y + b[i].z * w.z + b[i].w * w.w;
            }
            accA[e] = sA; accB[e] = sB;
        }
        xreduce32(accA, lane); xreduce32(accB, lane);
        route_token(accA[0] + bias, t0, lane, a_e, a_w, a_slot, lcnt);
        if (two) route_token(accB[0] + bias, t1, lane, a_e, a_w, a_slot, lcnt);
    }
    __syncthreads();
    if (threadIdx.x < NE) wgcnt[blockIdx.x * NE + threadIdx.x] = lcnt[threadIdx.x];
}
__device__ __forceinline__ void moe_scatter(char* lds, const int* __restrict__ wgcnt, int* __restrict__ pstart, int* __restrict__ tile_e, const int* __restrict__ a_e, const float* __restrict__ a_w,
                                            const int* __restrict__ a_slot, int* __restrict__ tokmap, float* __restrict__ w_buf, int* __restrict__ dest_of, int wg, int gw, int nw, int lane) {
    int* ps = (int*)lds;
    int* wb = ps + 64;
    int* part = ps + 128;
    __syncthreads();
    {
        const int e = threadIdx.x & 31, q = threadIdx.x >> 5, nwg_ = gridDim.x;
        int tot = 0, below = 0;
        const int per = (nwg_ + 15) / 16;
        for (int w = q * per; w < (q + 1) * per && w < nwg_; ++w) { const int c = wgcnt[w * NE + e]; tot += c; below += (w < wg) ? c : 0; }
        part[(q * NE + e) * 2] = tot; part[(q * NE + e) * 2 + 1] = below;
    }
    __syncthreads();
    if (threadIdx.x < NE) { int tot = 0, below = 0; for (int q = 0; q < 16; ++q) { tot += part[(q * NE + threadIdx.x) * 2]; below += part[(q * NE + threadIdx.x) * 2 + 1]; } ps[96 + threadIdx.x] = tot; wb[threadIdx.x] = below; }
    __syncthreads();
    if (threadIdx.x == 0) { int acc = 0; for (int e = 0; e < NE; ++e) { ps[e] = acc; acc += (ps[96 + e] + MT - 1) / MT * MT; } ps[NE] = acc; }
    __syncthreads();
    if (wg == 0) {
        if (threadIdx.x == 0) pstart[NE] = ps[NE] / MT;
        for (int tl_ = threadIdx.x; tl_ < NTILE; tl_ += 512) { const int r = tl_ * MT; int e = -1; for (int i = 0; i < NE; ++i) if (r >= ps[i] && r < ps[i + 1]) e = i; tile_e[tl_] = e; }
    }
    for (int t = gw; t < T; t += nw) {
        const int4 e4 = *(const int4*)(a_e + 4 * t), s4 = *(const int4*)(a_slot + 4 * t); const float4 w4 = *(const float4*)(a_w + 4 * t);
        const int ee[4] = {e4.x, e4.y, e4.z, e4.w}, sl[4] = {s4.x, s4.y, s4.z, s4.w}; const float ww[4] = {w4.x, w4.y, w4.z, w4.w};
#pragma unroll
        for (int k = 0; k < 4; ++k) {
            const int dest = ps[ee[k]] + wb[ee[k]] + sl[k];
            if (lane == 0) { w_buf[dest] = ww[k]; dest_of[4 * t + k] = dest; tokmap[dest] = t; }
        }
    }
}
__device__ __forceinline__ void final_rows(const bf16_t* __restrict__ h2, const unsigned char* __restrict__ out_a, const int* __restrict__ dest_of, const float* __restrict__ g, float* __restrict__ out, int gw, int nw, int lane) {
    float4 gv[4];
#pragma unroll
    for (int i = 0; i < 4; ++i) gv[i] = *(const float4*)(g + 256 * i + 4 * lane);
    for (int t = gw; t < T; t += nw) {
        const int4 d4 = *(const int4*)(dest_of + 4 * t);
        const int dd[4] = {d4.x, d4.y, d4.z, d4.w};
        uint2 hh[4]; unsigned oa[4][4];
#pragma unroll
        for (int i = 0; i < 4; ++i) hh[i] = *(const uint2*)(h2 + (size_t)t * 1024 + 256 * i + 4 * lane);
#pragma unroll
        for (int k = 0; k < 4; ++k)
#pragma unroll
            for (int i = 0; i < 4; ++i) oa[k][i] = *(const unsigned*)(out_a + (size_t)dd[k] * 1024 + 256 * i + 4 * lane);
        float4 a[4];
        float ss = 0.f;
#pragma unroll
        for (int i = 0; i < 4; ++i) {
            float s0 = 0.f, s1 = 0.f, s2 = 0.f, s3 = 0.f;
#pragma unroll
            for (int k = 0; k < 4; ++k) {
                const auto lo = __builtin_amdgcn_cvt_pk_f32_fp8(oa[k][i], false), hi = __builtin_amdgcn_cvt_pk_f32_fp8(oa[k][i], true);
                s0 += lo[0]; s1 += lo[1]; s2 += hi[0]; s3 += hi[1];
            }
            a[i] = make_float4(blo(hh[i].x) + 0.125f * s0, bhi(hh[i].x) + 0.125f * s1, blo(hh[i].y) + 0.125f * s2, bhi(hh[i].y) + 0.125f * s3);
            ss += ssq4(a[i]);
        }
        ss = wave_sum(ss);
        const float rs = rsqrtf(ss * (1.f / 1024.f) + 1e-5f);
#pragma unroll
        for (int i = 0; i < 4; ++i) *(float4*)(out + (size_t)t * 1024 + 256 * i + 4 * lane) = make_float4(a[i].x * rs * gv[i].x, a[i].y * rs * gv[i].y, a[i].z * rs * gv[i].z, a[i].w * rs * gv[i].w);
    }
}
}

template <bool PERM64, class RowMap>
__device__ __forceinline__ void p_convT(char* lds, const float* __restrict__ W, int K, int N, int nmat, pg::bf16_t* __restrict__ Bt, int nrows_out, RowMap rowmap, int wg, int nwg, const float* __restrict__ kscale = nullptr) {
    uint2* Ls = (uint2*)lds;
    const int tid = opaque_tid();
    const int tk = K / 128, tn = nrows_out / 128, per = tk * tn, total = per * nmat;
    float4 x[2][4];
    auto issue = [&](int tile) {
        const int mat = tile / per, r = tile % per, jn = r / tk, jk = r % tk;
#pragma unroll
        for (int j = 0; j < 2; ++j) {
            const int bid = tid + 512 * j, kb = bid >> 5, n4 = (bid & 31) * 4;
            const int n0 = rowmap(jn * 128 + (n4 & 64));
            const float* src = W + (size_t)mat * K * N + (size_t)(jk * 128 + 4 * kb) * N + n0 + (n4 & 63);
            const bool ok = n0 >= 0 && n0 + (n4 & 63) < N;
#pragma unroll
            for (int rr = 0; rr < 4; ++rr) x[j][rr] = ok ? *(const float4*)(src + (size_t)rr * N) : make_float4(0.f, 0.f, 0.f, 0.f);
        }
    };
    int tile = wg;
    if (tile < total) issue(tile);
    while (tile < total) {
        const int mat = tile / per, r = tile % per, jn = r / tk, jk = r % tk;
        __syncthreads();
#pragma unroll
        for (int j = 0; j < 2; ++j) {
            const int bid = tid + 512 * j, kb = bid >> 5, n4 = (bid & 31) * 4;
            float ks[4];
#pragma unroll
            for (int rr = 0; rr < 4; ++rr) ks[rr] = kscale ? kscale[jk * 128 + 4 * kb + rr] : 1.f;
            uint4 d0, d1;
            d0.x = pg::cvt_pk_bf16(x[j][0].x * ks[0], x[j][1].x * ks[1]); d0.y = pg::cvt_pk_bf16(x[j][2].x * ks[2], x[j][3].x * ks[3]);
            d0.z = pg::cvt_pk_bf16(x[j][0].y * ks[0], x[j][1].y * ks[1]); d0.w = pg::cvt_pk_bf16(x[j][2].y * ks[2], x[j][3].y * ks[3]);
            d1.x = pg::cvt_pk_bf16(x[j][0].z * ks[0], x[j][1].z * ks[1]); d1.y = pg::cvt_pk_bf16(x[j][2].z * ks[2], x[j][3].z * ks[3]);
            d1.z = pg::cvt_pk_bf16(x[j][0].w * ks[0], x[j][1].w * ks[1]); d1.w = pg::cvt_pk_bf16(x[j][2].w * ks[2], x[j][3].w * ks[3]);
            *(uint4*)(Ls + kb * 130 + n4) = d0; *(uint4*)(Ls + kb * 130 + n4 + 2) = d1;
        }
        const int nxt = tile + nwg;
        if (nxt < total) issue(nxt);
        __syncthreads();
#pragma unroll
        for (int i = 0; i < 4; ++i) {
            const int c = tid + 512 * i, n = c >> 4, kc = c & 15;
            const int ns = PERM64 ? ((n & 64) | (n & 15) | ((n & 16) << 1) | ((n & 32) >> 1)) : n;
            const uint2 lo = Ls[(2 * kc) * 130 + ns], hi = Ls[(2 * kc + 1) * 130 + ns];
            *(uint4*)(Bt + ((size_t)mat * nrows_out + jn * 128 + n) * K + jk * 128 + 8 * kc) = make_uint4(lo.x, lo.y, hi.x, hi.y);
        }
        tile = nxt;
    }
}

template <class RowMap>
__device__ __forceinline__ void p_convT8(char* lds, const float* __restrict__ W, int K, int N, int nmat, unsigned char* __restrict__ Bt, int nrows_out, RowMap rowmap, int wg, int nwg, const float* __restrict__ kscale = nullptr) {
    unsigned* Ls = (unsigned*)lds;
    const int tid = opaque_tid();
    const int tk = K / 128, tn = nrows_out / 128, per = tk * tn, total = per * nmat;
    float4 x[2][4];
    auto issue = [&](int tile) {
        const int mat = tile / per, r = tile % per, jn = r / tk, jk = r % tk;
#pragma unroll
        for (int j = 0; j < 2; ++j) {
            const int bid = tid + 512 * j, kb = bid >> 5, n4 = (bid & 31) * 4;
            const int n0 = rowmap(jn * 128 + (n4 & 64));
            const float* src = W + (size_t)mat * K * N + (size_t)(jk * 128 + 4 * kb) * N + n0 + (n4 & 63);
            const bool ok = n0 >= 0 && n0 + (n4 & 63) < N;
#pragma unroll
            for (int rr = 0; rr < 4; ++rr) x[j][rr] = ok ? *(const float4*)(src + (size_t)rr * N) : make_float4(0.f, 0.f, 0.f, 0.f);
        }
    };
    int tile = wg;
    if (tile < total) issue(tile);
    while (tile < total) {
        const int mat = tile / per, r = tile % per, jn = r / tk, jk = r % tk;
        __syncthreads();
#pragma unroll
        for (int j = 0; j < 2; ++j) {
            const int bid = tid + 512 * j, kb = bid >> 5, n4 = (bid & 31) * 4;
            float ks[4];
#pragma unroll
            for (int rr = 0; rr < 4; ++rr) ks[rr] = pg::W8_SCALE * (kscale ? kscale[jk * 128 + 4 * kb + rr] : 1.f);
            uint4 d;
            d.x = pg::pk4_fp8(x[j][0].x * ks[0], x[j][1].x * ks[1], x[j][2].x * ks[2], x[j][3].x * ks[3]);
            d.y = pg::pk4_fp8(x[j][0].y * ks[0], x[j][1].y * ks[1], x[j][2].y * ks[2], x[j][3].y * ks[3]);
            d.z = pg::pk4_fp8(x[j][0].z * ks[0], x[j][1].z * ks[1], x[j][2].z * ks[2], x[j][3].z * ks[3]);
            d.w = pg::pk4_fp8(x[j][0].w * ks[0], x[j][1].w * ks[1], x[j][2].w * ks[2], x[j][3].w * ks[3]);
            *(uint4*)(Ls + kb * 132 + n4) = d;
        }
        const int nxt = tile + nwg;
        if (nxt < total) issue(nxt);
        __syncthreads();
#pragma unroll
        for (int i = 0; i < 2; ++i) {
            const int c = tid + 512 * i, n = c >> 3, kc = c & 7;
            uint4 y; y.x = Ls[(4 * kc + 0) * 132 + n]; y.y = Ls[(4 * kc + 1) * 132 + n]; y.z = Ls[(4 * kc + 2) * 132 + n]; y.w = Ls[(4 * kc + 3) * 132 + n];
            *(uint4*)(Bt + ((size_t)mat * nrows_out + jn * 128 + n) * K + jk * 128 + 16 * kc) = y;
        }
        tile = nxt;
    }
}

struct Params {
    const float *x, *mem; const int* positions;
    const float *g_mix_norm, *w_mix_in, *cmp_pos_k, *cmp_pos_v, *cmp_w1_k, *cmp_b1_k, *cmp_w2_k, *cmp_w1_v, *cmp_b1_v, *cmp_w2_v, *conv_w, *g_nsa_out, *g_conv_out, *w_mix_out,
        *g_xattn_norm, *g_mem_norm, *w_xq, *w_xkv, *w_xo, *g_moe_norm, *w_router, *b_router, *w_gate_up, *b_gate_up, *w_down, *b_down, *g_final;
    float* out;
    unsigned* bar; unsigned* queue;
    int *wgcnt, *counts, *pstart, *tile_e, *a_e, *a_slot, *dest_of, *tok_buf;
    float *a_w, *w_buf;
    unsigned* selmask;
    float *hid_k, *hid_v, *kc, *vc, *memn, *xkv, *hbuf, *xn, *o_cmp, *o_slc, *o_win, *xq, *proj, *xo;
    unsigned short *hmid, *out_a, *xg, *wt_gu, *wt_dn; unsigned char *hmid8, *wt_dn8, *wt_gu8, *xg8, *xn8, *out_a8, *h1_8, *xo8, *wt_xq8, *wt_xo8; unsigned short* h1_bf; float* ssq; float* wrt;
    unsigned short *q_bf, *kcmp, *vcmp, *kslc, *vslcT, *kwin, *vwinT, *u_bf, *cb_bf; float *gates, *cosT, *sinT;
    unsigned short *xq_bf, *xk_bf, *xvT_bf, *ocmp_bf, *owin_bf, *onsa_bf;
    unsigned short *wt_c1k, *wt_c1v, *kc_bf, *vcT_bf; float *Pab_k, *Pab_v, *b1p_k, *b1p_v;
    unsigned short *xn_bf, *memn_bf, *xo_bf, *wt_mix_in, *wt_xkv, *wt_mix_out, *wt_xq, *wt_xo;
};

__global__ void __launch_bounds__(512, 2) mega_fwd(Params p) {
    extern __shared__ __attribute__((aligned(16))) char lds[];
    if (threadIdx.x < 4) ((unsigned*)lds)[threadIdx.x] = 0u;
    __syncthreads();
    XcdBarrier bar = xcd_barrier_post(p.bar, (volatile LAS unsigned*)lds);
    LAS unsigned char* glds = (LAS unsigned char*)(lds + 1024);

    {
        const int wg = blockIdx.x, nwg = gridDim.x;
        auto ident = [](int j) { return j; };
        auto mixmap = [](int j) {
            const int unit = j >> 8, blk = (j & 255) >> 6;
            if (unit < 2) return C_Q + unit * 256 + blk * 64;
            if (unit == 2) return blk < 2 ? C_KC + blk * 64 : C_VC + (blk - 2) * 64;
            if (unit == 3) return blk < 2 ? C_KS + blk * 64 : C_VS + (blk - 2) * 64;
            if (unit == 4) return blk < 2 ? C_KW + blk * 64 : C_VW + (blk - 2) * 64;
            if (unit < 9) return blk < 2 ? C_CH + (unit - 5) * 128 + blk * 64 : C_CC + (unit - 5) * 128 + (blk - 2) * 64;
            if (unit < 11) return C_CB + (unit - 9) * 256 + blk * 64;
            return blk == 0 ? C_GL : -1;
        };
        p_convT<true>(lds + 1024, p.w_mix_in, D, INC, 1, p.wt_mix_in, 3072, mixmap, wg, nwg);
        p_convT<false>(lds + 1024, p.w_xkv, D, 2048, 1, p.wt_xkv, 2048, ident, wg, nwg);
        p_convT<false>(lds + 1024, p.w_mix_out, D, D, 1, p.wt_mix_out, D, ident, wg, nwg);
        p_convT8(lds + 1024, p.w_xq, D, D, 1, p.wt_xq8, D, ident, wg, nwg, p.g_xattn_norm);
        p_convT8(lds + 1024, p.w_xo, D, D, 1, p.wt_xo8, D, ident, wg, nwg);
        auto gumap = [](int j) { const int blk = j >> 8, w = j & 255; return w < 128 ? 128 * blk + w : 1024 + 128 * blk + (w - 128); };
        p_convT8(lds + 1024, p.w_gate_up, D, 2048, NE, p.wt_gu8, 2048, gumap, wg, nwg);
        p_convT8(lds + 1024, p.w_down, DFF, D, NE, p.wt_dn8, D, ident, wg, nwg);
        p_convT<false>(lds + 1024, p.cmp_w1_k, 1024, 256, 2, p.wt_c1k, 256, ident, wg, nwg);
        p_convT<false>(lds + 1024, p.cmp_w1_v, 1024, 256, 2, p.wt_c1v, 256, ident, wg, nwg);
        for (int o = wg * 8 + (threadIdx.x >> 6); o < 512; o += nwg * 8) {
            if (o < 256) posbias_wave(o, threadIdx.x & 63, p.cmp_pos_k, p.cmp_w1_k, p.cmp_b1_k, p.b1p_k); else posbias_wave(o - 256, threadIdx.x & 63, p.cmp_pos_v, p.cmp_w1_v, p.cmp_b1_v, p.b1p_v);
        }
        __syncthreads();
    }
    p_rope_table(blockIdx.x * 512 + threadIdx.x, gridDim.x * 512, p.positions, p.cosT, p.sinT);
    for (int i = blockIdx.x * 512 + threadIdx.x; i < PMAX; i += gridDim.x * 512) p.tok_buf[i] = 0;
    for (int idx = blockIdx.x * 512 + threadIdx.x; idx < 1024 * NE; idx += gridDim.x * 512) p.wrt[(idx & 31) * tl::WR_STRIDE + (idx >> 5)] = p.g_moe_norm[idx >> 5] * p.w_router[idx];
    tl::rmsnorm_rows(p.x, p.g_mix_norm, p.xn_bf, T, (int)(blockIdx.x * 8 + (opaque_tid() >> 6)), (int)(gridDim.x * 8), opaque_tid() & 63);
    tl::rmsnorm_rows(p.mem, p.g_mem_norm, p.memn_bf, NB * NMEM, (int)(blockIdx.x * 8 + (opaque_tid() >> 6)), (int)(gridDim.x * 8), opaque_tid() & 63);
    xcd_barrier(bar);
    {
        pg::DenseOrder So; So.init(p.xn_bf, p.wt_mix_in, T, 3072, 2048u, 2048u, (int)gridDim.x, (int)blockIdx.x);
        pg::EpiMixIn E{p.q_bf, p.kcmp, p.vslcT, p.u_bf, p.cb_bf, p.gates, p.cosT, p.sinT};
        pg::gemm_phase(glds, D, 2048u, 2048u, So, E);
    }
    xcd_barrier(bar);
    {
        volatile int* item_s = (volatile int*)(lds + 64);
        for (;;) {
            __syncthreads();
            if (threadIdx.x == 0) *item_s = (int)atomicAdd(p.queue, 1u);
            __syncthreads();
            const int item = __builtin_amdgcn_readfirstlane(*item_s);
            if (item >= 96 + 512) break;
            if (item < 64) {
                const int pm = item >> 3, pn = item & 7;
                pg::OneUnit So; So.u.A = (const char*)p.memn_bf + (size_t)pm * 256 * 2048; So.u.B = (const char*)p.wt_xkv + (size_t)pn * 256 * 2048; So.u.row0 = pm * 256; So.u.col0 = pn * 256; So.u.aux = 0;
                pg::EpiXkv E{p.xk_bf, p.xvT_bf};
                pg::gemm_phase(glds, D, 2048u, 2048u, So, E);
            } else if (item < 96) {
                const int which = (item - 64) >> 4, r = (item - 64) & 15, pm = r >> 1, pn = r & 1;
                pg::OneUnit So; So.u.A = (const char*)(which ? p.vcmp : p.kcmp) + (size_t)pm * 256 * 2048; So.u.B = (const char*)(which ? p.wt_c1v : p.wt_c1k) + (size_t)pn * 256 * 2048; So.u.row0 = pm * 256; So.u.col0 = pn * 256; So.u.aux = 0;
                pg::EpiF32R E{which ? p.Pab_v : p.Pab_k, 512, nullptr, 512};
                pg::gemm_phase(glds, 1024, 2048u, 2048u, So, E);
            } else {
                const int idx = item - 96, tq = 31 - (idx >> 4), bg = idx & 15;
                at::attn64_unit<1>(lds + 1024, bg >> 1, bg & 1, tq, p.q_bf, p.kwin, p.vwinT, p.selmask, p.owin_bf, nullptr, nullptr, nullptr);
            }
        }
    }
    xcd_barrier(bar);
    p_cmp_finalize(lds + 1024, p.Pab_k, p.Pab_v, p.b1p_k, p.b1p_v, p.cmp_w2_k, p.cmp_w2_v, p.kc_bf, p.vcT_bf, blockIdx.x, gridDim.x);
    xcd_barrier(bar);
    for (int item = blockIdx.x; item < 256; item += gridDim.x) {
        const int bg = item >> 4, j = item & 15;
        at::cmp_unit(lds + 1024, bg >> 1, bg & 1, 31 - j, p.q_bf, p.kc_bf, p.vcT_bf, p.ocmp_bf, p.selmask);
        at::cmp_unit(lds + 1024, bg >> 1, bg & 1, j, p.q_bf, p.kc_bf, p.vcT_bf, p.ocmp_bf, p.selmask);
        asm volatile("s_waitcnt vmcnt(0)" ::: "memory");
        __syncthreads();
        at::attn64_unit<0>(lds + 1024, bg >> 1, bg & 1, 31 - j, p.q_bf, p.kslc, p.vslcT, p.selmask, p.onsa_bf, p.ocmp_bf, p.owin_bf, p.gates);
        at::attn64_unit<0>(lds + 1024, bg >> 1, bg & 1, j, p.q_bf, p.kslc, p.vslcT, p.selmask, p.onsa_bf, p.ocmp_bf, p.owin_bf, p.gates);
    }
    xcd_barrier(bar);
    tl::mix_post(p.onsa_bf, p.u_bf, p.cb_bf, p.conv_w, p.g_nsa_out, p.g_conv_out, p.xn_bf  , (int)(blockIdx.x * 8 + (opaque_tid() >> 6)), (int)(gridDim.x * 8), opaque_tid() & 63);
    xcd_barrier(bar);
    {
        pg::DenseOrder So; So.init(p.xn_bf, p.wt_mix_out, T, D, 2048u, 2048u, (int)gridDim.x, (int)blockIdx.x);
        pg::EpiResNormStats E{p.x, p.h1_bf, p.ssq, p.h1_8};
        pg::gemm_phase(glds, D, 2048u, 2048u, So, E);
    }
    xcd_barrier(bar);
    {
        pg::DenseOrder So; So.init(p.h1_8, p.wt_xq8, T, D, 1024u, 1024u, (int)gridDim.x, (int)blockIdx.x);
        pg::EpiBf16RowScale E{p.xq_bf, p.ssq, 0.0625f * 1.4426950408889634f * pg::W8_INV};
        pg::gemm_phase_f8(glds, D, 1024u, 1024u, So, E);
        for (int L = blockIdx.x; L < (T / 256) * (D / 256); L += gridDim.x) {
            int pm, h; pg::dense_map(L, T / 256, D / 256, pm, h);
            const int b = pm >> 3, qt = (pm & 7) * 2;
            at::xattn_unit(lds + 1024, b, h, qt, p.xq_bf, p.xk_bf, p.xvT_bf, p.xo8);
            at::xattn_unit(lds + 1024, b, h, qt + 1, p.xq_bf, p.xk_bf, p.xvT_bf, p.xo8);
        }
    }
    xcd_barrier(bar);
    {
        pg::DenseOrder So; So.init(p.xo8, p.wt_xo8, T, D, 1024u, 1024u, (int)gridDim.x, (int)blockIdx.x);
        pg::EpiBf16Res E{p.h1_bf, pg::W8_INV * (1.f / 16.f)};
        pg::gemm_phase_f8(glds, D, 1024u, 1024u, So, E);
    }
    xcd_barrier(bar);
    tl::norm_router(lds + 1024, p.h1_bf, p.g_moe_norm, p.wrt, p.b_router, p.xn8, p.a_e, p.a_w, p.a_slot, p.wgcnt, (int)(blockIdx.x * 8 + (opaque_tid() >> 6)), (int)(gridDim.x * 8), opaque_tid() & 63);
    xcd_barrier(bar);
    tl::moe_scatter(lds + 1024, p.wgcnt, p.pstart, p.tile_e, p.a_e, p.a_w, p.a_slot, p.tok_buf, p.w_buf, p.dest_of, blockIdx.x, (int)(blockIdx.x * 8 + (opaque_tid() >> 6)), (int)(gridDim.x * 8), opaque_tid() & 63);
    xcd_barrier(bar);
    {
        pg::MoeOrderB<8> So; So.init(p.xn8, p.wt_gu8, p.tile_e, p.pstart[NE], (size_t)2048 * 1024, 1024u, (int)gridDim.x, (int)blockIdx.x);
        pg::EpiSwigluF8 E{p.hmid8, p.b_gate_up};
        pg::gemm_phase_f8g(glds, D, 1024u, 1024u, So, E, (const char*)p.xn8, p.tok_buf);
    }
    xcd_barrier(bar);
    {
        pg::MoeOrderB<4> So; So.init(p.hmid8, p.wt_dn8, p.tile_e, p.pstart[NE], (size_t)1024 * 1024, 1024u, (int)gridDim.x, (int)blockIdx.x);
        pg::EpiDownScaleF8 E{p.out_a8, p.b_down, p.w_buf};
        pg::gemm_phase_f8(glds, DFF, 1024u, 1024u, So, E);
    }
    xcd_barrier(bar);
    tl::final_rows(p.h1_bf, p.out_a8, p.dest_of, p.g_final, p.out, (int)(blockIdx.x * 8 + (opaque_tid() >> 6)), (int)(gridDim.x * 8), opaque_tid() & 63);
}
__global__ void k_fail(float* out, int n) { const int i = blockIdx.x * 256 + threadIdx.x; if (i < n) out[i] = __builtin_nanf(""); }
}

extern "C" void kernel_launch(void* const* d_in, const int* in_sizes, int n_in, void* d_out, int out_size, void* d_ws, size_t ws_size, hipStream_t stream) {
    Params p{};
    p.x = (const float*)d_in[0]; p.mem = (const float*)d_in[1]; p.positions = (const int*)d_in[2];
    const float** fp = &p.g_mix_norm;
    for (int i = 0; i < 27; ++i) fp[i] = (const float*)d_in[3 + i];
    p.out = (float*)d_out;

    char* ws = (char*)d_ws;
    size_t off = 0;
    auto take = [&](size_t bytes) { char* q = ws + off; off += (bytes + 255) & ~(size_t)255; return q; };
    p.bar = (unsigned*)take(XCD_BAR_WORDS * 4);
    p.counts = (int*)take(NE * 4);
    p.queue = (unsigned*)take(256);
    const size_t zero_bytes = off;
    p.pstart = (int*)take((NE + 1) * 4);
    p.wgcnt = (int*)take(1024 * NE * 4);
    p.tile_e = (int*)take(NTILE * 4);
    p.a_e = (int*)take(NA * 4);
    p.a_w = (float*)take(NA * 4);
    p.a_slot = (int*)take(NA * 4);
    p.dest_of = (int*)take(NA * 4);
    p.w_buf = (float*)take(PMAX * 4);
    p.tok_buf = (int*)take(PMAX * 4);
    p.selmask = (unsigned*)take((size_t)NB * 2 * S * 4);
    p.out_a8 = (unsigned char*)take((size_t)PMAX * D);
    p.xn8 = (unsigned char*)take((size_t)T * D);
    p.h1_bf = (unsigned short*)take((size_t)T * D * 2);
    p.ssq = (float*)take((size_t)T * 16 * 4);
    p.wrt = (float*)take((size_t)NE * 1028 * 4);
    p.hmid8 = (unsigned char*)take((size_t)PMAX * DFF);
    p.wt_gu8 = (unsigned char*)take((size_t)NE * 2048 * D);
    p.wt_dn8 = (unsigned char*)take((size_t)NE * D * DFF);
    p.q_bf = (unsigned short*)take((size_t)T * 512 * 2);
    p.kcmp = (unsigned short*)take((size_t)T * 128 * 2 * 4); p.vcmp = p.kcmp + (size_t)T * 128; p.kslc = p.vcmp + (size_t)T * 128; p.kwin = p.kslc + (size_t)T * 128;
    p.vslcT = (unsigned short*)take((size_t)T * 128 * 2 * 2); p.vwinT = p.vslcT + (size_t)T * 128;
    p.u_bf = (unsigned short*)take((size_t)T * 512 * 2); p.cb_bf = (unsigned short*)take((size_t)T * 512 * 2);
    p.gates = (float*)take((size_t)T * 24 * 4); p.cosT = (float*)take((size_t)T * 32 * 4); p.sinT = (float*)take((size_t)T * 32 * 4);
    p.wt_c1k = (unsigned short*)take((size_t)512 * 1024 * 2); p.wt_c1v = (unsigned short*)take((size_t)512 * 1024 * 2);
    p.kc_bf = (unsigned short*)take((size_t)16 * 128 * 64 * 2); p.vcT_bf = (unsigned short*)take((size_t)16 * 64 * 128 * 2);
    p.Pab_k = (float*)take((size_t)(2048 + 1) * 512 * 4); p.Pab_v = (float*)take((size_t)(2048 + 1) * 512 * 4);
    p.b1p_k = (float*)take(256 * 4); p.b1p_v = (float*)take(256 * 4);
    p.ocmp_bf = (unsigned short*)take((size_t)T * 512 * 2); p.owin_bf = (unsigned short*)take((size_t)T * 512 * 2); p.onsa_bf = (unsigned short*)take((size_t)T * 512 * 2);
    p.xq_bf = (unsigned short*)take((size_t)T * D * 2); p.xk_bf = (unsigned short*)take((size_t)NB * NMEM * D * 2); p.xvT_bf = (unsigned short*)take((size_t)NB * NMEM * D * 2);
    p.xn_bf = (unsigned short*)take((size_t)T * D * 2);
    p.memn_bf = (unsigned short*)take((size_t)NB * NMEM * D * 2);
    p.xo8 = (unsigned char*)take((size_t)T * D);
    p.h1_8 = (unsigned char*)take((size_t)T * D);
    p.wt_mix_in = (unsigned short*)take((size_t)3072 * D * 2);
    p.wt_xkv = (unsigned short*)take((size_t)2048 * D * 2);
    p.wt_mix_out = (unsigned short*)take((size_t)D * D * 2);
    p.wt_xq8 = (unsigned char*)take((size_t)D * D);
    p.wt_xo8 = (unsigned char*)take((size_t)D * D);

    static int grid = 0;
    if (grid == 0) {
        int dev = 0, cus = 0;
        if (hipGetDevice(&dev) != hipSuccess || hipDeviceGetAttribute(&cus, hipDeviceAttributeMultiprocessorCount, dev) != hipSuccess) cus = -1;
        if (hipFuncSetAttribute((const void*)mega_fwd, hipFuncAttributeMaxDynamicSharedMemorySize, LDS_BYTES) != hipSuccess) cus = -1;
        int per_cu = 0;
        if (cus > 0 && (hipOccupancyMaxActiveBlocksPerMultiprocessor(&per_cu, (const void*)mega_fwd, 512, LDS_BYTES) != hipSuccess || per_cu < 1)) cus = -1;
        (void)hipGetLastError();
        grid = cus > 0 ? cus : -1;
    }
    if (grid < 0 || off > ws_size) { k_fail<<<(out_size + 255) / 256, 256, 0, stream>>>((float*)d_out, out_size); return; }
    (void)hipMemsetAsync(d_ws, 0, zero_bytes, stream);
    hipLaunchKernelGGL(mega_fwd, dim3(grid), dim3(512), LDS_BYTES, stream, p);
}
```

```cpp
#include <hip/hip_runtime.h>
#include <hip/hip_bf16.h>
#include <stdint.h>
#include <cstdio>

#define XB_TMO      128
#define XB_XCNT(j)  (256  + 64 * (j))
#define XB_XSUB(j)  (1280 + 64 * (j))
#define XB_XGEN(j)  (2304 + 64 * (j))
#define XB_TOP      3328
#define XB_TOPGEN   3392
#define XCD_BAR_WORDS 3456
#define XB_SPIN_CAP (1u << 18)
#define LAS __attribute__((address_space(3)))

__device__ __forceinline__ unsigned xb_ld(unsigned* p)              { return __hip_atomic_load(p, __ATOMIC_RELAXED, __HIP_MEMORY_SCOPE_AGENT); }
__device__ __forceinline__ unsigned xb_add(unsigned* p, unsigned v) { return __hip_atomic_fetch_add(p, v, __ATOMIC_RELAXED, __HIP_MEMORY_SCOPE_AGENT); }
__device__ __forceinline__ unsigned xb_xcc_id() { return (unsigned)__builtin_amdgcn_s_getreg((3 << 11) | 20) & 0xFu; }
#define XB_SPIN(cond, bar) do { unsigned _sp = 0; while (cond) { __builtin_amdgcn_s_sleep(1); \
    if ((++_sp & 255u) == 0u) { if (xb_ld(&(bar)[XB_TMO])) break; if (_sp > XB_SPIN_CAP) { atomicAdd(&(bar)[XB_TMO], 1u); break; } } } } while (0)

struct XcdBarrier {
    unsigned* bar; unsigned x;
    volatile LAS unsigned* st;
};

__device__ __forceinline__ XcdBarrier xcd_barrier_post(unsigned* bar, volatile LAS unsigned* st) {
    XcdBarrier b; b.bar = bar; b.x = xb_xcc_id(); b.st = st;
    if (threadIdx.x == 0) (void)xb_add(&bar[XB_XCNT(b.x)], 1u);
    return b;
}
__device__ __forceinline__ void xcd_barrier_complete(unsigned* bar, unsigned x, unsigned& nloc, unsigned& nx) {
    const unsigned G = gridDim.x * gridDim.y * gridDim.z;
    unsigned sum, cnt, mine, sp = 0u;
    for (;;) {
        sum = 0u; cnt = 0u; mine = 0u;
#pragma unroll
        for (unsigned j = 0; j < 16; ++j) { const unsigned c = xb_ld(&bar[XB_XCNT(j)]); sum += c; cnt += (c > 0u) ? 1u : 0u; mine = (j == x) ? c : mine; }
        if (sum == G) break;
        __builtin_amdgcn_s_sleep(1);
        if ((++sp & 255u) == 0u) { if (xb_ld(&bar[XB_TMO])) break; if (sp > XB_SPIN_CAP) { atomicAdd(&bar[XB_TMO], 1u); break; } }
    }
    nloc = mine > 0u ? mine : 1u; nx = cnt > 0u ? cnt : 1u;
}

__device__ __forceinline__ void xcd_barrier(const XcdBarrier& b) {
    asm volatile("s_waitcnt vmcnt(0)" ::: "memory");
    __syncthreads();
    if (threadIdx.x == 0) {
        unsigned* bar = b.bar;
        __builtin_amdgcn_s_waitcnt(0);
        unsigned nloc = b.st[0], nx = b.st[1];
        if (nloc == 0u) { xcd_barrier_complete(bar, b.x, nloc, nx); b.st[0] = nloc; b.st[1] = nx; }
        const unsigned old = xb_add(&bar[XB_XSUB(b.x)], 1u);
        const unsigned gen = old / nloc;
        if (old + 1u == (gen + 1u) * nloc) {
            __builtin_amdgcn_fence(__ATOMIC_RELEASE, "agent");
            asm volatile("s_waitcnt vmcnt(0)" ::: "memory");
            const unsigned og = xb_add(&bar[XB_TOP], 1u);
            const unsigned tg = og / nx;
            if (og + 1u == (tg + 1u) * nx) xb_add(&bar[XB_TOPGEN], 1u);
            else XB_SPIN(xb_ld(&bar[XB_TOPGEN]) == tg, bar);
            __builtin_amdgcn_fence(__ATOMIC_ACQUIRE, "agent");
            xb_add(&bar[XB_XGEN(b.x)], 1u);
            asm volatile("s_waitcnt vmcnt(0)" ::: "memory");
        } else {
            XB_SPIN(xb_ld(&bar[XB_XGEN(b.x)]) == gen, bar);
            __builtin_amdgcn_fence(__ATOMIC_ACQUIRE, "agent");
            asm volatile("s_waitcnt vmcnt(0)" ::: "memory");
        }
    }
    __syncthreads();
}


namespace {
constexpr int D = 1024, NB = 8, S = 2048, T = NB * S, NMEM = 256;
constexpr int INC = 2840;
constexpr int C_Q = 0, C_KC = 512, C_VC = 640, C_KS = 768, C_VS = 896, C_KW = 1024, C_VW = 1152, C_GL = 1280, C_CH = 1304, C_CB = 1816, C_CC = 2328;
constexpr int NC = 127, NCR = NB * NC * 2;
constexpr int NE = 32, TOPK = 4, DFF = 1024, NA = T * TOPK;
constexpr int MT = 256;
constexpr int PMAX = NA + NE * MT, NTILE = PMAX / MT;
constexpr int LDS_BYTES = 144 * 1024, VB_LDS = 40960;
constexpr float QS = 0.125f * 1.4426950408889634f;

__device__ __forceinline__ int opaque_tid() { int t = threadIdx.x; asm volatile("" : "+v"(t)); return t; }
__device__ __forceinline__ float dpp_xor8(float v) { return __uint_as_float(__builtin_amdgcn_update_dpp(0u, __float_as_uint(v), 0x128, 0xf, 0xf, true)); }
__device__ __forceinline__ float dpp_xor4(float v) { unsigned r = __builtin_amdgcn_update_dpp(__float_as_uint(v), __float_as_uint(v), 0x104, 0xf, 0x5, false); r = __builtin_amdgcn_update_dpp(r, __float_as_uint(v), 0x114, 0xf, 0xa, false); return __uint_as_float(r); }
__device__ __forceinline__ float dpp_xor2(float v) { return __uint_as_float(__builtin_amdgcn_update_dpp(0u, __float_as_uint(v), 0x4e, 0xf, 0xf, true)); }
__device__ __forceinline__ float dpp_xor1(float v) { return __uint_as_float(__builtin_amdgcn_update_dpp(0u, __float_as_uint(v), 0xb1, 0xf, 0xf, true)); }

__device__ __forceinline__ float lane_xor32(float v) { const auto r = __builtin_amdgcn_permlane32_swap(__float_as_uint(v), __float_as_uint(v), false, false); return __uint_as_float((threadIdx.x & 32) ? r[0] : r[1]); }
__device__ __forceinline__ float lane_xor16(float v) { const auto r = __builtin_amdgcn_permlane16_swap(__float_as_uint(v), __float_as_uint(v), false, false); return __uint_as_float((threadIdx.x & 16) ? r[0] : r[1]); }
__device__ __forceinline__ float wave_sum(float v) {
    { const auto r = __builtin_amdgcn_permlane32_swap(__float_as_uint(v), __float_as_uint(v), false, false); v = __uint_as_float(r[0]) + __uint_as_float(r[1]); }
    { const auto r = __builtin_amdgcn_permlane16_swap(__float_as_uint(v), __float_as_uint(v), false, false); v = __uint_as_float(r[0]) + __uint_as_float(r[1]); }
    v += dpp_xor8(v); v += dpp_xor4(v); v += dpp_xor2(v); v += dpp_xor1(v); return v;
}
__device__ __forceinline__ float wave_max(float v) {
    { const auto r = __builtin_amdgcn_permlane32_swap(__float_as_uint(v), __float_as_uint(v), false, false); v = fmaxf(__uint_as_float(r[0]), __uint_as_float(r[1])); }
    { const auto r = __builtin_amdgcn_permlane16_swap(__float_as_uint(v), __float_as_uint(v), false, false); v = fmaxf(__uint_as_float(r[0]), __uint_as_float(r[1])); }
    v = fmaxf(v, dpp_xor8(v)); v = fmaxf(v, dpp_xor4(v)); v = fmaxf(v, dpp_xor2(v)); v = fmaxf(v, dpp_xor1(v)); return v;
}

namespace pg { __device__ __forceinline__ unsigned cvt_pk_bf16(float lo, float hi); __device__ __forceinline__ unsigned cvt_pk_bf16_acc(float lo, float hi); }
struct VB { int vb, nvb, tid; char* lds; };
#define VB_ITEMS(n) for (int _it = 0, item = v.vb; _it < ((n) + v.nvb - 1) / v.nvb; ++_it, item += v.nvb)


__device__ __forceinline__ unsigned short f2bf_rne(float f) { unsigned u = __float_as_uint(f); u += 0x7FFFu + ((u >> 16) & 1u); return (unsigned short)(u >> 16); }


__device__ __forceinline__ float gelu_tanh(float x) { const float u = 0.7978845608028654f * (x + 0.044715f * x * x * x); return 0.5f * x * (1.f + tanhf(u)); }

__device__ __forceinline__ void st_out(float* p, float x) { *p = x; }
__device__ __forceinline__ void st_out(unsigned short* p, float x) { *p = f2bf_rne(x); }


typedef _Float16 h2_t __attribute__((ext_vector_type(2)));
__device__ __forceinline__ void p_rope_table(int gtid, int gn, const int* __restrict__ pos, unsigned* __restrict__ csT) {
    const bool fixed_f = (gn & 31) == 0;
    float inv0 = powf(10000.f, -(float)(gtid & 31) / 32.f);
    for (int i = gtid; i < T * 32; i += gn) {
        const int t = i >> 5, f = i & 31;
        const float inv = fixed_f ? inv0 : powf(10000.f, -(float)f / 32.f);
        const float ang = (float)pos[t] * inv;
        float sn, cs; sincosf(ang, &sn, &cs);
        const h2_t hv = {(_Float16)cs, (_Float16)sn};
        csT[i] = __builtin_bit_cast(unsigned, hv);
    }
}


namespace pg {
typedef unsigned short bf16_t;
typedef short bf16x8 __attribute__((ext_vector_type(8)));
typedef float f32x4 __attribute__((ext_vector_type(4)));
constexpr int BM = 256, BK = 64, HALF = 128, HTB = HALF * BK * 2, STAGE_BYTES = 8 * HTB;
__device__ __forceinline__ int lds_byte(int r, int c) { const int st = (r >> 4) * 2 + (c >> 5), rr = r & 15, cc = c & 31, ob = rr * 64 + cc * 2; return st * 1024 + (ob ^ (((ob >> 9) & 1) << 5)); }
__device__ __forceinline__ void stage_rc(int b, int& R, int& C) { const int st = b / 1024, sb = b % 1024, swz = sb ^ (((sb >> 9) & 1) << 5); R = (st >> 1) * 16 + swz / 64; C = (st & 1) * 32 + (swz % 64) / 2; }
typedef float f32x2_t __attribute__((ext_vector_type(2)));
typedef __bf16 bf16x2_t __attribute__((ext_vector_type(2)));
__device__ __forceinline__ unsigned cvt_pk_bf16_acc(float lo, float hi) { const f32x2_t v = {lo, hi}; const bf16x2_t b = __builtin_convertvector(v, bf16x2_t); return __builtin_bit_cast(unsigned, b); }
__device__ __forceinline__ unsigned cvt_pk_bf16(float lo, float hi) { unsigned r; asm volatile("v_cvt_pk_bf16_f32 %0, %1, %2" : "=v"(r) : "v"(lo), "v"(hi)); return r; }
__device__ __forceinline__ bf16_t f2bf(float f) { unsigned u = __float_as_uint(f); u += 0x7FFFu + ((u >> 16) & 1u); return (bf16_t)(u >> 16); }

__device__ __forceinline__ unsigned pk4_fp8(float a, float b, float c, float d);
__device__ __forceinline__ uint4 pair16(uint2 a, uint2 b) {
    const auto rx = __builtin_amdgcn_permlane16_swap(a.x, b.x, false, false);
    const auto ry = __builtin_amdgcn_permlane16_swap(a.y, b.y, false, false);
    return make_uint4(rx[0], ry[0], rx[1], ry[1]);
}
__device__ __forceinline__ int pair16_col(int fq) { return (fq & 1) ? 16 + 4 * (fq - 1) : 4 * fq; }
struct GUnit { const char* A; const char* B; int row0, col0, aux; };

template <bool VSW = false, class Epi, class Sched>
__device__ __forceinline__ void gemm_phase(LAS unsigned char* lds, const int K, const unsigned lda_b, const unsigned ldb_b, const Sched& S, const Epi& E) {
    const int tid = opaque_tid(), wid = __builtin_amdgcn_readfirstlane(tid >> 6), lane = tid & 63, wr = wid >> 2, wc = wid & 3, fr = lane & 15, fq = lane >> 4;
    const int nt = K / BK;
    unsigned voffA[2], voffB[2];
#pragma unroll
    for (int i = 0; i < 2; ++i) { int R, C; stage_rc(tid * 16 + i * 8192, R, C); voffA[i] = (unsigned)R * lda_b + (unsigned)C * 2u; voffB[i] = (unsigned)R * ldb_b + (unsigned)C * 2u; }
    const size_t kstep = (size_t)(BK * 2);
    const size_t hstepA = (size_t)HALF * lda_b, hstepB = (size_t)HALF * ldb_b;
    const unsigned ldsw = (unsigned)wid * 1024u;
    int aoff = lds_byte(wr * 64 + fr, fq * 8), boff = lds_byte(wc * 32 + fr, fq * 8);
    auto set_offs = [&](bool vsw) {
        aoff = vsw ? 4 * HTB + lds_byte(64 + fr, fq * 8) : lds_byte(wr * 64 + fr, fq * 8);
        boff = vsw ? lds_byte(32 * (2 * wr + wc - 2) + fr, fq * 8) - 4 * HTB : lds_byte(wc * 32 + fr, fq * 8);
    };
#define PG8_SA(b, h) (((b) * 2 + (h)) * HTB)
#define PG8_SB(b, h) ((4 + (b) * 2 + (h)) * HTB)
#define PG8_STAGE(bufoff, gbase, voff) do { _Pragma("unroll") for (int _i = 0; _i < 2; ++_i) \
        __builtin_amdgcn_global_load_lds((const unsigned*)((const char*)(gbase) + (voff)[_i]), (LAS unsigned*)(lds + (bufoff) + ldsw + _i * 8192), 16, 0, 0); } while (0)
#define PG8_LDA(dst, b, h) do { _Pragma("unroll") for (int m = 0; m < 4; ++m) _Pragma("unroll") for (int k = 0; k < 2; ++k) dst[m][k] = *(const LAS bf16x8*)(lds + PG8_SA(b, h) + aoff + m * 2048 + k * 1024); } while (0)
#define PG8_LDB(dst, b, h) do { _Pragma("unroll") for (int n = 0; n < 2; ++n) _Pragma("unroll") for (int k = 0; k < 2; ++k) dst[n][k] = *(const LAS bf16x8*)(lds + PG8_SB(b, h) + boff + n * 2048 + k * 1024); } while (0)
#define PG8_MMA(ai, bj, At, Bt) do { __builtin_amdgcn_s_setprio(1); _Pragma("unroll") for (int m = 0; m < 4; ++m) _Pragma("unroll") for (int n = 0; n < 2; ++n) _Pragma("unroll") for (int k = 0; k < 2; ++k) \
        acc[ai][bj][m][n] = __builtin_amdgcn_mfma_f32_16x16x32_bf16(Bt[n][k], At[m][k], acc[ai][bj][m][n], 0, 0, 0); __builtin_amdgcn_s_setprio(0); } while (0)
#define PG8_WAIT_V(n) asm volatile("s_waitcnt vmcnt(" #n ")" ::: "memory")
#define PG8_WAIT_L(n) asm volatile("s_waitcnt lgkmcnt(" #n ")" ::: "memory")
#define PG8_BAR __builtin_amdgcn_s_barrier()
#define PG8_SCHED __builtin_amdgcn_sched_barrier(0)
    GUnit cur, nxt; int ui = 0;
    if (!S.next(0, cur)) return;
    if (VSW) set_offs(cur.aux != 0 && wc >= 2);
    f32x4 acc[2][2][4][2];
#pragma unroll
    for (int a = 0; a < 2; ++a)
#pragma unroll
        for (int b = 0; b < 2; ++b)
#pragma unroll
            for (int m = 0; m < 4; ++m)
#pragma unroll
                for (int n = 0; n < 2; ++n) acc[a][b][m][n] = (f32x4){0.f, 0.f, 0.f, 0.f};
    bf16x8 At[4][2], B0[2][2], B1[2][2];
    const char* cA = cur.A; const char* cB = cur.B;
    PG8_STAGE(PG8_SB(0, 0), cB, voffB); PG8_STAGE(PG8_SA(0, 0), cA, voffA); PG8_STAGE(PG8_SB(0, 1), cB + hstepB, voffB); PG8_STAGE(PG8_SA(0, 1), cA + hstepA, voffA);
    if (wr == 1) PG8_BAR;
    PG8_WAIT_V(4); PG8_BAR;
    PG8_STAGE(PG8_SB(1, 0), cB + kstep, voffB); PG8_STAGE(PG8_SA(1, 0), cA + kstep, voffA); PG8_STAGE(PG8_SB(1, 1), cB + hstepB + kstep, voffB);
    PG8_WAIT_V(6); PG8_BAR;
    for (;;) {
        const bool has_next = S.next(ui + 1, nxt);
        const char* nA = has_next ? nxt.A : cA; const char* nB = has_next ? nxt.B : cB;
        for (int t = 0; t < nt; t += 2) {
            const bool last = (t == nt - 2);
            const char* a1 = cA + (size_t)(t + 1) * kstep;
            const char* a2 = last ? nA : cA + (size_t)(t + 2) * kstep; const char* b2 = last ? nB : cB + (size_t)(t + 2) * kstep;
            const char* a3 = a2 + kstep; const char* b3 = b2 + kstep;
            PG8_LDB(B0, 0, 0); PG8_SCHED; PG8_LDA(At, 0, 0); PG8_STAGE(PG8_SA(1, 1), a1 + hstepA, voffA);
            PG8_WAIT_L(8); PG8_BAR; PG8_WAIT_L(0); PG8_MMA(0, 0, At, B0); PG8_BAR; PG8_SCHED;
            PG8_LDB(B1, 0, 1); PG8_STAGE(PG8_SB(0, 0), b2, voffB);
            PG8_BAR; PG8_WAIT_L(0); PG8_MMA(0, 1, At, B1); PG8_BAR;
            PG8_LDA(At, 0, 1); PG8_STAGE(PG8_SA(0, 0), a2, voffA);
            PG8_BAR; PG8_WAIT_L(0); PG8_MMA(1, 0, At, B0); PG8_BAR; PG8_SCHED;
            PG8_STAGE(PG8_SB(0, 1), b2 + hstepB, voffB);
            PG8_WAIT_V(6); PG8_BAR; PG8_MMA(1, 1, At, B1); PG8_BAR;
            PG8_LDB(B0, 1, 0); PG8_SCHED; PG8_LDA(At, 1, 0); PG8_STAGE(PG8_SA(0, 1), a2 + hstepA, voffA);
            PG8_WAIT_L(8); PG8_BAR; PG8_WAIT_L(0); PG8_MMA(0, 0, At, B0); PG8_BAR; PG8_SCHED;
            PG8_LDB(B1, 1, 1); PG8_STAGE(PG8_SB(1, 0), b3, voffB);
            PG8_BAR; PG8_WAIT_L(0); PG8_MMA(0, 1, At, B1); PG8_BAR;
            PG8_LDA(At, 1, 1); PG8_STAGE(PG8_SA(1, 0), a3, voffA);
            PG8_BAR; PG8_WAIT_L(0); PG8_MMA(1, 0, At, B0); PG8_BAR; PG8_SCHED;
            PG8_STAGE(PG8_SB(1, 1), b3 + hstepB, voffB);
            PG8_WAIT_V(6); PG8_BAR; PG8_MMA(1, 1, At, B1); PG8_BAR;
        }
        E(acc, cur, wr, wc, fr, fq);
        if (!has_next) break;
#pragma unroll
        for (int a = 0; a < 2; ++a)
#pragma unroll
            for (int b = 0; b < 2; ++b)
#pragma unroll
                for (int m = 0; m < 4; ++m)
#pragma unroll
                    for (int n = 0; n < 2; ++n) acc[a][b][m][n] = (f32x4){0.f, 0.f, 0.f, 0.f};
        cur = nxt; cA = nA; cB = nB; ++ui; if (VSW) set_offs(cur.aux != 0 && wc >= 2);
    }
    PG8_WAIT_V(0);
    if (wr == 0) PG8_BAR;
    PG8_BAR;
#undef PG8_SA
#undef PG8_SB
#undef PG8_STAGE
#undef PG8_LDA
#undef PG8_LDB
#undef PG8_MMA
#undef PG8_WAIT_V
#undef PG8_WAIT_L
#undef PG8_BAR
#undef PG8_SCHED
}

typedef int v4i_t __attribute__((ext_vector_type(4)));
typedef int v8i_t __attribute__((ext_vector_type(8)));
template <class Epi, class Sched>
__device__ __forceinline__ void gemm_phase_f8(LAS unsigned char* lds, const int K  , const unsigned lda_b, const unsigned ldb_b, const Sched& S, const Epi& E) {
    const int tid = opaque_tid(), wid = __builtin_amdgcn_readfirstlane(tid >> 6), lane = tid & 63, wr = wid >> 2, wc = wid & 3, fr = lane & 15, fq = lane >> 4;
    const int nt = K / 128;
    unsigned voffA[2], voffB[2];
#pragma unroll
    for (int i = 0; i < 2; ++i) { int R, C; stage_rc(tid * 16 + i * 8192, R, C); voffA[i] = (unsigned)R * lda_b + (unsigned)C * 2u; voffB[i] = (unsigned)R * ldb_b + (unsigned)C * 2u; }
    const size_t kstep = (size_t)(BK * 2);
    const size_t hstepA = (size_t)HALF * lda_b, hstepB = (size_t)HALF * ldb_b;
    const unsigned ldsw = (unsigned)wid * 1024u;
    const int aoff = lds_byte(wr * 64 + fr, fq * 8), boff = lds_byte(wc * 32 + fr, fq * 8);
#define PG8_SA(b, h) (((b) * 2 + (h)) * HTB)
#define PG8_SB(b, h) ((4 + (b) * 2 + (h)) * HTB)
#define PG8_STAGE(bufoff, gbase, voff) do { _Pragma("unroll") for (int _i = 0; _i < 2; ++_i) \
        __builtin_amdgcn_global_load_lds((const unsigned*)((const char*)(gbase) + (voff)[_i]), (LAS unsigned*)(lds + (bufoff) + ldsw + _i * 8192), 16, 0, 0); } while (0)
#define PG8_LDA(dst, b, h) do { _Pragma("unroll") for (int m = 0; m < 4; ++m) { const v4i_t lo_ = *(const LAS v4i_t*)(lds + PG8_SA(b, h) + aoff + m * 2048), hi_ = *(const LAS v4i_t*)(lds + PG8_SA(b, h) + aoff + m * 2048 + 1024); dst[m] = __builtin_shufflevector(lo_, hi_, 0, 1, 2, 3, 4, 5, 6, 7); } } while (0)
#define PG8_LDB(dst, b, h) do { _Pragma("unroll") for (int n = 0; n < 2; ++n) { const v4i_t lo_ = *(const LAS v4i_t*)(lds + PG8_SB(b, h) + boff + n * 2048), hi_ = *(const LAS v4i_t*)(lds + PG8_SB(b, h) + boff + n * 2048 + 1024); dst[n] = __builtin_shufflevector(lo_, hi_, 0, 1, 2, 3, 4, 5, 6, 7); } } while (0)
#define PG8_MMA(ai, bj, At, Bt) do { __builtin_amdgcn_s_setprio(1); _Pragma("unroll") for (int m = 0; m < 4; ++m) _Pragma("unroll") for (int n = 0; n < 2; ++n) \
        asm volatile("v_mfma_scale_f32_16x16x128_f8f6f4 %0, %1, %2, %0, %3, %3 op_sel_hi:[0,0,0]" : "+v"(acc[ai][bj][m][n]) : "v"(Bt[n]), "v"(At[m]), "v"(unit_scale)); __builtin_amdgcn_s_setprio(0); } while (0)
#define PG8_MMA0(ai, bj, At, Bt) do { __builtin_amdgcn_s_setprio(1); _Pragma("unroll") for (int m = 0; m < 4; ++m) _Pragma("unroll") for (int n = 0; n < 2; ++n) \
        asm volatile("v_mfma_scale_f32_16x16x128_f8f6f4 %0, %1, %2, 0, %3, %3 op_sel_hi:[0,0,0]" : "=v"(acc[ai][bj][m][n]) : "v"(Bt[n]), "v"(At[m]), "v"(unit_scale)); __builtin_amdgcn_s_setprio(0); } while (0)
#define PG8_WAIT_V(n) asm volatile("s_waitcnt vmcnt(" #n ")" ::: "memory")
#define PG8_WAIT_L(n) asm volatile("s_waitcnt lgkmcnt(" #n ")" ::: "memory")
#define PG8_BAR __builtin_amdgcn_s_barrier()
#define PG8_SCHED __builtin_amdgcn_sched_barrier(0)
    const int unit_scale = 0x7f7f7f7f;
    GUnit cur, nxt; int ui = 0;
    if (!S.next(0, cur)) return;
    f32x4 acc[2][2][4][2];
    v8i_t At[4], B0[2], B1[2];
    const char* cA = cur.A; const char* cB = cur.B;
    PG8_STAGE(PG8_SB(0, 0), cB, voffB); PG8_STAGE(PG8_SA(0, 0), cA, voffA); PG8_STAGE(PG8_SB(0, 1), cB + hstepB, voffB); PG8_STAGE(PG8_SA(0, 1), cA + hstepA, voffA);
    if (wr == 1) PG8_BAR;
    PG8_WAIT_V(4); PG8_BAR;
    PG8_STAGE(PG8_SB(1, 0), cB + kstep, voffB); PG8_STAGE(PG8_SA(1, 0), cA + kstep, voffA); PG8_STAGE(PG8_SB(1, 1), cB + hstepB + kstep, voffB);
    PG8_WAIT_V(6); PG8_BAR;
    for (;;) {
        const bool has_next = S.next(ui + 1, nxt);
        const typename Epi::Pre pre = E.preload(cur, wr, wc, fr, fq);
        const char* nA = has_next ? nxt.A : cA; const char* nB = has_next ? nxt.B : cB;
        {
            const int t = 0;
            const bool last = (t == nt - 2);
            const char* a1 = cA + (size_t)(t + 1) * kstep;
            const char* a2 = last ? nA : cA + (size_t)(t + 2) * kstep; const char* b2 = last ? nB : cB + (size_t)(t + 2) * kstep;
            const char* a3 = a2 + kstep; const char* b3 = b2 + kstep;
            PG8_LDB(B0, 0, 0); PG8_SCHED; PG8_LDA(At, 0, 0); PG8_STAGE(PG8_SA(1, 1), a1 + hstepA, voffA);
            PG8_WAIT_L(8); PG8_BAR; PG8_WAIT_L(0); PG8_MMA0(0, 0, At, B0); PG8_BAR; PG8_SCHED;
            PG8_LDB(B1, 0, 1); PG8_STAGE(PG8_SB(0, 0), b2, voffB);
            PG8_BAR; PG8_WAIT_L(0); PG8_MMA0(0, 1, At, B1); PG8_BAR;
            PG8_LDA(At, 0, 1); PG8_STAGE(PG8_SA(0, 0), a2, voffA);
            PG8_BAR; PG8_WAIT_L(0); PG8_MMA0(1, 0, At, B0); PG8_BAR; PG8_SCHED;
            PG8_STAGE(PG8_SB(0, 1), b2 + hstepB, voffB);
            PG8_WAIT_V(6); PG8_BAR; PG8_MMA0(1, 1, At, B1); PG8_BAR;
            PG8_LDB(B0, 1, 0); PG8_SCHED; PG8_LDA(At, 1, 0); PG8_STAGE(PG8_SA(0, 1), a2 + hstepA, voffA);
            PG8_WAIT_L(8); PG8_BAR; PG8_WAIT_L(0); PG8_MMA(0, 0, At, B0); PG8_BAR; PG8_SCHED;
            PG8_LDB(B1, 1, 1); PG8_STAGE(PG8_SB(1, 0), b3, voffB);
            PG8_BAR; PG8_WAIT_L(0); PG8_MMA(0, 1, At, B1); PG8_BAR;
            PG8_LDA(At, 1, 1); PG8_STAGE(PG8_SA(1, 0), a3, voffA);
            PG8_BAR; PG8_WAIT_L(0); PG8_MMA(1, 0, At, B0); PG8_BAR; PG8_SCHED;
            PG8_STAGE(PG8_SB(1, 1), b3 + hstepB, voffB);
            PG8_WAIT_V(6); PG8_BAR; PG8_MMA(1, 1, At, B1); PG8_BAR;
        }
#pragma nounroll
        for (int t = 2; t < nt; t += 2) {
            const bool last = (t == nt - 2);
            const char* a1 = cA + (size_t)(t + 1) * kstep;
            const char* a2 = last ? nA : cA + (size_t)(t + 2) * kstep; const char* b2 = last ? nB : cB + (size_t)(t + 2) * kstep;
            const char* a3 = a2 + kstep; const char* b3 = b2 + kstep;
            PG8_LDB(B0, 0, 0); PG8_SCHED; PG8_LDA(At, 0, 0); PG8_STAGE(PG8_SA(1, 1), a1 + hstepA, voffA);
            PG8_WAIT_L(8); PG8_BAR; PG8_WAIT_L(0); PG8_MMA(0, 0, At, B0); PG8_BAR; PG8_SCHED;
            PG8_LDB(B1, 0, 1); PG8_STAGE(PG8_SB(0, 0), b2, voffB);
            PG8_BAR; PG8_WAIT_L(0); PG8_MMA(0, 1, At, B1); PG8_BAR;
            PG8_LDA(At, 0, 1); PG8_STAGE(PG8_SA(0, 0), a2, voffA);
            PG8_BAR; PG8_WAIT_L(0); PG8_MMA(1, 0, At, B0); PG8_BAR; PG8_SCHED;
            PG8_STAGE(PG8_SB(0, 1), b2 + hstepB, voffB);
            PG8_WAIT_V(6); PG8_BAR; PG8_MMA(1, 1, At, B1); PG8_BAR;
            PG8_LDB(B0, 1, 0); PG8_SCHED; PG8_LDA(At, 1, 0); PG8_STAGE(PG8_SA(0, 1), a2 + hstepA, voffA);
            PG8_WAIT_L(8); PG8_BAR; PG8_WAIT_L(0); PG8_MMA(0, 0, At, B0); PG8_BAR; PG8_SCHED;
            PG8_LDB(B1, 1, 1); PG8_STAGE(PG8_SB(1, 0), b3, voffB);
            PG8_BAR; PG8_WAIT_L(0); PG8_MMA(0, 1, At, B1); PG8_BAR;
            PG8_LDA(At, 1, 1); PG8_STAGE(PG8_SA(1, 0), a3, voffA);
            PG8_BAR; PG8_WAIT_L(0); PG8_MMA(1, 0, At, B0); PG8_BAR; PG8_SCHED;
            PG8_STAGE(PG8_SB(1, 1), b3 + hstepB, voffB);
            PG8_WAIT_V(6); PG8_BAR; PG8_MMA(1, 1, At, B1); PG8_BAR;
        }
        asm volatile("s_nop 15\n\ts_nop 15" ::: "memory");
        E(acc, cur, wr, wc, fr, fq, pre);
        if (!has_next) break;
        cur = nxt; cA = nA; cB = nB; ++ui;
    }
    PG8_WAIT_V(0);
    if (wr == 0) PG8_BAR;
    PG8_BAR;
#undef PG8_SA
#undef PG8_SB
#undef PG8_STAGE
#undef PG8_LDA
#undef PG8_LDB
#undef PG8_MMA
#undef PG8_MMA0
#undef PG8_WAIT_V
#undef PG8_WAIT_L
#undef PG8_BAR
#undef PG8_SCHED
}

template <class Epi, class Sched>
__device__ __forceinline__ void gemm_phase_f8g(LAS unsigned char* lds, const int K  , const unsigned lda_b, const unsigned ldb_b, const Sched& S, const Epi& E, const char* Abase, const int* __restrict__ tok) {
    const int tid = opaque_tid(), wid = __builtin_amdgcn_readfirstlane(tid >> 6), lane = tid & 63, wr = wid >> 2, wc = wid & 3, fr = lane & 15, fq = lane >> 4;
    const int nt = K / 128;
    unsigned voffA[2], voffB[2];
    int RA[2]; unsigned CA[2];
#pragma unroll
    for (int i = 0; i < 2; ++i) { int R, C; stage_rc(tid * 16 + i * 8192, R, C); RA[i] = R; CA[i] = (unsigned)C * 2u; voffA[i] = 0u; voffB[i] = (unsigned)R * ldb_b + (unsigned)C * 2u; }
    unsigned cv0[2], cv1[2], nv0[2], nv1[2];
#define PG8_TOKV(v0_, v1_, row0_) do { const int t_ = opaque_tid(); _Pragma("unroll") for (int i_ = 0; i_ < 2; ++i_) { int R_, C_; stage_rc(t_ * 16 + i_ * 8192, R_, C_); v0_[i_] = (unsigned)tok[(row0_) + R_] * lda_b + (unsigned)C_ * 2u; v1_[i_] = (unsigned)tok[(row0_) + HALF + R_] * lda_b + (unsigned)C_ * 2u; } } while (0)
    const size_t kstep = (size_t)(BK * 2);
    const size_t hstepA = (size_t)HALF * lda_b, hstepB = (size_t)HALF * ldb_b;
    const unsigned ldsw = (unsigned)wid * 1024u;
    const int aoff = lds_byte(wr * 64 + fr, fq * 8), boff = lds_byte(wc * 32 + fr, fq * 8);
#define PG8_SA(b, h) (((b) * 2 + (h)) * HTB)
#define PG8_SB(b, h) ((4 + (b) * 2 + (h)) * HTB)
#define PG8_STAGE(bufoff, gbase, voff) do { _Pragma("unroll") for (int _i = 0; _i < 2; ++_i) \
        __builtin_amdgcn_global_load_lds((const unsigned*)((const char*)(gbase) + (voff)[_i]), (LAS unsigned*)(lds + (bufoff) + ldsw + _i * 8192), 16, 0, 0); } while (0)
#define PG8_LDA(dst, b, h) do { _Pragma("unroll") for (int m = 0; m < 4; ++m) { const v4i_t lo_ = *(const LAS v4i_t*)(lds + PG8_SA(b, h) + aoff + m * 2048), hi_ = *(const LAS v4i_t*)(lds + PG8_SA(b, h) + aoff + m * 2048 + 1024); dst[m] = __builtin_shufflevector(lo_, hi_, 0, 1, 2, 3, 4, 5, 6, 7); } } while (0)
#define PG8_LDB(dst, b, h) do { _Pragma("unroll") for (int n = 0; n < 2; ++n) { const v4i_t lo_ = *(const LAS v4i_t*)(lds + PG8_SB(b, h) + boff + n * 2048), hi_ = *(const LAS v4i_t*)(lds + PG8_SB(b, h) + boff + n * 2048 + 1024); dst[n] = __builtin_shufflevector(lo_, hi_, 0, 1, 2, 3, 4, 5, 6, 7); } } while (0)
#define PG8_MMA(ai, bj, At, Bt) do { __builtin_amdgcn_s_setprio(1); _Pragma("unroll") for (int m = 0; m < 4; ++m) _Pragma("unroll") for (int n = 0; n < 2; ++n) \
        asm volatile("v_mfma_scale_f32_16x16x128_f8f6f4 %0, %1, %2, %0, %3, %3 op_sel_hi:[0,0,0]" : "+v"(acc[ai][bj][m][n]) : "v"(Bt[n]), "v"(At[m]), "v"(unit_scale)); __builtin_amdgcn_s_setprio(0); } while (0)
#define PG8_MMA0(ai, bj, At, Bt) do { __builtin_amdgcn_s_setprio(1); _Pragma("unroll") for (int m = 0; m < 4; ++m) _Pragma("unroll") for (int n = 0; n < 2; ++n) \
        asm volatile("v_mfma_scale_f32_16x16x128_f8f6f4 %0, %1, %2, 0, %3, %3 op_sel_hi:[0,0,0]" : "=v"(acc[ai][bj][m][n]) : "v"(Bt[n]), "v"(At[m]), "v"(unit_scale)); __builtin_amdgcn_s_setprio(0); } while (0)
#define PG8_WAIT_V(n) asm volatile("s_waitcnt vmcnt(" #n ")" ::: "memory")
#define PG8_WAIT_L(n) asm volatile("s_waitcnt lgkmcnt(" #n ")" ::: "memory")
#define PG8_BAR __builtin_amdgcn_s_barrier()
#define PG8_SCHED __builtin_amdgcn_sched_barrier(0)
    const int unit_scale = 0x7f7f7f7f;
    GUnit cur, nxt; int ui = 0;
    if (!S.next(0, cur)) return;
    f32x4 acc[2][2][4][2];
    v8i_t At[4], B0[2], B1[2];
    const char* cB = cur.B;
    PG8_TOKV(cv0, cv1, cur.row0);
    PG8_STAGE(PG8_SB(0, 0), cB, voffB); PG8_STAGE(PG8_SA(0, 0), Abase, cv0); PG8_STAGE(PG8_SB(0, 1), cB + hstepB, voffB); PG8_STAGE(PG8_SA(0, 1), Abase, cv1);
    if (wr == 1) PG8_BAR;
    PG8_WAIT_V(4); PG8_BAR;
    PG8_STAGE(PG8_SB(1, 0), cB + kstep, voffB); PG8_STAGE(PG8_SA(1, 0), Abase + kstep, cv0); PG8_STAGE(PG8_SB(1, 1), cB + hstepB + kstep, voffB);
    PG8_WAIT_V(6); PG8_BAR;
    for (;;) {
        const bool has_next = S.next(ui + 1, nxt);
        const typename Epi::Pre pre = E.preload(cur, wr, wc, fr, fq);
        const char* nB = has_next ? nxt.B : cB;
        if (has_next) PG8_TOKV(nv0, nv1, nxt.row0); else { nv0[0] = cv0[0]; nv0[1] = cv0[1]; nv1[0] = cv1[0]; nv1[1] = cv1[1]; }
        {
            const char* a1 = Abase + kstep;
            const char* a2 = Abase + 2 * kstep; const char* b2 = cB + 2 * kstep;
            const char* a3 = a2 + kstep; const char* b3 = b2 + kstep;
            PG8_LDB(B0, 0, 0); PG8_SCHED; PG8_LDA(At, 0, 0); PG8_STAGE(PG8_SA(1, 1), a1, cv1);
            PG8_WAIT_L(8); PG8_BAR; PG8_WAIT_L(0); PG8_MMA0(0, 0, At, B0); PG8_BAR; PG8_SCHED;
            PG8_LDB(B1, 0, 1); PG8_STAGE(PG8_SB(0, 0), b2, voffB);
            PG8_BAR; PG8_WAIT_L(0); PG8_MMA0(0, 1, At, B1); PG8_BAR;
            PG8_LDA(At, 0, 1); PG8_STAGE(PG8_SA(0, 0), a2, cv0);
            PG8_BAR; PG8_WAIT_L(0); PG8_MMA0(1, 0, At, B0); PG8_BAR; PG8_SCHED;
            PG8_STAGE(PG8_SB(0, 1), b2 + hstepB, voffB);
            PG8_WAIT_V(6); PG8_BAR; PG8_MMA0(1, 1, At, B1); PG8_BAR;
            PG8_LDB(B0, 1, 0); PG8_SCHED; PG8_LDA(At, 1, 0); PG8_STAGE(PG8_SA(0, 1), a2, cv1);
            PG8_WAIT_L(8); PG8_BAR; PG8_WAIT_L(0); PG8_MMA(0, 0, At, B0); PG8_BAR; PG8_SCHED;
            PG8_LDB(B1, 1, 1); PG8_STAGE(PG8_SB(1, 0), b3, voffB);
            PG8_BAR; PG8_WAIT_L(0); PG8_MMA(0, 1, At, B1); PG8_BAR;
            PG8_LDA(At, 1, 1); PG8_STAGE(PG8_SA(1, 0), a3, cv0);
            PG8_BAR; PG8_WAIT_L(0); PG8_MMA(1, 0, At, B0); PG8_BAR; PG8_SCHED;
            PG8_STAGE(PG8_SB(1, 1), b3 + hstepB, voffB);
            PG8_WAIT_V(6); PG8_BAR; PG8_MMA(1, 1, At, B1); PG8_BAR;
        }
#pragma nounroll
        for (int t = 2; t < nt; t += 2) {
            const bool last = (t == nt - 2);
            const char* a1 = Abase + (size_t)(t + 1) * kstep;
            const char* a2 = last ? Abase : Abase + (size_t)(t + 2) * kstep; const char* b2 = last ? nB : cB + (size_t)(t + 2) * kstep;
            const char* a3 = a2 + kstep; const char* b3 = b2 + kstep;
            unsigned v20[2], v21[2];
            v20[0] = last ? nv0[0] : cv0[0]; v20[1] = last ? nv0[1] : cv0[1]; v21[0] = last ? nv1[0] : cv1[0]; v21[1] = last ? nv1[1] : cv1[1];
            PG8_LDB(B0, 0, 0); PG8_SCHED; PG8_LDA(At, 0, 0); PG8_STAGE(PG8_SA(1, 1), a1, cv1);
            PG8_WAIT_L(8); PG8_BAR; PG8_WAIT_L(0); PG8_MMA(0, 0, At, B0); PG8_BAR; PG8_SCHED;
            PG8_LDB(B1, 0, 1); PG8_STAGE(PG8_SB(0, 0), b2, voffB);
            PG8_BAR; PG8_WAIT_L(0); PG8_MMA(0, 1, At, B1); PG8_BAR;
            PG8_LDA(At, 0, 1); PG8_STAGE(PG8_SA(0, 0), a2, v20);
            PG8_BAR; PG8_WAIT_L(0); PG8_MMA(1, 0, At, B0); PG8_BAR; PG8_SCHED;
            PG8_STAGE(PG8_SB(0, 1), b2 + hstepB, voffB);
            PG8_WAIT_V(6); PG8_BAR; PG8_MMA(1, 1, At, B1); PG8_BAR;
            PG8_LDB(B0, 1, 0); PG8_SCHED; PG8_LDA(At, 1, 0); PG8_STAGE(PG8_SA(0, 1), a2, v21);
            PG8_WAIT_L(8); PG8_BAR; PG8_WAIT_L(0); PG8_MMA(0, 0, At, B0); PG8_BAR; PG8_SCHED;
            PG8_LDB(B1, 1, 1); PG8_STAGE(PG8_SB(1, 0), b3, voffB);
            PG8_BAR; PG8_WAIT_L(0); PG8_MMA(0, 1, At, B1); PG8_BAR;
            PG8_LDA(At, 1, 1); PG8_STAGE(PG8_SA(1, 0), a3, v20);
            PG8_BAR; PG8_WAIT_L(0); PG8_MMA(1, 0, At, B0); PG8_BAR; PG8_SCHED;
            PG8_STAGE(PG8_SB(1, 1), b3 + hstepB, voffB);
            PG8_WAIT_V(6); PG8_BAR; PG8_MMA(1, 1, At, B1); PG8_BAR;
        }
        asm volatile("s_nop 15\n\ts_nop 15" ::: "memory");
        E(acc, cur, wr, wc, fr, fq, pre);
        if (!has_next) break;
        cur = nxt; cB = nB; ++ui; cv0[0] = nv0[0]; cv0[1] = nv0[1]; cv1[0] = nv1[0]; cv1[1] = nv1[1];
    }
    PG8_WAIT_V(0);
    if (wr == 0) PG8_BAR;
    PG8_BAR;
#undef PG8_TOKV
#undef PG8_SA
#undef PG8_SB
#undef PG8_STAGE
#undef PG8_LDA
#undef PG8_LDB
#undef PG8_MMA
#undef PG8_MMA0
#undef PG8_WAIT_V
#undef PG8_WAIT_L
#undef PG8_BAR
#undef PG8_SCHED
}

__device__ __forceinline__ void dense_map(int L, int nM, int nN, int& pm, int& pn) {
    const int nwg = nM * nN;
    int wgid = L; { const int q = nwg / 8, r = nwg % 8, xcd = wgid % 8, off = wgid / 8; wgid = (xcd < r ? xcd * (q + 1) : r * (q + 1) + (xcd - r) * q) + off; }
    const int nig = 8 * nN, gid = wgid / nig, fm = gid * 8, gsz = (nM - fm) < 8 ? (nM - fm) : 8;
    pm = fm + ((wgid % nig) % gsz); pn = (wgid % nig) / gsz;
}
struct DenseOrder {
    const char* A; const char* Bt; unsigned lda_b, ldb_b; int nM, nN, nwg, G, c; unsigned aux_mask = 0u;
    __device__ void init(const void* A_, const void* Bt_, int M, int N, unsigned lda_b_, unsigned ldb_b_, int G_, int c_) { A = (const char*)A_; Bt = (const char*)Bt_; lda_b = lda_b_; ldb_b = ldb_b_; nM = M / BM; nN = N / BM; nwg = nM * nN; G = G_; c = c_; }
    __device__ bool next(int i, GUnit& u) const {
        const long L = (long)i * G + c; if (L >= nwg) return false;
        int pm, pn; dense_map((int)L, nM, nN, pm, pn);
        u.A = A + (size_t)pm * BM * lda_b; u.B = Bt + (size_t)pn * BM * ldb_b; u.row0 = pm * BM; u.col0 = pn * BM; u.aux = (int)((aux_mask >> pn) & 1u); return true;
    }
};


struct OneUnit {
    GUnit u;
    __device__ bool next(int i, GUnit& o) const { if (i != 0) return false; o = u; return true; }
};
struct EpiF32R {
    float* C; int ldc; const float* res; int ncols;
    __device__ __forceinline__ void operator()(const f32x4 (&acc)[2][2][4][2], const GUnit& u, int wr, int wc, int fr, int fq) const {
        const int row0 = u.row0 + wr * 64 + fr, col0 = u.col0 + wc * 32 + 4 * fq;
#pragma unroll
        for (int ai = 0; ai < 2; ++ai)
#pragma unroll
            for (int m = 0; m < 4; ++m) {
                const size_t ro = (size_t)(row0 + ai * HALF + m * 16) * ldc;
#pragma unroll
                for (int bj = 0; bj < 2; ++bj)
#pragma unroll
                    for (int n = 0; n < 2; ++n) {
                        const int col = col0 + bj * HALF + n * 16;
                        if (col < ncols) { f32x4 x = acc[ai][bj][m][n]; if (res) x += *(const f32x4*)(res + ro + col); *(f32x4*)(C + ro + col) = x; }
                    }
            }
    }
};


struct EpiResNormStats {
    const float* res; bf16_t* Hb; float* ss; unsigned char* H8;
    __device__ __forceinline__ void operator()(const f32x4 (&acc)[2][2][4][2], const GUnit& u, int wr, int wc, int fr, int fq) const {
        const int row0 = u.row0 + wr * 64 + fr, col0 = u.col0 + wc * 32 + 4 * fq;
#pragma unroll
        for (int ai = 0; ai < 2; ++ai) {
            f32x4 r[4][2][2];
#pragma unroll
            for (int m = 0; m < 4; ++m)
#pragma unroll
                for (int bj = 0; bj < 2; ++bj)
#pragma unroll
                    for (int n = 0; n < 2; ++n) r[m][bj][n] = *(const f32x4*)(res + (size_t)(row0 + ai * HALF + m * 16) * 1024 + col0 + bj * HALF + n * 16);
            asm volatile("" ::: "memory");
#pragma unroll
            for (int m = 0; m < 4; ++m) {
                const int row = row0 + ai * HALF + m * 16;
                const size_t ro = (size_t)row * 1024;
                float sq = 0.f;
                unsigned d8[4];
#pragma unroll
                for (int bj = 0; bj < 2; ++bj) {
                    uint2 o[2];
#pragma unroll
                    for (int n = 0; n < 2; ++n) {
                        const f32x4 x = acc[ai][bj][m][n] + r[m][bj][n];
                        o[n].x = cvt_pk_bf16(x[0], x[1]); o[n].y = cvt_pk_bf16(x[2], x[3]);
                        d8[bj * 2 + n] = pk4_fp8(x[0], x[1], x[2], x[3]);
                        sq += x[0] * x[0] + x[1] * x[1] + x[2] * x[2] + x[3] * x[3];
                    }
                    *(uint4*)(Hb + ro + u.col0 + wc * 32 + bj * HALF + pair16_col(fq)) = pair16(o[0], o[1]);
                }
                *(uint4*)(H8 + ro + u.col0 + wc * 64 + fq * 16) = make_uint4(d8[0], d8[1], d8[2], d8[3]);
                sq += __shfl_xor(sq, 16); sq += __shfl_xor(sq, 32);
                if (fq == 0) ss[(size_t)row * 16 + (u.col0 >> 8) * 4 + wc] = sq;
            }
            asm volatile("" ::: "memory");
        }
    }
};
struct EpiBf16RowScale {
    bf16_t* O; const float* ss; float scale;
    struct Pre {};
    __device__ __forceinline__ Pre preload(const GUnit&, int, int, int, int) const { return Pre{}; }
    __device__ __forceinline__ void operator()(const f32x4 (&acc)[2][2][4][2], const GUnit& u, int wr, int wc, int fr, int fq, const Pre&) const {
        const int row0 = u.row0 + wr * 64 + fr;
        f32x4 sv[2][4];
#pragma unroll
        for (int ai = 0; ai < 2; ++ai)
#pragma unroll
            for (int m = 0; m < 4; ++m) sv[ai][m] = *(const f32x4*)(ss + (size_t)(row0 + ai * HALF + m * 16) * 16 + 4 * fq);
        asm volatile("" ::: "memory");
#pragma unroll
        for (int ai = 0; ai < 2; ++ai)
#pragma unroll
            for (int m = 0; m < 4; ++m) {
                const f32x4 v = sv[ai][m];
                float tot = (v[0] + v[1]) + (v[2] + v[3]);
                tot += lane_xor16(tot); tot += lane_xor32(tot);
                const float rs = rsqrtf(tot * (1.f / 1024.f) + 1e-5f) * scale;
                bf16_t* rowp = O + (size_t)(row0 + ai * HALF + m * 16) * 1024 + u.col0 + wc * 32 + pair16_col(fq);
#pragma unroll
                for (int bj = 0; bj < 2; ++bj) {
                    uint2 o[2];
#pragma unroll
                    for (int n = 0; n < 2; ++n) { const f32x4 x = acc[ai][bj][m][n] * rs; o[n].x = cvt_pk_bf16(x[0], x[1]); o[n].y = cvt_pk_bf16(x[2], x[3]); }
                    *(uint4*)(rowp + bj * HALF) = pair16(o[0], o[1]);
                }
            }
    }
};

struct EpiBf16Res {
    bf16_t* H; float scale;
    struct Pre {};
    __device__ __forceinline__ Pre preload(const GUnit&, int, int, int, int) const { return Pre{}; }
    __device__ __forceinline__ void operator()(const f32x4 (&acc)[2][2][4][2], const GUnit& u, int wr, int wc, int fr, int fq, const Pre&) const {
        bf16_t* base = H + (size_t)(u.row0 + wr * 64 + fr) * 1024 + u.col0 + wc * 32 + pair16_col(fq);
        uint4 v[2][4][2];
#pragma unroll
        for (int ai = 0; ai < 2; ++ai)
#pragma unroll
            for (int m = 0; m < 4; ++m)
#pragma unroll
                for (int bj = 0; bj < 2; ++bj) v[ai][m][bj] = *(const uint4*)(base + (size_t)(ai * HALF + m * 16) * 1024 + bj * HALF);
        asm volatile("" ::: "memory");
#pragma unroll
        for (int ai = 0; ai < 2; ++ai)
#pragma unroll
            for (int m = 0; m < 4; ++m)
#pragma unroll
                for (int bj = 0; bj < 2; ++bj) {
                    const uint4 pc = pair16(make_uint2(v[ai][m][bj].x, v[ai][m][bj].y), make_uint2(v[ai][m][bj].z, v[ai][m][bj].w));
                    const uint2 rr[2] = {make_uint2(pc.x, pc.y), make_uint2(pc.z, pc.w)};
                    uint2 o[2];
#pragma unroll
                    for (int n = 0; n < 2; ++n) {
                        const uint2 r = rr[n];
                        const f32x4 a = acc[ai][bj][m][n] * scale;
                        o[n].x = cvt_pk_bf16(a[0] + __uint_as_float(r.x << 16), a[1] + __uint_as_float(r.x & 0xffff0000u)); o[n].y = cvt_pk_bf16(a[2] + __uint_as_float(r.y << 16), a[3] + __uint_as_float(r.y & 0xffff0000u));
                    }
                    *(uint4*)(base + (size_t)(ai * HALF + m * 16) * 1024 + bj * HALF) = pair16(o[0], o[1]);
                }
    }
};
struct EpiBf16S {
    bf16_t* O; int ldc; float scale;
    __device__ __forceinline__ void operator()(const f32x4 (&acc)[2][2][4][2], const GUnit& u, int wr, int wc, int fr, int fq) const {
        const int row0 = u.row0 + wr * 64 + fr, col0 = u.col0 + wc * 32 + 4 * fq;
#pragma unroll
        for (int ai = 0; ai < 2; ++ai)
#pragma unroll
            for (int m = 0; m < 4; ++m) {
                bf16_t* rowp = O + (size_t)(row0 + ai * HALF + m * 16) * ldc + col0;
#pragma unroll
                for (int bj = 0; bj < 2; ++bj)
#pragma unroll
                    for (int n = 0; n < 2; ++n) { const f32x4 x = acc[ai][bj][m][n] * scale; uint2 o; o.x = cvt_pk_bf16(x[0], x[1]); o.y = cvt_pk_bf16(x[2], x[3]); *(uint2*)(rowp + bj * HALF + n * 16) = o; }
            }
    }
};
struct EpiXkv {
    bf16_t *xk, *xvT;
    __device__ __forceinline__ void operator()(const f32x4 (&acc)[2][2][4][2], const GUnit& u, int wr, int wc, int fr, int fq) const {
        const int row0 = u.row0 + wr * 64 + fr, col0 = u.col0 + wc * 32 + 4 * fq;
        const bool isv = u.col0 >= 1024;
#pragma unroll
        for (int ai = 0; ai < 2; ++ai)
#pragma unroll
            for (int m = 0; m < 4; ++m) {
                const int row = row0 + ai * HALF + m * 16, b = row >> 8, key = row & 255;
#pragma unroll
                for (int bj = 0; bj < 2; ++bj)
#pragma unroll
                    for (int n = 0; n < 2; ++n) {
                        const int col = (col0 + bj * HALF + n * 16) & 1023, h = col >> 8, d = col & 255;
                        const f32x4 x = acc[ai][bj][m][n];
                        uint2 o; o.x = cvt_pk_bf16_acc(x[0], x[1]); o.y = cvt_pk_bf16_acc(x[2], x[3]);
                        if (!isv) *(uint2*)(xk + ((size_t)(b * 4 + h) * 256 + key) * 256 + d) = o;
                        else { bf16_t* base = xvT + ((size_t)(b * 4 + h) * 256 + d) * 256 + key;
                               base[0] = (bf16_t)(o.x & 0xffff); base[256] = (bf16_t)(o.x >> 16); base[512] = (bf16_t)(o.y & 0xffff); base[768] = (bf16_t)(o.y >> 16); }
                    }
            }
    }
};

struct EpiMixIn {
    bf16_t *q, *kk  , *vt  , *u, *cb; float* gates; const float* cosT; const float* sinT;
    __device__ __forceinline__ void operator()(const f32x4 (&acc)[2][2][4][2], const GUnit& un, int wr, int wc, int fr, int fq) const {
        const int pn = un.col0 >> 8, pc = pair16_col(fq);
        if (pn <= 4) {
            if (pn >= 3 && wc >= 2) {
                const int v = 2 * wr + wc - 2, b = un.row0 >> 11;
#pragma unroll
                for (int ai = 0; ai < 2; ++ai)
#pragma unroll
                    for (int m = 0; m < 4; ++m) {
                        bf16_t* base = vt + (size_t)(pn - 3) * ((size_t)T * 128) + ((size_t)(b * 2 + (m >> 1)) * 64 + 32 * ai + 16 * (m & 1) + fr) * S + ((un.row0 + 32 * v) & (S - 1));
#pragma unroll
                        for (int bj = 0; bj < 2; ++bj) {
                            const f32x4 xa = acc[ai][bj][m][0], xb = acc[ai][bj][m][1];
                            uint2 pa, pb; pa.x = cvt_pk_bf16_acc(xa[0], xa[1]); pa.y = cvt_pk_bf16_acc(xa[2], xa[3]); pb.x = cvt_pk_bf16_acc(xb[0], xb[1]); pb.y = cvt_pk_bf16_acc(xb[2], xb[3]);
                            *(uint4*)(base + bj * HALF + pc) = pair16(pa, pb);
                        }
                    }
                return;
            }
            const bool rope = (pn < 2) || (wc < 2);
            const int trow = un.row0 + wr * 64 + fr;
            uint4 cs[2][4][2];
            if (rope) {
#pragma unroll
                for (int ai = 0; ai < 2; ++ai)
#pragma unroll
                    for (int m = 0; m < 4; ++m)
#pragma unroll
                        for (int n = 0; n < 2; ++n) cs[ai][m][n] = *(const uint4*)((const unsigned*)cosT + (size_t)(trow + ai * HALF + m * 16) * 32 + 16 * n + 4 * fq);
            } else {
#pragma unroll
                for (int ai = 0; ai < 2; ++ai)
#pragma unroll
                    for (int m = 0; m < 4; ++m)
#pragma unroll
                        for (int n = 0; n < 2; ++n) cs[ai][m][n] = make_uint4(0x3c00u, 0x3c00u, 0x3c00u, 0x3c00u);
            }
            asm volatile("" ::: "memory");
            const float qs = (pn < 2) ? QS : 1.f;
#pragma unroll
            for (int ai = 0; ai < 2; ++ai)
#pragma unroll
                for (int m = 0; m < 4; ++m) {
                    const int t = trow + ai * HALF + m * 16, b = t >> 11, sq = t & 2047;
                    uint2 o[2][2];
#pragma unroll
                    for (int n = 0; n < 2; ++n) {
                        const f32x4 x0 = acc[ai][0][m][n], x1 = acc[ai][1][m][n];
                        const unsigned cw[4] = {cs[ai][m][n].x, cs[ai][m][n].y, cs[ai][m][n].z, cs[ai][m][n].w};
                        float r0[4], r1[4];
#pragma unroll
                        for (int j = 0; j < 4; ++j) {
                            const h2_t hv = __builtin_bit_cast(h2_t, cw[j]);
                            const float c = (float)hv[0] * qs, sn = (float)hv[1] * qs;
                            r0[j] = x0[j] * c - x1[j] * sn; r1[j] = x1[j] * c + x0[j] * sn;
                        }
                        o[0][n].x = cvt_pk_bf16(r0[0], r0[1]); o[0][n].y = cvt_pk_bf16(r0[2], r0[3]); o[1][n].x = cvt_pk_bf16(r1[0], r1[1]); o[1][n].y = cvt_pk_bf16(r1[2], r1[3]);
                    }
                    bf16_t* dst;
                    if (pn < 2) dst = q + (size_t)t * 512 + (pn * 4 + wc) * 64;
                    else {
                        const int ki = (pn == 2) ? (wc >> 1) : pn - 1;
                        dst = kk + (size_t)ki * ((size_t)T * 128) + ((size_t)(b * 2 + (wc & 1)) * S + sq) * 64;
                    }
                    *(uint4*)(dst + pc) = pair16(o[0][0], o[0][1]); *(uint4*)(dst + 32 + pc) = pair16(o[1][0], o[1][1]);
                }
        } else if (pn < 9) {
#pragma unroll
            for (int ai = 0; ai < 2; ++ai)
#pragma unroll
                for (int m = 0; m < 4; ++m) {
                    const int t = un.row0 + ai * HALF + wr * 64 + m * 16 + fr;
                    uint2 o[2];
#pragma unroll
                    for (int n = 0; n < 2; ++n) {
                        const f32x4 x = acc[ai][0][m][n] * acc[ai][1][m][n];
                        o[n].x = cvt_pk_bf16(x[0], x[1]); o[n].y = cvt_pk_bf16(x[2], x[3]);
                    }
                    *(uint4*)(u + (size_t)t * 512 + (pn - 5) * 128 + wc * 32 + pc) = pair16(o[0], o[1]);
                }
        } else if (pn < 11) {
#pragma unroll
            for (int ai = 0; ai < 2; ++ai)
#pragma unroll
                for (int m = 0; m < 4; ++m) {
                    const int t = un.row0 + ai * HALF + wr * 64 + m * 16 + fr;
#pragma unroll
                    for (int bj = 0; bj < 2; ++bj) {
                        uint2 o[2];
#pragma unroll
                        for (int n = 0; n < 2; ++n) {
                            const f32x4 x = acc[ai][bj][m][n];
                            o[n].x = cvt_pk_bf16_acc(x[0], x[1]); o[n].y = cvt_pk_bf16_acc(x[2], x[3]);
                        }
                        *(uint4*)(cb + (size_t)t * 512 + (pn - 9) * 256 + bj * 128 + wc * 32 + pc) = pair16(o[0], o[1]);
                    }
                }
        } else if (wc == 0) {
#pragma unroll
            for (int ai = 0; ai < 2; ++ai)
#pragma unroll
                for (int m = 0; m < 4; ++m) {
                    const int t = un.row0 + ai * HALF + wr * 64 + m * 16 + fr;
#pragma unroll
                    for (int n = 0; n < 2; ++n)
                        if (n == 0 || fq < 2) {
                            const f32x4 x = acc[ai][0][m][n];
                            f32x4 sg;
#pragma unroll
                            for (int j = 0; j < 4; ++j) sg[j] = 1.f / (1.f + __expf(-x[j]));
                            *(f32x4*)(gates + (size_t)t * 24 + 16 * n + 4 * fq) = sg;
                        }
                }
        }
    }
};
struct EpiSwiglu {
    bf16_t* H; const float* bias;
    __device__ __forceinline__ void operator()(const f32x4 (&acc)[2][2][4][2], const GUnit& u, int wr, int wc, int fr, int fq) const {
        const int row0 = u.row0 + wr * 64 + fr, pn = u.col0 >> 8, cl0 = wc * 32 + 4 * fq;
        const float* bg = bias + (size_t)u.aux * 2048 + pn * 128 + cl0;
        f32x4 bgv[2], buv[2];
#pragma unroll
        for (int n = 0; n < 2; ++n) { bgv[n] = *(const f32x4*)(bg + n * 16); buv[n] = *(const f32x4*)(bg + 1024 + n * 16); }
#pragma unroll
        for (int ai = 0; ai < 2; ++ai)
#pragma unroll
            for (int m = 0; m < 4; ++m) {
                bf16_t* rowp = H + (size_t)(row0 + ai * HALF + m * 16) * 1024 + pn * 128 + cl0;
#pragma unroll
                for (int n = 0; n < 2; ++n) {
                    const f32x4 g4 = acc[ai][0][m][n] + bgv[n], u4 = acc[ai][1][m][n] + buv[n];
                    float h[4];
#pragma unroll
                    for (int j = 0; j < 4; ++j) {
                        const float g = fminf(g4[j], 7.f), uu = fminf(fmaxf(u4[j], -7.f), 7.f);
                        h[j] = (uu + 1.f) * (g / (1.f + __expf(-1.702f * g)));
                    }
                    uint2 o; o.x = cvt_pk_bf16(h[0], h[1]); o.y = cvt_pk_bf16(h[2], h[3]);
                    *(uint2*)(rowp + n * 16) = o;
                }
            }
    }
};
struct EpiDownScale {
    bf16_t* O; const float* bias; const float* w_buf;
    __device__ __forceinline__ void operator()(const f32x4 (&acc)[2][2][4][2], const GUnit& u, int wr, int wc, int fr, int fq) const {
        const int row0 = u.row0 + wr * 64 + fr, col0 = u.col0 + wc * 32 + 4 * fq;
        f32x4 bv[2][2];
#pragma unroll
        for (int bj = 0; bj < 2; ++bj)
#pragma unroll
            for (int n = 0; n < 2; ++n) bv[bj][n] = *(const f32x4*)(bias + (size_t)u.aux * 1024 + col0 + bj * HALF + n * 16);
#pragma unroll
        for (int ai = 0; ai < 2; ++ai)
#pragma unroll
            for (int m = 0; m < 4; ++m) {
                const int row = row0 + ai * HALF + m * 16;
                const float w = w_buf[row];
                bf16_t* rowp = O + (size_t)row * 1024 + col0;
#pragma unroll
                for (int bj = 0; bj < 2; ++bj)
#pragma unroll
                    for (int n = 0; n < 2; ++n) {
                        const f32x4 x = (acc[ai][bj][m][n] + bv[bj][n]) * w;
                        uint2 o; o.x = cvt_pk_bf16(x[0], x[1]); o.y = cvt_pk_bf16(x[2], x[3]);
                        *(uint2*)(rowp + bj * HALF + n * 16) = o;
                    }
            }
    }
};

constexpr float W8_SCALE = 64.f, W8_INV = 1.f / 64.f;
__device__ __forceinline__ unsigned pk4_fp8(float a, float b, float c, float d) { unsigned w = 0; w = __builtin_amdgcn_cvt_pk_fp8_f32(a, b, w, false); w = __builtin_amdgcn_cvt_pk_fp8_f32(c, d, w, true); return w; }
struct EpiSwigluF8out {
    unsigned char* H; const float* bias;
    __device__ __forceinline__ void operator()(const f32x4 (&acc)[2][2][4][2], const GUnit& u, int wr, int wc, int fr, int fq) const {
        const int row0 = u.row0 + wr * 64 + fr, pn = u.col0 >> 8, cl0 = wc * 32 + 4 * fq;
        const float* bg = bias + (size_t)u.aux * 2048 + pn * 128 + cl0;
        f32x4 bgv[2], buv[2];
#pragma unroll
        for (int n = 0; n < 2; ++n) { bgv[n] = *(const f32x4*)(bg + n * 16); buv[n] = *(const f32x4*)(bg + 1024 + n * 16); }
#pragma unroll
        for (int ai = 0; ai < 2; ++ai)
#pragma unroll
            for (int m = 0; m < 4; ++m) {
                unsigned char* rowp = H + (size_t)(row0 + ai * HALF + m * 16) * 1024 + pn * 128 + cl0;
#pragma unroll
                for (int n = 0; n < 2; ++n) {
                    const f32x4 g4 = acc[ai][0][m][n] + bgv[n], u4 = acc[ai][1][m][n] + buv[n];
                    float h[4];
#pragma unroll
                    for (int j = 0; j < 4; ++j) {
                        const float g = fminf(g4[j], 7.f), uu = fminf(fmaxf(u4[j], -7.f), 7.f);
                        h[j] = (uu + 1.f) * (g / (1.f + __expf(-1.702f * g)));
                    }
                    *(unsigned*)(rowp + n * 16) = pk4_fp8(h[0], h[1], h[2], h[3]);
                }
            }
    }
};
struct EpiSwigluF8 {
    unsigned char* H; const bf16_t* bias16;
    struct Pre { uint2 g[2], u[2]; };
    __device__ __forceinline__ Pre preload(const GUnit& u, int wr, int wc, int fr, int fq) const {
        Pre q; const int pn = u.col0 >> 8, cl0 = wc * 32 + 4 * fq;
        const bf16_t* bg = bias16 + (size_t)u.aux * 2048 + pn * 128 + cl0;
#pragma unroll
        for (int n = 0; n < 2; ++n) { q.g[n] = *(const uint2*)(bg + n * 16); q.u[n] = *(const uint2*)(bg + 1024 + n * 16); }
        return q;
    }
    __device__ __forceinline__ void operator()(const f32x4 (&acc)[2][2][4][2], const GUnit& u, int wr, int wc, int fr, int fq, const Pre& q) const {
        const int row0 = u.row0 + wr * 64 + fr, pn = u.col0 >> 8, cl0 = wc * 32 + 4 * fq;
        f32x4 bgv[2], buv[2];
#pragma unroll
        for (int n = 0; n < 2; ++n) {
            bgv[n] = (f32x4){__uint_as_float(q.g[n].x << 16), __uint_as_float(q.g[n].x & 0xffff0000u), __uint_as_float(q.g[n].y << 16), __uint_as_float(q.g[n].y & 0xffff0000u)};
            buv[n] = (f32x4){__uint_as_float(q.u[n].x << 16), __uint_as_float(q.u[n].x & 0xffff0000u), __uint_as_float(q.u[n].y << 16), __uint_as_float(q.u[n].y & 0xffff0000u)} + 1.f;
        }
#pragma unroll
        for (int ai = 0; ai < 2; ++ai)
#pragma unroll
            for (int m = 0; m < 4; ++m) {
                unsigned d[2];
#pragma unroll
                for (int n = 0; n < 2; ++n) {
                    float h[4];
#pragma unroll
                    for (int hf = 0; hf < 2; ++hf) {
                        const f32x2_t ag = {acc[ai][0][m][n][2 * hf], acc[ai][0][m][n][2 * hf + 1]}, au = {acc[ai][1][m][n][2 * hf], acc[ai][1][m][n][2 * hf + 1]};
                        const f32x2_t bg2 = {bgv[n][2 * hf], bgv[n][2 * hf + 1]}, bu2 = {buv[n][2 * hf], buv[n][2 * hf + 1]};
                        f32x2_t g2 = __builtin_elementwise_fma(ag, (f32x2_t){W8_INV, W8_INV}, bg2), u2 = __builtin_elementwise_fma(au, (f32x2_t){W8_INV, W8_INV}, bu2);
                        g2 = (f32x2_t){fminf(g2[0], 7.f), fminf(g2[1], 7.f)};
                        u2 = (f32x2_t){fminf(fmaxf(u2[0], -6.f), 8.f), fminf(fmaxf(u2[1], -6.f), 8.f)};
                        const f32x2_t z = g2 * (f32x2_t){-1.702f * 1.4426950408889634f, -1.702f * 1.4426950408889634f};
                        const f32x2_t e = (f32x2_t){__builtin_amdgcn_exp2f(z[0]), __builtin_amdgcn_exp2f(z[1])} + (f32x2_t){1.f, 1.f};
                        const f32x2_t r = {__builtin_amdgcn_rcpf(e[0]), __builtin_amdgcn_rcpf(e[1])};
                        const f32x2_t hh = (u2 * g2) * r;
                        h[2 * hf] = hh[0]; h[2 * hf + 1] = hh[1];
                    }
                    d[n] = pk4_fp8(h[0], h[1], h[2], h[3]);
                }
                *(uint2*)(H + (size_t)(row0 + ai * HALF + m * 16) * 1024 + pn * 128 + wc * 32 + fq * 8) = make_uint2(d[0], d[1]);
            }
    }
};
struct EpiDownScaleF8 {
    unsigned char* O; const float* bias; const float* w_buf;
    struct Pre { f32x4 bv[2][2]; float w[2][4]; };
    __device__ __forceinline__ Pre preload(const GUnit& u, int wr, int wc, int fr, int fq) const {
        Pre q; const int row0 = u.row0 + wr * 64 + fr, col0 = u.col0 + wc * 32 + 4 * fq;
#pragma unroll
        for (int bj = 0; bj < 2; ++bj)
#pragma unroll
            for (int n = 0; n < 2; ++n) q.bv[bj][n] = *(const f32x4*)(bias + (size_t)u.aux * 1024 + col0 + bj * HALF + n * 16);
#pragma unroll
        for (int ai = 0; ai < 2; ++ai)
#pragma unroll
            for (int m = 0; m < 4; ++m) q.w[ai][m] = w_buf[row0 + ai * HALF + m * 16];
        return q;
    }
    __device__ __forceinline__ void operator()(const f32x4 (&acc)[2][2][4][2], const GUnit& u, int wr, int wc, int fr, int fq, const Pre& q) const {
        const int row0 = u.row0 + wr * 64 + fr, col0 = u.col0 + wc * 32 + 4 * fq;
        f32x4 bv[2][2];
#pragma unroll
        for (int bj = 0; bj < 2; ++bj)
#pragma unroll
            for (int n = 0; n < 2; ++n) bv[bj][n] = q.bv[bj][n];
#pragma unroll
        for (int ai = 0; ai < 2; ++ai)
#pragma unroll
            for (int m = 0; m < 4; ++m) {
                const int row = row0 + ai * HALF + m * 16;
                const float w = q.w[ai][m] * 8.f;
                unsigned d[4];
#pragma unroll
                for (int bj = 0; bj < 2; ++bj)
#pragma unroll
                    for (int n = 0; n < 2; ++n) {
                        const f32x2_t w2 = {w, w}, wi2 = {W8_INV, W8_INV};
                        const f32x2_t xl = __builtin_elementwise_fma((f32x2_t){acc[ai][bj][m][n][0], acc[ai][bj][m][n][1]}, wi2, (f32x2_t){bv[bj][n][0], bv[bj][n][1]}) * w2;
                        const f32x2_t xh = __builtin_elementwise_fma((f32x2_t){acc[ai][bj][m][n][2], acc[ai][bj][m][n][3]}, wi2, (f32x2_t){bv[bj][n][2], bv[bj][n][3]}) * w2;
                        d[bj * 2 + n] = pk4_fp8(xl[0], xl[1], xh[0], xh[1]);
                    }
                *(uint4*)(O + (size_t)row * 1024 + u.col0 + wc * 64 + fq * 16) = make_uint4(d[0], d[1], d[2], d[3]);
            }
    }
};
template <int NPN>
struct MoeOrderB {
    const char* A; const char* Bt; const int* tile_e; int nunits, G, c; size_t bt_expert_bytes; unsigned row_b;
    __device__ void init(const void* A_, const void* Bt_, const int* tile_e_, int ntiles, size_t bt_expert_bytes_, unsigned row_b_, int G_, int c_) { A = (const char*)A_; Bt = (const char*)Bt_; tile_e = tile_e_; nunits = ntiles * NPN; bt_expert_bytes = bt_expert_bytes_; row_b = row_b_; G = G_; c = c_; }
    __device__ bool next(int i, GUnit& u) const {
        const int cp = (G & 7) == 0 ? (c & 7) * (G >> 3) + (c >> 3) : c;
        const int L = i * G + cp; if (L >= nunits) return false;
        const int tl = L / NPN, pn = L % NPN, e = tile_e[tl];
        u.A = A + (size_t)tl * BM * row_b; u.B = Bt + (size_t)e * bt_expert_bytes + (size_t)pn * BM * row_b; u.row0 = tl * BM; u.col0 = pn * BM; u.aux = e; return true;
    }
};
}


__device__ __forceinline__ void posbias_wave(int n, int lane, const float* __restrict__ pos, const float* __restrict__ w1, const float* __restrict__ b1, float* __restrict__ b1p) {
    float acc = 0.f;
#pragma unroll
    for (int i = 0; i < 32; ++i) { const int k = lane + 64 * i; acc += pos[k] * w1[(size_t)k * 256 + n]; }
    acc = wave_sum(acc);
    if (lane == 0) b1p[n] = acc + b1[n];
}
__device__ __forceinline__ void p_cmp_finalize(char* lds, const float* __restrict__ Pab_k, const float* __restrict__ Pab_v, const float* __restrict__ b1p_k, const float* __restrict__ b1p_v,
                                               const float* __restrict__ w2k, const float* __restrict__ w2v, pg::bf16_t* __restrict__ kc, pg::bf16_t* __restrict__ vcT, int wg, int nwg) {
    const int lane = threadIdx.x & 63, wv = threadIdx.x >> 6;
    float* hs = (float*)lds + wv * 256;
    for (int it = wg * 8 + wv; it < 2 * 16 * 128; it += nwg * 8) {
        const int which = it >> 11, row = it & 2047, bg = row >> 7, c = row & 127;
        const float* P = which ? Pab_v : Pab_k; const float* bp = which ? b1p_v : b1p_k; const float* w2 = which ? w2v : w2k;
        float o = 0.f;
        if (c < 127) {
#pragma unroll
            for (int i = 0; i < 4; ++i) { const int n = lane + 64 * i; hs[n] = gelu_tanh(P[(size_t)row * 512 + n] + P[(size_t)(row + 1) * 512 + 256 + n] + bp[n]); }
            __builtin_amdgcn_s_waitcnt(0);
            for (int n0 = 0; n0 < 256; n0 += 16) {
                float wv[16];
#pragma unroll
                for (int j = 0; j < 16; ++j) wv[j] = w2[(n0 + j) * 64 + lane];
#pragma unroll
                for (int j = 0; j < 16; ++j) o += hs[n0 + j] * wv[j];
            }
        }
        if (which == 0) kc[(size_t)row * 64 + lane] = pg::f2bf(o); else vcT[((size_t)bg * 64 + lane) * 128 + c] = pg::f2bf(o);
    }
}

namespace at {
using pg::bf16_t;
typedef short bf16x8 __attribute__((ext_vector_type(8)));
typedef float f32x16 __attribute__((ext_vector_type(16)));
typedef float f32x4 __attribute__((ext_vector_type(4)));
constexpr int TROW = 144, TILE_B = 64 * TROW;
#define AT_MFMA(a, b, c) __builtin_amdgcn_mfma_f32_32x32x16_bf16(a, b, c, 0, 0, 0)
__device__ __forceinline__ bf16x8 pack8(const f32x16& p, int s8) {
    union { unsigned u[4]; bf16x8 v; } x;
#pragma unroll
    for (int i = 0; i < 4; ++i) x.u[i] = pg::cvt_pk_bf16(p[s8 + 2 * i], p[s8 + 2 * i + 1]);
    return x.v;
}
#define AT_MAX3(a, b, c) __builtin_fmaxf(__builtin_fmaxf((a), (b)), (c))
template <int MODE>
__device__ __forceinline__ void attn64_unit(char* lds, int b, int g, int tq, const bf16_t* __restrict__ Q, const bf16_t* __restrict__ Kh, const bf16_t* __restrict__ VT,
                                            const unsigned* __restrict__ selmask, bf16_t* __restrict__ out, const bf16_t* __restrict__ o_cmp, const bf16_t* __restrict__ o_win, const float* __restrict__ gates) {
    const int tid = opaque_tid(), lane = tid & 63, r32 = lane & 31, hi = lane >> 5;
    const int wid = __builtin_amdgcn_readfirstlane(tid >> 6), hl = wid >> 1, qs = wid & 1;
    const int ql = 32 * qs + r32, qpos = tq * 64 + ql, h = g * 4 + hl;
    const size_t trow = (size_t)b * S + qpos;
    const bf16_t* Kb = Kh + (size_t)(b * 2 + g) * S * 64;
    const bf16_t* Vb = VT + (size_t)(b * 2 + g) * 64 * S;
    const int srow = tid >> 3, sch = tid & 7;
    const int kst = srow * TROW + sch * 16;
    const int vst = TILE_B + srow * TROW + ((sch >> 1) * 16 + (sch & 1) * 4) * 2;
    bf16x8 qf[4];
#pragma unroll
    for (int d0 = 0; d0 < 4; ++d0) qf[d0] = *(const bf16x8*)(Q + trow * 512 + h * 64 + 16 * d0 + 8 * hi);
    unsigned msk = 0xffffffffu;
    if (MODE == 0) msk = selmask[(size_t)(b * 2 + g) * S + qpos];
    const int nt = (MODE == 0) ? tq + 1 : (tq < 8 ? tq + 1 : 9);
    f32x16 o0, o1;
#pragma unroll
    for (int r = 0; r < 16; ++r) { o0[r] = 0.f; o1[r] = 0.f; }
    float m = -INFINITY, l = 0.f;
    uint4 k1, v1, k2, v2;
    k1 = *(const uint4*)(Kb + (size_t)(tq * 64 + srow) * 64 + sch * 8); v1 = *(const uint4*)(Vb + (size_t)srow * S + tq * 64 + sch * 8);
    if (nt > 1) { k2 = *(const uint4*)(Kb + (size_t)((tq - 1) * 64 + srow) * 64 + sch * 8); v2 = *(const uint4*)(Vb + (size_t)srow * S + (tq - 1) * 64 + sch * 8); }
    __syncthreads();
    *(uint4*)(lds + kst) = k1; *(uint2*)(lds + vst) = make_uint2(v1.x, v1.y); *(uint2*)(lds + vst + 16) = make_uint2(v1.z, v1.w);
    asm volatile("" : "+v"(qf[0]), "+v"(qf[1]), "+v"(qf[2]), "+v"(qf[3]), "+v"(msk));
    __syncthreads();
    auto step = [&](int i, uint4& kA, uint4& vA, uint4& kB, uint4& vB) {
        if (i + 2 < nt) { const int tile = tq - i - 2; kB = *(const uint4*)(Kb + (size_t)(tile * 64 + srow) * 64 + sch * 8); vB = *(const uint4*)(Vb + (size_t)srow * S + tile * 64 + sch * 8); }
        const char* kb_ = lds + (i & 1) * 2 * TILE_B; const char* vb_ = kb_ + TILE_B;
        f32x16 p0, p1;
        bf16x8 kf[8], vf[8];
#pragma unroll
        for (int d0 = 0; d0 < 4; ++d0) { kf[2 * d0] = *(const bf16x8*)(kb_ + r32 * TROW + d0 * 32 + hi * 16); kf[2 * d0 + 1] = *(const bf16x8*)(kb_ + (32 + r32) * TROW + d0 * 32 + hi * 16); }
        asm volatile("s_waitcnt lgkmcnt(0)" ::: "memory");
#pragma unroll
        for (int ks = 0; ks < 4; ++ks) { vf[2 * ks] = *(const bf16x8*)(vb_ + r32 * TROW + ks * 32 + hi * 16); vf[2 * ks + 1] = *(const bf16x8*)(vb_ + (32 + r32) * TROW + ks * 32 + hi * 16); }
        {
            const f32x16 z16 = {0.f, 0.f, 0.f, 0.f, 0.f, 0.f, 0.f, 0.f, 0.f, 0.f, 0.f, 0.f, 0.f, 0.f, 0.f, 0.f};
            p0 = AT_MFMA(kf[0], qf[0], z16); p1 = AT_MFMA(kf[1], qf[0], z16);
        }
#pragma unroll
        for (int d0 = 1; d0 < 4; ++d0) { p0 = AT_MFMA(kf[2 * d0], qf[d0], p0); p1 = AT_MFMA(kf[2 * d0 + 1], qf[d0], p1); }
        asm volatile("s_nop 15\n\ts_nop 7" : "+v"(p0), "+v"(p1));
        float mx;
        asm volatile("v_max3_f32 %0, %1, %2, %3" : "=v"(mx) : "v"(p0[0]), "v"(p1[0]), "v"(p0[1]));
        asm volatile("v_max3_f32 %0, %1, %2, %3" : "=v"(mx) : "v"(mx), "v"(p1[1]), "v"(p0[2]));
#pragma unroll
        for (int r = 2; r < 15; ++r) asm volatile("v_max3_f32 %0, %1, %2, %3" : "=v"(mx) : "v"(mx), "v"(p1[r]), "v"(p0[r + 1]));
        asm volatile("v_max3_f32 %0, %1, %2, %3" : "=v"(mx) : "v"(mx), "v"(p1[15]), "v"(p1[15]));
        mx = fmaxf(mx, lane_xor32(mx));
        if (i == 0) m = mx;
        else if (__builtin_amdgcn_ballot_w64(mx > m + 8.f) != 0ull) {
            const float mn = fmaxf(m, mx), alpha = __builtin_amdgcn_exp2f(m - mn);
            m = mn; l *= alpha;
#pragma unroll
            for (int r = 0; r < 16; ++r) { o0[r] *= alpha; o1[r] *= alpha; }
        }
        f32x16 e0, e1;
#pragma unroll
        for (int r = 0; r < 16; ++r) { e0[r] = __builtin_amdgcn_exp2f(p0[r] - m); e1[r] = __builtin_amdgcn_exp2f(p1[r] - m); }
        if (i == 0) {
#pragma unroll
            for (int r = 0; r < 16; ++r) { const int kl = (r & 3) + 8 * (r >> 2) + 4 * hi; if (kl > ql) e0[r] = 0.f; if (kl + 32 > ql) e1[r] = 0.f; }
        } else if (MODE == 1) {
            if (i == 8) {
#pragma unroll
                for (int r = 0; r < 16; ++r) { const int kl = (r & 3) + 8 * (r >> 2) + 4 * hi; if (kl <= ql) e0[r] = 0.f; if (kl + 32 <= ql) e1[r] = 0.f; }
            }
        } else {
            const float f = ((msk >> (tq - i)) & 1u) ? 1.f : 0.f;
            e0 *= f; e1 *= f;
        }
        float ls = 0.f;
#pragma unroll
        for (int r = 0; r < 16; ++r) ls += e0[r] + e1[r];
        p0 = e0; p1 = e1;
        l += ls;
        bf16x8 pb[4];
        pb[0] = pack8(p0, 0); pb[1] = pack8(p0, 8); pb[2] = pack8(p1, 0); pb[3] = pack8(p1, 8);
        asm volatile("s_waitcnt lgkmcnt(0)" ::: "memory");
#pragma unroll
        for (int ks = 0; ks < 4; ++ks) { o0 = AT_MFMA(vf[2 * ks], pb[ks], o0); o1 = AT_MFMA(vf[2 * ks + 1], pb[ks], o1); }
        if (i + 1 < nt) {
            char* nb = lds + ((i + 1) & 1) * 2 * TILE_B;
            *(uint4*)(nb + kst) = kA; *(uint2*)(nb + vst) = make_uint2(vA.x, vA.y); *(uint2*)(nb + vst + 16) = make_uint2(vA.z, vA.w);
        }
        __syncthreads();
    };
    for (int i = 0; i < nt; i += 2) {
        step(i, k2, v2, k1, v1);
        if (i + 1 < nt) step(i + 1, k1, v1, k2, v2);
    }
    const float lt = l + lane_xor32(l), inv = 1.f / lt;
    const size_t obase = trow * 512 + h * 64 + 8 * hi;
    float g0 = 0.f, g1 = inv, g2 = 0.f;
    uint4 cc[2][2], ww[2][2];
    if (MODE == 0) {
        g0 = gates[trow * 24 + h * 3 + 0]; g1 = gates[trow * 24 + h * 3 + 1] * inv; g2 = gates[trow * 24 + h * 3 + 2];
#pragma unroll
        for (int dh = 0; dh < 2; ++dh)
#pragma unroll
            for (int rp = 0; rp < 2; ++rp) { cc[dh][rp] = *(const uint4*)(o_cmp + obase + 32 * dh + 16 * rp); ww[dh][rp] = *(const uint4*)(o_win + obase + 32 * dh + 16 * rp); }
    }
#pragma unroll
    for (int dh = 0; dh < 2; ++dh)
#pragma unroll
        for (int rp = 0; rp < 2; ++rp) {
            const f32x16& oo = dh ? o1 : o0;
            float x[8];
#pragma unroll
            for (int j = 0; j < 4; ++j) {
                const auto r = __builtin_amdgcn_permlane32_swap(__float_as_uint(oo[8 * rp + j]), __float_as_uint(oo[8 * rp + 4 + j]), false, false);
                x[j] = __uint_as_float(r[0]) * g1; x[4 + j] = __uint_as_float(r[1]) * g1;
            }
            if (MODE == 0) {
                const unsigned cw[4] = {cc[dh][rp].x, cc[dh][rp].y, cc[dh][rp].z, cc[dh][rp].w}, wv[4] = {ww[dh][rp].x, ww[dh][rp].y, ww[dh][rp].z, ww[dh][rp].w};
#pragma unroll
                for (int k = 0; k < 4; ++k) {
                    x[2 * k] += g0 * __uint_as_float(cw[k] << 16) + g2 * __uint_as_float(wv[k] << 16);
                    x[2 * k + 1] += g0 * __uint_as_float(cw[k] & 0xffff0000u) + g2 * __uint_as_float(wv[k] & 0xffff0000u);
                }
            }
            uint4 o; o.x = pg::cvt_pk_bf16(x[0], x[1]); o.y = pg::cvt_pk_bf16(x[2], x[3]); o.z = pg::cvt_pk_bf16(x[4], x[5]); o.w = pg::cvt_pk_bf16(x[6], x[7]);
            *(uint4*)(out + obase + 32 * dh + 16 * rp) = o;
        }
}

constexpr int CK_ROW = 144, CV_ROW = 272, CK_B = 128 * CK_ROW, CV_B = 64 * CV_ROW, CP_OFF = CK_B + CV_B, CI_OFF = CP_OFF + 4 * 64 * 32 * 4, CMP_LDS = CI_OFF + 64 * 32 * 8;
__device__ __forceinline__ void cmp_unit(char* lds, int b, int g, int tq, const bf16_t* __restrict__ Q, const bf16_t* __restrict__ kc, const bf16_t* __restrict__ vcT,
                                         bf16_t* __restrict__ out, unsigned* __restrict__ selmask) {
    const int tid = opaque_tid(), lane = tid & 63, r32 = lane & 31, hi = lane >> 5;
    const int wid = __builtin_amdgcn_readfirstlane(tid >> 6), hl = wid >> 1, qs = wid & 1;
    const int ql = 32 * qs + r32, qpos = tq * 64 + ql, h = g * 4 + hl, bg = b * 2 + g;
    const size_t trow = (size_t)b * S + qpos;
    __syncthreads();
#pragma unroll
    for (int i = 0; i < 2; ++i) {
        const int ch = tid + 512 * i;
        { const int row = ch >> 3, c8 = ch & 7; *(uint4*)(lds + row * CK_ROW + c8 * 16) = *(const uint4*)(kc + ((size_t)bg * 128 + row) * 64 + c8 * 8); }
        { const int row = ch >> 4, c16 = ch & 15; const uint4 x = *(const uint4*)(vcT + ((size_t)bg * 64 + row) * 128 + c16 * 8);
          char* dst = lds + CK_B + row * CV_ROW + ((c16 >> 1) * 16 + (c16 & 1) * 4) * 2; *(uint2*)dst = make_uint2(x.x, x.y); *(uint2*)(dst + 16) = make_uint2(x.z, x.w); }
    }
    bf16x8 qf[4];
#pragma unroll
    for (int d0 = 0; d0 < 4; ++d0) qf[d0] = *(const bf16x8*)(Q + trow * 512 + h * 64 + 16 * d0 + 8 * hi);
    __syncthreads();
    f32x16 p[4];
#pragma unroll
    for (int kh = 0; kh < 4; ++kh) {
#pragma unroll
        for (int r = 0; r < 16; ++r) p[kh][r] = 0.f;
#pragma unroll
        for (int d0 = 0; d0 < 4; ++d0) { const bf16x8 kf = *(const bf16x8*)(lds + (32 * kh + r32) * CK_ROW + d0 * 32 + hi * 16); p[kh] = AT_MFMA(kf, qf[d0], p[kh]); }
    }
    float mx = -1e30f;
#pragma unroll
    for (int kh = 0; kh < 4; ++kh)
#pragma unroll
        for (int r = 0; r < 16; ++r) { const int c = 32 * kh + (r & 3) + 8 * (r >> 2) + 4 * hi; if (16 * c + 31 > qpos) p[kh][r] = -1e30f; mx = fmaxf(mx, p[kh][r]); }
    mx = fmaxf(mx, lane_xor32(mx));
    float ls = 0.f;
#pragma unroll
    for (int kh = 0; kh < 4; ++kh)
#pragma unroll
        for (int r = 0; r < 16; ++r) { p[kh][r] = __builtin_amdgcn_exp2f(p[kh][r] - mx); ls += p[kh][r]; }
    ls += lane_xor32(ls);
    const float inv = (mx > -1e29f) ? 1.f / ls : 0.f;
#pragma unroll
    for (int kh = 0; kh < 4; ++kh)
#pragma unroll
        for (int r = 0; r < 16; ++r) p[kh][r] *= inv;
    f32x16 o0, o1;
#pragma unroll
    for (int r = 0; r < 16; ++r) { o0[r] = 0.f; o1[r] = 0.f; }
#pragma unroll
    for (int ks = 0; ks < 8; ++ks) {
        const bf16x8 pb = pack8(p[ks >> 1], (ks & 1) * 8);
        const bf16x8 vf0 = *(const bf16x8*)(lds + CK_B + r32 * CV_ROW + ks * 32 + hi * 16), vf1 = *(const bf16x8*)(lds + CK_B + (32 + r32) * CV_ROW + ks * 32 + hi * 16);
        o0 = AT_MFMA(vf0, pb, o0); o1 = AT_MFMA(vf1, pb, o1);
    }
    bf16_t* orow = out + trow * 512 + h * 64 + 8 * hi;
#pragma unroll
    for (int dh = 0; dh < 2; ++dh)
#pragma unroll
        for (int rp = 0; rp < 2; ++rp) {
            const f32x16& oo = dh ? o1 : o0;
            const unsigned ax = pg::cvt_pk_bf16_acc(oo[8 * rp], oo[8 * rp + 1]), ay = pg::cvt_pk_bf16_acc(oo[8 * rp + 2], oo[8 * rp + 3]);
            const unsigned bx = pg::cvt_pk_bf16_acc(oo[8 * rp + 4], oo[8 * rp + 5]), by = pg::cvt_pk_bf16_acc(oo[8 * rp + 6], oo[8 * rp + 7]);
            const auto rx = __builtin_amdgcn_permlane32_swap(ax, bx, false, false);
            const auto ry = __builtin_amdgcn_permlane32_swap(ay, by, false, false);
            *(uint4*)(orow + 32 * dh + 16 * rp) = make_uint4(rx[0], ry[0], rx[1], ry[1]);
        }
    float inn[16], car[16];
#pragma unroll
    for (int t = 0; t < 16; ++t) { const f32x16& pk = p[t >> 2]; const int r0 = 4 * (t & 3); car[t] = 0.5f * pk[r0 + 3]; inn[t] = pk[r0] + pk[r0 + 1] + pk[r0 + 2] + car[t]; }
    float* part = (float*)(lds + CP_OFF) + (hl * 64 + ql) * 32;
#pragma unroll
    for (int t = 0; t < 16; ++t) {
        const float co = lane_xor32(car[t]);
        const float cprev = t > 0 ? lane_xor32(car[t - 1]) : 0.f;
        part[2 * t + hi] = inn[t] + (hi ? co : cprev);
    }
    __syncthreads();
    unsigned long long* impk = (unsigned long long*)(lds + CI_OFF);
    const float* pall = (const float*)(lds + CP_OFF);
#pragma unroll
    for (int k = 0; k < 4; ++k) {
        const int idx = tid + 512 * k, q = idx >> 5, j = idx & 31, cur = tq;
        float imp = ((pall[(0 * 64 + q) * 32 + j] + pall[(1 * 64 + q) * 32 + j]) + pall[(2 * 64 + q) * 32 + j]) + pall[(3 * 64 + q) * 32 + j];
        if (j == 0 || j == cur || j == cur - 1) imp = 1e30f; else if (j > cur) imp = -1e30f;
        const unsigned bb = __float_as_uint(imp), uo = (bb & 0x80000000u) ? ~bb : (bb | 0x80000000u);
        impk[idx] = ((unsigned long long)uo << 5) | (unsigned)(31 - j);
    }
    __syncthreads();
#pragma unroll
    for (int k = 0; k < 4; ++k) {
        const int idx = tid + 512 * k, q = idx >> 5;
        const unsigned long long mine = impk[idx];
        int rank = 0;
#pragma unroll
        for (int i = 0; i < 32; ++i) rank += (impk[q * 32 + i] > mine) ? 1 : 0;
        const unsigned long long bal = __ballot(rank < 16);
        if ((lane & 31) == 0) selmask[(size_t)bg * S + tq * 64 + q] = (unsigned)(hi ? (bal >> 32) : (bal & 0xffffffffull));
    }
}

constexpr int XK_ROW = 528, XV_ROW = 144, XK_B = 64 * XK_ROW, XV_B = 256 * XV_ROW;
typedef float f32x4v __attribute__((ext_vector_type(4)));
#define XT_MFMA(a, b, c) __builtin_amdgcn_mfma_f32_16x16x32_bf16(a, b, c, 0, 0, 0)
__device__ __forceinline__ void xattn_unit(char* lds, int b, int h, int qt, const bf16_t* __restrict__ Q, const bf16_t* __restrict__ xk, const bf16_t* __restrict__ xvT, unsigned char* __restrict__ out) {
    const int tid = opaque_tid(), lane = tid & 63, l15 = lane & 15, quad = lane >> 4;
    const int wid = __builtin_amdgcn_readfirstlane(tid >> 6);
    const size_t trow = (size_t)b * S + qt * 128 + wid * 16 + l15;
    const bf16_t* Kb = xk + (size_t)(b * 4 + h) * 256 * 256;
    const bf16_t* Vb = xvT + (size_t)(b * 4 + h) * 256 * 256;
    bf16x8 qf[8];
#pragma unroll
    for (int ds = 0; ds < 8; ++ds) qf[ds] = *(const bf16x8*)(Q + trow * 1024 + h * 256 + 32 * ds + 8 * quad);
    f32x4v o[16];
#pragma unroll
    for (int db = 0; db < 16; ++db) o[db] = (f32x4v){0.f, 0.f, 0.f, 0.f};
    float m = -INFINITY, l = 0.f;
    constexpr int XIMG = XK_B + XV_B;
    for (int kt2 = 0; kt2 < 2; ++kt2) {
        __syncthreads();
        uint4 kx[2][4], vx[2][4];
#pragma unroll
        for (int hf = 0; hf < 2; ++hf)
#pragma unroll
            for (int i = 0; i < 4; ++i) {
                const int ch = tid + 512 * i, kt = 2 * kt2 + hf;
                kx[hf][i] = *(const uint4*)(Kb + (size_t)(kt * 64 + (ch >> 5)) * 256 + (ch & 31) * 8);
                vx[hf][i] = *(const uint4*)(Vb + (size_t)(ch >> 3) * 256 + kt * 64 + (ch & 7) * 8);
            }
#pragma unroll
        for (int hf = 0; hf < 2; ++hf)
#pragma unroll
            for (int i = 0; i < 4; ++i) {
                const int ch = tid + 512 * i;
                char* Lw = lds + hf * XIMG;
                { const int row = ch >> 5, c = ch & 31; *(uint4*)(Lw + row * XK_ROW + c * 16) = kx[hf][i]; }
                { const int row = ch >> 3, c = ch & 7, cp = c & 3; const uint4 x = vx[hf][i];
                  char* dst = Lw + XK_B + row * XV_ROW + ((c >> 2) * 32 + 16 * (cp & 1) + 4 * (cp >> 1)) * 2; *(uint2*)dst = make_uint2(x.x, x.y); *(uint2*)(dst + 16) = make_uint2(x.z, x.w); }
            }
        __syncthreads();
      for (int hf = 0; hf < 2; ++hf) {
        const char* L = lds + hf * XIMG;
        f32x4v sc[4];
#pragma unroll
        for (int kb = 0; kb < 4; ++kb) {
            sc[kb] = (f32x4v){0.f, 0.f, 0.f, 0.f};
#pragma unroll
            for (int ds = 0; ds < 8; ++ds) { const bf16x8 kf = *(const bf16x8*)(L + (16 * kb + l15) * XK_ROW + ds * 64 + quad * 16); sc[kb] = XT_MFMA(kf, qf[ds], sc[kb]); }
        }
        float mx = -INFINITY;
#pragma unroll
        for (int kb = 0; kb < 4; ++kb)
#pragma unroll
            for (int r = 0; r < 4; ++r) mx = fmaxf(mx, sc[kb][r]);
        mx = fmaxf(mx, lane_xor16(mx)); mx = fmaxf(mx, lane_xor32(mx));
        const float mn = fmaxf(m, mx), alpha = __builtin_amdgcn_exp2f(m - mn);
        m = mn;
        float ls = 0.f;
#pragma unroll
        for (int kb = 0; kb < 4; ++kb)
#pragma unroll
            for (int r = 0; r < 4; ++r) { sc[kb][r] = __builtin_amdgcn_exp2f(sc[kb][r] - mn); ls += sc[kb][r]; }
        l = l * alpha + ls;
#pragma unroll
        for (int db = 0; db < 16; ++db) o[db] *= alpha;
#pragma unroll
        for (int k2 = 0; k2 < 2; ++k2) {
            union { unsigned u[4]; bf16x8 v; } pb;
            pb.u[0] = pg::cvt_pk_bf16(sc[2 * k2][0], sc[2 * k2][1]); pb.u[1] = pg::cvt_pk_bf16(sc[2 * k2][2], sc[2 * k2][3]);
            pb.u[2] = pg::cvt_pk_bf16(sc[2 * k2 + 1][0], sc[2 * k2 + 1][1]); pb.u[3] = pg::cvt_pk_bf16(sc[2 * k2 + 1][2], sc[2 * k2 + 1][3]);
#pragma unroll
            for (int db = 0; db < 16; ++db) { const bf16x8 vf = *(const bf16x8*)(L + XK_B + (16 * db + l15) * XV_ROW + k2 * 64 + quad * 16); o[db] = XT_MFMA(vf, pb.v, o[db]); }
        }
          }
    }
    l += lane_xor16(l); l += lane_xor32(l);
    const float inv = 1.f / l;
    unsigned char* orow = out + trow * 1024 + h * 256 + 16 * quad;
    const float inv16 = inv * 16.f;
#pragma unroll
    for (int s4 = 0; s4 < 4; ++s4) {
        unsigned d[4];
#pragma unroll
        for (int dl = 0; dl < 4; ++dl) { const int db = 4 * s4 + dl; d[dl] = pg::pk4_fp8(o[db][0] * inv16, o[db][1] * inv16, o[db][2] * inv16, o[db][3] * inv16); }
        *(uint4*)(orow + 64 * s4) = make_uint4(d[0], d[1], d[2], d[3]);
    }
}
}


namespace tl {
using pg::bf16_t; using pg::cvt_pk_bf16;
__device__ __forceinline__ float blo(unsigned u) { return __uint_as_float(u << 16); }
__device__ __forceinline__ float bhi(unsigned u) { return __uint_as_float(u & 0xffff0000u); }
__device__ __forceinline__ float ssq4(const float4& a) { return a.x * a.x + a.y * a.y + a.z * a.z + a.w * a.w; }

__device__ __forceinline__ void rmsnorm_rows(const float* __restrict__ in, const float* __restrict__ g, bf16_t* __restrict__ out, int rows, int gw, int nw, int lane) {
    float4 gv[4];
#pragma unroll
    for (int i = 0; i < 4; ++i) gv[i] = *(const float4*)(g + 256 * i + 4 * lane);
    for (int rb = gw; rb < rows; rb += 8 * nw) {
        float4 a[8][4];
#pragma unroll
        for (int j = 0; j < 8; ++j)
#pragma unroll
            for (int i = 0; i < 4; ++i) a[j][i] = (rb + nw * j < rows) ? *(const float4*)(in + (size_t)(rb + nw * j) * 1024 + 256 * i + 4 * lane) : make_float4(0.f, 0.f, 0.f, 0.f);
        asm volatile("" ::: "memory");
#pragma unroll
        for (int j = 0; j < 8; ++j) {
            const int r = rb + nw * j;
            float sa = ssq4(a[j][0]) + ssq4(a[j][1]) + ssq4(a[j][2]) + ssq4(a[j][3]);
            sa = wave_sum(sa);
            const float ra = rsqrtf(sa * (1.f / 1024.f) + 1e-5f);
            if (r < rows) {
#pragma unroll
                for (int i = 0; i < 4; ++i) {
                    uint2 o; o.x = cvt_pk_bf16(a[j][i].x * ra * gv[i].x, a[j][i].y * ra * gv[i].y); o.y = cvt_pk_bf16(a[j][i].z * ra * gv[i].z, a[j][i].w * ra * gv[i].w);
                    *(uint2*)(out + (size_t)r * 1024 + 256 * i + 4 * lane) = o;
                }
            }
        }
    }
}

__device__ __forceinline__ void mix_post(const bf16_t* __restrict__ o_nsa, const bf16_t* __restrict__ ub, const bf16_t* __restrict__ cbb, const float* __restrict__ conv_w,
                                         const float* __restrict__ g_nsa, const float* __restrict__ g_conv, bf16_t* __restrict__ omix, int gw, int nw, int lane) {
    float cw[3][8], gn[8], gc[8];
#pragma unroll
    for (int j = 0; j < 8; ++j) { gn[j] = g_nsa[8 * lane + j]; gc[j] = g_conv[8 * lane + j]; cw[0][j] = conv_w[8 * lane + j]; cw[1][j] = conv_w[512 + 8 * lane + j]; cw[2][j] = conv_w[1024 + 8 * lane + j]; }
    for (int tb = gw; tb < T; tb += 4 * nw) {
      const uint4 zero = make_uint4(0u, 0u, 0u, 0u);
      uint4 L_on[4], L_c[4], L_u2[4], L_u1[4], L_u0[4];
#pragma unroll
      for (int j = 0; j < 4; ++j) {
        const int t = min(tb + nw * j, T - 1), sq = t & (S - 1);
        L_on[j] = *(const uint4*)(o_nsa + (size_t)t * 512 + 8 * lane); L_c[j] = *(const uint4*)(cbb + (size_t)t * 512 + 8 * lane); L_u2[j] = *(const uint4*)(ub + (size_t)t * 512 + 8 * lane);
        L_u1[j] = *(const uint4*)(ub + (size_t)(t - (sq >= 1 ? 1 : 0)) * 512 + 8 * lane); L_u0[j] = *(const uint4*)(ub + (size_t)(t - (sq >= 2 ? 2 : 0)) * 512 + 8 * lane);
        if (sq < 1) L_u1[j] = zero;
        if (sq < 2) L_u0[j] = zero;
      }
      asm volatile("" ::: "memory");
#pragma unroll
      for (int j = 0; j < 4; ++j) {
        const int t = tb + nw * j;
        if (t < T) {
        const uint4 on4 = L_on[j], c4 = L_c[j], u2 = L_u2[j], u1 = L_u1[j], u0 = L_u0[j];
        const unsigned onw[4] = {on4.x, on4.y, on4.z, on4.w}, cbw[4] = {c4.x, c4.y, c4.z, c4.w}, u0w[4] = {u0.x, u0.y, u0.z, u0.w}, u1w[4] = {u1.x, u1.y, u1.z, u1.w}, u2w[4] = {u2.x, u2.y, u2.z, u2.w};
        float on[8], oc[8], ssn = 0.f, ssc = 0.f;
#pragma unroll
        for (int q = 0; q < 4; ++q) {
            on[2 * q] = blo(onw[q]); on[2 * q + 1] = bhi(onw[q]);
            const float y0 = cw[0][2 * q] * blo(u0w[q]) + cw[1][2 * q] * blo(u1w[q]) + cw[2][2 * q] * blo(u2w[q]);
            const float y1 = cw[0][2 * q + 1] * bhi(u0w[q]) + cw[1][2 * q + 1] * bhi(u1w[q]) + cw[2][2 * q + 1] * bhi(u2w[q]);
            oc[2 * q] = blo(cbw[q]) * y0; oc[2 * q + 1] = bhi(cbw[q]) * y1;
        }
#pragma unroll
        for (int j = 0; j < 8; ++j) { ssn += on[j] * on[j]; ssc += oc[j] * oc[j]; }
        ssn = wave_sum(ssn); ssc = wave_sum(ssc);
        const float rn = rsqrtf(ssn * (1.f / 512.f) + 1e-5f), rc = rsqrtf(ssc * (1.f / 512.f) + 1e-5f);
        uint4 o1, o2;
        o1.x = cvt_pk_bf16(on[0] * rn * gn[0], on[1] * rn * gn[1]); o1.y = cvt_pk_bf16(on[2] * rn * gn[2], on[3] * rn * gn[3]); o1.z = cvt_pk_bf16(on[4] * rn * gn[4], on[5] * rn * gn[5]); o1.w = cvt_pk_bf16(on[6] * rn * gn[6], on[7] * rn * gn[7]);
        o2.x = cvt_pk_bf16(oc[0] * rc * gc[0], oc[1] * rc * gc[1]); o2.y = cvt_pk_bf16(oc[2] * rc * gc[2], oc[3] * rc * gc[3]); o2.z = cvt_pk_bf16(oc[4] * rc * gc[4], oc[5] * rc * gc[5]); o2.w = cvt_pk_bf16(oc[6] * rc * gc[6], oc[7] * rc * gc[7]);
        *(uint4*)(omix + (size_t)t * 1024 + 8 * lane) = o1; *(uint4*)(omix + (size_t)t * 1024 + 512 + 8 * lane) = o2;
        }
      }
    }
}

__device__ __forceinline__ void xreduce32(float (&acc)[32], int lane) {
    const bool b3 = lane & 8, b2 = lane & 4, b1 = lane & 2;
#pragma unroll
    for (int e = 0; e < 16; ++e) { const auto r = __builtin_amdgcn_permlane32_swap(__float_as_uint(acc[e]), __float_as_uint(acc[e + 16]), false, false); acc[e] = __uint_as_float(r[0]) + __uint_as_float(r[1]); }
#pragma unroll
    for (int e = 0; e < 8; ++e) { const auto r = __builtin_amdgcn_permlane16_swap(__float_as_uint(acc[e]), __float_as_uint(acc[e + 8]), false, false); acc[e] = __uint_as_float(r[0]) + __uint_as_float(r[1]); }
#pragma unroll
    for (int e = 0; e < 4; ++e) { const float snd = b3 ? acc[e] : acc[e + 4], kp = b3 ? acc[e + 4] : acc[e]; acc[e] = kp + dpp_xor8(snd); }
#pragma unroll
    for (int e = 0; e < 2; ++e) { const float snd = b2 ? acc[e] : acc[e + 2], kp = b2 ? acc[e + 2] : acc[e]; acc[e] = kp + dpp_xor4(snd); }
    { const float snd = b1 ? acc[0] : acc[1], kp = b1 ? acc[1] : acc[0]; acc[0] = kp + dpp_xor2(snd); }
    acc[0] += dpp_xor1(acc[0]);
}
__device__ __forceinline__ void route_token(float logit, int t, int lane, int* __restrict__ a_e, float* __restrict__ a_w, int* __restrict__ a_slot, int* lcnt) {
    const int e = lane >> 1;
    int rank = 0;
#pragma unroll
    for (int i = 0; i < 32; ++i) { const float x = __int_as_float(__builtin_amdgcn_readlane(__float_as_int(logit), 2 * i)); rank += (x > logit || (x == logit && i < e)) ? 1 : 0; }
    const float vmax = wave_max(logit);
    const bool sel = (rank < TOPK) && !(lane & 1);
    const float ex = sel ? __expf(logit - vmax) : 0.f;
    const float sum = wave_sum(ex);
    if (sel) { const int a = t * TOPK + rank; a_e[a] = e; a_w[a] = ex / sum; a_slot[a] = atomicAdd(&lcnt[e], 1); }
}
constexpr int WR_STRIDE = 1028;
constexpr int RW_ROW = 2064;
constexpr int RW_IMG = NE * RW_ROW;
__device__ __forceinline__ void norm_router(char* lds, const bf16_t* __restrict__ h2, const float* __restrict__ g, const float* __restrict__ wr, const float* __restrict__ br, unsigned char* __restrict__ xn8,
                                            int* __restrict__ a_e, float* __restrict__ a_w, int* __restrict__ a_slot, int* __restrict__ wgcnt  , int gw, int nw, int lane) {
    typedef short rbf16x8 __attribute__((ext_vector_type(8)));
    typedef float rf32x4 __attribute__((ext_vector_type(4)));
    int* lcnt = (int*)(lds + 2 * RW_IMG);
    float* wlog = (float*)(lds + 2 * RW_IMG + 128) + (threadIdx.x >> 6) * 272;
    __syncthreads();
    {
        constexpr int NP = (2 * RW_IMG / 16 + 511) / 512;
        uint4 st[NP];
#pragma unroll
        for (int i = 0; i < NP; ++i) { const int idx = (int)threadIdx.x + 512 * i; st[i] = idx < 2 * RW_IMG / 16 ? ((const uint4*)wr)[idx] : make_uint4(0u, 0u, 0u, 0u); }
#pragma unroll
        for (int i = 0; i < NP; ++i) { const int idx = (int)threadIdx.x + 512 * i; if (idx < 2 * RW_IMG / 16) ((uint4*)lds)[idx] = st[i]; }
    }
    if (threadIdx.x < NE) lcnt[threadIdx.x] = 0;
    const int l15 = lane & 15, quad = lane >> 4;
    int tb = gw;
    do {
        const int trow = tb + nw * (l15 & 7);
        const bool valid = l15 < 8 && trow < T;
        rbf16x8 af[32];
        const bf16_t* ap = h2 + (size_t)(valid ? trow : tb) * 1024 + 8 * quad;
#pragma unroll
        for (int ks = 0; ks < 32; ++ks) { const uint4 v = valid ? *(const uint4*)(ap + 32 * ks) : make_uint4(0u, 0u, 0u, 0u); af[ks] = __builtin_bit_cast(rbf16x8, v); }
        if (tb == gw) __syncthreads();
        rf32x4 acc0 = {0.f, 0.f, 0.f, 0.f}, acc1 = acc0, accs = acc0;
        const char* bh = lds + l15 * RW_ROW + quad * 16;
        rbf16x8 bq[2][4];
        bq[0][0] = *(const rbf16x8*)(bh); bq[0][1] = *(const rbf16x8*)(bh + 16 * RW_ROW); bq[0][2] = *(const rbf16x8*)(bh + RW_IMG); bq[0][3] = *(const rbf16x8*)(bh + RW_IMG + 16 * RW_ROW);
#pragma unroll
        for (int ks = 0; ks < 32; ++ks) {
            if (ks + 1 < 32) {
                const int o = (ks + 1) * 64;
                bq[(ks + 1) & 1][0] = *(const rbf16x8*)(bh + o); bq[(ks + 1) & 1][1] = *(const rbf16x8*)(bh + 16 * RW_ROW + o);
                bq[(ks + 1) & 1][2] = *(const rbf16x8*)(bh + RW_IMG + o); bq[(ks + 1) & 1][3] = *(const rbf16x8*)(bh + RW_IMG + 16 * RW_ROW + o);
            }
            acc0 = __builtin_amdgcn_mfma_f32_16x16x32_bf16(af[ks], bq[ks & 1][0], acc0, 0, 0, 0); acc1 = __builtin_amdgcn_mfma_f32_16x16x32_bf16(af[ks], bq[ks & 1][1], acc1, 0, 0, 0);
            acc0 = __builtin_amdgcn_mfma_f32_16x16x32_bf16(af[ks], bq[ks & 1][2], acc0, 0, 0, 0); acc1 = __builtin_amdgcn_mfma_f32_16x16x32_bf16(af[ks], bq[ks & 1][3], acc1, 0, 0, 0);
            accs = __builtin_amdgcn_mfma_f32_16x16x32_bf16(af[ks], af[ks], accs, 0, 0, 0);
        }
        {
            const int rsel = l15 & 3;
            const float dg = rsel == 0 ? accs[0] : rsel == 1 ? accs[1] : rsel == 2 ? accs[2] : accs[3];
            if (quad == (l15 >> 2)) wlog[256 + l15] = rsqrtf(dg * (1.f / 1024.f) + 1e-5f);
        }
        __builtin_amdgcn_fence(__ATOMIC_RELEASE, "wavefront"); __builtin_amdgcn_s_waitcnt(0xc07f);
        if (quad < 2) {
            const rf32x4 rs4 = *(const rf32x4*)(wlog + 256 + 4 * quad);
            const float b0 = br[l15], b1 = br[16 + l15];
#pragma unroll
            for (int r = 0; r < 4; ++r) { wlog[(4 * quad + r) * 32 + l15] = rs4[r] * acc0[r] + b0; wlog[(4 * quad + r) * 32 + 16 + l15] = rs4[r] * acc1[r] + b1; }
        }
        __builtin_amdgcn_fence(__ATOMIC_RELEASE, "wavefront"); __builtin_amdgcn_s_waitcnt(0xc07f);
        float4 gv[4];
#pragma unroll
        for (int i = 0; i < 4; ++i) gv[i] = *(const float4*)(g + 256 * i + 4 * lane);
        uint2 hv[8][4];
#pragma unroll
        for (int j = 0; j < 8; ++j)
#pragma unroll
            for (int i = 0; i < 4; ++i) hv[j][i] = *(const uint2*)(h2 + (size_t)min(tb + nw * j, T - 1) * 1024 + 256 * i + 4 * lane);
        asm volatile("" ::: "memory");
        const bool full = tb + 7 * nw < T;
        if (full) {
            float rsv[8];
#pragma unroll
            for (int j = 0; j < 8; ++j) rsv[j] = wlog[256 + j];
#pragma unroll
            for (int j = 0; j < 8; ++j)
#pragma unroll
                for (int i = 0; i < 4; ++i)
                    *(unsigned*)(xn8 + (size_t)(tb + nw * j) * 1024 + 256 * i + 4 * lane) = pg::pk4_fp8(blo(hv[j][i].x) * rsv[j] * gv[i].x, bhi(hv[j][i].x) * rsv[j] * gv[i].y, blo(hv[j][i].y) * rsv[j] * gv[i].z, bhi(hv[j][i].y) * rsv[j] * gv[i].w);
        } else {
#pragma unroll
            for (int j = 0; j < 8; ++j) {
                const int t = tb + nw * j;
                if (t < T) {
                    const float rs = wlog[256 + j];
#pragma unroll
                    for (int i = 0; i < 4; ++i)
                        *(unsigned*)(xn8 + (size_t)t * 1024 + 256 * i + 4 * lane) = pg::pk4_fp8(blo(hv[j][i].x) * rs * gv[i].x, bhi(hv[j][i].x) * rs * gv[i].y, blo(hv[j][i].y) * rs * gv[i].z, bhi(hv[j][i].y) * rs * gv[i].w);
                }
            }
        }
        {
            const int j = lane >> 3, sub = lane & 7, t = tb + nw * j;
            const rf32x4 own = *(const rf32x4*)(wlog + j * 32 + 4 * sub);
            float v[4] = {own[0], own[1], own[2], own[3]};
            float bv[4]; int bi[4];
#pragma unroll
            for (int r = 0; r < 4; ++r) {
                float cv = v[0]; int ci = 4 * sub;
#pragma unroll
                for (int k = 1; k < 4; ++k) { const bool tk = v[k] > cv; cv = tk ? v[k] : cv; ci = tk ? 4 * sub + k : ci; }
                { const float ov = dpp_xor1(cv); const int oi = __float_as_int(dpp_xor1(__int_as_float(ci))); const bool tk = ov > cv || (ov == cv && oi < ci); cv = tk ? ov : cv; ci = tk ? oi : ci; }
                { const float ov = dpp_xor2(cv); const int oi = __float_as_int(dpp_xor2(__int_as_float(ci))); const bool tk = ov > cv || (ov == cv && oi < ci); cv = tk ? ov : cv; ci = tk ? oi : ci; }
                { const float ov = dpp_xor4(cv); const int oi = __float_as_int(dpp_xor4(__int_as_float(ci))); const bool tk = ov > cv || (ov == cv && oi < ci); cv = tk ? ov : cv; ci = tk ? oi : ci; }
                bv[r] = cv; bi[r] = ci;
#pragma unroll
                for (int k = 0; k < 4; ++k) if (ci == 4 * sub + k) v[k] = -INFINITY;
            }
            const float e1 = __expf(bv[1] - bv[0]), e2 = __expf(bv[2] - bv[0]), e3 = __expf(bv[3] - bv[0]);
            const float sum = ((1.f + e1) + e2) + e3;
            if (sub < TOPK && t < T) {
                const float ex = sub == 0 ? 1.f : sub == 1 ? e1 : sub == 2 ? e2 : e3;
                const int e = sub == 0 ? bi[0] : sub == 1 ? bi[1] : sub == 2 ? bi[2] : bi[3];
                const int a = t * TOPK + sub;
                a_e[a] = e; a_w[a] = ex / sum; a_slot[a] = atomicAdd(&lcnt[e], 1);
            }
        }
        tb += 8 * nw;
    } while (tb < T);
    __syncthreads();
    if (threadIdx.x < NE) wgcnt[blockIdx.x * NE + threadIdx.x] = lcnt[threadIdx.x];
}
__device__ __forceinline__ void moe_scatter(char* lds, const int* __restrict__ wgcnt, int* __restrict__ pstart, int* __restrict__ tile_e, const int* __restrict__ a_e, const float* __restrict__ a_w,
                                            const int* __restrict__ a_slot, int* __restrict__ tokmap, float* __restrict__ w_buf, int* __restrict__ dest_of, int wg, int gw, int nw, int lane) {
    int* ps = (int*)lds;
    int* wb = ps + 64;
    int* part = ps + 128;
    __syncthreads();
    {
        const int e = threadIdx.x & 31, q = threadIdx.x >> 5, nwg_ = gridDim.x;
        int tot = 0, below = 0;
        const int per = (nwg_ + 15) / 16;
        for (int base = 0; base < per; base += 16) {
            int cv[16];
#pragma unroll
            for (int i = 0; i < 16; ++i) { const int w = q * per + base + i; cv[i] = (base + i < per && w < nwg_) ? wgcnt[w * NE + e] : 0; }
#pragma unroll
            for (int i = 0; i < 16; ++i) { const int w = q * per + base + i; tot += cv[i]; below += (w < wg) ? cv[i] : 0; }
        }
        part[(q * NE + e) * 2] = tot; part[(q * NE + e) * 2 + 1] = below;
    }
    __syncthreads();
    if (threadIdx.x < NE) { int tot = 0, below = 0; for (int q = 0; q < 16; ++q) { tot += part[(q * NE + threadIdx.x) * 2]; below += part[(q * NE + threadIdx.x) * 2 + 1]; } ps[96 + threadIdx.x] = tot; wb[threadIdx.x] = below; }
    __syncthreads();
    if (threadIdx.x == 0) { int acc = 0; for (int e = 0; e < NE; ++e) { ps[e] = acc; acc += (ps[96 + e] + MT - 1) / MT * MT; } ps[NE] = acc; }
    __syncthreads();
    if (wg == 0) {
        if (threadIdx.x == 0) pstart[NE] = ps[NE] / MT;
        for (int tl_ = threadIdx.x; tl_ < NTILE; tl_ += 512) { const int r = tl_ * MT; int e = -1; for (int i = 0; i < NE; ++i) if (r >= ps[i] && r < ps[i + 1]) e = i; tile_e[tl_] = e; }
    }
    for (int i = threadIdx.x; i < 8 * ((T + nw - 1) / nw); i += 512) {
        const int t = (gw - (int)(threadIdx.x >> 6)) + (i & 7) + nw * (i >> 3);
        if (t < T) {
            const int4 e4 = *(const int4*)(a_e + 4 * t), s4 = *(const int4*)(a_slot + 4 * t); const float4 w4 = *(const float4*)(a_w + 4 * t);
            const int ee[4] = {e4.x, e4.y, e4.z, e4.w}, sl[4] = {s4.x, s4.y, s4.z, s4.w}; const float ww[4] = {w4.x, w4.y, w4.z, w4.w};
            int dd[4];
#pragma unroll
            for (int k = 0; k < 4; ++k) { dd[k] = ps[ee[k]] + wb[ee[k]] + sl[k]; w_buf[dd[k]] = ww[k]; tokmap[dd[k]] = t; }
            *(int4*)(dest_of + 4 * t) = make_int4(dd[0], dd[1], dd[2], dd[3]);
        }
    }
    (void)lane;
}
__device__ __forceinline__ void final_rows(const bf16_t* __restrict__ h2, const unsigned char* __restrict__ out_a, const int* __restrict__ dest_of, const float* __restrict__ g, float* __restrict__ out, int gw, int nw, int lane) {
    const int cp = 128 * ((lane >> 1) & 1) + 32 * (lane >> 4) + 16 * (lane & 1) + 4 * ((lane >> 2) & 3);
    float4 gv[4];
#pragma unroll
    for (int i = 0; i < 4; ++i) gv[i] = *(const float4*)(g + 256 * i + cp);
    for (int t = gw; t < T; t += nw) {
        const int4 d4 = *(const int4*)(dest_of + 4 * t);
        const int dd[4] = {d4.x, d4.y, d4.z, d4.w};
        uint2 hh[4]; unsigned oa[4][4];
#pragma unroll
        for (int i = 0; i < 4; ++i) hh[i] = *(const uint2*)(h2 + (size_t)t * 1024 + 256 * i + cp);
#pragma unroll
        for (int k = 0; k < 4; ++k)
#pragma unroll
            for (int i = 0; i < 4; ++i) oa[k][i] = *(const unsigned*)(out_a + (size_t)dd[k] * 1024 + 256 * i + 4 * lane);
        float4 a[4];
        float ss = 0.f;
#pragma unroll
        for (int i = 0; i < 4; ++i) {
            float s0 = 0.f, s1 = 0.f, s2 = 0.f, s3 = 0.f;
#pragma unroll
            for (int k = 0; k < 4; ++k) {
                const auto lo = __builtin_amdgcn_cvt_pk_f32_fp8(oa[k][i], false), hi = __builtin_amdgcn_cvt_pk_f32_fp8(oa[k][i], true);
                s0 += lo[0]; s1 += lo[1]; s2 += hi[0]; s3 += hi[1];
            }
            a[i] = make_float4(blo(hh[i].x) + 0.125f * s0, bhi(hh[i].x) + 0.125f * s1, blo(hh[i].y) + 0.125f * s2, bhi(hh[i].y) + 0.125f * s3);
            ss += ssq4(a[i]);
        }
        ss = wave_sum(ss);
        const float rs = rsqrtf(ss * (1.f / 1024.f) + 1e-5f);
#pragma unroll
        for (int i = 0; i < 4; ++i) *(float4*)(out + (size_t)t * 1024 + 256 * i + cp) = make_float4(a[i].x * rs * gv[i].x, a[i].y * rs * gv[i].y, a[i].z * rs * gv[i].z, a[i].w * rs * gv[i].w);
    }
}
}

template <bool PERM64, class RowMap>
__device__ __forceinline__ void p_convT(char* lds, const float* __restrict__ W, int K, int N, int nmat, pg::bf16_t* __restrict__ Bt, int nrows_out, RowMap rowmap, int wg, int nwg, const float* __restrict__ kscale = nullptr) {
    uint2* Ls = (uint2*)lds;
    const int tid = opaque_tid();
    const int tk = K / 128, tn = nrows_out / 128, per = tk * tn, total = per * nmat;
    float4 x[2][4];
    auto issue = [&](int tile) {
        const int mat = tile / per, r = tile % per, jn = r / tk, jk = r % tk;
#pragma unroll
        for (int j = 0; j < 2; ++j) {
            const int bid = tid + 512 * j, kb = bid >> 5, n4 = (bid & 31) * 4;
            const int n0 = rowmap(jn * 128 + (n4 & 96));
            const float* src = W + (size_t)mat * K * N + (size_t)(jk * 128 + 4 * kb) * N + n0 + (n4 & 31);
            const bool ok = n0 >= 0 && n0 + (n4 & 31) < N;
#pragma unroll
            for (int rr = 0; rr < 4; ++rr) x[j][rr] = ok ? *(const float4*)(src + (size_t)rr * N) : make_float4(0.f, 0.f, 0.f, 0.f);
        }
    };
    int tile = wg;
    if (tile < total) issue(tile);
    while (tile < total) {
        const int mat = tile / per, r = tile % per, jn = r / tk, jk = r % tk;
        __syncthreads();
#pragma unroll
        for (int j = 0; j < 2; ++j) {
            const int bid = tid + 512 * j, kb = bid >> 5, n4 = (bid & 31) * 4;
            float ks[4];
#pragma unroll
            for (int rr = 0; rr < 4; ++rr) ks[rr] = kscale ? kscale[jk * 128 + 4 * kb + rr] : 1.f;
            uint4 d0, d1;
            d0.x = pg::cvt_pk_bf16(x[j][0].x * ks[0], x[j][1].x * ks[1]); d0.y = pg::cvt_pk_bf16(x[j][2].x * ks[2], x[j][3].x * ks[3]);
            d0.z = pg::cvt_pk_bf16(x[j][0].y * ks[0], x[j][1].y * ks[1]); d0.w = pg::cvt_pk_bf16(x[j][2].y * ks[2], x[j][3].y * ks[3]);
            d1.x = pg::cvt_pk_bf16(x[j][0].z * ks[0], x[j][1].z * ks[1]); d1.y = pg::cvt_pk_bf16(x[j][2].z * ks[2], x[j][3].z * ks[3]);
            d1.z = pg::cvt_pk_bf16(x[j][0].w * ks[0], x[j][1].w * ks[1]); d1.w = pg::cvt_pk_bf16(x[j][2].w * ks[2], x[j][3].w * ks[3]);
            *(uint4*)(Ls + kb * 130 + n4) = d0; *(uint4*)(Ls + kb * 130 + n4 + 2) = d1;
        }
        const int nxt = tile + nwg;
        if (nxt < total) issue(nxt);
        __syncthreads();
#pragma unroll
        for (int i = 0; i < 4; ++i) {
            const int c = tid + 512 * i, n = c >> 4, kc = c & 15;
            const int ns = PERM64 ? ((n & 64) | (n & 15) | ((n & 16) << 1) | ((n & 32) >> 1)) : n;
            const uint2 lo = Ls[(2 * kc) * 130 + ns], hi = Ls[(2 * kc + 1) * 130 + ns];
            *(uint4*)(Bt + ((size_t)mat * nrows_out + jn * 128 + n) * K + jk * 128 + 8 * kc) = make_uint4(lo.x, lo.y, hi.x, hi.y);
        }
        tile = nxt;
    }
}

struct K256 { __device__ __forceinline__ int operator()(int k) const { return (k & ~255) | (((k >> 3) & 1) << 7) | (((k >> 6) & 3) << 5) | (((k >> 2) & 1) << 4) | (((k >> 4) & 3) << 2); } };
struct KXo { __device__ __forceinline__ int operator()(int k) const { return (k & ~63) | (((k >> 2) & 3) << 4) | (((k >> 4) & 3) << 2); } };
struct KIdent { __device__ __forceinline__ int operator()(int k) const { return k; } };
struct KHmid { __device__ __forceinline__ int operator()(int k) const { return (k & ~31) | (((k >> 2) & 1) << 4) | (((k >> 3) & 3) << 2); } };
template <class RowMap, class KMap = KIdent>
__device__ __forceinline__ void p_convT8(char* lds, const float* __restrict__ W, int K, int N, int nmat, unsigned char* __restrict__ Bt, int nrows_out, RowMap rowmap, int wg, int nwg, const float* __restrict__ kscale = nullptr, KMap kmap = KMap()) {
    unsigned* Ls = (unsigned*)lds;
    const int tid = opaque_tid();
    const int tk = K / 128, tn = nrows_out / 128, per = tk * tn, total = per * nmat;
    float4 x[2][4];
    auto issue = [&](int tile) {
        const int mat = tile / per, r = tile % per, jn = r / tk, jk = r % tk;
#pragma unroll
        for (int j = 0; j < 2; ++j) {
            const int bid = tid + 512 * j, kb = bid >> 5, n4 = (bid & 31) * 4;
            const int n0 = rowmap(jn * 128 + (n4 & 64));
            const float* src = W + (size_t)mat * K * N + (size_t)kmap(jk * 128 + 4 * kb) * N + n0 + (n4 & 63);
            const bool ok = n0 >= 0 && n0 + (n4 & 63) < N;
#pragma unroll
            for (int rr = 0; rr < 4; ++rr) x[j][rr] = ok ? *(const float4*)(src + (size_t)rr * N) : make_float4(0.f, 0.f, 0.f, 0.f);
        }
    };
    int tile = wg;
    if (tile < total) issue(tile);
    while (tile < total) {
        const int mat = tile / per, r = tile % per, jn = r / tk, jk = r % tk;
        __syncthreads();
#pragma unroll
        for (int j = 0; j < 2; ++j) {
            const int bid = tid + 512 * j, kb = bid >> 5, n4 = (bid & 31) * 4;
            float ks[4];
#pragma unroll
            for (int rr = 0; rr < 4; ++rr) ks[rr] = pg::W8_SCALE * (kscale ? kscale[kmap(jk * 128 + 4 * kb) + rr] : 1.f);
            uint4 d;
            d.x = pg::pk4_fp8(x[j][0].x * ks[0], x[j][1].x * ks[1], x[j][2].x * ks[2], x[j][3].x * ks[3]);
            d.y = pg::pk4_fp8(x[j][0].y * ks[0], x[j][1].y * ks[1], x[j][2].y * ks[2], x[j][3].y * ks[3]);
            d.z = pg::pk4_fp8(x[j][0].z * ks[0], x[j][1].z * ks[1], x[j][2].z * ks[2], x[j][3].z * ks[3]);
            d.w = pg::pk4_fp8(x[j][0].w * ks[0], x[j][1].w * ks[1], x[j][2].w * ks[2], x[j][3].w * ks[3]);
            *(uint4*)(Ls + kb * 132 + n4) = d;
        }
        const int nxt = tile + nwg;
        if (nxt < total) issue(nxt);
        __syncthreads();
#pragma unroll
        for (int i = 0; i < 2; ++i) {
            const int c = tid + 512 * i, n = c >> 3, kc = c & 7;
            uint4 y; y.x = Ls[(4 * kc + 0) * 132 + n]; y.y = Ls[(4 * kc + 1) * 132 + n]; y.z = Ls[(4 * kc + 2) * 132 + n]; y.w = Ls[(4 * kc + 3) * 132 + n];
            *(uint4*)(Bt + ((size_t)mat * nrows_out + jn * 128 + n) * K + jk * 128 + 16 * kc) = y;
        }
        tile = nxt;
    }
}

struct Params {
    const float *x, *mem; const int* positions;
    const float *g_mix_norm, *w_mix_in, *cmp_pos_k, *cmp_pos_v, *cmp_w1_k, *cmp_b1_k, *cmp_w2_k, *cmp_w1_v, *cmp_b1_v, *cmp_w2_v, *conv_w, *g_nsa_out, *g_conv_out, *w_mix_out,
        *g_xattn_norm, *g_mem_norm, *w_xq, *w_xkv, *w_xo, *g_moe_norm, *w_router, *b_router, *w_gate_up, *b_gate_up, *w_down, *b_down, *g_final;
    float* out;
    unsigned* bar; unsigned* queue;
    int *wgcnt, *counts, *pstart, *tile_e, *a_e, *a_slot, *dest_of, *tok_buf;
    float *a_w, *w_buf;
    unsigned* selmask;
    float *hid_k, *hid_v, *kc, *vc, *memn, *xkv, *hbuf, *xn, *o_cmp, *o_slc, *o_win, *xq, *proj, *xo;
    unsigned short *hmid, *out_a, *xg, *wt_gu, *wt_dn; unsigned char *hmid8, *wt_dn8, *wt_gu8, *xg8, *xn8, *out_a8, *h1_8, *xo8, *wt_xq8, *wt_xo8; unsigned short* h1_bf; float* ssq; float* wrt;
    unsigned short *q_bf, *kcmp, *vcmp, *kslc, *vslcT, *kwin, *vwinT, *u_bf, *cb_bf; float *gates, *cosT, *sinT;
    unsigned short *xq_bf, *xk_bf, *xvT_bf, *ocmp_bf, *owin_bf, *onsa_bf;
    unsigned short *wt_c1k, *wt_c1v, *kc_bf, *vcT_bf, *bgu_bf; float *Pab_k, *Pab_v, *b1p_k, *b1p_v;
    unsigned short *xn_bf, *memn_bf, *xo_bf, *wt_mix_in, *wt_xkv, *wt_mix_out, *wt_xq, *wt_xo;
};

typedef const __attribute__((address_space(4))) Params* KParams;
#define P (*kp)
#define KP_FRESH asm volatile("" : "+s"(kp))
__global__ void __launch_bounds__(512, 2) mega_fwd(Params p_unused) {
    KParams kp = (KParams)__builtin_amdgcn_kernarg_segment_ptr();
    extern __shared__ __attribute__((aligned(16))) char lds[];
    if (threadIdx.x < 4) ((unsigned*)lds)[threadIdx.x] = 0u;
    __syncthreads();
    XcdBarrier bar = xcd_barrier_post(P.bar, (volatile LAS unsigned*)lds);
    LAS unsigned char* glds = (LAS unsigned char*)(lds + 1024);

    {
        const int wg = blockIdx.x, nwg = gridDim.x;
        auto ident = [](int j) { return j; };
        auto mixmap = [](int j) {
            const int unit = j >> 8, g = (j & 255) >> 5, bj = g >> 2, wc = g & 3;
            if (unit < 2) return C_Q + (unit * 4 + wc) * 64 + 32 * bj;
            if (unit == 2) return (wc < 2 ? C_KC + wc * 64 : C_VC + (wc - 2) * 64) + 32 * bj;
            if (unit == 3) return (wc < 2 ? C_KS + wc * 64 : C_VS + (wc - 2) * 64) + 32 * bj;
            if (unit == 4) return (wc < 2 ? C_KW + wc * 64 : C_VW + (wc - 2) * 64) + 32 * bj;
            if (unit < 9) return (bj ? C_CC : C_CH) + (unit - 5) * 128 + 32 * wc;
            if (unit < 11) return C_CB + (unit - 9) * 256 + 32 * g;
            return g == 0 ? C_GL : -1;
        };
        p_convT<false>(lds + 1024, P.w_mix_in, D, INC, 1, P.wt_mix_in, 3072, mixmap, wg, nwg);
        p_convT<false>(lds + 1024, P.w_xkv, D, 2048, 1, P.wt_xkv, 2048, ident, wg, nwg);
        p_convT<false>(lds + 1024, P.w_mix_out, D, D, 1, P.wt_mix_out, D, ident, wg, nwg);
        p_convT8(lds + 1024, P.w_xq, D, D, 1, P.wt_xq8, D, ident, wg, nwg, P.g_xattn_norm, K256());
        p_convT8(lds + 1024, P.w_xo, D, D, 1, P.wt_xo8, D, ident, wg, nwg, nullptr, KXo());
        auto gumap = [](int j) { const int blk = j >> 8, w = j & 255; return w < 128 ? 128 * blk + w : 1024 + 128 * blk + (w - 128); };
        p_convT8(lds + 1024, P.w_gate_up, D, 2048, NE, P.wt_gu8, 2048, gumap, wg, nwg);
        p_convT8(lds + 1024, P.w_down, DFF, D, NE, P.wt_dn8, D, ident, wg, nwg, nullptr, KHmid());
        p_convT<false>(lds + 1024, P.cmp_w1_k, 1024, 256, 2, P.wt_c1k, 256, ident, wg, nwg);
        p_convT<false>(lds + 1024, P.cmp_w1_v, 1024, 256, 2, P.wt_c1v, 256, ident, wg, nwg);
        for (int o = wg * 8 + (threadIdx.x >> 6); o < 512; o += nwg * 8) {
            if (o < 256) posbias_wave(o, threadIdx.x & 63, P.cmp_pos_k, P.cmp_w1_k, P.cmp_b1_k, P.b1p_k); else posbias_wave(o - 256, threadIdx.x & 63, P.cmp_pos_v, P.cmp_w1_v, P.cmp_b1_v, P.b1p_v);
        }
        __syncthreads();
    }
    p_rope_table(blockIdx.x * 512 + threadIdx.x, gridDim.x * 512, P.positions, (unsigned*)P.cosT);
    for (int i = blockIdx.x * 512 + threadIdx.x; i < NE * 2048; i += gridDim.x * 512) P.bgu_bf[i] = f2bf_rne(P.b_gate_up[i]);
    for (int i = blockIdx.x * 512 + threadIdx.x; i < PMAX; i += gridDim.x * 512) P.tok_buf[i] = 0;
    for (int idx = blockIdx.x * 512 + threadIdx.x; idx < 512 * NE; idx += gridDim.x * 512) {
        const int e = idx >> 9, k = (idx & 511) * 2;
        const float w0 = P.g_moe_norm[k] * P.w_router[k * NE + e], w1 = P.g_moe_norm[k + 1] * P.w_router[(k + 1) * NE + e];
        const unsigned short h0 = f2bf_rne(w0), h1 = f2bf_rne(w1);
        const unsigned short l0 = f2bf_rne(w0 - __uint_as_float((unsigned)h0 << 16)), l1 = f2bf_rne(w1 - __uint_as_float((unsigned)h1 << 16));
        *(unsigned*)((char*)P.wrt + e * tl::RW_ROW + k * 2) = (unsigned)h0 | ((unsigned)h1 << 16);
        *(unsigned*)((char*)P.wrt + tl::RW_IMG + e * tl::RW_ROW + k * 2) = (unsigned)l0 | ((unsigned)l1 << 16);
    }
    tl::rmsnorm_rows(P.x, P.g_mix_norm, P.xn_bf, T, (int)(blockIdx.x * 8 + (opaque_tid() >> 6)), (int)(gridDim.x * 8), opaque_tid() & 63);
    tl::rmsnorm_rows(P.mem, P.g_mem_norm, P.memn_bf, NB * NMEM, (int)(blockIdx.x * 8 + (opaque_tid() >> 6)), (int)(gridDim.x * 8), opaque_tid() & 63);
    xcd_barrier(bar);
    KP_FRESH;
    {
        pg::DenseOrder So; So.init(P.xn_bf, P.wt_mix_in, T, 3072, 2048u, 2048u, (int)gridDim.x, (int)blockIdx.x); So.aux_mask = (1u << 3) | (1u << 4);
        pg::EpiMixIn E{P.q_bf, P.kcmp, P.vslcT, P.u_bf, P.cb_bf, P.gates, P.cosT, P.sinT};
        pg::gemm_phase<true>(glds, D, 2048u, 2048u, So, E);
    }
    xcd_barrier(bar);
    KP_FRESH;
    {
        volatile int* item_s = (volatile int*)(lds + 64);
        for (;;) {
            __syncthreads();
            if (threadIdx.x == 0) *item_s = (int)atomicAdd(P.queue, 1u);
            __syncthreads();
            const int item = __builtin_amdgcn_readfirstlane(*item_s);
            if (item >= 96 + 512) break;
            if (item < 64) {
                const int pm = item >> 3, pn = item & 7;
                pg::OneUnit So; So.u.A = (const char*)P.memn_bf + (size_t)pm * 256 * 2048; So.u.B = (const char*)P.wt_xkv + (size_t)pn * 256 * 2048; So.u.row0 = pm * 256; So.u.col0 = pn * 256; So.u.aux = 0;
                pg::EpiXkv E{P.xk_bf, P.xvT_bf};
                pg::gemm_phase(glds, D, 2048u, 2048u, So, E);
            } else if (item < 96) {
                const int which = (item - 64) >> 4, r = (item - 64) & 15, pm = r >> 1, pn = r & 1;
                pg::OneUnit So; So.u.A = (const char*)(which ? P.vcmp : P.kcmp) + (size_t)pm * 256 * 2048; So.u.B = (const char*)(which ? P.wt_c1v : P.wt_c1k) + (size_t)pn * 256 * 2048; So.u.row0 = pm * 256; So.u.col0 = pn * 256; So.u.aux = 0;
                pg::EpiF32R E{which ? P.Pab_v : P.Pab_k, 512, nullptr, 512};
                pg::gemm_phase(glds, 1024, 2048u, 2048u, So, E);
            } else {
                const int idx = item - 96, tq = 31 - (idx >> 4), bg = idx & 15;
                at::attn64_unit<1>(lds + 1024, bg >> 1, bg & 1, tq, P.q_bf, P.kwin, P.vwinT, P.selmask, P.owin_bf, nullptr, nullptr, nullptr);
            }
        }
    }
    xcd_barrier(bar);
    KP_FRESH;
    p_cmp_finalize(lds + 1024, P.Pab_k, P.Pab_v, P.b1p_k, P.b1p_v, P.cmp_w2_k, P.cmp_w2_v, P.kc_bf, P.vcT_bf, blockIdx.x, gridDim.x);
    xcd_barrier(bar);
    KP_FRESH;
    for (int item0 = blockIdx.x; item0 < 256; item0 += gridDim.x) {
        const int item = (item0 & 7) * 32 + (item0 >> 3);
        const int bg = item >> 4, j = item & 15;
        at::cmp_unit(lds + 1024, bg >> 1, bg & 1, 31 - j, P.q_bf, P.kc_bf, P.vcT_bf, P.ocmp_bf, P.selmask);
        at::cmp_unit(lds + 1024, bg >> 1, bg & 1, j, P.q_bf, P.kc_bf, P.vcT_bf, P.ocmp_bf, P.selmask);
        asm volatile("s_waitcnt vmcnt(0)" ::: "memory");
        __syncthreads();
        at::attn64_unit<0>(lds + 1024, bg >> 1, bg & 1, 31 - j, P.q_bf, P.kslc, P.vslcT, P.selmask, P.onsa_bf, P.ocmp_bf, P.owin_bf, P.gates);
        at::attn64_unit<0>(lds + 1024, bg >> 1, bg & 1, j, P.q_bf, P.kslc, P.vslcT, P.selmask, P.onsa_bf, P.ocmp_bf, P.owin_bf, P.gates);
    }
    xcd_barrier(bar);
    KP_FRESH;
    tl::mix_post(P.onsa_bf, P.u_bf, P.cb_bf, P.conv_w, P.g_nsa_out, P.g_conv_out, P.xn_bf  , (int)(blockIdx.x * 8 + (opaque_tid() >> 6)), (int)(gridDim.x * 8), opaque_tid() & 63);
    xcd_barrier(bar);
    KP_FRESH;
    {
        pg::DenseOrder So; So.init(P.xn_bf, P.wt_mix_out, T, D, 2048u, 2048u, (int)gridDim.x, (int)blockIdx.x);
        pg::EpiResNormStats E{P.x, P.h1_bf, P.ssq, P.h1_8};
        pg::gemm_phase(glds, D, 2048u, 2048u, So, E);
    }
    xcd_barrier(bar);
    KP_FRESH;
    {
        pg::DenseOrder So; So.init(P.h1_8, P.wt_xq8, T, D, 1024u, 1024u, (int)gridDim.x, (int)blockIdx.x);
        pg::EpiBf16RowScale E{P.xq_bf, P.ssq, 0.0625f * 1.4426950408889634f * pg::W8_INV};
        pg::gemm_phase_f8(glds, D, 1024u, 1024u, So, E);
        for (int L = blockIdx.x; L < (T / 256) * (D / 256); L += gridDim.x) {
            int pm, h; pg::dense_map(L, T / 256, D / 256, pm, h);
            const int b = pm >> 3, qt = (pm & 7) * 2;
            at::xattn_unit(lds + 1024, b, h, qt, P.xq_bf, P.xk_bf, P.xvT_bf, P.xo8);
            at::xattn_unit(lds + 1024, b, h, qt + 1, P.xq_bf, P.xk_bf, P.xvT_bf, P.xo8);
        }
    }
    xcd_barrier(bar);
    KP_FRESH;
    {
        pg::DenseOrder So; So.init(P.xo8, P.wt_xo8, T, D, 1024u, 1024u, (int)gridDim.x, (int)blockIdx.x);
        pg::EpiBf16Res E{P.h1_bf, pg::W8_INV * (1.f / 16.f)};
        pg::gemm_phase_f8(glds, D, 1024u, 1024u, So, E);
    }
    xcd_barrier(bar);
    KP_FRESH;
    tl::norm_router(lds + 1024, P.h1_bf, P.g_moe_norm, P.wrt, P.b_router, P.xn8, P.a_e, P.a_w, P.a_slot, P.wgcnt, (int)(blockIdx.x * 8 + (opaque_tid() >> 6)), (int)(gridDim.x * 8), opaque_tid() & 63);
    xcd_barrier(bar);
    KP_FRESH;
    tl::moe_scatter(lds + 1024, P.wgcnt, P.pstart, P.tile_e, P.a_e, P.a_w, P.a_slot, P.tok_buf, P.w_buf, P.dest_of, blockIdx.x, (int)(blockIdx.x * 8 + (opaque_tid() >> 6)), (int)(gridDim.x * 8), opaque_tid() & 63);
    xcd_barrier(bar);
    KP_FRESH;
    {
        pg::MoeOrderB<8> So; So.init(P.xn8, P.wt_gu8, P.tile_e, P.pstart[NE], (size_t)2048 * 1024, 1024u, (int)gridDim.x, (int)blockIdx.x);
        pg::EpiSwigluF8 E{P.hmid8, P.bgu_bf};
        pg::gemm_phase_f8g(glds, D, 1024u, 1024u, So, E, (const char*)P.xn8, P.tok_buf);
    }
    xcd_barrier(bar);
    KP_FRESH;
    {
        pg::MoeOrderB<4> So; So.init(P.hmid8, P.wt_dn8, P.tile_e, P.pstart[NE], (size_t)1024 * 1024, 1024u, (int)gridDim.x, (int)blockIdx.x);
        pg::EpiDownScaleF8 E{P.out_a8, P.b_down, P.w_buf};
        pg::gemm_phase_f8(glds, DFF, 1024u, 1024u, So, E);
    }
    xcd_barrier(bar);
    KP_FRESH;
    tl::final_rows(P.h1_bf, P.out_a8, P.dest_of, P.g_final, P.out, (int)(blockIdx.x * 8 + (opaque_tid() >> 6)), (int)(gridDim.x * 8), opaque_tid() & 63);
}
__global__ void k_fail(float* out, int n) { const int i = blockIdx.x * 256 + threadIdx.x; if (i < n) out[i] = __builtin_nanf(""); }
}

extern "C" void kernel_launch(void* const* d_in, const int* in_sizes, int n_in, void* d_out, int out_size, void* d_ws, size_t ws_size, hipStream_t stream) {
    Params p{};
    p.x = (const float*)d_in[0]; p.mem = (const float*)d_in[1]; p.positions = (const int*)d_in[2];
    const float** fp = &p.g_mix_norm;
    for (int i = 0; i < 27; ++i) fp[i] = (const float*)d_in[3 + i];
    p.out = (float*)d_out;

    char* ws = (char*)d_ws;
    size_t off = 0;
    auto take = [&](size_t bytes) { char* q = ws + off; off += (bytes + 255) & ~(size_t)255; return q; };
    p.bar = (unsigned*)take(XCD_BAR_WORDS * 4);
    p.counts = (int*)take(NE * 4);
    p.queue = (unsigned*)take(256);
    const size_t zero_bytes = off;
    p.pstart = (int*)take((NE + 1) * 4);
    p.wgcnt = (int*)take(1024 * NE * 4);
    p.tile_e = (int*)take(NTILE * 4);
    p.a_e = (int*)take(NA * 4);
    p.a_w = (float*)take(NA * 4);
    p.a_slot = (int*)take(NA * 4);
    p.dest_of = (int*)take(NA * 4);
    p.w_buf = (float*)take(PMAX * 4);
    p.tok_buf = (int*)take(PMAX * 4);
    p.selmask = (unsigned*)take((size_t)NB * 2 * S * 4);
    p.out_a8 = (unsigned char*)take((size_t)PMAX * D);
    p.xn8 = (unsigned char*)take((size_t)T * D);
    p.h1_bf = (unsigned short*)take((size_t)T * D * 2);
    p.ssq = (float*)take((size_t)T * 16 * 4);
    p.wrt = (float*)take((size_t)2 * tl::RW_IMG + 256);
    p.hmid8 = (unsigned char*)take((size_t)PMAX * DFF);
    p.wt_gu8 = (unsigned char*)take((size_t)NE * 2048 * D);
    p.wt_dn8 = (unsigned char*)take((size_t)NE * D * DFF);
    p.q_bf = (unsigned short*)take((size_t)T * 512 * 2);
    p.kcmp = (unsigned short*)take((size_t)T * 128 * 2 * 4); p.vcmp = p.kcmp + (size_t)T * 128; p.kslc = p.vcmp + (size_t)T * 128; p.kwin = p.kslc + (size_t)T * 128;
    p.vslcT = (unsigned short*)take((size_t)T * 128 * 2 * 2); p.vwinT = p.vslcT + (size_t)T * 128;
    p.u_bf = (unsigned short*)take((size_t)T * 512 * 2); p.cb_bf = (unsigned short*)take((size_t)T * 512 * 2);
    p.gates = (float*)take((size_t)T * 24 * 4); p.cosT = (float*)take((size_t)T * 32 * 4); p.sinT = (float*)take((size_t)T * 32 * 4);
    p.wt_c1k = (unsigned short*)take((size_t)512 * 1024 * 2); p.wt_c1v = (unsigned short*)take((size_t)512 * 1024 * 2);
    p.kc_bf = (unsigned short*)take((size_t)16 * 128 * 64 * 2); p.vcT_bf = (unsigned short*)take((size_t)16 * 64 * 128 * 2);
    p.Pab_k = (float*)take((size_t)(2048 + 1) * 512 * 4); p.Pab_v = (float*)take((size_t)(2048 + 1) * 512 * 4);
    p.b1p_k = (float*)take(256 * 4); p.b1p_v = (float*)take(256 * 4);
    p.bgu_bf = (unsigned short*)take((size_t)NE * 2048 * 2);
    p.ocmp_bf = (unsigned short*)take((size_t)T * 512 * 2); p.owin_bf = (unsigned short*)take((size_t)T * 512 * 2); p.onsa_bf = (unsigned short*)take((size_t)T * 512 * 2);
    p.xq_bf = (unsigned short*)take((size_t)T * D * 2); p.xk_bf = (unsigned short*)take((size_t)NB * NMEM * D * 2); p.xvT_bf = (unsigned short*)take((size_t)NB * NMEM * D * 2);
    p.xn_bf = (unsigned short*)take((size_t)T * D * 2);
    p.memn_bf = (unsigned short*)take((size_t)NB * NMEM * D * 2);
    p.xo8 = (unsigned char*)take((size_t)T * D);
    p.h1_8 = (unsigned char*)take((size_t)T * D);
    p.wt_mix_in = (unsigned short*)take((size_t)3072 * D * 2);
    p.wt_xkv = (unsigned short*)take((size_t)2048 * D * 2);
    p.wt_mix_out = (unsigned short*)take((size_t)D * D * 2);
    p.wt_xq8 = (unsigned char*)take((size_t)D * D);
    p.wt_xo8 = (unsigned char*)take((size_t)D * D);

    static int grid = 0;
    if (grid == 0) {
        int dev = 0, cus = 0;
        if (hipGetDevice(&dev) != hipSuccess || hipDeviceGetAttribute(&cus, hipDeviceAttributeMultiprocessorCount, dev) != hipSuccess) cus = -1;
        if (hipFuncSetAttribute((const void*)mega_fwd, hipFuncAttributeMaxDynamicSharedMemorySize, LDS_BYTES) != hipSuccess) cus = -1;
        int per_cu = 0;
        if (cus > 0 && (hipOccupancyMaxActiveBlocksPerMultiprocessor(&per_cu, (const void*)mega_fwd, 512, LDS_BYTES) != hipSuccess || per_cu < 1)) cus = -1;
        (void)hipGetLastError();
        grid = cus > 0 ? cus : -1;
    }
    if (grid < 0 || off > ws_size) { k_fail<<<(out_size + 255) / 256, 256, 0, stream>>>((float*)d_out, out_size); return; }
    (void)hipMemsetAsync(d_ws, 0, zero_bytes, stream);
    hipLaunchKernelGGL(mega_fwd, dim3(grid), dim3(512), LDS_BYTES, stream, p);
}
```

```cpp
#include <hip/hip_runtime.h>
#include <hip/hip_bf16.h>
#include <stdint.h>
#include <cstdio>

#define XB_TMO      128
#define XB_XCNT(j)  (256  + 64 * (j))
#define XB_XSUB(j)  (1280 + 64 * (j))
#define XB_XGEN(j)  (2304 + 64 * (j))
#define XB_TOP      3328
#define XB_TOPGEN   3392
#define XCD_BAR_WORDS 3456
#define XB_SPIN_CAP (1u << 18)
#define LAS __attribute__((address_space(3)))

__device__ __forceinline__ unsigned xb_ld(unsigned* p)              { return __hip_atomic_load(p, __ATOMIC_RELAXED, __HIP_MEMORY_SCOPE_AGENT); }
__device__ __forceinline__ unsigned xb_add(unsigned* p, unsigned v) { return __hip_atomic_fetch_add(p, v, __ATOMIC_RELAXED, __HIP_MEMORY_SCOPE_AGENT); }
__device__ __forceinline__ unsigned xb_xcc_id() { return (unsigned)__builtin_amdgcn_s_getreg((3 << 11) | 20) & 0xFu; }
#define XB_SPIN(cond, bar) do { unsigned _sp = 0; while (cond) { __builtin_amdgcn_s_sleep(1); \
    if ((++_sp & 255u) == 0u) { if (xb_ld(&(bar)[XB_TMO])) break; if (_sp > XB_SPIN_CAP) { atomicAdd(&(bar)[XB_TMO], 1u); break; } } } } while (0)

struct XcdBarrier {
    unsigned* bar; unsigned x;
    volatile LAS unsigned* st;
};

__device__ __forceinline__ XcdBarrier xcd_barrier_post(unsigned* bar, volatile LAS unsigned* st) {
    XcdBarrier b; b.bar = bar; b.x = xb_xcc_id(); b.st = st;
    if (threadIdx.x == 0) (void)xb_add(&bar[XB_XCNT(b.x)], 1u);
    return b;
}
__device__ __forceinline__ void xcd_barrier_complete(unsigned* bar, unsigned x, unsigned& nloc, unsigned& nx) {
    const unsigned G = gridDim.x * gridDim.y * gridDim.z;
    unsigned sum, cnt, mine, sp = 0u;
    for (;;) {
        sum = 0u; cnt = 0u; mine = 0u;
#pragma unroll
        for (unsigned j = 0; j < 16; ++j) { const unsigned c = xb_ld(&bar[XB_XCNT(j)]); sum += c; cnt += (c > 0u) ? 1u : 0u; mine = (j == x) ? c : mine; }
        if (sum == G) break;
        __builtin_amdgcn_s_sleep(1);
        if ((++sp & 255u) == 0u) { if (xb_ld(&bar[XB_TMO])) break; if (sp > XB_SPIN_CAP) { atomicAdd(&bar[XB_TMO], 1u); break; } }
    }
    nloc = mine > 0u ? mine : 1u; nx = cnt > 0u ? cnt : 1u;
}

__device__ __forceinline__ void xcd_barrier(const XcdBarrier& b) {
    asm volatile("s_waitcnt vmcnt(0)" ::: "memory");
    __syncthreads();
    if (threadIdx.x == 0) {
        unsigned* bar = b.bar;
        __builtin_amdgcn_s_waitcnt(0);
        unsigned nloc = b.st[0], nx = b.st[1];
        if (nloc == 0u) { xcd_barrier_complete(bar, b.x, nloc, nx); b.st[0] = nloc; b.st[1] = nx; }
        const unsigned old = xb_add(&bar[XB_XSUB(b.x)], 1u);
        const unsigned gen = old / nloc;
        if (old + 1u == (gen + 1u) * nloc) {
            __builtin_amdgcn_fence(__ATOMIC_RELEASE, "agent");
            asm volatile("s_waitcnt vmcnt(0)" ::: "memory");
            const unsigned og = xb_add(&bar[XB_TOP], 1u);
            const unsigned tg = og / nx;
            if (og + 1u == (tg + 1u) * nx) xb_add(&bar[XB_TOPGEN], 1u);
            else XB_SPIN(xb_ld(&bar[XB_TOPGEN]) == tg, bar);
            __builtin_amdgcn_fence(__ATOMIC_ACQUIRE, "agent");
            xb_add(&bar[XB_XGEN(b.x)], 1u);
            asm volatile("s_waitcnt vmcnt(0)" ::: "memory");
        } else {
            XB_SPIN(xb_ld(&bar[XB_XGEN(b.x)]) == gen, bar);
            __builtin_amdgcn_fence(__ATOMIC_ACQUIRE, "agent");
            asm volatile("s_waitcnt vmcnt(0)" ::: "memory");
        }
    }
    __syncthreads();
}


namespace {
constexpr int D = 1024, NB = 8, S = 2048, T = NB * S, NMEM = 256;
constexpr int INC = 2840;
constexpr int C_Q = 0, C_KC = 512, C_VC = 640, C_KS = 768, C_VS = 896, C_KW = 1024, C_VW = 1152, C_GL = 1280, C_CH = 1304, C_CB = 1816, C_CC = 2328;
constexpr int NC = 127, NCR = NB * NC * 2;
constexpr int NE = 32, TOPK = 4, DFF = 1024, NA = T * TOPK;
constexpr int MT = 256;
constexpr int PMAX = NA + NE * MT, NTILE = PMAX / MT;
constexpr int LDS_BYTES = 144 * 1024, VB_LDS = 40960;
constexpr float QS = 0.125f * 1.4426950408889634f;

__device__ __forceinline__ int opaque_tid() { int t = threadIdx.x; asm volatile("" : "+v"(t)); return t; }
__device__ __forceinline__ float dpp_xor8(float v) { return __uint_as_float(__builtin_amdgcn_update_dpp(0u, __float_as_uint(v), 0x128, 0xf, 0xf, true)); }
__device__ __forceinline__ float dpp_xor4(float v) { unsigned r = __builtin_amdgcn_update_dpp(__float_as_uint(v), __float_as_uint(v), 0x104, 0xf, 0x5, false); r = __builtin_amdgcn_update_dpp(r, __float_as_uint(v), 0x114, 0xf, 0xa, false); return __uint_as_float(r); }
__device__ __forceinline__ float dpp_xor2(float v) { return __uint_as_float(__builtin_amdgcn_update_dpp(0u, __float_as_uint(v), 0x4e, 0xf, 0xf, true)); }
__device__ __forceinline__ float dpp_xor1(float v) { return __uint_as_float(__builtin_amdgcn_update_dpp(0u, __float_as_uint(v), 0xb1, 0xf, 0xf, true)); }

__device__ __forceinline__ float lane_xor32(float v) { const auto r = __builtin_amdgcn_permlane32_swap(__float_as_uint(v), __float_as_uint(v), false, false); return __uint_as_float((threadIdx.x & 32) ? r[0] : r[1]); }
__device__ __forceinline__ float lane_xor16(float v) { const auto r = __builtin_amdgcn_permlane16_swap(__float_as_uint(v), __float_as_uint(v), false, false); return __uint_as_float((threadIdx.x & 16) ? r[0] : r[1]); }
__device__ __forceinline__ float wave_sum(float v) {
    { const auto r = __builtin_amdgcn_permlane32_swap(__float_as_uint(v), __float_as_uint(v), false, false); v = __uint_as_float(r[0]) + __uint_as_float(r[1]); }
    { const auto r = __builtin_amdgcn_permlane16_swap(__float_as_uint(v), __float_as_uint(v), false, false); v = __uint_as_float(r[0]) + __uint_as_float(r[1]); }
    v += dpp_xor8(v); v += dpp_xor4(v); v += dpp_xor2(v); v += dpp_xor1(v); return v;
}
__device__ __forceinline__ float wave_max(float v) {
    { const auto r = __builtin_amdgcn_permlane32_swap(__float_as_uint(v), __float_as_uint(v), false, false); v = fmaxf(__uint_as_float(r[0]), __uint_as_float(r[1])); }
    { const auto r = __builtin_amdgcn_permlane16_swap(__float_as_uint(v), __float_as_uint(v), false, false); v = fmaxf(__uint_as_float(r[0]), __uint_as_float(r[1])); }
    v = fmaxf(v, dpp_xor8(v)); v = fmaxf(v, dpp_xor4(v)); v = fmaxf(v, dpp_xor2(v)); v = fmaxf(v, dpp_xor1(v)); return v;
}

namespace pg { __device__ __forceinline__ unsigned cvt_pk_bf16(float lo, float hi); __device__ __forceinline__ unsigned cvt_pk_bf16_acc(float lo, float hi); }
struct VB { int vb, nvb, tid; char* lds; };
#define VB_ITEMS(n) for (int _it = 0, item = v.vb; _it < ((n) + v.nvb - 1) / v.nvb; ++_it, item += v.nvb)


__device__ __forceinline__ unsigned short f2bf_rne(float f) { unsigned u = __float_as_uint(f); u += 0x7FFFu + ((u >> 16) & 1u); return (unsigned short)(u >> 16); }


__device__ __forceinline__ float gelu_tanh(float x) { const float u = 0.7978845608028654f * (x + 0.044715f * x * x * x); return 0.5f * x * (1.f + tanhf(u)); }

__device__ __forceinline__ void st_out(float* p, float x) { *p = x; }
__device__ __forceinline__ void st_out(unsigned short* p, float x) { *p = f2bf_rne(x); }


typedef _Float16 h2_t __attribute__((ext_vector_type(2)));
__device__ __forceinline__ void p_rope_table(int gtid, int gn, const int* __restrict__ pos, unsigned* __restrict__ csT) {
    const bool fixed_f = (gn & 31) == 0;
    float inv0 = powf(10000.f, -(float)(gtid & 31) / 32.f);
    for (int i = gtid; i < T * 32; i += gn) {
        const int t = i >> 5, f = i & 31;
        const float inv = fixed_f ? inv0 : powf(10000.f, -(float)f / 32.f);
        const float ang = (float)pos[t] * inv;
        float sn, cs; sincosf(ang, &sn, &cs);
        const h2_t hv = {(_Float16)cs, (_Float16)sn};
        csT[i] = __builtin_bit_cast(unsigned, hv);
    }
}


namespace pg {
typedef unsigned short bf16_t;
typedef short bf16x8 __attribute__((ext_vector_type(8)));
typedef float f32x4 __attribute__((ext_vector_type(4)));
constexpr int BM = 256, BK = 64, HALF = 128, HTB = HALF * BK * 2, STAGE_BYTES = 8 * HTB;
__device__ __forceinline__ int lds_byte(int r, int c) { const int st = (r >> 4) * 2 + (c >> 5), rr = r & 15, cc = c & 31, ob = rr * 64 + cc * 2; return st * 1024 + (ob ^ (((ob >> 9) & 1) << 5)); }
__device__ __forceinline__ void stage_rc(int b, int& R, int& C) { const int st = b / 1024, sb = b % 1024, swz = sb ^ (((sb >> 9) & 1) << 5); R = (st >> 1) * 16 + swz / 64; C = (st & 1) * 32 + (swz % 64) / 2; }
typedef float f32x2_t __attribute__((ext_vector_type(2)));
typedef __bf16 bf16x2_t __attribute__((ext_vector_type(2)));
__device__ __forceinline__ unsigned cvt_pk_bf16_acc(float lo, float hi) { const f32x2_t v = {lo, hi}; const bf16x2_t b = __builtin_convertvector(v, bf16x2_t); return __builtin_bit_cast(unsigned, b); }
__device__ __forceinline__ unsigned cvt_pk_bf16(float lo, float hi) { unsigned r; asm volatile("v_cvt_pk_bf16_f32 %0, %1, %2" : "=v"(r) : "v"(lo), "v"(hi)); return r; }
__device__ __forceinline__ bf16_t f2bf(float f) { unsigned u = __float_as_uint(f); u += 0x7FFFu + ((u >> 16) & 1u); return (bf16_t)(u >> 16); }

__device__ __forceinline__ unsigned pk4_fp8(float a, float b, float c, float d);
__device__ __forceinline__ uint4 pair16(uint2 a, uint2 b) {
    const auto rx = __builtin_amdgcn_permlane16_swap(a.x, b.x, false, false);
    const auto ry = __builtin_amdgcn_permlane16_swap(a.y, b.y, false, false);
    return make_uint4(rx[0], ry[0], rx[1], ry[1]);
}
__device__ __forceinline__ int pair16_col(int fq) { return (fq & 1) ? 16 + 4 * (fq - 1) : 4 * fq; }
struct GUnit { const char* A; const char* B; int row0, col0, aux; };

template <bool VSW = false, class Epi, class Sched>
__device__ __forceinline__ void gemm_phase(LAS unsigned char* lds, const int K, const unsigned lda_b, const unsigned ldb_b, const Sched& S, const Epi& E) {
    const int tid = opaque_tid(), wid = __builtin_amdgcn_readfirstlane(tid >> 6), lane = tid & 63, wr = wid >> 2, wc = wid & 3, fr = lane & 15, fq = lane >> 4;
    const int nt = K / BK;
    unsigned voffA[2], voffB[2];
#pragma unroll
    for (int i = 0; i < 2; ++i) { int R, C; stage_rc(tid * 16 + i * 8192, R, C); voffA[i] = (unsigned)R * lda_b + (unsigned)C * 2u; voffB[i] = (unsigned)R * ldb_b + (unsigned)C * 2u; }
    const size_t kstep = (size_t)(BK * 2);
    const size_t hstepA = (size_t)HALF * lda_b, hstepB = (size_t)HALF * ldb_b;
    const unsigned ldsw = (unsigned)wid * 1024u;
    int aoff = lds_byte(wr * 64 + fr, fq * 8), boff = lds_byte(wc * 32 + fr, fq * 8);
    auto set_offs = [&](bool vsw) {
        aoff = vsw ? 4 * HTB + lds_byte(64 + fr, fq * 8) : lds_byte(wr * 64 + fr, fq * 8);
        boff = vsw ? lds_byte(32 * (2 * wr + wc - 2) + fr, fq * 8) - 4 * HTB : lds_byte(wc * 32 + fr, fq * 8);
    };
#define PG8_SA(b, h) (((b) * 2 + (h)) * HTB)
#define PG8_SB(b, h) ((4 + (b) * 2 + (h)) * HTB)
#define PG8_STAGE(bufoff, gbase, voff) do { _Pragma("unroll") for (int _i = 0; _i < 2; ++_i) \
        __builtin_amdgcn_global_load_lds((const unsigned*)((const char*)(gbase) + (voff)[_i]), (LAS unsigned*)(lds + (bufoff) + ldsw + _i * 8192), 16, 0, 0); } while (0)
#define PG8_LDA(dst, b, h) do { _Pragma("unroll") for (int m = 0; m < 4; ++m) _Pragma("unroll") for (int k = 0; k < 2; ++k) dst[m][k] = *(const LAS bf16x8*)(lds + PG8_SA(b, h) + aoff + m * 2048 + k * 1024); } while (0)
#define PG8_LDB(dst, b, h) do { _Pragma("unroll") for (int n = 0; n < 2; ++n) _Pragma("unroll") for (int k = 0; k < 2; ++k) dst[n][k] = *(const LAS bf16x8*)(lds + PG8_SB(b, h) + boff + n * 2048 + k * 1024); } while (0)
#define PG8_MMA(ai, bj, At, Bt) do { __builtin_amdgcn_s_setprio(1); _Pragma("unroll") for (int m = 0; m < 4; ++m) _Pragma("unroll") for (int n = 0; n < 2; ++n) _Pragma("unroll") for (int k = 0; k < 2; ++k) \
        acc[ai][bj][m][n] = __builtin_amdgcn_mfma_f32_16x16x32_bf16(Bt[n][k], At[m][k], acc[ai][bj][m][n], 0, 0, 0); __builtin_amdgcn_s_setprio(0); } while (0)
#define PG8_WAIT_V(n) asm volatile("s_waitcnt vmcnt(" #n ")" ::: "memory")
#define PG8_WAIT_L(n) asm volatile("s_waitcnt lgkmcnt(" #n ")" ::: "memory")
#define PG8_BAR __builtin_amdgcn_s_barrier()
#define PG8_SCHED __builtin_amdgcn_sched_barrier(0)
    GUnit cur, nxt; int ui = 0;
    if (!S.next(0, cur)) return;
    if (VSW) set_offs(cur.aux != 0 && wc >= 2);
    f32x4 acc[2][2][4][2];
#pragma unroll
    for (int a = 0; a < 2; ++a)
#pragma unroll
        for (int b = 0; b < 2; ++b)
#pragma unroll
            for (int m = 0; m < 4; ++m)
#pragma unroll
                for (int n = 0; n < 2; ++n) acc[a][b][m][n] = (f32x4){0.f, 0.f, 0.f, 0.f};
    bf16x8 At[4][2], B0[2][2], B1[2][2];
    const char* cA = cur.A; const char* cB = cur.B;
    PG8_STAGE(PG8_SB(0, 0), cB, voffB); PG8_STAGE(PG8_SA(0, 0), cA, voffA); PG8_STAGE(PG8_SB(0, 1), cB + hstepB, voffB); PG8_STAGE(PG8_SA(0, 1), cA + hstepA, voffA);
    if (wr == 1) PG8_BAR;
    PG8_WAIT_V(4); PG8_BAR;
    PG8_STAGE(PG8_SB(1, 0), cB + kstep, voffB); PG8_STAGE(PG8_SA(1, 0), cA + kstep, voffA); PG8_STAGE(PG8_SB(1, 1), cB + hstepB + kstep, voffB);
    PG8_WAIT_V(6); PG8_BAR;
    for (;;) {
        const bool has_next = S.next(ui + 1, nxt);
        const char* nA = has_next ? nxt.A : cA; const char* nB = has_next ? nxt.B : cB;
        for (int t = 0; t < nt; t += 2) {
            const bool last = (t == nt - 2);
            const char* a1 = cA + (size_t)(t + 1) * kstep;
            const char* a2 = last ? nA : cA + (size_t)(t + 2) * kstep; const char* b2 = last ? nB : cB + (size_t)(t + 2) * kstep;
            const char* a3 = a2 + kstep; const char* b3 = b2 + kstep;
            PG8_LDB(B0, 0, 0); PG8_SCHED; PG8_LDA(At, 0, 0); PG8_STAGE(PG8_SA(1, 1), a1 + hstepA, voffA);
            PG8_WAIT_L(8); PG8_BAR; PG8_WAIT_L(0); PG8_MMA(0, 0, At, B0); PG8_BAR; PG8_SCHED;
            PG8_LDB(B1, 0, 1); PG8_STAGE(PG8_SB(0, 0), b2, voffB);
            PG8_BAR; PG8_WAIT_L(0); PG8_MMA(0, 1, At, B1); PG8_BAR;
            PG8_LDA(At, 0, 1); PG8_STAGE(PG8_SA(0, 0), a2, voffA);
            PG8_BAR; PG8_WAIT_L(0); PG8_MMA(1, 0, At, B0); PG8_BAR; PG8_SCHED;
            PG8_STAGE(PG8_SB(0, 1), b2 + hstepB, voffB);
            PG8_WAIT_V(6); PG8_BAR; PG8_MMA(1, 1, At, B1); PG8_BAR;
            PG8_LDB(B0, 1, 0); PG8_SCHED; PG8_LDA(At, 1, 0); PG8_STAGE(PG8_SA(0, 1), a2 + hstepA, voffA);
            PG8_WAIT_L(8); PG8_BAR; PG8_WAIT_L(0); PG8_MMA(0, 0, At, B0); PG8_BAR; PG8_SCHED;
            PG8_LDB(B1, 1, 1); PG8_STAGE(PG8_SB(1, 0), b3, voffB);
            PG8_BAR; PG8_WAIT_L(0); PG8_MMA(0, 1, At, B1); PG8_BAR;
            PG8_LDA(At, 1, 1); PG8_STAGE(PG8_SA(1, 0), a3, voffA);
            PG8_BAR; PG8_WAIT_L(0); PG8_MMA(1, 0, At, B0); PG8_BAR; PG8_SCHED;
            PG8_STAGE(PG8_SB(1, 1), b3 + hstepB, voffB);
            PG8_WAIT_V(6); PG8_BAR; PG8_MMA(1, 1, At, B1); PG8_BAR;
        }
        E(acc, cur, wr, wc, fr, fq);
        if (!has_next) break;
#pragma unroll
        for (int a = 0; a < 2; ++a)
#pragma unroll
            for (int b = 0; b < 2; ++b)
#pragma unroll
                for (int m = 0; m < 4; ++m)
#pragma unroll
                    for (int n = 0; n < 2; ++n) acc[a][b][m][n] = (f32x4){0.f, 0.f, 0.f, 0.f};
        cur = nxt; cA = nA; cB = nB; ++ui; if (VSW) set_offs(cur.aux != 0 && wc >= 2);
    }
    PG8_WAIT_V(0);
    if (wr == 0) PG8_BAR;
    PG8_BAR;
#undef PG8_SA
#undef PG8_SB
#undef PG8_STAGE
#undef PG8_LDA
#undef PG8_LDB
#undef PG8_MMA
#undef PG8_WAIT_V
#undef PG8_WAIT_L
#undef PG8_BAR
#undef PG8_SCHED
}

typedef int v4i_t __attribute__((ext_vector_type(4)));
typedef int v8i_t __attribute__((ext_vector_type(8)));
template <class Epi, class Sched>
__device__ __forceinline__ void gemm_phase_f8(LAS unsigned char* lds, const int K  , const unsigned lda_b, const unsigned ldb_b, const Sched& S, const Epi& E) {
    const int tid = opaque_tid(), wid = __builtin_amdgcn_readfirstlane(tid >> 6), lane = tid & 63, wr = wid >> 2, wc = wid & 3, fr = lane & 15, fq = lane >> 4;
    const int nt = K / 128;
    unsigned voffA[2], voffB[2];
#pragma unroll
    for (int i = 0; i < 2; ++i) { int R, C; stage_rc(tid * 16 + i * 8192, R, C); voffA[i] = (unsigned)R * lda_b + (unsigned)C * 2u; voffB[i] = (unsigned)R * ldb_b + (unsigned)C * 2u; }
    const size_t kstep = (size_t)(BK * 2);
    const size_t hstepA = (size_t)HALF * lda_b, hstepB = (size_t)HALF * ldb_b;
    const unsigned ldsw = (unsigned)wid * 1024u;
    const int aoff = lds_byte(wr * 64 + fr, fq * 8), boff = lds_byte(wc * 32 + fr, fq * 8);
#define PG8_SA(b, h) (((b) * 2 + (h)) * HTB)
#define PG8_SB(b, h) ((4 + (b) * 2 + (h)) * HTB)
#define PG8_STAGE(bufoff, gbase, voff) do { _Pragma("unroll") for (int _i = 0; _i < 2; ++_i) \
        __builtin_amdgcn_global_load_lds((const unsigned*)((const char*)(gbase) + (voff)[_i]), (LAS unsigned*)(lds + (bufoff) + ldsw + _i * 8192), 16, 0, 0); } while (0)
#define PG8_LDA(dst, b, h) do { _Pragma("unroll") for (int m = 0; m < 4; ++m) { const v4i_t lo_ = *(const LAS v4i_t*)(lds + PG8_SA(b, h) + aoff + m * 2048), hi_ = *(const LAS v4i_t*)(lds + PG8_SA(b, h) + aoff + m * 2048 + 1024); dst[m] = __builtin_shufflevector(lo_, hi_, 0, 1, 2, 3, 4, 5, 6, 7); } } while (0)
#define PG8_LDB(dst, b, h) do { _Pragma("unroll") for (int n = 0; n < 2; ++n) { const v4i_t lo_ = *(const LAS v4i_t*)(lds + PG8_SB(b, h) + boff + n * 2048), hi_ = *(const LAS v4i_t*)(lds + PG8_SB(b, h) + boff + n * 2048 + 1024); dst[n] = __builtin_shufflevector(lo_, hi_, 0, 1, 2, 3, 4, 5, 6, 7); } } while (0)
#define PG8_MMA(ai, bj, At, Bt) do { __builtin_amdgcn_s_setprio(1); _Pragma("unroll") for (int m = 0; m < 4; ++m) _Pragma("unroll") for (int n = 0; n < 2; ++n) \
        asm volatile("v_mfma_scale_f32_16x16x128_f8f6f4 %0, %1, %2, %0, %3, %3 op_sel_hi:[0,0,0]" : "+v"(acc[ai][bj][m][n]) : "v"(Bt[n]), "v"(At[m]), "v"(unit_scale)); __builtin_amdgcn_s_setprio(0); } while (0)
#define PG8_MMA0(ai, bj, At, Bt) do { __builtin_amdgcn_s_setprio(1); _Pragma("unroll") for (int m = 0; m < 4; ++m) _Pragma("unroll") for (int n = 0; n < 2; ++n) \
        asm volatile("v_mfma_scale_f32_16x16x128_f8f6f4 %0, %1, %2, 0, %3, %3 op_sel_hi:[0,0,0]" : "=v"(acc[ai][bj][m][n]) : "v"(Bt[n]), "v"(At[m]), "v"(unit_scale)); __builtin_amdgcn_s_setprio(0); } while (0)
#define PG8_WAIT_V(n) asm volatile("s_waitcnt vmcnt(" #n ")" ::: "memory")
#define PG8_WAIT_L(n) asm volatile("s_waitcnt lgkmcnt(" #n ")" ::: "memory")
#define PG8_BAR __builtin_amdgcn_s_barrier()
#define PG8_SCHED __builtin_amdgcn_sched_barrier(0)
    const int unit_scale = 0x7f7f7f7f;
    GUnit cur, nxt; int ui = 0;
    if (!S.next(0, cur)) return;
    f32x4 acc[2][2][4][2];
    v8i_t At[4], B0[2], B1[2];
    const char* cA = cur.A; const char* cB = cur.B;
    PG8_STAGE(PG8_SB(0, 0), cB, voffB); PG8_STAGE(PG8_SA(0, 0), cA, voffA); PG8_STAGE(PG8_SB(0, 1), cB + hstepB, voffB); PG8_STAGE(PG8_SA(0, 1), cA + hstepA, voffA);
    if (wr == 1) PG8_BAR;
    PG8_WAIT_V(4); PG8_BAR;
    PG8_STAGE(PG8_SB(1, 0), cB + kstep, voffB); PG8_STAGE(PG8_SA(1, 0), cA + kstep, voffA); PG8_STAGE(PG8_SB(1, 1), cB + hstepB + kstep, voffB);
    PG8_WAIT_V(6); PG8_BAR;
    for (;;) {
        const bool has_next = S.next(ui + 1, nxt);
        const typename Epi::Pre pre = E.preload(cur, wr, wc, fr, fq);
        const char* nA = has_next ? nxt.A : cA; const char* nB = has_next ? nxt.B : cB;
        {
            const int t = 0;
            const bool last = (t == nt - 2);
            const char* a1 = cA + (size_t)(t + 1) * kstep;
            const char* a2 = last ? nA : cA + (size_t)(t + 2) * kstep; const char* b2 = last ? nB : cB + (size_t)(t + 2) * kstep;
            const char* a3 = a2 + kstep; const char* b3 = b2 + kstep;
            PG8_LDB(B0, 0, 0); PG8_SCHED; PG8_LDA(At, 0, 0); PG8_STAGE(PG8_SA(1, 1), a1 + hstepA, voffA);
            PG8_WAIT_L(8); PG8_BAR; PG8_WAIT_L(0); PG8_MMA0(0, 0, At, B0); PG8_BAR; PG8_SCHED;
            PG8_LDB(B1, 0, 1); PG8_STAGE(PG8_SB(0, 0), b2, voffB);
            PG8_BAR; PG8_WAIT_L(0); PG8_MMA0(0, 1, At, B1); PG8_BAR;
            PG8_LDA(At, 0, 1); PG8_STAGE(PG8_SA(0, 0), a2, voffA);
            PG8_BAR; PG8_WAIT_L(0); PG8_MMA0(1, 0, At, B0); PG8_BAR; PG8_SCHED;
            PG8_STAGE(PG8_SB(0, 1), b2 + hstepB, voffB);
            PG8_WAIT_V(6); PG8_BAR; PG8_MMA0(1, 1, At, B1); PG8_BAR;
            PG8_LDB(B0, 1, 0); PG8_SCHED; PG8_LDA(At, 1, 0); PG8_STAGE(PG8_SA(0, 1), a2 + hstepA, voffA);
            PG8_WAIT_L(8); PG8_BAR; PG8_WAIT_L(0); PG8_MMA(0, 0, At, B0); PG8_BAR; PG8_SCHED;
            PG8_LDB(B1, 1, 1); PG8_STAGE(PG8_SB(1, 0), b3, voffB);
            PG8_BAR; PG8_WAIT_L(0); PG8_MMA(0, 1, At, B1); PG8_BAR;
            PG8_LDA(At, 1, 1); PG8_STAGE(PG8_SA(1, 0), a3, voffA);
            PG8_BAR; PG8_WAIT_L(0); PG8_MMA(1, 0, At, B0); PG8_BAR; PG8_SCHED;
            PG8_STAGE(PG8_SB(1, 1), b3 + hstepB, voffB);
            PG8_WAIT_V(6); PG8_BAR; PG8_MMA(1, 1, At, B1); PG8_BAR;
        }
#pragma nounroll
        for (int t = 2; t < nt; t += 2) {
            const bool last = (t == nt - 2);
            const char* a1 = cA + (size_t)(t + 1) * kstep;
            const char* a2 = last ? nA : cA + (size_t)(t + 2) * kstep; const char* b2 = last ? nB : cB + (size_t)(t + 2) * kstep;
            const char* a3 = a2 + kstep; const char* b3 = b2 + kstep;
            PG8_LDB(B0, 0, 0); PG8_SCHED; PG8_LDA(At, 0, 0); PG8_STAGE(PG8_SA(1, 1), a1 + hstepA, voffA);
            PG8_WAIT_L(8); PG8_BAR; PG8_WAIT_L(0); PG8_MMA(0, 0, At, B0); PG8_BAR; PG8_SCHED;
            PG8_LDB(B1, 0, 1); PG8_STAGE(PG8_SB(0, 0), b2, voffB);
            PG8_BAR; PG8_WAIT_L(0); PG8_MMA(0, 1, At, B1); PG8_BAR;
            PG8_LDA(At, 0, 1); PG8_STAGE(PG8_SA(0, 0), a2, voffA);
            PG8_BAR; PG8_WAIT_L(0); PG8_MMA(1, 0, At, B0); PG8_BAR; PG8_SCHED;
            PG8_STAGE(PG8_SB(0, 1), b2 + hstepB, voffB);
            PG8_WAIT_V(6); PG8_BAR; PG8_MMA(1, 1, At, B1); PG8_BAR;
            PG8_LDB(B0, 1, 0); PG8_SCHED; PG8_LDA(At, 1, 0); PG8_STAGE(PG8_SA(0, 1), a2 + hstepA, voffA);
            PG8_WAIT_L(8); PG8_BAR; PG8_WAIT_L(0); PG8_MMA(0, 0, At, B0); PG8_BAR; PG8_SCHED;
            PG8_LDB(B1, 1, 1); PG8_STAGE(PG8_SB(1, 0), b3, voffB);
            PG8_BAR; PG8_WAIT_L(0); PG8_MMA(0, 1, At, B1); PG8_BAR;
            PG8_LDA(At, 1, 1); PG8_STAGE(PG8_SA(1, 0), a3, voffA);
            PG8_BAR; PG8_WAIT_L(0); PG8_MMA(1, 0, At, B0); PG8_BAR; PG8_SCHED;
            PG8_STAGE(PG8_SB(1, 1), b3 + hstepB, voffB);
            PG8_WAIT_V(6); PG8_BAR; PG8_MMA(1, 1, At, B1); PG8_BAR;
        }
        asm volatile("s_nop 15\n\ts_nop 15" ::: "memory");
        E(acc, cur, wr, wc, fr, fq, pre);
        if (!has_next) break;
        cur = nxt; cA = nA; cB = nB; ++ui;
    }
    PG8_WAIT_V(0);
    if (wr == 0) PG8_BAR;
    PG8_BAR;
#undef PG8_SA
#undef PG8_SB
#undef PG8_STAGE
#undef PG8_LDA
#undef PG8_LDB
#undef PG8_MMA
#undef PG8_MMA0
#undef PG8_WAIT_V
#undef PG8_WAIT_L
#undef PG8_BAR
#undef PG8_SCHED
}

template <class Epi, class Sched>
__device__ __forceinline__ void gemm_phase_f8g(LAS unsigned char* lds, const int K  , const unsigned lda_b, const unsigned ldb_b, const Sched& S, const Epi& E, const char* Abase, const int* __restrict__ tok) {
    const int tid = opaque_tid(), wid = __builtin_amdgcn_readfirstlane(tid >> 6), lane = tid & 63, wr = wid >> 2, wc = wid & 3, fr = lane & 15, fq = lane >> 4;
    const int nt = K / 128;
    unsigned voffA[2], voffB[2];
    int RA[2]; unsigned CA[2];
#pragma unroll
    for (int i = 0; i < 2; ++i) { int R, C; stage_rc(tid * 16 + i * 8192, R, C); RA[i] = R; CA[i] = (unsigned)C * 2u; voffA[i] = 0u; voffB[i] = (unsigned)R * ldb_b + (unsigned)C * 2u; }
    unsigned cv0[2], cv1[2], nv0[2], nv1[2];
#define PG8_TOKV(v0_, v1_, row0_) do { const int t_ = opaque_tid(); _Pragma("unroll") for (int i_ = 0; i_ < 2; ++i_) { int R_, C_; stage_rc(t_ * 16 + i_ * 8192, R_, C_); v0_[i_] = (unsigned)tok[(row0_) + R_] * lda_b + (unsigned)C_ * 2u; v1_[i_] = (unsigned)tok[(row0_) + HALF + R_] * lda_b + (unsigned)C_ * 2u; } } while (0)
    const size_t kstep = (size_t)(BK * 2);
    const size_t hstepA = (size_t)HALF * lda_b, hstepB = (size_t)HALF * ldb_b;
    const unsigned ldsw = (unsigned)wid * 1024u;
    const int aoff = lds_byte(wr * 64 + fr, fq * 8), boff = lds_byte(wc * 32 + fr, fq * 8);
#define PG8_SA(b, h) (((b) * 2 + (h)) * HTB)
#define PG8_SB(b, h) ((4 + (b) * 2 + (h)) * HTB)
#define PG8_STAGE(bufoff, gbase, voff) do { _Pragma("unroll") for (int _i = 0; _i < 2; ++_i) \
        __builtin_amdgcn_global_load_lds((const unsigned*)((const char*)(gbase) + (voff)[_i]), (LAS unsigned*)(lds + (bufoff) + ldsw + _i * 8192), 16, 0, 0); } while (0)
#define PG8_LDA(dst, b, h) do { _Pragma("unroll") for (int m = 0; m < 4; ++m) { const v4i_t lo_ = *(const LAS v4i_t*)(lds + PG8_SA(b, h) + aoff + m * 2048), hi_ = *(const LAS v4i_t*)(lds + PG8_SA(b, h) + aoff + m * 2048 + 1024); dst[m] = __builtin_shufflevector(lo_, hi_, 0, 1, 2, 3, 4, 5, 6, 7); } } while (0)
#define PG8_LDB(dst, b, h) do { _Pragma("unroll") for (int n = 0; n < 2; ++n) { const v4i_t lo_ = *(const LAS v4i_t*)(lds + PG8_SB(b, h) + boff + n * 2048), hi_ = *(const LAS v4i_t*)(lds + PG8_SB(b, h) + boff + n * 2048 + 1024); dst[n] = __builtin_shufflevector(lo_, hi_, 0, 1, 2, 3, 4, 5, 6, 7); } } while (0)
#define PG8_MMA(ai, bj, At, Bt) do { __builtin_amdgcn_s_setprio(1); _Pragma("unroll") for (int m = 0; m < 4; ++m) _Pragma("unroll") for (int n = 0; n < 2; ++n) \
        asm volatile("v_mfma_scale_f32_16x16x128_f8f6f4 %0, %1, %2, %0, %3, %3 op_sel_hi:[0,0,0]" : "+v"(acc[ai][bj][m][n]) : "v"(Bt[n]), "v"(At[m]), "v"(unit_scale)); __builtin_amdgcn_s_setprio(0); } while (0)
#define PG8_WAIT_V(n) asm volatile("s_waitcnt vmcnt(" #n ")" ::: "memory")
#define PG8_WAIT_L(n) asm volatile("s_waitcnt lgkmcnt(" #n ")" ::: "memory")
#define PG8_BAR __builtin_amdgcn_s_barrier()
#define PG8_SCHED __builtin_amdgcn_sched_barrier(0)
    const int unit_scale = 0x7f7f7f7f;
    GUnit cur, nxt; int ui = 0;
    if (!S.next(0, cur)) return;
    f32x4 acc[2][2][4][2];
#pragma unroll
    for (int a = 0; a < 2; ++a)
#pragma unroll
        for (int b = 0; b < 2; ++b)
#pragma unroll
            for (int m = 0; m < 4; ++m)
#pragma unroll
                for (int n = 0; n < 2; ++n) acc[a][b][m][n] = (f32x4){0.f, 0.f, 0.f, 0.f};
    v8i_t At[4], B0[2], B1[2];
    const char* cB = cur.B;
    PG8_TOKV(cv0, cv1, cur.row0);
    PG8_STAGE(PG8_SB(0, 0), cB, voffB); PG8_STAGE(PG8_SA(0, 0), Abase, cv0); PG8_STAGE(PG8_SB(0, 1), cB + hstepB, voffB); PG8_STAGE(PG8_SA(0, 1), Abase, cv1);
    if (wr == 1) PG8_BAR;
    PG8_WAIT_V(4); PG8_BAR;
    PG8_STAGE(PG8_SB(1, 0), cB + kstep, voffB); PG8_STAGE(PG8_SA(1, 0), Abase + kstep, cv0); PG8_STAGE(PG8_SB(1, 1), cB + hstepB + kstep, voffB);
    PG8_WAIT_V(6); PG8_BAR;
    for (;;) {
        const bool has_next = S.next(ui + 1, nxt);
        const typename Epi::Pre pre = E.preload(cur, wr, wc, fr, fq);
        const char* nB = has_next ? nxt.B : cB;
        if (has_next) PG8_TOKV(nv0, nv1, nxt.row0); else { nv0[0] = cv0[0]; nv0[1] = cv0[1]; nv1[0] = cv1[0]; nv1[1] = cv1[1]; }
#pragma nounroll
        for (int t = 0; t < nt; t += 2) {
            const bool last = (t == nt - 2);
            const char* a1 = Abase + (size_t)(t + 1) * kstep;
            const char* a2 = last ? Abase : Abase + (size_t)(t + 2) * kstep; const char* b2 = last ? nB : cB + (size_t)(t + 2) * kstep;
            const char* a3 = a2 + kstep; const char* b3 = b2 + kstep;
            unsigned v20[2], v21[2];
            v20[0] = last ? nv0[0] : cv0[0]; v20[1] = last ? nv0[1] : cv0[1]; v21[0] = last ? nv1[0] : cv1[0]; v21[1] = last ? nv1[1] : cv1[1];
            PG8_LDB(B0, 0, 0); PG8_SCHED; PG8_LDA(At, 0, 0); PG8_STAGE(PG8_SA(1, 1), a1, cv1);
            PG8_WAIT_L(8); PG8_BAR; PG8_WAIT_L(0); PG8_MMA(0, 0, At, B0); PG8_BAR; PG8_SCHED;
            PG8_LDB(B1, 0, 1); PG8_STAGE(PG8_SB(0, 0), b2, voffB);
            PG8_BAR; PG8_WAIT_L(0); PG8_MMA(0, 1, At, B1); PG8_BAR;
            PG8_LDA(At, 0, 1); PG8_STAGE(PG8_SA(0, 0), a2, v20);
            PG8_BAR; PG8_WAIT_L(0); PG8_MMA(1, 0, At, B0); PG8_BAR; PG8_SCHED;
            PG8_STAGE(PG8_SB(0, 1), b2 + hstepB, voffB);
            PG8_WAIT_V(6); PG8_BAR; PG8_MMA(1, 1, At, B1); PG8_BAR;
            PG8_LDB(B0, 1, 0); PG8_SCHED; PG8_LDA(At, 1, 0); PG8_STAGE(PG8_SA(0, 1), a2, v21);
            PG8_WAIT_L(8); PG8_BAR; PG8_WAIT_L(0); PG8_MMA(0, 0, At, B0); PG8_BAR; PG8_SCHED;
            PG8_LDB(B1, 1, 1); PG8_STAGE(PG8_SB(1, 0), b3, voffB);
            PG8_BAR; PG8_WAIT_L(0); PG8_MMA(0, 1, At, B1); PG8_BAR;
            PG8_LDA(At, 1, 1); PG8_STAGE(PG8_SA(1, 0), a3, v20);
            PG8_BAR; PG8_WAIT_L(0); PG8_MMA(1, 0, At, B0); PG8_BAR; PG8_SCHED;
            PG8_STAGE(PG8_SB(1, 1), b3 + hstepB, voffB);
            PG8_WAIT_V(6); PG8_BAR; PG8_MMA(1, 1, At, B1); PG8_BAR;
        }
        asm volatile("s_nop 15\n\ts_nop 15" ::: "memory");
        E(acc, cur, wr, wc, fr, fq, pre);
        if (!has_next) break;
#pragma unroll
        for (int a = 0; a < 2; ++a)
#pragma unroll
            for (int b = 0; b < 2; ++b)
#pragma unroll
                for (int m = 0; m < 4; ++m)
#pragma unroll
                    for (int n = 0; n < 2; ++n) acc[a][b][m][n] = (f32x4){0.f, 0.f, 0.f, 0.f};
        cur = nxt; cB = nB; ++ui; cv0[0] = nv0[0]; cv0[1] = nv0[1]; cv1[0] = nv1[0]; cv1[1] = nv1[1];
    }
    PG8_WAIT_V(0);
    if (wr == 0) PG8_BAR;
    PG8_BAR;
#undef PG8_TOKV
#undef PG8_SA
#undef PG8_SB
#undef PG8_STAGE
#undef PG8_LDA
#undef PG8_LDB
#undef PG8_MMA
#undef PG8_WAIT_V
#undef PG8_WAIT_L
#undef PG8_BAR
#undef PG8_SCHED
}

__device__ __forceinline__ void dense_map(int L, int nM, int nN, int& pm, int& pn) {
    const int nwg = nM * nN;
    int wgid = L; { const int q = nwg / 8, r = nwg % 8, xcd = wgid % 8, off = wgid / 8; wgid = (xcd < r ? xcd * (q + 1) : r * (q + 1) + (xcd - r) * q) + off; }
    const int nig = 8 * nN, gid = wgid / nig, fm = gid * 8, gsz = (nM - fm) < 8 ? (nM - fm) : 8;
    pm = fm + ((wgid % nig) % gsz); pn = (wgid % nig) / gsz;
}
struct DenseOrder {
    const char* A; const char* Bt; unsigned lda_b, ldb_b; int nM, nN, nwg, G, c; unsigned aux_mask = 0u;
    __device__ void init(const void* A_, const void* Bt_, int M, int N, unsigned lda_b_, unsigned ldb_b_, int G_, int c_) { A = (const char*)A_; Bt = (const char*)Bt_; lda_b = lda_b_; ldb_b = ldb_b_; nM = M / BM; nN = N / BM; nwg = nM * nN; G = G_; c = c_; }
    __device__ bool next(int i, GUnit& u) const {
        const long L = (long)i * G + c; if (L >= nwg) return false;
        int pm, pn; dense_map((int)L, nM, nN, pm, pn);
        u.A = A + (size_t)pm * BM * lda_b; u.B = Bt + (size_t)pn * BM * ldb_b; u.row0 = pm * BM; u.col0 = pn * BM; u.aux = (int)((aux_mask >> pn) & 1u); return true;
    }
};


struct OneUnit {
    GUnit u;
    __device__ bool next(int i, GUnit& o) const { if (i != 0) return false; o = u; return true; }
};
struct EpiF32R {
    float* C; int ldc; const float* res; int ncols;
    __device__ __forceinline__ void operator()(const f32x4 (&acc)[2][2][4][2], const GUnit& u, int wr, int wc, int fr, int fq) const {
        const int row0 = u.row0 + wr * 64 + fr, col0 = u.col0 + wc * 32 + 4 * fq;
#pragma unroll
        for (int ai = 0; ai < 2; ++ai)
#pragma unroll
            for (int m = 0; m < 4; ++m) {
                const size_t ro = (size_t)(row0 + ai * HALF + m * 16) * ldc;
#pragma unroll
                for (int bj = 0; bj < 2; ++bj)
#pragma unroll
                    for (int n = 0; n < 2; ++n) {
                        const int col = col0 + bj * HALF + n * 16;
                        if (col < ncols) { f32x4 x = acc[ai][bj][m][n]; if (res) x += *(const f32x4*)(res + ro + col); *(f32x4*)(C + ro + col) = x; }
                    }
            }
    }
};


struct EpiResNormStats {
    const float* res; bf16_t* Hb; float* ss; unsigned char* H8;
    __device__ __forceinline__ void operator()(const f32x4 (&acc)[2][2][4][2], const GUnit& u, int wr, int wc, int fr, int fq) const {
        const int row0 = u.row0 + wr * 64 + fr, col0 = u.col0 + wc * 32 + 4 * fq;
#pragma unroll
        for (int ai = 0; ai < 2; ++ai) {
            f32x4 r[4][2][2];
#pragma unroll
            for (int m = 0; m < 4; ++m)
#pragma unroll
                for (int bj = 0; bj < 2; ++bj)
#pragma unroll
                    for (int n = 0; n < 2; ++n) r[m][bj][n] = *(const f32x4*)(res + (size_t)(row0 + ai * HALF + m * 16) * 1024 + col0 + bj * HALF + n * 16);
            asm volatile("" ::: "memory");
#pragma unroll
            for (int m = 0; m < 4; ++m) {
                const int row = row0 + ai * HALF + m * 16;
                const size_t ro = (size_t)row * 1024;
                float sq = 0.f;
                unsigned d8[4];
#pragma unroll
                for (int bj = 0; bj < 2; ++bj) {
                    uint2 o[2];
#pragma unroll
                    for (int n = 0; n < 2; ++n) {
                        const f32x4 x = acc[ai][bj][m][n] + r[m][bj][n];
                        o[n].x = cvt_pk_bf16(x[0], x[1]); o[n].y = cvt_pk_bf16(x[2], x[3]);
                        d8[bj * 2 + n] = pk4_fp8(x[0], x[1], x[2], x[3]);
                        sq += x[0] * x[0] + x[1] * x[1] + x[2] * x[2] + x[3] * x[3];
                    }
                    *(uint4*)(Hb + ro + u.col0 + wc * 32 + bj * HALF + pair16_col(fq)) = pair16(o[0], o[1]);
                }
                *(uint4*)(H8 + ro + u.col0 + wc * 64 + fq * 16) = make_uint4(d8[0], d8[1], d8[2], d8[3]);
                sq += __shfl_xor(sq, 16); sq += __shfl_xor(sq, 32);
                if (fq == 0) ss[(size_t)row * 16 + (u.col0 >> 8) * 4 + wc] = sq;
            }
            asm volatile("" ::: "memory");
        }
    }
};
struct EpiBf16RowScale {
    bf16_t* O; const float* ss; float scale;
    struct Pre {};
    __device__ __forceinline__ Pre preload(const GUnit&, int, int, int, int) const { return Pre{}; }
    __device__ __forceinline__ void operator()(const f32x4 (&acc)[2][2][4][2], const GUnit& u, int wr, int wc, int fr, int fq, const Pre&) const {
        const int row0 = u.row0 + wr * 64 + fr;
        f32x4 sv[2][4];
#pragma unroll
        for (int ai = 0; ai < 2; ++ai)
#pragma unroll
            for (int m = 0; m < 4; ++m) sv[ai][m] = *(const f32x4*)(ss + (size_t)(row0 + ai * HALF + m * 16) * 16 + 4 * fq);
        asm volatile("" ::: "memory");
#pragma unroll
        for (int ai = 0; ai < 2; ++ai)
#pragma unroll
            for (int m = 0; m < 4; ++m) {
                const f32x4 v = sv[ai][m];
                float tot = (v[0] + v[1]) + (v[2] + v[3]);
                tot += lane_xor16(tot); tot += lane_xor32(tot);
                const float rs = rsqrtf(tot * (1.f / 1024.f) + 1e-5f) * scale;
                bf16_t* rowp = O + (size_t)(row0 + ai * HALF + m * 16) * 1024 + u.col0 + wc * 32 + pair16_col(fq);
#pragma unroll
                for (int bj = 0; bj < 2; ++bj) {
                    uint2 o[2];
#pragma unroll
                    for (int n = 0; n < 2; ++n) { const f32x4 x = acc[ai][bj][m][n] * rs; o[n].x = cvt_pk_bf16(x[0], x[1]); o[n].y = cvt_pk_bf16(x[2], x[3]); }
                    *(uint4*)(rowp + bj * HALF) = pair16(o[0], o[1]);
                }
            }
    }
};

struct EpiBf16Res {
    bf16_t* H; float scale;
    struct Pre {};
    __device__ __forceinline__ Pre preload(const GUnit&, int, int, int, int) const { return Pre{}; }
    __device__ __forceinline__ void operator()(const f32x4 (&acc)[2][2][4][2], const GUnit& u, int wr, int wc, int fr, int fq, const Pre&) const {
        bf16_t* base = H + (size_t)(u.row0 + wr * 64 + fr) * 1024 + u.col0 + wc * 32 + pair16_col(fq);
        uint4 v[2][4][2];
#pragma unroll
        for (int ai = 0; ai < 2; ++ai)
#pragma unroll
            for (int m = 0; m < 4; ++m)
#pragma unroll
                for (int bj = 0; bj < 2; ++bj) v[ai][m][bj] = *(const uint4*)(base + (size_t)(ai * HALF + m * 16) * 1024 + bj * HALF);
        asm volatile("" ::: "memory");
#pragma unroll
        for (int ai = 0; ai < 2; ++ai)
#pragma unroll
            for (int m = 0; m < 4; ++m)
#pragma unroll
                for (int bj = 0; bj < 2; ++bj) {
                    const uint4 pc = pair16(make_uint2(v[ai][m][bj].x, v[ai][m][bj].y), make_uint2(v[ai][m][bj].z, v[ai][m][bj].w));
                    const uint2 rr[2] = {make_uint2(pc.x, pc.y), make_uint2(pc.z, pc.w)};
                    uint2 o[2];
#pragma unroll
                    for (int n = 0; n < 2; ++n) {
                        const uint2 r = rr[n];
                        const f32x4 a = acc[ai][bj][m][n] * scale;
                        o[n].x = cvt_pk_bf16(a[0] + __uint_as_float(r.x << 16), a[1] + __uint_as_float(r.x & 0xffff0000u)); o[n].y = cvt_pk_bf16(a[2] + __uint_as_float(r.y << 16), a[3] + __uint_as_float(r.y & 0xffff0000u));
                    }
                    *(uint4*)(base + (size_t)(ai * HALF + m * 16) * 1024 + bj * HALF) = pair16(o[0], o[1]);
                }
    }
};
struct EpiBf16S {
    bf16_t* O; int ldc; float scale;
    __device__ __forceinline__ void operator()(const f32x4 (&acc)[2][2][4][2], const GUnit& u, int wr, int wc, int fr, int fq) const {
        const int row0 = u.row0 + wr * 64 + fr, col0 = u.col0 + wc * 32 + 4 * fq;
#pragma unroll
        for (int ai = 0; ai < 2; ++ai)
#pragma unroll
            for (int m = 0; m < 4; ++m) {
                bf16_t* rowp = O + (size_t)(row0 + ai * HALF + m * 16) * ldc + col0;
#pragma unroll
                for (int bj = 0; bj < 2; ++bj)
#pragma unroll
                    for (int n = 0; n < 2; ++n) { const f32x4 x = acc[ai][bj][m][n] * scale; uint2 o; o.x = cvt_pk_bf16(x[0], x[1]); o.y = cvt_pk_bf16(x[2], x[3]); *(uint2*)(rowp + bj * HALF + n * 16) = o; }
            }
    }
};
struct EpiXkv {
    bf16_t *xk, *xvT;
    __device__ __forceinline__ void operator()(const f32x4 (&acc)[2][2][4][2], const GUnit& u, int wr, int wc, int fr, int fq) const {
        const int row0 = u.row0 + wr * 64 + fr, col0 = u.col0 + wc * 32 + 4 * fq;
        const bool isv = u.col0 >= 1024;
#pragma unroll
        for (int ai = 0; ai < 2; ++ai)
#pragma unroll
            for (int m = 0; m < 4; ++m) {
                const int row = row0 + ai * HALF + m * 16, b = row >> 8, key = row & 255;
#pragma unroll
                for (int bj = 0; bj < 2; ++bj)
#pragma unroll
                    for (int n = 0; n < 2; ++n) {
                        const int col = (col0 + bj * HALF + n * 16) & 1023, h = col >> 8, d = col & 255;
                        const f32x4 x = acc[ai][bj][m][n];
                        uint2 o; o.x = cvt_pk_bf16_acc(x[0], x[1]); o.y = cvt_pk_bf16_acc(x[2], x[3]);
                        if (!isv) *(uint2*)(xk + ((size_t)(b * 4 + h) * 256 + key) * 256 + d) = o;
                        else { bf16_t* base = xvT + ((size_t)(b * 4 + h) * 256 + d) * 256 + key;
                               base[0] = (bf16_t)(o.x & 0xffff); base[256] = (bf16_t)(o.x >> 16); base[512] = (bf16_t)(o.y & 0xffff); base[768] = (bf16_t)(o.y >> 16); }
                    }
            }
    }
};

struct EpiMixIn {
    bf16_t *q, *kk  , *vt  , *u, *cb; float* gates; const float* cosT; const float* sinT;
    __device__ __forceinline__ void operator()(const f32x4 (&acc)[2][2][4][2], const GUnit& un, int wr, int wc, int fr, int fq) const {
        const int pn = un.col0 >> 8, pc = pair16_col(fq);
        if (pn <= 4) {
            if (pn >= 3 && wc >= 2) {
                const int v = 2 * wr + wc - 2, b = un.row0 >> 11;
#pragma unroll
                for (int ai = 0; ai < 2; ++ai)
#pragma unroll
                    for (int m = 0; m < 4; ++m) {
                        bf16_t* base = vt + (size_t)(pn - 3) * ((size_t)T * 128) + ((size_t)(b * 2 + (m >> 1)) * 64 + 32 * ai + 16 * (m & 1) + fr) * S + ((un.row0 + 32 * v) & (S - 1));
#pragma unroll
                        for (int bj = 0; bj < 2; ++bj) {
                            const f32x4 xa = acc[ai][bj][m][0], xb = acc[ai][bj][m][1];
                            uint2 pa, pb; pa.x = cvt_pk_bf16_acc(xa[0], xa[1]); pa.y = cvt_pk_bf16_acc(xa[2], xa[3]); pb.x = cvt_pk_bf16_acc(xb[0], xb[1]); pb.y = cvt_pk_bf16_acc(xb[2], xb[3]);
                            *(uint4*)(base + bj * HALF + pc) = pair16(pa, pb);
                        }
                    }
                return;
            }
            const bool rope = (pn < 2) || (wc < 2);
            const int trow = un.row0 + wr * 64 + fr;
            uint4 cs[2][4][2];
            if (rope) {
#pragma unroll
                for (int ai = 0; ai < 2; ++ai)
#pragma unroll
                    for (int m = 0; m < 4; ++m)
#pragma unroll
                        for (int n = 0; n < 2; ++n) cs[ai][m][n] = *(const uint4*)((const unsigned*)cosT + (size_t)(trow + ai * HALF + m * 16) * 32 + 16 * n + 4 * fq);
            } else {
#pragma unroll
                for (int ai = 0; ai < 2; ++ai)
#pragma unroll
                    for (int m = 0; m < 4; ++m)
#pragma unroll
                        for (int n = 0; n < 2; ++n) cs[ai][m][n] = make_uint4(0x3c00u, 0x3c00u, 0x3c00u, 0x3c00u);
            }
            asm volatile("" ::: "memory");
            const float qs = (pn < 2) ? QS : 1.f;
#pragma unroll
            for (int ai = 0; ai < 2; ++ai)
#pragma unroll
                for (int m = 0; m < 4; ++m) {
                    const int t = trow + ai * HALF + m * 16, b = t >> 11, sq = t & 2047;
                    uint2 o[2][2];
#pragma unroll
                    for (int n = 0; n < 2; ++n) {
                        const f32x4 x0 = acc[ai][0][m][n], x1 = acc[ai][1][m][n];
                        const unsigned cw[4] = {cs[ai][m][n].x, cs[ai][m][n].y, cs[ai][m][n].z, cs[ai][m][n].w};
                        float r0[4], r1[4];
#pragma unroll
                        for (int j = 0; j < 4; ++j) {
                            const h2_t hv = __builtin_bit_cast(h2_t, cw[j]);
                            const float c = (float)hv[0] * qs, sn = (float)hv[1] * qs;
                            r0[j] = x0[j] * c - x1[j] * sn; r1[j] = x1[j] * c + x0[j] * sn;
                        }
                        o[0][n].x = cvt_pk_bf16(r0[0], r0[1]); o[0][n].y = cvt_pk_bf16(r0[2], r0[3]); o[1][n].x = cvt_pk_bf16(r1[0], r1[1]); o[1][n].y = cvt_pk_bf16(r1[2], r1[3]);
                    }
                    bf16_t* dst;
                    if (pn < 2) dst = q + (size_t)t * 512 + (pn * 4 + wc) * 64;
                    else {
                        const int ki = (pn == 2) ? (wc >> 1) : pn - 1;
                        dst = kk + (size_t)ki * ((size_t)T * 128) + ((size_t)(b * 2 + (wc & 1)) * S + sq) * 64;
                    }
                    *(uint4*)(dst + pc) = pair16(o[0][0], o[0][1]); *(uint4*)(dst + 32 + pc) = pair16(o[1][0], o[1][1]);
                }
        } else if (pn < 9) {
#pragma unroll
            for (int ai = 0; ai < 2; ++ai)
#pragma unroll
                for (int m = 0; m < 4; ++m) {
                    const int t = un.row0 + ai * HALF + wr * 64 + m * 16 + fr;
                    uint2 o[2];
#pragma unroll
                    for (int n = 0; n < 2; ++n) {
                        const f32x4 x = acc[ai][0][m][n] * acc[ai][1][m][n];
                        o[n].x = cvt_pk_bf16(x[0], x[1]); o[n].y = cvt_pk_bf16(x[2], x[3]);
                    }
                    *(uint4*)(u + (size_t)t * 512 + (pn - 5) * 128 + wc * 32 + pc) = pair16(o[0], o[1]);
                }
        } else if (pn < 11) {
#pragma unroll
            for (int ai = 0; ai < 2; ++ai)
#pragma unroll
                for (int m = 0; m < 4; ++m) {
                    const int t = un.row0 + ai * HALF + wr * 64 + m * 16 + fr;
#pragma unroll
                    for (int bj = 0; bj < 2; ++bj) {
                        uint2 o[2];
#pragma unroll
                        for (int n = 0; n < 2; ++n) {
                            const f32x4 x = acc[ai][bj][m][n];
                            o[n].x = cvt_pk_bf16_acc(x[0], x[1]); o[n].y = cvt_pk_bf16_acc(x[2], x[3]);
                        }
                        *(uint4*)(cb + (size_t)t * 512 + (pn - 9) * 256 + bj * 128 + wc * 32 + pc) = pair16(o[0], o[1]);
                    }
                }
        } else if (wc == 0) {
#pragma unroll
            for (int ai = 0; ai < 2; ++ai)
#pragma unroll
                for (int m = 0; m < 4; ++m) {
                    const int t = un.row0 + ai * HALF + wr * 64 + m * 16 + fr;
#pragma unroll
                    for (int n = 0; n < 2; ++n)
                        if (n == 0 || fq < 2) {
                            const f32x4 x = acc[ai][0][m][n];
                            f32x4 sg;
#pragma unroll
                            for (int j = 0; j < 4; ++j) sg[j] = 1.f / (1.f + __expf(-x[j]));
                            *(f32x4*)(gates + (size_t)t * 24 + 16 * n + 4 * fq) = sg;
                        }
                }
        }
    }
};
struct EpiSwiglu {
    bf16_t* H; const float* bias;
    __device__ __forceinline__ void operator()(const f32x4 (&acc)[2][2][4][2], const GUnit& u, int wr, int wc, int fr, int fq) const {
        const int row0 = u.row0 + wr * 64 + fr, pn = u.col0 >> 8, cl0 = wc * 32 + 4 * fq;
        const float* bg = bias + (size_t)u.aux * 2048 + pn * 128 + cl0;
        f32x4 bgv[2], buv[2];
#pragma unroll
        for (int n = 0; n < 2; ++n) { bgv[n] = *(const f32x4*)(bg + n * 16); buv[n] = *(const f32x4*)(bg + 1024 + n * 16); }
#pragma unroll
        for (int ai = 0; ai < 2; ++ai)
#pragma unroll
            for (int m = 0; m < 4; ++m) {
                bf16_t* rowp = H + (size_t)(row0 + ai * HALF + m * 16) * 1024 + pn * 128 + cl0;
#pragma unroll
                for (int n = 0; n < 2; ++n) {
                    const f32x4 g4 = acc[ai][0][m][n] + bgv[n], u4 = acc[ai][1][m][n] + buv[n];
                    float h[4];
#pragma unroll
                    for (int j = 0; j < 4; ++j) {
                        const float g = fminf(g4[j], 7.f), uu = fminf(fmaxf(u4[j], -7.f), 7.f);
                        h[j] = (uu + 1.f) * (g / (1.f + __expf(-1.702f * g)));
                    }
                    uint2 o; o.x = cvt_pk_bf16(h[0], h[1]); o.y = cvt_pk_bf16(h[2], h[3]);
                    *(uint2*)(rowp + n * 16) = o;
                }
            }
    }
};
struct EpiDownScale {
    bf16_t* O; const float* bias; const float* w_buf;
    __device__ __forceinline__ void operator()(const f32x4 (&acc)[2][2][4][2], const GUnit& u, int wr, int wc, int fr, int fq) const {
        const int row0 = u.row0 + wr * 64 + fr, col0 = u.col0 + wc * 32 + 4 * fq;
        f32x4 bv[2][2];
#pragma unroll
        for (int bj = 0; bj < 2; ++bj)
#pragma unroll
            for (int n = 0; n < 2; ++n) bv[bj][n] = *(const f32x4*)(bias + (size_t)u.aux * 1024 + col0 + bj * HALF + n * 16);
#pragma unroll
        for (int ai = 0; ai < 2; ++ai)
#pragma unroll
            for (int m = 0; m < 4; ++m) {
                const int row = row0 + ai * HALF + m * 16;
                const float w = w_buf[row];
                bf16_t* rowp = O + (size_t)row * 1024 + col0;
#pragma unroll
                for (int bj = 0; bj < 2; ++bj)
#pragma unroll
                    for (int n = 0; n < 2; ++n) {
                        const f32x4 x = (acc[ai][bj][m][n] + bv[bj][n]) * w;
                        uint2 o; o.x = cvt_pk_bf16(x[0], x[1]); o.y = cvt_pk_bf16(x[2], x[3]);
                        *(uint2*)(rowp + bj * HALF + n * 16) = o;
                    }
            }
    }
};

constexpr float W8_SCALE = 64.f, W8_INV = 1.f / 64.f;
__device__ __forceinline__ unsigned pk4_fp8(float a, float b, float c, float d) { unsigned w = 0; w = __builtin_amdgcn_cvt_pk_fp8_f32(a, b, w, false); w = __builtin_amdgcn_cvt_pk_fp8_f32(c, d, w, true); return w; }
struct EpiSwigluF8out {
    unsigned char* H; const float* bias;
    __device__ __forceinline__ void operator()(const f32x4 (&acc)[2][2][4][2], const GUnit& u, int wr, int wc, int fr, int fq) const {
        const int row0 = u.row0 + wr * 64 + fr, pn = u.col0 >> 8, cl0 = wc * 32 + 4 * fq;
        const float* bg = bias + (size_t)u.aux * 2048 + pn * 128 + cl0;
        f32x4 bgv[2], buv[2];
#pragma unroll
        for (int n = 0; n < 2; ++n) { bgv[n] = *(const f32x4*)(bg + n * 16); buv[n] = *(const f32x4*)(bg + 1024 + n * 16); }
#pragma unroll
        for (int ai = 0; ai < 2; ++ai)
#pragma unroll
            for (int m = 0; m < 4; ++m) {
                unsigned char* rowp = H + (size_t)(row0 + ai * HALF + m * 16) * 1024 + pn * 128 + cl0;
#pragma unroll
                for (int n = 0; n < 2; ++n) {
                    const f32x4 g4 = acc[ai][0][m][n] + bgv[n], u4 = acc[ai][1][m][n] + buv[n];
                    float h[4];
#pragma unroll
                    for (int j = 0; j < 4; ++j) {
                        const float g = fminf(g4[j], 7.f), uu = fminf(fmaxf(u4[j], -7.f), 7.f);
                        h[j] = (uu + 1.f) * (g / (1.f + __expf(-1.702f * g)));
                    }
                    *(unsigned*)(rowp + n * 16) = pk4_fp8(h[0], h[1], h[2], h[3]);
                }
            }
    }
};
struct EpiSwigluF8 {
    unsigned char* H; const float* bias;
    struct Pre { f32x4 bgv[2], buv[2]; };
    __device__ __forceinline__ Pre preload(const GUnit& u, int wr, int wc, int fr, int fq) const {
        Pre q; const int pn = u.col0 >> 8, cl0 = wc * 32 + 4 * fq;
        const float* bg = bias + (size_t)u.aux * 2048 + pn * 128 + cl0;
#pragma unroll
        for (int n = 0; n < 2; ++n) { q.bgv[n] = *(const f32x4*)(bg + n * 16); q.buv[n] = *(const f32x4*)(bg + 1024 + n * 16) + 1.f; }
        return q;
    }
    __device__ __forceinline__ void operator()(const f32x4 (&acc)[2][2][4][2], const GUnit& u, int wr, int wc, int fr, int fq, const Pre& q) const {
        const int row0 = u.row0 + wr * 64 + fr, pn = u.col0 >> 8, cl0 = wc * 32 + 4 * fq;
        f32x4 bgv[2], buv[2];
#pragma unroll
        for (int n = 0; n < 2; ++n) { bgv[n] = q.bgv[n]; buv[n] = q.buv[n]; }
#pragma unroll
        for (int ai = 0; ai < 2; ++ai)
#pragma unroll
            for (int m = 0; m < 4; ++m) {
                unsigned d[2];
#pragma unroll
                for (int n = 0; n < 2; ++n) {
                    float h[4];
#pragma unroll
                    for (int hf = 0; hf < 2; ++hf) {
                        const f32x2_t ag = {acc[ai][0][m][n][2 * hf], acc[ai][0][m][n][2 * hf + 1]}, au = {acc[ai][1][m][n][2 * hf], acc[ai][1][m][n][2 * hf + 1]};
                        const f32x2_t bg2 = {bgv[n][2 * hf], bgv[n][2 * hf + 1]}, bu2 = {buv[n][2 * hf], buv[n][2 * hf + 1]};
                        f32x2_t g2 = __builtin_elementwise_fma(ag, (f32x2_t){W8_INV, W8_INV}, bg2), u2 = __builtin_elementwise_fma(au, (f32x2_t){W8_INV, W8_INV}, bu2);
                        g2 = (f32x2_t){fminf(g2[0], 7.f), fminf(g2[1], 7.f)};
                        u2 = (f32x2_t){fminf(fmaxf(u2[0], -6.f), 8.f), fminf(fmaxf(u2[1], -6.f), 8.f)};
                        const f32x2_t z = g2 * (f32x2_t){-1.702f * 1.4426950408889634f, -1.702f * 1.4426950408889634f};
                        const f32x2_t e = (f32x2_t){__builtin_amdgcn_exp2f(z[0]), __builtin_amdgcn_exp2f(z[1])} + (f32x2_t){1.f, 1.f};
                        const f32x2_t r = {__builtin_amdgcn_rcpf(e[0]), __builtin_amdgcn_rcpf(e[1])};
                        const f32x2_t hh = (u2 * g2) * r;
                        h[2 * hf] = hh[0]; h[2 * hf + 1] = hh[1];
                    }
                    d[n] = pk4_fp8(h[0], h[1], h[2], h[3]);
                }
                *(uint2*)(H + (size_t)(row0 + ai * HALF + m * 16) * 1024 + pn * 128 + wc * 32 + fq * 8) = make_uint2(d[0], d[1]);
            }
    }
};
struct EpiDownScaleF8 {
    unsigned char* O; const float* bias; const float* w_buf;
    struct Pre { f32x4 bv[2][2]; float w[2][4]; };
    __device__ __forceinline__ Pre preload(const GUnit& u, int wr, int wc, int fr, int fq) const {
        Pre q; const int row0 = u.row0 + wr * 64 + fr, col0 = u.col0 + wc * 32 + 4 * fq;
#pragma unroll
        for (int bj = 0; bj < 2; ++bj)
#pragma unroll
            for (int n = 0; n < 2; ++n) q.bv[bj][n] = *(const f32x4*)(bias + (size_t)u.aux * 1024 + col0 + bj * HALF + n * 16);
#pragma unroll
        for (int ai = 0; ai < 2; ++ai)
#pragma unroll
            for (int m = 0; m < 4; ++m) q.w[ai][m] = w_buf[row0 + ai * HALF + m * 16];
        return q;
    }
    __device__ __forceinline__ void operator()(const f32x4 (&acc)[2][2][4][2], const GUnit& u, int wr, int wc, int fr, int fq, const Pre& q) const {
        const int row0 = u.row0 + wr * 64 + fr, col0 = u.col0 + wc * 32 + 4 * fq;
        f32x4 bv[2][2];
#pragma unroll
        for (int bj = 0; bj < 2; ++bj)
#pragma unroll
            for (int n = 0; n < 2; ++n) bv[bj][n] = q.bv[bj][n];
#pragma unroll
        for (int ai = 0; ai < 2; ++ai)
#pragma unroll
            for (int m = 0; m < 4; ++m) {
                const int row = row0 + ai * HALF + m * 16;
                const float w = q.w[ai][m] * 8.f;
                unsigned d[4];
#pragma unroll
                for (int bj = 0; bj < 2; ++bj)
#pragma unroll
                    for (int n = 0; n < 2; ++n) {
                        const f32x2_t w2 = {w, w}, wi2 = {W8_INV, W8_INV};
                        const f32x2_t xl = __builtin_elementwise_fma((f32x2_t){acc[ai][bj][m][n][0], acc[ai][bj][m][n][1]}, wi2, (f32x2_t){bv[bj][n][0], bv[bj][n][1]}) * w2;
                        const f32x2_t xh = __builtin_elementwise_fma((f32x2_t){acc[ai][bj][m][n][2], acc[ai][bj][m][n][3]}, wi2, (f32x2_t){bv[bj][n][2], bv[bj][n][3]}) * w2;
                        d[bj * 2 + n] = pk4_fp8(xl[0], xl[1], xh[0], xh[1]);
                    }
                *(uint4*)(O + (size_t)row * 1024 + u.col0 + wc * 64 + fq * 16) = make_uint4(d[0], d[1], d[2], d[3]);
            }
    }
};
template <int NPN>
struct MoeOrderB {
    const char* A; const char* Bt; const int* tile_e; int nunits, G, c; size_t bt_expert_bytes; unsigned row_b;
    __device__ void init(const void* A_, const void* Bt_, const int* tile_e_, int ntiles, size_t bt_expert_bytes_, unsigned row_b_, int G_, int c_) { A = (const char*)A_; Bt = (const char*)Bt_; tile_e = tile_e_; nunits = ntiles * NPN; bt_expert_bytes = bt_expert_bytes_; row_b = row_b_; G = G_; c = c_; }
    __device__ bool next(int i, GUnit& u) const {
        const int cp = (G & 7) == 0 ? (c & 7) * (G >> 3) + (c >> 3) : c;
        const int L = i * G + cp; if (L >= nunits) return false;
        const int tl = L / NPN, pn = L % NPN, e = tile_e[tl];
        u.A = A + (size_t)tl * BM * row_b; u.B = Bt + (size_t)e * bt_expert_bytes + (size_t)pn * BM * row_b; u.row0 = tl * BM; u.col0 = pn * BM; u.aux = e; return true;
    }
};
}


__device__ __forceinline__ void posbias_wave(int n, int lane, const float* __restrict__ pos, const float* __restrict__ w1, const float* __restrict__ b1, float* __restrict__ b1p) {
    float acc = 0.f;
#pragma unroll
    for (int i = 0; i < 32; ++i) { const int k = lane + 64 * i; acc += pos[k] * w1[(size_t)k * 256 + n]; }
    acc = wave_sum(acc);
    if (lane == 0) b1p[n] = acc + b1[n];
}
__device__ __forceinline__ void p_cmp_finalize(char* lds, const float* __restrict__ Pab_k, const float* __restrict__ Pab_v, const float* __restrict__ b1p_k, const float* __restrict__ b1p_v,
                                               const float* __restrict__ w2k, const float* __restrict__ w2v, pg::bf16_t* __restrict__ kc, pg::bf16_t* __restrict__ vcT, int wg, int nwg) {
    const int lane = threadIdx.x & 63, wv = threadIdx.x >> 6;
    float* hs = (float*)lds + wv * 256;
    for (int it = wg * 8 + wv; it < 2 * 16 * 128; it += nwg * 8) {
        const int which = it >> 11, row = it & 2047, bg = row >> 7, c = row & 127;
        const float* P = which ? Pab_v : Pab_k; const float* bp = which ? b1p_v : b1p_k; const float* w2 = which ? w2v : w2k;
        float o = 0.f;
        if (c < 127) {
#pragma unroll
            for (int i = 0; i < 4; ++i) { const int n = lane + 64 * i; hs[n] = gelu_tanh(P[(size_t)row * 512 + n] + P[(size_t)(row + 1) * 512 + 256 + n] + bp[n]); }
            __builtin_amdgcn_s_waitcnt(0);
            for (int n0 = 0; n0 < 256; n0 += 16) {
                float wv[16];
#pragma unroll
                for (int j = 0; j < 16; ++j) wv[j] = w2[(n0 + j) * 64 + lane];
#pragma unroll
                for (int j = 0; j < 16; ++j) o += hs[n0 + j] * wv[j];
            }
        }
        if (which == 0) kc[(size_t)row * 64 + lane] = pg::f2bf(o); else vcT[((size_t)bg * 64 + lane) * 128 + c] = pg::f2bf(o);
    }
}

namespace at {
using pg::bf16_t;
typedef short bf16x8 __attribute__((ext_vector_type(8)));
typedef float f32x16 __attribute__((ext_vector_type(16)));
typedef float f32x4 __attribute__((ext_vector_type(4)));
constexpr int TROW = 144, TILE_B = 64 * TROW;
#define AT_MFMA(a, b, c) __builtin_amdgcn_mfma_f32_32x32x16_bf16(a, b, c, 0, 0, 0)
__device__ __forceinline__ bf16x8 pack8(const f32x16& p, int s8) {
    union { unsigned u[4]; bf16x8 v; } x;
#pragma unroll
    for (int i = 0; i < 4; ++i) x.u[i] = pg::cvt_pk_bf16(p[s8 + 2 * i], p[s8 + 2 * i + 1]);
    return x.v;
}
#define AT_MAX3(a, b, c) __builtin_fmaxf(__builtin_fmaxf((a), (b)), (c))
template <int MODE>
__device__ __forceinline__ void attn64_unit(char* lds, int b, int g, int tq, const bf16_t* __restrict__ Q, const bf16_t* __restrict__ Kh, const bf16_t* __restrict__ VT,
                                            const unsigned* __restrict__ selmask, bf16_t* __restrict__ out, const bf16_t* __restrict__ o_cmp, const bf16_t* __restrict__ o_win, const float* __restrict__ gates) {
    const int tid = opaque_tid(), lane = tid & 63, r32 = lane & 31, hi = lane >> 5;
    const int wid = __builtin_amdgcn_readfirstlane(tid >> 6), hl = wid >> 1, qs = wid & 1;
    const int ql = 32 * qs + r32, qpos = tq * 64 + ql, h = g * 4 + hl;
    const size_t trow = (size_t)b * S + qpos;
    const bf16_t* Kb = Kh + (size_t)(b * 2 + g) * S * 64;
    const bf16_t* Vb = VT + (size_t)(b * 2 + g) * 64 * S;
    const int srow = tid >> 3, sch = tid & 7;
    const int kst = srow * TROW + sch * 16;
    const int vst = TILE_B + srow * TROW + ((sch >> 1) * 16 + (sch & 1) * 4) * 2;
    bf16x8 qf[4];
#pragma unroll
    for (int d0 = 0; d0 < 4; ++d0) qf[d0] = *(const bf16x8*)(Q + trow * 512 + h * 64 + 16 * d0 + 8 * hi);
    unsigned msk = 0xffffffffu;
    if (MODE == 0) msk = selmask[(size_t)(b * 2 + g) * S + qpos];
    const int nt = (MODE == 0) ? tq + 1 : (tq < 8 ? tq + 1 : 9);
    f32x16 o0, o1;
#pragma unroll
    for (int r = 0; r < 16; ++r) { o0[r] = 0.f; o1[r] = 0.f; }
    float m = -INFINITY, l = 0.f;
    uint4 k1, v1, k2, v2;
    k1 = *(const uint4*)(Kb + (size_t)(tq * 64 + srow) * 64 + sch * 8); v1 = *(const uint4*)(Vb + (size_t)srow * S + tq * 64 + sch * 8);
    if (nt > 1) { k2 = *(const uint4*)(Kb + (size_t)((tq - 1) * 64 + srow) * 64 + sch * 8); v2 = *(const uint4*)(Vb + (size_t)srow * S + (tq - 1) * 64 + sch * 8); }
    __syncthreads();
    *(uint4*)(lds + kst) = k1; *(uint2*)(lds + vst) = make_uint2(v1.x, v1.y); *(uint2*)(lds + vst + 16) = make_uint2(v1.z, v1.w);
    asm volatile("" : "+v"(qf[0]), "+v"(qf[1]), "+v"(qf[2]), "+v"(qf[3]), "+v"(msk));
    __syncthreads();
    auto step = [&](int i, uint4& kA, uint4& vA, uint4& kB, uint4& vB) {
        if (i + 2 < nt) { const int tile = tq - i - 2; kB = *(const uint4*)(Kb + (size_t)(tile * 64 + srow) * 64 + sch * 8); vB = *(const uint4*)(Vb + (size_t)srow * S + tile * 64 + sch * 8); }
        const char* kb_ = lds + (i & 1) * 2 * TILE_B; const char* vb_ = kb_ + TILE_B;
        f32x16 p0, p1;
        bf16x8 kf[8], vf[8];
#pragma unroll
        for (int d0 = 0; d0 < 4; ++d0) { kf[2 * d0] = *(const bf16x8*)(kb_ + r32 * TROW + d0 * 32 + hi * 16); kf[2 * d0 + 1] = *(const bf16x8*)(kb_ + (32 + r32) * TROW + d0 * 32 + hi * 16); }
        asm volatile("s_waitcnt lgkmcnt(0)" ::: "memory");
#pragma unroll
        for (int ks = 0; ks < 4; ++ks) { vf[2 * ks] = *(const bf16x8*)(vb_ + r32 * TROW + ks * 32 + hi * 16); vf[2 * ks + 1] = *(const bf16x8*)(vb_ + (32 + r32) * TROW + ks * 32 + hi * 16); }
        {
            const f32x16 z16 = {0.f, 0.f, 0.f, 0.f, 0.f, 0.f, 0.f, 0.f, 0.f, 0.f, 0.f, 0.f, 0.f, 0.f, 0.f, 0.f};
            p0 = AT_MFMA(kf[0], qf[0], z16); p1 = AT_MFMA(kf[1], qf[0], z16);
        }
#pragma unroll
        for (int d0 = 1; d0 < 4; ++d0) { p0 = AT_MFMA(kf[2 * d0], qf[d0], p0); p1 = AT_MFMA(kf[2 * d0 + 1], qf[d0], p1); }
        asm volatile("s_nop 15\n\ts_nop 7" : "+v"(p0), "+v"(p1));
        float mx;
        asm volatile("v_max3_f32 %0, %1, %2, %3" : "=v"(mx) : "v"(p0[0]), "v"(p1[0]), "v"(p0[1]));
        asm volatile("v_max3_f32 %0, %1, %2, %3" : "=v"(mx) : "v"(mx), "v"(p1[1]), "v"(p0[2]));
#pragma unroll
        for (int r = 2; r < 15; ++r) asm volatile("v_max3_f32 %0, %1, %2, %3" : "=v"(mx) : "v"(mx), "v"(p1[r]), "v"(p0[r + 1]));
        asm volatile("v_max3_f32 %0, %1, %2, %3" : "=v"(mx) : "v"(mx), "v"(p1[15]), "v"(p1[15]));
        mx = fmaxf(mx, lane_xor32(mx));
        if (i == 0) m = mx;
        else if (__builtin_amdgcn_ballot_w64(mx > m + 8.f) != 0ull) {
            const float mn = fmaxf(m, mx), alpha = __builtin_amdgcn_exp2f(m - mn);
            m = mn; l *= alpha;
#pragma unroll
            for (int r = 0; r < 16; ++r) { o0[r] *= alpha; o1[r] *= alpha; }
        }
        f32x16 e0, e1;
#pragma unroll
        for (int r = 0; r < 16; ++r) { e0[r] = __builtin_amdgcn_exp2f(p0[r] - m); e1[r] = __builtin_amdgcn_exp2f(p1[r] - m); }
        if (i == 0) {
#pragma unroll
            for (int r = 0; r < 16; ++r) { const int kl = (r & 3) + 8 * (r >> 2) + 4 * hi; if (kl > ql) e0[r] = 0.f; if (kl + 32 > ql) e1[r] = 0.f; }
        } else if (MODE == 1) {
            if (i == 8) {
#pragma unroll
                for (int r = 0; r < 16; ++r) { const int kl = (r & 3) + 8 * (r >> 2) + 4 * hi; if (kl <= ql) e0[r] = 0.f; if (kl + 32 <= ql) e1[r] = 0.f; }
            }
        } else {
            const float f = ((msk >> (tq - i)) & 1u) ? 1.f : 0.f;
            e0 *= f; e1 *= f;
        }
        float ls = 0.f;
#pragma unroll
        for (int r = 0; r < 16; ++r) ls += e0[r] + e1[r];
        p0 = e0; p1 = e1;
        l += ls;
        bf16x8 pb[4];
        pb[0] = pack8(p0, 0); pb[1] = pack8(p0, 8); pb[2] = pack8(p1, 0); pb[3] = pack8(p1, 8);
        asm volatile("s_waitcnt lgkmcnt(0)" ::: "memory");
#pragma unroll
        for (int ks = 0; ks < 4; ++ks) { o0 = AT_MFMA(vf[2 * ks], pb[ks], o0); o1 = AT_MFMA(vf[2 * ks + 1], pb[ks], o1); }
        if (i + 1 < nt) {
            char* nb = lds + ((i + 1) & 1) * 2 * TILE_B;
            *(uint4*)(nb + kst) = kA; *(uint2*)(nb + vst) = make_uint2(vA.x, vA.y); *(uint2*)(nb + vst + 16) = make_uint2(vA.z, vA.w);
        }
        __syncthreads();
    };
    for (int i = 0; i < nt; i += 2) {
        step(i, k2, v2, k1, v1);
        if (i + 1 < nt) step(i + 1, k1, v1, k2, v2);
    }
    const float lt = l + lane_xor32(l), inv = 1.f / lt;
    const size_t obase = trow * 512 + h * 64 + 8 * hi;
    float g0 = 0.f, g1 = inv, g2 = 0.f;
    uint4 cc[2][2], ww[2][2];
    if (MODE == 0) {
        g0 = gates[trow * 24 + h * 3 + 0]; g1 = gates[trow * 24 + h * 3 + 1] * inv; g2 = gates[trow * 24 + h * 3 + 2];
#pragma unroll
        for (int dh = 0; dh < 2; ++dh)
#pragma unroll
            for (int rp = 0; rp < 2; ++rp) { cc[dh][rp] = *(const uint4*)(o_cmp + obase + 32 * dh + 16 * rp); ww[dh][rp] = *(const uint4*)(o_win + obase + 32 * dh + 16 * rp); }
    }
#pragma unroll
    for (int dh = 0; dh < 2; ++dh)
#pragma unroll
        for (int rp = 0; rp < 2; ++rp) {
            const f32x16& oo = dh ? o1 : o0;
            float x[8];
#pragma unroll
            for (int j = 0; j < 4; ++j) {
                const auto r = __builtin_amdgcn_permlane32_swap(__float_as_uint(oo[8 * rp + j]), __float_as_uint(oo[8 * rp + 4 + j]), false, false);
                x[j] = __uint_as_float(r[0]) * g1; x[4 + j] = __uint_as_float(r[1]) * g1;
            }
            if (MODE == 0) {
                const unsigned cw[4] = {cc[dh][rp].x, cc[dh][rp].y, cc[dh][rp].z, cc[dh][rp].w}, wv[4] = {ww[dh][rp].x, ww[dh][rp].y, ww[dh][rp].z, ww[dh][rp].w};
#pragma unroll
                for (int k = 0; k < 4; ++k) {
                    x[2 * k] += g0 * __uint_as_float(cw[k] << 16) + g2 * __uint_as_float(wv[k] << 16);
                    x[2 * k + 1] += g0 * __uint_as_float(cw[k] & 0xffff0000u) + g2 * __uint_as_float(wv[k] & 0xffff0000u);
                }
            }
            uint4 o; o.x = pg::cvt_pk_bf16(x[0], x[1]); o.y = pg::cvt_pk_bf16(x[2], x[3]); o.z = pg::cvt_pk_bf16(x[4], x[5]); o.w = pg::cvt_pk_bf16(x[6], x[7]);
            *(uint4*)(out + obase + 32 * dh + 16 * rp) = o;
        }
}

constexpr int CK_ROW = 144, CV_ROW = 272, CK_B = 128 * CK_ROW, CV_B = 64 * CV_ROW, CP_OFF = CK_B + CV_B, CI_OFF = CP_OFF + 4 * 64 * 32 * 4, CMP_LDS = CI_OFF + 64 * 32 * 8;
__device__ __forceinline__ void cmp_unit(char* lds, int b, int g, int tq, const bf16_t* __restrict__ Q, const bf16_t* __restrict__ kc, const bf16_t* __restrict__ vcT,
                                         bf16_t* __restrict__ out, unsigned* __restrict__ selmask) {
    const int tid = opaque_tid(), lane = tid & 63, r32 = lane & 31, hi = lane >> 5;
    const int wid = __builtin_amdgcn_readfirstlane(tid >> 6), hl = wid >> 1, qs = wid & 1;
    const int ql = 32 * qs + r32, qpos = tq * 64 + ql, h = g * 4 + hl, bg = b * 2 + g;
    const size_t trow = (size_t)b * S + qpos;
    __syncthreads();
#pragma unroll
    for (int i = 0; i < 2; ++i) {
        const int ch = tid + 512 * i;
        { const int row = ch >> 3, c8 = ch & 7; *(uint4*)(lds + row * CK_ROW + c8 * 16) = *(const uint4*)(kc + ((size_t)bg * 128 + row) * 64 + c8 * 8); }
        { const int row = ch >> 4, c16 = ch & 15; const uint4 x = *(const uint4*)(vcT + ((size_t)bg * 64 + row) * 128 + c16 * 8);
          char* dst = lds + CK_B + row * CV_ROW + ((c16 >> 1) * 16 + (c16 & 1) * 4) * 2; *(uint2*)dst = make_uint2(x.x, x.y); *(uint2*)(dst + 16) = make_uint2(x.z, x.w); }
    }
    bf16x8 qf[4];
#pragma unroll
    for (int d0 = 0; d0 < 4; ++d0) qf[d0] = *(const bf16x8*)(Q + trow * 512 + h * 64 + 16 * d0 + 8 * hi);
    __syncthreads();
    f32x16 p[4];
#pragma unroll
    for (int kh = 0; kh < 4; ++kh) {
#pragma unroll
        for (int r = 0; r < 16; ++r) p[kh][r] = 0.f;
#pragma unroll
        for (int d0 = 0; d0 < 4; ++d0) { const bf16x8 kf = *(const bf16x8*)(lds + (32 * kh + r32) * CK_ROW + d0 * 32 + hi * 16); p[kh] = AT_MFMA(kf, qf[d0], p[kh]); }
    }
    float mx = -1e30f;
#pragma unroll
    for (int kh = 0; kh < 4; ++kh)
#pragma unroll
        for (int r = 0; r < 16; ++r) { const int c = 32 * kh + (r & 3) + 8 * (r >> 2) + 4 * hi; if (16 * c + 31 > qpos) p[kh][r] = -1e30f; mx = fmaxf(mx, p[kh][r]); }
    mx = fmaxf(mx, lane_xor32(mx));
    float ls = 0.f;
#pragma unroll
    for (int kh = 0; kh < 4; ++kh)
#pragma unroll
        for (int r = 0; r < 16; ++r) { p[kh][r] = __builtin_amdgcn_exp2f(p[kh][r] - mx); ls += p[kh][r]; }
    ls += lane_xor32(ls);
    const float inv = (mx > -1e29f) ? 1.f / ls : 0.f;
#pragma unroll
    for (int kh = 0; kh < 4; ++kh)
#pragma unroll
        for (int r = 0; r < 16; ++r) p[kh][r] *= inv;
    f32x16 o0, o1;
#pragma unroll
    for (int r = 0; r < 16; ++r) { o0[r] = 0.f; o1[r] = 0.f; }
#pragma unroll
    for (int ks = 0; ks < 8; ++ks) {
        const bf16x8 pb = pack8(p[ks >> 1], (ks & 1) * 8);
        const bf16x8 vf0 = *(const bf16x8*)(lds + CK_B + r32 * CV_ROW + ks * 32 + hi * 16), vf1 = *(const bf16x8*)(lds + CK_B + (32 + r32) * CV_ROW + ks * 32 + hi * 16);
        o0 = AT_MFMA(vf0, pb, o0); o1 = AT_MFMA(vf1, pb, o1);
    }
    bf16_t* orow = out + trow * 512 + h * 64 + 8 * hi;
#pragma unroll
    for (int dh = 0; dh < 2; ++dh)
#pragma unroll
        for (int rp = 0; rp < 2; ++rp) {
            const f32x16& oo = dh ? o1 : o0;
            const unsigned ax = pg::cvt_pk_bf16_acc(oo[8 * rp], oo[8 * rp + 1]), ay = pg::cvt_pk_bf16_acc(oo[8 * rp + 2], oo[8 * rp + 3]);
            const unsigned bx = pg::cvt_pk_bf16_acc(oo[8 * rp + 4], oo[8 * rp + 5]), by = pg::cvt_pk_bf16_acc(oo[8 * rp + 6], oo[8 * rp + 7]);
            const auto rx = __builtin_amdgcn_permlane32_swap(ax, bx, false, false);
            const auto ry = __builtin_amdgcn_permlane32_swap(ay, by, false, false);
            *(uint4*)(orow + 32 * dh + 16 * rp) = make_uint4(rx[0], ry[0], rx[1], ry[1]);
        }
    float inn[16], car[16];
#pragma unroll
    for (int t = 0; t < 16; ++t) { const f32x16& pk = p[t >> 2]; const int r0 = 4 * (t & 3); car[t] = 0.5f * pk[r0 + 3]; inn[t] = pk[r0] + pk[r0 + 1] + pk[r0 + 2] + car[t]; }
    float* part = (float*)(lds + CP_OFF) + (hl * 64 + ql) * 32;
#pragma unroll
    for (int t = 0; t < 16; ++t) {
        const float co = lane_xor32(car[t]);
        const float cprev = t > 0 ? lane_xor32(car[t - 1]) : 0.f;
        part[2 * t + hi] = inn[t] + (hi ? co : cprev);
    }
    __syncthreads();
    unsigned long long* impk = (unsigned long long*)(lds + CI_OFF);
    const float* pall = (const float*)(lds + CP_OFF);
#pragma unroll
    for (int k = 0; k < 4; ++k) {
        const int idx = tid + 512 * k, q = idx >> 5, j = idx & 31, cur = tq;
        float imp = ((pall[(0 * 64 + q) * 32 + j] + pall[(1 * 64 + q) * 32 + j]) + pall[(2 * 64 + q) * 32 + j]) + pall[(3 * 64 + q) * 32 + j];
        if (j == 0 || j == cur || j == cur - 1) imp = 1e30f; else if (j > cur) imp = -1e30f;
        const unsigned bb = __float_as_uint(imp), uo = (bb & 0x80000000u) ? ~bb : (bb | 0x80000000u);
        impk[idx] = ((unsigned long long)uo << 5) | (unsigned)(31 - j);
    }
    __syncthreads();
#pragma unroll
    for (int k = 0; k < 4; ++k) {
        const int idx = tid + 512 * k, q = idx >> 5;
        const unsigned long long mine = impk[idx];
        int rank = 0;
#pragma unroll
        for (int i = 0; i < 32; ++i) rank += (impk[q * 32 + i] > mine) ? 1 : 0;
        const unsigned long long bal = __ballot(rank < 16);
        if ((lane & 31) == 0) selmask[(size_t)bg * S + tq * 64 + q] = (unsigned)(hi ? (bal >> 32) : (bal & 0xffffffffull));
    }
}

constexpr int XK_ROW = 528, XV_ROW = 144, XK_B = 64 * XK_ROW, XV_B = 256 * XV_ROW;
typedef float f32x4v __attribute__((ext_vector_type(4)));
#define XT_MFMA(a, b, c) __builtin_amdgcn_mfma_f32_16x16x32_bf16(a, b, c, 0, 0, 0)
__device__ __forceinline__ void xattn_unit(char* lds, int b, int h, int qt, const bf16_t* __restrict__ Q, const bf16_t* __restrict__ xk, const bf16_t* __restrict__ xvT, unsigned char* __restrict__ out) {
    const int tid = opaque_tid(), lane = tid & 63, l15 = lane & 15, quad = lane >> 4;
    const int wid = __builtin_amdgcn_readfirstlane(tid >> 6);
    const size_t trow = (size_t)b * S + qt * 128 + wid * 16 + l15;
    const bf16_t* Kb = xk + (size_t)(b * 4 + h) * 256 * 256;
    const bf16_t* Vb = xvT + (size_t)(b * 4 + h) * 256 * 256;
    bf16x8 qf[8];
#pragma unroll
    for (int ds = 0; ds < 8; ++ds) qf[ds] = *(const bf16x8*)(Q + trow * 1024 + h * 256 + 32 * ds + 8 * quad);
    f32x4v o[16];
#pragma unroll
    for (int db = 0; db < 16; ++db) o[db] = (f32x4v){0.f, 0.f, 0.f, 0.f};
    float m = -INFINITY, l = 0.f;
    constexpr int XIMG = XK_B + XV_B;
    for (int kt2 = 0; kt2 < 2; ++kt2) {
        __syncthreads();
        uint4 kx[2][4], vx[2][4];
#pragma unroll
        for (int hf = 0; hf < 2; ++hf)
#pragma unroll
            for (int i = 0; i < 4; ++i) {
                const int ch = tid + 512 * i, kt = 2 * kt2 + hf;
                kx[hf][i] = *(const uint4*)(Kb + (size_t)(kt * 64 + (ch >> 5)) * 256 + (ch & 31) * 8);
                vx[hf][i] = *(const uint4*)(Vb + (size_t)(ch >> 3) * 256 + kt * 64 + (ch & 7) * 8);
            }
#pragma unroll
        for (int hf = 0; hf < 2; ++hf)
#pragma unroll
            for (int i = 0; i < 4; ++i) {
                const int ch = tid + 512 * i;
                char* Lw = lds + hf * XIMG;
                { const int row = ch >> 5, c = ch & 31; *(uint4*)(Lw + row * XK_ROW + c * 16) = kx[hf][i]; }
                { const int row = ch >> 3, c = ch & 7, cp = c & 3; const uint4 x = vx[hf][i];
                  char* dst = Lw + XK_B + row * XV_ROW + ((c >> 2) * 32 + 16 * (cp & 1) + 4 * (cp >> 1)) * 2; *(uint2*)dst = make_uint2(x.x, x.y); *(uint2*)(dst + 16) = make_uint2(x.z, x.w); }
            }
        __syncthreads();
      for (int hf = 0; hf < 2; ++hf) {
        const char* L = lds + hf * XIMG;
        f32x4v sc[4];
#pragma unroll
        for (int kb = 0; kb < 4; ++kb) {
            sc[kb] = (f32x4v){0.f, 0.f, 0.f, 0.f};
#pragma unroll
            for (int ds = 0; ds < 8; ++ds) { const bf16x8 kf = *(const bf16x8*)(L + (16 * kb + l15) * XK_ROW + ds * 64 + quad * 16); sc[kb] = XT_MFMA(kf, qf[ds], sc[kb]); }
        }
        float mx = -INFINITY;
#pragma unroll
        for (int kb = 0; kb < 4; ++kb)
#pragma unroll
            for (int r = 0; r < 4; ++r) mx = fmaxf(mx, sc[kb][r]);
        mx = fmaxf(mx, lane_xor16(mx)); mx = fmaxf(mx, lane_xor32(mx));
        const float mn = fmaxf(m, mx), alpha = __builtin_amdgcn_exp2f(m - mn);
        m = mn;
        float ls = 0.f;
#pragma unroll
        for (int kb = 0; kb < 4; ++kb)
#pragma unroll
            for (int r = 0; r < 4; ++r) { sc[kb][r] = __builtin_amdgcn_exp2f(sc[kb][r] - mn); ls += sc[kb][r]; }
        l = l * alpha + ls;
#pragma unroll
        for (int db = 0; db < 16; ++db) o[db] *= alpha;
#pragma unroll
        for (int k2 = 0; k2 < 2; ++k2) {
            union { unsigned u[4]; bf16x8 v; } pb;
            pb.u[0] = pg::cvt_pk_bf16(sc[2 * k2][0], sc[2 * k2][1]); pb.u[1] = pg::cvt_pk_bf16(sc[2 * k2][2], sc[2 * k2][3]);
            pb.u[2] = pg::cvt_pk_bf16(sc[2 * k2 + 1][0], sc[2 * k2 + 1][1]); pb.u[3] = pg::cvt_pk_bf16(sc[2 * k2 + 1][2], sc[2 * k2 + 1][3]);
#pragma unroll
            for (int db = 0; db < 16; ++db) { const bf16x8 vf = *(const bf16x8*)(L + XK_B + (16 * db + l15) * XV_ROW + k2 * 64 + quad * 16); o[db] = XT_MFMA(vf, pb.v, o[db]); }
        }
          }
    }
    l += lane_xor16(l); l += lane_xor32(l);
    const float inv = 1.f / l;
    unsigned char* orow = out + trow * 1024 + h * 256 + 16 * quad;
    const float inv16 = inv * 16.f;
#pragma unroll
    for (int s4 = 0; s4 < 4; ++s4) {
        unsigned d[4];
#pragma unroll
        for (int dl = 0; dl < 4; ++dl) { const int db = 4 * s4 + dl; d[dl] = pg::pk4_fp8(o[db][0] * inv16, o[db][1] * inv16, o[db][2] * inv16, o[db][3] * inv16); }
        *(uint4*)(orow + 64 * s4) = make_uint4(d[0], d[1], d[2], d[3]);
    }
}
}


namespace tl {
using pg::bf16_t; using pg::cvt_pk_bf16;
__device__ __forceinline__ float blo(unsigned u) { return __uint_as_float(u << 16); }
__device__ __forceinline__ float bhi(unsigned u) { return __uint_as_float(u & 0xffff0000u); }
__device__ __forceinline__ float ssq4(const float4& a) { return a.x * a.x + a.y * a.y + a.z * a.z + a.w * a.w; }

__device__ __forceinline__ void rmsnorm_rows(const float* __restrict__ in, const float* __restrict__ g, bf16_t* __restrict__ out, int rows, int gw, int nw, int lane) {
    float4 gv[4];
#pragma unroll
    for (int i = 0; i < 4; ++i) gv[i] = *(const float4*)(g + 256 * i + 4 * lane);
    for (int rb = gw; rb < rows; rb += 8 * nw) {
        float4 a[8][4];
#pragma unroll
        for (int j = 0; j < 8; ++j)
#pragma unroll
            for (int i = 0; i < 4; ++i) a[j][i] = (rb + nw * j < rows) ? *(const float4*)(in + (size_t)(rb + nw * j) * 1024 + 256 * i + 4 * lane) : make_float4(0.f, 0.f, 0.f, 0.f);
        asm volatile("" ::: "memory");
#pragma unroll
        for (int j = 0; j < 8; ++j) {
            const int r = rb + nw * j;
            float sa = ssq4(a[j][0]) + ssq4(a[j][1]) + ssq4(a[j][2]) + ssq4(a[j][3]);
            sa = wave_sum(sa);
            const float ra = rsqrtf(sa * (1.f / 1024.f) + 1e-5f);
            if (r < rows) {
#pragma unroll
                for (int i = 0; i < 4; ++i) {
                    uint2 o; o.x = cvt_pk_bf16(a[j][i].x * ra * gv[i].x, a[j][i].y * ra * gv[i].y); o.y = cvt_pk_bf16(a[j][i].z * ra * gv[i].z, a[j][i].w * ra * gv[i].w);
                    *(uint2*)(out + (size_t)r * 1024 + 256 * i + 4 * lane) = o;
                }
            }
        }
    }
}

__device__ __forceinline__ void mix_post(const bf16_t* __restrict__ o_nsa, const bf16_t* __restrict__ ub, const bf16_t* __restrict__ cbb, const float* __restrict__ conv_w,
                                         const float* __restrict__ g_nsa, const float* __restrict__ g_conv, bf16_t* __restrict__ omix, int gw, int nw, int lane) {
    float cw[3][8], gn[8], gc[8];
#pragma unroll
    for (int j = 0; j < 8; ++j) { gn[j] = g_nsa[8 * lane + j]; gc[j] = g_conv[8 * lane + j]; cw[0][j] = conv_w[8 * lane + j]; cw[1][j] = conv_w[512 + 8 * lane + j]; cw[2][j] = conv_w[1024 + 8 * lane + j]; }
    for (int tb = gw; tb < T; tb += 4 * nw) {
      const uint4 zero = make_uint4(0u, 0u, 0u, 0u);
      uint4 L_on[4], L_c[4], L_u2[4], L_u1[4], L_u0[4];
#pragma unroll
      for (int j = 0; j < 4; ++j) {
        const int t = min(tb + nw * j, T - 1), sq = t & (S - 1);
        L_on[j] = *(const uint4*)(o_nsa + (size_t)t * 512 + 8 * lane); L_c[j] = *(const uint4*)(cbb + (size_t)t * 512 + 8 * lane); L_u2[j] = *(const uint4*)(ub + (size_t)t * 512 + 8 * lane);
        L_u1[j] = *(const uint4*)(ub + (size_t)(t - (sq >= 1 ? 1 : 0)) * 512 + 8 * lane); L_u0[j] = *(const uint4*)(ub + (size_t)(t - (sq >= 2 ? 2 : 0)) * 512 + 8 * lane);
        if (sq < 1) L_u1[j] = zero;
        if (sq < 2) L_u0[j] = zero;
      }
      asm volatile("" ::: "memory");
#pragma unroll
      for (int j = 0; j < 4; ++j) {
        const int t = tb + nw * j;
        if (t < T) {
        const uint4 on4 = L_on[j], c4 = L_c[j], u2 = L_u2[j], u1 = L_u1[j], u0 = L_u0[j];
        const unsigned onw[4] = {on4.x, on4.y, on4.z, on4.w}, cbw[4] = {c4.x, c4.y, c4.z, c4.w}, u0w[4] = {u0.x, u0.y, u0.z, u0.w}, u1w[4] = {u1.x, u1.y, u1.z, u1.w}, u2w[4] = {u2.x, u2.y, u2.z, u2.w};
        float on[8], oc[8], ssn = 0.f, ssc = 0.f;
#pragma unroll
        for (int q = 0; q < 4; ++q) {
            on[2 * q] = blo(onw[q]); on[2 * q + 1] = bhi(onw[q]);
            const float y0 = cw[0][2 * q] * blo(u0w[q]) + cw[1][2 * q] * blo(u1w[q]) + cw[2][2 * q] * blo(u2w[q]);
            const float y1 = cw[0][2 * q + 1] * bhi(u0w[q]) + cw[1][2 * q + 1] * bhi(u1w[q]) + cw[2][2 * q + 1] * bhi(u2w[q]);
            oc[2 * q] = blo(cbw[q]) * y0; oc[2 * q + 1] = bhi(cbw[q]) * y1;
        }
#pragma unroll
        for (int j = 0; j < 8; ++j) { ssn += on[j] * on[j]; ssc += oc[j] * oc[j]; }
        ssn = wave_sum(ssn); ssc = wave_sum(ssc);
        const float rn = rsqrtf(ssn * (1.f / 512.f) + 1e-5f), rc = rsqrtf(ssc * (1.f / 512.f) + 1e-5f);
        uint4 o1, o2;
        o1.x = cvt_pk_bf16(on[0] * rn * gn[0], on[1] * rn * gn[1]); o1.y = cvt_pk_bf16(on[2] * rn * gn[2], on[3] * rn * gn[3]); o1.z = cvt_pk_bf16(on[4] * rn * gn[4], on[5] * rn * gn[5]); o1.w = cvt_pk_bf16(on[6] * rn * gn[6], on[7] * rn * gn[7]);
        o2.x = cvt_pk_bf16(oc[0] * rc * gc[0], oc[1] * rc * gc[1]); o2.y = cvt_pk_bf16(oc[2] * rc * gc[2], oc[3] * rc * gc[3]); o2.z = cvt_pk_bf16(oc[4] * rc * gc[4], oc[5] * rc * gc[5]); o2.w = cvt_pk_bf16(oc[6] * rc * gc[6], oc[7] * rc * gc[7]);
        *(uint4*)(omix + (size_t)t * 1024 + 8 * lane) = o1; *(uint4*)(omix + (size_t)t * 1024 + 512 + 8 * lane) = o2;
        }
      }
    }
}

__device__ __forceinline__ void xreduce32(float (&acc)[32], int lane) {
    const bool b3 = lane & 8, b2 = lane & 4, b1 = lane & 2;
#pragma unroll
    for (int e = 0; e < 16; ++e) { const auto r = __builtin_amdgcn_permlane32_swap(__float_as_uint(acc[e]), __float_as_uint(acc[e + 16]), false, false); acc[e] = __uint_as_float(r[0]) + __uint_as_float(r[1]); }
#pragma unroll
    for (int e = 0; e < 8; ++e) { const auto r = __builtin_amdgcn_permlane16_swap(__float_as_uint(acc[e]), __float_as_uint(acc[e + 8]), false, false); acc[e] = __uint_as_float(r[0]) + __uint_as_float(r[1]); }
#pragma unroll
    for (int e = 0; e < 4; ++e) { const float snd = b3 ? acc[e] : acc[e + 4], kp = b3 ? acc[e + 4] : acc[e]; acc[e] = kp + dpp_xor8(snd); }
#pragma unroll
    for (int e = 0; e < 2; ++e) { const float snd = b2 ? acc[e] : acc[e + 2], kp = b2 ? acc[e + 2] : acc[e]; acc[e] = kp + dpp_xor4(snd); }
    { const float snd = b1 ? acc[0] : acc[1], kp = b1 ? acc[1] : acc[0]; acc[0] = kp + dpp_xor2(snd); }
    acc[0] += dpp_xor1(acc[0]);
}
__device__ __forceinline__ void route_token(float logit, int t, int lane, int* __restrict__ a_e, float* __restrict__ a_w, int* __restrict__ a_slot, int* lcnt) {
    const int e = lane >> 1;
    int rank = 0;
#pragma unroll
    for (int i = 0; i < 32; ++i) { const float x = __int_as_float(__builtin_amdgcn_readlane(__float_as_int(logit), 2 * i)); rank += (x > logit || (x == logit && i < e)) ? 1 : 0; }
    const float vmax = wave_max(logit);
    const bool sel = (rank < TOPK) && !(lane & 1);
    const float ex = sel ? __expf(logit - vmax) : 0.f;
    const float sum = wave_sum(ex);
    if (sel) { const int a = t * TOPK + rank; a_e[a] = e; a_w[a] = ex / sum; a_slot[a] = atomicAdd(&lcnt[e], 1); }
}
constexpr int WR_STRIDE = 1028;
constexpr int RW_ROW = 2064;
constexpr int RW_IMG = NE * RW_ROW;
__device__ __forceinline__ void norm_router(char* lds, const bf16_t* __restrict__ h2, const float* __restrict__ g, const float* __restrict__ wr, const float* __restrict__ br, unsigned char* __restrict__ xn8,
                                            int* __restrict__ a_e, float* __restrict__ a_w, int* __restrict__ a_slot, int* __restrict__ wgcnt  , int gw, int nw, int lane) {
    typedef short rbf16x8 __attribute__((ext_vector_type(8)));
    typedef float rf32x4 __attribute__((ext_vector_type(4)));
    int* lcnt = (int*)(lds + 2 * RW_IMG);
    float* wlog = (float*)(lds + 2 * RW_IMG + 128) + (threadIdx.x >> 6) * 272;
    __syncthreads();
    {
        constexpr int NP = (2 * RW_IMG / 16 + 511) / 512;
        uint4 st[NP];
#pragma unroll
        for (int i = 0; i < NP; ++i) { const int idx = (int)threadIdx.x + 512 * i; st[i] = idx < 2 * RW_IMG / 16 ? ((const uint4*)wr)[idx] : make_uint4(0u, 0u, 0u, 0u); }
#pragma unroll
        for (int i = 0; i < NP; ++i) { const int idx = (int)threadIdx.x + 512 * i; if (idx < 2 * RW_IMG / 16) ((uint4*)lds)[idx] = st[i]; }
    }
    if (threadIdx.x < NE) lcnt[threadIdx.x] = 0;
    const int l15 = lane & 15, quad = lane >> 4;
    int tb = gw;
    do {
        const int trow = tb + nw * (l15 & 7);
        const bool valid = l15 < 8 && trow < T;
        rbf16x8 af[32];
        const bf16_t* ap = h2 + (size_t)(valid ? trow : tb) * 1024 + 8 * quad;
#pragma unroll
        for (int ks = 0; ks < 32; ++ks) { const uint4 v = valid ? *(const uint4*)(ap + 32 * ks) : make_uint4(0u, 0u, 0u, 0u); af[ks] = __builtin_bit_cast(rbf16x8, v); }
        if (tb == gw) __syncthreads();
        rf32x4 acc0 = {0.f, 0.f, 0.f, 0.f}, acc1 = acc0, accs = acc0;
        const char* bh = lds + l15 * RW_ROW + quad * 16;
        rbf16x8 bq[2][4];
        bq[0][0] = *(const rbf16x8*)(bh); bq[0][1] = *(const rbf16x8*)(bh + 16 * RW_ROW); bq[0][2] = *(const rbf16x8*)(bh + RW_IMG); bq[0][3] = *(const rbf16x8*)(bh + RW_IMG + 16 * RW_ROW);
#pragma unroll
        for (int ks = 0; ks < 32; ++ks) {
            if (ks + 1 < 32) {
                const int o = (ks + 1) * 64;
                bq[(ks + 1) & 1][0] = *(const rbf16x8*)(bh + o); bq[(ks + 1) & 1][1] = *(const rbf16x8*)(bh + 16 * RW_ROW + o);
                bq[(ks + 1) & 1][2] = *(const rbf16x8*)(bh + RW_IMG + o); bq[(ks + 1) & 1][3] = *(const rbf16x8*)(bh + RW_IMG + 16 * RW_ROW + o);
            }
            acc0 = __builtin_amdgcn_mfma_f32_16x16x32_bf16(af[ks], bq[ks & 1][0], acc0, 0, 0, 0); acc1 = __builtin_amdgcn_mfma_f32_16x16x32_bf16(af[ks], bq[ks & 1][1], acc1, 0, 0, 0);
            acc0 = __builtin_amdgcn_mfma_f32_16x16x32_bf16(af[ks], bq[ks & 1][2], acc0, 0, 0, 0); acc1 = __builtin_amdgcn_mfma_f32_16x16x32_bf16(af[ks], bq[ks & 1][3], acc1, 0, 0, 0);
            accs = __builtin_amdgcn_mfma_f32_16x16x32_bf16(af[ks], af[ks], accs, 0, 0, 0);
        }
        {
            const int rsel = l15 & 3;
            const float dg = rsel == 0 ? accs[0] : rsel == 1 ? accs[1] : rsel == 2 ? accs[2] : accs[3];
            if (quad == (l15 >> 2)) wlog[256 + l15] = rsqrtf(dg * (1.f / 1024.f) + 1e-5f);
        }
        __builtin_amdgcn_fence(__ATOMIC_RELEASE, "wavefront"); __builtin_amdgcn_s_waitcnt(0xc07f);
        if (quad < 2) {
            const rf32x4 rs4 = *(const rf32x4*)(wlog + 256 + 4 * quad);
            const float b0 = br[l15], b1 = br[16 + l15];
#pragma unroll
            for (int r = 0; r < 4; ++r) { wlog[(4 * quad + r) * 32 + l15] = rs4[r] * acc0[r] + b0; wlog[(4 * quad + r) * 32 + 16 + l15] = rs4[r] * acc1[r] + b1; }
        }
        __builtin_amdgcn_fence(__ATOMIC_RELEASE, "wavefront"); __builtin_amdgcn_s_waitcnt(0xc07f);
        float4 gv[4];
#pragma unroll
        for (int i = 0; i < 4; ++i) gv[i] = *(const float4*)(g + 256 * i + 4 * lane);
        uint2 hv[8][4];
#pragma unroll
        for (int j = 0; j < 8; ++j)
#pragma unroll
            for (int i = 0; i < 4; ++i) hv[j][i] = *(const uint2*)(h2 + (size_t)min(tb + nw * j, T - 1) * 1024 + 256 * i + 4 * lane);
        asm volatile("" ::: "memory");
        const bool full = tb + 7 * nw < T;
        if (full) {
            float rsv[8];
#pragma unroll
            for (int j = 0; j < 8; ++j) rsv[j] = wlog[256 + j];
#pragma unroll
            for (int j = 0; j < 8; ++j)
#pragma unroll
                for (int i = 0; i < 4; ++i)
                    *(unsigned*)(xn8 + (size_t)(tb + nw * j) * 1024 + 256 * i + 4 * lane) = pg::pk4_fp8(blo(hv[j][i].x) * rsv[j] * gv[i].x, bhi(hv[j][i].x) * rsv[j] * gv[i].y, blo(hv[j][i].y) * rsv[j] * gv[i].z, bhi(hv[j][i].y) * rsv[j] * gv[i].w);
        } else {
#pragma unroll
            for (int j = 0; j < 8; ++j) {
                const int t = tb + nw * j;
                if (t < T) {
                    const float rs = wlog[256 + j];
#pragma unroll
                    for (int i = 0; i < 4; ++i)
                        *(unsigned*)(xn8 + (size_t)t * 1024 + 256 * i + 4 * lane) = pg::pk4_fp8(blo(hv[j][i].x) * rs * gv[i].x, bhi(hv[j][i].x) * rs * gv[i].y, blo(hv[j][i].y) * rs * gv[i].z, bhi(hv[j][i].y) * rs * gv[i].w);
                }
            }
        }
        {
            const int j = lane >> 3, sub = lane & 7, t = tb + nw * j;
            const rf32x4 own = *(const rf32x4*)(wlog + j * 32 + 4 * sub);
            float v[4] = {own[0], own[1], own[2], own[3]};
            float bv[4]; int bi[4];
#pragma unroll
            for (int r = 0; r < 4; ++r) {
                float cv = v[0]; int ci = 4 * sub;
#pragma unroll
                for (int k = 1; k < 4; ++k) { const bool tk = v[k] > cv; cv = tk ? v[k] : cv; ci = tk ? 4 * sub + k : ci; }
                { const float ov = dpp_xor1(cv); const int oi = __float_as_int(dpp_xor1(__int_as_float(ci))); const bool tk = ov > cv || (ov == cv && oi < ci); cv = tk ? ov : cv; ci = tk ? oi : ci; }
                { const float ov = dpp_xor2(cv); const int oi = __float_as_int(dpp_xor2(__int_as_float(ci))); const bool tk = ov > cv || (ov == cv && oi < ci); cv = tk ? ov : cv; ci = tk ? oi : ci; }
                { const float ov = dpp_xor4(cv); const int oi = __float_as_int(dpp_xor4(__int_as_float(ci))); const bool tk = ov > cv || (ov == cv && oi < ci); cv = tk ? ov : cv; ci = tk ? oi : ci; }
                bv[r] = cv; bi[r] = ci;
#pragma unroll
                for (int k = 0; k < 4; ++k) if (ci == 4 * sub + k) v[k] = -INFINITY;
            }
            const float e1 = __expf(bv[1] - bv[0]), e2 = __expf(bv[2] - bv[0]), e3 = __expf(bv[3] - bv[0]);
            const float sum = ((1.f + e1) + e2) + e3;
            if (sub < TOPK && t < T) {
                const float ex = sub == 0 ? 1.f : sub == 1 ? e1 : sub == 2 ? e2 : e3;
                const int e = sub == 0 ? bi[0] : sub == 1 ? bi[1] : sub == 2 ? bi[2] : bi[3];
                const int a = t * TOPK + sub;
                a_e[a] = e; a_w[a] = ex / sum; a_slot[a] = atomicAdd(&lcnt[e], 1);
            }
        }
        tb += 8 * nw;
    } while (tb < T);
    __syncthreads();
    if (threadIdx.x < NE) wgcnt[blockIdx.x * NE + threadIdx.x] = lcnt[threadIdx.x];
}
__device__ __forceinline__ void moe_scatter(char* lds, const int* __restrict__ wgcnt, int* __restrict__ pstart, int* __restrict__ tile_e, const int* __restrict__ a_e, const float* __restrict__ a_w,
                                            const int* __restrict__ a_slot, int* __restrict__ tokmap, float* __restrict__ w_buf, int* __restrict__ dest_of, int wg, int gw, int nw, int lane) {
    int* ps = (int*)lds;
    int* wb = ps + 64;
    int* part = ps + 128;
    __syncthreads();
    {
        const int e = threadIdx.x & 31, q = threadIdx.x >> 5, nwg_ = gridDim.x;
        int tot = 0, below = 0;
        const int per = (nwg_ + 15) / 16;
        for (int base = 0; base < per; base += 16) {
            int cv[16];
#pragma unroll
            for (int i = 0; i < 16; ++i) { const int w = q * per + base + i; cv[i] = (base + i < per && w < nwg_) ? wgcnt[w * NE + e] : 0; }
#pragma unroll
            for (int i = 0; i < 16; ++i) { const int w = q * per + base + i; tot += cv[i]; below += (w < wg) ? cv[i] : 0; }
        }
        part[(q * NE + e) * 2] = tot; part[(q * NE + e) * 2 + 1] = below;
    }
    __syncthreads();
    if (threadIdx.x < NE) { int tot = 0, below = 0; for (int q = 0; q < 16; ++q) { tot += part[(q * NE + threadIdx.x) * 2]; below += part[(q * NE + threadIdx.x) * 2 + 1]; } ps[96 + threadIdx.x] = tot; wb[threadIdx.x] = below; }
    __syncthreads();
    if (threadIdx.x == 0) { int acc = 0; for (int e = 0; e < NE; ++e) { ps[e] = acc; acc += (ps[96 + e] + MT - 1) / MT * MT; } ps[NE] = acc; }
    __syncthreads();
    if (wg == 0) {
        if (threadIdx.x == 0) pstart[NE] = ps[NE] / MT;
        for (int tl_ = threadIdx.x; tl_ < NTILE; tl_ += 512) { const int r = tl_ * MT; int e = -1; for (int i = 0; i < NE; ++i) if (r >= ps[i] && r < ps[i + 1]) e = i; tile_e[tl_] = e; }
    }
    for (int i = threadIdx.x; i < 8 * ((T + nw - 1) / nw); i += 512) {
        const int t = (gw - (int)(threadIdx.x >> 6)) + (i & 7) + nw * (i >> 3);
        if (t < T) {
            const int4 e4 = *(const int4*)(a_e + 4 * t), s4 = *(const int4*)(a_slot + 4 * t); const float4 w4 = *(const float4*)(a_w + 4 * t);
            const int ee[4] = {e4.x, e4.y, e4.z, e4.w}, sl[4] = {s4.x, s4.y, s4.z, s4.w}; const float ww[4] = {w4.x, w4.y, w4.z, w4.w};
            int dd[4];
#pragma unroll
            for (int k = 0; k < 4; ++k) { dd[k] = ps[ee[k]] + wb[ee[k]] + sl[k]; w_buf[dd[k]] = ww[k]; tokmap[dd[k]] = t; }
            *(int4*)(dest_of + 4 * t) = make_int4(dd[0], dd[1], dd[2], dd[3]);
        }
    }
    (void)lane;
}
__device__ __forceinline__ void final_rows(const bf16_t* __restrict__ h2, const unsigned char* __restrict__ out_a, const int* __restrict__ dest_of, const float* __restrict__ g, float* __restrict__ out, int gw, int nw, int lane) {
    const int cp = 128 * ((lane >> 1) & 1) + 32 * (lane >> 4) + 16 * (lane & 1) + 4 * ((lane >> 2) & 3);
    float4 gv[4];
#pragma unroll
    for (int i = 0; i < 4; ++i) gv[i] = *(const float4*)(g + 256 * i + cp);
    for (int t = gw; t < T; t += nw) {
        const int4 d4 = *(const int4*)(dest_of + 4 * t);
        const int dd[4] = {d4.x, d4.y, d4.z, d4.w};
        uint2 hh[4]; unsigned oa[4][4];
#pragma unroll
        for (int i = 0; i < 4; ++i) hh[i] = *(const uint2*)(h2 + (size_t)t * 1024 + 256 * i + cp);
#pragma unroll
        for (int k = 0; k < 4; ++k)
#pragma unroll
            for (int i = 0; i < 4; ++i) oa[k][i] = *(const unsigned*)(out_a + (size_t)dd[k] * 1024 + 256 * i + 4 * lane);
        float4 a[4];
        float ss = 0.f;
#pragma unroll
        for (int i = 0; i < 4; ++i) {
            float s0 = 0.f, s1 = 0.f, s2 = 0.f, s3 = 0.f;
#pragma unroll
            for (int k = 0; k < 4; ++k) {
                const auto lo = __builtin_amdgcn_cvt_pk_f32_fp8(oa[k][i], false), hi = __builtin_amdgcn_cvt_pk_f32_fp8(oa[k][i], true);
                s0 += lo[0]; s1 += lo[1]; s2 += hi[0]; s3 += hi[1];
            }
            a[i] = make_float4(blo(hh[i].x) + 0.125f * s0, bhi(hh[i].x) + 0.125f * s1, blo(hh[i].y) + 0.125f * s2, bhi(hh[i].y) + 0.125f * s3);
            ss += ssq4(a[i]);
        }
        ss = wave_sum(ss);
        const float rs = rsqrtf(ss * (1.f / 1024.f) + 1e-5f);
#pragma unroll
        for (int i = 0; i < 4; ++i) *(float4*)(out + (size_t)t * 1024 + 256 * i + cp) = make_float4(a[i].x * rs * gv[i].x, a[i].y * rs * gv[i].y, a[i].z * rs * gv[i].z, a[i].w * rs * gv[i].w);
    }
}
}

template <bool PERM64, class RowMap>
__device__ __forceinline__ void p_convT(char* lds, const float* __restrict__ W, int K, int N, int nmat, pg::bf16_t* __restrict__ Bt, int nrows_out, RowMap rowmap, int wg, int nwg, const float* __restrict__ kscale = nullptr) {
    uint2* Ls = (uint2*)lds;
    const int tid = opaque_tid();
    const int tk = K / 128, tn = nrows_out / 128, per = tk * tn, total = per * nmat;
    float4 x[2][4];
    auto issue = [&](int tile) {
        const int mat = tile / per, r = tile % per, jn = r / tk, jk = r % tk;
#pragma unroll
        for (int j = 0; j < 2; ++j) {
            const int bid = tid + 512 * j, kb = bid >> 5, n4 = (bid & 31) * 4;
            const int n0 = rowmap(jn * 128 + (n4 & 96));
            const float* src = W + (size_t)mat * K * N + (size_t)(jk * 128 + 4 * kb) * N + n0 + (n4 & 31);
            const bool ok = n0 >= 0 && n0 + (n4 & 31) < N;
#pragma unroll
            for (int rr = 0; rr < 4; ++rr) x[j][rr] = ok ? *(const float4*)(src + (size_t)rr * N) : make_float4(0.f, 0.f, 0.f, 0.f);
        }
    };
    int tile = wg;
    if (tile < total) issue(tile);
    while (tile < total) {
        const int mat = tile / per, r = tile % per, jn = r / tk, jk = r % tk;
        __syncthreads();
#pragma unroll
        for (int j = 0; j < 2; ++j) {
            const int bid = tid + 512 * j, kb = bid >> 5, n4 = (bid & 31) * 4;
            float ks[4];
#pragma unroll
            for (int rr = 0; rr < 4; ++rr) ks[rr] = kscale ? kscale[jk * 128 + 4 * kb + rr] : 1.f;
            uint4 d0, d1;
            d0.x = pg::cvt_pk_bf16(x[j][0].x * ks[0], x[j][1].x * ks[1]); d0.y = pg::cvt_pk_bf16(x[j][2].x * ks[2], x[j][3].x * ks[3]);
            d0.z = pg::cvt_pk_bf16(x[j][0].y * ks[0], x[j][1].y * ks[1]); d0.w = pg::cvt_pk_bf16(x[j][2].y * ks[2], x[j][3].y * ks[3]);
            d1.x = pg::cvt_pk_bf16(x[j][0].z * ks[0], x[j][1].z * ks[1]); d1.y = pg::cvt_pk_bf16(x[j][2].z * ks[2], x[j][3].z * ks[3]);
            d1.z = pg::cvt_pk_bf16(x[j][0].w * ks[0], x[j][1].w * ks[1]); d1.w = pg::cvt_pk_bf16(x[j][2].w * ks[2], x[j][3].w * ks[3]);
            *(uint4*)(Ls + kb * 130 + n4) = d0; *(uint4*)(Ls + kb * 130 + n4 + 2) = d1;
        }
        const int nxt = tile + nwg;
        if (nxt < total) issue(nxt);
        __syncthreads();
#pragma unroll
        for (int i = 0; i < 4; ++i) {
            const int c = tid + 512 * i, n = c >> 4, kc = c & 15;
            const int ns = PERM64 ? ((n & 64) | (n & 15) | ((n & 16) << 1) | ((n & 32) >> 1)) : n;
            const uint2 lo = Ls[(2 * kc) * 130 + ns], hi = Ls[(2 * kc + 1) * 130 + ns];
            *(uint4*)(Bt + ((size_t)mat * nrows_out + jn * 128 + n) * K + jk * 128 + 8 * kc) = make_uint4(lo.x, lo.y, hi.x, hi.y);
        }
        tile = nxt;
    }
}

struct K256 { __device__ __forceinline__ int operator()(int k) const { return (k & ~255) | (((k >> 3) & 1) << 7) | (((k >> 6) & 3) << 5) | (((k >> 2) & 1) << 4) | (((k >> 4) & 3) << 2); } };
struct KXo { __device__ __forceinline__ int operator()(int k) const { return (k & ~63) | (((k >> 2) & 3) << 4) | (((k >> 4) & 3) << 2); } };
struct KIdent { __device__ __forceinline__ int operator()(int k) const { return k; } };
struct KHmid { __device__ __forceinline__ int operator()(int k) const { return (k & ~31) | (((k >> 2) & 1) << 4) | (((k >> 3) & 3) << 2); } };
template <class RowMap, class KMap = KIdent>
__device__ __forceinline__ void p_convT8(char* lds, const float* __restrict__ W, int K, int N, int nmat, unsigned char* __restrict__ Bt, int nrows_out, RowMap rowmap, int wg, int nwg, const float* __restrict__ kscale = nullptr, KMap kmap = KMap()) {
    unsigned* Ls = (unsigned*)lds;
    const int tid = opaque_tid();
    const int tk = K / 128, tn = nrows_out / 128, per = tk * tn, total = per * nmat;
    float4 x[2][4];
    auto issue = [&](int tile) {
        const int mat = tile / per, r = tile % per, jk = r / tn, jn = r % tn;
#pragma unroll
        for (int j = 0; j < 2; ++j) {
            const int bid = tid + 512 * j, kb = bid >> 5, n4 = (bid & 31) * 4;
            const int n0 = rowmap(jn * 128 + (n4 & 64));
            const float* src = W + (size_t)mat * K * N + (size_t)kmap(jk * 128 + 4 * kb) * N + n0 + (n4 & 63);
            const bool ok = n0 >= 0 && n0 + (n4 & 63) < N;
#pragma unroll
            for (int rr = 0; rr < 4; ++rr) x[j][rr] = ok ? *(const float4*)(src + (size_t)rr * N) : make_float4(0.f, 0.f, 0.f, 0.f);
        }
    };
    int tile = wg;
    if (tile < total) issue(tile);
    while (tile < total) {
        const int mat = tile / per, r = tile % per, jk = r / tn, jn = r % tn;
        __syncthreads();
#pragma unroll
        for (int j = 0; j < 2; ++j) {
            const int bid = tid + 512 * j, kb = bid >> 5, n4 = (bid & 31) * 4;
            float ks[4];
#pragma unroll
            for (int rr = 0; rr < 4; ++rr) ks[rr] = pg::W8_SCALE * (kscale ? kscale[kmap(jk * 128 + 4 * kb) + rr] : 1.f);
            uint4 d;
            d.x = pg::pk4_fp8(x[j][0].x * ks[0], x[j][1].x * ks[1], x[j][2].x * ks[2], x[j][3].x * ks[3]);
            d.y = pg::pk4_fp8(x[j][0].y * ks[0], x[j][1].y * ks[1], x[j][2].y * ks[2], x[j][3].y * ks[3]);
            d.z = pg::pk4_fp8(x[j][0].z * ks[0], x[j][1].z * ks[1], x[j][2].z * ks[2], x[j][3].z * ks[3]);
            d.w = pg::pk4_fp8(x[j][0].w * ks[0], x[j][1].w * ks[1], x[j][2].w * ks[2], x[j][3].w * ks[3]);
            *(uint4*)(Ls + kb * 132 + n4) = d;
        }
        const int nxt = tile + nwg;
        if (nxt < total) issue(nxt);
        __syncthreads();
#pragma unroll
        for (int i = 0; i < 2; ++i) {
            const int c = tid + 512 * i, n = c >> 3, kc = c & 7;
            uint4 y; y.x = Ls[(4 * kc + 0) * 132 + n]; y.y = Ls[(4 * kc + 1) * 132 + n]; y.z = Ls[(4 * kc + 2) * 132 + n]; y.w = Ls[(4 * kc + 3) * 132 + n];
            *(uint4*)(Bt + ((size_t)mat * nrows_out + jn * 128 + n) * K + jk * 128 + 16 * kc) = y;
        }
        tile = nxt;
    }
}

struct Params {
    const float *x, *mem; const int* positions;
    const float *g_mix_norm, *w_mix_in, *cmp_pos_k, *cmp_pos_v, *cmp_w1_k, *cmp_b1_k, *cmp_w2_k, *cmp_w1_v, *cmp_b1_v, *cmp_w2_v, *conv_w, *g_nsa_out, *g_conv_out, *w_mix_out,
        *g_xattn_norm, *g_mem_norm, *w_xq, *w_xkv, *w_xo, *g_moe_norm, *w_router, *b_router, *w_gate_up, *b_gate_up, *w_down, *b_down, *g_final;
    float* out;
    unsigned* bar; unsigned* queue;
    int *wgcnt, *counts, *pstart, *tile_e, *a_e, *a_slot, *dest_of, *tok_buf;
    float *a_w, *w_buf;
    unsigned* selmask;
    float *hid_k, *hid_v, *kc, *vc, *memn, *xkv, *hbuf, *xn, *o_cmp, *o_slc, *o_win, *xq, *proj, *xo;
    unsigned short *hmid, *out_a, *xg, *wt_gu, *wt_dn; unsigned char *hmid8, *wt_dn8, *wt_gu8, *xg8, *xn8, *out_a8, *h1_8, *xo8, *wt_xq8, *wt_xo8; unsigned short* h1_bf; float* ssq; float* wrt;
    unsigned short *q_bf, *kcmp, *vcmp, *kslc, *vslcT, *kwin, *vwinT, *u_bf, *cb_bf; float *gates, *cosT, *sinT;
    unsigned short *xq_bf, *xk_bf, *xvT_bf, *ocmp_bf, *owin_bf, *onsa_bf;
    unsigned short *wt_c1k, *wt_c1v, *kc_bf, *vcT_bf; float *Pab_k, *Pab_v, *b1p_k, *b1p_v;
    unsigned short *xn_bf, *memn_bf, *xo_bf, *wt_mix_in, *wt_xkv, *wt_mix_out, *wt_xq, *wt_xo;
};

typedef const __attribute__((address_space(4))) Params* KParams;
#define P (*kp)
#define KP_FRESH asm volatile("" : "+s"(kp))
__global__ void __launch_bounds__(512, 2) mega_fwd(Params p_unused) {
    KParams kp = (KParams)__builtin_amdgcn_kernarg_segment_ptr();
    extern __shared__ __attribute__((aligned(16))) char lds[];
    if (threadIdx.x < 4) ((unsigned*)lds)[threadIdx.x] = 0u;
    __syncthreads();
    XcdBarrier bar = xcd_barrier_post(P.bar, (volatile LAS unsigned*)lds);
    LAS unsigned char* glds = (LAS unsigned char*)(lds + 1024);

    {
        const int wg = blockIdx.x, nwg = gridDim.x;
        auto ident = [](int j) { return j; };
        auto mixmap = [](int j) {
            const int unit = j >> 8, g = (j & 255) >> 5, bj = g >> 2, wc = g & 3;
            if (unit < 2) return C_Q + (unit * 4 + wc) * 64 + 32 * bj;
            if (unit == 2) return (wc < 2 ? C_KC + wc * 64 : C_VC + (wc - 2) * 64) + 32 * bj;
            if (unit == 3) return (wc < 2 ? C_KS + wc * 64 : C_VS + (wc - 2) * 64) + 32 * bj;
            if (unit == 4) return (wc < 2 ? C_KW + wc * 64 : C_VW + (wc - 2) * 64) + 32 * bj;
            if (unit < 9) return (bj ? C_CC : C_CH) + (unit - 5) * 128 + 32 * wc;
            if (unit < 11) return C_CB + (unit - 9) * 256 + 32 * g;
            return g == 0 ? C_GL : -1;
        };
        p_convT<false>(lds + 1024, P.w_mix_in, D, INC, 1, P.wt_mix_in, 3072, mixmap, wg, nwg);
        p_convT<false>(lds + 1024, P.w_xkv, D, 2048, 1, P.wt_xkv, 2048, ident, wg, nwg);
        p_convT<false>(lds + 1024, P.w_mix_out, D, D, 1, P.wt_mix_out, D, ident, wg, nwg);
        p_convT8(lds + 1024, P.w_xq, D, D, 1, P.wt_xq8, D, ident, wg, nwg, P.g_xattn_norm, K256());
        p_convT8(lds + 1024, P.w_xo, D, D, 1, P.wt_xo8, D, ident, wg, nwg, nullptr, KXo());
        auto gumap = [](int j) { const int blk = j >> 8, w = j & 255; return w < 128 ? 128 * blk + w : 1024 + 128 * blk + (w - 128); };
        p_convT8(lds + 1024, P.w_gate_up, D, 2048, NE, P.wt_gu8, 2048, gumap, wg, nwg);
        p_convT8(lds + 1024, P.w_down, DFF, D, NE, P.wt_dn8, D, ident, wg, nwg, nullptr, KHmid());
        p_convT<false>(lds + 1024, P.cmp_w1_k, 1024, 256, 2, P.wt_c1k, 256, ident, wg, nwg);
        p_convT<false>(lds + 1024, P.cmp_w1_v, 1024, 256, 2, P.wt_c1v, 256, ident, wg, nwg);
        for (int o = wg * 8 + (threadIdx.x >> 6); o < 512; o += nwg * 8) {
            if (o < 256) posbias_wave(o, threadIdx.x & 63, P.cmp_pos_k, P.cmp_w1_k, P.cmp_b1_k, P.b1p_k); else posbias_wave(o - 256, threadIdx.x & 63, P.cmp_pos_v, P.cmp_w1_v, P.cmp_b1_v, P.b1p_v);
        }
        __syncthreads();
    }
    p_rope_table(blockIdx.x * 512 + threadIdx.x, gridDim.x * 512, P.positions, (unsigned*)P.cosT);
    for (int i = blockIdx.x * 512 + threadIdx.x; i < PMAX; i += gridDim.x * 512) P.tok_buf[i] = 0;
    for (int idx = blockIdx.x * 512 + threadIdx.x; idx < 512 * NE; idx += gridDim.x * 512) {
        const int e = idx >> 9, k = (idx & 511) * 2;
        const float w0 = P.g_moe_norm[k] * P.w_router[k * NE + e], w1 = P.g_moe_norm[k + 1] * P.w_router[(k + 1) * NE + e];
        const unsigned short h0 = f2bf_rne(w0), h1 = f2bf_rne(w1);
        const unsigned short l0 = f2bf_rne(w0 - __uint_as_float((unsigned)h0 << 16)), l1 = f2bf_rne(w1 - __uint_as_float((unsigned)h1 << 16));
        *(unsigned*)((char*)P.wrt + e * tl::RW_ROW + k * 2) = (unsigned)h0 | ((unsigned)h1 << 16);
        *(unsigned*)((char*)P.wrt + tl::RW_IMG + e * tl::RW_ROW + k * 2) = (unsigned)l0 | ((unsigned)l1 << 16);
    }
    tl::rmsnorm_rows(P.x, P.g_mix_norm, P.xn_bf, T, (int)(blockIdx.x * 8 + (opaque_tid() >> 6)), (int)(gridDim.x * 8), opaque_tid() & 63);
    tl::rmsnorm_rows(P.mem, P.g_mem_norm, P.memn_bf, NB * NMEM, (int)(blockIdx.x * 8 + (opaque_tid() >> 6)), (int)(gridDim.x * 8), opaque_tid() & 63);
    xcd_barrier(bar);
    KP_FRESH;
    {
        pg::DenseOrder So; So.init(P.xn_bf, P.wt_mix_in, T, 3072, 2048u, 2048u, (int)gridDim.x, (int)blockIdx.x); So.aux_mask = (1u << 3) | (1u << 4);
        pg::EpiMixIn E{P.q_bf, P.kcmp, P.vslcT, P.u_bf, P.cb_bf, P.gates, P.cosT, P.sinT};
        pg::gemm_phase<true>(glds, D, 2048u, 2048u, So, E);
    }
    xcd_barrier(bar);
    KP_FRESH;
    {
        volatile int* item_s = (volatile int*)(lds + 64);
        for (;;) {
            __syncthreads();
            if (threadIdx.x == 0) *item_s = (int)atomicAdd(P.queue, 1u);
            __syncthreads();
            const int item = __builtin_amdgcn_readfirstlane(*item_s);
            if (item >= 96 + 512) break;
            if (item < 64) {
                const int pm = item >> 3, pn = item & 7;
                pg::OneUnit So; So.u.A = (const char*)P.memn_bf + (size_t)pm * 256 * 2048; So.u.B = (const char*)P.wt_xkv + (size_t)pn * 256 * 2048; So.u.row0 = pm * 256; So.u.col0 = pn * 256; So.u.aux = 0;
                pg::EpiXkv E{P.xk_bf, P.xvT_bf};
                pg::gemm_phase(glds, D, 2048u, 2048u, So, E);
            } else if (item < 96) {
                const int which = (item - 64) >> 4, r = (item - 64) & 15, pm = r >> 1, pn = r & 1;
                pg::OneUnit So; So.u.A = (const char*)(which ? P.vcmp : P.kcmp) + (size_t)pm * 256 * 2048; So.u.B = (const char*)(which ? P.wt_c1v : P.wt_c1k) + (size_t)pn * 256 * 2048; So.u.row0 = pm * 256; So.u.col0 = pn * 256; So.u.aux = 0;
                pg::EpiF32R E{which ? P.Pab_v : P.Pab_k, 512, nullptr, 512};
                pg::gemm_phase(glds, 1024, 2048u, 2048u, So, E);
            } else {
                const int idx = item - 96, tq = 31 - (idx >> 4), bg = idx & 15;
                at::attn64_unit<1>(lds + 1024, bg >> 1, bg & 1, tq, P.q_bf, P.kwin, P.vwinT, P.selmask, P.owin_bf, nullptr, nullptr, nullptr);
            }
        }
    }
    xcd_barrier(bar);
    KP_FRESH;
    p_cmp_finalize(lds + 1024, P.Pab_k, P.Pab_v, P.b1p_k, P.b1p_v, P.cmp_w2_k, P.cmp_w2_v, P.kc_bf, P.vcT_bf, blockIdx.x, gridDim.x);
    xcd_barrier(bar);
    KP_FRESH;
    for (int item0 = blockIdx.x; item0 < 256; item0 += gridDim.x) {
        const int item = (item0 & 7) * 32 + (item0 >> 3);
        const int bg = item >> 4, j = item & 15;
        at::cmp_unit(lds + 1024, bg >> 1, bg & 1, 31 - j, P.q_bf, P.kc_bf, P.vcT_bf, P.ocmp_bf, P.selmask);
        at::cmp_unit(lds + 1024, bg >> 1, bg & 1, j, P.q_bf, P.kc_bf, P.vcT_bf, P.ocmp_bf, P.selmask);
        asm volatile("s_waitcnt vmcnt(0)" ::: "memory");
        __syncthreads();
        at::attn64_unit<0>(lds + 1024, bg >> 1, bg & 1, 31 - j, P.q_bf, P.kslc, P.vslcT, P.selmask, P.onsa_bf, P.ocmp_bf, P.owin_bf, P.gates);
        at::attn64_unit<0>(lds + 1024, bg >> 1, bg & 1, j, P.q_bf, P.kslc, P.vslcT, P.selmask, P.onsa_bf, P.ocmp_bf, P.owin_bf, P.gates);
    }
    xcd_barrier(bar);
    KP_FRESH;
    tl::mix_post(P.onsa_bf, P.u_bf, P.cb_bf, P.conv_w, P.g_nsa_out, P.g_conv_out, P.xn_bf  , (int)(blockIdx.x * 8 + (opaque_tid() >> 6)), (int)(gridDim.x * 8), opaque_tid() & 63);
    xcd_barrier(bar);
    KP_FRESH;
    {
        pg::DenseOrder So; So.init(P.xn_bf, P.wt_mix_out, T, D, 2048u, 2048u, (int)gridDim.x, (int)blockIdx.x);
        pg::EpiResNormStats E{P.x, P.h1_bf, P.ssq, P.h1_8};
        pg::gemm_phase(glds, D, 2048u, 2048u, So, E);
    }
    xcd_barrier(bar);
    KP_FRESH;
    {
        pg::DenseOrder So; So.init(P.h1_8, P.wt_xq8, T, D, 1024u, 1024u, (int)gridDim.x, (int)blockIdx.x);
        pg::EpiBf16RowScale E{P.xq_bf, P.ssq, 0.0625f * 1.4426950408889634f * pg::W8_INV};
        pg::gemm_phase_f8(glds, D, 1024u, 1024u, So, E);
        for (int L = blockIdx.x; L < (T / 256) * (D / 256); L += gridDim.x) {
            int pm, h; pg::dense_map(L, T / 256, D / 256, pm, h);
            const int b = pm >> 3, qt = (pm & 7) * 2;
            at::xattn_unit(lds + 1024, b, h, qt, P.xq_bf, P.xk_bf, P.xvT_bf, P.xo8);
            at::xattn_unit(lds + 1024, b, h, qt + 1, P.xq_bf, P.xk_bf, P.xvT_bf, P.xo8);
        }
    }
    xcd_barrier(bar);
    KP_FRESH;
    {
        pg::DenseOrder So; So.init(P.xo8, P.wt_xo8, T, D, 1024u, 1024u, (int)gridDim.x, (int)blockIdx.x);
        pg::EpiBf16Res E{P.h1_bf, pg::W8_INV * (1.f / 16.f)};
        pg::gemm_phase_f8(glds, D, 1024u, 1024u, So, E);
    }
    xcd_barrier(bar);
    KP_FRESH;
    tl::norm_router(lds + 1024, P.h1_bf, P.g_moe_norm, P.wrt, P.b_router, P.xn8, P.a_e, P.a_w, P.a_slot, P.wgcnt, (int)(blockIdx.x * 8 + (opaque_tid() >> 6)), (int)(gridDim.x * 8), opaque_tid() & 63);
    xcd_barrier(bar);
    KP_FRESH;
    tl::moe_scatter(lds + 1024, P.wgcnt, P.pstart, P.tile_e, P.a_e, P.a_w, P.a_slot, P.tok_buf, P.w_buf, P.dest_of, blockIdx.x, (int)(blockIdx.x * 8 + (opaque_tid() >> 6)), (int)(gridDim.x * 8), opaque_tid() & 63);
    xcd_barrier(bar);
    KP_FRESH;
    {
        pg::MoeOrderB<8> So; So.init(P.xn8, P.wt_gu8, P.tile_e, P.pstart[NE], (size_t)2048 * 1024, 1024u, (int)gridDim.x, (int)blockIdx.x);
        pg::EpiSwigluF8 E{P.hmid8, P.b_gate_up};
        pg::gemm_phase_f8g(glds, D, 1024u, 1024u, So, E, (const char*)P.xn8, P.tok_buf);
    }
    xcd_barrier(bar);
    KP_FRESH;
    {
        pg::MoeOrderB<4> So; So.init(P.hmid8, P.wt_dn8, P.tile_e, P.pstart[NE], (size_t)1024 * 1024, 1024u, (int)gridDim.x, (int)blockIdx.x);
        pg::EpiDownScaleF8 E{P.out_a8, P.b_down, P.w_buf};
        pg::gemm_phase_f8(glds, DFF, 1024u, 1024u, So, E);
    }
    xcd_barrier(bar);
    KP_FRESH;
    tl::final_rows(P.h1_bf, P.out_a8, P.dest_of, P.g_final, P.out, (int)(blockIdx.x * 8 + (opaque_tid() >> 6)), (int)(gridDim.x * 8), opaque_tid() & 63);
}
__global__ void k_fail(float* out, int n) { const int i = blockIdx.x * 256 + threadIdx.x; if (i < n) out[i] = __builtin_nanf(""); }
}

extern "C" void kernel_launch(void* const* d_in, const int* in_sizes, int n_in, void* d_out, int out_size, void* d_ws, size_t ws_size, hipStream_t stream) {
    Params p{};
    p.x = (const float*)d_in[0]; p.mem = (const float*)d_in[1]; p.positions = (const int*)d_in[2];
    const float** fp = &p.g_mix_norm;
    for (int i = 0; i < 27; ++i) fp[i] = (const float*)d_in[3 + i];
    p.out = (float*)d_out;

    char* ws = (char*)d_ws;
    size_t off = 0;
    auto take = [&](size_t bytes) { char* q = ws + off; off += (bytes + 255) & ~(size_t)255; return q; };
    p.bar = (unsigned*)take(XCD_BAR_WORDS * 4);
    p.counts = (int*)take(NE * 4);
    p.queue = (unsigned*)take(256);
    const size_t zero_bytes = off;
    p.pstart = (int*)take((NE + 1) * 4);
    p.wgcnt = (int*)take(1024 * NE * 4);
    p.tile_e = (int*)take(NTILE * 4);
    p.a_e = (int*)take(NA * 4);
    p.a_w = (float*)take(NA * 4);
    p.a_slot = (int*)take(NA * 4);
    p.dest_of = (int*)take(NA * 4);
    p.w_buf = (float*)take(PMAX * 4);
    p.tok_buf = (int*)take(PMAX * 4);
    p.selmask = (unsigned*)take((size_t)NB * 2 * S * 4);
    p.out_a8 = (unsigned char*)take((size_t)PMAX * D);
    p.xn8 = (unsigned char*)take((size_t)T * D);
    p.h1_bf = (unsigned short*)take((size_t)T * D * 2);
    p.ssq = (float*)take((size_t)T * 16 * 4);
    p.wrt = (float*)take((size_t)2 * tl::RW_IMG + 256);
    p.hmid8 = (unsigned char*)take((size_t)PMAX * DFF);
    p.wt_gu8 = (unsigned char*)take((size_t)NE * 2048 * D);
    p.wt_dn8 = (unsigned char*)take((size_t)NE * D * DFF);
    p.q_bf = (unsigned short*)take((size_t)T * 512 * 2);
    p.kcmp = (unsigned short*)take((size_t)T * 128 * 2 * 4); p.vcmp = p.kcmp + (size_t)T * 128; p.kslc = p.vcmp + (size_t)T * 128; p.kwin = p.kslc + (size_t)T * 128;
    p.vslcT = (unsigned short*)take((size_t)T * 128 * 2 * 2); p.vwinT = p.vslcT + (size_t)T * 128;
    p.u_bf = (unsigned short*)take((size_t)T * 512 * 2); p.cb_bf = (unsigned short*)take((size_t)T * 512 * 2);
    p.gates = (float*)take((size_t)T * 24 * 4); p.cosT = (float*)take((size_t)T * 32 * 4); p.sinT = (float*)take((size_t)T * 32 * 4);
    p.wt_c1k = (unsigned short*)take((size_t)512 * 1024 * 2); p.wt_c1v = (unsigned short*)take((size_t)512 * 1024 * 2);
    p.kc_bf = (unsigned short*)take((size_t)16 * 128 * 64 * 2); p.vcT_bf = (unsigned short*)take((size_t)16 * 64 * 128 * 2);
    p.Pab_k = (float*)take((size_t)(2048 + 1) * 512 * 4); p.Pab_v = (float*)take((size_t)(2048 + 1) * 512 * 4);
    p.b1p_k = (float*)take(256 * 4); p.b1p_v = (float*)take(256 * 4);
    p.ocmp_bf = (unsigned short*)take((size_t)T * 512 * 2); p.owin_bf = (unsigned short*)take((size_t)T * 512 * 2); p.onsa_bf = (unsigned short*)take((size_t)T * 512 * 2);
    p.xq_bf = (unsigned short*)take((size_t)T * D * 2); p.xk_bf = (unsigned short*)take((size_t)NB * NMEM * D * 2); p.xvT_bf = (unsigned short*)take((size_t)NB * NMEM * D * 2);
    p.xn_bf = (unsigned short*)take((size_t)T * D * 2);
    p.memn_bf = (unsigned short*)take((size_t)NB * NMEM * D * 2);
    p.xo8 = (unsigned char*)take((size_t)T * D);
    p.h1_8 = (unsigned char*)take((size_t)T * D);
    p.wt_mix_in = (unsigned short*)take((size_t)3072 * D * 2);
    p.wt_xkv = (unsigned short*)take((size_t)2048 * D * 2);
    p.wt_mix_out = (unsigned short*)take((size_t)D * D * 2);
    p.wt_xq8 = (unsigned char*)take((size_t)D * D);
    p.wt_xo8 = (unsigned char*)take((size_t)D * D);

    static int grid = 0;
    if (grid == 0) {
        int dev = 0, cus = 0;
        if (hipGetDevice(&dev) != hipSuccess || hipDeviceGetAttribute(&cus, hipDeviceAttributeMultiprocessorCount, dev) != hipSuccess) cus = -1;
        if (hipFuncSetAttribute((const void*)mega_fwd, hipFuncAttributeMaxDynamicSharedMemorySize, LDS_BYTES) != hipSuccess) cus = -1;
        int per_cu = 0;
        if (cus > 0 && (hipOccupancyMaxActiveBlocksPerMultiprocessor(&per_cu, (const void*)mega_fwd, 512, LDS_BYTES) != hipSuccess || per_cu < 1)) cus = -1;
        (void)hipGetLastError();
        grid = cus > 0 ? cus : -1;
    }
    if (grid < 0 || off > ws_size) { k_fail<<<(out_size + 255) / 256, 256, 0, stream>>>((float*)d_out, out_size); return; }
    (void)hipMemsetAsync(d_ws, 0, zero_bytes, stream);
    hipLaunchKernelGGL(mega_fwd, dim3(grid), dim3(512), LDS_BYTES, stream, p);
}
```
